# Optimizing an MI355X kernel written in HIP

```python
import math
import jax
import jax.numpy as jnp
from jax import lax
import numpy as np

D_MODEL = 1024
BATCH = 16
SEQ = 2048
DEPTH = 4

GRID_W = 64
CTX_LEN = 256
HEAD_DIM = 64
DN_HEADS = 4
DN_WIDTH = DN_HEADS * HEAD_DIM
DN_CHUNK = 64
CONV_W = 5
SWA_HEADS = 8
SWA_KV_HEADS = 2
SWA_GROUP = SWA_HEADS // SWA_KV_HEADS
SWA_WIDTH = SWA_HEADS * HEAD_DIM
SWA_KV_WIDTH = SWA_KV_HEADS * HEAD_DIM
WINDOW = 128
SWA_BLOCK = 128
ROPE_BASE = 10000.0
HG_HEADS = 4
HG_WIDTH = HG_HEADS * HEAD_DIM
HG_CHUNK = 64
D_MIX = DN_WIDTH + SWA_WIDTH + HG_WIDTH
D_FF = 4 * D_MODEL
N_MOD = 6
EPS = 1e-6
F32 = jnp.float32
IN_SIZES = (3 * DN_WIDTH, DN_WIDTH, 2 * DN_HEADS, 2 * DN_HEADS,
            SWA_WIDTH, SWA_KV_WIDTH, SWA_KV_WIDTH,
            HG_WIDTH, 2 * HG_WIDTH, HG_WIDTH, HG_WIDTH)
D_IN = 4 * DN_WIDTH + 4 * DN_HEADS + SWA_WIDTH + 2 * SWA_KV_WIDTH + 5 * HG_WIDTH

kernel_name = 'hybrid_dit_deltanet_swa_hgrn2'


def rmsnorm(x, gain):
    xf = x.astype(F32)
    y = xf * lax.rsqrt(jnp.mean(xf * xf, axis=-1, keepdims=True) + EPS)
    return (y * gain.astype(F32)).astype(x.dtype)


def modulate(h, shift, scale):
    return h * (1 + scale) + shift


def to_heads(a, n):
    B, T, _ = a.shape
    return a.reshape(B, T, n, -1).transpose(0, 2, 1, 3)


def from_heads(a):
    B, H, T, d = a.shape
    return a.transpose(0, 2, 1, 3).reshape(B, T, H * d)


def l2norm(a):
    a = a.astype(F32)
    return a * lax.rsqrt(jnp.sum(a * a, axis=-1, keepdims=True) + EPS)


def head_norm_gate(o, gain, gate):
    o = o * lax.rsqrt(jnp.mean(o * o, axis=-1, keepdims=True) + EPS) * gain.astype(F32)
    return (from_heads(o) * jax.nn.silu(gate.astype(F32))).astype(gate.dtype)


def centred_conv(a, w):
    pad = CONV_W // 2
    return lax.conv_general_dilated(a, w[:, None, :], (1,), [(pad, pad)],
                                    dimension_numbers=('NWC', 'WIO', 'NWC'),
                                    feature_group_count=a.shape[-1])


def split_in(p):
    out, start = [], 0
    for size in IN_SIZES:
        out.append(p[..., start:start + size])
        start += size
    return out


def flip_t(a, d):
    return jnp.flip(a, axis=2) if d else a


def to_chunks(a, C):
    B, H, T = a.shape[:3]
    return jnp.moveaxis(a.reshape((B, H, T // C, C) + a.shape[3:]), 2, 0)


def from_chunks(a):
    a = jnp.moveaxis(a, 0, 2)
    return a.reshape(a.shape[:2] + (-1,) + a.shape[4:])


def axial_rope_tables(T):
    rows = T // GRID_W
    row = jnp.repeat(jnp.arange(rows), GRID_W).astype(F32)
    col = jnp.tile(jnp.arange(GRID_W), rows).astype(F32)
    half = HEAD_DIM // 2
    inv = ROPE_BASE ** (-jnp.arange(0, half, 2, dtype=F32) / half)
    ang = jnp.concatenate([row[:, None] * inv, col[:, None] * inv], axis=-1)
    return jnp.cos(ang), jnp.sin(ang)


def apply_rope(a, cos, sin):
    a1, a2 = a[..., :HEAD_DIM // 2], a[..., HEAD_DIM // 2:]
    return jnp.concatenate([a1 * cos - a2 * sin, a1 * sin + a2 * cos], axis=-1)


def gated_delta_scan(q, k, v, beta, g, S0):
    C = DN_CHUNK
    tri = jnp.tril(jnp.ones((C, C), bool))
    strict = jnp.tril(jnp.ones((C, C), bool), -1)
    eye = jnp.eye(C, dtype=F32)

    def step(S, blk):
        qi, ki, vi, bi, gi = blk
        gc = jnp.cumsum(gi, axis=-1)
        decay = jnp.exp(jnp.where(tri, gc[..., :, None] - gc[..., None, :], -jnp.inf))
        kb = ki * bi[..., None]
        a = jnp.where(strict, jnp.einsum('bhid,bhjd->bhij', kb, ki) * decay, 0.0) + eye
        rhs = jnp.concatenate([vi * bi[..., None], kb * jnp.exp(gc)[..., None]], axis=-1)
        uw = lax.linalg.triangular_solve(a, rhs, left_side=True, lower=True, unit_diagonal=True)
        u, w = uw[..., :HEAD_DIM], uw[..., HEAD_DIM:]
        v_new = u - jnp.einsum('bhck,bhkv->bhcv', w, S)
        scores = jnp.einsum('bhid,bhjd->bhij', qi, ki) * decay
        o = (jnp.einsum('bhck,bhkv->bhcv', qi * jnp.exp(gc)[..., None], S)
             + jnp.einsum('bhij,bhjv->bhiv', scores, v_new))
        g_last = gc[..., -1:]
        S = (S * jnp.exp(g_last)[..., None]
             + jnp.einsum('bhck,bhcv->bhkv', ki * jnp.exp(g_last - gc)[..., None], v_new))
        return S, o

    S, o = lax.scan(step, S0, tuple(to_chunks(t, C) for t in (q, k, v, beta, g)))
    return from_chunks(o), S


def gla_scan(q, k, v, logf, S0):
    C = HG_CHUNK
    tri = jnp.tril(jnp.ones((C, C), bool))[:, :, None]

    def step(S, blk):
        qi, ki, vi, lfi = blk
        bc = jnp.cumsum(lfi, axis=2)
        decay = jnp.exp(jnp.where(tri, bc[:, :, :, None, :] - bc[:, :, None, :, :], -jnp.inf))
        scores = jnp.einsum('bhik,bhijk,bhjk->bhij', qi, decay, ki)
        o = (jnp.einsum('bhij,bhjv->bhiv', scores, vi)
             + jnp.einsum('bhck,bhkv->bhcv', qi * jnp.exp(bc), S))
        b_last = bc[:, :, -1:, :]
        S = (S * jnp.exp(b_last)[:, :, 0, :, None]
             + jnp.einsum('bhck,bhcv->bhkv', ki * jnp.exp(b_last - bc), vi))
        return S, o

    S, o = lax.scan(step, S0, tuple(to_chunks(t, C) for t in (q, k, v, logf)))
    return from_chunks(o), S


def deltanet_group(p_lat, p_ctx, conv_w, A_log, dt_bias, norm_g, need_ctx):
    def prep(qkv, a, b):
        qkv = jax.nn.silu(centred_conv(qkv, conv_w))
        q, k, v = jnp.split(qkv, 3, axis=-1)
        q = l2norm(to_heads(q, DN_HEADS)) * HEAD_DIM ** -0.5
        k = l2norm(to_heads(k, DN_HEADS))
        v = to_heads(v, DN_HEADS).astype(F32)
        B, T, _ = a.shape
        a = a.reshape(B, T, 2, DN_HEADS).astype(F32)
        g = -jnp.exp(A_log.astype(F32)) * jax.nn.softplus(a + dt_bias.astype(F32))
        beta = jax.nn.sigmoid(b.reshape(B, T, 2, DN_HEADS).astype(F32))
        return q, k, v, g.transpose(2, 0, 3, 1), beta.transpose(2, 0, 3, 1)

    qkv_l, gate_l, a_l, b_l = p_lat
    qkv_c, gate_c, a_c, b_c = p_ctx
    ql, kl, vl, gl, bl = prep(qkv_l, a_l, b_l)
    qc, kc, vc, gc, bc = prep(qkv_c, a_c, b_c)
    B, H = ql.shape[:2]
    o_l = jnp.zeros_like(vl)
    o_c = jnp.zeros_like(vc)
    for d in range(2):
        S0 = jnp.zeros((B, H, HEAD_DIM, HEAD_DIM), F32)
        oc, S_ctx = gated_delta_scan(flip_t(qc, d), flip_t(kc, d), flip_t(vc, d),
                                     flip_t(bc[d], d), flip_t(gc[d], d), S0)
        ol, _ = gated_delta_scan(flip_t(ql, d), flip_t(kl, d), flip_t(vl, d),
                                 flip_t(bl[d], d), flip_t(gl[d], d), S_ctx)
        o_l = o_l + flip_t(ol, d)
        o_c = o_c + flip_t(oc, d)
    y_l = head_norm_gate(o_l, norm_g, gate_l)
    y_c = head_norm_gate(o_c, norm_g, gate_c) if need_ctx else None
    return y_l, y_c


def swa_group(q_l, k_l, v_l, q_c, k_c, v_c, sink, cos, sin, need_ctx):
    B, T, _ = q_l.shape
    L = k_c.shape[1]
    nb, Bk = T // SWA_BLOCK, SWA_BLOCK
    scale = HEAD_DIM ** -0.5
    ql = apply_rope(to_heads(q_l, SWA_HEADS).astype(F32), cos, sin) * scale
    kl = apply_rope(to_heads(k_l, SWA_KV_HEADS).astype(F32), cos, sin)
    vl = to_heads(v_l, SWA_KV_HEADS).astype(F32)
    kc = to_heads(k_c, SWA_KV_HEADS).astype(F32)
    vc = to_heads(v_c, SWA_KV_HEADS).astype(F32)
    sink = sink.astype(F32).reshape(SWA_KV_HEADS, SWA_GROUP)
    qb = ql.reshape(B, SWA_KV_HEADS, SWA_GROUP, nb, Bk, HEAD_DIM)

    def band(a):
        ap = jnp.pad(a, ((0, 0), (0, 0), (Bk, Bk), (0, 0))).reshape(B, SWA_KV_HEADS, nb + 2, Bk, HEAD_DIM)
        return jnp.concatenate([ap[:, :, :-2], ap[:, :, 1:-1], ap[:, :, 2:]], axis=3)

    kb, vb = band(kl), band(vl)
    blk = jnp.arange(nb)[:, None]
    qpos = blk * Bk + jnp.arange(Bk)[None, :]
    kpos = (blk - 1) * Bk + jnp.arange(3 * Bk)[None, :]
    valid = ((jnp.abs(qpos[:, :, None] - kpos[:, None, :]) <= WINDOW)
             & (kpos[:, None, :] >= 0) & (kpos[:, None, :] < T))
    s_loc = jnp.where(valid, jnp.einsum('bhgnqd,bhnkd->bhgnqk', qb, kb), -jnp.inf)
    s_ctx = jnp.einsum('bhgnqd,bhld->bhgnql', qb, kc)
    s_sink = jnp.broadcast_to(sink[None, :, :, None, None, None], s_loc.shape[:-1] + (1,))
    p = jax.nn.softmax(jnp.concatenate([s_loc, s_ctx, s_sink], axis=-1), axis=-1)
    o = (jnp.einsum('bhgnqk,bhnkd->bhgnqd', p[..., :3 * Bk], vb)
         + jnp.einsum('bhgnql,bhld->bhgnqd', p[..., 3 * Bk:3 * Bk + L], vc))
    y_l = from_heads(o.reshape(B, SWA_HEADS, T, HEAD_DIM)).astype(q_l.dtype)
    y_c = None
    if need_ctx:
        qc = (to_heads(q_c, SWA_HEADS).astype(F32) * scale).reshape(B, SWA_KV_HEADS, SWA_GROUP, L, HEAD_DIM)
        s_cc = jnp.einsum('bhgld,bhmd->bhglm', qc, kc)
        s_sk = jnp.broadcast_to(sink[None, :, :, None, None], s_cc.shape[:-1] + (1,))
        pc = jax.nn.softmax(jnp.concatenate([s_cc, s_sk], axis=-1), axis=-1)
        oc = jnp.einsum('bhglm,bhmd->bhgld', pc[..., :L], vc)
        y_c = from_heads(oc.reshape(B, SWA_HEADS, L, HEAD_DIM)).astype(q_c.dtype)
    return y_l, y_c


def hgrn2_group(p_lat, p_ctx, lb, norm_g, need_ctx):
    lbh = lb.astype(F32).reshape(2, HG_HEADS, HEAD_DIM)

    def prep(q, f, i):
        B, T, _ = f.shape
        z = f.reshape(B, T, 2, HG_HEADS, HEAD_DIM).astype(F32)
        logf = jnp.logaddexp(jnp.log(lbh), jnp.log1p(-lbh) + jax.nn.log_sigmoid(z))
        k = (1 - lbh) * jax.nn.sigmoid(-z)
        perm = (2, 0, 3, 1, 4)
        return (to_heads(q, HG_HEADS).astype(F32), to_heads(i, HG_HEADS).astype(F32),
                k.transpose(perm), logf.transpose(perm))

    q_l, f_l, i_l, gate_l = p_lat
    q_c, f_c, i_c, gate_c = p_ctx
    ql, vl, kl, lfl = prep(q_l, f_l, i_l)
    qc, vc, kc, lfc = prep(q_c, f_c, i_c)
    B = ql.shape[0]
    o_l = jnp.zeros_like(vl)
    o_c = jnp.zeros_like(vc)
    for d in range(2):
        S0 = jnp.zeros((B, HG_HEADS, HEAD_DIM, HEAD_DIM), F32)
        oc, S_ctx = gla_scan(flip_t(qc, d), flip_t(kc[d], d), flip_t(vc, d), flip_t(lfc[d], d), S0)
        ol, _ = gla_scan(flip_t(ql, d), flip_t(kl[d], d), flip_t(vl, d), flip_t(lfl[d], d), S_ctx)
        o_l = o_l + flip_t(ol, d)
        o_c = o_c + flip_t(oc, d)
    y_l = head_norm_gate(o_l, norm_g, gate_l)
    y_c = head_norm_gate(o_c, norm_g, gate_c) if need_ctx else None
    return y_l, y_c


def mixer_layer(hl, hc, w_in, w_out, dn_conv, dn_A_log, dn_dt_bias, dn_norm, swa_sink,
                hg_lb, hg_norm, cos, sin, need_ctx):
    pl = split_in(hl @ w_in)
    pc = split_in(hc @ w_in)
    dn_l, dn_c = deltanet_group(pl[0:4], pc[0:4], dn_conv, dn_A_log, dn_dt_bias, dn_norm, need_ctx)
    sw_l, sw_c = swa_group(pl[4], pl[5], pl[6], pc[4], pc[5], pc[6], swa_sink, cos, sin, need_ctx)
    hg_l, hg_c = hgrn2_group(pl[7:11], pc[7:11], hg_lb, hg_norm, need_ctx)
    yl = jnp.concatenate([dn_l, sw_l, hg_l], axis=-1) @ w_out
    yc = jnp.concatenate([dn_c, sw_c, hg_c], axis=-1) @ w_out if need_ctx else None
    return yl, yc


def sqrelu_mlp(h, w1, w2):
    return jnp.square(jax.nn.relu(h @ w1)) @ w2


def setup_inputs(seed: int = 0) -> dict:
    key = jax.random.key(seed)
    ks = jax.random.split(key, 20)

    def nrm(k, shape, s):
        return jax.random.normal(k, shape, F32) * s

    dt = jnp.exp(jax.random.uniform(ks[11], (DEPTH, 2, DN_HEADS), F32, math.log(1e-3), math.log(1e-1)))
    return {
        'x': nrm(ks[0], (BATCH, SEQ, D_MODEL), 1.0),
        'c': nrm(ks[1], (BATCH, D_MODEL), 1.0),
        'ctx': nrm(ks[2], (BATCH, CTX_LEN, D_MODEL), 1.0),
        'c_ctx': nrm(ks[3], (D_MODEL,), 1.0),
        'w_ada': nrm(ks[4], (DEPTH, D_MODEL, N_MOD * D_MODEL), 0.5 * D_MODEL ** -0.5),
        'b_ada': nrm(ks[5], (DEPTH, N_MOD * D_MODEL), 0.01),
        'norm1': 1.0 + nrm(ks[6], (DEPTH, D_MODEL), 0.02),
        'norm2': 1.0 + nrm(ks[7], (DEPTH, D_MODEL), 0.02),
        'w_in': nrm(ks[8], (DEPTH, D_MODEL, D_IN), D_MODEL ** -0.5),
        'dn_conv': nrm(ks[9], (DEPTH, CONV_W, 3 * DN_WIDTH), CONV_W ** -0.5),
        'dn_A_log': jnp.log(jax.random.uniform(ks[10], (DEPTH, 2, DN_HEADS), F32, 1.0, 16.0)),
        'dn_dt_bias': dt + jnp.log(-jnp.expm1(-dt)),
        'dn_norm': 1.0 + nrm(ks[12], (DEPTH, HEAD_DIM), 0.02),
        'swa_sink': nrm(ks[13], (DEPTH, SWA_HEADS), 0.5),
        'hg_lb_logits': nrm(ks[14], (2, DEPTH, HG_WIDTH), 0.5),
        'hg_norm': 1.0 + nrm(ks[15], (DEPTH, HEAD_DIM), 0.02),
        'w_out': nrm(ks[16], (DEPTH, D_MIX, D_MODEL), D_MIX ** -0.5),
        'w_ff1': nrm(ks[17], (DEPTH, D_MODEL, D_FF), D_MODEL ** -0.5),
        'w_ff2': nrm(ks[18], (DEPTH, D_FF, D_MODEL), D_FF ** -0.5),
        'norm_f': 1.0 + nrm(ks[19], (D_MODEL,), 0.02),
    }


def reference(x, c, ctx, c_ctx, w_ada, b_ada, norm1, norm2, w_in, dn_conv, dn_A_log, dn_dt_bias,
              dn_norm, swa_sink, hg_lb_logits, hg_norm, w_out, w_ff1, w_ff2, norm_f):
    B, T, _ = x.shape
    cos, sin = axial_rope_tables(T)
    lb_all = jnp.cumsum(jax.nn.softmax(hg_lb_logits.astype(F32), axis=1), axis=1)
    lb_all = lb_all - lb_all[:, :1]
    xl, xc = x, ctx
    for l in range(DEPTH):
        need_ctx = l < DEPTH - 1
        ml = (jax.nn.silu(c) @ w_ada[l] + b_ada[l]).reshape(B, N_MOD, 1, D_MODEL)
        mc = (jax.nn.silu(c_ctx) @ w_ada[l] + b_ada[l]).reshape(1, N_MOD, 1, D_MODEL)
        hl = modulate(rmsnorm(xl, norm1[l]), ml[:, 0], ml[:, 1])
        hc = modulate(rmsnorm(xc, norm1[l]), mc[:, 0], mc[:, 1])
        yl, yc = mixer_layer(hl, hc, w_in[l], w_out[l], dn_conv[l], dn_A_log[l], dn_dt_bias[l],
                             dn_norm[l], swa_sink[l], lb_all[:, l], hg_norm[l], cos, sin, need_ctx)
        xl = xl + ml[:, 2] * yl
        xl = xl + ml[:, 5] * sqrelu_mlp(modulate(rmsnorm(xl, norm2[l]), ml[:, 3], ml[:, 4]), w_ff1[l], w_ff2[l])
        if need_ctx:
            xc = xc + mc[:, 2] * yc
            xc = xc + mc[:, 5] * sqrelu_mlp(modulate(rmsnorm(xc, norm2[l]), mc[:, 3], mc[:, 4]), w_ff1[l], w_ff2[l])
    return rmsnorm(xl, norm_f)
```

```cpp
#include <hip/hip_runtime.h>
#include <hip/hip_cooperative_groups.h>
#include <cstdio>
#include <cstdint>
namespace cg = cooperative_groups;

__device__ __forceinline__ int lane_id_fresh() { unsigned m = ~0u; asm volatile("" : "+s"(m)); return (int)__builtin_amdgcn_mbcnt_hi(m, __builtin_amdgcn_mbcnt_lo(m, 0u)); }
namespace pg8 {
#define PG8_LAS __attribute__((address_space(3)))
typedef unsigned short bf16_t;
typedef short bf16x8 __attribute__((ext_vector_type(8)));
typedef float f32x4 __attribute__((ext_vector_type(4)));
typedef unsigned u32x4 __attribute__((ext_vector_type(4)));
constexpr int BM = 256, BK = 64, HALF = 128, HTB = HALF * BK * 2  , STAGE_BYTES = 8 * HTB, NXCD = 8, WGM = 8;

__host__ __device__ __forceinline__ int lds_byte(int r, int c) { const int st = (r >> 4) * 2 + (c >> 5), rr = r & 15, cc = c & 31, ob = rr * 64 + cc * 2; return st * 1024 + (ob ^ (((ob >> 9) & 1) << 5)); }
__host__ __device__ __forceinline__ void stage_rc(int b, int& R, int& C) { const int st = b / 1024, sb = b % 1024, swz = sb ^ (((sb >> 9) & 1) << 5); R = (st >> 1) * 16 + swz / 64; C = (st & 1) * 32 + (swz % 64) / 2; }
__host__ __device__ __forceinline__ int perm32(int rho) { const int n = rho >> 4, i = rho & 15; return 8 * (i >> 2) + 4 * n + (i & 3); }

struct Unit { int pm, pn; };
struct Gemm { const bf16_t* A; const bf16_t* Bt; int M, N, K; };

struct StaticOrder {
    int nM, nN, nwg, G, c;
    __host__ __device__ void init(int M, int N, int G_, int c_) { nM = M / BM; nN = N / BM; nwg = nM * nN; G = G_; c = c_; }
    __host__ __device__ bool next(int i, Unit& u) const {
        const long L = (long)i * G + c; if (L >= nwg) return false;
        int wgid = (int)L; { const int q = nwg / NXCD, r = nwg % NXCD, xcd = wgid % NXCD, off = wgid / NXCD; wgid = (xcd < r ? xcd * (q + 1) : r * (q + 1) + (xcd - r) * q) + off; }
        const int nig = WGM * nN, gid = wgid / nig, fm = gid * WGM, gsz = (nM - fm) < WGM ? (nM - fm) : WGM;
        u.pm = fm + ((wgid % nig) % gsz); u.pn = (wgid % nig) / gsz; return true;
    }
    __device__ __forceinline__ void a_ready(const Unit&) const {}
    __device__ __forceinline__ void done(const Unit&) const {}
};

__device__ __forceinline__ unsigned cvt_pk_bf16(float lo, float hi) { unsigned r; asm volatile("v_cvt_pk_bf16_f32 %0, %1, %2" : "=v"(r) : "v"(lo), "v"(hi)); return r; }

template <int ACT  > struct EpiBf16 {
    static constexpr bool PERM = true, AFTER_DRAIN = false;
    bf16_t* O; int ldc;
    __device__ __forceinline__ void operator()(const f32x4 (&acc)[2][2][4][2], const Unit& u, int wr, int wc, int fr, int fq) const {
        const int row0 = u.pm * BM + wr * 64 + fr; const int col0 = u.pn * BM + wc * 32 + 8 * fq;
#pragma unroll
        for (int ai = 0; ai < 2; ++ai)
#pragma unroll
            for (int m = 0; m < 4; ++m) { bf16_t* rowp = O + (size_t)(row0 + ai * HALF + m * 16) * ldc + col0;
#pragma unroll
                for (int bj = 0; bj < 2; ++bj) { f32x4 v0 = acc[ai][bj][m][0], v1 = acc[ai][bj][m][1];
                    if (ACT == 1) {
#pragma unroll
                        for (int e = 0; e < 4; ++e) { float a = fmaxf(v0[e], 0.f), b = fmaxf(v1[e], 0.f); v0[e] = a * a; v1[e] = b * b; } }
                    u32x4 w; w.x = cvt_pk_bf16(v0[0], v0[1]); w.y = cvt_pk_bf16(v0[2], v0[3]); w.z = cvt_pk_bf16(v1[0], v1[1]); w.w = cvt_pk_bf16(v1[2], v1[3]);
                    *(u32x4*)(rowp + bj * HALF) = w; } }
    }
};
struct EpiRes {
    static constexpr bool PERM = false, AFTER_DRAIN = false;
    float* Xl; float* Xc; const float* gates;
    __device__ __forceinline__ void operator()(const f32x4 (&acc)[2][2][4][2], const Unit& u, int wr, int wc, int fr, int fq) const {
        const int b = u.pm / 9, tt = u.pm - b * 9;
        float* base = (tt == 0) ? Xc + ((size_t)(b * 256) << 10) : Xl + ((size_t)(b * 2048 + (tt - 1) * 256) << 10);
        const float* g = gates + (size_t)((tt == 0) ? 16 : b) * 6144;
        const int col0 = u.pn * BM + wc * 32 + 4 * fq;
        float* rp0 = base + ((size_t)(wr * 64 + fr) << 10) + col0;
#pragma unroll
        for (int bj = 0; bj < 2; ++bj)
#pragma unroll
            for (int n = 0; n < 2; ++n) { const f32x4 gvv = *(const f32x4*)(g + col0 + bj * HALF + n * 16);
#pragma unroll
                for (int ai = 0; ai < 2; ++ai) {
#pragma unroll
                    for (int m = 0; m < 4; ++m) { f32x4* pp = (f32x4*)(rp0 + (size_t)(ai * HALF + m * 16) * 1024 + bj * HALF + n * 16); f32x4 xv = *pp; xv = xv + gvv * acc[ai][bj][m][n]; *pp = xv; }
                    asm volatile("" ::: "memory"); } }
    }
};
template <class Epi, class Sched, bool ALIGN_EPI = false, bool SP2 = false>
__device__ __forceinline__ void gemm_phase(PG8_LAS unsigned char* lds, const Gemm g, const Sched& S, const Epi& E, const int wvs) {
    const int tid = wvs * 64 + lane_id_fresh(); const int wid = __builtin_amdgcn_readfirstlane(tid >> 6), lane = tid & 63, wr = wid >> 2, wc = wid & 3, fr = lane & 15, fq = lane >> 4;
    const int K = g.K, nt = K / BK;
    unsigned voffA[2], voffB[2];
#pragma unroll
    for (int i = 0; i < 2; ++i) { int R, C; stage_rc(tid * 16 + i * 8192, R, C); const int Rb = Epi::PERM ? ((R & ~31) + perm32(R & 31)) : R;
        voffA[i] = (unsigned)(R * K + C) * 2u; voffB[i] = (unsigned)(Rb * K + C) * 2u; }
    const size_t kstep = (size_t)(BK * 2);
    const size_t hstep = (size_t)HALF * K * 2;
    const size_t tstep = 2 * hstep;
    const unsigned ldsw = (unsigned)wid * 1024u;
    const int aoff = lds_byte(wr * 64 + fr, fq * 8), boff = lds_byte(wc * 32 + fr, fq * 8);
#define PG8_SA(b, h) (((b) * 2 + (h)) * HTB)
#define PG8_SB(b, h) ((4 + (b) * 2 + (h)) * HTB)
#define PG8_STAGE(bufoff, gbase, voff) do { _Pragma("unroll") for (int _i = 0; _i < 2; ++_i) \
        __builtin_amdgcn_global_load_lds((const unsigned*)((const char*)(gbase) + (voff)[_i]), (PG8_LAS unsigned*)(lds + (bufoff) + ldsw + _i * 8192), 16, 0, 0); } while (0)
#define PG8_LDA(dst, b, h) do { _Pragma("unroll") for (int m = 0; m < 4; ++m) _Pragma("unroll") for (int k = 0; k < 2; ++k) dst[m][k] = *(const PG8_LAS bf16x8*)(lds + PG8_SA(b, h) + aoff + m * 2048 + k * 1024); } while (0)
#define PG8_LDB(dst, b, h) do { _Pragma("unroll") for (int n = 0; n < 2; ++n) _Pragma("unroll") for (int k = 0; k < 2; ++k) dst[n][k] = *(const PG8_LAS bf16x8*)(lds + PG8_SB(b, h) + boff + n * 2048 + k * 1024); } while (0)
#define PG8_MMA(ai, bj, At, Bt) do { __builtin_amdgcn_s_setprio(1); _Pragma("unroll") for (int m = 0; m < 4; ++m) _Pragma("unroll") for (int n = 0; n < 2; ++n) _Pragma("unroll") for (int k = 0; k < 2; ++k) \
        acc[ai][bj][m][n] = __builtin_amdgcn_mfma_f32_16x16x32_bf16(Bt[n][k], At[m][k], acc[ai][bj][m][n], 0, 0, 0); __builtin_amdgcn_s_setprio(0); } while (0)
#define PG8_WAIT_V(n) asm volatile("s_waitcnt vmcnt(" #n ")" ::: "memory")
#define PG8_WAIT_L(n) asm volatile("s_waitcnt lgkmcnt(" #n ")" ::: "memory")
#define PG8_BAR __builtin_amdgcn_s_barrier()
#define PG8_SCHED __builtin_amdgcn_sched_barrier(0)
    Unit cur, nxt; int ui = 0;
    if (!S.next(0, cur)) return;
    f32x4 acc[2][2][4][2];
#pragma unroll
    for (int a = 0; a < 2; ++a)
#pragma unroll
        for (int b = 0; b < 2; ++b)
#pragma unroll
            for (int m = 0; m < 4; ++m)
#pragma unroll
                for (int n = 0; n < 2; ++n) acc[a][b][m][n] = (f32x4){0.f, 0.f, 0.f, 0.f};
    bf16x8 At[4][2], B0[2][2], B1[2][2];
    const char* cA = (const char*)g.A + (size_t)cur.pm * tstep; const char* cB = (const char*)g.Bt + (size_t)cur.pn * tstep;
    S.a_ready(cur);
    if constexpr (SP2) {
        PG8_STAGE(PG8_SB(0, 0), cB, voffB); PG8_STAGE(PG8_SB(0, 1), cB + hstep, voffB); PG8_STAGE(PG8_SA(0, 0), cA, voffA); PG8_STAGE(PG8_SA(0, 1), cA + hstep, voffA);
        if (wr == 1) PG8_BAR;
        PG8_WAIT_V(2); PG8_BAR;
        PG8_STAGE(PG8_SB(1, 0), cB + kstep, voffB); PG8_STAGE(PG8_SA(1, 0), cA + kstep, voffA); PG8_STAGE(PG8_SB(1, 1), cB + hstep + kstep, voffB);
        PG8_WAIT_V(6); PG8_BAR;
    } else {
        PG8_STAGE(PG8_SB(0, 0), cB, voffB); PG8_STAGE(PG8_SA(0, 0), cA, voffA); PG8_STAGE(PG8_SB(0, 1), cB + hstep, voffB); PG8_STAGE(PG8_SA(0, 1), cA + hstep, voffA);
        if (wr == 1) PG8_BAR;
        PG8_WAIT_V(4); PG8_BAR;
        PG8_STAGE(PG8_SB(1, 0), cB + kstep, voffB); PG8_STAGE(PG8_SA(1, 0), cA + kstep, voffA); PG8_STAGE(PG8_SB(1, 1), cB + hstep + kstep, voffB);
        PG8_WAIT_V(6); PG8_BAR;
    }
    for (;;) {
        const bool has_next = S.next(ui + 1, nxt);
        const char* nA = has_next ? (const char*)g.A + (size_t)nxt.pm * tstep : cA; const char* nB = has_next ? (const char*)g.Bt + (size_t)nxt.pn * tstep : cB;
        for (int t = 0; t < nt; t += 2) {
            const bool last = (t == nt - 2);
            const char* a1 = cA + (size_t)(t + 1) * kstep;
            const char* a2 = last ? nA : cA + (size_t)(t + 2) * kstep; const char* b2 = last ? nB : cB + (size_t)(t + 2) * kstep;
            const char* a3 = a2 + kstep; const char* b3 = b2 + kstep;
            if (last && has_next) S.a_ready(nxt);
            if constexpr (SP2) {
            PG8_LDB(B0, 0, 0); PG8_LDB(B1, 0, 1); PG8_SCHED; PG8_LDA(At, 0, 0); PG8_STAGE(PG8_SA(1, 1), a1 + hstep, voffA);
            PG8_WAIT_V(8); PG8_WAIT_L(0); PG8_BAR; PG8_MMA(0, 0, At, B0); PG8_MMA(0, 1, At, B1); PG8_BAR; PG8_SCHED;
            PG8_LDA(At, 0, 1); PG8_STAGE(PG8_SB(0, 0), b2, voffB); PG8_STAGE(PG8_SB(0, 1), b2 + hstep, voffB); PG8_STAGE(PG8_SA(0, 0), a2, voffA);
            PG8_WAIT_V(8); PG8_WAIT_L(0); PG8_BAR; PG8_MMA(1, 0, At, B0); PG8_MMA(1, 1, At, B1); PG8_BAR; PG8_SCHED;
            PG8_LDB(B0, 1, 0); PG8_LDB(B1, 1, 1); PG8_SCHED; PG8_LDA(At, 1, 0); PG8_STAGE(PG8_SA(0, 1), a2 + hstep, voffA);
            PG8_WAIT_V(8); PG8_WAIT_L(0); PG8_BAR; PG8_MMA(0, 0, At, B0); PG8_MMA(0, 1, At, B1); PG8_BAR; PG8_SCHED;
            PG8_LDA(At, 1, 1); PG8_STAGE(PG8_SB(1, 0), b3, voffB); PG8_STAGE(PG8_SB(1, 1), b3 + hstep, voffB); PG8_STAGE(PG8_SA(1, 0), a3, voffA);
            PG8_WAIT_V(8); PG8_WAIT_L(0); PG8_BAR; PG8_MMA(1, 0, At, B0); PG8_MMA(1, 1, At, B1); PG8_BAR; PG8_SCHED;
            } else {
            PG8_LDB(B0, 0, 0); PG8_SCHED; PG8_LDA(At, 0, 0); PG8_STAGE(PG8_SA(1, 1), a1 + hstep, voffA);
            PG8_WAIT_L(8); PG8_BAR; PG8_WAIT_L(0); PG8_MMA(0, 0, At, B0); PG8_BAR; PG8_SCHED;
            PG8_LDB(B1, 0, 1); PG8_STAGE(PG8_SB(0, 0), b2, voffB);
            PG8_BAR; PG8_WAIT_L(0); PG8_MMA(0, 1, At, B1); PG8_BAR;
            PG8_LDA(At, 0, 1); PG8_STAGE(PG8_SA(0, 0), a2, voffA);
            PG8_BAR; PG8_WAIT_L(0); PG8_MMA(1, 0, At, B0); PG8_BAR; PG8_SCHED;
            PG8_STAGE(PG8_SB(0, 1), b2 + hstep, voffB);
            PG8_WAIT_V(6); PG8_BAR; PG8_MMA(1, 1, At, B1); PG8_BAR;
            PG8_LDB(B0, 1, 0); PG8_SCHED; PG8_LDA(At, 1, 0); PG8_STAGE(PG8_SA(0, 1), a2 + hstep, voffA);
            PG8_WAIT_L(8); PG8_BAR; PG8_WAIT_L(0); PG8_MMA(0, 0, At, B0); PG8_BAR; PG8_SCHED;
            PG8_LDB(B1, 1, 1); PG8_STAGE(PG8_SB(1, 0), b3, voffB);
            PG8_BAR; PG8_WAIT_L(0); PG8_MMA(0, 1, At, B1); PG8_BAR;
            PG8_LDA(At, 1, 1); PG8_STAGE(PG8_SA(1, 0), a3, voffA);
            PG8_BAR; PG8_WAIT_L(0); PG8_MMA(1, 0, At, B0); PG8_BAR; PG8_SCHED;
            PG8_STAGE(PG8_SB(1, 1), b3 + hstep, voffB);
            PG8_WAIT_V(6); PG8_BAR; PG8_MMA(1, 1, At, B1); PG8_BAR;
            }
        }
        if constexpr (ALIGN_EPI) { if (wr == 0) PG8_BAR; }
        if constexpr (!Epi::AFTER_DRAIN) { E(acc, cur, wr, wc, fr, fq); S.done(cur); }
        if (!has_next) break;
#pragma unroll
        for (int a = 0; a < 2; ++a)
#pragma unroll
            for (int b = 0; b < 2; ++b)
#pragma unroll
                for (int m = 0; m < 4; ++m)
#pragma unroll
                    for (int n = 0; n < 2; ++n) acc[a][b][m][n] = (f32x4){0.f, 0.f, 0.f, 0.f};
        cur = nxt; cA = nA; cB = nB; ++ui;
        if constexpr (ALIGN_EPI) { if (wr == 1) PG8_BAR; }
    }
    PG8_WAIT_V(0);
    if constexpr (!ALIGN_EPI) { if (wr == 0) PG8_BAR; }
    PG8_BAR;
    if constexpr (Epi::AFTER_DRAIN) { E.fused(acc, cur, wr, wc, fr, fq, lds, wid, lane); S.done(cur); }
#undef PG8_SA
#undef PG8_SB
#undef PG8_STAGE
#undef PG8_LDA
#undef PG8_LDB
#undef PG8_MMA
#undef PG8_WAIT_V
#undef PG8_WAIT_L
#undef PG8_BAR
#undef PG8_SCHED
}
}

constexpr int D = 1024, BATCH = 16, SEQ = 2048, CTX = 256, DEPTH = 4;
constexpr int TPB = CTX + SEQ;
constexpr int M = BATCH * TPB;
constexpr int DIN = 3088, NP = 3072, DFF = 4096;
constexpr int PC_DNQ = 0, PC_DNG = 768, PC_SQ = 1024, PC_SK = 1536, PC_SV = 1664, PC_HQ = 1792, PC_HF = 2048, PC_HI = 2560, PC_HG = 2816;
constexpr float EPS = 1e-6f;
constexpr size_t MiB = 1u << 20;
constexpr size_t WS_CTL = 0, WS_MODS = 1 * MiB, WS_ROPE = 3 * MiB, WS_LB = 3 * MiB + 512 * 1024, WS_AB = 4 * MiB;
constexpr size_t WS_WIN = 7 * MiB, WS_WOUT = 13 * MiB, WS_W1 = 15 * MiB, WS_W2 = 23 * MiB, WS_XC = 32 * MiB, WS_HY = 48 * MiB, WS_P = 120 * MiB;
constexpr size_t WS_OD = WS_P + 216 * MiB, WS_END = WS_P + 288 * MiB;
constexpr int LDS_BYTES = 147456;
constexpr int NWAVES = 8, NTHR = 512;

#define LAS __attribute__((address_space(3)))
typedef unsigned short bf16_t;
typedef float f32x4 __attribute__((ext_vector_type(4)));
typedef short bf16x8 __attribute__((ext_vector_type(8)));
typedef short s16x4 __attribute__((ext_vector_type(4)));
typedef unsigned u32x4 __attribute__((ext_vector_type(4)));
typedef unsigned u32x2 __attribute__((ext_vector_type(2)));

struct Params {
    const float *x, *c, *ctx, *c_ctx, *w_ada, *b_ada, *norm1, *norm2, *w_in, *dn_conv, *dn_A_log, *dn_dt_bias, *dn_norm, *swa_sink, *hg_lb, *hg_norm, *w_out, *w_ff1, *w_ff2, *norm_f;
    float* out; unsigned char* ws;
};

__device__ __forceinline__ float bflo(unsigned u) { return __uint_as_float(u << 16); }
__device__ __forceinline__ float bfhi(unsigned u) { return __uint_as_float(u & 0xffff0000u); }
__device__ __forceinline__ unsigned pk2(float lo, float hi) { return pg8::cvt_pk_bf16(lo, hi); }
__device__ __forceinline__ float siluf(float v) { return v / (1.f + __expf(-v)); }
__device__ __forceinline__ float sigmf(float v) { return 1.f / (1.f + __expf(-v)); }
__device__ __forceinline__ float wave_sum(float v) {
#pragma unroll
    for (int o = 1; o < 64; o <<= 1) v += __shfl_xor(v, o);
    return v;
}
template <int CTRL> __device__ __forceinline__ float dpp(float x) { return __builtin_bit_cast(float, __builtin_amdgcn_mov_dpp(__builtin_bit_cast(int, x), CTRL, 0xf, 0xf, true)); }
constexpr int XOR1 = 0xB1, XOR2 = 0x4E, XOR7 = 0x141;
__device__ __forceinline__ float sum8(float v) { v += dpp<XOR1>(v); v += dpp<XOR2>(v); v += dpp<XOR7>(v); return v; }
__device__ __forceinline__ float xrow16_max(float x) {
    auto s = __builtin_amdgcn_permlane16_swap(__float_as_uint(x), __float_as_uint(x), false, false);
    x = fmaxf(__uint_as_float(s[0]), __uint_as_float(s[1]));
    auto t = __builtin_amdgcn_permlane32_swap(__float_as_uint(x), __float_as_uint(x), false, false);
    return fmaxf(__uint_as_float(t[0]), __uint_as_float(t[1]));
}
__device__ __forceinline__ float xrow16_sum(float x) {
    auto s = __builtin_amdgcn_permlane16_swap(__float_as_uint(x), __float_as_uint(x), false, false);
    x = __uint_as_float(s[0]) + __uint_as_float(s[1]);
    auto t = __builtin_amdgcn_permlane32_swap(__float_as_uint(x), __float_as_uint(x), false, false);
    return __uint_as_float(t[0]) + __uint_as_float(t[1]);
}
__device__ __forceinline__ const float* xrow_c(const float* Xl, const float* Xc, int r) { const int b = r / TPB, t = r - b * TPB; return t < CTX ? Xc + ((size_t)(b * CTX + t) << 10) : Xl + ((size_t)(b * SEQ + t - CTX) << 10); }
__device__ __forceinline__ int cidx(int r) { const int b = r / TPB, t = r - b * TPB; return t < CTX ? 16 : b; }

__device__ __forceinline__ void phase_prologue(const Params& p, LAS unsigned char* lds, const int wvs) {
    const int tid = wvs * 64 + lane_id_fresh(); const int lane = tid & 63, w = tid >> 6;
    float* mods = (float*)(p.ws + WS_MODS);
    LAS float* sc = (LAS float*)lds;
    LAS float* red = (LAS float*)(lds + 81920);
    for (int idx = tid; idx < 17 * 1024; idx += NTHR) { const int ci = idx >> 10, k = idx & 1023; const float v = ci < 16 ? p.c[ci * 1024 + k] : p.c_ctx[k]; sc[k * 20 + ci] = v / (1.f + expf(-v)); }
    __syncthreads();
    for (int it = blockIdx.x; it < DEPTH * 96; it += gridDim.x) {
        const int l = it / 96, cgp = it - l * 96, col = cgp * 64 + lane;
        float acc[17];
#pragma unroll
        for (int i = 0; i < 17; ++i) acc[i] = 0.f;
        const float* wp = p.w_ada + ((size_t)l * 1024 + w * 128) * 6144 + col;
#pragma unroll 8
        for (int kk = 0; kk < 128; ++kk) {
            const float wv = wp[(size_t)kk * 6144];
            const LAS f32x4* s4 = (const LAS f32x4*)(sc + (w * 128 + kk) * 20);
            const f32x4 s0 = s4[0], s1 = s4[1], s2 = s4[2], s3 = s4[3]; const float s16 = sc[(w * 128 + kk) * 20 + 16];
#pragma unroll
            for (int e = 0; e < 4; ++e) { acc[e] += wv * s0[e]; acc[4 + e] += wv * s1[e]; acc[8 + e] += wv * s2[e]; acc[12 + e] += wv * s3[e]; }
            acc[16] += wv * s16;
        }
#pragma unroll
        for (int i = 0; i < 17; ++i) red[(w * 17 + i) * 64 + lane] = acc[i];
        __syncthreads();
        for (int idx = tid; idx < 17 * 64; idx += NTHR) { const int i = idx >> 6, cl = idx & 63; float s = 0.f;
#pragma unroll
            for (int ww = 0; ww < 8; ++ww) s += red[(ww * 17 + i) * 64 + cl];
            mods[((size_t)l * 17 + i) * 6144 + cgp * 64 + cl] = s + p.b_ada[l * 6144 + cgp * 64 + cl]; }
        __syncthreads();
    }
    const int gt = blockIdx.x * NTHR + tid, GT = gridDim.x * NTHR;
    { float* rc = (float*)(p.ws + WS_ROPE); float* rs = rc + 2048 * 32;
      for (int idx = gt; idx < 2048 * 32; idx += GT) { const int t = idx >> 5, d = idx & 31; const float pos = (float)(d < 16 ? (t >> 6) : (t & 63));
          const float inv = expf(-(float)(d & 15) * (9.210340371976184f / 16.f)); const float ang = pos * inv; rc[idx] = cosf(ang); rs[idx] = sinf(ang); } }
    { float* LB = (float*)(p.ws + WS_LB);
      for (int idx = gt; idx < 2 * 256; idx += GT) { const int d = idx >> 8, cc = idx & 255; float v[DEPTH]; float mx = -1e30f;
#pragma unroll
          for (int l = 0; l < DEPTH; ++l) { v[l] = p.hg_lb[(d * DEPTH + l) * 256 + cc]; mx = fmaxf(mx, v[l]); }
          float s = 0.f;
#pragma unroll
          for (int l = 0; l < DEPTH; ++l) { v[l] = expf(v[l] - mx); s += v[l]; }
          float cum = 0.f;
#pragma unroll
          for (int l = 0; l < DEPTH; ++l) { if (l > 0) cum += v[l] / s; LB[(d * DEPTH + l) * 256 + cc] = cum; } } }
    { const f32x4* src = (const f32x4*)p.x; f32x4* dst = (f32x4*)p.out; for (int i = gt; i < BATCH * SEQ * D / 4; i += GT) dst[i] = src[i];
      const f32x4* s2 = (const f32x4*)p.ctx; f32x4* d2 = (f32x4*)(p.ws + WS_XC); for (int i = gt; i < BATCH * CTX * D / 4; i += GT) d2[i] = s2[i]; }
}

__device__ __forceinline__ void transpose_item(const float* W, int K, int ldw, int scol0, bf16_t* WT, int n0, int k0, LAS float* scr, int lane) {
#pragma unroll 8
    for (int i = 0; i < 32; ++i) { const int kk = 2 * i + (lane >> 5); scr[kk * 33 + (lane & 31)] = W[(size_t)(k0 + kk) * ldw + scol0 + (lane & 31)]; }
    asm volatile("s_waitcnt lgkmcnt(0)" ::: "memory");
    const int c = lane & 7;
#pragma unroll
    for (int j = 0; j < 4; ++j) { const int n = (lane >> 3) + 8 * j; const LAS float* s = scr + (8 * c) * 33 + n;
        u32x4 o; o.x = pk2(s[0 * 33], s[1 * 33]); o.y = pk2(s[2 * 33], s[3 * 33]); o.z = pk2(s[4 * 33], s[5 * 33]); o.w = pk2(s[6 * 33], s[7 * 33]);
        *(u32x4*)(WT + (size_t)(n0 + n) * K + k0 + 8 * c) = o; }
    asm volatile("s_waitcnt lgkmcnt(0)" ::: "memory");
}

template <bool FIRST> __device__ __forceinline__ void phase_norm(const Params& p, int l, LAS unsigned char* lds, const int wvs) {
    const int tid = wvs * 64 + lane_id_fresh(); const int lane = tid & 63, w = tid >> 6;
    const int gw = blockIdx.x * NWAVES + w, NGW = gridDim.x * NWAVES;
    const float* mods = (const float*)(p.ws + WS_MODS);
    LAS float* wab = (LAS float*)lds;
    if (FIRST) {
        LAS float* scr = (LAS float*)(lds + 65536 + w * 8704);
        constexpr int I_IN = 16 * 96, I_OUT = 16 * 32, I_1 = 16 * 128, I_2 = 64 * 32;
        for (int it = gw; it < I_IN + I_OUT + I_1 + I_2; it += NGW) {
            int r = it;
            if (r < I_IN) { const int kb = r / 96, nb = r - kb * 96; const int n0 = nb * 32; transpose_item(p.w_in + (size_t)l * D * DIN, D, DIN, n0 + (n0 >= 1024 ? 16 : 0), (bf16_t*)(p.ws + WS_WIN), n0, kb * 64, scr, lane); continue; }
            r -= I_IN;
            if (r < I_OUT) { const int kb = r / 32, nb = r - kb * 32; transpose_item(p.w_out + (size_t)l * D * D, D, D, nb * 32, (bf16_t*)(p.ws + WS_WOUT), nb * 32, kb * 64, scr, lane); continue; }
            r -= I_OUT;
            if (r < I_1) { const int kb = r / 128, nb = r - kb * 128; transpose_item(p.w_ff1 + (size_t)l * D * DFF, D, DFF, nb * 32, (bf16_t*)(p.ws + WS_W1), nb * 32, kb * 64, scr, lane); continue; }
            r -= I_1;
            { const int kb = r / 32, nb = r - kb * 32; transpose_item(p.w_ff2 + (size_t)l * DFF * D, DFF, D, nb * 32, (bf16_t*)(p.ws + WS_W2), nb * 32, kb * 64, scr, lane); }
        }
        const float* wi = p.w_in + (size_t)l * D * DIN + 1024;
        for (int idx = tid; idx < 4096; idx += NTHR) { const int k = idx >> 2, j4 = (idx & 3) * 4; const f32x4 v = *(const f32x4*)(wi + (size_t)k * DIN + j4);
#pragma unroll
            for (int e = 0; e < 4; ++e) wab[(j4 + e) * 1024 + k] = v[e]; }
        __syncthreads();
    }
    const float* nw = (FIRST ? p.norm1 : p.norm2) + l * D;
    bf16_t* H = (bf16_t*)(p.ws + WS_HY);
    float* AB = (float*)(p.ws + WS_AB);
    const float* Xc = (const float*)(p.ws + WS_XC);
    for (int r = gw; r < M; r += NGW) {
        const f32x4* xr = (const f32x4*)xrow_c(p.out, Xc, r) + lane;
        f32x4 v[4]; float ss = 0.f;
#pragma unroll
        for (int j = 0; j < 4; ++j) { v[j] = xr[64 * j]; ss += (v[j][0] * v[j][0] + v[j][1] * v[j][1]) + (v[j][2] * v[j][2] + v[j][3] * v[j][3]); }
        const float rstd = rsqrtf(wave_sum(ss) * (1.f / D) + EPS);
        const float* md = mods + ((size_t)l * 17 + cidx(r)) * 6144 + (FIRST ? 0 : 3 * 1024);
        float acc[16];
#pragma unroll
        for (int o = 0; o < 16; ++o) acc[o] = 0.f;
        u32x2* hp = (u32x2*)(H + (size_t)r * D) + lane;
#pragma unroll
        for (int j = 0; j < 4; ++j) { const int k = 4 * (lane + 64 * j);
            const f32x4 g = *(const f32x4*)(nw + k), sh = *(const f32x4*)(md + k), sl = *(const f32x4*)(md + 1024 + k);
            f32x4 h;
#pragma unroll
            for (int e = 0; e < 4; ++e) h[e] = (v[j][e] * rstd * g[e]) * (1.f + sl[e]) + sh[e];
            u32x2 o2; o2.x = pk2(h[0], h[1]); o2.y = pk2(h[2], h[3]); hp[64 * j] = o2;
            if (FIRST) {
#pragma unroll
                for (int o = 0; o < 16; ++o) { const f32x4 wv = *(const LAS f32x4*)(wab + o * 1024 + k); acc[o] += (h[0] * wv[0] + h[1] * wv[1]) + (h[2] * wv[2] + h[3] * wv[3]); }
            }
        }
        if (FIRST) { float outv = 0.f;
#pragma unroll
            for (int o = 0; o < 16; ++o) { const float s = wave_sum(acc[o]); if (lane == o) outv = s; }
            if (lane < 16) AB[(size_t)r * 16 + lane] = outv; }
    }
}

constexpr int SST = 68;
__device__ __forceinline__ void dn_seq(const Params& p, int l, int s, LAS unsigned char* lds, const int wvs) {
    const int tid = wvs * 64 + lane_id_fresh(); const int lane = tid & 63, w = tid >> 6;
    const int b = s >> 3, h = (s >> 1) & 3, d = s & 1;
    LAS float* qs = (LAS float*)lds; LAS float* ks = qs + 64 * SST; LAS float* vs = ks + 64 * SST; LAS float* ob = vs + 64 * SST;
    LAS float* sa = ob + 64 * SST; LAS float* sb = sa + 64; LAS float* sqk = sb + 64;
    const bf16_t* P = (const bf16_t*)(p.ws + WS_P);
    const float* AB = (const float*)(p.ws + WS_AB);
    bf16_t* OD = (bf16_t*)(p.ws + WS_OD) + (size_t)d * M * 512;
    const float* cw = p.dn_conv + (size_t)l * 5 * 768;
    const float nA = -expf(p.dn_A_log[(l * 2 + d) * 4 + h]); const float dtb = p.dn_dt_bias[(l * 2 + d) * 4 + h];
    const int part = lane & 7, col = w * 8 + (lane >> 3);
    float S[8];
#pragma unroll
    for (int i = 0; i < 8; ++i) S[i] = 0.f;
    for (int ci = 0; ci < 36; ++ci) {
        const int nc = d == 0 ? ci : (ci < 4 ? 3 - ci : 39 - ci);
        const int base = b * TPB + nc * 64, seg_lo = b * TPB + (nc < 4 ? 0 : CTX), seg_hi = b * TPB + (nc < 4 ? CTX : TPB);
#pragma unroll 4
        for (int it = 0; it < 12; ++it) { const int idx = tid + NTHR * it; const int pp = idx / 96, cp = idx - pp * 96; const int c = cp * 2, which = c >> 6, cc = c & 63;
            const int pcol = which * 256 + h * 64 + cc; float a0 = 0.f, a1 = 0.f;
#pragma unroll
            for (int t = 0; t < 5; ++t) { const int r = base + pp + t - 2;
                if (r >= seg_lo && r < seg_hi) { const unsigned raw = *(const unsigned*)(P + (size_t)r * NP + pcol); a0 += bflo(raw) * cw[t * 768 + pcol]; a1 += bfhi(raw) * cw[t * 768 + pcol + 1]; } }
            a0 = a0 / (1.f + __expf(-a0)); a1 = a1 / (1.f + __expf(-a1));
            const int pq = d ? 63 - pp : pp; LAS float* dst = which == 0 ? qs : (which == 1 ? ks : vs);
            dst[pq * SST + cc] = a0; dst[pq * SST + cc + 1] = a1; }
        if (tid < 64) { const int r = base + tid; const float ai = AB[(size_t)r * 16 + d * 4 + h], bi = AB[(size_t)r * 16 + 8 + d * 4 + h];
            const float xs = ai + dtb; const float sp = xs > 20.f ? xs : log1pf(expf(xs)); const int pq = d ? 63 - tid : tid;
            sa[pq] = expf(nA * sp); sb[pq] = 1.f / (1.f + expf(-bi)); }
        __syncthreads();
        if (tid < 64) { LAS float* qr = qs + tid * SST; LAS float* kr = ks + tid * SST; float sq = 0.f, sk = 0.f, qk = 0.f;
            for (int i = 0; i < 64; ++i) { const float a = qr[i], bq = kr[i]; sq += a * a; sk += bq * bq; qk += a * bq; }
            const float rq = rsqrtf(sq + EPS) * 0.125f, rk = rsqrtf(sk + EPS);
            for (int i = 0; i < 64; ++i) { qr[i] *= rq; kr[i] *= rk; }
            sqk[tid] = qk * rq * rk; }
        __syncthreads();
        for (int tt = 0; tt < 64; ++tt) {
            const float a = sa[tt], bt = sb[tt], qk = sqk[tt];
            const f32x4 k0 = *(const LAS f32x4*)(ks + tt * SST + part * 8), k1 = *(const LAS f32x4*)(ks + tt * SST + part * 8 + 4);
            const f32x4 q0 = *(const LAS f32x4*)(qs + tt * SST + part * 8), q1 = *(const LAS f32x4*)(qs + tt * SST + part * 8 + 4);
            const float vv = vs[tt * SST + col];
            float kS = (k0[0] * S[0] + k0[1] * S[1]) + (k0[2] * S[2] + k0[3] * S[3]) + (k1[0] * S[4] + k1[1] * S[5]) + (k1[2] * S[6] + k1[3] * S[7]);
            float qS = (q0[0] * S[0] + q0[1] * S[1]) + (q0[2] * S[2] + q0[3] * S[3]) + (q1[0] * S[4] + q1[1] * S[5]) + (q1[2] * S[6] + q1[3] * S[7]);
            kS = sum8(kS); qS = sum8(qS);
            const float delta = bt * (vv - a * kS);
            const float o = a * qS + qk * delta;
#pragma unroll
            for (int i = 0; i < 4; ++i) { S[i] = a * S[i] + k0[i] * delta; S[4 + i] = a * S[4 + i] + k1[i] * delta; }
            if (part == 0) ob[tt * SST + col] = o;
        }
        __syncthreads();
        for (int it = 0; it < 4; ++it) { const int idx = tid + NTHR * it; const int tt = idx >> 5, c2 = (idx & 31) * 2; const int row = base + (d ? 63 - tt : tt);
            *(unsigned*)(OD + (size_t)row * 512 + h * 64 + c2) = pk2(ob[tt * SST + c2], ob[tt * SST + c2 + 1]); }
        __syncthreads();
    }
}

__device__ __forceinline__ void hg_seq(const Params& p, int l, int s, LAS unsigned char* lds, const int wvs) {
    const int tid = wvs * 64 + lane_id_fresh(); const int lane = tid & 63, w = tid >> 6;
    const int b = s >> 3, h = (s >> 1) & 3, d = s & 1;
    LAS float* qs = (LAS float*)lds; LAS float* fs = qs + 64 * SST; LAS float* ks = fs + 64 * SST; LAS float* vs = ks + 64 * SST; LAS float* ob = vs + 64 * SST;
    const bf16_t* P = (const bf16_t*)(p.ws + WS_P);
    bf16_t* OD = (bf16_t*)(p.ws + WS_OD) + (size_t)d * M * 512;
    const float* LB = (const float*)(p.ws + WS_LB) + (d * DEPTH + l) * 256 + h * 64;
    const int part = lane & 7, col = w * 8 + (lane >> 3);
    float S[8];
#pragma unroll
    for (int i = 0; i < 8; ++i) S[i] = 0.f;
    for (int ci = 0; ci < 36; ++ci) {
        const int nc = d == 0 ? ci : (ci < 4 ? 3 - ci : 39 - ci);
        const int base = b * TPB + nc * 64;
        for (int it = 0; it < 4; ++it) { const int idx = tid + NTHR * it; const int pp = idx >> 5, cc = (idx & 31) * 2; const size_t ro = (size_t)(base + pp) * NP + h * 64 + cc;
            const unsigned rq = *(const unsigned*)(P + ro + PC_HQ), rz = *(const unsigned*)(P + ro + PC_HF + d * 256), rv = *(const unsigned*)(P + ro + PC_HI);
            const float lb0 = LB[cc], lb1 = LB[cc + 1];
            const float z0 = bflo(rz), z1 = bfhi(rz);
            const float sg0 = 1.f / (1.f + __expf(-z0)), sg1 = 1.f / (1.f + __expf(-z1));
            const int pq = d ? 63 - pp : pp; const int o = pq * SST + cc;
            qs[o] = bflo(rq); qs[o + 1] = bfhi(rq); vs[o] = bflo(rv); vs[o + 1] = bfhi(rv);
            fs[o] = lb0 + (1.f - lb0) * sg0; fs[o + 1] = lb1 + (1.f - lb1) * sg1;
            ks[o] = (1.f - lb0) * (1.f - sg0); ks[o + 1] = (1.f - lb1) * (1.f - sg1); }
        __syncthreads();
        for (int tt = 0; tt < 64; ++tt) {
            const f32x4 f0 = *(const LAS f32x4*)(fs + tt * SST + part * 8), f1 = *(const LAS f32x4*)(fs + tt * SST + part * 8 + 4);
            const f32x4 k0 = *(const LAS f32x4*)(ks + tt * SST + part * 8), k1 = *(const LAS f32x4*)(ks + tt * SST + part * 8 + 4);
            const f32x4 q0 = *(const LAS f32x4*)(qs + tt * SST + part * 8), q1 = *(const LAS f32x4*)(qs + tt * SST + part * 8 + 4);
            const float vv = vs[tt * SST + col];
#pragma unroll
            for (int i = 0; i < 4; ++i) { S[i] = f0[i] * S[i] + k0[i] * vv; S[4 + i] = f1[i] * S[4 + i] + k1[i] * vv; }
            float o = (q0[0] * S[0] + q0[1] * S[1]) + (q0[2] * S[2] + q0[3] * S[3]) + (q1[0] * S[4] + q1[1] * S[5]) + (q1[2] * S[6] + q1[3] * S[7]);
            o = sum8(o);
            if (part == 0) ob[tt * SST + col] = o;
        }
        __syncthreads();
        for (int it = 0; it < 4; ++it) { const int idx = tid + NTHR * it; const int tt = idx >> 5, c2 = (idx & 31) * 2; const int row = base + (d ? 63 - tt : tt);
            *(unsigned*)(OD + (size_t)row * 512 + 256 + h * 64 + c2) = pk2(ob[tt * SST + c2], ob[tt * SST + c2 + 1]); }
        __syncthreads();
    }
}

constexpr int KST = 72, VST = 136;
__device__ __forceinline__ void swa_unit(const Params& p, int l, int unit, LAS unsigned char* lds, const int wvs) {
    const int tid = wvs * 64 + lane_id_fresh(); const int lane = tid & 63, w = tid >> 6;
    const int b = unit / 36, rem = unit - b * 36, kvh = rem / 18, qb = rem - kvh * 18;
    const bool qctx = qb < 2;
    const bf16_t* P = (const bf16_t*)(p.ws + WS_P);
    const float* rc = (const float*)(p.ws + WS_ROPE); const float* rs = rc + 2048 * 32;
    bf16_t* Y = (bf16_t*)(p.ws + WS_HY);
    LAS bf16_t* Ks = (LAS bf16_t*)lds; LAS bf16_t* Vt = Ks + 128 * KST;
    const int hh = w >> 1, qhalf = w & 1, head = kvh * 4 + hh;
    const int fr = lane & 15, fq = lane >> 4;
    const int rowq0 = b * TPB + qb * 128 + qhalf * 64;
    bf16x8 qf[4][2];
#pragma unroll
    for (int qt = 0; qt < 4; ++qt) {
        const int row = rowq0 + qt * 16 + fr; const bf16_t* qp = P + (size_t)row * NP + PC_SQ + head * 64 + fq * 8;
        const u32x4 r1 = *(const u32x4*)qp, r2 = *(const u32x4*)(qp + 32);
        float a1[8], a2[8];
#pragma unroll
        for (int e = 0; e < 4; ++e) { a1[2 * e] = bflo(r1[e]); a1[2 * e + 1] = bfhi(r1[e]); a2[2 * e] = bflo(r2[e]); a2[2 * e + 1] = bfhi(r2[e]); }
        if (!qctx) { const int t = (qb - 2) * 128 + qhalf * 64 + qt * 16 + fr; const float* cp = rc + t * 32 + fq * 8; const float* sp = rs + t * 32 + fq * 8;
#pragma unroll
            for (int e = 0; e < 8; ++e) { const float cs = cp[e], sn = sp[e]; const float o1 = a1[e] * cs - a2[e] * sn, o2 = a1[e] * sn + a2[e] * cs; a1[e] = o1; a2[e] = o2; } }
        u32x4 o1, o2;
#pragma unroll
        for (int e = 0; e < 4; ++e) { o1[e] = pk2(a1[2 * e] * 0.125f, a1[2 * e + 1] * 0.125f); o2[e] = pk2(a2[2 * e] * 0.125f, a2[2 * e + 1] * 0.125f); }
        qf[qt][0] = __builtin_bit_cast(bf16x8, o1); qf[qt][1] = __builtin_bit_cast(bf16x8, o2);
    }
    const float sink = p.swa_sink[l * 8 + head];
    float mrun[4], lrun[4]; f32x4 O[4][4];
#pragma unroll
    for (int qt = 0; qt < 4; ++qt) { mrun[qt] = sink; lrun[qt] = 1.f;
#pragma unroll
        for (int dv = 0; dv < 4; ++dv) O[qt][dv] = (f32x4){0.f, 0.f, 0.f, 0.f}; }
    for (int ki = 0; ki < 5; ++ki) {
        int blk, rel; bool valid, local;
        if (qctx) { blk = ki; valid = ki < 2; local = false; rel = 0; }
        else if (ki < 3) { blk = qb - 1 + ki; valid = blk >= 2 && blk <= 17; local = true; rel = ki - 1; }
        else { blk = ki - 3; valid = true; local = false; rel = 0; }
        if (!valid) continue;
        const int rowk0 = b * TPB + blk * 128;
        {
            const int key = tid >> 2, g = tid & 3; const bf16_t* kp = P + (size_t)(rowk0 + key) * NP + PC_SK + kvh * 64 + g * 8;
            const u32x4 r1 = *(const u32x4*)kp, r2 = *(const u32x4*)(kp + 32);
            u32x4 o1 = r1, o2 = r2;
            if (local) { float a1[8], a2[8];
#pragma unroll
                for (int e = 0; e < 4; ++e) { a1[2 * e] = bflo(r1[e]); a1[2 * e + 1] = bfhi(r1[e]); a2[2 * e] = bflo(r2[e]); a2[2 * e + 1] = bfhi(r2[e]); }
                const int t = (blk - 2) * 128 + key; const float* cp = rc + t * 32 + g * 8; const float* sp = rs + t * 32 + g * 8;
#pragma unroll
                for (int e = 0; e < 8; ++e) { const float cs = cp[e], sn = sp[e]; const float x1 = a1[e] * cs - a2[e] * sn, x2 = a1[e] * sn + a2[e] * cs; a1[e] = x1; a2[e] = x2; }
#pragma unroll
                for (int e = 0; e < 4; ++e) { o1[e] = pk2(a1[2 * e], a1[2 * e + 1]); o2[e] = pk2(a2[2 * e], a2[2 * e + 1]); } }
            *(LAS u32x4*)(Ks + key * KST + g * 8) = o1; *(LAS u32x4*)(Ks + key * KST + 32 + g * 8) = o2;
#pragma unroll
            for (int it = 0; it < 2; ++it) { const int idx = tid + NTHR * it; const int vk = idx >> 3, vg = idx & 7;
                const u32x4 rv = *(const u32x4*)(P + (size_t)(rowk0 + vk) * NP + PC_SV + kvh * 64 + vg * 8);
#pragma unroll
                for (int e = 0; e < 4; ++e) { Vt[(vg * 8 + 2 * e) * VST + vk] = (bf16_t)(rv[e] & 0xffffu); Vt[(vg * 8 + 2 * e + 1) * VST + vk] = (bf16_t)(rv[e] >> 16); } }
        }
        __syncthreads();
#pragma unroll
        for (int qt = 0; qt < 4; ++qt) {
            f32x4 Sx[8];
#pragma unroll
            for (int kt = 0; kt < 8; ++kt) { Sx[kt] = (f32x4){0.f, 0.f, 0.f, 0.f};
#pragma unroll
                for (int kk = 0; kk < 2; ++kk) { const bf16x8 A = *(const LAS bf16x8*)(Ks + (kt * 16 + fr) * KST + kk * 32 + fq * 8);
                    Sx[kt] = __builtin_amdgcn_mfma_f32_16x16x32_bf16(A, qf[qt][kk], Sx[kt], 0, 0, 0); } }
            if (rel != 0) { int qi = qhalf * 64 + qt * 16 + fr; asm volatile("" : "+v"(qi));
#pragma unroll
                for (int kt = 0; kt < 8; ++kt)
#pragma unroll
                    for (int j = 0; j < 4; ++j) { const int kx = kt * 16 + fq * 4 + j; const bool ok = rel < 0 ? (kx >= qi) : (kx <= qi); if (!ok) Sx[kt][j] = -1e30f; } }
            float mx = -1e30f;
#pragma unroll
            for (int kt = 0; kt < 8; ++kt) mx = fmaxf(mx, fmaxf(fmaxf(Sx[kt][0], Sx[kt][1]), fmaxf(Sx[kt][2], Sx[kt][3])));
            mx = xrow16_max(mx);
            const float mnew = fmaxf(mrun[qt], mx); const float alpha = __expf(mrun[qt] - mnew); mrun[qt] = mnew;
            float rsum = 0.f;
#pragma unroll
            for (int kt = 0; kt < 8; ++kt)
#pragma unroll
                for (int j = 0; j < 4; ++j) { const float e = __expf(Sx[kt][j] - mnew); Sx[kt][j] = e; rsum += e; }
            rsum = xrow16_sum(rsum);
            lrun[qt] = lrun[qt] * alpha + rsum;
#pragma unroll
            for (int dv = 0; dv < 4; ++dv) O[qt][dv] = O[qt][dv] * alpha;
#pragma unroll
            for (int ks2 = 0; ks2 < 4; ++ks2) {
                u32x4 pb; pb[0] = pk2(Sx[2 * ks2][0], Sx[2 * ks2][1]); pb[1] = pk2(Sx[2 * ks2][2], Sx[2 * ks2][3]); pb[2] = pk2(Sx[2 * ks2 + 1][0], Sx[2 * ks2 + 1][1]); pb[3] = pk2(Sx[2 * ks2 + 1][2], Sx[2 * ks2 + 1][3]);
                const bf16x8 Bp = __builtin_bit_cast(bf16x8, pb);
#pragma unroll
                for (int dv = 0; dv < 4; ++dv) { const LAS bf16_t* vp = Vt + (dv * 16 + fr) * VST + ks2 * 32 + fq * 4;
                    const u32x2 lo = *(const LAS u32x2*)vp, hi = *(const LAS u32x2*)(vp + 16);
                    u32x4 av; av[0] = lo[0]; av[1] = lo[1]; av[2] = hi[0]; av[3] = hi[1];
                    O[qt][dv] = __builtin_amdgcn_mfma_f32_16x16x32_bf16(__builtin_bit_cast(bf16x8, av), Bp, O[qt][dv], 0, 0, 0); }
            }
        }
        __syncthreads();
    }
#pragma unroll
    for (int qt = 0; qt < 4; ++qt) { const float inv = 1.f / lrun[qt]; const int row = rowq0 + qt * 16 + fr;
#pragma unroll
        for (int dv = 0; dv < 4; ++dv) { u32x2 o2; o2[0] = pk2(O[qt][dv][0] * inv, O[qt][dv][1] * inv); o2[1] = pk2(O[qt][dv][2] * inv, O[qt][dv][3] * inv);
            *(u32x2*)(Y + (size_t)row * D + 256 + head * 64 + dv * 16 + fq * 4) = o2; } }
}

__device__ __forceinline__ void phase_mixers(const Params& p, int l, LAS unsigned char* lds, const int wvs) {
    for (int s = blockIdx.x; s < 256; s += gridDim.x) { if (s < 128) dn_seq(p, l, s, lds, wvs); else hg_seq(p, l, s - 128, lds, wvs); }
    unsigned* ctr = (unsigned*)(p.ws + WS_CTL) + 64 * (1 + l);
    LAS int* su = (LAS int*)(lds + 140 * 1024);
    for (;;) {
        __syncthreads();
        if (wvs == 0 && lane_id_fresh() == 0) su[0] = (int)atomicAdd(ctr, 1u);
        __syncthreads();
        const int unit = su[0];
        if (unit >= 576) break;
        swa_unit(p, l, unit, lds, wvs);
    }
}

__device__ __forceinline__ void phase_finalize(const Params& p, int l, const int wvs) {
    const int tid = wvs * 64 + lane_id_fresh(); const int lane = tid & 63, w = tid >> 6;
    const int gw = blockIdx.x * NWAVES + w, NGW = gridDim.x * NWAVES;
    const bf16_t* P = (const bf16_t*)(p.ws + WS_P);
    const bf16_t* OD0 = (const bf16_t*)(p.ws + WS_OD); const bf16_t* OD1 = OD0 + (size_t)M * 512;
    bf16_t* Y = (bf16_t*)(p.ws + WS_HY);
    const int seg = lane >> 3, d0 = (lane & 7) * 8;
    const int hd = seg & 3; const bool isdn = seg < 4;
    const float* gain = (isdn ? p.dn_norm : p.hg_norm) + l * 64 + d0;
    const f32x4 g0 = *(const f32x4*)gain, g1 = *(const f32x4*)(gain + 4);
    const int ocol = (isdn ? 0 : 256) + hd * 64 + d0, gcol = (isdn ? PC_DNG : PC_HG) + hd * 64 + d0, ycol = (isdn ? 0 : 768) + hd * 64 + d0;
    for (int r = gw; r < M; r += NGW) {
        const u32x4 a = *(const u32x4*)(OD0 + (size_t)r * 512 + ocol), bq = *(const u32x4*)(OD1 + (size_t)r * 512 + ocol), gt = *(const u32x4*)(P + (size_t)r * NP + gcol);
        float o[8]; float ss = 0.f;
#pragma unroll
        for (int e = 0; e < 4; ++e) { o[2 * e] = bflo(a[e]) + bflo(bq[e]); o[2 * e + 1] = bfhi(a[e]) + bfhi(bq[e]); ss += o[2 * e] * o[2 * e] + o[2 * e + 1] * o[2 * e + 1]; }
        ss = sum8(ss);
        const float rms = rsqrtf(ss * (1.f / 64.f) + EPS);
        u32x4 y;
#pragma unroll
        for (int e = 0; e < 4; ++e) { const float ga = bflo(gt[e]), gb = bfhi(gt[e]);
            const float ge0 = e < 2 ? g0[2 * e] : g1[2 * e - 4], ge1 = e < 2 ? g0[2 * e + 1] : g1[2 * e - 3];
            y[e] = pk2(o[2 * e] * rms * ge0 * siluf(ga), o[2 * e + 1] * rms * ge1 * siluf(gb)); }
        *(u32x4*)(Y + (size_t)r * D + ycol) = y;
    }
}

__device__ __forceinline__ void phase_final(const Params& p, const int wvs) {
    const int tid = wvs * 64 + lane_id_fresh(); const int lane = tid & 63, w = tid >> 6;
    const int gw = blockIdx.x * NWAVES + w, NGW = gridDim.x * NWAVES;
    for (int r = gw; r < BATCH * SEQ; r += NGW) {
        f32x4* xr = (f32x4*)(p.out + ((size_t)r << 10)) + lane;
        f32x4 v[4]; float ss = 0.f;
#pragma unroll
        for (int j = 0; j < 4; ++j) { v[j] = xr[64 * j]; ss += (v[j][0] * v[j][0] + v[j][1] * v[j][1]) + (v[j][2] * v[j][2] + v[j][3] * v[j][3]); }
        const float rstd = rsqrtf(wave_sum(ss) * (1.f / D) + EPS);
#pragma unroll
        for (int j = 0; j < 4; ++j) { const f32x4 g = *(const f32x4*)(p.norm_f + 4 * (lane + 64 * j)); xr[64 * j] = v[j] * rstd * g; }
    }
}

__global__ void __launch_bounds__(NTHR, 2) fwd_megakernel(Params p) {
    extern __shared__ __attribute__((aligned(16))) unsigned char lds_raw[];
    LAS unsigned char* lds = (LAS unsigned char*)lds_raw;
    cg::grid_group grid = cg::this_grid();
    const int G = gridDim.x, c = blockIdx.x;
    const int wvs = __builtin_amdgcn_readfirstlane((int)(threadIdx.x >> 6));
    phase_prologue(p, lds, wvs);
    grid.sync();
    const float* mods = (const float*)(p.ws + WS_MODS);
    float* Xc = (float*)(p.ws + WS_XC);
    bf16_t* HY = (bf16_t*)(p.ws + WS_HY); bf16_t* PB = (bf16_t*)(p.ws + WS_P);
    for (int l = 0; l < DEPTH; ++l) {
        phase_norm<true>(p, l, lds, wvs);
        grid.sync();
        { pg8::Gemm g{HY, (const bf16_t*)(p.ws + WS_WIN), M, NP, D}; pg8::StaticOrder S; S.init(M, NP, G, c); pg8::EpiBf16<0> E{PB, NP};
          pg8::gemm_phase<pg8::EpiBf16<0>, pg8::StaticOrder, true, true>(lds, g, S, E, wvs); }
        grid.sync();
        phase_mixers(p, l, lds, wvs);
        grid.sync();
        phase_finalize(p, l, wvs);
        grid.sync();
        { pg8::Gemm g{HY, (const bf16_t*)(p.ws + WS_WOUT), M, D, D}; pg8::StaticOrder S; S.init(M, D, G, c); pg8::EpiRes E{p.out, Xc, mods + ((size_t)l * 17 * 6 + 2) * 1024};
          pg8::gemm_phase<pg8::EpiRes, pg8::StaticOrder, true, true>(lds, g, S, E, wvs); }
        grid.sync();
        phase_norm<false>(p, l, lds, wvs);
        grid.sync();
        { pg8::Gemm g{HY, (const bf16_t*)(p.ws + WS_W1), M, DFF, D}; pg8::StaticOrder S; S.init(M, DFF, G, c); pg8::EpiBf16<1> E{PB, DFF};
          pg8::gemm_phase<pg8::EpiBf16<1>, pg8::StaticOrder, true, true>(lds, g, S, E, wvs); }
        grid.sync();
        { pg8::Gemm g{PB, (const bf16_t*)(p.ws + WS_W2), M, D, DFF}; pg8::StaticOrder S; S.init(M, D, G, c); pg8::EpiRes E{p.out, Xc, mods + ((size_t)l * 17 * 6 + 5) * 1024};
          pg8::gemm_phase<pg8::EpiRes, pg8::StaticOrder, true, true>(lds, g, S, E, wvs); }
        grid.sync();
    }
    phase_final(p, wvs);
}

extern "C" void kernel_launch(void* const* d_in, const int* in_sizes, int n_in, void* d_out, int out_size, void* d_ws, size_t ws_size, hipStream_t stream) {
    static int grid = 0;
    if (grid == 0) {
        if (n_in != 20 || ws_size < WS_END) { fprintf(stderr, "kernel_launch: need 20 inputs and >= %zu bytes of workspace (got %d, %zu)\n", (size_t)WS_END, n_in, ws_size); grid = -1; return; }
        int dev = 0, cus = 0, per_cu = 0;
        hipGetDevice(&dev); hipDeviceGetAttribute(&cus, hipDeviceAttributeMultiprocessorCount, dev);
        if (hipFuncSetAttribute((const void*)fwd_megakernel, hipFuncAttributeMaxDynamicSharedMemorySize, LDS_BYTES) != hipSuccess) { fprintf(stderr, "kernel_launch: hipFuncSetAttribute failed\n"); grid = -1; return; }
        if (hipOccupancyMaxActiveBlocksPerMultiprocessor(&per_cu, (const void*)fwd_megakernel, NTHR, LDS_BYTES) != hipSuccess || per_cu < 1) { fprintf(stderr, "kernel_launch: occupancy query says %d blocks/CU\n", per_cu); per_cu = 1; }
        (void)hipGetLastError();
        grid = cus;
    }
    if (grid < 0) return;
    hipMemsetAsync((char*)d_ws + WS_CTL, 0, 4096, stream);
    Params p{};
    const float** pp = (const float**)&p;
    for (int i = 0; i < 20; ++i) pp[i] = (const float*)d_in[i];
    p.out = (float*)d_out; p.ws = (unsigned char*)d_ws;
    void* args[] = {&p};
    hipError_t e = hipLaunchCooperativeKernel((const void*)fwd_megakernel, dim3(grid), dim3(NTHR), args, LDS_BYTES, stream);
    if (e != hipSuccess) fprintf(stderr, "cooperative launch failed: %s (grid %d)\n", hipGetErrorString(e), grid);
}
```

```cpp
#include <hip/hip_runtime.h>
#include <hip/hip_cooperative_groups.h>
#include <cstdio>
#include <cstdint>
namespace cg = cooperative_groups;

__device__ __forceinline__ int lane_id_fresh() { unsigned m = ~0u; asm volatile("" : "+s"(m)); return (int)__builtin_amdgcn_mbcnt_hi(m, __builtin_amdgcn_mbcnt_lo(m, 0u)); }
namespace pg8 {
#define PG8_LAS __attribute__((address_space(3)))
typedef unsigned short bf16_t;
typedef short bf16x8 __attribute__((ext_vector_type(8)));
typedef float f32x4 __attribute__((ext_vector_type(4)));
typedef unsigned u32x4 __attribute__((ext_vector_type(4)));
constexpr int BM = 256, BK = 64, HALF = 128, HTB = HALF * BK * 2  , STAGE_BYTES = 8 * HTB, NXCD = 8, WGM = 8;

__host__ __device__ __forceinline__ int lds_byte(int r, int c) { const int st = (r >> 4) * 2 + (c >> 5), rr = r & 15, cc = c & 31, ob = rr * 64 + cc * 2; return st * 1024 + (ob ^ (((ob >> 9) & 1) << 5)); }
__host__ __device__ __forceinline__ void stage_rc(int b, int& R, int& C) { const int st = b / 1024, sb = b % 1024, swz = sb ^ (((sb >> 9) & 1) << 5); R = (st >> 1) * 16 + swz / 64; C = (st & 1) * 32 + (swz % 64) / 2; }
__host__ __device__ __forceinline__ int perm32(int rho) { const int n = rho >> 4, i = rho & 15; return 8 * (i >> 2) + 4 * n + (i & 3); }

struct Unit { int pm, pn; };
struct Gemm { const bf16_t* A; const bf16_t* Bt; int M, N, K; };

struct StaticOrder {
    int nM, nN, nwg, G, c;
    __host__ __device__ void init(int M, int N, int G_, int c_) { nM = M / BM; nN = N / BM; nwg = nM * nN; G = G_; c = c_; }
    __host__ __device__ bool next(int i, Unit& u) const {
        const long L = (long)i * G + c; if (L >= nwg) return false;
        int wgid = (int)L; { const int q = nwg / NXCD, r = nwg % NXCD, xcd = wgid % NXCD, off = wgid / NXCD; wgid = (xcd < r ? xcd * (q + 1) : r * (q + 1) + (xcd - r) * q) + off; }
        const int nig = WGM * nN, gid = wgid / nig, fm = gid * WGM, gsz = (nM - fm) < WGM ? (nM - fm) : WGM;
        u.pm = fm + ((wgid % nig) % gsz); u.pn = (wgid % nig) / gsz; return true;
    }
    __device__ __forceinline__ void a_ready(const Unit&) const {}
    __device__ __forceinline__ void done(const Unit&) const {}
};

__device__ __forceinline__ unsigned cvt_pk_bf16(float lo, float hi) { unsigned r; asm volatile("v_cvt_pk_bf16_f32 %0, %1, %2" : "=v"(r) : "v"(lo), "v"(hi)); return r; }

template <int ACT  > struct EpiBf16 {
    static constexpr bool PERM = true, AFTER_DRAIN = false;
    bf16_t* O; int ldc;
    __device__ __forceinline__ void operator()(const f32x4 (&acc)[2][2][4][2], const Unit& u, int wr, int wc, int fr, int fq) const {
        const int row0 = u.pm * BM + wr * 64 + fr; const int col0 = u.pn * BM + wc * 32 + 8 * fq;
#pragma unroll
        for (int ai = 0; ai < 2; ++ai)
#pragma unroll
            for (int m = 0; m < 4; ++m) { bf16_t* rowp = O + (size_t)(row0 + ai * HALF + m * 16) * ldc + col0;
#pragma unroll
                for (int bj = 0; bj < 2; ++bj) { f32x4 v0 = acc[ai][bj][m][0], v1 = acc[ai][bj][m][1];
                    if (ACT == 1) {
#pragma unroll
                        for (int e = 0; e < 4; ++e) { float a = fmaxf(v0[e], 0.f), b = fmaxf(v1[e], 0.f); v0[e] = a * a; v1[e] = b * b; } }
                    u32x4 w; w.x = cvt_pk_bf16(v0[0], v0[1]); w.y = cvt_pk_bf16(v0[2], v0[3]); w.z = cvt_pk_bf16(v1[0], v1[1]); w.w = cvt_pk_bf16(v1[2], v1[3]);
                    *(u32x4*)(rowp + bj * HALF) = w; } }
    }
};
struct EpiRes {
    static constexpr bool PERM = false, AFTER_DRAIN = false;
    float* Xl; float* Xc; const float* gates;
    __device__ __forceinline__ void operator()(const f32x4 (&acc)[2][2][4][2], const Unit& u, int wr, int wc, int fr, int fq) const {
        const int b = u.pm / 9, tt = u.pm - b * 9;
        float* base = (tt == 0) ? Xc + ((size_t)(b * 256) << 10) : Xl + ((size_t)(b * 2048 + (tt - 1) * 256) << 10);
        const float* g = gates + (size_t)((tt == 0) ? 16 : b) * 6144;
        const int col0 = u.pn * BM + wc * 32 + 4 * fq;
        float* rp0 = base + ((size_t)(wr * 64 + fr) << 10) + col0;
#pragma unroll
        for (int bj = 0; bj < 2; ++bj)
#pragma unroll
            for (int n = 0; n < 2; ++n) { const f32x4 gvv = *(const f32x4*)(g + col0 + bj * HALF + n * 16);
#pragma unroll
                for (int ai = 0; ai < 2; ++ai) {
#pragma unroll
                    for (int m = 0; m < 4; ++m) { f32x4* pp = (f32x4*)(rp0 + (size_t)(ai * HALF + m * 16) * 1024 + bj * HALF + n * 16); f32x4 xv = *pp; xv = xv + gvv * acc[ai][bj][m][n]; *pp = xv; }
                    asm volatile("" ::: "memory"); } }
    }
};
template <class Epi, class Sched, bool ALIGN_EPI = false, bool SP2 = false>
__device__ __forceinline__ void gemm_phase(PG8_LAS unsigned char* lds, const Gemm g, const Sched& S, const Epi& E, const int wvs) {
    const int tid = wvs * 64 + lane_id_fresh(); const int wid = __builtin_amdgcn_readfirstlane(tid >> 6), lane = tid & 63, wr = wid >> 2, wc = wid & 3, fr = lane & 15, fq = lane >> 4;
    const int K = g.K, nt = K / BK;
    unsigned voffA[2], voffB[2];
#pragma unroll
    for (int i = 0; i < 2; ++i) { int R, C; stage_rc(tid * 16 + i * 8192, R, C); const int Rb = Epi::PERM ? ((R & ~31) + perm32(R & 31)) : R;
        voffA[i] = (unsigned)(R * K + C) * 2u; voffB[i] = (unsigned)(Rb * K + C) * 2u; }
    const size_t kstep = (size_t)(BK * 2);
    const size_t hstep = (size_t)HALF * K * 2;
    const size_t tstep = 2 * hstep;
    const unsigned ldsw = (unsigned)wid * 1024u;
    const int aoff = lds_byte(wr * 64 + fr, fq * 8), boff = lds_byte(wc * 32 + fr, fq * 8);
#define PG8_SA(b, h) (((b) * 2 + (h)) * HTB)
#define PG8_SB(b, h) ((4 + (b) * 2 + (h)) * HTB)
#define PG8_STAGE(bufoff, gbase, voff) do { _Pragma("unroll") for (int _i = 0; _i < 2; ++_i) \
        __builtin_amdgcn_global_load_lds((const unsigned*)((const char*)(gbase) + (voff)[_i]), (PG8_LAS unsigned*)(lds + (bufoff) + ldsw + _i * 8192), 16, 0, 0); } while (0)
#define PG8_LDA(dst, b, h) do { _Pragma("unroll") for (int m = 0; m < 4; ++m) _Pragma("unroll") for (int k = 0; k < 2; ++k) dst[m][k] = *(const PG8_LAS bf16x8*)(lds + PG8_SA(b, h) + aoff + m * 2048 + k * 1024); } while (0)
#define PG8_LDB(dst, b, h) do { _Pragma("unroll") for (int n = 0; n < 2; ++n) _Pragma("unroll") for (int k = 0; k < 2; ++k) dst[n][k] = *(const PG8_LAS bf16x8*)(lds + PG8_SB(b, h) + boff + n * 2048 + k * 1024); } while (0)
#define PG8_MMA(ai, bj, At, Bt) do { __builtin_amdgcn_s_setprio(1); _Pragma("unroll") for (int m = 0; m < 4; ++m) _Pragma("unroll") for (int n = 0; n < 2; ++n) _Pragma("unroll") for (int k = 0; k < 2; ++k) \
        acc[ai][bj][m][n] = __builtin_amdgcn_mfma_f32_16x16x32_bf16(Bt[n][k], At[m][k], acc[ai][bj][m][n], 0, 0, 0); __builtin_amdgcn_s_setprio(0); } while (0)
#define PG8_WAIT_V(n) asm volatile("s_waitcnt vmcnt(" #n ")" ::: "memory")
#define PG8_WAIT_L(n) asm volatile("s_waitcnt lgkmcnt(" #n ")" ::: "memory")
#define PG8_BAR __builtin_amdgcn_s_barrier()
#define PG8_SCHED __builtin_amdgcn_sched_barrier(0)
    Unit cur, nxt; int ui = 0;
    if (!S.next(0, cur)) return;
    f32x4 acc[2][2][4][2];
#pragma unroll
    for (int a = 0; a < 2; ++a)
#pragma unroll
        for (int b = 0; b < 2; ++b)
#pragma unroll
            for (int m = 0; m < 4; ++m)
#pragma unroll
                for (int n = 0; n < 2; ++n) acc[a][b][m][n] = (f32x4){0.f, 0.f, 0.f, 0.f};
    bf16x8 At[4][2], B0[2][2], B1[2][2];
    const char* cA = (const char*)g.A + (size_t)cur.pm * tstep; const char* cB = (const char*)g.Bt + (size_t)cur.pn * tstep;
    S.a_ready(cur);
    if constexpr (SP2) {
        PG8_STAGE(PG8_SB(0, 0), cB, voffB); PG8_STAGE(PG8_SB(0, 1), cB + hstep, voffB); PG8_STAGE(PG8_SA(0, 0), cA, voffA); PG8_STAGE(PG8_SA(0, 1), cA + hstep, voffA);
        if (wr == 1) PG8_BAR;
        PG8_WAIT_V(2); PG8_BAR;
        PG8_STAGE(PG8_SB(1, 0), cB + kstep, voffB); PG8_STAGE(PG8_SA(1, 0), cA + kstep, voffA); PG8_STAGE(PG8_SB(1, 1), cB + hstep + kstep, voffB);
        PG8_WAIT_V(6); PG8_BAR;
    } else {
        PG8_STAGE(PG8_SB(0, 0), cB, voffB); PG8_STAGE(PG8_SA(0, 0), cA, voffA); PG8_STAGE(PG8_SB(0, 1), cB + hstep, voffB); PG8_STAGE(PG8_SA(0, 1), cA + hstep, voffA);
        if (wr == 1) PG8_BAR;
        PG8_WAIT_V(4); PG8_BAR;
        PG8_STAGE(PG8_SB(1, 0), cB + kstep, voffB); PG8_STAGE(PG8_SA(1, 0), cA + kstep, voffA); PG8_STAGE(PG8_SB(1, 1), cB + hstep + kstep, voffB);
        PG8_WAIT_V(6); PG8_BAR;
    }
    for (;;) {
        const bool has_next = S.next(ui + 1, nxt);
        const char* nA = has_next ? (const char*)g.A + (size_t)nxt.pm * tstep : cA; const char* nB = has_next ? (const char*)g.Bt + (size_t)nxt.pn * tstep : cB;
        for (int t = 0; t < nt; t += 2) {
            const bool last = (t == nt - 2);
            const char* a1 = cA + (size_t)(t + 1) * kstep;
            const char* a2 = last ? nA : cA + (size_t)(t + 2) * kstep; const char* b2 = last ? nB : cB + (size_t)(t + 2) * kstep;
            const char* a3 = a2 + kstep; const char* b3 = b2 + kstep;
            if (last && has_next) S.a_ready(nxt);
            if constexpr (SP2) {
            PG8_LDB(B0, 0, 0); PG8_LDB(B1, 0, 1); PG8_SCHED; PG8_LDA(At, 0, 0); PG8_STAGE(PG8_SA(1, 1), a1 + hstep, voffA);
            PG8_WAIT_V(8); PG8_WAIT_L(0); PG8_BAR; PG8_MMA(0, 0, At, B0); PG8_MMA(0, 1, At, B1); PG8_BAR; PG8_SCHED;
            PG8_LDA(At, 0, 1); PG8_STAGE(PG8_SB(0, 0), b2, voffB); PG8_STAGE(PG8_SB(0, 1), b2 + hstep, voffB); PG8_STAGE(PG8_SA(0, 0), a2, voffA);
            PG8_WAIT_V(8); PG8_WAIT_L(0); PG8_BAR; PG8_MMA(1, 0, At, B0); PG8_MMA(1, 1, At, B1); PG8_BAR; PG8_SCHED;
            PG8_LDB(B0, 1, 0); PG8_LDB(B1, 1, 1); PG8_SCHED; PG8_LDA(At, 1, 0); PG8_STAGE(PG8_SA(0, 1), a2 + hstep, voffA);
            PG8_WAIT_V(8); PG8_WAIT_L(0); PG8_BAR; PG8_MMA(0, 0, At, B0); PG8_MMA(0, 1, At, B1); PG8_BAR; PG8_SCHED;
            PG8_LDA(At, 1, 1); PG8_STAGE(PG8_SB(1, 0), b3, voffB); PG8_STAGE(PG8_SB(1, 1), b3 + hstep, voffB); PG8_STAGE(PG8_SA(1, 0), a3, voffA);
            PG8_WAIT_V(8); PG8_WAIT_L(0); PG8_BAR; PG8_MMA(1, 0, At, B0); PG8_MMA(1, 1, At, B1); PG8_BAR; PG8_SCHED;
            } else {
            PG8_LDB(B0, 0, 0); PG8_SCHED; PG8_LDA(At, 0, 0); PG8_STAGE(PG8_SA(1, 1), a1 + hstep, voffA);
            PG8_WAIT_L(8); PG8_BAR; PG8_WAIT_L(0); PG8_MMA(0, 0, At, B0); PG8_BAR; PG8_SCHED;
            PG8_LDB(B1, 0, 1); PG8_STAGE(PG8_SB(0, 0), b2, voffB);
            PG8_BAR; PG8_WAIT_L(0); PG8_MMA(0, 1, At, B1); PG8_BAR;
            PG8_LDA(At, 0, 1); PG8_STAGE(PG8_SA(0, 0), a2, voffA);
            PG8_BAR; PG8_WAIT_L(0); PG8_MMA(1, 0, At, B0); PG8_BAR; PG8_SCHED;
            PG8_STAGE(PG8_SB(0, 1), b2 + hstep, voffB);
            PG8_WAIT_V(6); PG8_BAR; PG8_MMA(1, 1, At, B1); PG8_BAR;
            PG8_LDB(B0, 1, 0); PG8_SCHED; PG8_LDA(At, 1, 0); PG8_STAGE(PG8_SA(0, 1), a2 + hstep, voffA);
            PG8_WAIT_L(8); PG8_BAR; PG8_WAIT_L(0); PG8_MMA(0, 0, At, B0); PG8_BAR; PG8_SCHED;
            PG8_LDB(B1, 1, 1); PG8_STAGE(PG8_SB(1, 0), b3, voffB);
            PG8_BAR; PG8_WAIT_L(0); PG8_MMA(0, 1, At, B1); PG8_BAR;
            PG8_LDA(At, 1, 1); PG8_STAGE(PG8_SA(1, 0), a3, voffA);
            PG8_BAR; PG8_WAIT_L(0); PG8_MMA(1, 0, At, B0); PG8_BAR; PG8_SCHED;
            PG8_STAGE(PG8_SB(1, 1), b3 + hstep, voffB);
            PG8_WAIT_V(6); PG8_BAR; PG8_MMA(1, 1, At, B1); PG8_BAR;
            }
        }
        if constexpr (ALIGN_EPI) { if (wr == 0) PG8_BAR; }
        if constexpr (!Epi::AFTER_DRAIN) { E(acc, cur, wr, wc, fr, fq); S.done(cur); }
        if (!has_next) break;
#pragma unroll
        for (int a = 0; a < 2; ++a)
#pragma unroll
            for (int b = 0; b < 2; ++b)
#pragma unroll
                for (int m = 0; m < 4; ++m)
#pragma unroll
                    for (int n = 0; n < 2; ++n) acc[a][b][m][n] = (f32x4){0.f, 0.f, 0.f, 0.f};
        cur = nxt; cA = nA; cB = nB; ++ui;
        if constexpr (ALIGN_EPI) { if (wr == 1) PG8_BAR; }
    }
    PG8_WAIT_V(0);
    if constexpr (!ALIGN_EPI) { if (wr == 0) PG8_BAR; }
    PG8_BAR;
    if constexpr (Epi::AFTER_DRAIN) { E.fused(acc, cur, wr, wc, fr, fq, lds, wid, lane); S.done(cur); }
#undef PG8_SA
#undef PG8_SB
#undef PG8_STAGE
#undef PG8_LDA
#undef PG8_LDB
#undef PG8_MMA
#undef PG8_WAIT_V
#undef PG8_WAIT_L
#undef PG8_BAR
#undef PG8_SCHED
}
}

constexpr int D = 1024, BATCH = 16, SEQ = 2048, CTX = 256, DEPTH = 4;
constexpr int TPB = CTX + SEQ;
constexpr int M = BATCH * TPB;
constexpr int DIN = 3088, NP = 3072, DFF = 4096;
constexpr int PC_DNQ = 0, PC_DNG = 768, PC_SQ = 1024, PC_SK = 1536, PC_SV = 1664, PC_HQ = 1792, PC_HF = 2048, PC_HI = 2560, PC_HG = 2816;
constexpr float EPS = 1e-6f;
constexpr size_t MiB = 1u << 20;
constexpr size_t WS_CTL = 0, WS_MODS = 1 * MiB, WS_ROPE = 3 * MiB, WS_LB = 3 * MiB + 512 * 1024, WS_AB = 4 * MiB;
constexpr size_t WS_WIN = 7 * MiB, WS_WOUT = 13 * MiB, WS_W1 = 15 * MiB, WS_W2 = 23 * MiB, WS_XC = 32 * MiB, WS_HY = 48 * MiB, WS_P = 120 * MiB;
constexpr size_t WS_OD = WS_P + 216 * MiB, WS_END = WS_P + 288 * MiB;
constexpr int LDS_BYTES = 147456;
constexpr int NWAVES = 8, NTHR = 512;

#define LAS __attribute__((address_space(3)))
typedef unsigned short bf16_t;
typedef float f32x4 __attribute__((ext_vector_type(4)));
typedef short bf16x8 __attribute__((ext_vector_type(8)));
typedef short s16x4 __attribute__((ext_vector_type(4)));
typedef unsigned u32x4 __attribute__((ext_vector_type(4)));
typedef unsigned u32x2 __attribute__((ext_vector_type(2)));

struct Params {
    const float *x, *c, *ctx, *c_ctx, *w_ada, *b_ada, *norm1, *norm2, *w_in, *dn_conv, *dn_A_log, *dn_dt_bias, *dn_norm, *swa_sink, *hg_lb, *hg_norm, *w_out, *w_ff1, *w_ff2, *norm_f;
    float* out; unsigned char* ws;
};

__device__ __forceinline__ float bflo(unsigned u) { return __uint_as_float(u << 16); }
__device__ __forceinline__ float bfhi(unsigned u) { return __uint_as_float(u & 0xffff0000u); }
__device__ __forceinline__ unsigned pk2(float lo, float hi) { return pg8::cvt_pk_bf16(lo, hi); }
__device__ __forceinline__ bf16_t bf1(float f) { unsigned u = __float_as_uint(f); u += 0x7fffu + ((u >> 16) & 1u); return (bf16_t)(u >> 16); }
__device__ __forceinline__ float siluf(float v) { return v / (1.f + __expf(-v)); }
__device__ __forceinline__ float sigmf(float v) { return 1.f / (1.f + __expf(-v)); }
__device__ __forceinline__ float wave_sum(float v) {
#pragma unroll
    for (int o = 1; o < 64; o <<= 1) v += __shfl_xor(v, o);
    return v;
}
template <int CTRL> __device__ __forceinline__ float dpp(float x) { return __builtin_bit_cast(float, __builtin_amdgcn_mov_dpp(__builtin_bit_cast(int, x), CTRL, 0xf, 0xf, true)); }
constexpr int XOR1 = 0xB1, XOR2 = 0x4E, XOR7 = 0x141;
__device__ __forceinline__ float sum8(float v) { v += dpp<XOR1>(v); v += dpp<XOR2>(v); v += dpp<XOR7>(v); return v; }
__device__ __forceinline__ float xrow16_max(float x) {
    auto s = __builtin_amdgcn_permlane16_swap(__float_as_uint(x), __float_as_uint(x), false, false);
    x = fmaxf(__uint_as_float(s[0]), __uint_as_float(s[1]));
    auto t = __builtin_amdgcn_permlane32_swap(__float_as_uint(x), __float_as_uint(x), false, false);
    return fmaxf(__uint_as_float(t[0]), __uint_as_float(t[1]));
}
__device__ __forceinline__ float xrow16_sum(float x) {
    auto s = __builtin_amdgcn_permlane16_swap(__float_as_uint(x), __float_as_uint(x), false, false);
    x = __uint_as_float(s[0]) + __uint_as_float(s[1]);
    auto t = __builtin_amdgcn_permlane32_swap(__float_as_uint(x), __float_as_uint(x), false, false);
    return __uint_as_float(t[0]) + __uint_as_float(t[1]);
}
__device__ __forceinline__ const float* xrow_c(const float* Xl, const float* Xc, int r) { const int b = r / TPB, t = r - b * TPB; return t < CTX ? Xc + ((size_t)(b * CTX + t) << 10) : Xl + ((size_t)(b * SEQ + t - CTX) << 10); }
__device__ __forceinline__ int cidx(int r) { const int b = r / TPB, t = r - b * TPB; return t < CTX ? 16 : b; }

__device__ __forceinline__ void phase_prologue(const Params& p, LAS unsigned char* lds, const int wvs) {
    const int tid = wvs * 64 + lane_id_fresh(); const int lane = tid & 63, w = tid >> 6;
    float* mods = (float*)(p.ws + WS_MODS);
    LAS float* sc = (LAS float*)lds;
    LAS float* red = (LAS float*)(lds + 81920);
    for (int idx = tid; idx < 17 * 1024; idx += NTHR) { const int ci = idx >> 10, k = idx & 1023; const float v = ci < 16 ? p.c[ci * 1024 + k] : p.c_ctx[k]; sc[k * 20 + ci] = v / (1.f + expf(-v)); }
    __syncthreads();
    for (int it = blockIdx.x; it < DEPTH * 96; it += gridDim.x) {
        const int l = it / 96, cgp = it - l * 96, col = cgp * 64 + lane;
        float acc[17];
#pragma unroll
        for (int i = 0; i < 17; ++i) acc[i] = 0.f;
        const float* wp = p.w_ada + ((size_t)l * 1024 + w * 128) * 6144 + col;
#pragma unroll 8
        for (int kk = 0; kk < 128; ++kk) {
            const float wv = wp[(size_t)kk * 6144];
            const LAS f32x4* s4 = (const LAS f32x4*)(sc + (w * 128 + kk) * 20);
            const f32x4 s0 = s4[0], s1 = s4[1], s2 = s4[2], s3 = s4[3]; const float s16 = sc[(w * 128 + kk) * 20 + 16];
#pragma unroll
            for (int e = 0; e < 4; ++e) { acc[e] += wv * s0[e]; acc[4 + e] += wv * s1[e]; acc[8 + e] += wv * s2[e]; acc[12 + e] += wv * s3[e]; }
            acc[16] += wv * s16;
        }
#pragma unroll
        for (int i = 0; i < 17; ++i) red[(w * 17 + i) * 64 + lane] = acc[i];
        __syncthreads();
        for (int idx = tid; idx < 17 * 64; idx += NTHR) { const int i = idx >> 6, cl = idx & 63; float s = 0.f;
#pragma unroll
            for (int ww = 0; ww < 8; ++ww) s += red[(ww * 17 + i) * 64 + cl];
            mods[((size_t)l * 17 + i) * 6144 + cgp * 64 + cl] = s + p.b_ada[l * 6144 + cgp * 64 + cl]; }
        __syncthreads();
    }
    const int gt = blockIdx.x * NTHR + tid, GT = gridDim.x * NTHR;
    { float* rc = (float*)(p.ws + WS_ROPE); float* rs = rc + 2048 * 32;
      for (int idx = gt; idx < 2048 * 32; idx += GT) { const int t = idx >> 5, d = idx & 31; const float pos = (float)(d < 16 ? (t >> 6) : (t & 63));
          const float inv = expf(-(float)(d & 15) * (9.210340371976184f / 16.f)); const float ang = pos * inv; rc[idx] = cosf(ang); rs[idx] = sinf(ang); } }
    { float* LB = (float*)(p.ws + WS_LB);
      for (int idx = gt; idx < 2 * 256; idx += GT) { const int d = idx >> 8, cc = idx & 255; float v[DEPTH]; float mx = -1e30f;
#pragma unroll
          for (int l = 0; l < DEPTH; ++l) { v[l] = p.hg_lb[(d * DEPTH + l) * 256 + cc]; mx = fmaxf(mx, v[l]); }
          float s = 0.f;
#pragma unroll
          for (int l = 0; l < DEPTH; ++l) { v[l] = expf(v[l] - mx); s += v[l]; }
          float cum = 0.f;
#pragma unroll
          for (int l = 0; l < DEPTH; ++l) { if (l > 0) cum += v[l] / s; LB[(d * DEPTH + l) * 256 + cc] = cum; } } }
    { const f32x4* src = (const f32x4*)p.x; f32x4* dst = (f32x4*)p.out; for (int i = gt; i < BATCH * SEQ * D / 4; i += GT) dst[i] = src[i];
      const f32x4* s2 = (const f32x4*)p.ctx; f32x4* d2 = (f32x4*)(p.ws + WS_XC); for (int i = gt; i < BATCH * CTX * D / 4; i += GT) d2[i] = s2[i]; }
}

__device__ __forceinline__ void transpose_item(const float* W, int K, int ldw, int scol0, bf16_t* WT, int n0, int k0, LAS float* scr, int lane) {
#pragma unroll 8
    for (int i = 0; i < 32; ++i) { const int kk = 2 * i + (lane >> 5); scr[kk * 33 + (lane & 31)] = W[(size_t)(k0 + kk) * ldw + scol0 + (lane & 31)]; }
    asm volatile("s_waitcnt lgkmcnt(0)" ::: "memory");
    const int c = lane & 7;
#pragma unroll
    for (int j = 0; j < 4; ++j) { const int n = (lane >> 3) + 8 * j; const LAS float* s = scr + (8 * c) * 33 + n;
        u32x4 o; o.x = pk2(s[0 * 33], s[1 * 33]); o.y = pk2(s[2 * 33], s[3 * 33]); o.z = pk2(s[4 * 33], s[5 * 33]); o.w = pk2(s[6 * 33], s[7 * 33]);
        *(u32x4*)(WT + (size_t)(n0 + n) * K + k0 + 8 * c) = o; }
    asm volatile("s_waitcnt lgkmcnt(0)" ::: "memory");
}

template <bool FIRST> __device__ __forceinline__ void phase_norm(const Params& p, int l, LAS unsigned char* lds, const int wvs) {
    const int tid = wvs * 64 + lane_id_fresh(); const int lane = tid & 63, w = tid >> 6;
    const int gw = blockIdx.x * NWAVES + w, NGW = gridDim.x * NWAVES;
    const float* mods = (const float*)(p.ws + WS_MODS);
    LAS float* wab = (LAS float*)lds;
    if (FIRST) {
        LAS float* scr = (LAS float*)(lds + 65536 + w * 8704);
        constexpr int I_IN = 16 * 96, I_OUT = 16 * 32, I_1 = 16 * 128, I_2 = 64 * 32;
        for (int it = gw; it < I_IN + I_OUT + I_1 + I_2; it += NGW) {
            int r = it;
            if (r < I_IN) { const int kb = r / 96, nb = r - kb * 96; const int n0 = nb * 32; transpose_item(p.w_in + (size_t)l * D * DIN, D, DIN, n0 + (n0 >= 1024 ? 16 : 0), (bf16_t*)(p.ws + WS_WIN), n0, kb * 64, scr, lane); continue; }
            r -= I_IN;
            if (r < I_OUT) { const int kb = r / 32, nb = r - kb * 32; transpose_item(p.w_out + (size_t)l * D * D, D, D, nb * 32, (bf16_t*)(p.ws + WS_WOUT), nb * 32, kb * 64, scr, lane); continue; }
            r -= I_OUT;
            if (r < I_1) { const int kb = r / 128, nb = r - kb * 128; transpose_item(p.w_ff1 + (size_t)l * D * DFF, D, DFF, nb * 32, (bf16_t*)(p.ws + WS_W1), nb * 32, kb * 64, scr, lane); continue; }
            r -= I_1;
            { const int kb = r / 32, nb = r - kb * 32; transpose_item(p.w_ff2 + (size_t)l * DFF * D, DFF, D, nb * 32, (bf16_t*)(p.ws + WS_W2), nb * 32, kb * 64, scr, lane); }
        }
        const float* wi = p.w_in + (size_t)l * D * DIN + 1024;
        for (int idx = tid; idx < 4096; idx += NTHR) { const int k = idx >> 2, j4 = (idx & 3) * 4; const f32x4 v = *(const f32x4*)(wi + (size_t)k * DIN + j4);
#pragma unroll
            for (int e = 0; e < 4; ++e) wab[(j4 + e) * 1024 + k] = v[e]; }
        __syncthreads();
    }
    const float* nw = (FIRST ? p.norm1 : p.norm2) + l * D;
    bf16_t* H = (bf16_t*)(p.ws + WS_HY);
    float* AB = (float*)(p.ws + WS_AB);
    const float* Xc = (const float*)(p.ws + WS_XC);
    for (int r = gw; r < M; r += NGW) {
        const f32x4* xr = (const f32x4*)xrow_c(p.out, Xc, r) + lane;
        f32x4 v[4]; float ss = 0.f;
#pragma unroll
        for (int j = 0; j < 4; ++j) { v[j] = xr[64 * j]; ss += (v[j][0] * v[j][0] + v[j][1] * v[j][1]) + (v[j][2] * v[j][2] + v[j][3] * v[j][3]); }
        const float rstd = rsqrtf(wave_sum(ss) * (1.f / D) + EPS);
        const float* md = mods + ((size_t)l * 17 + cidx(r)) * 6144 + (FIRST ? 0 : 3 * 1024);
        float acc[16];
#pragma unroll
        for (int o = 0; o < 16; ++o) acc[o] = 0.f;
        u32x2* hp = (u32x2*)(H + (size_t)r * D) + lane;
#pragma unroll
        for (int j = 0; j < 4; ++j) { const int k = 4 * (lane + 64 * j);
            const f32x4 g = *(const f32x4*)(nw + k), sh = *(const f32x4*)(md + k), sl = *(const f32x4*)(md + 1024 + k);
            f32x4 h;
#pragma unroll
            for (int e = 0; e < 4; ++e) h[e] = (v[j][e] * rstd * g[e]) * (1.f + sl[e]) + sh[e];
            u32x2 o2; o2.x = pk2(h[0], h[1]); o2.y = pk2(h[2], h[3]); hp[64 * j] = o2;
            if (FIRST) {
#pragma unroll
                for (int o = 0; o < 16; ++o) { const f32x4 wv = *(const LAS f32x4*)(wab + o * 1024 + k); acc[o] += (h[0] * wv[0] + h[1] * wv[1]) + (h[2] * wv[2] + h[3] * wv[3]); }
            }
        }
        if (FIRST) { float outv = 0.f;
#pragma unroll
            for (int o = 0; o < 16; ++o) { const float s = wave_sum(acc[o]); if (lane == o) outv = s; }
            if (lane < 16) AB[(size_t)r * 16 + lane] = outv; }
    }
}

constexpr int SST = 68;
constexpr int HST = 72;
__device__ __forceinline__ bf16x8 ldA_perm(const LAS bf16_t* base, int row, int s, int fq) {
    const LAS bf16_t* ap = base + row * HST + s * 32 + fq * 4; const u32x2 lo = *(const LAS u32x2*)ap, hi = *(const LAS u32x2*)(ap + 16);
    u32x4 av; av[0] = lo[0]; av[1] = lo[1]; av[2] = hi[0]; av[3] = hi[1]; return __builtin_bit_cast(bf16x8, av);
}
__device__ __forceinline__ bf16x8 packB(const f32x4& a, const f32x4& b) {
    u32x4 pb; pb[0] = bf1(a[0]) | ((unsigned)bf1(a[1]) << 16); pb[1] = bf1(a[2]) | ((unsigned)bf1(a[3]) << 16); pb[2] = bf1(b[0]) | ((unsigned)bf1(b[1]) << 16); pb[3] = bf1(b[2]) | ((unsigned)bf1(b[3]) << 16);
    return __builtin_bit_cast(bf16x8, pb);
}
__device__ __forceinline__ void dn_seq(const Params& p, int l, int s, LAS unsigned char* lds, const int wvs) {
    const int tid = wvs * 64 + lane_id_fresh(); const int lane = tid & 63;
    const int b = s >> 3, h = (s >> 1) & 3, d = s & 1;
    LAS float* qs = (LAS float*)lds; LAS float* ks = qs + 64 * SST; LAS float* vs = ks + 64 * SST;
    LAS bf16_t* QH = (LAS bf16_t*)(vs + 64 * SST); LAS bf16_t* KH = QH + 64 * HST; LAS bf16_t* KTT = KH + 64 * HST; LAS bf16_t* LM = KTT + 64 * HST; LAS bf16_t* SCM = LM + 64 * HST; LAS bf16_t* OB = SCM + 64 * HST;
    LAS float* LF = (LAS float*)(OB + 64 * HST);
    LAS bf16_t* DI = (LAS bf16_t*)(LF + 4 * 16 * 17);
    LAS float* GC = (LAS float*)(DI + 4 * 16 * 24); LAS float* EG = GC + 64; LAS float* BETA = EG + 64; LAS float* GL = BETA + 64;
    const bf16_t* P = (const bf16_t*)(p.ws + WS_P);
    const float* AB = (const float*)(p.ws + WS_AB);
    bf16_t* OD = (bf16_t*)(p.ws + WS_OD) + (size_t)d * M * 512 + h * 64;
    const float* cw = p.dn_conv + (size_t)l * 5 * 768;
    const float nA = -expf(p.dn_A_log[(l * 2 + d) * 4 + h]); const float dtb = p.dn_dt_bias[(l * 2 + d) * 4 + h];
    const int fr = lane & 15, fq = lane >> 4;
    const int V = wvs & 3, half = wvs >> 2;
    const f32x4 zero4 = (f32x4){0.f, 0.f, 0.f, 0.f};
    constexpr int RST = 200;
    LAS bf16_t* RAW = KTT;
    const int c4 = tid % 48, tg = tid / 48;
    float wc[5][4];
    { const int ch = c4 * 4, pcol = (ch >> 6) * 256 + h * 64 + (ch & 63);
#pragma unroll
      for (int t = 0; t < 5; ++t) { const f32x4 w4 = *(const f32x4*)(cw + t * 768 + pcol); wc[t][0] = w4[0]; wc[t][1] = w4[1]; wc[t][2] = w4[2]; wc[t][3] = w4[3]; } }
    LAS float* cdst = ((c4 >> 4) == 0 ? qs : ((c4 >> 4) == 1 ? ks : vs)) + (c4 & 15) * 4;
    u32x4 praw[4]; float pa = 0.f, pb_ = 0.f;
    { const int nc0 = d == 0 ? 0 : 3; const int base0 = b * TPB + nc0 * 64, lo0 = b * TPB, hi0 = b * TPB + CTX;
#pragma unroll
      for (int k = 0; k < 4; ++k) { const int q = tid + NTHR * k; const int rr = q / 24, pc = q - rr * 24; const int r = base0 - 2 + rr;
          praw[k] = (q < 68 * 24 && r >= lo0 && r < hi0) ? *(const u32x4*)(P + (size_t)r * NP + (pc >> 3) * 256 + h * 64 + (pc & 7) * 8) : (u32x4){0u, 0u, 0u, 0u}; }
      if (wvs == 0) { const int r = base0 + (d ? 63 - lane : lane); pa = AB[(size_t)r * 16 + d * 4 + h]; pb_ = AB[(size_t)r * 16 + 8 + d * 4 + h]; } }
    f32x4 Sacc[4];
#pragma unroll
    for (int T = 0; T < 4; ++T) Sacc[T] = zero4;
    for (int ci = 0; ci < 36; ++ci) {
        const int nc = d == 0 ? ci : (ci < 4 ? 3 - ci : 39 - ci);
        const int base = b * TPB + nc * 64, seg_lo = b * TPB + (nc < 4 ? 0 : CTX), seg_hi = b * TPB + (nc < 4 ? CTX : TPB);
#pragma unroll
        for (int k = 0; k < 4; ++k) { const int q = tid + NTHR * k; if (q < 68 * 24) { const int rr = q / 24, pc = q - rr * 24; *(LAS u32x4*)(RAW + rr * RST + pc * 8) = praw[k]; } }
        const float a_in = pa, b_in = pb_;
        if (ci + 1 < 36) { const int c2 = ci + 1; const int nc2 = d == 0 ? c2 : (c2 < 4 ? 3 - c2 : 39 - c2);
            const int base2 = b * TPB + nc2 * 64, lo2 = b * TPB + (nc2 < 4 ? 0 : CTX), hi2 = b * TPB + (nc2 < 4 ? CTX : TPB);
#pragma unroll
            for (int k = 0; k < 4; ++k) { const int q = tid + NTHR * k; const int rr = q / 24, pc = q - rr * 24; const int r = base2 - 2 + rr;
                praw[k] = (q < 68 * 24 && r >= lo2 && r < hi2) ? *(const u32x4*)(P + (size_t)r * NP + (pc >> 3) * 256 + h * 64 + (pc & 7) * 8) : (u32x4){0u, 0u, 0u, 0u}; }
            if (wvs == 0) { const int r = base2 + (d ? 63 - lane : lane); pa = AB[(size_t)r * 16 + d * 4 + h]; pb_ = AB[(size_t)r * 16 + 8 + d * 4 + h]; } }
        __syncthreads();
        if (tid < 480) {
#pragma unroll
            for (int m = 0; m < 7; ++m) { const int pp = tg + 10 * m; if (pp < 64) { float a0 = 0.f, a1 = 0.f, a2 = 0.f, a3 = 0.f;
#pragma unroll
                for (int t = 0; t < 5; ++t) { const u32x2 raw = *(const LAS u32x2*)(RAW + (pp + t) * RST + c4 * 4);
                    a0 += bflo(raw[0]) * wc[t][0]; a1 += bfhi(raw[0]) * wc[t][1]; a2 += bflo(raw[1]) * wc[t][2]; a3 += bfhi(raw[1]) * wc[t][3]; }
                f32x4 o; o[0] = a0 / (1.f + __expf(-a0)); o[1] = a1 / (1.f + __expf(-a1)); o[2] = a2 / (1.f + __expf(-a2)); o[3] = a3 / (1.f + __expf(-a3));
                const int pq = d ? 63 - pp : pp; *(LAS f32x4*)(cdst + pq * SST) = o; } } }
        if (wvs == 0) { const float ai = a_in, bi = b_in;
            const float xs = ai + dtb; const float sp = xs > 20.f ? xs : log1pf(expf(xs)); float x = nA * sp;
#pragma unroll
            for (int o = 1; o < 64; o <<= 1) { const float y = __shfl_up(x, o); if (lane >= o) x += y; }
            GC[lane] = x; EG[lane] = __expf(x); BETA[lane] = 1.f / (1.f + expf(-bi)); if (lane == 63) { GL[0] = x; GL[1] = __expf(x); } }
        __syncthreads();
        { const int t = tid >> 3, part = tid & 7;
          const f32x4 q0 = *(const LAS f32x4*)(qs + t * SST + part * 8), q1 = *(const LAS f32x4*)(qs + t * SST + part * 8 + 4);
          const f32x4 k0 = *(const LAS f32x4*)(ks + t * SST + part * 8), k1 = *(const LAS f32x4*)(ks + t * SST + part * 8 + 4);
          float sq = (q0[0] * q0[0] + q0[1] * q0[1]) + (q0[2] * q0[2] + q0[3] * q0[3]) + (q1[0] * q1[0] + q1[1] * q1[1]) + (q1[2] * q1[2] + q1[3] * q1[3]);
          float sk = (k0[0] * k0[0] + k0[1] * k0[1]) + (k0[2] * k0[2] + k0[3] * k0[3]) + (k1[0] * k1[0] + k1[1] * k1[1]) + (k1[2] * k1[2] + k1[3] * k1[3]);
          sq = sum8(sq); sk = sum8(sk);
          const float rq = rsqrtf(sq + EPS) * 0.125f, rk = rsqrtf(sk + EPS), ekt = __expf(GL[0] - GC[t]);
          u32x4 qo, ko;
          qo[0] = pk2(q0[0] * rq, q0[1] * rq); qo[1] = pk2(q0[2] * rq, q0[3] * rq); qo[2] = pk2(q1[0] * rq, q1[1] * rq); qo[3] = pk2(q1[2] * rq, q1[3] * rq);
          ko[0] = pk2(k0[0] * rk, k0[1] * rk); ko[1] = pk2(k0[2] * rk, k0[3] * rk); ko[2] = pk2(k1[0] * rk, k1[1] * rk); ko[3] = pk2(k1[2] * rk, k1[3] * rk);
          *(LAS u32x4*)(QH + t * HST + part * 8) = qo; *(LAS u32x4*)(KH + t * HST + part * 8) = ko;
          const float rke = rk * ekt;
#pragma unroll
          for (int e = 0; e < 4; ++e) { KTT[(part * 8 + e) * HST + t] = bf1(k0[e] * rke); KTT[(part * 8 + 4 + e) * HST + t] = bf1(k1[e] * rke); } }
        __syncthreads();
        { const int I = wvs >> 1;
#pragma unroll
          for (int jj = 0; jj < 2; ++jj) { const int J = 2 * (wvs & 1) + jj; f32x4 ckk = zero4, cqk = zero4;
#pragma unroll
              for (int kk = 0; kk < 2; ++kk) { const bf16x8 Ak = *(const LAS bf16x8*)(KH + (I * 16 + fr) * HST + kk * 32 + fq * 8), Aq = *(const LAS bf16x8*)(QH + (I * 16 + fr) * HST + kk * 32 + fq * 8);
                  const bf16x8 B = *(const LAS bf16x8*)(KH + (J * 16 + fr) * HST + kk * 32 + fq * 8);
                  ckk = __builtin_amdgcn_mfma_f32_16x16x32_bf16(Ak, B, ckk, 0, 0, 0); cqk = __builtin_amdgcn_mfma_f32_16x16x32_bf16(Aq, B, cqk, 0, 0, 0); }
              const int j = J * 16 + fr; const float gj = GC[j];
#pragma unroll
              for (int r = 0; r < 4; ++r) { const int i = I * 16 + fq * 4 + r; const float dec = __expf(fminf(GC[i] - gj, 0.f));
                  const float lv = j < i ? BETA[i] * ckk[r] * dec : 0.f, sv = j <= i ? cqk[r] * dec : 0.f;
                  LM[i * HST + j] = bf1(lv); SCM[i * HST + j] = bf1(sv); if (I == J) LF[(I * 16 + fq * 4 + r) * 17 + fr] = lv; } } }
        __syncthreads();
        if (wvs == 0) { const int I = lane >> 4, c = lane & 15; float x[16];
#pragma unroll
            for (int i = 0; i < 16; ++i) { float acc = (i == c) ? 1.f : 0.f;
#pragma unroll
                for (int j = 0; j < i; ++j) acc -= LF[(I * 16 + i) * 17 + j] * x[j];
                x[i] = acc; DI[(I * 16 + i) * 24 + c] = bf1(acc); } }
        f32x4 R[4], QS[2];
        { bf16x8 Bs[2];
#pragma unroll
          for (int s2 = 0; s2 < 2; ++s2) Bs[s2] = packB(Sacc[2 * s2], Sacc[2 * s2 + 1]);
#pragma unroll
          for (int I = 0; I < 4; ++I) { f32x4 c = zero4;
#pragma unroll
              for (int s2 = 0; s2 < 2; ++s2) c = __builtin_amdgcn_mfma_f32_16x16x32_bf16(ldA_perm(KH, I * 16 + fr, s2, fq), Bs[s2], c, 0, 0, 0);
#pragma unroll
              for (int r = 0; r < 4; ++r) { const int i = I * 16 + fq * 4 + r; R[I][r] = BETA[i] * (vs[i * SST + V * 16 + fr] - EG[i] * c[r]); } }
#pragma unroll
          for (int ii = 0; ii < 2; ++ii) { const int I = 2 * half + ii; f32x4 c = zero4;
#pragma unroll
              for (int s2 = 0; s2 < 2; ++s2) c = __builtin_amdgcn_mfma_f32_16x16x32_bf16(ldA_perm(QH, I * 16 + fr, s2, fq), Bs[s2], c, 0, 0, 0);
              QS[ii] = c; } }
        __syncthreads();
        bf16x8 Bx0, Bx1;
        { bf16x8 AD[4];
#pragma unroll
          for (int I = 0; I < 4; ++I) { const u32x2 lo = *(const LAS u32x2*)(DI + (I * 16 + fr) * 24 + fq * 4); u32x4 av; av[0] = lo[0]; av[1] = lo[1]; av[2] = 0u; av[3] = 0u; AD[I] = __builtin_bit_cast(bf16x8, av); }
          const f32x4 X0 = __builtin_amdgcn_mfma_f32_16x16x32_bf16(AD[0], packB(R[0], zero4), zero4, 0, 0, 0);
          f32x4 T1 = __builtin_amdgcn_mfma_f32_16x16x32_bf16(ldA_perm(LM, 16 + fr, 0, fq), packB(X0, zero4), zero4, 0, 0, 0);
          const f32x4 X1 = __builtin_amdgcn_mfma_f32_16x16x32_bf16(AD[1], packB(R[1] - T1, zero4), zero4, 0, 0, 0);
          Bx0 = packB(X0, X1);
          f32x4 T2 = __builtin_amdgcn_mfma_f32_16x16x32_bf16(ldA_perm(LM, 32 + fr, 0, fq), Bx0, zero4, 0, 0, 0);
          const f32x4 X2 = __builtin_amdgcn_mfma_f32_16x16x32_bf16(AD[2], packB(R[2] - T2, zero4), zero4, 0, 0, 0);
          f32x4 T3 = __builtin_amdgcn_mfma_f32_16x16x32_bf16(ldA_perm(LM, 48 + fr, 0, fq), Bx0, zero4, 0, 0, 0);
          T3 = __builtin_amdgcn_mfma_f32_16x16x32_bf16(ldA_perm(LM, 48 + fr, 1, fq), packB(X2, zero4), T3, 0, 0, 0);
          const f32x4 X3 = __builtin_amdgcn_mfma_f32_16x16x32_bf16(AD[3], packB(R[3] - T3, zero4), zero4, 0, 0, 0);
          Bx1 = packB(X2, X3); }
#pragma unroll
        for (int ii = 0; ii < 2; ++ii) { const int I = 2 * half + ii; f32x4 c;
#pragma unroll
            for (int r = 0; r < 4; ++r) c[r] = EG[I * 16 + fq * 4 + r] * QS[ii][r];
            c = __builtin_amdgcn_mfma_f32_16x16x32_bf16(ldA_perm(SCM, I * 16 + fr, 0, fq), Bx0, c, 0, 0, 0);
            c = __builtin_amdgcn_mfma_f32_16x16x32_bf16(ldA_perm(SCM, I * 16 + fr, 1, fq), Bx1, c, 0, 0, 0);
#pragma unroll
            for (int r = 0; r < 4; ++r) OB[(I * 16 + fq * 4 + r) * HST + V * 16 + fr] = bf1(c[r]); }
        { const float egl = GL[1];
#pragma unroll
          for (int T = 0; T < 4; ++T) { f32x4 c = Sacc[T] * egl;
              c = __builtin_amdgcn_mfma_f32_16x16x32_bf16(ldA_perm(KTT, T * 16 + fr, 0, fq), Bx0, c, 0, 0, 0);
              c = __builtin_amdgcn_mfma_f32_16x16x32_bf16(ldA_perm(KTT, T * 16 + fr, 1, fq), Bx1, c, 0, 0, 0);
              Sacc[T] = c; } }
        __syncthreads();
#pragma unroll
        for (int it = 0; it < 4; ++it) { const int idx = tid + NTHR * it; const int i = idx >> 5, c2 = (idx & 31) * 2; const int row = base + (d ? 63 - i : i);
            *(unsigned*)(OD + (size_t)row * 512 + c2) = *(const LAS unsigned*)(OB + i * HST + c2); }
    }
    __syncthreads();
}

__device__ __forceinline__ void hg_seq(const Params& p, int l, int s, LAS unsigned char* lds, const int wvs) {
    const int tid = wvs * 64 + lane_id_fresh(); const int lane = tid & 63;
    const int b = s >> 3, h = (s >> 1) & 3, d = s & 1;
    LAS bf16_t* QT = (LAS bf16_t*)lds; LAS bf16_t* KT = QT + 64 * HST; LAS bf16_t* QP = KT + 64 * HST; LAS bf16_t* KTT = QP + 64 * HST; LAS bf16_t* VT = KTT + 64 * HST; LAS bf16_t* SC = VT + 64 * HST;
    LAS float* GS = (LAS float*)(SC + 64 * HST); LAS float* MID = GS + 512; LAS float* BLS = MID + 64; LAS float* EBL = BLS + 64; LAS bf16_t* OB = (LAS bf16_t*)(EBL + 64);
    const bf16_t* P = (const bf16_t*)(p.ws + WS_P);
    bf16_t* OD = (bf16_t*)(p.ws + WS_OD) + (size_t)d * M * 512 + 256 + h * 64;
    const int kx = tid & 63, g = tid >> 6;
    const float lb = ((const float*)(p.ws + WS_LB))[(d * DEPTH + l) * 256 + h * 64 + kx];
    const int fr = lane & 15, fq = lane >> 4;
    const int V = wvs & 3, half = wvs >> 2;
    f32x4 Sacc[4];
#pragma unroll
    for (int T = 0; T < 4; ++T) Sacc[T] = (f32x4){0.f, 0.f, 0.f, 0.f};
    unsigned short rq[8], rz[8], rv[8];
    { const int nc = d == 0 ? 0 : 3; const int base = b * TPB + nc * 64;
#pragma unroll
      for (int e = 0; e < 8; ++e) { const int t = g * 8 + e; const int pp = d ? 63 - t : t; const bf16_t* rp = P + (size_t)(base + pp) * NP + h * 64 + kx;
          rq[e] = rp[PC_HQ]; rz[e] = rp[PC_HF + d * 256]; rv[e] = rp[PC_HI]; } }
    for (int ci = 0; ci < 36; ++ci) {
        const int nc = d == 0 ? ci : (ci < 4 ? 3 - ci : 39 - ci);
        const int base = b * TPB + nc * 64;
        float qv[8], kv[8], bc[8]; float run = 0.f;
#pragma unroll
        for (int e = 0; e < 8; ++e) { const float z = bflo(rz[e]); const float sg = 1.f / (1.f + __expf(-z)); const float f = lb + (1.f - lb) * sg;
            run += __logf(f); bc[e] = run; kv[e] = (1.f - lb) * (1.f - sg); qv[e] = bflo(rq[e]); }
        GS[g * 64 + kx] = run;
#pragma unroll
        for (int e = 0; e < 8; ++e) VT[kx * HST + g * 8 + e] = rv[e];
        __syncthreads();
        { float off = 0.f;
#pragma unroll
          for (int gg = 0; gg < 7; ++gg) { const float x = GS[gg * 64 + kx]; off += (gg < g) ? x : 0.f; }
#pragma unroll
          for (int e = 0; e < 8; ++e) bc[e] += off; }
        if (g == 3) MID[kx] = bc[7];
        if (g == 7) { BLS[kx] = bc[7]; EBL[kx] = __expf(bc[7]); }
        if (ci + 1 < 36) { const int c2 = ci + 1; const int nc2 = d == 0 ? c2 : (c2 < 4 ? 3 - c2 : 39 - c2); const int base2 = b * TPB + nc2 * 64;
#pragma unroll
            for (int e = 0; e < 8; ++e) { const int t = g * 8 + e; const int pp = d ? 63 - t : t; const bf16_t* rp = P + (size_t)(base2 + pp) * NP + h * 64 + kx;
                rq[e] = rp[PC_HQ]; rz[e] = rp[PC_HF + d * 256]; rv[e] = rp[PC_HI]; } }
        __syncthreads();
        { const float mid = MID[kx], bl = BLS[kx];
#pragma unroll
          for (int e = 0; e < 8; ++e) { const int t = g * 8 + e; const float E = fminf(fmaxf(bc[e] - mid, -80.f), 80.f);
              const float eq = __expf(E), ek = __expf(-E);
              QT[t * HST + kx] = bf1(qv[e] * eq); KT[t * HST + kx] = bf1(kv[e] * ek);
              QP[t * HST + kx] = bf1(qv[e] * __expf(bc[e])); KTT[kx * HST + t] = bf1(kv[e] * __expf(bl - bc[e])); } }
        __syncthreads();
        { const int I = wvs >> 1;
#pragma unroll
          for (int jj = 0; jj < 2; ++jj) { const int J = 2 * (wvs & 1) + jj; f32x4 c = (f32x4){0.f, 0.f, 0.f, 0.f};
#pragma unroll
              for (int kk = 0; kk < 2; ++kk) { const bf16x8 A = *(const LAS bf16x8*)(QT + (I * 16 + fr) * HST + kk * 32 + fq * 8); const bf16x8 B = *(const LAS bf16x8*)(KT + (J * 16 + fr) * HST + kk * 32 + fq * 8);
                  c = __builtin_amdgcn_mfma_f32_16x16x32_bf16(A, B, c, 0, 0, 0); }
#pragma unroll
              for (int r = 0; r < 4; ++r) { const int i = I * 16 + fq * 4 + r, j = J * 16 + fr; SC[i * HST + j] = bf1(j <= i ? c[r] : 0.f); } } }
        __syncthreads();
        { bf16x8 Bs[2];
#pragma unroll
          for (int s2 = 0; s2 < 2; ++s2) { u32x4 pb; pb[0] = bf1(Sacc[2 * s2][0]) | ((unsigned)bf1(Sacc[2 * s2][1]) << 16); pb[1] = bf1(Sacc[2 * s2][2]) | ((unsigned)bf1(Sacc[2 * s2][3]) << 16); pb[2] = bf1(Sacc[2 * s2 + 1][0]) | ((unsigned)bf1(Sacc[2 * s2 + 1][1]) << 16); pb[3] = bf1(Sacc[2 * s2 + 1][2]) | ((unsigned)bf1(Sacc[2 * s2 + 1][3]) << 16); Bs[s2] = __builtin_bit_cast(bf16x8, pb); }
          bf16x8 Bv[2];
#pragma unroll
          for (int s2 = 0; s2 < 2; ++s2) Bv[s2] = *(const LAS bf16x8*)(VT + (V * 16 + fr) * HST + s2 * 32 + fq * 8);
#pragma unroll
          for (int ii = 0; ii < 2; ++ii) { const int I = 2 * half + ii; f32x4 o = (f32x4){0.f, 0.f, 0.f, 0.f};
#pragma unroll
              for (int s2 = 0; s2 < 2; ++s2) { const LAS bf16_t* ap = QP + (I * 16 + fr) * HST + s2 * 32 + fq * 4; const u32x2 lo = *(const LAS u32x2*)ap, hi = *(const LAS u32x2*)(ap + 16);
                  u32x4 av; av[0] = lo[0]; av[1] = lo[1]; av[2] = hi[0]; av[3] = hi[1];
                  o = __builtin_amdgcn_mfma_f32_16x16x32_bf16(__builtin_bit_cast(bf16x8, av), Bs[s2], o, 0, 0, 0); }
#pragma unroll
              for (int s2 = 0; s2 < 2; ++s2) { const bf16x8 A = *(const LAS bf16x8*)(SC + (I * 16 + fr) * HST + s2 * 32 + fq * 8); o = __builtin_amdgcn_mfma_f32_16x16x32_bf16(A, Bv[s2], o, 0, 0, 0); }
#pragma unroll
              for (int r = 0; r < 4; ++r) { const int i = I * 16 + fq * 4 + r; OB[i * HST + V * 16 + fr] = bf1(o[r]); } }
#pragma unroll
          for (int T = 0; T < 4; ++T) { f32x4 c;
#pragma unroll
              for (int r = 0; r < 4; ++r) c[r] = Sacc[T][r] * EBL[T * 16 + fq * 4 + r];
#pragma unroll
              for (int s2 = 0; s2 < 2; ++s2) { const bf16x8 A = *(const LAS bf16x8*)(KTT + (T * 16 + fr) * HST + s2 * 32 + fq * 8); c = __builtin_amdgcn_mfma_f32_16x16x32_bf16(A, Bv[s2], c, 0, 0, 0); }
              Sacc[T] = c; } }
        __syncthreads();
#pragma unroll
        for (int it = 0; it < 4; ++it) { const int idx = tid + NTHR * it; const int i = idx >> 5, c2 = (idx & 31) * 2; const int row = base + (d ? 63 - i : i);
            *(unsigned*)(OD + (size_t)row * 512 + c2) = *(const LAS unsigned*)(OB + i * HST + c2); }
    }
}

constexpr int KST = 72, VST = 136;
__device__ __forceinline__ void swa_unit(const Params& p, int l, int unit, LAS unsigned char* lds, const int wvs) {
    const int tid = wvs * 64 + lane_id_fresh(); const int lane = tid & 63, w = tid >> 6;
    const int b = unit / 36, rem = unit - b * 36, kvh = rem / 18, qb = rem - kvh * 18;
    const bool qctx = qb < 2;
    const bf16_t* P = (const bf16_t*)(p.ws + WS_P);
    const float* rc = (const float*)(p.ws + WS_ROPE); const float* rs = rc + 2048 * 32;
    bf16_t* Y = (bf16_t*)(p.ws + WS_HY);
    LAS bf16_t* Ks = (LAS bf16_t*)lds; LAS bf16_t* Vt = Ks + 128 * KST;
    const int hh = w >> 1, qhalf = w & 1, head = kvh * 4 + hh;
    const int fr = lane & 15, fq = lane >> 4;
    const int rowq0 = b * TPB + qb * 128 + qhalf * 64;
    bf16x8 qf[4][2];
#pragma unroll
    for (int qt = 0; qt < 4; ++qt) {
        const int row = rowq0 + qt * 16 + fr; const bf16_t* qp = P + (size_t)row * NP + PC_SQ + head * 64 + fq * 8;
        const u32x4 r1 = *(const u32x4*)qp, r2 = *(const u32x4*)(qp + 32);
        float a1[8], a2[8];
#pragma unroll
        for (int e = 0; e < 4; ++e) { a1[2 * e] = bflo(r1[e]); a1[2 * e + 1] = bfhi(r1[e]); a2[2 * e] = bflo(r2[e]); a2[2 * e + 1] = bfhi(r2[e]); }
        if (!qctx) { const int t = (qb - 2) * 128 + qhalf * 64 + qt * 16 + fr; const float* cp = rc + t * 32 + fq * 8; const float* sp = rs + t * 32 + fq * 8;
#pragma unroll
            for (int e = 0; e < 8; ++e) { const float cs = cp[e], sn = sp[e]; const float o1 = a1[e] * cs - a2[e] * sn, o2 = a1[e] * sn + a2[e] * cs; a1[e] = o1; a2[e] = o2; } }
        u32x4 o1, o2;
#pragma unroll
        for (int e = 0; e < 4; ++e) { o1[e] = pk2(a1[2 * e] * 0.125f, a1[2 * e + 1] * 0.125f); o2[e] = pk2(a2[2 * e] * 0.125f, a2[2 * e + 1] * 0.125f); }
        qf[qt][0] = __builtin_bit_cast(bf16x8, o1); qf[qt][1] = __builtin_bit_cast(bf16x8, o2);
    }
    const float sink = p.swa_sink[l * 8 + head];
    float mrun[4], lrun[4]; f32x4 O[4][4];
#pragma unroll
    for (int qt = 0; qt < 4; ++qt) { mrun[qt] = sink; lrun[qt] = 1.f;
#pragma unroll
        for (int dv = 0; dv < 4; ++dv) O[qt][dv] = (f32x4){0.f, 0.f, 0.f, 0.f}; }
    for (int ki = 0; ki < 5; ++ki) {
        int blk, rel; bool valid, local;
        if (qctx) { blk = ki; valid = ki < 2; local = false; rel = 0; }
        else if (ki < 3) { blk = qb - 1 + ki; valid = blk >= 2 && blk <= 17; local = true; rel = ki - 1; }
        else { blk = ki - 3; valid = true; local = false; rel = 0; }
        if (!valid) continue;
        const int rowk0 = b * TPB + blk * 128;
        {
            const int key = tid >> 2, g = tid & 3; const bf16_t* kp = P + (size_t)(rowk0 + key) * NP + PC_SK + kvh * 64 + g * 8;
            const u32x4 r1 = *(const u32x4*)kp, r2 = *(const u32x4*)(kp + 32);
            u32x4 o1 = r1, o2 = r2;
            if (local) { float a1[8], a2[8];
#pragma unroll
                for (int e = 0; e < 4; ++e) { a1[2 * e] = bflo(r1[e]); a1[2 * e + 1] = bfhi(r1[e]); a2[2 * e] = bflo(r2[e]); a2[2 * e + 1] = bfhi(r2[e]); }
                const int t = (blk - 2) * 128 + key; const float* cp = rc + t * 32 + g * 8; const float* sp = rs + t * 32 + g * 8;
#pragma unroll
                for (int e = 0; e < 8; ++e) { const float cs = cp[e], sn = sp[e]; const float x1 = a1[e] * cs - a2[e] * sn, x2 = a1[e] * sn + a2[e] * cs; a1[e] = x1; a2[e] = x2; }
#pragma unroll
                for (int e = 0; e < 4; ++e) { o1[e] = pk2(a1[2 * e], a1[2 * e + 1]); o2[e] = pk2(a2[2 * e], a2[2 * e + 1]); } }
            *(LAS u32x4*)(Ks + key * KST + g * 8) = o1; *(LAS u32x4*)(Ks + key * KST + 32 + g * 8) = o2;
#pragma unroll
            for (int it = 0; it < 2; ++it) { const int idx = tid + NTHR * it; const int vk = idx >> 3, vg = idx & 7;
                const u32x4 rv = *(const u32x4*)(P + (size_t)(rowk0 + vk) * NP + PC_SV + kvh * 64 + vg * 8);
#pragma unroll
                for (int e = 0; e < 4; ++e) { Vt[(vg * 8 + 2 * e) * VST + vk] = (bf16_t)(rv[e] & 0xffffu); Vt[(vg * 8 + 2 * e + 1) * VST + vk] = (bf16_t)(rv[e] >> 16); } }
        }
        __syncthreads();
#pragma unroll
        for (int qt = 0; qt < 4; ++qt) {
            f32x4 Sx[8];
#pragma unroll
            for (int kt = 0; kt < 8; ++kt) { Sx[kt] = (f32x4){0.f, 0.f, 0.f, 0.f};
#pragma unroll
                for (int kk = 0; kk < 2; ++kk) { const bf16x8 A = *(const LAS bf16x8*)(Ks + (kt * 16 + fr) * KST + kk * 32 + fq * 8);
                    Sx[kt] = __builtin_amdgcn_mfma_f32_16x16x32_bf16(A, qf[qt][kk], Sx[kt], 0, 0, 0); } }
            if (rel != 0) { int qi = qhalf * 64 + qt * 16 + fr; asm volatile("" : "+v"(qi));
#pragma unroll
                for (int kt = 0; kt < 8; ++kt)
#pragma unroll
                    for (int j = 0; j < 4; ++j) { const int kx = kt * 16 + fq * 4 + j; const bool ok = rel < 0 ? (kx >= qi) : (kx <= qi); if (!ok) Sx[kt][j] = -1e30f; } }
            float mx = -1e30f;
#pragma unroll
            for (int kt = 0; kt < 8; ++kt) mx = fmaxf(mx, fmaxf(fmaxf(Sx[kt][0], Sx[kt][1]), fmaxf(Sx[kt][2], Sx[kt][3])));
            mx = xrow16_max(mx);
            const float mnew = fmaxf(mrun[qt], mx); const float alpha = __expf(mrun[qt] - mnew); mrun[qt] = mnew;
            float rsum = 0.f;
#pragma unroll
            for (int kt = 0; kt < 8; ++kt)
#pragma unroll
                for (int j = 0; j < 4; ++j) { const float e = __expf(Sx[kt][j] - mnew); Sx[kt][j] = e; rsum += e; }
            rsum = xrow16_sum(rsum);
            lrun[qt] = lrun[qt] * alpha + rsum;
#pragma unroll
            for (int dv = 0; dv < 4; ++dv) O[qt][dv] = O[qt][dv] * alpha;
#pragma unroll
            for (int ks2 = 0; ks2 < 4; ++ks2) {
                u32x4 pb; pb[0] = pk2(Sx[2 * ks2][0], Sx[2 * ks2][1]); pb[1] = pk2(Sx[2 * ks2][2], Sx[2 * ks2][3]); pb[2] = pk2(Sx[2 * ks2 + 1][0], Sx[2 * ks2 + 1][1]); pb[3] = pk2(Sx[2 * ks2 + 1][2], Sx[2 * ks2 + 1][3]);
                const bf16x8 Bp = __builtin_bit_cast(bf16x8, pb);
#pragma unroll
                for (int dv = 0; dv < 4; ++dv) { const LAS bf16_t* vp = Vt + (dv * 16 + fr) * VST + ks2 * 32 + fq * 4;
                    const u32x2 lo = *(const LAS u32x2*)vp, hi = *(const LAS u32x2*)(vp + 16);
                    u32x4 av; av[0] = lo[0]; av[1] = lo[1]; av[2] = hi[0]; av[3] = hi[1];
                    O[qt][dv] = __builtin_amdgcn_mfma_f32_16x16x32_bf16(__builtin_bit_cast(bf16x8, av), Bp, O[qt][dv], 0, 0, 0); }
            }
        }
        __syncthreads();
    }
#pragma unroll
    for (int qt = 0; qt < 4; ++qt) { const float inv = 1.f / lrun[qt]; const int row = rowq0 + qt * 16 + fr;
#pragma unroll
        for (int dv = 0; dv < 4; ++dv) { u32x2 o2; o2[0] = pk2(O[qt][dv][0] * inv, O[qt][dv][1] * inv); o2[1] = pk2(O[qt][dv][2] * inv, O[qt][dv][3] * inv);
            *(u32x2*)(Y + (size_t)row * D + 256 + head * 64 + dv * 16 + fq * 4) = o2; } }
}

__device__ __forceinline__ void phase_mixers(const Params& p, int l, LAS unsigned char* lds, const int wvs) {
    for (int s = blockIdx.x; s < 256; s += gridDim.x) { if (s < 128) dn_seq(p, l, s, lds, wvs); else hg_seq(p, l, s - 128, lds, wvs); }
    unsigned* ctr = (unsigned*)(p.ws + WS_CTL) + 64 * (1 + l);
    LAS int* su = (LAS int*)(lds + 140 * 1024);
    for (;;) {
        __syncthreads();
        if (wvs == 0 && lane_id_fresh() == 0) su[0] = (int)atomicAdd(ctr, 1u);
        __syncthreads();
        const int unit = su[0];
        if (unit >= 576) break;
        swa_unit(p, l, unit, lds, wvs);
    }
}

__device__ __forceinline__ void phase_finalize(const Params& p, int l, const int wvs) {
    const int tid = wvs * 64 + lane_id_fresh(); const int lane = tid & 63, w = tid >> 6;
    const int gw = blockIdx.x * NWAVES + w, NGW = gridDim.x * NWAVES;
    const bf16_t* P = (const bf16_t*)(p.ws + WS_P);
    const bf16_t* OD0 = (const bf16_t*)(p.ws + WS_OD); const bf16_t* OD1 = OD0 + (size_t)M * 512;
    bf16_t* Y = (bf16_t*)(p.ws + WS_HY);
    const int seg = lane >> 3, d0 = (lane & 7) * 8;
    const int hd = seg & 3; const bool isdn = seg < 4;
    const float* gain = (isdn ? p.dn_norm : p.hg_norm) + l * 64 + d0;
    const f32x4 g0 = *(const f32x4*)gain, g1 = *(const f32x4*)(gain + 4);
    const int ocol = (isdn ? 0 : 256) + hd * 64 + d0, gcol = (isdn ? PC_DNG : PC_HG) + hd * 64 + d0, ycol = (isdn ? 0 : 768) + hd * 64 + d0;
    for (int r = gw; r < M; r += NGW) {
        const u32x4 a = *(const u32x4*)(OD0 + (size_t)r * 512 + ocol), bq = *(const u32x4*)(OD1 + (size_t)r * 512 + ocol), gt = *(const u32x4*)(P + (size_t)r * NP + gcol);
        float o[8]; float ss = 0.f;
#pragma unroll
        for (int e = 0; e < 4; ++e) { o[2 * e] = bflo(a[e]) + bflo(bq[e]); o[2 * e + 1] = bfhi(a[e]) + bfhi(bq[e]); ss += o[2 * e] * o[2 * e] + o[2 * e + 1] * o[2 * e + 1]; }
        ss = sum8(ss);
        const float rms = rsqrtf(ss * (1.f / 64.f) + EPS);
        u32x4 y;
#pragma unroll
        for (int e = 0; e < 4; ++e) { const float ga = bflo(gt[e]), gb = bfhi(gt[e]);
            const float ge0 = e < 2 ? g0[2 * e] : g1[2 * e - 4], ge1 = e < 2 ? g0[2 * e + 1] : g1[2 * e - 3];
            y[e] = pk2(o[2 * e] * rms * ge0 * siluf(ga), o[2 * e + 1] * rms * ge1 * siluf(gb)); }
        *(u32x4*)(Y + (size_t)r * D + ycol) = y;
    }
}

__device__ __forceinline__ void phase_final(const Params& p, const int wvs) {
    const int tid = wvs * 64 + lane_id_fresh(); const int lane = tid & 63, w = tid >> 6;
    const int gw = blockIdx.x * NWAVES + w, NGW = gridDim.x * NWAVES;
    for (int r = gw; r < BATCH * SEQ; r += NGW) {
        f32x4* xr = (f32x4*)(p.out + ((size_t)r << 10)) + lane;
        f32x4 v[4]; float ss = 0.f;
#pragma unroll
        for (int j = 0; j < 4; ++j) { v[j] = xr[64 * j]; ss += (v[j][0] * v[j][0] + v[j][1] * v[j][1]) + (v[j][2] * v[j][2] + v[j][3] * v[j][3]); }
        const float rstd = rsqrtf(wave_sum(ss) * (1.f / D) + EPS);
#pragma unroll
        for (int j = 0; j < 4; ++j) { const f32x4 g = *(const f32x4*)(p.norm_f + 4 * (lane + 64 * j)); xr[64 * j] = v[j] * rstd * g; }
    }
}

__device__ __forceinline__ void gsync(cg::grid_group& grid) {
    asm volatile("s_waitcnt vmcnt(0) lgkmcnt(0)" ::: "memory");
    grid.sync();
    __builtin_amdgcn_fence(__ATOMIC_ACQUIRE, "agent");
    asm volatile("s_waitcnt vmcnt(0)" ::: "memory");
}
__global__ void __launch_bounds__(NTHR, 2) fwd_megakernel(Params p) {
    extern __shared__ __attribute__((aligned(16))) unsigned char lds_raw[];
    LAS unsigned char* lds = (LAS unsigned char*)lds_raw;
    cg::grid_group grid = cg::this_grid();
    const int G = gridDim.x, c = blockIdx.x;
    const int wvs = __builtin_amdgcn_readfirstlane((int)(threadIdx.x >> 6));
    phase_prologue(p, lds, wvs);
    gsync(grid);
    const float* mods = (const float*)(p.ws + WS_MODS);
    float* Xc = (float*)(p.ws + WS_XC);
    bf16_t* HY = (bf16_t*)(p.ws + WS_HY); bf16_t* PB = (bf16_t*)(p.ws + WS_P);
    for (int l = 0; l < DEPTH; ++l) {
        phase_norm<true>(p, l, lds, wvs);
        gsync(grid);
        { pg8::Gemm g{HY, (const bf16_t*)(p.ws + WS_WIN), M, NP, D}; pg8::StaticOrder S; S.init(M, NP, G, c); pg8::EpiBf16<0> E{PB, NP};
          pg8::gemm_phase<pg8::EpiBf16<0>, pg8::StaticOrder, true, true>(lds, g, S, E, wvs); }
        gsync(grid);
        phase_mixers(p, l, lds, wvs);
        gsync(grid);
        phase_finalize(p, l, wvs);
        gsync(grid);
        { pg8::Gemm g{HY, (const bf16_t*)(p.ws + WS_WOUT), M, D, D}; pg8::StaticOrder S; S.init(M, D, G, c); pg8::EpiRes E{p.out, Xc, mods + ((size_t)l * 17 * 6 + 2) * 1024};
          pg8::gemm_phase<pg8::EpiRes, pg8::StaticOrder, true, true>(lds, g, S, E, wvs); }
        gsync(grid);
        phase_norm<false>(p, l, lds, wvs);
        gsync(grid);
        { pg8::Gemm g{HY, (const bf16_t*)(p.ws + WS_W1), M, DFF, D}; pg8::StaticOrder S; S.init(M, DFF, G, c); pg8::EpiBf16<1> E{PB, DFF};
          pg8::gemm_phase<pg8::EpiBf16<1>, pg8::StaticOrder, true, true>(lds, g, S, E, wvs); }
        gsync(grid);
        { pg8::Gemm g{PB, (const bf16_t*)(p.ws + WS_W2), M, D, DFF}; pg8::StaticOrder S; S.init(M, D, G, c); pg8::EpiRes E{p.out, Xc, mods + ((size_t)l * 17 * 6 + 5) * 1024};
          pg8::gemm_phase<pg8::EpiRes, pg8::StaticOrder, true, true>(lds, g, S, E, wvs); }
        gsync(grid);
    }
    phase_final(p, wvs);
}

extern "C" void kernel_launch(void* const* d_in, const int* in_sizes, int n_in, void* d_out, int out_size, void* d_ws, size_t ws_size, hipStream_t stream) {
    static int grid = 0;
    if (grid == 0) {
        if (n_in != 20 || ws_size < WS_END) { fprintf(stderr, "kernel_launch: need 20 inputs and >= %zu bytes of workspace (got %d, %zu)\n", (size_t)WS_END, n_in, ws_size); grid = -1; return; }
        int dev = 0, cus = 0, per_cu = 0;
        hipGetDevice(&dev); hipDeviceGetAttribute(&cus, hipDeviceAttributeMultiprocessorCount, dev);
        if (hipFuncSetAttribute((const void*)fwd_megakernel, hipFuncAttributeMaxDynamicSharedMemorySize, LDS_BYTES) != hipSuccess) { fprintf(stderr, "kernel_launch: hipFuncSetAttribute failed\n"); grid = -1; return; }
        if (hipOccupancyMaxActiveBlocksPerMultiprocessor(&per_cu, (const void*)fwd_megakernel, NTHR, LDS_BYTES) != hipSuccess || per_cu < 1) { fprintf(stderr, "kernel_launch: occupancy query says %d blocks/CU\n", per_cu); per_cu = 1; }
        (void)hipGetLastError();
        grid = cus;
    }
    if (grid < 0) return;
    hipMemsetAsync((char*)d_ws + WS_CTL, 0, 4096, stream);
    Params p{};
    const float** pp = (const float**)&p;
    for (int i = 0; i < 20; ++i) pp[i] = (const float*)d_in[i];
    p.out = (float*)d_out; p.ws = (unsigned char*)d_ws;
    void* args[] = {&p};
    hipError_t e = hipLaunchCooperativeKernel((const void*)fwd_megakernel, dim3(grid), dim3(NTHR), args, LDS_BYTES, stream);
    if (e != hipSuccess) fprintf(stderr, "cooperative launch failed: %s (grid %d)\n", hipGetErrorString(e), grid);
}
```

```cpp
#include <hip/hip_runtime.h>
#include <hip/hip_cooperative_groups.h>
#include <cstdio>
#include <cstdint>
namespace cg = cooperative_groups;

__device__ __forceinline__ int lane_id_fresh() { unsigned m = ~0u; asm volatile("" : "+s"(m)); return (int)__builtin_amdgcn_mbcnt_hi(m, __builtin_amdgcn_mbcnt_lo(m, 0u)); }
namespace pg8 {
#define PG8_LAS __attribute__((address_space(3)))
typedef unsigned short bf16_t;
typedef short bf16x8 __attribute__((ext_vector_type(8)));
typedef float f32x4 __attribute__((ext_vector_type(4)));
typedef unsigned u32x4 __attribute__((ext_vector_type(4)));
constexpr int BM = 256, BK = 64, HALF = 128, HTB = HALF * BK * 2  , STAGE_BYTES = 8 * HTB, NXCD = 8, WGM = 8;

__host__ __device__ __forceinline__ int lds_byte(int r, int c) { const int st = (r >> 4) * 2 + (c >> 5), rr = r & 15, cc = c & 31, ob = rr * 64 + cc * 2; return st * 1024 + (ob ^ (((ob >> 9) & 1) << 5)); }
__host__ __device__ __forceinline__ void stage_rc(int b, int& R, int& C) { const int st = b / 1024, sb = b % 1024, swz = sb ^ (((sb >> 9) & 1) << 5); R = (st >> 1) * 16 + swz / 64; C = (st & 1) * 32 + (swz % 64) / 2; }
__host__ __device__ __forceinline__ int perm32(int rho) { const int n = rho >> 4, i = rho & 15; return 8 * (i >> 2) + 4 * n + (i & 3); }

struct Unit { int pm, pn; };
struct Gemm { const bf16_t* A; const bf16_t* Bt; int M, N, K; };

struct StaticOrder {
    int nM, nN, nwg, G, c;
    __host__ __device__ void init(int M, int N, int G_, int c_) { nM = M / BM; nN = N / BM; nwg = nM * nN; G = G_; c = c_; }
    __host__ __device__ bool next(int i, Unit& u) const {
        const long L = (long)i * G + c; if (L >= nwg) return false;
        int wgid = (int)L; { const int q = nwg / NXCD, r = nwg % NXCD, xcd = wgid % NXCD, off = wgid / NXCD; wgid = (xcd < r ? xcd * (q + 1) : r * (q + 1) + (xcd - r) * q) + off; }
        const int nig = WGM * nN, gid = wgid / nig, fm = gid * WGM, gsz = (nM - fm) < WGM ? (nM - fm) : WGM;
        u.pm = fm + ((wgid % nig) % gsz); u.pn = (wgid % nig) / gsz; return true;
    }
    __device__ __forceinline__ void a_ready(const Unit&) const {}
    __device__ __forceinline__ void done(const Unit&) const {}
};

__device__ __forceinline__ unsigned cvt_pk_bf16(float lo, float hi) { unsigned r; asm volatile("v_cvt_pk_bf16_f32 %0, %1, %2" : "=v"(r) : "v"(lo), "v"(hi)); return r; }

template <int ACT  > struct EpiBf16 {
    static constexpr bool PERM = true, AFTER_DRAIN = false;
    bf16_t* O; int ldc;
    __device__ __forceinline__ void operator()(const f32x4 (&acc)[2][2][4][2], const Unit& u, int wr, int wc, int fr, int fq) const {
        const int row0 = u.pm * BM + wr * 64 + fr; const int col0 = u.pn * BM + wc * 32 + 8 * fq;
#pragma unroll
        for (int ai = 0; ai < 2; ++ai)
#pragma unroll
            for (int m = 0; m < 4; ++m) { bf16_t* rowp = O + (size_t)(row0 + ai * HALF + m * 16) * ldc + col0;
#pragma unroll
                for (int bj = 0; bj < 2; ++bj) { f32x4 v0 = acc[ai][bj][m][0], v1 = acc[ai][bj][m][1];
                    if (ACT == 1) {
#pragma unroll
                        for (int e = 0; e < 4; ++e) { float a = fmaxf(v0[e], 0.f), b = fmaxf(v1[e], 0.f); v0[e] = a * a; v1[e] = b * b; } }
                    u32x4 w; w.x = cvt_pk_bf16(v0[0], v0[1]); w.y = cvt_pk_bf16(v0[2], v0[3]); w.z = cvt_pk_bf16(v1[0], v1[1]); w.w = cvt_pk_bf16(v1[2], v1[3]);
                    *(u32x4*)(rowp + bj * HALF) = w; } }
    }
};
struct EpiRes {
    static constexpr bool PERM = false, AFTER_DRAIN = false;
    float* Xl; float* Xc; const float* gates;
    __device__ __forceinline__ void operator()(const f32x4 (&acc)[2][2][4][2], const Unit& u, int wr, int wc, int fr, int fq) const {
        const int b = u.pm / 9, tt = u.pm - b * 9;
        float* base = (tt == 0) ? Xc + ((size_t)(b * 256) << 10) : Xl + ((size_t)(b * 2048 + (tt - 1) * 256) << 10);
        const float* g = gates + (size_t)((tt == 0) ? 16 : b) * 6144;
        const int col0 = u.pn * BM + wc * 32 + 4 * fq;
        float* rp0 = base + ((size_t)(wr * 64 + fr) << 10) + col0;
#pragma unroll
        for (int bj = 0; bj < 2; ++bj)
#pragma unroll
            for (int n = 0; n < 2; ++n) { const f32x4 gvv = *(const f32x4*)(g + col0 + bj * HALF + n * 16);
#pragma unroll
                for (int ai = 0; ai < 2; ++ai) {
#pragma unroll
                    for (int m = 0; m < 4; ++m) { f32x4* pp = (f32x4*)(rp0 + (size_t)(ai * HALF + m * 16) * 1024 + bj * HALF + n * 16); f32x4 xv = *pp; xv = xv + gvv * acc[ai][bj][m][n]; *pp = xv; }
                    asm volatile("" ::: "memory"); } }
    }
};
template <class Epi, class Sched, bool ALIGN_EPI = false, bool SP2 = false>
__device__ __forceinline__ void gemm_phase(PG8_LAS unsigned char* lds, const Gemm g, const Sched& S, const Epi& E, const int wvs) {
    const int tid = wvs * 64 + lane_id_fresh(); const int wid = __builtin_amdgcn_readfirstlane(tid >> 6), lane = tid & 63, wr = wid >> 2, wc = wid & 3, fr = lane & 15, fq = lane >> 4;
    const int K = g.K, nt = K / BK;
    unsigned voffA[2], voffB[2];
#pragma unroll
    for (int i = 0; i < 2; ++i) { int R, C; stage_rc(tid * 16 + i * 8192, R, C); const int Rb = Epi::PERM ? ((R & ~31) + perm32(R & 31)) : R;
        voffA[i] = (unsigned)(R * K + C) * 2u; voffB[i] = (unsigned)(Rb * K + C) * 2u; }
    const size_t kstep = (size_t)(BK * 2);
    const size_t hstep = (size_t)HALF * K * 2;
    const size_t tstep = 2 * hstep;
    const unsigned ldsw = (unsigned)wid * 1024u;
    const int aoff = lds_byte(wr * 64 + fr, fq * 8), boff = lds_byte(wc * 32 + fr, fq * 8);
#define PG8_SA(b, h) (((b) * 2 + (h)) * HTB)
#define PG8_SB(b, h) ((4 + (b) * 2 + (h)) * HTB)
#define PG8_STAGE(bufoff, gbase, voff) do { _Pragma("unroll") for (int _i = 0; _i < 2; ++_i) \
        __builtin_amdgcn_global_load_lds((const unsigned*)((const char*)(gbase) + (voff)[_i]), (PG8_LAS unsigned*)(lds + (bufoff) + ldsw + _i * 8192), 16, 0, 0); } while (0)
#define PG8_LDA(dst, b, h) do { _Pragma("unroll") for (int m = 0; m < 4; ++m) _Pragma("unroll") for (int k = 0; k < 2; ++k) dst[m][k] = *(const PG8_LAS bf16x8*)(lds + PG8_SA(b, h) + aoff + m * 2048 + k * 1024); } while (0)
#define PG8_LDB(dst, b, h) do { _Pragma("unroll") for (int n = 0; n < 2; ++n) _Pragma("unroll") for (int k = 0; k < 2; ++k) dst[n][k] = *(const PG8_LAS bf16x8*)(lds + PG8_SB(b, h) + boff + n * 2048 + k * 1024); } while (0)
#define PG8_MMA(ai, bj, At, Bt) do { __builtin_amdgcn_s_setprio(1); _Pragma("unroll") for (int m = 0; m < 4; ++m) _Pragma("unroll") for (int n = 0; n < 2; ++n) _Pragma("unroll") for (int k = 0; k < 2; ++k) \
        acc[ai][bj][m][n] = __builtin_amdgcn_mfma_f32_16x16x32_bf16(Bt[n][k], At[m][k], acc[ai][bj][m][n], 0, 0, 0); __builtin_amdgcn_s_setprio(0); } while (0)
#define PG8_WAIT_V(n) asm volatile("s_waitcnt vmcnt(" #n ")" ::: "memory")
#define PG8_WAIT_L(n) asm volatile("s_waitcnt lgkmcnt(" #n ")" ::: "memory")
#define PG8_BAR __builtin_amdgcn_s_barrier()
#define PG8_SCHED __builtin_amdgcn_sched_barrier(0)
    Unit cur, nxt; int ui = 0;
    if (!S.next(0, cur)) return;
    f32x4 acc[2][2][4][2];
#pragma unroll
    for (int a = 0; a < 2; ++a)
#pragma unroll
        for (int b = 0; b < 2; ++b)
#pragma unroll
            for (int m = 0; m < 4; ++m)
#pragma unroll
                for (int n = 0; n < 2; ++n) acc[a][b][m][n] = (f32x4){0.f, 0.f, 0.f, 0.f};
    bf16x8 At[4][2], B0[2][2], B1[2][2];
    const char* cA = (const char*)g.A + (size_t)cur.pm * tstep; const char* cB = (const char*)g.Bt + (size_t)cur.pn * tstep;
    S.a_ready(cur);
    if constexpr (SP2) {
        PG8_STAGE(PG8_SB(0, 0), cB, voffB); PG8_STAGE(PG8_SB(0, 1), cB + hstep, voffB); PG8_STAGE(PG8_SA(0, 0), cA, voffA); PG8_STAGE(PG8_SA(0, 1), cA + hstep, voffA);
        if (wr == 1) PG8_BAR;
        PG8_WAIT_V(2); PG8_BAR;
        PG8_STAGE(PG8_SB(1, 0), cB + kstep, voffB); PG8_STAGE(PG8_SA(1, 0), cA + kstep, voffA); PG8_STAGE(PG8_SB(1, 1), cB + hstep + kstep, voffB);
        PG8_WAIT_V(6); PG8_BAR;
    } else {
        PG8_STAGE(PG8_SB(0, 0), cB, voffB); PG8_STAGE(PG8_SA(0, 0), cA, voffA); PG8_STAGE(PG8_SB(0, 1), cB + hstep, voffB); PG8_STAGE(PG8_SA(0, 1), cA + hstep, voffA);
        if (wr == 1) PG8_BAR;
        PG8_WAIT_V(4); PG8_BAR;
        PG8_STAGE(PG8_SB(1, 0), cB + kstep, voffB); PG8_STAGE(PG8_SA(1, 0), cA + kstep, voffA); PG8_STAGE(PG8_SB(1, 1), cB + hstep + kstep, voffB);
        PG8_WAIT_V(6); PG8_BAR;
    }
    for (;;) {
        const bool has_next = S.next(ui + 1, nxt);
        const char* nA = has_next ? (const char*)g.A + (size_t)nxt.pm * tstep : cA; const char* nB = has_next ? (const char*)g.Bt + (size_t)nxt.pn * tstep : cB;
        for (int t = 0; t < nt; t += 2) {
            const bool last = (t == nt - 2);
            const char* a1 = cA + (size_t)(t + 1) * kstep;
            const char* a2 = last ? nA : cA + (size_t)(t + 2) * kstep; const char* b2 = last ? nB : cB + (size_t)(t + 2) * kstep;
            const char* a3 = a2 + kstep; const char* b3 = b2 + kstep;
            if (last && has_next) S.a_ready(nxt);
            if constexpr (SP2) {
            PG8_LDB(B0, 0, 0); PG8_LDB(B1, 0, 1); PG8_SCHED; PG8_LDA(At, 0, 0); PG8_STAGE(PG8_SA(1, 1), a1 + hstep, voffA);
            PG8_WAIT_V(8); PG8_WAIT_L(0); PG8_BAR; PG8_MMA(0, 0, At, B0); PG8_MMA(0, 1, At, B1); PG8_BAR; PG8_SCHED;
            PG8_LDA(At, 0, 1); PG8_STAGE(PG8_SB(0, 0), b2, voffB); PG8_STAGE(PG8_SB(0, 1), b2 + hstep, voffB); PG8_STAGE(PG8_SA(0, 0), a2, voffA);
            PG8_WAIT_V(8); PG8_WAIT_L(0); PG8_BAR; PG8_MMA(1, 0, At, B0); PG8_MMA(1, 1, At, B1); PG8_BAR; PG8_SCHED;
            PG8_LDB(B0, 1, 0); PG8_LDB(B1, 1, 1); PG8_SCHED; PG8_LDA(At, 1, 0); PG8_STAGE(PG8_SA(0, 1), a2 + hstep, voffA);
            PG8_WAIT_V(8); PG8_WAIT_L(0); PG8_BAR; PG8_MMA(0, 0, At, B0); PG8_MMA(0, 1, At, B1); PG8_BAR; PG8_SCHED;
            PG8_LDA(At, 1, 1); PG8_STAGE(PG8_SB(1, 0), b3, voffB); PG8_STAGE(PG8_SB(1, 1), b3 + hstep, voffB); PG8_STAGE(PG8_SA(1, 0), a3, voffA);
            PG8_WAIT_V(8); PG8_WAIT_L(0); PG8_BAR; PG8_MMA(1, 0, At, B0); PG8_MMA(1, 1, At, B1); PG8_BAR; PG8_SCHED;
            } else {
            PG8_LDB(B0, 0, 0); PG8_SCHED; PG8_LDA(At, 0, 0); PG8_STAGE(PG8_SA(1, 1), a1 + hstep, voffA);
            PG8_WAIT_L(8); PG8_BAR; PG8_WAIT_L(0); PG8_MMA(0, 0, At, B0); PG8_BAR; PG8_SCHED;
            PG8_LDB(B1, 0, 1); PG8_STAGE(PG8_SB(0, 0), b2, voffB);
            PG8_BAR; PG8_WAIT_L(0); PG8_MMA(0, 1, At, B1); PG8_BAR;
            PG8_LDA(At, 0, 1); PG8_STAGE(PG8_SA(0, 0), a2, voffA);
            PG8_BAR; PG8_WAIT_L(0); PG8_MMA(1, 0, At, B0); PG8_BAR; PG8_SCHED;
            PG8_STAGE(PG8_SB(0, 1), b2 + hstep, voffB);
            PG8_WAIT_V(6); PG8_BAR; PG8_MMA(1, 1, At, B1); PG8_BAR;
            PG8_LDB(B0, 1, 0); PG8_SCHED; PG8_LDA(At, 1, 0); PG8_STAGE(PG8_SA(0, 1), a2 + hstep, voffA);
            PG8_WAIT_L(8); PG8_BAR; PG8_WAIT_L(0); PG8_MMA(0, 0, At, B0); PG8_BAR; PG8_SCHED;
            PG8_LDB(B1, 1, 1); PG8_STAGE(PG8_SB(1, 0), b3, voffB);
            PG8_BAR; PG8_WAIT_L(0); PG8_MMA(0, 1, At, B1); PG8_BAR;
            PG8_LDA(At, 1, 1); PG8_STAGE(PG8_SA(1, 0), a3, voffA);
            PG8_BAR; PG8_WAIT_L(0); PG8_MMA(1, 0, At, B0); PG8_BAR; PG8_SCHED;
            PG8_STAGE(PG8_SB(1, 1), b3 + hstep, voffB);
            PG8_WAIT_V(6); PG8_BAR; PG8_MMA(1, 1, At, B1); PG8_BAR;
            }
        }
        if constexpr (ALIGN_EPI) { if (wr == 0) PG8_BAR; }
        if constexpr (!Epi::AFTER_DRAIN) { E(acc, cur, wr, wc, fr, fq); S.done(cur); }
        if (!has_next) break;
#pragma unroll
        for (int a = 0; a < 2; ++a)
#pragma unroll
            for (int b = 0; b < 2; ++b)
#pragma unroll
                for (int m = 0; m < 4; ++m)
#pragma unroll
                    for (int n = 0; n < 2; ++n) acc[a][b][m][n] = (f32x4){0.f, 0.f, 0.f, 0.f};
        cur = nxt; cA = nA; cB = nB; ++ui;
        if constexpr (ALIGN_EPI) { if (wr == 1) PG8_BAR; }
    }
    PG8_WAIT_V(0);
    if constexpr (!ALIGN_EPI) { if (wr == 0) PG8_BAR; }
    PG8_BAR;
    if constexpr (Epi::AFTER_DRAIN) { E.fused(acc, cur, wr, wc, fr, fq, lds, wid, lane); S.done(cur); }
#undef PG8_SA
#undef PG8_SB
#undef PG8_STAGE
#undef PG8_LDA
#undef PG8_LDB
#undef PG8_MMA
#undef PG8_WAIT_V
#undef PG8_WAIT_L
#undef PG8_BAR
#undef PG8_SCHED
}
}

constexpr int D = 1024, BATCH = 16, SEQ = 2048, CTX = 256, DEPTH = 4;
constexpr int TPB = CTX + SEQ;
constexpr int M = BATCH * TPB;
constexpr int DIN = 3088, NP = 3072, DFF = 4096;
constexpr int PC_DNQ = 0, PC_DNG = 768, PC_SQ = 1024, PC_SK = 1536, PC_SV = 1664, PC_HQ = 1792, PC_HF = 2048, PC_HI = 2560, PC_HG = 2816;
constexpr float EPS = 1e-6f;
constexpr size_t MiB = 1u << 20;
constexpr size_t WS_CTL = 0, WS_MODS = 1 * MiB, WS_ROPE = 3 * MiB, WS_LB = 3 * MiB + 512 * 1024, WS_AB = 4 * MiB;
constexpr size_t WS_WIN = 7 * MiB, WS_WOUT = 13 * MiB, WS_W1 = 15 * MiB, WS_W2 = 23 * MiB, WS_XC = 32 * MiB, WS_HY = 48 * MiB, WS_P = 120 * MiB;
constexpr size_t WS_OD = WS_P + 216 * MiB, WS_END = WS_P + 288 * MiB;
constexpr int LDS_BYTES = 147456;
constexpr int NWAVES = 8, NTHR = 512;

#define LAS __attribute__((address_space(3)))
typedef unsigned short bf16_t;
typedef float f32x4 __attribute__((ext_vector_type(4)));
typedef short bf16x8 __attribute__((ext_vector_type(8)));
typedef short s16x4 __attribute__((ext_vector_type(4)));
typedef unsigned u32x4 __attribute__((ext_vector_type(4)));
typedef unsigned u32x2 __attribute__((ext_vector_type(2)));

struct Params {
    const float *x, *c, *ctx, *c_ctx, *w_ada, *b_ada, *norm1, *norm2, *w_in, *dn_conv, *dn_A_log, *dn_dt_bias, *dn_norm, *swa_sink, *hg_lb, *hg_norm, *w_out, *w_ff1, *w_ff2, *norm_f;
    float* out; unsigned char* ws;
};

__device__ __forceinline__ float bflo(unsigned u) { return __uint_as_float(u << 16); }
__device__ __forceinline__ float bfhi(unsigned u) { return __uint_as_float(u & 0xffff0000u); }
__device__ __forceinline__ unsigned pk2(float lo, float hi) { return pg8::cvt_pk_bf16(lo, hi); }
__device__ __forceinline__ bf16_t bf1(float f) { unsigned u = __float_as_uint(f); u += 0x7fffu + ((u >> 16) & 1u); return (bf16_t)(u >> 16); }
__device__ __forceinline__ float siluf(float v) { return v / (1.f + __expf(-v)); }
__device__ __forceinline__ float sigmf(float v) { return 1.f / (1.f + __expf(-v)); }
__device__ __forceinline__ float wave_sum(float v) {
#pragma unroll
    for (int o = 1; o < 64; o <<= 1) v += __shfl_xor(v, o);
    return v;
}
template <int CTRL> __device__ __forceinline__ float dpp(float x) { return __builtin_bit_cast(float, __builtin_amdgcn_mov_dpp(__builtin_bit_cast(int, x), CTRL, 0xf, 0xf, true)); }
constexpr int XOR1 = 0xB1, XOR2 = 0x4E, XOR7 = 0x141;
__device__ __forceinline__ float sum8(float v) { v += dpp<XOR1>(v); v += dpp<XOR2>(v); v += dpp<XOR7>(v); return v; }
__device__ __forceinline__ float xrow16_max(float x) {
    auto s = __builtin_amdgcn_permlane16_swap(__float_as_uint(x), __float_as_uint(x), false, false);
    x = fmaxf(__uint_as_float(s[0]), __uint_as_float(s[1]));
    auto t = __builtin_amdgcn_permlane32_swap(__float_as_uint(x), __float_as_uint(x), false, false);
    return fmaxf(__uint_as_float(t[0]), __uint_as_float(t[1]));
}
__device__ __forceinline__ float xrow16_sum(float x) {
    auto s = __builtin_amdgcn_permlane16_swap(__float_as_uint(x), __float_as_uint(x), false, false);
    x = __uint_as_float(s[0]) + __uint_as_float(s[1]);
    auto t = __builtin_amdgcn_permlane32_swap(__float_as_uint(x), __float_as_uint(x), false, false);
    return __uint_as_float(t[0]) + __uint_as_float(t[1]);
}
__device__ __forceinline__ const float* xrow_c(const float* Xl, const float* Xc, int r) { const int b = r / TPB, t = r - b * TPB; return t < CTX ? Xc + ((size_t)(b * CTX + t) << 10) : Xl + ((size_t)(b * SEQ + t - CTX) << 10); }
__device__ __forceinline__ int cidx(int r) { const int b = r / TPB, t = r - b * TPB; return t < CTX ? 16 : b; }

__device__ __forceinline__ void phase_prologue(const Params& p, LAS unsigned char* lds, const int wvs) {
    const int tid = wvs * 64 + lane_id_fresh(); const int lane = tid & 63, w = tid >> 6;
    float* mods = (float*)(p.ws + WS_MODS);
    LAS float* sc = (LAS float*)lds;
    LAS float* red = (LAS float*)(lds + 81920);
    for (int idx = tid; idx < 17 * 1024; idx += NTHR) { const int ci = idx >> 10, k = idx & 1023; const float v = ci < 16 ? p.c[ci * 1024 + k] : p.c_ctx[k]; sc[k * 20 + ci] = v / (1.f + expf(-v)); }
    __syncthreads();
    for (int it = blockIdx.x; it < DEPTH * 96; it += gridDim.x) {
        const int l = it / 96, cgp = it - l * 96, col = cgp * 64 + lane;
        float acc[17];
#pragma unroll
        for (int i = 0; i < 17; ++i) acc[i] = 0.f;
        const float* wp = p.w_ada + ((size_t)l * 1024 + w * 128) * 6144 + col;
#pragma unroll 8
        for (int kk = 0; kk < 128; ++kk) {
            const float wv = wp[(size_t)kk * 6144];
            const LAS f32x4* s4 = (const LAS f32x4*)(sc + (w * 128 + kk) * 20);
            const f32x4 s0 = s4[0], s1 = s4[1], s2 = s4[2], s3 = s4[3]; const float s16 = sc[(w * 128 + kk) * 20 + 16];
#pragma unroll
            for (int e = 0; e < 4; ++e) { acc[e] += wv * s0[e]; acc[4 + e] += wv * s1[e]; acc[8 + e] += wv * s2[e]; acc[12 + e] += wv * s3[e]; }
            acc[16] += wv * s16;
        }
#pragma unroll
        for (int i = 0; i < 17; ++i) red[(w * 17 + i) * 64 + lane] = acc[i];
        __syncthreads();
        for (int idx = tid; idx < 17 * 64; idx += NTHR) { const int i = idx >> 6, cl = idx & 63; float s = 0.f;
#pragma unroll
            for (int ww = 0; ww < 8; ++ww) s += red[(ww * 17 + i) * 64 + cl];
            mods[((size_t)l * 17 + i) * 6144 + cgp * 64 + cl] = s + p.b_ada[l * 6144 + cgp * 64 + cl]; }
        __syncthreads();
    }
    const int gt = blockIdx.x * NTHR + tid, GT = gridDim.x * NTHR;
    { float* rc = (float*)(p.ws + WS_ROPE); float* rs = rc + 2048 * 32;
      for (int idx = gt; idx < 2048 * 32; idx += GT) { const int t = idx >> 5, d = idx & 31; const float pos = (float)(d < 16 ? (t >> 6) : (t & 63));
          const float inv = expf(-(float)(d & 15) * (9.210340371976184f / 16.f)); const float ang = pos * inv; rc[idx] = cosf(ang); rs[idx] = sinf(ang); } }
    { float* LB = (float*)(p.ws + WS_LB);
      for (int idx = gt; idx < 2 * 256; idx += GT) { const int d = idx >> 8, cc = idx & 255; float v[DEPTH]; float mx = -1e30f;
#pragma unroll
          for (int l = 0; l < DEPTH; ++l) { v[l] = p.hg_lb[(d * DEPTH + l) * 256 + cc]; mx = fmaxf(mx, v[l]); }
          float s = 0.f;
#pragma unroll
          for (int l = 0; l < DEPTH; ++l) { v[l] = expf(v[l] - mx); s += v[l]; }
          float cum = 0.f;
#pragma unroll
          for (int l = 0; l < DEPTH; ++l) { if (l > 0) cum += v[l] / s; LB[(d * DEPTH + l) * 256 + cc] = cum; } } }
    { const f32x4* src = (const f32x4*)p.x; f32x4* dst = (f32x4*)p.out; for (int i = gt; i < BATCH * SEQ * D / 4; i += GT) dst[i] = src[i];
      const f32x4* s2 = (const f32x4*)p.ctx; f32x4* d2 = (f32x4*)(p.ws + WS_XC); for (int i = gt; i < BATCH * CTX * D / 4; i += GT) d2[i] = s2[i]; }
}

__device__ __forceinline__ void transpose_item(const float* W, int K, int ldw, int scol0, bf16_t* WT, int n0, int k0, LAS float* scr, int lane) {
#pragma unroll 8
    for (int i = 0; i < 32; ++i) { const int kk = 2 * i + (lane >> 5); scr[kk * 33 + (lane & 31)] = W[(size_t)(k0 + kk) * ldw + scol0 + (lane & 31)]; }
    asm volatile("s_waitcnt lgkmcnt(0)" ::: "memory");
    const int c = lane & 7;
#pragma unroll
    for (int j = 0; j < 4; ++j) { const int n = (lane >> 3) + 8 * j; const LAS float* s = scr + (8 * c) * 33 + n;
        u32x4 o; o.x = pk2(s[0 * 33], s[1 * 33]); o.y = pk2(s[2 * 33], s[3 * 33]); o.z = pk2(s[4 * 33], s[5 * 33]); o.w = pk2(s[6 * 33], s[7 * 33]);
        *(u32x4*)(WT + (size_t)(n0 + n) * K + k0 + 8 * c) = o; }
    asm volatile("s_waitcnt lgkmcnt(0)" ::: "memory");
}

template <bool FIRST> __device__ __forceinline__ void phase_norm(const Params& p, int l, LAS unsigned char* lds, const int wvs) {
    const int tid = wvs * 64 + lane_id_fresh(); const int lane = tid & 63, w = tid >> 6;
    const int gw = blockIdx.x * NWAVES + w, NGW = gridDim.x * NWAVES;
    const float* mods = (const float*)(p.ws + WS_MODS);
    LAS float* wab = (LAS float*)lds;
    if (FIRST) {
        LAS float* scr = (LAS float*)(lds + 65536 + w * 8704);
        constexpr int I_IN = 16 * 96, I_OUT = 16 * 32, I_1 = 16 * 128, I_2 = 64 * 32;
        for (int it = gw; it < I_IN + I_OUT + I_1 + I_2; it += NGW) {
            int r = it;
            if (r < I_IN) { const int kb = r / 96, nb = r - kb * 96; const int n0 = nb * 32; transpose_item(p.w_in + (size_t)l * D * DIN, D, DIN, n0 + (n0 >= 1024 ? 16 : 0), (bf16_t*)(p.ws + WS_WIN), n0, kb * 64, scr, lane); continue; }
            r -= I_IN;
            if (r < I_OUT) { const int kb = r / 32, nb = r - kb * 32; transpose_item(p.w_out + (size_t)l * D * D, D, D, nb * 32, (bf16_t*)(p.ws + WS_WOUT), nb * 32, kb * 64, scr, lane); continue; }
            r -= I_OUT;
            if (r < I_1) { const int kb = r / 128, nb = r - kb * 128; transpose_item(p.w_ff1 + (size_t)l * D * DFF, D, DFF, nb * 32, (bf16_t*)(p.ws + WS_W1), nb * 32, kb * 64, scr, lane); continue; }
            r -= I_1;
            { const int kb = r / 32, nb = r - kb * 32; transpose_item(p.w_ff2 + (size_t)l * DFF * D, DFF, D, nb * 32, (bf16_t*)(p.ws + WS_W2), nb * 32, kb * 64, scr, lane); }
        }
        const float* wi = p.w_in + (size_t)l * D * DIN + 1024;
        for (int idx = tid; idx < 4096; idx += NTHR) { const int k = idx >> 2, j4 = (idx & 3) * 4; const f32x4 v = *(const f32x4*)(wi + (size_t)k * DIN + j4);
#pragma unroll
            for (int e = 0; e < 4; ++e) wab[(j4 + e) * 1024 + k] = v[e]; }
        __syncthreads();
    }
    const float* nw = (FIRST ? p.norm1 : p.norm2) + l * D;
    bf16_t* H = (bf16_t*)(p.ws + WS_HY);
    float* AB = (float*)(p.ws + WS_AB);
    const float* Xc = (const float*)(p.ws + WS_XC);
    for (int r = gw; r < M; r += NGW) {
        const f32x4* xr = (const f32x4*)xrow_c(p.out, Xc, r) + lane;
        f32x4 v[4]; float ss = 0.f;
#pragma unroll
        for (int j = 0; j < 4; ++j) { v[j] = xr[64 * j]; ss += (v[j][0] * v[j][0] + v[j][1] * v[j][1]) + (v[j][2] * v[j][2] + v[j][3] * v[j][3]); }
        const float rstd = rsqrtf(wave_sum(ss) * (1.f / D) + EPS);
        const float* md = mods + ((size_t)l * 17 + cidx(r)) * 6144 + (FIRST ? 0 : 3 * 1024);
        float acc[16];
#pragma unroll
        for (int o = 0; o < 16; ++o) acc[o] = 0.f;
        u32x2* hp = (u32x2*)(H + (size_t)r * D) + lane;
#pragma unroll
        for (int j = 0; j < 4; ++j) { const int k = 4 * (lane + 64 * j);
            const f32x4 g = *(const f32x4*)(nw + k), sh = *(const f32x4*)(md + k), sl = *(const f32x4*)(md + 1024 + k);
            f32x4 h;
#pragma unroll
            for (int e = 0; e < 4; ++e) h[e] = (v[j][e] * rstd * g[e]) * (1.f + sl[e]) + sh[e];
            u32x2 o2; o2.x = pk2(h[0], h[1]); o2.y = pk2(h[2], h[3]); hp[64 * j] = o2;
            if (FIRST) {
#pragma unroll
                for (int o = 0; o < 16; ++o) { const f32x4 wv = *(const LAS f32x4*)(wab + o * 1024 + k); acc[o] += (h[0] * wv[0] + h[1] * wv[1]) + (h[2] * wv[2] + h[3] * wv[3]); }
            }
        }
        if (FIRST) { float outv = 0.f;
#pragma unroll
            for (int o = 0; o < 16; ++o) { const float s = wave_sum(acc[o]); if (lane == o) outv = s; }
            if (lane < 16) AB[(size_t)r * 16 + lane] = outv; }
    }
}

constexpr int SST = 68;
constexpr int HST = 72;
__device__ __forceinline__ bf16x8 ldA_perm(const LAS bf16_t* base, int row, int s, int fq) {
    const LAS bf16_t* ap = base + row * HST + s * 32 + fq * 4; const u32x2 lo = *(const LAS u32x2*)ap, hi = *(const LAS u32x2*)(ap + 16);
    u32x4 av; av[0] = lo[0]; av[1] = lo[1]; av[2] = hi[0]; av[3] = hi[1]; return __builtin_bit_cast(bf16x8, av);
}
__device__ __forceinline__ bf16x8 packB(const f32x4& a, const f32x4& b) {
    u32x4 pb; pb[0] = bf1(a[0]) | ((unsigned)bf1(a[1]) << 16); pb[1] = bf1(a[2]) | ((unsigned)bf1(a[3]) << 16); pb[2] = bf1(b[0]) | ((unsigned)bf1(b[1]) << 16); pb[3] = bf1(b[2]) | ((unsigned)bf1(b[3]) << 16);
    return __builtin_bit_cast(bf16x8, pb);
}
__device__ __forceinline__ void dn_seq(const Params& p, int l, int s, LAS unsigned char* lds, const int wvs) {
    const int tid = wvs * 64 + lane_id_fresh(); const int lane = tid & 63;
    const int b = s >> 3, h = (s >> 1) & 3, d = s & 1;
    LAS float* qs = (LAS float*)lds; LAS float* ks = qs + 64 * SST; LAS float* vs = ks + 64 * SST;
    LAS bf16_t* QH = (LAS bf16_t*)(vs + 64 * SST); LAS bf16_t* KH = QH + 64 * HST; LAS bf16_t* KTT = KH + 64 * HST; LAS bf16_t* LM = KTT + 64 * HST; LAS bf16_t* SCM = LM + 64 * HST; LAS bf16_t* OB = SCM + 64 * HST;
    LAS float* LF = (LAS float*)(OB + 64 * HST);
    LAS bf16_t* DI = (LAS bf16_t*)(LF + 4 * 16 * 17);
    LAS float* GC = (LAS float*)(DI + 4 * 16 * 24); LAS float* EG = GC + 64; LAS float* BETA = EG + 64; LAS float* GL = BETA + 64;
    const bf16_t* P = (const bf16_t*)(p.ws + WS_P);
    const float* AB = (const float*)(p.ws + WS_AB);
    bf16_t* OD = (bf16_t*)(p.ws + WS_OD) + (size_t)d * M * 512 + h * 64;
    const float* cw = p.dn_conv + (size_t)l * 5 * 768;
    const float nA = -expf(p.dn_A_log[(l * 2 + d) * 4 + h]); const float dtb = p.dn_dt_bias[(l * 2 + d) * 4 + h];
    const int fr = lane & 15, fq = lane >> 4;
    const int V = wvs & 3, half = wvs >> 2;
    const f32x4 zero4 = (f32x4){0.f, 0.f, 0.f, 0.f};
    constexpr int RST = 200;
    LAS bf16_t* RAW = KTT;
    const int c4 = tid % 48, tg = tid / 48;
    float wc[5][4];
    { const int ch = c4 * 4, pcol = (ch >> 6) * 256 + h * 64 + (ch & 63);
#pragma unroll
      for (int t = 0; t < 5; ++t) { const f32x4 w4 = *(const f32x4*)(cw + t * 768 + pcol); wc[t][0] = w4[0]; wc[t][1] = w4[1]; wc[t][2] = w4[2]; wc[t][3] = w4[3]; } }
    LAS float* cdst = ((c4 >> 4) == 0 ? qs : ((c4 >> 4) == 1 ? ks : vs)) + (c4 & 15) * 4;
    u32x4 praw[4]; float pa = 0.f, pb_ = 0.f;
    { const int nc0 = d == 0 ? 0 : 3; const int base0 = b * TPB + nc0 * 64, lo0 = b * TPB, hi0 = b * TPB + CTX;
#pragma unroll
      for (int k = 0; k < 4; ++k) { const int q = tid + NTHR * k; const int rr = q / 24, pc = q - rr * 24; const int r = base0 - 2 + rr;
          praw[k] = (q < 68 * 24 && r >= lo0 && r < hi0) ? *(const u32x4*)(P + (size_t)r * NP + (pc >> 3) * 256 + h * 64 + (pc & 7) * 8) : (u32x4){0u, 0u, 0u, 0u}; }
      if (wvs == 0) { const int r = base0 + (d ? 63 - lane : lane); pa = AB[(size_t)r * 16 + d * 4 + h]; pb_ = AB[(size_t)r * 16 + 8 + d * 4 + h]; } }
    f32x4 Sacc[4];
#pragma unroll
    for (int T = 0; T < 4; ++T) Sacc[T] = zero4;
    for (int ci = 0; ci < 36; ++ci) {
        const int nc = d == 0 ? ci : (ci < 4 ? 3 - ci : 39 - ci);
        const int base = b * TPB + nc * 64, seg_lo = b * TPB + (nc < 4 ? 0 : CTX), seg_hi = b * TPB + (nc < 4 ? CTX : TPB);
#pragma unroll
        for (int k = 0; k < 4; ++k) { const int q = tid + NTHR * k; if (q < 68 * 24) { const int rr = q / 24, pc = q - rr * 24; *(LAS u32x4*)(RAW + rr * RST + pc * 8) = praw[k]; } }
        const float a_in = pa, b_in = pb_;
        if (ci + 1 < 36) { const int c2 = ci + 1; const int nc2 = d == 0 ? c2 : (c2 < 4 ? 3 - c2 : 39 - c2);
            const int base2 = b * TPB + nc2 * 64, lo2 = b * TPB + (nc2 < 4 ? 0 : CTX), hi2 = b * TPB + (nc2 < 4 ? CTX : TPB);
#pragma unroll
            for (int k = 0; k < 4; ++k) { const int q = tid + NTHR * k; const int rr = q / 24, pc = q - rr * 24; const int r = base2 - 2 + rr;
                praw[k] = (q < 68 * 24 && r >= lo2 && r < hi2) ? *(const u32x4*)(P + (size_t)r * NP + (pc >> 3) * 256 + h * 64 + (pc & 7) * 8) : (u32x4){0u, 0u, 0u, 0u}; }
            if (wvs == 0) { const int r = base2 + (d ? 63 - lane : lane); pa = AB[(size_t)r * 16 + d * 4 + h]; pb_ = AB[(size_t)r * 16 + 8 + d * 4 + h]; } }
        __syncthreads();
        if (tid < 480) {
#pragma unroll
            for (int m = 0; m < 7; ++m) { const int pp = tg + 10 * m; if (pp < 64) { float a0 = 0.f, a1 = 0.f, a2 = 0.f, a3 = 0.f;
#pragma unroll
                for (int t = 0; t < 5; ++t) { const u32x2 raw = *(const LAS u32x2*)(RAW + (pp + t) * RST + c4 * 4);
                    a0 += bflo(raw[0]) * wc[t][0]; a1 += bfhi(raw[0]) * wc[t][1]; a2 += bflo(raw[1]) * wc[t][2]; a3 += bfhi(raw[1]) * wc[t][3]; }
                f32x4 o; o[0] = a0 / (1.f + __expf(-a0)); o[1] = a1 / (1.f + __expf(-a1)); o[2] = a2 / (1.f + __expf(-a2)); o[3] = a3 / (1.f + __expf(-a3));
                const int pq = d ? 63 - pp : pp; *(LAS f32x4*)(cdst + pq * SST) = o; } } }
        if (wvs == 0) { const float ai = a_in, bi = b_in;
            const float xs = ai + dtb; const float sp = xs > 20.f ? xs : log1pf(expf(xs)); float x = nA * sp;
#pragma unroll
            for (int o = 1; o < 64; o <<= 1) { const float y = __shfl_up(x, o); if (lane >= o) x += y; }
            GC[lane] = x; EG[lane] = __expf(x); BETA[lane] = 1.f / (1.f + expf(-bi)); if (lane == 63) { GL[0] = x; GL[1] = __expf(x); } }
        __syncthreads();
        { const int t = tid >> 3, part = tid & 7;
          const f32x4 q0 = *(const LAS f32x4*)(qs + t * SST + part * 8), q1 = *(const LAS f32x4*)(qs + t * SST + part * 8 + 4);
          const f32x4 k0 = *(const LAS f32x4*)(ks + t * SST + part * 8), k1 = *(const LAS f32x4*)(ks + t * SST + part * 8 + 4);
          float sq = (q0[0] * q0[0] + q0[1] * q0[1]) + (q0[2] * q0[2] + q0[3] * q0[3]) + (q1[0] * q1[0] + q1[1] * q1[1]) + (q1[2] * q1[2] + q1[3] * q1[3]);
          float sk = (k0[0] * k0[0] + k0[1] * k0[1]) + (k0[2] * k0[2] + k0[3] * k0[3]) + (k1[0] * k1[0] + k1[1] * k1[1]) + (k1[2] * k1[2] + k1[3] * k1[3]);
          sq = sum8(sq); sk = sum8(sk);
          const float rq = rsqrtf(sq + EPS) * 0.125f, rk = rsqrtf(sk + EPS), ekt = __expf(GL[0] - GC[t]);
          u32x4 qo, ko;
          qo[0] = pk2(q0[0] * rq, q0[1] * rq); qo[1] = pk2(q0[2] * rq, q0[3] * rq); qo[2] = pk2(q1[0] * rq, q1[1] * rq); qo[3] = pk2(q1[2] * rq, q1[3] * rq);
          ko[0] = pk2(k0[0] * rk, k0[1] * rk); ko[1] = pk2(k0[2] * rk, k0[3] * rk); ko[2] = pk2(k1[0] * rk, k1[1] * rk); ko[3] = pk2(k1[2] * rk, k1[3] * rk);
          *(LAS u32x4*)(QH + t * HST + part * 8) = qo; *(LAS u32x4*)(KH + t * HST + part * 8) = ko;
          const float rke = rk * ekt;
#pragma unroll
          for (int e = 0; e < 4; ++e) { KTT[(part * 8 + e) * HST + t] = bf1(k0[e] * rke); KTT[(part * 8 + 4 + e) * HST + t] = bf1(k1[e] * rke); } }
        __syncthreads();
        { const int I = wvs >> 1;
#pragma unroll
          for (int jj = 0; jj < 2; ++jj) { const int J = 2 * (wvs & 1) + jj; f32x4 ckk = zero4, cqk = zero4;
#pragma unroll
              for (int kk = 0; kk < 2; ++kk) { const bf16x8 Ak = *(const LAS bf16x8*)(KH + (I * 16 + fr) * HST + kk * 32 + fq * 8), Aq = *(const LAS bf16x8*)(QH + (I * 16 + fr) * HST + kk * 32 + fq * 8);
                  const bf16x8 B = *(const LAS bf16x8*)(KH + (J * 16 + fr) * HST + kk * 32 + fq * 8);
                  ckk = __builtin_amdgcn_mfma_f32_16x16x32_bf16(Ak, B, ckk, 0, 0, 0); cqk = __builtin_amdgcn_mfma_f32_16x16x32_bf16(Aq, B, cqk, 0, 0, 0); }
              const int j = J * 16 + fr; const float gj = GC[j];
#pragma unroll
              for (int r = 0; r < 4; ++r) { const int i = I * 16 + fq * 4 + r; const float dec = __expf(fminf(GC[i] - gj, 0.f));
                  const float lv = j < i ? BETA[i] * ckk[r] * dec : 0.f, sv = j <= i ? cqk[r] * dec : 0.f;
                  LM[i * HST + j] = bf1(lv); SCM[i * HST + j] = bf1(sv); if (I == J) LF[(I * 16 + fq * 4 + r) * 17 + fr] = lv; } } }
        __syncthreads();
        if (wvs == 0) { const int I = lane >> 4, c = lane & 15; float x[16];
#pragma unroll
            for (int i = 0; i < 16; ++i) { float acc = (i == c) ? 1.f : 0.f;
#pragma unroll
                for (int j = 0; j < i; ++j) acc -= LF[(I * 16 + i) * 17 + j] * x[j];
                x[i] = acc; DI[(I * 16 + i) * 24 + c] = bf1(acc); } }
        f32x4 R[4], QS[2];
        { bf16x8 Bs[2];
#pragma unroll
          for (int s2 = 0; s2 < 2; ++s2) Bs[s2] = packB(Sacc[2 * s2], Sacc[2 * s2 + 1]);
#pragma unroll
          for (int I = 0; I < 4; ++I) { f32x4 c = zero4;
#pragma unroll
              for (int s2 = 0; s2 < 2; ++s2) c = __builtin_amdgcn_mfma_f32_16x16x32_bf16(ldA_perm(KH, I * 16 + fr, s2, fq), Bs[s2], c, 0, 0, 0);
#pragma unroll
              for (int r = 0; r < 4; ++r) { const int i = I * 16 + fq * 4 + r; R[I][r] = BETA[i] * (vs[i * SST + V * 16 + fr] - EG[i] * c[r]); } }
#pragma unroll
          for (int ii = 0; ii < 2; ++ii) { const int I = 2 * half + ii; f32x4 c = zero4;
#pragma unroll
              for (int s2 = 0; s2 < 2; ++s2) c = __builtin_amdgcn_mfma_f32_16x16x32_bf16(ldA_perm(QH, I * 16 + fr, s2, fq), Bs[s2], c, 0, 0, 0);
              QS[ii] = c; } }
        __syncthreads();
        bf16x8 Bx0, Bx1;
        { bf16x8 AD[4];
#pragma unroll
          for (int I = 0; I < 4; ++I) { const u32x2 lo = *(const LAS u32x2*)(DI + (I * 16 + fr) * 24 + fq * 4); u32x4 av; av[0] = lo[0]; av[1] = lo[1]; av[2] = 0u; av[3] = 0u; AD[I] = __builtin_bit_cast(bf16x8, av); }
          const f32x4 X0 = __builtin_amdgcn_mfma_f32_16x16x32_bf16(AD[0], packB(R[0], zero4), zero4, 0, 0, 0);
          f32x4 T1 = __builtin_amdgcn_mfma_f32_16x16x32_bf16(ldA_perm(LM, 16 + fr, 0, fq), packB(X0, zero4), zero4, 0, 0, 0);
          const f32x4 X1 = __builtin_amdgcn_mfma_f32_16x16x32_bf16(AD[1], packB(R[1] - T1, zero4), zero4, 0, 0, 0);
          Bx0 = packB(X0, X1);
          f32x4 T2 = __builtin_amdgcn_mfma_f32_16x16x32_bf16(ldA_perm(LM, 32 + fr, 0, fq), Bx0, zero4, 0, 0, 0);
          const f32x4 X2 = __builtin_amdgcn_mfma_f32_16x16x32_bf16(AD[2], packB(R[2] - T2, zero4), zero4, 0, 0, 0);
          f32x4 T3 = __builtin_amdgcn_mfma_f32_16x16x32_bf16(ldA_perm(LM, 48 + fr, 0, fq), Bx0, zero4, 0, 0, 0);
          T3 = __builtin_amdgcn_mfma_f32_16x16x32_bf16(ldA_perm(LM, 48 + fr, 1, fq), packB(X2, zero4), T3, 0, 0, 0);
          const f32x4 X3 = __builtin_amdgcn_mfma_f32_16x16x32_bf16(AD[3], packB(R[3] - T3, zero4), zero4, 0, 0, 0);
          Bx1 = packB(X2, X3); }
#pragma unroll
        for (int ii = 0; ii < 2; ++ii) { const int I = 2 * half + ii; f32x4 c;
#pragma unroll
            for (int r = 0; r < 4; ++r) c[r] = EG[I * 16 + fq * 4 + r] * QS[ii][r];
            c = __builtin_amdgcn_mfma_f32_16x16x32_bf16(ldA_perm(SCM, I * 16 + fr, 0, fq), Bx0, c, 0, 0, 0);
            c = __builtin_amdgcn_mfma_f32_16x16x32_bf16(ldA_perm(SCM, I * 16 + fr, 1, fq), Bx1, c, 0, 0, 0);
#pragma unroll
            for (int r = 0; r < 4; ++r) OB[(I * 16 + fq * 4 + r) * HST + V * 16 + fr] = bf1(c[r]); }
        { const float egl = GL[1];
#pragma unroll
          for (int T = 0; T < 4; ++T) { f32x4 c = Sacc[T] * egl;
              c = __builtin_amdgcn_mfma_f32_16x16x32_bf16(ldA_perm(KTT, T * 16 + fr, 0, fq), Bx0, c, 0, 0, 0);
              c = __builtin_amdgcn_mfma_f32_16x16x32_bf16(ldA_perm(KTT, T * 16 + fr, 1, fq), Bx1, c, 0, 0, 0);
              Sacc[T] = c; } }
        __syncthreads();
#pragma unroll
        for (int it = 0; it < 4; ++it) { const int idx = tid + NTHR * it; const int i = idx >> 5, c2 = (idx & 31) * 2; const int row = base + (d ? 63 - i : i);
            *(unsigned*)(OD + (size_t)row * 512 + c2) = *(const LAS unsigned*)(OB + i * HST + c2); }
    }
    __syncthreads();
}

__device__ __forceinline__ void hg_seq(const Params& p, int l, int s, LAS unsigned char* lds, const int wvs) {
    const int tid = wvs * 64 + lane_id_fresh(); const int lane = tid & 63;
    const int b = s >> 3, h = (s >> 1) & 3, d = s & 1;
    LAS bf16_t* QT = (LAS bf16_t*)lds; LAS bf16_t* KT = QT + 64 * HST; LAS bf16_t* QP = KT + 64 * HST; LAS bf16_t* KTT = QP + 64 * HST; LAS bf16_t* VT = KTT + 64 * HST; LAS bf16_t* SC = VT + 64 * HST;
    LAS float* GS = (LAS float*)(SC + 64 * HST); LAS float* MID = GS + 512; LAS float* BLS = MID + 64; LAS float* EBL = BLS + 64; LAS bf16_t* OB = (LAS bf16_t*)(EBL + 64);
    const bf16_t* P = (const bf16_t*)(p.ws + WS_P);
    bf16_t* OD = (bf16_t*)(p.ws + WS_OD) + (size_t)d * M * 512 + 256 + h * 64;
    const int kx = tid & 63, g = tid >> 6;
    const float lb = ((const float*)(p.ws + WS_LB))[(d * DEPTH + l) * 256 + h * 64 + kx];
    const int fr = lane & 15, fq = lane >> 4;
    const int V = wvs & 3, half = wvs >> 2;
    f32x4 Sacc[4];
#pragma unroll
    for (int T = 0; T < 4; ++T) Sacc[T] = (f32x4){0.f, 0.f, 0.f, 0.f};
    unsigned short rq[8], rz[8], rv[8];
    { const int nc = d == 0 ? 0 : 3; const int base = b * TPB + nc * 64;
#pragma unroll
      for (int e = 0; e < 8; ++e) { const int t = g * 8 + e; const int pp = d ? 63 - t : t; const bf16_t* rp = P + (size_t)(base + pp) * NP + h * 64 + kx;
          rq[e] = rp[PC_HQ]; rz[e] = rp[PC_HF + d * 256]; rv[e] = rp[PC_HI]; } }
    for (int ci = 0; ci < 36; ++ci) {
        const int nc = d == 0 ? ci : (ci < 4 ? 3 - ci : 39 - ci);
        const int base = b * TPB + nc * 64;
        float qv[8], kv[8], bc[8]; float run = 0.f;
#pragma unroll
        for (int e = 0; e < 8; ++e) { const float z = bflo(rz[e]); const float sg = 1.f / (1.f + __expf(-z)); const float f = lb + (1.f - lb) * sg;
            run += __logf(f); bc[e] = run; kv[e] = (1.f - lb) * (1.f - sg); qv[e] = bflo(rq[e]); }
        GS[g * 64 + kx] = run;
#pragma unroll
        for (int e = 0; e < 8; ++e) VT[kx * HST + g * 8 + e] = rv[e];
        __syncthreads();
        { float off = 0.f;
#pragma unroll
          for (int gg = 0; gg < 7; ++gg) { const float x = GS[gg * 64 + kx]; off += (gg < g) ? x : 0.f; }
#pragma unroll
          for (int e = 0; e < 8; ++e) bc[e] += off; }
        if (g == 3) MID[kx] = bc[7];
        if (g == 7) { BLS[kx] = bc[7]; EBL[kx] = __expf(bc[7]); }
        if (ci + 1 < 36) { const int c2 = ci + 1; const int nc2 = d == 0 ? c2 : (c2 < 4 ? 3 - c2 : 39 - c2); const int base2 = b * TPB + nc2 * 64;
#pragma unroll
            for (int e = 0; e < 8; ++e) { const int t = g * 8 + e; const int pp = d ? 63 - t : t; const bf16_t* rp = P + (size_t)(base2 + pp) * NP + h * 64 + kx;
                rq[e] = rp[PC_HQ]; rz[e] = rp[PC_HF + d * 256]; rv[e] = rp[PC_HI]; } }
        __syncthreads();
        { const float mid = MID[kx], bl = BLS[kx];
#pragma unroll
          for (int e = 0; e < 8; ++e) { const int t = g * 8 + e; const float E = fminf(fmaxf(bc[e] - mid, -80.f), 80.f);
              const float eq = __expf(E), ek = __expf(-E);
              QT[t * HST + kx] = bf1(qv[e] * eq); KT[t * HST + kx] = bf1(kv[e] * ek);
              QP[t * HST + kx] = bf1(qv[e] * __expf(bc[e])); KTT[kx * HST + t] = bf1(kv[e] * __expf(bl - bc[e])); } }
        __syncthreads();
        { const int I = wvs >> 1;
#pragma unroll
          for (int jj = 0; jj < 2; ++jj) { const int J = 2 * (wvs & 1) + jj; f32x4 c = (f32x4){0.f, 0.f, 0.f, 0.f};
#pragma unroll
              for (int kk = 0; kk < 2; ++kk) { const bf16x8 A = *(const LAS bf16x8*)(QT + (I * 16 + fr) * HST + kk * 32 + fq * 8); const bf16x8 B = *(const LAS bf16x8*)(KT + (J * 16 + fr) * HST + kk * 32 + fq * 8);
                  c = __builtin_amdgcn_mfma_f32_16x16x32_bf16(A, B, c, 0, 0, 0); }
#pragma unroll
              for (int r = 0; r < 4; ++r) { const int i = I * 16 + fq * 4 + r, j = J * 16 + fr; SC[i * HST + j] = bf1(j <= i ? c[r] : 0.f); } } }
        __syncthreads();
        { bf16x8 Bs[2];
#pragma unroll
          for (int s2 = 0; s2 < 2; ++s2) { u32x4 pb; pb[0] = bf1(Sacc[2 * s2][0]) | ((unsigned)bf1(Sacc[2 * s2][1]) << 16); pb[1] = bf1(Sacc[2 * s2][2]) | ((unsigned)bf1(Sacc[2 * s2][3]) << 16); pb[2] = bf1(Sacc[2 * s2 + 1][0]) | ((unsigned)bf1(Sacc[2 * s2 + 1][1]) << 16); pb[3] = bf1(Sacc[2 * s2 + 1][2]) | ((unsigned)bf1(Sacc[2 * s2 + 1][3]) << 16); Bs[s2] = __builtin_bit_cast(bf16x8, pb); }
          bf16x8 Bv[2];
#pragma unroll
          for (int s2 = 0; s2 < 2; ++s2) Bv[s2] = *(const LAS bf16x8*)(VT + (V * 16 + fr) * HST + s2 * 32 + fq * 8);
#pragma unroll
          for (int ii = 0; ii < 2; ++ii) { const int I = 2 * half + ii; f32x4 o = (f32x4){0.f, 0.f, 0.f, 0.f};
#pragma unroll
              for (int s2 = 0; s2 < 2; ++s2) { const LAS bf16_t* ap = QP + (I * 16 + fr) * HST + s2 * 32 + fq * 4; const u32x2 lo = *(const LAS u32x2*)ap, hi = *(const LAS u32x2*)(ap + 16);
                  u32x4 av; av[0] = lo[0]; av[1] = lo[1]; av[2] = hi[0]; av[3] = hi[1];
                  o = __builtin_amdgcn_mfma_f32_16x16x32_bf16(__builtin_bit_cast(bf16x8, av), Bs[s2], o, 0, 0, 0); }
#pragma unroll
              for (int s2 = 0; s2 < 2; ++s2) { const bf16x8 A = *(const LAS bf16x8*)(SC + (I * 16 + fr) * HST + s2 * 32 + fq * 8); o = __builtin_amdgcn_mfma_f32_16x16x32_bf16(A, Bv[s2], o, 0, 0, 0); }
#pragma unroll
              for (int r = 0; r < 4; ++r) { const int i = I * 16 + fq * 4 + r; OB[i * HST + V * 16 + fr] = bf1(o[r]); } }
#pragma unroll
          for (int T = 0; T < 4; ++T) { f32x4 c;
#pragma unroll
              for (int r = 0; r < 4; ++r) c[r] = Sacc[T][r] * EBL[T * 16 + fq * 4 + r];
#pragma unroll
              for (int s2 = 0; s2 < 2; ++s2) { const bf16x8 A = *(const LAS bf16x8*)(KTT + (T * 16 + fr) * HST + s2 * 32 + fq * 8); c = __builtin_amdgcn_mfma_f32_16x16x32_bf16(A, Bv[s2], c, 0, 0, 0); }
              Sacc[T] = c; } }
        __syncthreads();
#pragma unroll
        for (int it = 0; it < 4; ++it) { const int idx = tid + NTHR * it; const int i = idx >> 5, c2 = (idx & 31) * 2; const int row = base + (d ? 63 - i : i);
            *(unsigned*)(OD + (size_t)row * 512 + c2) = *(const LAS unsigned*)(OB + i * HST + c2); }
    }
}

constexpr int KST = 72, VST = 136;
__device__ __forceinline__ void swa_unit(const Params& p, int l, int unit, LAS unsigned char* lds, const int wvs) {
    const int tid = wvs * 64 + lane_id_fresh(); const int lane = tid & 63, w = tid >> 6;
    const int b = unit / 36, rem = unit - b * 36, kvh = rem / 18, qb = rem - kvh * 18;
    const bool qctx = qb < 2;
    const bf16_t* P = (const bf16_t*)(p.ws + WS_P);
    const float* rc = (const float*)(p.ws + WS_ROPE); const float* rs = rc + 2048 * 32;
    bf16_t* Y = (bf16_t*)(p.ws + WS_HY);
    LAS bf16_t* Ks = (LAS bf16_t*)lds; LAS bf16_t* Vt = Ks + 128 * KST;
    const int hh = w >> 1, qhalf = w & 1, head = kvh * 4 + hh;
    const int fr = lane & 15, fq = lane >> 4;
    const int rowq0 = b * TPB + qb * 128 + qhalf * 64;
    bf16x8 qf[4][2];
#pragma unroll
    for (int qt = 0; qt < 4; ++qt) {
        const int row = rowq0 + qt * 16 + fr; const bf16_t* qp = P + (size_t)row * NP + PC_SQ + head * 64 + fq * 8;
        const u32x4 r1 = *(const u32x4*)qp, r2 = *(const u32x4*)(qp + 32);
        float a1[8], a2[8];
#pragma unroll
        for (int e = 0; e < 4; ++e) { a1[2 * e] = bflo(r1[e]); a1[2 * e + 1] = bfhi(r1[e]); a2[2 * e] = bflo(r2[e]); a2[2 * e + 1] = bfhi(r2[e]); }
        if (!qctx) { const int t = (qb - 2) * 128 + qhalf * 64 + qt * 16 + fr; const float* cp = rc + t * 32 + fq * 8; const float* sp = rs + t * 32 + fq * 8;
#pragma unroll
            for (int e = 0; e < 8; ++e) { const float cs = cp[e], sn = sp[e]; const float o1 = a1[e] * cs - a2[e] * sn, o2 = a1[e] * sn + a2[e] * cs; a1[e] = o1; a2[e] = o2; } }
        u32x4 o1, o2;
#pragma unroll
        for (int e = 0; e < 4; ++e) { o1[e] = pk2(a1[2 * e] * 0.125f, a1[2 * e + 1] * 0.125f); o2[e] = pk2(a2[2 * e] * 0.125f, a2[2 * e + 1] * 0.125f); }
        qf[qt][0] = __builtin_bit_cast(bf16x8, o1); qf[qt][1] = __builtin_bit_cast(bf16x8, o2);
    }
    const float sink = p.swa_sink[l * 8 + head];
    float mrun[4], lrun[4]; f32x4 O[4][4];
#pragma unroll
    for (int qt = 0; qt < 4; ++qt) { mrun[qt] = sink; lrun[qt] = 1.f;
#pragma unroll
        for (int dv = 0; dv < 4; ++dv) O[qt][dv] = (f32x4){0.f, 0.f, 0.f, 0.f}; }
    for (int ki = 0; ki < 5; ++ki) {
        int blk, rel; bool valid, local;
        if (qctx) { blk = ki; valid = ki < 2; local = false; rel = 0; }
        else if (ki < 3) { blk = qb - 1 + ki; valid = blk >= 2 && blk <= 17; local = true; rel = ki - 1; }
        else { blk = ki - 3; valid = true; local = false; rel = 0; }
        if (!valid) continue;
        const int rowk0 = b * TPB + blk * 128;
        {
            const int key = tid >> 2, g = tid & 3; const bf16_t* kp = P + (size_t)(rowk0 + key) * NP + PC_SK + kvh * 64 + g * 8;
            const u32x4 r1 = *(const u32x4*)kp, r2 = *(const u32x4*)(kp + 32);
            u32x4 o1 = r1, o2 = r2;
            if (local) { float a1[8], a2[8];
#pragma unroll
                for (int e = 0; e < 4; ++e) { a1[2 * e] = bflo(r1[e]); a1[2 * e + 1] = bfhi(r1[e]); a2[2 * e] = bflo(r2[e]); a2[2 * e + 1] = bfhi(r2[e]); }
                const int t = (blk - 2) * 128 + key; const float* cp = rc + t * 32 + g * 8; const float* sp = rs + t * 32 + g * 8;
#pragma unroll
                for (int e = 0; e < 8; ++e) { const float cs = cp[e], sn = sp[e]; const float x1 = a1[e] * cs - a2[e] * sn, x2 = a1[e] * sn + a2[e] * cs; a1[e] = x1; a2[e] = x2; }
#pragma unroll
                for (int e = 0; e < 4; ++e) { o1[e] = pk2(a1[2 * e], a1[2 * e + 1]); o2[e] = pk2(a2[2 * e], a2[2 * e + 1]); } }
            *(LAS u32x4*)(Ks + key * KST + g * 8) = o1; *(LAS u32x4*)(Ks + key * KST + 32 + g * 8) = o2;
#pragma unroll
            for (int it = 0; it < 2; ++it) { const int idx = tid + NTHR * it; const int vk = idx >> 3, vg = idx & 7;
                const u32x4 rv = *(const u32x4*)(P + (size_t)(rowk0 + vk) * NP + PC_SV + kvh * 64 + vg * 8);
#pragma unroll
                for (int e = 0; e < 4; ++e) { Vt[(vg * 8 + 2 * e) * VST + vk] = (bf16_t)(rv[e] & 0xffffu); Vt[(vg * 8 + 2 * e + 1) * VST + vk] = (bf16_t)(rv[e] >> 16); } }
        }
        __syncthreads();
#pragma unroll
        for (int qt = 0; qt < 4; ++qt) {
            f32x4 Sx[8];
#pragma unroll
            for (int kt = 0; kt < 8; ++kt) { Sx[kt] = (f32x4){0.f, 0.f, 0.f, 0.f};
#pragma unroll
                for (int kk = 0; kk < 2; ++kk) { const bf16x8 A = *(const LAS bf16x8*)(Ks + (kt * 16 + fr) * KST + kk * 32 + fq * 8);
                    Sx[kt] = __builtin_amdgcn_mfma_f32_16x16x32_bf16(A, qf[qt][kk], Sx[kt], 0, 0, 0); } }
            if (rel != 0) { int qi = qhalf * 64 + qt * 16 + fr; asm volatile("" : "+v"(qi));
#pragma unroll
                for (int kt = 0; kt < 8; ++kt)
#pragma unroll
                    for (int j = 0; j < 4; ++j) { const int kx = kt * 16 + fq * 4 + j; const bool ok = rel < 0 ? (kx >= qi) : (kx <= qi); if (!ok) Sx[kt][j] = -1e30f; } }
            float mx = -1e30f;
#pragma unroll
            for (int kt = 0; kt < 8; ++kt) mx = fmaxf(mx, fmaxf(fmaxf(Sx[kt][0], Sx[kt][1]), fmaxf(Sx[kt][2], Sx[kt][3])));
            mx = xrow16_max(mx);
            const float mnew = fmaxf(mrun[qt], mx); const float alpha = __expf(mrun[qt] - mnew); mrun[qt] = mnew;
            float rsum = 0.f;
#pragma unroll
            for (int kt = 0; kt < 8; ++kt)
#pragma unroll
                for (int j = 0; j < 4; ++j) { const float e = __expf(Sx[kt][j] - mnew); Sx[kt][j] = e; rsum += e; }
            rsum = xrow16_sum(rsum);
            lrun[qt] = lrun[qt] * alpha + rsum;
#pragma unroll
            for (int dv = 0; dv < 4; ++dv) O[qt][dv] = O[qt][dv] * alpha;
#pragma unroll
            for (int ks2 = 0; ks2 < 4; ++ks2) {
                u32x4 pb; pb[0] = pk2(Sx[2 * ks2][0], Sx[2 * ks2][1]); pb[1] = pk2(Sx[2 * ks2][2], Sx[2 * ks2][3]); pb[2] = pk2(Sx[2 * ks2 + 1][0], Sx[2 * ks2 + 1][1]); pb[3] = pk2(Sx[2 * ks2 + 1][2], Sx[2 * ks2 + 1][3]);
                const bf16x8 Bp = __builtin_bit_cast(bf16x8, pb);
#pragma unroll
                for (int dv = 0; dv < 4; ++dv) { const LAS bf16_t* vp = Vt + (dv * 16 + fr) * VST + ks2 * 32 + fq * 4;
                    const u32x2 lo = *(const LAS u32x2*)vp, hi = *(const LAS u32x2*)(vp + 16);
                    u32x4 av; av[0] = lo[0]; av[1] = lo[1]; av[2] = hi[0]; av[3] = hi[1];
                    O[qt][dv] = __builtin_amdgcn_mfma_f32_16x16x32_bf16(__builtin_bit_cast(bf16x8, av), Bp, O[qt][dv], 0, 0, 0); }
            }
        }
        __syncthreads();
    }
#pragma unroll
    for (int qt = 0; qt < 4; ++qt) { const float inv = 1.f / lrun[qt]; const int row = rowq0 + qt * 16 + fr;
#pragma unroll
        for (int dv = 0; dv < 4; ++dv) { u32x2 o2; o2[0] = pk2(O[qt][dv][0] * inv, O[qt][dv][1] * inv); o2[1] = pk2(O[qt][dv][2] * inv, O[qt][dv][3] * inv);
            *(u32x2*)(Y + (size_t)row * D + 256 + head * 64 + dv * 16 + fq * 4) = o2; } }
}

__device__ __forceinline__ void phase_mixers(const Params& p, int l, LAS unsigned char* lds, const int wvs) {
    for (int s = blockIdx.x; s < 256; s += gridDim.x) { if (s < 128) dn_seq(p, l, s, lds, wvs); else hg_seq(p, l, s - 128, lds, wvs); }
    unsigned* ctr = (unsigned*)(p.ws + WS_CTL) + 64 * (1 + l);
    LAS int* su = (LAS int*)(lds + 140 * 1024);
    for (;;) {
        __syncthreads();
        if (wvs == 0 && lane_id_fresh() == 0) su[0] = (int)atomicAdd(ctr, 1u);
        __syncthreads();
        const int unit = su[0];
        if (unit >= 576) break;
        swa_unit(p, l, unit, lds, wvs);
    }
}

__device__ __forceinline__ void phase_finalize(const Params& p, int l, const int wvs) {
    const int tid = wvs * 64 + lane_id_fresh(); const int lane = tid & 63, w = tid >> 6;
    const int gw = blockIdx.x * NWAVES + w, NGW = gridDim.x * NWAVES;
    const bf16_t* P = (const bf16_t*)(p.ws + WS_P);
    const bf16_t* OD0 = (const bf16_t*)(p.ws + WS_OD); const bf16_t* OD1 = OD0 + (size_t)M * 512;
    bf16_t* Y = (bf16_t*)(p.ws + WS_HY);
    const int seg = lane >> 3, d0 = (lane & 7) * 8;
    const int hd = seg & 3; const bool isdn = seg < 4;
    const float* gain = (isdn ? p.dn_norm : p.hg_norm) + l * 64 + d0;
    const f32x4 g0 = *(const f32x4*)gain, g1 = *(const f32x4*)(gain + 4);
    const int ocol = (isdn ? 0 : 256) + hd * 64 + d0, gcol = (isdn ? PC_DNG : PC_HG) + hd * 64 + d0, ycol = (isdn ? 0 : 768) + hd * 64 + d0;
    for (int r = gw; r < M; r += NGW) {
        const u32x4 a = *(const u32x4*)(OD0 + (size_t)r * 512 + ocol), bq = *(const u32x4*)(OD1 + (size_t)r * 512 + ocol), gt = *(const u32x4*)(P + (size_t)r * NP + gcol);
        float o[8]; float ss = 0.f;
#pragma unroll
        for (int e = 0; e < 4; ++e) { o[2 * e] = bflo(a[e]) + bflo(bq[e]); o[2 * e + 1] = bfhi(a[e]) + bfhi(bq[e]); ss += o[2 * e] * o[2 * e] + o[2 * e + 1] * o[2 * e + 1]; }
        ss = sum8(ss);
        const float rms = rsqrtf(ss * (1.f / 64.f) + EPS);
        u32x4 y;
#pragma unroll
        for (int e = 0; e < 4; ++e) { const float ga = bflo(gt[e]), gb = bfhi(gt[e]);
            const float ge0 = e < 2 ? g0[2 * e] : g1[2 * e - 4], ge1 = e < 2 ? g0[2 * e + 1] : g1[2 * e - 3];
            y[e] = pk2(o[2 * e] * rms * ge0 * siluf(ga), o[2 * e + 1] * rms * ge1 * siluf(gb)); }
        *(u32x4*)(Y + (size_t)r * D + ycol) = y;
    }
}

__device__ __forceinline__ void phase_final(const Params& p, const int wvs) {
    const int tid = wvs * 64 + lane_id_fresh(); const int lane = tid & 63, w = tid >> 6;
    const int gw = blockIdx.x * NWAVES + w, NGW = gridDim.x * NWAVES;
    for (int r = gw; r < BATCH * SEQ; r += NGW) {
        f32x4* xr = (f32x4*)(p.out + ((size_t)r << 10)) + lane;
        f32x4 v[4]; float ss = 0.f;
#pragma unroll
        for (int j = 0; j < 4; ++j) { v[j] = xr[64 * j]; ss += (v[j][0] * v[j][0] + v[j][1] * v[j][1]) + (v[j][2] * v[j][2] + v[j][3] * v[j][3]); }
        const float rstd = rsqrtf(wave_sum(ss) * (1.f / D) + EPS);
#pragma unroll
        for (int j = 0; j < 4; ++j) { const f32x4 g = *(const f32x4*)(p.norm_f + 4 * (lane + 64 * j)); xr[64 * j] = v[j] * rstd * g; }
    }
}

#define XB_TMO      128
#define XB_XCNT(j)  (256  + 64 * (j))
#define XB_XSUB(j)  (1280 + 64 * (j))
#define XB_XGEN(j)  (2304 + 64 * (j))
#define XB_TOP      3328
#define XB_TOPGEN   3392
#define XCD_BAR_WORDS 3456
#define XB_SPIN_CAP (1u << 18)

__device__ __forceinline__ unsigned xb_ld(unsigned* p)              { return __hip_atomic_load(p, __ATOMIC_RELAXED, __HIP_MEMORY_SCOPE_AGENT); }
__device__ __forceinline__ unsigned xb_add(unsigned* p, unsigned v) { return __hip_atomic_fetch_add(p, v, __ATOMIC_RELAXED, __HIP_MEMORY_SCOPE_AGENT); }
__device__ __forceinline__ unsigned xb_xcc_id() { return (unsigned)__builtin_amdgcn_s_getreg((3 << 11) | 20) & 0xFu; }
#define XB_SPIN(cond, bar) do { unsigned _sp = 0; while (cond) { __builtin_amdgcn_s_sleep(1); \
    if ((++_sp & 255u) == 0u) { if (xb_ld(&(bar)[XB_TMO])) break; if (_sp > XB_SPIN_CAP) { atomicAdd(&(bar)[XB_TMO], 1u); break; } } } } while (0)

struct XcdBarrier {
    unsigned* bar; unsigned x;
    volatile LAS unsigned* st;
};

__device__ __forceinline__ XcdBarrier xcd_barrier_post(unsigned* bar, volatile LAS unsigned* st) {
    XcdBarrier b; b.bar = bar; b.x = xb_xcc_id(); b.st = st;
    if (threadIdx.x == 0) (void)xb_add(&bar[XB_XCNT(b.x)], 1u);
    return b;
}
__device__ __forceinline__ void xcd_barrier_complete(unsigned* bar, unsigned x, unsigned& nloc, unsigned& nx) {
    const unsigned G = gridDim.x * gridDim.y * gridDim.z;
    unsigned sum, cnt, mine, sp = 0u;
    for (;;) {
        sum = 0u; cnt = 0u; mine = 0u;
#pragma unroll
        for (unsigned j = 0; j < 16; ++j) { const unsigned c = xb_ld(&bar[XB_XCNT(j)]); sum += c; cnt += (c > 0u) ? 1u : 0u; mine = (j == x) ? c : mine; }
        if (sum == G) break;
        __builtin_amdgcn_s_sleep(1);
        if ((++sp & 255u) == 0u) { if (xb_ld(&bar[XB_TMO])) break; if (sp > XB_SPIN_CAP) { atomicAdd(&bar[XB_TMO], 1u); break; } }
    }
    nloc = mine > 0u ? mine : 1u; nx = cnt > 0u ? cnt : 1u;
}

__device__ __forceinline__ void xcd_barrier(const XcdBarrier& b) {
    asm volatile("s_waitcnt vmcnt(0)" ::: "memory");
    __syncthreads();
    if (threadIdx.x == 0) {
        unsigned* bar = b.bar;
        __builtin_amdgcn_s_waitcnt(0);
        unsigned nloc = b.st[0], nx = b.st[1];
        if (nloc == 0u) { xcd_barrier_complete(bar, b.x, nloc, nx); b.st[0] = nloc; b.st[1] = nx; }
        const unsigned old = xb_add(&bar[XB_XSUB(b.x)], 1u);
        const unsigned gen = old / nloc;
        if (old + 1u == (gen + 1u) * nloc) {
            __builtin_amdgcn_fence(__ATOMIC_RELEASE, "agent");
            asm volatile("s_waitcnt vmcnt(0)" ::: "memory");
            const unsigned og = xb_add(&bar[XB_TOP], 1u);
            const unsigned tg = og / nx;
            if (og + 1u == (tg + 1u) * nx) xb_add(&bar[XB_TOPGEN], 1u);
            else XB_SPIN(xb_ld(&bar[XB_TOPGEN]) == tg, bar);
            __builtin_amdgcn_fence(__ATOMIC_ACQUIRE, "agent");
            xb_add(&bar[XB_XGEN(b.x)], 1u);
            asm volatile("s_waitcnt vmcnt(0)" ::: "memory");
        } else {
            XB_SPIN(xb_ld(&bar[XB_XGEN(b.x)]) == gen, bar);
            __builtin_amdgcn_fence(__ATOMIC_ACQUIRE, "agent");
            asm volatile("s_waitcnt vmcnt(0)" ::: "memory");
        }
    }
    __syncthreads();
}

__device__ __forceinline__ void gsync(cg::grid_group& grid) {
    asm volatile("s_waitcnt vmcnt(0) lgkmcnt(0)" ::: "memory");
    grid.sync();
    __builtin_amdgcn_fence(__ATOMIC_ACQUIRE, "agent");
    asm volatile("s_waitcnt vmcnt(0)" ::: "memory");
}
__global__ void __launch_bounds__(NTHR, 2) fwd_megakernel(Params p) {
    extern __shared__ __attribute__((aligned(16))) unsigned char lds_raw[];
    LAS unsigned char* lds = (LAS unsigned char*)lds_raw;
    cg::grid_group grid = cg::this_grid();
    const int G = gridDim.x, c = blockIdx.x;
    const int wvs = __builtin_amdgcn_readfirstlane((int)(threadIdx.x >> 6));
    { volatile LAS unsigned* st0 = (volatile LAS unsigned*)(lds + 143360 + 64); if (threadIdx.x < 2) st0[threadIdx.x] = 0u; }
    __syncthreads();
    const XcdBarrier xbar = xcd_barrier_post((unsigned*)(p.ws + WS_CTL) + 4096, (volatile LAS unsigned*)(lds + 143360 + 64));
    phase_prologue(p, lds, wvs);
    gsync(grid);
    const float* mods = (const float*)(p.ws + WS_MODS);
    float* Xc = (float*)(p.ws + WS_XC);
    bf16_t* HY = (bf16_t*)(p.ws + WS_HY); bf16_t* PB = (bf16_t*)(p.ws + WS_P);
    for (int l = 0; l < DEPTH; ++l) {
        phase_norm<true>(p, l, lds, wvs);
        xcd_barrier(xbar);
        { pg8::Gemm g{HY, (const bf16_t*)(p.ws + WS_WIN), M, NP, D}; pg8::StaticOrder S; S.init(M, NP, G, c); pg8::EpiBf16<0> E{PB, NP};
          pg8::gemm_phase<pg8::EpiBf16<0>, pg8::StaticOrder, true, true>(lds, g, S, E, wvs); }
        xcd_barrier(xbar);
        phase_mixers(p, l, lds, wvs);
        xcd_barrier(xbar);
        phase_finalize(p, l, wvs);
        xcd_barrier(xbar);
        { pg8::Gemm g{HY, (const bf16_t*)(p.ws + WS_WOUT), M, D, D}; pg8::StaticOrder S; S.init(M, D, G, c); pg8::EpiRes E{p.out, Xc, mods + ((size_t)l * 17 * 6 + 2) * 1024};
          pg8::gemm_phase<pg8::EpiRes, pg8::StaticOrder, true, true>(lds, g, S, E, wvs); }
        xcd_barrier(xbar);
        phase_norm<false>(p, l, lds, wvs);
        xcd_barrier(xbar);
        { pg8::Gemm g{HY, (const bf16_t*)(p.ws + WS_W1), M, DFF, D}; pg8::StaticOrder S; S.init(M, DFF, G, c); pg8::EpiBf16<1> E{PB, DFF};
          pg8::gemm_phase<pg8::EpiBf16<1>, pg8::StaticOrder, true, true>(lds, g, S, E, wvs); }
        xcd_barrier(xbar);
        { pg8::Gemm g{PB, (const bf16_t*)(p.ws + WS_W2), M, D, DFF}; pg8::StaticOrder S; S.init(M, D, G, c); pg8::EpiRes E{p.out, Xc, mods + ((size_t)l * 17 * 6 + 5) * 1024};
          pg8::gemm_phase<pg8::EpiRes, pg8::StaticOrder, true, true>(lds, g, S, E, wvs); }
        xcd_barrier(xbar);
    }
    phase_final(p, wvs);
}

extern "C" void kernel_launch(void* const* d_in, const int* in_sizes, int n_in, void* d_out, int out_size, void* d_ws, size_t ws_size, hipStream_t stream) {
    static int grid = 0;
    if (grid == 0) {
        if (n_in != 20 || ws_size < WS_END) { fprintf(stderr, "kernel_launch: need 20 inputs and >= %zu bytes of workspace (got %d, %zu)\n", (size_t)WS_END, n_in, ws_size); grid = -1; return; }
        int dev = 0, cus = 0, per_cu = 0;
        hipGetDevice(&dev); hipDeviceGetAttribute(&cus, hipDeviceAttributeMultiprocessorCount, dev);
        if (hipFuncSetAttribute((const void*)fwd_megakernel, hipFuncAttributeMaxDynamicSharedMemorySize, LDS_BYTES) != hipSuccess) { fprintf(stderr, "kernel_launch: hipFuncSetAttribute failed\n"); grid = -1; return; }
        if (hipOccupancyMaxActiveBlocksPerMultiprocessor(&per_cu, (const void*)fwd_megakernel, NTHR, LDS_BYTES) != hipSuccess || per_cu < 1) { fprintf(stderr, "kernel_launch: occupancy query says %d blocks/CU\n", per_cu); per_cu = 1; }
        (void)hipGetLastError();
        grid = cus;
    }
    if (grid < 0) return;
    hipMemsetAsync((char*)d_ws + WS_CTL, 0, 65536, stream);
    Params p{};
    const float** pp = (const float**)&p;
    for (int i = 0; i < 20; ++i) pp[i] = (const float*)d_in[i];
    p.out = (float*)d_out; p.ws = (unsigned char*)d_ws;
    void* args[] = {&p};
    hipError_t e = hipLaunchCooperativeKernel((const void*)fwd_megakernel, dim3(grid), dim3(NTHR), args, LDS_BYTES, stream);
    if (e != hipSuccess) fprintf(stderr, "cooperative launch failed: %s (grid %d)\n", hipGetErrorString(e), grid);
}
```

```cpp
#include <hip/hip_runtime.h>
#include <hip/hip_cooperative_groups.h>
#include <cstdio>
#include <cstdint>
namespace cg = cooperative_groups;

__device__ __forceinline__ int lane_id_fresh() { unsigned m = ~0u; asm volatile("" : "+s"(m)); return (int)__builtin_amdgcn_mbcnt_hi(m, __builtin_amdgcn_mbcnt_lo(m, 0u)); }
namespace pg8 {
#define PG8_LAS __attribute__((address_space(3)))
typedef unsigned short bf16_t;
typedef short bf16x8 __attribute__((ext_vector_type(8)));
typedef float f32x4 __attribute__((ext_vector_type(4)));
typedef unsigned u32x4 __attribute__((ext_vector_type(4)));
constexpr int BM = 256, BK = 64, HALF = 128, HTB = HALF * BK * 2  , STAGE_BYTES = 8 * HTB, NXCD = 8, WGM = 8;

__host__ __device__ __forceinline__ int lds_byte(int r, int c) { const int st = (r >> 4) * 2 + (c >> 5), rr = r & 15, cc = c & 31, ob = rr * 64 + cc * 2; return st * 1024 + (ob ^ (((ob >> 9) & 1) << 5)); }
__host__ __device__ __forceinline__ void stage_rc(int b, int& R, int& C) { const int st = b / 1024, sb = b % 1024, swz = sb ^ (((sb >> 9) & 1) << 5); R = (st >> 1) * 16 + swz / 64; C = (st & 1) * 32 + (swz % 64) / 2; }
__host__ __device__ __forceinline__ int perm32(int rho) { const int n = rho >> 4, i = rho & 15; return 8 * (i >> 2) + 4 * n + (i & 3); }

struct Unit { int pm, pn; };
struct Gemm { const bf16_t* A; const bf16_t* Bt; int M, N, K; };

struct StaticOrder {
    int nM, nN, nwg, G, c;
    __host__ __device__ void init(int M, int N, int G_, int c_) { nM = M / BM; nN = N / BM; nwg = nM * nN; G = G_; c = c_; }
    __host__ __device__ bool next(int i, Unit& u) const {
        const long L = (long)i * G + c; if (L >= nwg) return false;
        int wgid = (int)L; { const int q = nwg / NXCD, r = nwg % NXCD, xcd = wgid % NXCD, off = wgid / NXCD; wgid = (xcd < r ? xcd * (q + 1) : r * (q + 1) + (xcd - r) * q) + off; }
        const int nig = WGM * nN, gid = wgid / nig, fm = gid * WGM, gsz = (nM - fm) < WGM ? (nM - fm) : WGM;
        u.pm = fm + ((wgid % nig) % gsz); u.pn = (wgid % nig) / gsz; return true;
    }
    __device__ __forceinline__ void a_ready(const Unit&) const {}
    __device__ __forceinline__ void done(const Unit&) const {}
};

struct Order2 {
    StaticOrder so; int lat;
    __host__ __device__ void init(int N, int G_, int c_, int lat_) { lat = lat_; so.init(lat_ ? 32768 : 36864, N, G_, c_); }
    __host__ __device__ bool next(int i, Unit& u) const { if (!so.next(i, u)) return false; if (lat) u.pm = (u.pm >> 3) * 9 + 1 + (u.pm & 7); return true; }
    __device__ __forceinline__ void a_ready(const Unit&) const {}
    __device__ __forceinline__ void done(const Unit&) const {}
};
__device__ __forceinline__ unsigned cvt_pk_bf16(float lo, float hi) { unsigned r; asm volatile("v_cvt_pk_bf16_f32 %0, %1, %2" : "=v"(r) : "v"(lo), "v"(hi)); return r; }

template <int ACT  > struct EpiBf16 {
    static constexpr bool PERM = true, AFTER_DRAIN = false;
    bf16_t* O; int ldc;
    __device__ __forceinline__ void operator()(const f32x4 (&acc)[2][2][4][2], const Unit& u, int wr, int wc, int fr, int fq) const {
        const int row0 = u.pm * BM + wr * 64 + fr; const int col0 = u.pn * BM + wc * 32 + 8 * fq;
#pragma unroll
        for (int ai = 0; ai < 2; ++ai)
#pragma unroll
            for (int m = 0; m < 4; ++m) { bf16_t* rowp = O + (size_t)(row0 + ai * HALF + m * 16) * ldc + col0;
#pragma unroll
                for (int bj = 0; bj < 2; ++bj) { f32x4 v0 = acc[ai][bj][m][0], v1 = acc[ai][bj][m][1];
                    if (ACT == 1) {
#pragma unroll
                        for (int e = 0; e < 4; ++e) { float a = fmaxf(v0[e], 0.f), b = fmaxf(v1[e], 0.f); v0[e] = a * a; v1[e] = b * b; } }
                    u32x4 w; w.x = cvt_pk_bf16(v0[0], v0[1]); w.y = cvt_pk_bf16(v0[2], v0[3]); w.z = cvt_pk_bf16(v1[0], v1[1]); w.w = cvt_pk_bf16(v1[2], v1[3]);
                    *(u32x4*)(rowp + bj * HALF) = w; } }
    }
};
struct EpiRes {
    static constexpr bool PERM = false, AFTER_DRAIN = false;
    float* Xl; float* Xc; const float* gates;
    __device__ __forceinline__ void operator()(const f32x4 (&acc)[2][2][4][2], const Unit& u, int wr, int wc, int fr, int fq) const {
        const int b = u.pm / 9, tt = u.pm - b * 9;
        float* base = (tt == 0) ? Xc + ((size_t)(b * 256) << 10) : Xl + ((size_t)(b * 2048 + (tt - 1) * 256) << 10);
        const float* g = gates + (size_t)((tt == 0) ? 16 : b) * 6144;
        const int col0 = u.pn * BM + wc * 32 + 4 * fq;
        float* rp0 = base + ((size_t)(wr * 64 + fr) << 10) + col0;
#pragma unroll
        for (int bj = 0; bj < 2; ++bj)
#pragma unroll
            for (int n = 0; n < 2; ++n) { const f32x4 gvv = *(const f32x4*)(g + col0 + bj * HALF + n * 16);
#pragma unroll
                for (int ai = 0; ai < 2; ++ai) {
#pragma unroll
                    for (int m = 0; m < 4; ++m) { f32x4* pp = (f32x4*)(rp0 + (size_t)(ai * HALF + m * 16) * 1024 + bj * HALF + n * 16); f32x4 xv = *pp; xv = xv + gvv * acc[ai][bj][m][n]; *pp = xv; }
                    asm volatile("" ::: "memory"); } }
    }
};
template <class Epi, class Sched, bool ALIGN_EPI = false, bool SP2 = false>
__device__ __forceinline__ void gemm_phase(PG8_LAS unsigned char* lds, const Gemm g, const Sched& S, const Epi& E, const int wvs) {
    const int tid = wvs * 64 + lane_id_fresh(); const int wid = __builtin_amdgcn_readfirstlane(tid >> 6), lane = tid & 63, wr = wid >> 2, wc = wid & 3, fr = lane & 15, fq = lane >> 4;
    const int K = g.K, nt = K / BK;
    unsigned voffA[2], voffB[2];
#pragma unroll
    for (int i = 0; i < 2; ++i) { int R, C; stage_rc(tid * 16 + i * 8192, R, C); const int Rb = Epi::PERM ? ((R & ~31) + perm32(R & 31)) : R;
        voffA[i] = (unsigned)(R * K + C) * 2u; voffB[i] = (unsigned)(Rb * K + C) * 2u; }
    const size_t kstep = (size_t)(BK * 2);
    const size_t hstep = (size_t)HALF * K * 2;
    const size_t tstep = 2 * hstep;
    const unsigned ldsw = (unsigned)wid * 1024u;
    const int aoff = lds_byte(wr * 64 + fr, fq * 8), boff = lds_byte(wc * 32 + fr, fq * 8);
#define PG8_SA(b, h) (((b) * 2 + (h)) * HTB)
#define PG8_SB(b, h) ((4 + (b) * 2 + (h)) * HTB)
#define PG8_STAGE(bufoff, gbase, voff) do { _Pragma("unroll") for (int _i = 0; _i < 2; ++_i) \
        __builtin_amdgcn_global_load_lds((const unsigned*)((const char*)(gbase) + (voff)[_i]), (PG8_LAS unsigned*)(lds + (bufoff) + ldsw + _i * 8192), 16, 0, 0); } while (0)
#define PG8_LDA(dst, b, h) do { _Pragma("unroll") for (int m = 0; m < 4; ++m) _Pragma("unroll") for (int k = 0; k < 2; ++k) dst[m][k] = *(const PG8_LAS bf16x8*)(lds + PG8_SA(b, h) + aoff + m * 2048 + k * 1024); } while (0)
#define PG8_LDB(dst, b, h) do { _Pragma("unroll") for (int n = 0; n < 2; ++n) _Pragma("unroll") for (int k = 0; k < 2; ++k) dst[n][k] = *(const PG8_LAS bf16x8*)(lds + PG8_SB(b, h) + boff + n * 2048 + k * 1024); } while (0)
#define PG8_MMA(ai, bj, At, Bt) do { __builtin_amdgcn_s_setprio(1); _Pragma("unroll") for (int m = 0; m < 4; ++m) _Pragma("unroll") for (int n = 0; n < 2; ++n) _Pragma("unroll") for (int k = 0; k < 2; ++k) \
        acc[ai][bj][m][n] = __builtin_amdgcn_mfma_f32_16x16x32_bf16(Bt[n][k], At[m][k], acc[ai][bj][m][n], 0, 0, 0); __builtin_amdgcn_s_setprio(0); } while (0)
#define PG8_WAIT_V(n) asm volatile("s_waitcnt vmcnt(" #n ")" ::: "memory")
#define PG8_WAIT_L(n) asm volatile("s_waitcnt lgkmcnt(" #n ")" ::: "memory")
#define PG8_BAR __builtin_amdgcn_s_barrier()
#define PG8_SCHED __builtin_amdgcn_sched_barrier(0)
    Unit cur, nxt; int ui = 0;
    if (!S.next(0, cur)) return;
    f32x4 acc[2][2][4][2];
#pragma unroll
    for (int a = 0; a < 2; ++a)
#pragma unroll
        for (int b = 0; b < 2; ++b)
#pragma unroll
            for (int m = 0; m < 4; ++m)
#pragma unroll
                for (int n = 0; n < 2; ++n) acc[a][b][m][n] = (f32x4){0.f, 0.f, 0.f, 0.f};
    bf16x8 At[4][2], B0[2][2], B1[2][2];
    const char* cA = (const char*)g.A + (size_t)cur.pm * tstep; const char* cB = (const char*)g.Bt + (size_t)cur.pn * tstep;
    S.a_ready(cur);
    if constexpr (SP2) {
        PG8_STAGE(PG8_SB(0, 0), cB, voffB); PG8_STAGE(PG8_SB(0, 1), cB + hstep, voffB); PG8_STAGE(PG8_SA(0, 0), cA, voffA); PG8_STAGE(PG8_SA(0, 1), cA + hstep, voffA);
        if (wr == 1) PG8_BAR;
        PG8_WAIT_V(2); PG8_BAR;
        PG8_STAGE(PG8_SB(1, 0), cB + kstep, voffB); PG8_STAGE(PG8_SA(1, 0), cA + kstep, voffA); PG8_STAGE(PG8_SB(1, 1), cB + hstep + kstep, voffB);
        PG8_WAIT_V(6); PG8_BAR;
    } else {
        PG8_STAGE(PG8_SB(0, 0), cB, voffB); PG8_STAGE(PG8_SA(0, 0), cA, voffA); PG8_STAGE(PG8_SB(0, 1), cB + hstep, voffB); PG8_STAGE(PG8_SA(0, 1), cA + hstep, voffA);
        if (wr == 1) PG8_BAR;
        PG8_WAIT_V(4); PG8_BAR;
        PG8_STAGE(PG8_SB(1, 0), cB + kstep, voffB); PG8_STAGE(PG8_SA(1, 0), cA + kstep, voffA); PG8_STAGE(PG8_SB(1, 1), cB + hstep + kstep, voffB);
        PG8_WAIT_V(6); PG8_BAR;
    }
    for (;;) {
        const bool has_next = S.next(ui + 1, nxt);
        const char* nA = has_next ? (const char*)g.A + (size_t)nxt.pm * tstep : cA; const char* nB = has_next ? (const char*)g.Bt + (size_t)nxt.pn * tstep : cB;
        for (int t = 0; t < nt; t += 2) {
            const bool last = (t == nt - 2);
            const char* a1 = cA + (size_t)(t + 1) * kstep;
            const char* a2 = last ? nA : cA + (size_t)(t + 2) * kstep; const char* b2 = last ? nB : cB + (size_t)(t + 2) * kstep;
            const char* a3 = a2 + kstep; const char* b3 = b2 + kstep;
            if (last && has_next) S.a_ready(nxt);
            if constexpr (SP2) {
            PG8_LDB(B0, 0, 0); PG8_LDB(B1, 0, 1); PG8_SCHED; PG8_LDA(At, 0, 0); PG8_STAGE(PG8_SA(1, 1), a1 + hstep, voffA);
            PG8_WAIT_V(8); PG8_WAIT_L(0); PG8_BAR; PG8_MMA(0, 0, At, B0); PG8_MMA(0, 1, At, B1); PG8_BAR; PG8_SCHED;
            PG8_LDA(At, 0, 1); PG8_STAGE(PG8_SB(0, 0), b2, voffB); PG8_STAGE(PG8_SB(0, 1), b2 + hstep, voffB); PG8_STAGE(PG8_SA(0, 0), a2, voffA);
            PG8_WAIT_V(8); PG8_WAIT_L(0); PG8_BAR; PG8_MMA(1, 0, At, B0); PG8_MMA(1, 1, At, B1); PG8_BAR; PG8_SCHED;
            PG8_LDB(B0, 1, 0); PG8_LDB(B1, 1, 1); PG8_SCHED; PG8_LDA(At, 1, 0); PG8_STAGE(PG8_SA(0, 1), a2 + hstep, voffA);
            PG8_WAIT_V(8); PG8_WAIT_L(0); PG8_BAR; PG8_MMA(0, 0, At, B0); PG8_MMA(0, 1, At, B1); PG8_BAR; PG8_SCHED;
            PG8_LDA(At, 1, 1); PG8_STAGE(PG8_SB(1, 0), b3, voffB); PG8_STAGE(PG8_SB(1, 1), b3 + hstep, voffB); PG8_STAGE(PG8_SA(1, 0), a3, voffA);
            PG8_WAIT_V(8); PG8_WAIT_L(0); PG8_BAR; PG8_MMA(1, 0, At, B0); PG8_MMA(1, 1, At, B1); PG8_BAR; PG8_SCHED;
            } else {
            PG8_LDB(B0, 0, 0); PG8_SCHED; PG8_LDA(At, 0, 0); PG8_STAGE(PG8_SA(1, 1), a1 + hstep, voffA);
            PG8_WAIT_L(8); PG8_BAR; PG8_WAIT_L(0); PG8_MMA(0, 0, At, B0); PG8_BAR; PG8_SCHED;
            PG8_LDB(B1, 0, 1); PG8_STAGE(PG8_SB(0, 0), b2, voffB);
            PG8_BAR; PG8_WAIT_L(0); PG8_MMA(0, 1, At, B1); PG8_BAR;
            PG8_LDA(At, 0, 1); PG8_STAGE(PG8_SA(0, 0), a2, voffA);
            PG8_BAR; PG8_WAIT_L(0); PG8_MMA(1, 0, At, B0); PG8_BAR; PG8_SCHED;
            PG8_STAGE(PG8_SB(0, 1), b2 + hstep, voffB);
            PG8_WAIT_V(6); PG8_BAR; PG8_MMA(1, 1, At, B1); PG8_BAR;
            PG8_LDB(B0, 1, 0); PG8_SCHED; PG8_LDA(At, 1, 0); PG8_STAGE(PG8_SA(0, 1), a2 + hstep, voffA);
            PG8_WAIT_L(8); PG8_BAR; PG8_WAIT_L(0); PG8_MMA(0, 0, At, B0); PG8_BAR; PG8_SCHED;
            PG8_LDB(B1, 1, 1); PG8_STAGE(PG8_SB(1, 0), b3, voffB);
            PG8_BAR; PG8_WAIT_L(0); PG8_MMA(0, 1, At, B1); PG8_BAR;
            PG8_LDA(At, 1, 1); PG8_STAGE(PG8_SA(1, 0), a3, voffA);
            PG8_BAR; PG8_WAIT_L(0); PG8_MMA(1, 0, At, B0); PG8_BAR; PG8_SCHED;
            PG8_STAGE(PG8_SB(1, 1), b3 + hstep, voffB);
            PG8_WAIT_V(6); PG8_BAR; PG8_MMA(1, 1, At, B1); PG8_BAR;
            }
        }
        if constexpr (ALIGN_EPI) { if (wr == 0) PG8_BAR; }
        if constexpr (!Epi::AFTER_DRAIN) { E(acc, cur, wr, wc, fr, fq); S.done(cur); }
        if (!has_next) break;
#pragma unroll
        for (int a = 0; a < 2; ++a)
#pragma unroll
            for (int b = 0; b < 2; ++b)
#pragma unroll
                for (int m = 0; m < 4; ++m)
#pragma unroll
                    for (int n = 0; n < 2; ++n) acc[a][b][m][n] = (f32x4){0.f, 0.f, 0.f, 0.f};
        cur = nxt; cA = nA; cB = nB; ++ui;
        if constexpr (ALIGN_EPI) { if (wr == 1) PG8_BAR; }
    }
    PG8_WAIT_V(0);
    if constexpr (!ALIGN_EPI) { if (wr == 0) PG8_BAR; }
    PG8_BAR;
    if constexpr (Epi::AFTER_DRAIN) { E.fused(acc, cur, wr, wc, fr, fq, lds, wid, lane); S.done(cur); }
#undef PG8_SA
#undef PG8_SB
#undef PG8_STAGE
#undef PG8_LDA
#undef PG8_LDB
#undef PG8_MMA
#undef PG8_WAIT_V
#undef PG8_WAIT_L
#undef PG8_BAR
#undef PG8_SCHED
}
}

constexpr int D = 1024, BATCH = 16, SEQ = 2048, CTX = 256, DEPTH = 4;
constexpr int TPB = CTX + SEQ;
constexpr int M = BATCH * TPB;
constexpr int DIN = 3088, NP = 3072, DFF = 4096;
constexpr int PC_DNQ = 0, PC_DNG = 768, PC_SQ = 1024, PC_SK = 1536, PC_SV = 1664, PC_HQ = 1792, PC_HF = 2048, PC_HI = 2560, PC_HG = 2816;
constexpr float EPS = 1e-6f;
constexpr size_t MiB = 1u << 20;
constexpr size_t WS_CTL = 0, WS_MODS = 1 * MiB, WS_ROPE = 3 * MiB, WS_LB = 3 * MiB + 512 * 1024, WS_AB = 4 * MiB;
constexpr size_t WS_WIN = 7 * MiB, WS_WOUT = 13 * MiB, WS_W1 = 15 * MiB, WS_W2 = 23 * MiB, WS_XC = 32 * MiB, WS_HY = 48 * MiB, WS_P = 120 * MiB;
constexpr size_t WS_OD = WS_P + 216 * MiB, WS_END = WS_P + 288 * MiB;
constexpr int LDS_BYTES = 147456;
constexpr int NWAVES = 8, NTHR = 512;

#define LAS __attribute__((address_space(3)))
typedef unsigned short bf16_t;
typedef float f32x4 __attribute__((ext_vector_type(4)));
typedef short bf16x8 __attribute__((ext_vector_type(8)));
typedef short s16x4 __attribute__((ext_vector_type(4)));
typedef unsigned u32x4 __attribute__((ext_vector_type(4)));
typedef unsigned u32x2 __attribute__((ext_vector_type(2)));

struct Params {
    const float *x, *c, *ctx, *c_ctx, *w_ada, *b_ada, *norm1, *norm2, *w_in, *dn_conv, *dn_A_log, *dn_dt_bias, *dn_norm, *swa_sink, *hg_lb, *hg_norm, *w_out, *w_ff1, *w_ff2, *norm_f;
    float* out; unsigned char* ws;
};

__device__ __forceinline__ float bflo(unsigned u) { return __uint_as_float(u << 16); }
__device__ __forceinline__ float bfhi(unsigned u) { return __uint_as_float(u & 0xffff0000u); }
__device__ __forceinline__ unsigned pk2(float lo, float hi) { return pg8::cvt_pk_bf16(lo, hi); }
__device__ __forceinline__ bf16_t bf1(float f) { unsigned u = __float_as_uint(f); u += 0x7fffu + ((u >> 16) & 1u); return (bf16_t)(u >> 16); }
__device__ __forceinline__ float siluf(float v) { return v / (1.f + __expf(-v)); }
__device__ __forceinline__ float sigmf(float v) { return 1.f / (1.f + __expf(-v)); }
__device__ __forceinline__ float wave_sum(float v) {
#pragma unroll
    for (int o = 1; o < 64; o <<= 1) v += __shfl_xor(v, o);
    return v;
}
template <int CTRL> __device__ __forceinline__ float dpp(float x) { return __builtin_bit_cast(float, __builtin_amdgcn_mov_dpp(__builtin_bit_cast(int, x), CTRL, 0xf, 0xf, true)); }
constexpr int XOR1 = 0xB1, XOR2 = 0x4E, XOR7 = 0x141;
__device__ __forceinline__ float sum8(float v) { v += dpp<XOR1>(v); v += dpp<XOR2>(v); v += dpp<XOR7>(v); return v; }
__device__ __forceinline__ float xrow16_max(float x) {
    auto s = __builtin_amdgcn_permlane16_swap(__float_as_uint(x), __float_as_uint(x), false, false);
    x = fmaxf(__uint_as_float(s[0]), __uint_as_float(s[1]));
    auto t = __builtin_amdgcn_permlane32_swap(__float_as_uint(x), __float_as_uint(x), false, false);
    return fmaxf(__uint_as_float(t[0]), __uint_as_float(t[1]));
}
__device__ __forceinline__ float xrow16_sum(float x) {
    auto s = __builtin_amdgcn_permlane16_swap(__float_as_uint(x), __float_as_uint(x), false, false);
    x = __uint_as_float(s[0]) + __uint_as_float(s[1]);
    auto t = __builtin_amdgcn_permlane32_swap(__float_as_uint(x), __float_as_uint(x), false, false);
    return __uint_as_float(t[0]) + __uint_as_float(t[1]);
}
__device__ __forceinline__ const float* xrow_c(const float* Xl, const float* Xc, int r) { const int b = r / TPB, t = r - b * TPB; return t < CTX ? Xc + ((size_t)(b * CTX + t) << 10) : Xl + ((size_t)(b * SEQ + t - CTX) << 10); }
__device__ __forceinline__ int cidx(int r) { const int b = r / TPB, t = r - b * TPB; return t < CTX ? 16 : b; }

__device__ __forceinline__ void phase_prologue(const Params& p, LAS unsigned char* lds, const int wvs) {
    const int tid = wvs * 64 + lane_id_fresh(); const int lane = tid & 63, w = tid >> 6;
    float* mods = (float*)(p.ws + WS_MODS);
    LAS float* sc = (LAS float*)lds;
    LAS float* red = (LAS float*)(lds + 81920);
    for (int idx = tid; idx < 17 * 1024; idx += NTHR) { const int ci = idx >> 10, k = idx & 1023; const float v = ci < 16 ? p.c[ci * 1024 + k] : p.c_ctx[k]; sc[k * 20 + ci] = v / (1.f + expf(-v)); }
    __syncthreads();
    for (int it = blockIdx.x; it < DEPTH * 96; it += gridDim.x) {
        const int l = it / 96, cgp = it - l * 96, col = cgp * 64 + lane;
        float acc[17];
#pragma unroll
        for (int i = 0; i < 17; ++i) acc[i] = 0.f;
        const float* wp = p.w_ada + ((size_t)l * 1024 + w * 128) * 6144 + col;
#pragma unroll 8
        for (int kk = 0; kk < 128; ++kk) {
            const float wv = wp[(size_t)kk * 6144];
            const LAS f32x4* s4 = (const LAS f32x4*)(sc + (w * 128 + kk) * 20);
            const f32x4 s0 = s4[0], s1 = s4[1], s2 = s4[2], s3 = s4[3]; const float s16 = sc[(w * 128 + kk) * 20 + 16];
#pragma unroll
            for (int e = 0; e < 4; ++e) { acc[e] += wv * s0[e]; acc[4 + e] += wv * s1[e]; acc[8 + e] += wv * s2[e]; acc[12 + e] += wv * s3[e]; }
            acc[16] += wv * s16;
        }
#pragma unroll
        for (int i = 0; i < 17; ++i) red[(w * 17 + i) * 64 + lane] = acc[i];
        __syncthreads();
        for (int idx = tid; idx < 17 * 64; idx += NTHR) { const int i = idx >> 6, cl = idx & 63; float s = 0.f;
#pragma unroll
            for (int ww = 0; ww < 8; ++ww) s += red[(ww * 17 + i) * 64 + cl];
            mods[((size_t)l * 17 + i) * 6144 + cgp * 64 + cl] = s + p.b_ada[l * 6144 + cgp * 64 + cl]; }
        __syncthreads();
    }
    const int gt = blockIdx.x * NTHR + tid, GT = gridDim.x * NTHR;
    { float* rc = (float*)(p.ws + WS_ROPE); float* rs = rc + 2048 * 32;
      for (int idx = gt; idx < 2048 * 32; idx += GT) { const int t = idx >> 5, d = idx & 31; const float pos = (float)(d < 16 ? (t >> 6) : (t & 63));
          const float inv = expf(-(float)(d & 15) * (9.210340371976184f / 16.f)); const float ang = pos * inv; rc[idx] = cosf(ang); rs[idx] = sinf(ang); } }
    { float* LB = (float*)(p.ws + WS_LB);
      for (int idx = gt; idx < 2 * 256; idx += GT) { const int d = idx >> 8, cc = idx & 255; float v[DEPTH]; float mx = -1e30f;
#pragma unroll
          for (int l = 0; l < DEPTH; ++l) { v[l] = p.hg_lb[(d * DEPTH + l) * 256 + cc]; mx = fmaxf(mx, v[l]); }
          float s = 0.f;
#pragma unroll
          for (int l = 0; l < DEPTH; ++l) { v[l] = expf(v[l] - mx); s += v[l]; }
          float cum = 0.f;
#pragma unroll
          for (int l = 0; l < DEPTH; ++l) { if (l > 0) cum += v[l] / s; LB[(d * DEPTH + l) * 256 + cc] = cum; } } }
    { const f32x4* src = (const f32x4*)p.x; f32x4* dst = (f32x4*)p.out; for (int i = gt; i < BATCH * SEQ * D / 4; i += GT) dst[i] = src[i];
      const f32x4* s2 = (const f32x4*)p.ctx; f32x4* d2 = (f32x4*)(p.ws + WS_XC); for (int i = gt; i < BATCH * CTX * D / 4; i += GT) d2[i] = s2[i]; }
}

__device__ __forceinline__ void transpose_item(const float* W, int K, int ldw, int scol0, bf16_t* WT, int n0, int k0, LAS float* scr, int lane) {
#pragma unroll 8
    for (int i = 0; i < 32; ++i) { const int kk = 2 * i + (lane >> 5); scr[kk * 33 + (lane & 31)] = W[(size_t)(k0 + kk) * ldw + scol0 + (lane & 31)]; }
    asm volatile("s_waitcnt lgkmcnt(0)" ::: "memory");
    const int c = lane & 7;
#pragma unroll
    for (int j = 0; j < 4; ++j) { const int n = (lane >> 3) + 8 * j; const LAS float* s = scr + (8 * c) * 33 + n;
        u32x4 o; o.x = pk2(s[0 * 33], s[1 * 33]); o.y = pk2(s[2 * 33], s[3 * 33]); o.z = pk2(s[4 * 33], s[5 * 33]); o.w = pk2(s[6 * 33], s[7 * 33]);
        *(u32x4*)(WT + (size_t)(n0 + n) * K + k0 + 8 * c) = o; }
    asm volatile("s_waitcnt lgkmcnt(0)" ::: "memory");
}

template <bool FIRST> __device__ __forceinline__ void phase_norm(const Params& p, int l, LAS unsigned char* lds, const int wvs) {
    const int tid = wvs * 64 + lane_id_fresh(); const int lane = tid & 63, w = tid >> 6;
    const int gw = blockIdx.x * NWAVES + w, NGW = gridDim.x * NWAVES;
    const float* mods = (const float*)(p.ws + WS_MODS);
    LAS float* wab = (LAS float*)lds;
    if (FIRST) {
        LAS float* scr = (LAS float*)(lds + 65536 + w * 8704);
        constexpr int I_IN = 16 * 96, I_OUT = 16 * 32, I_1 = 16 * 128, I_2 = 64 * 32;
        for (int it = gw; it < I_IN + I_OUT + I_1 + I_2; it += NGW) {
            int r = it;
            if (r < I_IN) { const int kb = r / 96, nb = r - kb * 96; const int n0 = nb * 32; transpose_item(p.w_in + (size_t)l * D * DIN, D, DIN, n0 + (n0 >= 1024 ? 16 : 0), (bf16_t*)(p.ws + WS_WIN), n0, kb * 64, scr, lane); continue; }
            r -= I_IN;
            if (r < I_OUT) { const int kb = r / 32, nb = r - kb * 32; transpose_item(p.w_out + (size_t)l * D * D, D, D, nb * 32, (bf16_t*)(p.ws + WS_WOUT), nb * 32, kb * 64, scr, lane); continue; }
            r -= I_OUT;
            if (r < I_1) { const int kb = r / 128, nb = r - kb * 128; transpose_item(p.w_ff1 + (size_t)l * D * DFF, D, DFF, nb * 32, (bf16_t*)(p.ws + WS_W1), nb * 32, kb * 64, scr, lane); continue; }
            r -= I_1;
            { const int kb = r / 32, nb = r - kb * 32; transpose_item(p.w_ff2 + (size_t)l * DFF * D, DFF, D, nb * 32, (bf16_t*)(p.ws + WS_W2), nb * 32, kb * 64, scr, lane); }
        }
        const float* wi = p.w_in + (size_t)l * D * DIN + 1024;
        for (int idx = tid; idx < 4096; idx += NTHR) { const int k = idx >> 2, j4 = (idx & 3) * 4; const f32x4 v = *(const f32x4*)(wi + (size_t)k * DIN + j4);
#pragma unroll
            for (int e = 0; e < 4; ++e) wab[(j4 + e) * 1024 + k] = v[e]; }
        __syncthreads();
    }
    const float* nw = (FIRST ? p.norm1 : p.norm2) + l * D;
    bf16_t* H = (bf16_t*)(p.ws + WS_HY);
    float* AB = (float*)(p.ws + WS_AB);
    const float* Xc = (const float*)(p.ws + WS_XC);
    for (int r = gw; r < M; r += NGW) {
        if (!FIRST && l == DEPTH - 1 && (r % TPB) < CTX) continue;
        const f32x4* xr = (const f32x4*)xrow_c(p.out, Xc, r) + lane;
        f32x4 v[4]; float ss = 0.f;
#pragma unroll
        for (int j = 0; j < 4; ++j) { v[j] = xr[64 * j]; ss += (v[j][0] * v[j][0] + v[j][1] * v[j][1]) + (v[j][2] * v[j][2] + v[j][3] * v[j][3]); }
        const float rstd = rsqrtf(wave_sum(ss) * (1.f / D) + EPS);
        const float* md = mods + ((size_t)l * 17 + cidx(r)) * 6144 + (FIRST ? 0 : 3 * 1024);
        float acc[16];
#pragma unroll
        for (int o = 0; o < 16; ++o) acc[o] = 0.f;
        u32x2* hp = (u32x2*)(H + (size_t)r * D) + lane;
#pragma unroll
        for (int j = 0; j < 4; ++j) { const int k = 4 * (lane + 64 * j);
            const f32x4 g = *(const f32x4*)(nw + k), sh = *(const f32x4*)(md + k), sl = *(const f32x4*)(md + 1024 + k);
            f32x4 h;
#pragma unroll
            for (int e = 0; e < 4; ++e) h[e] = (v[j][e] * rstd * g[e]) * (1.f + sl[e]) + sh[e];
            u32x2 o2; o2.x = pk2(h[0], h[1]); o2.y = pk2(h[2], h[3]); hp[64 * j] = o2;
            if (FIRST) {
#pragma unroll
                for (int o = 0; o < 16; ++o) { const f32x4 wv = *(const LAS f32x4*)(wab + o * 1024 + k); acc[o] += (h[0] * wv[0] + h[1] * wv[1]) + (h[2] * wv[2] + h[3] * wv[3]); }
            }
        }
        if (FIRST) { float outv = 0.f;
#pragma unroll
            for (int o = 0; o < 16; ++o) { const float s = wave_sum(acc[o]); if (lane == o) outv = s; }
            if (lane < 16) AB[(size_t)r * 16 + lane] = outv; }
    }
}

constexpr int SST = 68;
constexpr int HST = 72;
__device__ __forceinline__ bf16x8 ldA_perm(const LAS bf16_t* base, int row, int s, int fq) {
    const LAS bf16_t* ap = base + row * HST + s * 32 + fq * 4; const u32x2 lo = *(const LAS u32x2*)ap, hi = *(const LAS u32x2*)(ap + 16);
    u32x4 av; av[0] = lo[0]; av[1] = lo[1]; av[2] = hi[0]; av[3] = hi[1]; return __builtin_bit_cast(bf16x8, av);
}
__device__ __forceinline__ bf16x8 packB(const f32x4& a, const f32x4& b) {
    u32x4 pb; pb[0] = bf1(a[0]) | ((unsigned)bf1(a[1]) << 16); pb[1] = bf1(a[2]) | ((unsigned)bf1(a[3]) << 16); pb[2] = bf1(b[0]) | ((unsigned)bf1(b[1]) << 16); pb[3] = bf1(b[2]) | ((unsigned)bf1(b[3]) << 16);
    return __builtin_bit_cast(bf16x8, pb);
}
__device__ __forceinline__ void dn_seq(const Params& p, int l, int s, LAS unsigned char* lds, const int wvs) {
    const int tid = wvs * 64 + lane_id_fresh(); const int lane = tid & 63;
    const int b = s >> 3, h = (s >> 1) & 3, d = s & 1;
    LAS float* qs = (LAS float*)lds; LAS float* ks = qs + 64 * SST; LAS float* vs = ks + 64 * SST;
    LAS bf16_t* QH = (LAS bf16_t*)(vs + 64 * SST); LAS bf16_t* KH = QH + 64 * HST; LAS bf16_t* KTT = KH + 64 * HST; LAS bf16_t* LM = KTT + 64 * HST; LAS bf16_t* SCM = LM + 64 * HST; LAS bf16_t* OB = SCM + 64 * HST;
    LAS float* LF = (LAS float*)(OB + 64 * HST);
    LAS bf16_t* DI = (LAS bf16_t*)(LF + 4 * 16 * 17);
    LAS float* GC = (LAS float*)(DI + 4 * 16 * 24); LAS float* EG = GC + 64; LAS float* BETA = EG + 64; LAS float* GL = BETA + 64;
    const bf16_t* P = (const bf16_t*)(p.ws + WS_P);
    const float* AB = (const float*)(p.ws + WS_AB);
    bf16_t* OD = (bf16_t*)(p.ws + WS_OD) + (size_t)d * M * 512 + h * 64;
    const float* cw = p.dn_conv + (size_t)l * 5 * 768;
    const float nA = -expf(p.dn_A_log[(l * 2 + d) * 4 + h]); const float dtb = p.dn_dt_bias[(l * 2 + d) * 4 + h];
    const int fr = lane & 15, fq = lane >> 4;
    const int V = wvs & 3, half = wvs >> 2;
    const f32x4 zero4 = (f32x4){0.f, 0.f, 0.f, 0.f};
    constexpr int RST = 200;
    LAS bf16_t* RAW = KTT;
    const int c4 = tid % 48, tg = tid / 48;
    float wc[5][4];
    { const int ch = c4 * 4, pcol = (ch >> 6) * 256 + h * 64 + (ch & 63);
#pragma unroll
      for (int t = 0; t < 5; ++t) { const f32x4 w4 = *(const f32x4*)(cw + t * 768 + pcol); wc[t][0] = w4[0]; wc[t][1] = w4[1]; wc[t][2] = w4[2]; wc[t][3] = w4[3]; } }
    LAS float* cdst = ((c4 >> 4) == 0 ? qs : ((c4 >> 4) == 1 ? ks : vs)) + (c4 & 15) * 4;
    u32x4 praw[4]; float pa = 0.f, pb_ = 0.f;
    { const int nc0 = d == 0 ? 0 : 3; const int base0 = b * TPB + nc0 * 64, lo0 = b * TPB, hi0 = b * TPB + CTX;
#pragma unroll
      for (int k = 0; k < 4; ++k) { const int q = tid + NTHR * k; const int rr = q / 24, pc = q - rr * 24; const int r = base0 - 2 + rr;
          praw[k] = (q < 68 * 24 && r >= lo0 && r < hi0) ? *(const u32x4*)(P + (size_t)r * NP + (pc >> 3) * 256 + h * 64 + (pc & 7) * 8) : (u32x4){0u, 0u, 0u, 0u}; }
      if (wvs == 0) { const int r = base0 + (d ? 63 - lane : lane); pa = AB[(size_t)r * 16 + d * 4 + h]; pb_ = AB[(size_t)r * 16 + 8 + d * 4 + h]; } }
    f32x4 Sacc[4];
#pragma unroll
    for (int T = 0; T < 4; ++T) Sacc[T] = zero4;
    for (int ci = 0; ci < 36; ++ci) {
        const int nc = d == 0 ? ci : (ci < 4 ? 3 - ci : 39 - ci);
        const int base = b * TPB + nc * 64, seg_lo = b * TPB + (nc < 4 ? 0 : CTX), seg_hi = b * TPB + (nc < 4 ? CTX : TPB);
#pragma unroll
        for (int k = 0; k < 4; ++k) { const int q = tid + NTHR * k; if (q < 68 * 24) { const int rr = q / 24, pc = q - rr * 24; *(LAS u32x4*)(RAW + rr * RST + pc * 8) = praw[k]; } }
        const float a_in = pa, b_in = pb_;
        if (ci + 1 < 36) { const int c2 = ci + 1; const int nc2 = d == 0 ? c2 : (c2 < 4 ? 3 - c2 : 39 - c2);
            const int base2 = b * TPB + nc2 * 64, lo2 = b * TPB + (nc2 < 4 ? 0 : CTX), hi2 = b * TPB + (nc2 < 4 ? CTX : TPB);
#pragma unroll
            for (int k = 0; k < 4; ++k) { const int q = tid + NTHR * k; const int rr = q / 24, pc = q - rr * 24; const int r = base2 - 2 + rr;
                praw[k] = (q < 68 * 24 && r >= lo2 && r < hi2) ? *(const u32x4*)(P + (size_t)r * NP + (pc >> 3) * 256 + h * 64 + (pc & 7) * 8) : (u32x4){0u, 0u, 0u, 0u}; }
            if (wvs == 0) { const int r = base2 + (d ? 63 - lane : lane); pa = AB[(size_t)r * 16 + d * 4 + h]; pb_ = AB[(size_t)r * 16 + 8 + d * 4 + h]; } }
        __syncthreads();
        if (tid < 480) {
#pragma unroll
            for (int m = 0; m < 7; ++m) { const int pp = tg + 10 * m; if (pp < 64) { float a0 = 0.f, a1 = 0.f, a2 = 0.f, a3 = 0.f;
#pragma unroll
                for (int t = 0; t < 5; ++t) { const u32x2 raw = *(const LAS u32x2*)(RAW + (pp + t) * RST + c4 * 4);
                    a0 += bflo(raw[0]) * wc[t][0]; a1 += bfhi(raw[0]) * wc[t][1]; a2 += bflo(raw[1]) * wc[t][2]; a3 += bfhi(raw[1]) * wc[t][3]; }
                f32x4 o; o[0] = a0 / (1.f + __expf(-a0)); o[1] = a1 / (1.f + __expf(-a1)); o[2] = a2 / (1.f + __expf(-a2)); o[3] = a3 / (1.f + __expf(-a3));
                const int pq = d ? 63 - pp : pp; *(LAS f32x4*)(cdst + pq * SST) = o; } } }
        if (wvs == 0) { const float ai = a_in, bi = b_in;
            const float xs = ai + dtb; const float sp = xs > 20.f ? xs : log1pf(expf(xs)); float x = nA * sp;
#pragma unroll
            for (int o = 1; o < 64; o <<= 1) { const float y = __shfl_up(x, o); if (lane >= o) x += y; }
            GC[lane] = x; EG[lane] = __expf(x); BETA[lane] = 1.f / (1.f + expf(-bi)); if (lane == 63) { GL[0] = x; GL[1] = __expf(x); } }
        __syncthreads();
        { const int t = tid >> 3, part = tid & 7;
          const f32x4 q0 = *(const LAS f32x4*)(qs + t * SST + part * 8), q1 = *(const LAS f32x4*)(qs + t * SST + part * 8 + 4);
          const f32x4 k0 = *(const LAS f32x4*)(ks + t * SST + part * 8), k1 = *(const LAS f32x4*)(ks + t * SST + part * 8 + 4);
          float sq = (q0[0] * q0[0] + q0[1] * q0[1]) + (q0[2] * q0[2] + q0[3] * q0[3]) + (q1[0] * q1[0] + q1[1] * q1[1]) + (q1[2] * q1[2] + q1[3] * q1[3]);
          float sk = (k0[0] * k0[0] + k0[1] * k0[1]) + (k0[2] * k0[2] + k0[3] * k0[3]) + (k1[0] * k1[0] + k1[1] * k1[1]) + (k1[2] * k1[2] + k1[3] * k1[3]);
          sq = sum8(sq); sk = sum8(sk);
          const float rq = rsqrtf(sq + EPS) * 0.125f, rk = rsqrtf(sk + EPS), ekt = __expf(GL[0] - GC[t]);
          u32x4 qo, ko;
          qo[0] = pk2(q0[0] * rq, q0[1] * rq); qo[1] = pk2(q0[2] * rq, q0[3] * rq); qo[2] = pk2(q1[0] * rq, q1[1] * rq); qo[3] = pk2(q1[2] * rq, q1[3] * rq);
          ko[0] = pk2(k0[0] * rk, k0[1] * rk); ko[1] = pk2(k0[2] * rk, k0[3] * rk); ko[2] = pk2(k1[0] * rk, k1[1] * rk); ko[3] = pk2(k1[2] * rk, k1[3] * rk);
          *(LAS u32x4*)(QH + t * HST + part * 8) = qo; *(LAS u32x4*)(KH + t * HST + part * 8) = ko;
          const float rke = rk * ekt;
#pragma unroll
          for (int e = 0; e < 4; ++e) { KTT[(part * 8 + e) * HST + t] = bf1(k0[e] * rke); KTT[(part * 8 + 4 + e) * HST + t] = bf1(k1[e] * rke); } }
        __syncthreads();
        { const int I = wvs >> 1;
#pragma unroll
          for (int jj = 0; jj < 2; ++jj) { const int J = 2 * (wvs & 1) + jj; f32x4 ckk = zero4, cqk = zero4;
#pragma unroll
              for (int kk = 0; kk < 2; ++kk) { const bf16x8 Ak = *(const LAS bf16x8*)(KH + (I * 16 + fr) * HST + kk * 32 + fq * 8), Aq = *(const LAS bf16x8*)(QH + (I * 16 + fr) * HST + kk * 32 + fq * 8);
                  const bf16x8 B = *(const LAS bf16x8*)(KH + (J * 16 + fr) * HST + kk * 32 + fq * 8);
                  ckk = __builtin_amdgcn_mfma_f32_16x16x32_bf16(Ak, B, ckk, 0, 0, 0); cqk = __builtin_amdgcn_mfma_f32_16x16x32_bf16(Aq, B, cqk, 0, 0, 0); }
              const int j = J * 16 + fr; const float gj = GC[j];
#pragma unroll
              for (int r = 0; r < 4; ++r) { const int i = I * 16 + fq * 4 + r; const float dec = __expf(fminf(GC[i] - gj, 0.f));
                  const float lv = j < i ? BETA[i] * ckk[r] * dec : 0.f, sv = j <= i ? cqk[r] * dec : 0.f;
                  LM[i * HST + j] = bf1(lv); SCM[i * HST + j] = bf1(sv); if (I == J) LF[(I * 16 + fq * 4 + r) * 17 + fr] = lv; } } }
        __syncthreads();
        if (wvs == 0) { const int I = lane >> 4, c = lane & 15; float x[16];
#pragma unroll
            for (int i = 0; i < 16; ++i) { float acc = (i == c) ? 1.f : 0.f;
#pragma unroll
                for (int j = 0; j < i; ++j) acc -= LF[(I * 16 + i) * 17 + j] * x[j];
                x[i] = acc; DI[(I * 16 + i) * 24 + c] = bf1(acc); } }
        f32x4 R[4], QS[2];
        { bf16x8 Bs[2];
#pragma unroll
          for (int s2 = 0; s2 < 2; ++s2) Bs[s2] = packB(Sacc[2 * s2], Sacc[2 * s2 + 1]);
#pragma unroll
          for (int I = 0; I < 4; ++I) { f32x4 c = zero4;
#pragma unroll
              for (int s2 = 0; s2 < 2; ++s2) c = __builtin_amdgcn_mfma_f32_16x16x32_bf16(ldA_perm(KH, I * 16 + fr, s2, fq), Bs[s2], c, 0, 0, 0);
#pragma unroll
              for (int r = 0; r < 4; ++r) { const int i = I * 16 + fq * 4 + r; R[I][r] = BETA[i] * (vs[i * SST + V * 16 + fr] - EG[i] * c[r]); } }
#pragma unroll
          for (int ii = 0; ii < 2; ++ii) { const int I = 2 * half + ii; f32x4 c = zero4;
#pragma unroll
              for (int s2 = 0; s2 < 2; ++s2) c = __builtin_amdgcn_mfma_f32_16x16x32_bf16(ldA_perm(QH, I * 16 + fr, s2, fq), Bs[s2], c, 0, 0, 0);
              QS[ii] = c; } }
        __syncthreads();
        bf16x8 Bx0, Bx1;
        { bf16x8 AD[4];
#pragma unroll
          for (int I = 0; I < 4; ++I) { const u32x2 lo = *(const LAS u32x2*)(DI + (I * 16 + fr) * 24 + fq * 4); u32x4 av; av[0] = lo[0]; av[1] = lo[1]; av[2] = 0u; av[3] = 0u; AD[I] = __builtin_bit_cast(bf16x8, av); }
          const f32x4 X0 = __builtin_amdgcn_mfma_f32_16x16x32_bf16(AD[0], packB(R[0], zero4), zero4, 0, 0, 0);
          f32x4 T1 = __builtin_amdgcn_mfma_f32_16x16x32_bf16(ldA_perm(LM, 16 + fr, 0, fq), packB(X0, zero4), zero4, 0, 0, 0);
          const f32x4 X1 = __builtin_amdgcn_mfma_f32_16x16x32_bf16(AD[1], packB(R[1] - T1, zero4), zero4, 0, 0, 0);
          Bx0 = packB(X0, X1);
          f32x4 T2 = __builtin_amdgcn_mfma_f32_16x16x32_bf16(ldA_perm(LM, 32 + fr, 0, fq), Bx0, zero4, 0, 0, 0);
          const f32x4 X2 = __builtin_amdgcn_mfma_f32_16x16x32_bf16(AD[2], packB(R[2] - T2, zero4), zero4, 0, 0, 0);
          f32x4 T3 = __builtin_amdgcn_mfma_f32_16x16x32_bf16(ldA_perm(LM, 48 + fr, 0, fq), Bx0, zero4, 0, 0, 0);
          T3 = __builtin_amdgcn_mfma_f32_16x16x32_bf16(ldA_perm(LM, 48 + fr, 1, fq), packB(X2, zero4), T3, 0, 0, 0);
          const f32x4 X3 = __builtin_amdgcn_mfma_f32_16x16x32_bf16(AD[3], packB(R[3] - T3, zero4), zero4, 0, 0, 0);
          Bx1 = packB(X2, X3); }
#pragma unroll
        for (int ii = 0; ii < 2; ++ii) { const int I = 2 * half + ii; f32x4 c;
#pragma unroll
            for (int r = 0; r < 4; ++r) c[r] = EG[I * 16 + fq * 4 + r] * QS[ii][r];
            c = __builtin_amdgcn_mfma_f32_16x16x32_bf16(ldA_perm(SCM, I * 16 + fr, 0, fq), Bx0, c, 0, 0, 0);
            c = __builtin_amdgcn_mfma_f32_16x16x32_bf16(ldA_perm(SCM, I * 16 + fr, 1, fq), Bx1, c, 0, 0, 0);
#pragma unroll
            for (int r = 0; r < 4; ++r) OB[(I * 16 + fq * 4 + r) * HST + V * 16 + fr] = bf1(c[r]); }
        { const float egl = GL[1];
#pragma unroll
          for (int T = 0; T < 4; ++T) { f32x4 c = Sacc[T] * egl;
              c = __builtin_amdgcn_mfma_f32_16x16x32_bf16(ldA_perm(KTT, T * 16 + fr, 0, fq), Bx0, c, 0, 0, 0);
              c = __builtin_amdgcn_mfma_f32_16x16x32_bf16(ldA_perm(KTT, T * 16 + fr, 1, fq), Bx1, c, 0, 0, 0);
              Sacc[T] = c; } }
        __syncthreads();
#pragma unroll
        for (int it = 0; it < 4; ++it) { const int idx = tid + NTHR * it; const int i = idx >> 5, c2 = (idx & 31) * 2; const int row = base + (d ? 63 - i : i);
            *(unsigned*)(OD + (size_t)row * 512 + c2) = *(const LAS unsigned*)(OB + i * HST + c2); }
    }
    __syncthreads();
}

__device__ __forceinline__ void hg_seq(const Params& p, int l, int s, LAS unsigned char* lds, const int wvs) {
    const int tid = wvs * 64 + lane_id_fresh(); const int lane = tid & 63;
    const int b = s >> 3, h = (s >> 1) & 3, d = s & 1;
    LAS bf16_t* QT = (LAS bf16_t*)lds; LAS bf16_t* KT = QT + 64 * HST; LAS bf16_t* QP = KT + 64 * HST; LAS bf16_t* KTT = QP + 64 * HST; LAS bf16_t* VT = KTT + 64 * HST; LAS bf16_t* SC = VT + 64 * HST;
    LAS float* GS = (LAS float*)(SC + 64 * HST); LAS float* MID = GS + 512; LAS float* BLS = MID + 64; LAS float* EBL = BLS + 64; LAS bf16_t* OB = (LAS bf16_t*)(EBL + 64);
    const bf16_t* P = (const bf16_t*)(p.ws + WS_P);
    bf16_t* OD = (bf16_t*)(p.ws + WS_OD) + (size_t)d * M * 512 + 256 + h * 64;
    const int kx = tid & 63, g = tid >> 6;
    const float lb = ((const float*)(p.ws + WS_LB))[(d * DEPTH + l) * 256 + h * 64 + kx];
    const int fr = lane & 15, fq = lane >> 4;
    const int V = wvs & 3, half = wvs >> 2;
    f32x4 Sacc[4];
#pragma unroll
    for (int T = 0; T < 4; ++T) Sacc[T] = (f32x4){0.f, 0.f, 0.f, 0.f};
    unsigned short rq[8], rz[8], rv[8];
    { const int nc = d == 0 ? 0 : 3; const int base = b * TPB + nc * 64;
#pragma unroll
      for (int e = 0; e < 8; ++e) { const int t = g * 8 + e; const int pp = d ? 63 - t : t; const bf16_t* rp = P + (size_t)(base + pp) * NP + h * 64 + kx;
          rq[e] = rp[PC_HQ]; rz[e] = rp[PC_HF + d * 256]; rv[e] = rp[PC_HI]; } }
    for (int ci = 0; ci < 36; ++ci) {
        const int nc = d == 0 ? ci : (ci < 4 ? 3 - ci : 39 - ci);
        const int base = b * TPB + nc * 64;
        float qv[8], kv[8], bc[8]; float run = 0.f;
#pragma unroll
        for (int e = 0; e < 8; ++e) { const float z = bflo(rz[e]); const float sg = 1.f / (1.f + __expf(-z)); const float f = lb + (1.f - lb) * sg;
            run += __logf(f); bc[e] = run; kv[e] = (1.f - lb) * (1.f - sg); qv[e] = bflo(rq[e]); }
        GS[g * 64 + kx] = run;
#pragma unroll
        for (int e = 0; e < 8; ++e) VT[kx * HST + g * 8 + e] = rv[e];
        __syncthreads();
        { float off = 0.f;
#pragma unroll
          for (int gg = 0; gg < 7; ++gg) { const float x = GS[gg * 64 + kx]; off += (gg < g) ? x : 0.f; }
#pragma unroll
          for (int e = 0; e < 8; ++e) bc[e] += off; }
        if (g == 3) MID[kx] = bc[7];
        if (g == 7) { BLS[kx] = bc[7]; EBL[kx] = __expf(bc[7]); }
        if (ci + 1 < 36) { const int c2 = ci + 1; const int nc2 = d == 0 ? c2 : (c2 < 4 ? 3 - c2 : 39 - c2); const int base2 = b * TPB + nc2 * 64;
#pragma unroll
            for (int e = 0; e < 8; ++e) { const int t = g * 8 + e; const int pp = d ? 63 - t : t; const bf16_t* rp = P + (size_t)(base2 + pp) * NP + h * 64 + kx;
                rq[e] = rp[PC_HQ]; rz[e] = rp[PC_HF + d * 256]; rv[e] = rp[PC_HI]; } }
        __syncthreads();
        { const float mid = MID[kx], bl = BLS[kx];
#pragma unroll
          for (int e = 0; e < 8; ++e) { const int t = g * 8 + e; const float E = fminf(fmaxf(bc[e] - mid, -80.f), 80.f);
              const float eq = __expf(E), ek = __expf(-E);
              QT[t * HST + kx] = bf1(qv[e] * eq); KT[t * HST + kx] = bf1(kv[e] * ek);
              QP[t * HST + kx] = bf1(qv[e] * __expf(bc[e])); KTT[kx * HST + t] = bf1(kv[e] * __expf(bl - bc[e])); } }
        __syncthreads();
        { const int I = wvs >> 1;
#pragma unroll
          for (int jj = 0; jj < 2; ++jj) { const int J = 2 * (wvs & 1) + jj; f32x4 c = (f32x4){0.f, 0.f, 0.f, 0.f};
#pragma unroll
              for (int kk = 0; kk < 2; ++kk) { const bf16x8 A = *(const LAS bf16x8*)(QT + (I * 16 + fr) * HST + kk * 32 + fq * 8); const bf16x8 B = *(const LAS bf16x8*)(KT + (J * 16 + fr) * HST + kk * 32 + fq * 8);
                  c = __builtin_amdgcn_mfma_f32_16x16x32_bf16(A, B, c, 0, 0, 0); }
#pragma unroll
              for (int r = 0; r < 4; ++r) { const int i = I * 16 + fq * 4 + r, j = J * 16 + fr; SC[i * HST + j] = bf1(j <= i ? c[r] : 0.f); } } }
        __syncthreads();
        { bf16x8 Bs[2];
#pragma unroll
          for (int s2 = 0; s2 < 2; ++s2) { u32x4 pb; pb[0] = bf1(Sacc[2 * s2][0]) | ((unsigned)bf1(Sacc[2 * s2][1]) << 16); pb[1] = bf1(Sacc[2 * s2][2]) | ((unsigned)bf1(Sacc[2 * s2][3]) << 16); pb[2] = bf1(Sacc[2 * s2 + 1][0]) | ((unsigned)bf1(Sacc[2 * s2 + 1][1]) << 16); pb[3] = bf1(Sacc[2 * s2 + 1][2]) | ((unsigned)bf1(Sacc[2 * s2 + 1][3]) << 16); Bs[s2] = __builtin_bit_cast(bf16x8, pb); }
          bf16x8 Bv[2];
#pragma unroll
          for (int s2 = 0; s2 < 2; ++s2) Bv[s2] = *(const LAS bf16x8*)(VT + (V * 16 + fr) * HST + s2 * 32 + fq * 8);
#pragma unroll
          for (int ii = 0; ii < 2; ++ii) { const int I = 2 * half + ii; f32x4 o = (f32x4){0.f, 0.f, 0.f, 0.f};
#pragma unroll
              for (int s2 = 0; s2 < 2; ++s2) { const LAS bf16_t* ap = QP + (I * 16 + fr) * HST + s2 * 32 + fq * 4; const u32x2 lo = *(const LAS u32x2*)ap, hi = *(const LAS u32x2*)(ap + 16);
                  u32x4 av; av[0] = lo[0]; av[1] = lo[1]; av[2] = hi[0]; av[3] = hi[1];
                  o = __builtin_amdgcn_mfma_f32_16x16x32_bf16(__builtin_bit_cast(bf16x8, av), Bs[s2], o, 0, 0, 0); }
#pragma unroll
              for (int s2 = 0; s2 < 2; ++s2) { const bf16x8 A = *(const LAS bf16x8*)(SC + (I * 16 + fr) * HST + s2 * 32 + fq * 8); o = __builtin_amdgcn_mfma_f32_16x16x32_bf16(A, Bv[s2], o, 0, 0, 0); }
#pragma unroll
              for (int r = 0; r < 4; ++r) { const int i = I * 16 + fq * 4 + r; OB[i * HST + V * 16 + fr] = bf1(o[r]); } }
#pragma unroll
          for (int T = 0; T < 4; ++T) { f32x4 c;
#pragma unroll
              for (int r = 0; r < 4; ++r) c[r] = Sacc[T][r] * EBL[T * 16 + fq * 4 + r];
#pragma unroll
              for (int s2 = 0; s2 < 2; ++s2) { const bf16x8 A = *(const LAS bf16x8*)(KTT + (T * 16 + fr) * HST + s2 * 32 + fq * 8); c = __builtin_amdgcn_mfma_f32_16x16x32_bf16(A, Bv[s2], c, 0, 0, 0); }
              Sacc[T] = c; } }
        __syncthreads();
#pragma unroll
        for (int it = 0; it < 4; ++it) { const int idx = tid + NTHR * it; const int i = idx >> 5, c2 = (idx & 31) * 2; const int row = base + (d ? 63 - i : i);
            *(unsigned*)(OD + (size_t)row * 512 + c2) = *(const LAS unsigned*)(OB + i * HST + c2); }
    }
}

constexpr int KST = 72, VST = 136;
__device__ __forceinline__ void swa_unit(const Params& p, int l, int unit, LAS unsigned char* lds, const int wvs) {
    const int tid = wvs * 64 + lane_id_fresh(); const int lane = tid & 63, w = tid >> 6;
    const int b = unit / 36, rem = unit - b * 36, kvh = rem / 18, qb = rem - kvh * 18;
    const bool qctx = qb < 2;
    const bf16_t* P = (const bf16_t*)(p.ws + WS_P);
    const float* rc = (const float*)(p.ws + WS_ROPE); const float* rs = rc + 2048 * 32;
    bf16_t* Y = (bf16_t*)(p.ws + WS_HY);
    LAS bf16_t* Ks = (LAS bf16_t*)lds; LAS bf16_t* Vt = Ks + 128 * KST;
    const int hh = w >> 1, qhalf = w & 1, head = kvh * 4 + hh;
    const int fr = lane & 15, fq = lane >> 4;
    const int rowq0 = b * TPB + qb * 128 + qhalf * 64;
    bf16x8 qf[4][2];
#pragma unroll
    for (int qt = 0; qt < 4; ++qt) {
        const int row = rowq0 + qt * 16 + fr; const bf16_t* qp = P + (size_t)row * NP + PC_SQ + head * 64 + fq * 8;
        const u32x4 r1 = *(const u32x4*)qp, r2 = *(const u32x4*)(qp + 32);
        float a1[8], a2[8];
#pragma unroll
        for (int e = 0; e < 4; ++e) { a1[2 * e] = bflo(r1[e]); a1[2 * e + 1] = bfhi(r1[e]); a2[2 * e] = bflo(r2[e]); a2[2 * e + 1] = bfhi(r2[e]); }
        if (!qctx) { const int t = (qb - 2) * 128 + qhalf * 64 + qt * 16 + fr; const float* cp = rc + t * 32 + fq * 8; const float* sp = rs + t * 32 + fq * 8;
#pragma unroll
            for (int e = 0; e < 8; ++e) { const float cs = cp[e], sn = sp[e]; const float o1 = a1[e] * cs - a2[e] * sn, o2 = a1[e] * sn + a2[e] * cs; a1[e] = o1; a2[e] = o2; } }
        u32x4 o1, o2;
#pragma unroll
        for (int e = 0; e < 4; ++e) { o1[e] = pk2(a1[2 * e] * 0.125f, a1[2 * e + 1] * 0.125f); o2[e] = pk2(a2[2 * e] * 0.125f, a2[2 * e + 1] * 0.125f); }
        qf[qt][0] = __builtin_bit_cast(bf16x8, o1); qf[qt][1] = __builtin_bit_cast(bf16x8, o2);
    }
    const float sink = p.swa_sink[l * 8 + head];
    float mrun[4], lrun[4]; f32x4 O[4][4];
#pragma unroll
    for (int qt = 0; qt < 4; ++qt) { mrun[qt] = sink; lrun[qt] = 1.f;
#pragma unroll
        for (int dv = 0; dv < 4; ++dv) O[qt][dv] = (f32x4){0.f, 0.f, 0.f, 0.f}; }
    for (int ki = 0; ki < 5; ++ki) {
        int blk, rel; bool valid, local;
        if (qctx) { blk = ki; valid = ki < 2; local = false; rel = 0; }
        else if (ki < 3) { blk = qb - 1 + ki; valid = blk >= 2 && blk <= 17; local = true; rel = ki - 1; }
        else { blk = ki - 3; valid = true; local = false; rel = 0; }
        if (!valid) continue;
        const int rowk0 = b * TPB + blk * 128;
        {
            const int key = tid >> 2, g = tid & 3; const bf16_t* kp = P + (size_t)(rowk0 + key) * NP + PC_SK + kvh * 64 + g * 8;
            const u32x4 r1 = *(const u32x4*)kp, r2 = *(const u32x4*)(kp + 32);
            u32x4 o1 = r1, o2 = r2;
            if (local) { float a1[8], a2[8];
#pragma unroll
                for (int e = 0; e < 4; ++e) { a1[2 * e] = bflo(r1[e]); a1[2 * e + 1] = bfhi(r1[e]); a2[2 * e] = bflo(r2[e]); a2[2 * e + 1] = bfhi(r2[e]); }
                const int t = (blk - 2) * 128 + key; const float* cp = rc + t * 32 + g * 8; const float* sp = rs + t * 32 + g * 8;
#pragma unroll
                for (int e = 0; e < 8; ++e) { const float cs = cp[e], sn = sp[e]; const float x1 = a1[e] * cs - a2[e] * sn, x2 = a1[e] * sn + a2[e] * cs; a1[e] = x1; a2[e] = x2; }
#pragma unroll
                for (int e = 0; e < 4; ++e) { o1[e] = pk2(a1[2 * e], a1[2 * e + 1]); o2[e] = pk2(a2[2 * e], a2[2 * e + 1]); } }
            *(LAS u32x4*)(Ks + key * KST + g * 8) = o1; *(LAS u32x4*)(Ks + key * KST + 32 + g * 8) = o2;
#pragma unroll
            for (int it = 0; it < 2; ++it) { const int idx = tid + NTHR * it; const int vk = idx >> 3, vg = idx & 7;
                const u32x4 rv = *(const u32x4*)(P + (size_t)(rowk0 + vk) * NP + PC_SV + kvh * 64 + vg * 8);
#pragma unroll
                for (int e = 0; e < 4; ++e) { Vt[(vg * 8 + 2 * e) * VST + vk] = (bf16_t)(rv[e] & 0xffffu); Vt[(vg * 8 + 2 * e + 1) * VST + vk] = (bf16_t)(rv[e] >> 16); } }
        }
        __syncthreads();
#pragma unroll
        for (int qt = 0; qt < 4; ++qt) {
            f32x4 Sx[8];
#pragma unroll
            for (int kt = 0; kt < 8; ++kt) { Sx[kt] = (f32x4){0.f, 0.f, 0.f, 0.f};
#pragma unroll
                for (int kk = 0; kk < 2; ++kk) { const bf16x8 A = *(const LAS bf16x8*)(Ks + (kt * 16 + fr) * KST + kk * 32 + fq * 8);
                    Sx[kt] = __builtin_amdgcn_mfma_f32_16x16x32_bf16(A, qf[qt][kk], Sx[kt], 0, 0, 0); } }
            if (rel != 0) { int qi = qhalf * 64 + qt * 16 + fr; asm volatile("" : "+v"(qi));
#pragma unroll
                for (int kt = 0; kt < 8; ++kt)
#pragma unroll
                    for (int j = 0; j < 4; ++j) { const int kx = kt * 16 + fq * 4 + j; const bool ok = rel < 0 ? (kx >= qi) : (kx <= qi); if (!ok) Sx[kt][j] = -1e30f; } }
            float mx = -1e30f;
#pragma unroll
            for (int kt = 0; kt < 8; ++kt) mx = fmaxf(mx, fmaxf(fmaxf(Sx[kt][0], Sx[kt][1]), fmaxf(Sx[kt][2], Sx[kt][3])));
            mx = xrow16_max(mx);
            const float mnew = fmaxf(mrun[qt], mx); const float alpha = __expf(mrun[qt] - mnew); mrun[qt] = mnew;
            float rsum = 0.f;
#pragma unroll
            for (int kt = 0; kt < 8; ++kt)
#pragma unroll
                for (int j = 0; j < 4; ++j) { const float e = __expf(Sx[kt][j] - mnew); Sx[kt][j] = e; rsum += e; }
            rsum = xrow16_sum(rsum);
            lrun[qt] = lrun[qt] * alpha + rsum;
#pragma unroll
            for (int dv = 0; dv < 4; ++dv) O[qt][dv] = O[qt][dv] * alpha;
#pragma unroll
            for (int ks2 = 0; ks2 < 4; ++ks2) {
                u32x4 pb; pb[0] = pk2(Sx[2 * ks2][0], Sx[2 * ks2][1]); pb[1] = pk2(Sx[2 * ks2][2], Sx[2 * ks2][3]); pb[2] = pk2(Sx[2 * ks2 + 1][0], Sx[2 * ks2 + 1][1]); pb[3] = pk2(Sx[2 * ks2 + 1][2], Sx[2 * ks2 + 1][3]);
                const bf16x8 Bp = __builtin_bit_cast(bf16x8, pb);
#pragma unroll
                for (int dv = 0; dv < 4; ++dv) { const LAS bf16_t* vp = Vt + (dv * 16 + fr) * VST + ks2 * 32 + fq * 4;
                    const u32x2 lo = *(const LAS u32x2*)vp, hi = *(const LAS u32x2*)(vp + 16);
                    u32x4 av; av[0] = lo[0]; av[1] = lo[1]; av[2] = hi[0]; av[3] = hi[1];
                    O[qt][dv] = __builtin_amdgcn_mfma_f32_16x16x32_bf16(__builtin_bit_cast(bf16x8, av), Bp, O[qt][dv], 0, 0, 0); }
            }
        }
        __syncthreads();
    }
#pragma unroll
    for (int qt = 0; qt < 4; ++qt) { const float inv = 1.f / lrun[qt]; const int row = rowq0 + qt * 16 + fr;
#pragma unroll
        for (int dv = 0; dv < 4; ++dv) { u32x2 o2; o2[0] = pk2(O[qt][dv][0] * inv, O[qt][dv][1] * inv); o2[1] = pk2(O[qt][dv][2] * inv, O[qt][dv][3] * inv);
            *(u32x2*)(Y + (size_t)row * D + 256 + head * 64 + dv * 16 + fq * 4) = o2; } }
}

__device__ __forceinline__ void phase_mixers(const Params& p, int l, LAS unsigned char* lds, const int wvs) {
    for (int s = blockIdx.x; s < 256; s += gridDim.x) { if (s < 128) dn_seq(p, l, s, lds, wvs); else hg_seq(p, l, s - 128, lds, wvs); }
    unsigned* ctr = (unsigned*)(p.ws + WS_CTL) + 64 * (1 + l);
    LAS int* su = (LAS int*)(lds + 140 * 1024);
    for (;;) {
        __syncthreads();
        if (wvs == 0 && lane_id_fresh() == 0) su[0] = (int)atomicAdd(ctr, 1u);
        __syncthreads();
        const int unit = su[0];
        if (unit >= 576) break;
        swa_unit(p, l, unit, lds, wvs);
    }
}

__device__ __forceinline__ void phase_finalize(const Params& p, int l, const int wvs) {
    const int tid = wvs * 64 + lane_id_fresh(); const int lane = tid & 63, w = tid >> 6;
    const int gw = blockIdx.x * NWAVES + w, NGW = gridDim.x * NWAVES;
    const bf16_t* P = (const bf16_t*)(p.ws + WS_P);
    const bf16_t* OD0 = (const bf16_t*)(p.ws + WS_OD); const bf16_t* OD1 = OD0 + (size_t)M * 512;
    bf16_t* Y = (bf16_t*)(p.ws + WS_HY);
    const int seg = lane >> 3, d0 = (lane & 7) * 8;
    const int hd = seg & 3; const bool isdn = seg < 4;
    const float* gain = (isdn ? p.dn_norm : p.hg_norm) + l * 64 + d0;
    const f32x4 g0 = *(const f32x4*)gain, g1 = *(const f32x4*)(gain + 4);
    const int ocol = (isdn ? 0 : 256) + hd * 64 + d0, gcol = (isdn ? PC_DNG : PC_HG) + hd * 64 + d0, ycol = (isdn ? 0 : 768) + hd * 64 + d0;
    for (int r = gw; r < M; r += NGW) {
        const u32x4 a = *(const u32x4*)(OD0 + (size_t)r * 512 + ocol), bq = *(const u32x4*)(OD1 + (size_t)r * 512 + ocol), gt = *(const u32x4*)(P + (size_t)r * NP + gcol);
        float o[8]; float ss = 0.f;
#pragma unroll
        for (int e = 0; e < 4; ++e) { o[2 * e] = bflo(a[e]) + bflo(bq[e]); o[2 * e + 1] = bfhi(a[e]) + bfhi(bq[e]); ss += o[2 * e] * o[2 * e] + o[2 * e + 1] * o[2 * e + 1]; }
        ss = sum8(ss);
        const float rms = rsqrtf(ss * (1.f / 64.f) + EPS);
        u32x4 y;
#pragma unroll
        for (int e = 0; e < 4; ++e) { const float ga = bflo(gt[e]), gb = bfhi(gt[e]);
            const float ge0 = e < 2 ? g0[2 * e] : g1[2 * e - 4], ge1 = e < 2 ? g0[2 * e + 1] : g1[2 * e - 3];
            y[e] = pk2(o[2 * e] * rms * ge0 * siluf(ga), o[2 * e + 1] * rms * ge1 * siluf(gb)); }
        *(u32x4*)(Y + (size_t)r * D + ycol) = y;
    }
}

__device__ __forceinline__ void phase_final(const Params& p, const int wvs) {
    const int tid = wvs * 64 + lane_id_fresh(); const int lane = tid & 63, w = tid >> 6;
    const int gw = blockIdx.x * NWAVES + w, NGW = gridDim.x * NWAVES;
    for (int r = gw; r < BATCH * SEQ; r += NGW) {
        f32x4* xr = (f32x4*)(p.out + ((size_t)r << 10)) + lane;
        f32x4 v[4]; float ss = 0.f;
#pragma unroll
        for (int j = 0; j < 4; ++j) { v[j] = xr[64 * j]; ss += (v[j][0] * v[j][0] + v[j][1] * v[j][1]) + (v[j][2] * v[j][2] + v[j][3] * v[j][3]); }
        const float rstd = rsqrtf(wave_sum(ss) * (1.f / D) + EPS);
#pragma unroll
        for (int j = 0; j < 4; ++j) { const f32x4 g = *(const f32x4*)(p.norm_f + 4 * (lane + 64 * j)); xr[64 * j] = v[j] * rstd * g; }
    }
}

#define XB_TMO      128
#define XB_XCNT(j)  (256  + 64 * (j))
#define XB_XSUB(j)  (1280 + 64 * (j))
#define XB_XGEN(j)  (2304 + 64 * (j))
#define XB_TOP      3328
#define XB_TOPGEN   3392
#define XCD_BAR_WORDS 3456
#define XB_SPIN_CAP (1u << 18)

__device__ __forceinline__ unsigned xb_ld(unsigned* p)              { return __hip_atomic_load(p, __ATOMIC_RELAXED, __HIP_MEMORY_SCOPE_AGENT); }
__device__ __forceinline__ unsigned xb_add(unsigned* p, unsigned v) { return __hip_atomic_fetch_add(p, v, __ATOMIC_RELAXED, __HIP_MEMORY_SCOPE_AGENT); }
__device__ __forceinline__ unsigned xb_xcc_id() { return (unsigned)__builtin_amdgcn_s_getreg((3 << 11) | 20) & 0xFu; }
#define XB_SPIN(cond, bar) do { unsigned _sp = 0; while (cond) { __builtin_amdgcn_s_sleep(1); \
    if ((++_sp & 255u) == 0u) { if (xb_ld(&(bar)[XB_TMO])) break; if (_sp > XB_SPIN_CAP) { atomicAdd(&(bar)[XB_TMO], 1u); break; } } } } while (0)

struct XcdBarrier {
    unsigned* bar; unsigned x;
    volatile LAS unsigned* st;
};

__device__ __forceinline__ XcdBarrier xcd_barrier_post(unsigned* bar, volatile LAS unsigned* st) {
    XcdBarrier b; b.bar = bar; b.x = xb_xcc_id(); b.st = st;
    if (threadIdx.x == 0) (void)xb_add(&bar[XB_XCNT(b.x)], 1u);
    return b;
}
__device__ __forceinline__ void xcd_barrier_complete(unsigned* bar, unsigned x, unsigned& nloc, unsigned& nx) {
    const unsigned G = gridDim.x * gridDim.y * gridDim.z;
    unsigned sum, cnt, mine, sp = 0u;
    for (;;) {
        sum = 0u; cnt = 0u; mine = 0u;
#pragma unroll
        for (unsigned j = 0; j < 16; ++j) { const unsigned c = xb_ld(&bar[XB_XCNT(j)]); sum += c; cnt += (c > 0u) ? 1u : 0u; mine = (j == x) ? c : mine; }
        if (sum == G) break;
        __builtin_amdgcn_s_sleep(1);
        if ((++sp & 255u) == 0u) { if (xb_ld(&bar[XB_TMO])) break; if (sp > XB_SPIN_CAP) { atomicAdd(&bar[XB_TMO], 1u); break; } }
    }
    nloc = mine > 0u ? mine : 1u; nx = cnt > 0u ? cnt : 1u;
}

__device__ __forceinline__ void xcd_barrier(const XcdBarrier& b) {
    asm volatile("s_waitcnt vmcnt(0)" ::: "memory");
    __syncthreads();
    if (threadIdx.x == 0) {
        unsigned* bar = b.bar;
        __builtin_amdgcn_s_waitcnt(0);
        unsigned nloc = b.st[0], nx = b.st[1];
        if (nloc == 0u) { xcd_barrier_complete(bar, b.x, nloc, nx); b.st[0] = nloc; b.st[1] = nx; }
        const unsigned old = xb_add(&bar[XB_XSUB(b.x)], 1u);
        const unsigned gen = old / nloc;
        if (old + 1u == (gen + 1u) * nloc) {
            __builtin_amdgcn_fence(__ATOMIC_RELEASE, "agent");
            asm volatile("s_waitcnt vmcnt(0)" ::: "memory");
            const unsigned og = xb_add(&bar[XB_TOP], 1u);
            const unsigned tg = og / nx;
            if (og + 1u == (tg + 1u) * nx) xb_add(&bar[XB_TOPGEN], 1u);
            else XB_SPIN(xb_ld(&bar[XB_TOPGEN]) == tg, bar);
            __builtin_amdgcn_fence(__ATOMIC_ACQUIRE, "agent");
            xb_add(&bar[XB_XGEN(b.x)], 1u);
            asm volatile("s_waitcnt vmcnt(0)" ::: "memory");
        } else {
            XB_SPIN(xb_ld(&bar[XB_XGEN(b.x)]) == gen, bar);
            __builtin_amdgcn_fence(__ATOMIC_ACQUIRE, "agent");
            asm volatile("s_waitcnt vmcnt(0)" ::: "memory");
        }
    }
    __syncthreads();
}

__device__ __forceinline__ void gsync(cg::grid_group& grid) {
    asm volatile("s_waitcnt vmcnt(0) lgkmcnt(0)" ::: "memory");
    grid.sync();
    __builtin_amdgcn_fence(__ATOMIC_ACQUIRE, "agent");
    asm volatile("s_waitcnt vmcnt(0)" ::: "memory");
}
__global__ void __launch_bounds__(NTHR, 2) fwd_megakernel(Params p) {
    extern __shared__ __attribute__((aligned(16))) unsigned char lds_raw[];
    LAS unsigned char* lds = (LAS unsigned char*)lds_raw;
    cg::grid_group grid = cg::this_grid();
    const int G = gridDim.x, c = blockIdx.x;
    const int wvs = __builtin_amdgcn_readfirstlane((int)(threadIdx.x >> 6));
    { volatile LAS unsigned* st0 = (volatile LAS unsigned*)(lds + 143360 + 64); if (threadIdx.x < 2) st0[threadIdx.x] = 0u; }
    __syncthreads();
    const XcdBarrier xbar = xcd_barrier_post((unsigned*)(p.ws + WS_CTL) + 4096, (volatile LAS unsigned*)(lds + 143360 + 64));
    phase_prologue(p, lds, wvs);
    gsync(grid);
    const float* mods = (const float*)(p.ws + WS_MODS);
    float* Xc = (float*)(p.ws + WS_XC);
    bf16_t* HY = (bf16_t*)(p.ws + WS_HY); bf16_t* PB = (bf16_t*)(p.ws + WS_P);
    for (int l = 0; l < DEPTH; ++l) {
        const int lastl = (l == DEPTH - 1) ? 1 : 0;
        phase_norm<true>(p, l, lds, wvs);
        xcd_barrier(xbar);
        { pg8::Gemm g{HY, (const bf16_t*)(p.ws + WS_WIN), M, NP, D}; pg8::StaticOrder S; S.init(M, NP, G, c); pg8::EpiBf16<0> E{PB, NP};
          pg8::gemm_phase<pg8::EpiBf16<0>, pg8::StaticOrder, true, true>(lds, g, S, E, wvs); }
        xcd_barrier(xbar);
        phase_mixers(p, l, lds, wvs);
        xcd_barrier(xbar);
        phase_finalize(p, l, wvs);
        xcd_barrier(xbar);
        { pg8::Gemm g{HY, (const bf16_t*)(p.ws + WS_WOUT), M, D, D}; pg8::Order2 S; S.init(D, G, c, lastl); pg8::EpiRes E{p.out, Xc, mods + ((size_t)l * 17 * 6 + 2) * 1024};
          pg8::gemm_phase<pg8::EpiRes, pg8::Order2, true, true>(lds, g, S, E, wvs); }
        xcd_barrier(xbar);
        phase_norm<false>(p, l, lds, wvs);
        xcd_barrier(xbar);
        { pg8::Gemm g{HY, (const bf16_t*)(p.ws + WS_W1), M, DFF, D}; pg8::Order2 S; S.init(DFF, G, c, lastl); pg8::EpiBf16<1> E{PB, DFF};
          pg8::gemm_phase<pg8::EpiBf16<1>, pg8::Order2, true, true>(lds, g, S, E, wvs); }
        xcd_barrier(xbar);
        { pg8::Gemm g{PB, (const bf16_t*)(p.ws + WS_W2), M, D, DFF}; pg8::Order2 S; S.init(D, G, c, lastl); pg8::EpiRes E{p.out, Xc, mods + ((size_t)l * 17 * 6 + 5) * 1024};
          pg8::gemm_phase<pg8::EpiRes, pg8::Order2, true, true>(lds, g, S, E, wvs); }
        xcd_barrier(xbar);
    }
    phase_final(p, wvs);
}

extern "C" void kernel_launch(void* const* d_in, const int* in_sizes, int n_in, void* d_out, int out_size, void* d_ws, size_t ws_size, hipStream_t stream) {
    static int grid = 0;
    if (grid == 0) {
        if (n_in != 20 || ws_size < WS_END) { fprintf(stderr, "kernel_launch: need 20 inputs and >= %zu bytes of workspace (got %d, %zu)\n", (size_t)WS_END, n_in, ws_size); grid = -1; return; }
        int dev = 0, cus = 0, per_cu = 0;
        hipGetDevice(&dev); hipDeviceGetAttribute(&cus, hipDeviceAttributeMultiprocessorCount, dev);
        if (hipFuncSetAttribute((const void*)fwd_megakernel, hipFuncAttributeMaxDynamicSharedMemorySize, LDS_BYTES) != hipSuccess) { fprintf(stderr, "kernel_launch: hipFuncSetAttribute failed\n"); grid = -1; return; }
        if (hipOccupancyMaxActiveBlocksPerMultiprocessor(&per_cu, (const void*)fwd_megakernel, NTHR, LDS_BYTES) != hipSuccess || per_cu < 1) { fprintf(stderr, "kernel_launch: occupancy query says %d blocks/CU\n", per_cu); per_cu = 1; }
        (void)hipGetLastError();
        grid = cus;
    }
    if (grid < 0) return;
    hipMemsetAsync((char*)d_ws + WS_CTL, 0, 65536, stream);
    Params p{};
    const float** pp = (const float**)&p;
    for (int i = 0; i < 20; ++i) pp[i] = (const float*)d_in[i];
    p.out = (float*)d_out; p.ws = (unsigned char*)d_ws;
    void* args[] = {&p};
    hipError_t e = hipLaunchCooperativeKernel((const void*)fwd_megakernel, dim3(grid), dim3(NTHR), args, LDS_BYTES, stream);
    if (e != hipSuccess) fprintf(stderr, "cooperative launch failed: %s (grid %d)\n", hipGetErrorString(e), grid);
}
```

```cpp
#include <hip/hip_runtime.h>
#include <hip/hip_cooperative_groups.h>
#include <cstdio>
#include <cstdint>
namespace cg = cooperative_groups;

__device__ __forceinline__ int lane_id_fresh() { unsigned m = ~0u; asm volatile("" : "+s"(m)); return (int)__builtin_amdgcn_mbcnt_hi(m, __builtin_amdgcn_mbcnt_lo(m, 0u)); }
namespace pg8 {
#define PG8_LAS __attribute__((address_space(3)))
typedef unsigned short bf16_t;
typedef short bf16x8 __attribute__((ext_vector_type(8)));
typedef float f32x4 __attribute__((ext_vector_type(4)));
typedef unsigned u32x4 __attribute__((ext_vector_type(4)));
constexpr int BM = 256, BK = 64, HALF = 128, HTB = HALF * BK * 2  , STAGE_BYTES = 8 * HTB, NXCD = 8, WGM = 8;

__host__ __device__ __forceinline__ int lds_byte(int r, int c) { const int st = (r >> 4) * 2 + (c >> 5), rr = r & 15, cc = c & 31, ob = rr * 64 + cc * 2; return st * 1024 + (ob ^ (((ob >> 9) & 1) << 5)); }
__host__ __device__ __forceinline__ void stage_rc(int b, int& R, int& C) { const int st = b / 1024, sb = b % 1024, swz = sb ^ (((sb >> 9) & 1) << 5); R = (st >> 1) * 16 + swz / 64; C = (st & 1) * 32 + (swz % 64) / 2; }
__host__ __device__ __forceinline__ int perm32(int rho) { const int n = rho >> 4, i = rho & 15; return 8 * (i >> 2) + 4 * n + (i & 3); }

struct Unit { int pm, pn; };
struct Gemm { const bf16_t* A; const bf16_t* Bt; int M, N, K; };

struct StaticOrder {
    int nM, nN, nwg, G, c;
    __host__ __device__ void init(int M, int N, int G_, int c_) { nM = M / BM; nN = N / BM; nwg = nM * nN; G = G_; c = c_; }
    __host__ __device__ bool next(int i, Unit& u) const {
        const long L = (long)i * G + c; if (L >= nwg) return false;
        int wgid = (int)L; { const int q = nwg / NXCD, r = nwg % NXCD, xcd = wgid % NXCD, off = wgid / NXCD; wgid = (xcd < r ? xcd * (q + 1) : r * (q + 1) + (xcd - r) * q) + off; }
        const int nig = WGM * nN, gid = wgid / nig, fm = gid * WGM, gsz = (nM - fm) < WGM ? (nM - fm) : WGM;
        u.pm = fm + ((wgid % nig) % gsz); u.pn = (wgid % nig) / gsz; return true;
    }
    __device__ __forceinline__ void a_ready(const Unit&) const {}
    __device__ __forceinline__ void done(const Unit&) const {}
};

struct Order2 {
    StaticOrder so; int lat;
    __host__ __device__ void init(int N, int G_, int c_, int lat_) { lat = lat_; so.init(lat_ ? 32768 : 36864, N, G_, c_); }
    __host__ __device__ bool next(int i, Unit& u) const { if (!so.next(i, u)) return false; if (lat) u.pm = (u.pm >> 3) * 9 + 1 + (u.pm & 7); return true; }
    __device__ __forceinline__ void a_ready(const Unit&) const {}
    __device__ __forceinline__ void done(const Unit&) const {}
};
__device__ __forceinline__ unsigned cvt_pk_bf16(float lo, float hi) { unsigned r; asm volatile("v_cvt_pk_bf16_f32 %0, %1, %2" : "=v"(r) : "v"(lo), "v"(hi)); return r; }

template <int ACT  > struct EpiBf16 {
    static constexpr bool PERM = true, AFTER_DRAIN = false;
    bf16_t* O; int ldc;
    __device__ __forceinline__ void operator()(const f32x4 (&acc)[2][2][4][2], const Unit& u, int wr, int wc, int fr, int fq) const {
        const int row0 = u.pm * BM + wr * 64 + fr; const int col0 = u.pn * BM + wc * 32 + 8 * fq;
#pragma unroll
        for (int ai = 0; ai < 2; ++ai)
#pragma unroll
            for (int m = 0; m < 4; ++m) { bf16_t* rowp = O + (size_t)(row0 + ai * HALF + m * 16) * ldc + col0;
#pragma unroll
                for (int bj = 0; bj < 2; ++bj) { f32x4 v0 = acc[ai][bj][m][0], v1 = acc[ai][bj][m][1];
                    if (ACT == 1) {
#pragma unroll
                        for (int e = 0; e < 4; ++e) { float a = fmaxf(v0[e], 0.f), b = fmaxf(v1[e], 0.f); v0[e] = a * a; v1[e] = b * b; } }
                    u32x4 w; w.x = cvt_pk_bf16(v0[0], v0[1]); w.y = cvt_pk_bf16(v0[2], v0[3]); w.z = cvt_pk_bf16(v1[0], v1[1]); w.w = cvt_pk_bf16(v1[2], v1[3]);
                    *(u32x4*)(rowp + bj * HALF) = w; } }
    }
};
struct EpiRes {
    static constexpr bool PERM = false, AFTER_DRAIN = false;
    float* Xl; float* Xc; const float* gates;
    const float* Xl_in; const float* Xc_in;
    __device__ __forceinline__ void operator()(const f32x4 (&acc)[2][2][4][2], const Unit& u, int wr, int wc, int fr, int fq) const {
        const int b = u.pm / 9, tt = u.pm - b * 9;
        const size_t toff = (tt == 0) ? ((size_t)(b * 256) << 10) : ((size_t)(b * 2048 + (tt - 1) * 256) << 10);
        float* base = ((tt == 0) ? Xc : Xl) + toff; const float* base_in = ((tt == 0) ? Xc_in : Xl_in) + toff;
        const float* g = gates + (size_t)((tt == 0) ? 16 : b) * 6144;
        const int col0 = u.pn * BM + wc * 32 + 4 * fq;
        float* rp0 = base + ((size_t)(wr * 64 + fr) << 10) + col0; const float* rq0 = base_in + ((size_t)(wr * 64 + fr) << 10) + col0;
#pragma unroll
        for (int bj = 0; bj < 2; ++bj)
#pragma unroll
            for (int n = 0; n < 2; ++n) { const f32x4 gvv = *(const f32x4*)(g + col0 + bj * HALF + n * 16);
#pragma unroll
                for (int ai = 0; ai < 2; ++ai) {
#pragma unroll
                    for (int m = 0; m < 4; ++m) { const size_t eo = (size_t)(ai * HALF + m * 16) * 1024 + bj * HALF + n * 16; f32x4 xv = *(const f32x4*)(rq0 + eo); xv = xv + gvv * acc[ai][bj][m][n]; *(f32x4*)(rp0 + eo) = xv; }
                    asm volatile("" ::: "memory"); } }
    }
};
template <class Epi, class Sched, bool ALIGN_EPI = false, bool SP2 = false>
__device__ __forceinline__ void gemm_phase(PG8_LAS unsigned char* lds, const Gemm g, const Sched& S, const Epi& E, const int wvs) {
    const int tid = wvs * 64 + lane_id_fresh(); const int wid = __builtin_amdgcn_readfirstlane(tid >> 6), lane = tid & 63, wr = wid >> 2, wc = wid & 3, fr = lane & 15, fq = lane >> 4;
    const int K = g.K, nt = K / BK;
    unsigned voffA[2], voffB[2];
#pragma unroll
    for (int i = 0; i < 2; ++i) { int R, C; stage_rc(tid * 16 + i * 8192, R, C); const int Rb = Epi::PERM ? ((R & ~31) + perm32(R & 31)) : R;
        voffA[i] = (unsigned)(R * K + C) * 2u; voffB[i] = (unsigned)(Rb * K + C) * 2u; }
    const size_t kstep = (size_t)(BK * 2);
    const size_t hstep = (size_t)HALF * K * 2;
    const size_t tstep = 2 * hstep;
    const unsigned ldsw = (unsigned)wid * 1024u;
    const int aoff = lds_byte(wr * 64 + fr, fq * 8), boff = lds_byte(wc * 32 + fr, fq * 8);
#define PG8_SA(b, h) (((b) * 2 + (h)) * HTB)
#define PG8_SB(b, h) ((4 + (b) * 2 + (h)) * HTB)
#define PG8_STAGE(bufoff, gbase, voff) do { _Pragma("unroll") for (int _i = 0; _i < 2; ++_i) \
        __builtin_amdgcn_global_load_lds((const unsigned*)((const char*)(gbase) + (voff)[_i]), (PG8_LAS unsigned*)(lds + (bufoff) + ldsw + _i * 8192), 16, 0, 0); } while (0)
#define PG8_LDA(dst, b, h) do { _Pragma("unroll") for (int m = 0; m < 4; ++m) _Pragma("unroll") for (int k = 0; k < 2; ++k) dst[m][k] = *(const PG8_LAS bf16x8*)(lds + PG8_SA(b, h) + aoff + m * 2048 + k * 1024); } while (0)
#define PG8_LDB(dst, b, h) do { _Pragma("unroll") for (int n = 0; n < 2; ++n) _Pragma("unroll") for (int k = 0; k < 2; ++k) dst[n][k] = *(const PG8_LAS bf16x8*)(lds + PG8_SB(b, h) + boff + n * 2048 + k * 1024); } while (0)
#define PG8_MMA(ai, bj, At, Bt) do { __builtin_amdgcn_s_setprio(1); _Pragma("unroll") for (int m = 0; m < 4; ++m) _Pragma("unroll") for (int n = 0; n < 2; ++n) _Pragma("unroll") for (int k = 0; k < 2; ++k) \
        acc[ai][bj][m][n] = __builtin_amdgcn_mfma_f32_16x16x32_bf16(Bt[n][k], At[m][k], acc[ai][bj][m][n], 0, 0, 0); __builtin_amdgcn_s_setprio(0); } while (0)
#define PG8_WAIT_V(n) asm volatile("s_waitcnt vmcnt(" #n ")" ::: "memory")
#define PG8_WAIT_L(n) asm volatile("s_waitcnt lgkmcnt(" #n ")" ::: "memory")
#define PG8_BAR __builtin_amdgcn_s_barrier()
#define PG8_SCHED __builtin_amdgcn_sched_barrier(0)
    Unit cur, nxt; int ui = 0;
    if (!S.next(0, cur)) return;
    f32x4 acc[2][2][4][2];
#pragma unroll
    for (int a = 0; a < 2; ++a)
#pragma unroll
        for (int b = 0; b < 2; ++b)
#pragma unroll
            for (int m = 0; m < 4; ++m)
#pragma unroll
                for (int n = 0; n < 2; ++n) acc[a][b][m][n] = (f32x4){0.f, 0.f, 0.f, 0.f};
    bf16x8 At[4][2], B0[2][2], B1[2][2];
    const char* cA = (const char*)g.A + (size_t)cur.pm * tstep; const char* cB = (const char*)g.Bt + (size_t)cur.pn * tstep;
    S.a_ready(cur);
    if constexpr (SP2) {
        PG8_STAGE(PG8_SB(0, 0), cB, voffB); PG8_STAGE(PG8_SB(0, 1), cB + hstep, voffB); PG8_STAGE(PG8_SA(0, 0), cA, voffA); PG8_STAGE(PG8_SA(0, 1), cA + hstep, voffA);
        if (wr == 1) PG8_BAR;
        PG8_WAIT_V(2); PG8_BAR;
        PG8_STAGE(PG8_SB(1, 0), cB + kstep, voffB); PG8_STAGE(PG8_SA(1, 0), cA + kstep, voffA); PG8_STAGE(PG8_SB(1, 1), cB + hstep + kstep, voffB);
        PG8_WAIT_V(6); PG8_BAR;
    } else {
        PG8_STAGE(PG8_SB(0, 0), cB, voffB); PG8_STAGE(PG8_SA(0, 0), cA, voffA); PG8_STAGE(PG8_SB(0, 1), cB + hstep, voffB); PG8_STAGE(PG8_SA(0, 1), cA + hstep, voffA);
        if (wr == 1) PG8_BAR;
        PG8_WAIT_V(4); PG8_BAR;
        PG8_STAGE(PG8_SB(1, 0), cB + kstep, voffB); PG8_STAGE(PG8_SA(1, 0), cA + kstep, voffA); PG8_STAGE(PG8_SB(1, 1), cB + hstep + kstep, voffB);
        PG8_WAIT_V(6); PG8_BAR;
    }
    for (;;) {
        const bool has_next = S.next(ui + 1, nxt);
        const char* nA = has_next ? (const char*)g.A + (size_t)nxt.pm * tstep : cA; const char* nB = has_next ? (const char*)g.Bt + (size_t)nxt.pn * tstep : cB;
        for (int t = 0; t < nt; t += 2) {
            const bool last = (t == nt - 2);
            const char* a1 = cA + (size_t)(t + 1) * kstep;
            const char* a2 = last ? nA : cA + (size_t)(t + 2) * kstep; const char* b2 = last ? nB : cB + (size_t)(t + 2) * kstep;
            const char* a3 = a2 + kstep; const char* b3 = b2 + kstep;
            if (last && has_next) S.a_ready(nxt);
            if constexpr (SP2) {
            PG8_LDB(B0, 0, 0); PG8_LDB(B1, 0, 1); PG8_SCHED; PG8_LDA(At, 0, 0); PG8_STAGE(PG8_SA(1, 1), a1 + hstep, voffA);
            PG8_WAIT_V(8); PG8_WAIT_L(0); PG8_BAR; PG8_MMA(0, 0, At, B0); PG8_MMA(0, 1, At, B1); PG8_BAR; PG8_SCHED;
            PG8_LDA(At, 0, 1); PG8_STAGE(PG8_SB(0, 0), b2, voffB); PG8_STAGE(PG8_SB(0, 1), b2 + hstep, voffB); PG8_STAGE(PG8_SA(0, 0), a2, voffA);
            PG8_WAIT_V(8); PG8_WAIT_L(0); PG8_BAR; PG8_MMA(1, 0, At, B0); PG8_MMA(1, 1, At, B1); PG8_BAR; PG8_SCHED;
            PG8_LDB(B0, 1, 0); PG8_LDB(B1, 1, 1); PG8_SCHED; PG8_LDA(At, 1, 0); PG8_STAGE(PG8_SA(0, 1), a2 + hstep, voffA);
            PG8_WAIT_V(8); PG8_WAIT_L(0); PG8_BAR; PG8_MMA(0, 0, At, B0); PG8_MMA(0, 1, At, B1); PG8_BAR; PG8_SCHED;
            PG8_LDA(At, 1, 1); PG8_STAGE(PG8_SB(1, 0), b3, voffB); PG8_STAGE(PG8_SB(1, 1), b3 + hstep, voffB); PG8_STAGE(PG8_SA(1, 0), a3, voffA);
            PG8_WAIT_V(8); PG8_WAIT_L(0); PG8_BAR; PG8_MMA(1, 0, At, B0); PG8_MMA(1, 1, At, B1); PG8_BAR; PG8_SCHED;
            } else {
            PG8_LDB(B0, 0, 0); PG8_SCHED; PG8_LDA(At, 0, 0); PG8_STAGE(PG8_SA(1, 1), a1 + hstep, voffA);
            PG8_WAIT_L(8); PG8_BAR; PG8_WAIT_L(0); PG8_MMA(0, 0, At, B0); PG8_BAR; PG8_SCHED;
            PG8_LDB(B1, 0, 1); PG8_STAGE(PG8_SB(0, 0), b2, voffB);
            PG8_BAR; PG8_WAIT_L(0); PG8_MMA(0, 1, At, B1); PG8_BAR;
            PG8_LDA(At, 0, 1); PG8_STAGE(PG8_SA(0, 0), a2, voffA);
            PG8_BAR; PG8_WAIT_L(0); PG8_MMA(1, 0, At, B0); PG8_BAR; PG8_SCHED;
            PG8_STAGE(PG8_SB(0, 1), b2 + hstep, voffB);
            PG8_WAIT_V(6); PG8_BAR; PG8_MMA(1, 1, At, B1); PG8_BAR;
            PG8_LDB(B0, 1, 0); PG8_SCHED; PG8_LDA(At, 1, 0); PG8_STAGE(PG8_SA(0, 1), a2 + hstep, voffA);
            PG8_WAIT_L(8); PG8_BAR; PG8_WAIT_L(0); PG8_MMA(0, 0, At, B0); PG8_BAR; PG8_SCHED;
            PG8_LDB(B1, 1, 1); PG8_STAGE(PG8_SB(1, 0), b3, voffB);
            PG8_BAR; PG8_WAIT_L(0); PG8_MMA(0, 1, At, B1); PG8_BAR;
            PG8_LDA(At, 1, 1); PG8_STAGE(PG8_SA(1, 0), a3, voffA);
            PG8_BAR; PG8_WAIT_L(0); PG8_MMA(1, 0, At, B0); PG8_BAR; PG8_SCHED;
            PG8_STAGE(PG8_SB(1, 1), b3 + hstep, voffB);
            PG8_WAIT_V(6); PG8_BAR; PG8_MMA(1, 1, At, B1); PG8_BAR;
            }
        }
        if constexpr (ALIGN_EPI) { if (wr == 0) PG8_BAR; }
        if constexpr (!Epi::AFTER_DRAIN) { E(acc, cur, wr, wc, fr, fq); S.done(cur); }
        if (!has_next) break;
#pragma unroll
        for (int a = 0; a < 2; ++a)
#pragma unroll
            for (int b = 0; b < 2; ++b)
#pragma unroll
                for (int m = 0; m < 4; ++m)
#pragma unroll
                    for (int n = 0; n < 2; ++n) acc[a][b][m][n] = (f32x4){0.f, 0.f, 0.f, 0.f};
        cur = nxt; cA = nA; cB = nB; ++ui;
        if constexpr (ALIGN_EPI) { if (wr == 1) PG8_BAR; }
    }
    PG8_WAIT_V(0);
    if constexpr (!ALIGN_EPI) { if (wr == 0) PG8_BAR; }
    PG8_BAR;
    if constexpr (Epi::AFTER_DRAIN) { E.fused(acc, cur, wr, wc, fr, fq, lds, wid, lane); S.done(cur); }
#undef PG8_SA
#undef PG8_SB
#undef PG8_STAGE
#undef PG8_LDA
#undef PG8_LDB
#undef PG8_MMA
#undef PG8_WAIT_V
#undef PG8_WAIT_L
#undef PG8_BAR
#undef PG8_SCHED
}
}

constexpr int D = 1024, BATCH = 16, SEQ = 2048, CTX = 256, DEPTH = 4;
constexpr int TPB = CTX + SEQ;
constexpr int M = BATCH * TPB;
constexpr int DIN = 3088, NP = 3072, DFF = 4096;
constexpr int PC_DNQ = 0, PC_DNG = 768, PC_SQ = 1024, PC_SK = 1536, PC_SV = 1664, PC_HQ = 1792, PC_HF = 2048, PC_HI = 2560, PC_HG = 2816;
constexpr float EPS = 1e-6f;
constexpr size_t MiB = 1u << 20;
constexpr size_t WS_CTL = 0, WS_MODS = 1 * MiB, WS_ROPE = 3 * MiB, WS_LB = 3 * MiB + 512 * 1024, WS_AB = 4 * MiB;
constexpr size_t WS_WIN = 7 * MiB, WS_WOUT = 13 * MiB, WS_W1 = 15 * MiB, WS_W2 = 23 * MiB, WS_XC = 32 * MiB, WS_HY = 48 * MiB, WS_P = 120 * MiB;
constexpr size_t WS_OD = WS_P + 216 * MiB, WS_QKV = WS_P + 288 * MiB, WS_END = WS_QKV + 54 * MiB;
constexpr int LDS_BYTES = 147456;
constexpr int NWAVES = 8, NTHR = 512;

#define LAS __attribute__((address_space(3)))
typedef unsigned short bf16_t;
typedef float f32x4 __attribute__((ext_vector_type(4)));
typedef short bf16x8 __attribute__((ext_vector_type(8)));
typedef short s16x4 __attribute__((ext_vector_type(4)));
typedef unsigned u32x4 __attribute__((ext_vector_type(4)));
typedef unsigned u32x2 __attribute__((ext_vector_type(2)));

struct Params {
    const float *x, *c, *ctx, *c_ctx, *w_ada, *b_ada, *norm1, *norm2, *w_in, *dn_conv, *dn_A_log, *dn_dt_bias, *dn_norm, *swa_sink, *hg_lb, *hg_norm, *w_out, *w_ff1, *w_ff2, *norm_f;
    float* out; unsigned char* ws;
};

__device__ __forceinline__ float bflo(unsigned u) { return __uint_as_float(u << 16); }
__device__ __forceinline__ float bfhi(unsigned u) { return __uint_as_float(u & 0xffff0000u); }
__device__ __forceinline__ unsigned pk2(float lo, float hi) { return pg8::cvt_pk_bf16(lo, hi); }
__device__ __forceinline__ bf16_t bf1(float f) { unsigned u = __float_as_uint(f); u += 0x7fffu + ((u >> 16) & 1u); return (bf16_t)(u >> 16); }
__device__ __forceinline__ float siluf(float v) { return v / (1.f + __expf(-v)); }
__device__ __forceinline__ float sigmf(float v) { return 1.f / (1.f + __expf(-v)); }
__device__ __forceinline__ float wave_sum(float v) {
#pragma unroll
    for (int o = 1; o < 64; o <<= 1) v += __shfl_xor(v, o);
    return v;
}
template <int CTRL> __device__ __forceinline__ float dpp(float x) { return __builtin_bit_cast(float, __builtin_amdgcn_mov_dpp(__builtin_bit_cast(int, x), CTRL, 0xf, 0xf, true)); }
constexpr int XOR1 = 0xB1, XOR2 = 0x4E, XOR7 = 0x141;
__device__ __forceinline__ float sum8(float v) { v += dpp<XOR1>(v); v += dpp<XOR2>(v); v += dpp<XOR7>(v); return v; }
__device__ __forceinline__ float xrow16_max(float x) {
    auto s = __builtin_amdgcn_permlane16_swap(__float_as_uint(x), __float_as_uint(x), false, false);
    x = fmaxf(__uint_as_float(s[0]), __uint_as_float(s[1]));
    auto t = __builtin_amdgcn_permlane32_swap(__float_as_uint(x), __float_as_uint(x), false, false);
    return fmaxf(__uint_as_float(t[0]), __uint_as_float(t[1]));
}
__device__ __forceinline__ float xrow16_sum(float x) {
    auto s = __builtin_amdgcn_permlane16_swap(__float_as_uint(x), __float_as_uint(x), false, false);
    x = __uint_as_float(s[0]) + __uint_as_float(s[1]);
    auto t = __builtin_amdgcn_permlane32_swap(__float_as_uint(x), __float_as_uint(x), false, false);
    return __uint_as_float(t[0]) + __uint_as_float(t[1]);
}
__device__ __forceinline__ const float* xrow_c(const float* Xl, const float* Xc, int r) { const int b = r / TPB, t = r - b * TPB; return t < CTX ? Xc + ((size_t)(b * CTX + t) << 10) : Xl + ((size_t)(b * SEQ + t - CTX) << 10); }
__device__ __forceinline__ int cidx(int r) { const int b = r / TPB, t = r - b * TPB; return t < CTX ? 16 : b; }

__device__ __forceinline__ void phase_prologue(const Params& p, LAS unsigned char* lds, const int wvs) {
    const int tid = wvs * 64 + lane_id_fresh(); const int lane = tid & 63, w = tid >> 6;
    float* mods = (float*)(p.ws + WS_MODS);
    LAS float* sc = (LAS float*)lds;
    LAS float* red = (LAS float*)(lds + 81920);
    for (int idx = tid; idx < 17 * 1024; idx += NTHR) { const int ci = idx >> 10, k = idx & 1023; const float v = ci < 16 ? p.c[ci * 1024 + k] : p.c_ctx[k]; sc[k * 20 + ci] = v / (1.f + expf(-v)); }
    __syncthreads();
    for (int it = blockIdx.x; it < DEPTH * 96; it += gridDim.x) {
        const int l = it / 96, cgp = it - l * 96, col = cgp * 64 + lane;
        float acc[17];
#pragma unroll
        for (int i = 0; i < 17; ++i) acc[i] = 0.f;
        const float* wp = p.w_ada + ((size_t)l * 1024 + w * 128) * 6144 + col;
#pragma unroll 16
        for (int kk = 0; kk < 128; ++kk) {
            const float wv = wp[(size_t)kk * 6144];
            const LAS f32x4* s4 = (const LAS f32x4*)(sc + (w * 128 + kk) * 20);
            const f32x4 s0 = s4[0], s1 = s4[1], s2 = s4[2], s3 = s4[3]; const float s16 = sc[(w * 128 + kk) * 20 + 16];
#pragma unroll
            for (int e = 0; e < 4; ++e) { acc[e] += wv * s0[e]; acc[4 + e] += wv * s1[e]; acc[8 + e] += wv * s2[e]; acc[12 + e] += wv * s3[e]; }
            acc[16] += wv * s16;
        }
#pragma unroll
        for (int i = 0; i < 17; ++i) red[(w * 17 + i) * 64 + lane] = acc[i];
        __syncthreads();
        for (int idx = tid; idx < 17 * 64; idx += NTHR) { const int i = idx >> 6, cl = idx & 63; float s = 0.f;
#pragma unroll
            for (int ww = 0; ww < 8; ++ww) s += red[(ww * 17 + i) * 64 + cl];
            mods[((size_t)l * 17 + i) * 6144 + cgp * 64 + cl] = s + p.b_ada[l * 6144 + cgp * 64 + cl]; }
        __syncthreads();
    }
    const int gt = blockIdx.x * NTHR + tid, GT = gridDim.x * NTHR;
    { float* rc = (float*)(p.ws + WS_ROPE); float* rs = rc + 2048 * 32;
      for (int idx = gt; idx < 2048 * 32; idx += GT) { const int t = idx >> 5, d = idx & 31; const float pos = (float)(d < 16 ? (t >> 6) : (t & 63));
          const float inv = expf(-(float)(d & 15) * (9.210340371976184f / 16.f)); const float ang = pos * inv; rc[idx] = cosf(ang); rs[idx] = sinf(ang); } }
    { float* LB = (float*)(p.ws + WS_LB);
      for (int idx = gt; idx < 2 * 256; idx += GT) { const int d = idx >> 8, cc = idx & 255; float v[DEPTH]; float mx = -1e30f;
#pragma unroll
          for (int l = 0; l < DEPTH; ++l) { v[l] = p.hg_lb[(d * DEPTH + l) * 256 + cc]; mx = fmaxf(mx, v[l]); }
          float s = 0.f;
#pragma unroll
          for (int l = 0; l < DEPTH; ++l) { v[l] = expf(v[l] - mx); s += v[l]; }
          float cum = 0.f;
#pragma unroll
          for (int l = 0; l < DEPTH; ++l) { if (l > 0) cum += v[l] / s; LB[(d * DEPTH + l) * 256 + cc] = cum; } } }
}

__device__ __forceinline__ void transpose_item(const float* W, int K, int ldw, int scol0, bf16_t* WT, int n0, int k0, LAS float* scr, int lane) {
#pragma unroll 8
    for (int i = 0; i < 32; ++i) { const int kk = 2 * i + (lane >> 5); scr[kk * 33 + (lane & 31)] = W[(size_t)(k0 + kk) * ldw + scol0 + (lane & 31)]; }
    asm volatile("s_waitcnt lgkmcnt(0)" ::: "memory");
    const int c = lane & 7;
#pragma unroll
    for (int j = 0; j < 4; ++j) { const int n = (lane >> 3) + 8 * j; const LAS float* s = scr + (8 * c) * 33 + n;
        u32x4 o; o.x = pk2(s[0 * 33], s[1 * 33]); o.y = pk2(s[2 * 33], s[3 * 33]); o.z = pk2(s[4 * 33], s[5 * 33]); o.w = pk2(s[6 * 33], s[7 * 33]);
        *(u32x4*)(WT + (size_t)(n0 + n) * K + k0 + 8 * c) = o; }
    asm volatile("s_waitcnt lgkmcnt(0)" ::: "memory");
}

template <bool FIRST> __device__ __forceinline__ void phase_norm(const Params& p, int l, LAS unsigned char* lds, const int wvs) {
    const int tid = wvs * 64 + lane_id_fresh(); const int lane = tid & 63, w = tid >> 6;
    const int gw = blockIdx.x * NWAVES + w, NGW = gridDim.x * NWAVES;
    const float* mods = (const float*)(p.ws + WS_MODS);
    constexpr int WST = 1032;
    LAS bf16_t* wab = (LAS bf16_t*)lds;
    if (FIRST) {
        LAS float* scr = (LAS float*)(lds + 65536 + w * 8704);
        constexpr int I_IN = 16 * 96, I_OUT = 16 * 32, I_1 = 16 * 128, I_2 = 64 * 32;
        for (int it = gw; it < I_IN + I_OUT + I_1 + I_2; it += NGW) {
            int r = it;
            if (r < I_IN) { const int kb = r / 96, nb = r - kb * 96; const int n0 = nb * 32; transpose_item(p.w_in + (size_t)l * D * DIN, D, DIN, n0 + (n0 >= 1024 ? 16 : 0), (bf16_t*)(p.ws + WS_WIN), n0, kb * 64, scr, lane); continue; }
            r -= I_IN;
            if (r < I_OUT) { const int kb = r / 32, nb = r - kb * 32; transpose_item(p.w_out + (size_t)l * D * D, D, D, nb * 32, (bf16_t*)(p.ws + WS_WOUT), nb * 32, kb * 64, scr, lane); continue; }
            r -= I_OUT;
            if (r < I_1) { const int kb = r / 128, nb = r - kb * 128; transpose_item(p.w_ff1 + (size_t)l * D * DFF, D, DFF, nb * 32, (bf16_t*)(p.ws + WS_W1), nb * 32, kb * 64, scr, lane); continue; }
            r -= I_1;
            { const int kb = r / 32, nb = r - kb * 32; transpose_item(p.w_ff2 + (size_t)l * DFF * D, DFF, D, nb * 32, (bf16_t*)(p.ws + WS_W2), nb * 32, kb * 64, scr, lane); }
        }
        const float* wi = p.w_in + (size_t)l * D * DIN + 1024;
        for (int idx = tid; idx < 4096; idx += NTHR) { const int k = idx >> 2, j4 = (idx & 3) * 4; const f32x4 v = *(const f32x4*)(wi + (size_t)k * DIN + j4);
#pragma unroll
            for (int e = 0; e < 4; ++e) wab[(j4 + e) * WST + k] = bf1(v[e]); }
        __syncthreads();
    }
    const float* nw = (FIRST ? p.norm1 : p.norm2) + l * D;
    bf16_t* H = (bf16_t*)(p.ws + WS_HY);
    float* AB = (float*)(p.ws + WS_AB);
    const float* Xc = (const float*)(p.ws + WS_XC);
    int nrows = 0;
    for (int r = gw; r < M; r += NGW) {
        ++nrows;
        if (!FIRST && l == DEPTH - 1 && (r % TPB) < CTX) continue;
        const f32x4* xr = (const f32x4*)((FIRST && l == 0) ? xrow_c(p.x, p.ctx, r) : xrow_c(p.out, Xc, r)) + lane;
        f32x4 v[4]; float ss = 0.f;
#pragma unroll
        for (int j = 0; j < 4; ++j) { v[j] = xr[64 * j]; ss += (v[j][0] * v[j][0] + v[j][1] * v[j][1]) + (v[j][2] * v[j][2] + v[j][3] * v[j][3]); }
        const float rstd = rsqrtf(wave_sum(ss) * (1.f / D) + EPS);
        const float* md = mods + ((size_t)l * 17 + cidx(r)) * 6144 + (FIRST ? 0 : 3 * 1024);
        u32x2* hp = (u32x2*)(H + (size_t)r * D) + lane;
#pragma unroll
        for (int j = 0; j < 4; ++j) { const int k = 4 * (lane + 64 * j);
            const f32x4 g = *(const f32x4*)(nw + k), sh = *(const f32x4*)(md + k), sl = *(const f32x4*)(md + 1024 + k);
            f32x4 h;
#pragma unroll
            for (int e = 0; e < 4; ++e) h[e] = (v[j][e] * rstd * g[e]) * (1.f + sl[e]) + sh[e];
            u32x2 o2; o2.x = pk2(h[0], h[1]); o2.y = pk2(h[2], h[3]); hp[64 * j] = o2;
        }
    }
    if (FIRST) {
        asm volatile("s_waitcnt vmcnt(0)" ::: "memory");
        const int fr = lane & 15, fq = lane >> 4;
        for (int b0 = 0; b0 < nrows; b0 += 16) {
            const int kr = b0 + fr; const bool ok = kr < nrows; const bf16_t* hp = H + (size_t)(gw + (ok ? kr : 0) * NGW) * D + fq * 8;
            f32x4 c = (f32x4){0.f, 0.f, 0.f, 0.f};
#pragma unroll 8
            for (int ks = 0; ks < 32; ++ks) { u32x4 av = *(const u32x4*)(hp + ks * 32); if (!ok) av = (u32x4){0u, 0u, 0u, 0u};
                const bf16x8 bv = *(const LAS bf16x8*)(wab + fr * WST + ks * 32 + fq * 8);
                c = __builtin_amdgcn_mfma_f32_16x16x32_bf16(__builtin_bit_cast(bf16x8, av), bv, c, 0, 0, 0); }
#pragma unroll
            for (int j = 0; j < 4; ++j) { const int k2 = b0 + fq * 4 + j; if (k2 < nrows) AB[(size_t)(gw + k2 * NGW) * 16 + fr] = c[j]; }
        }
    }
}

constexpr int SST = 68;
constexpr int HST = 72;
__device__ __forceinline__ bf16x8 ldA_perm(const LAS bf16_t* base, int row, int s, int fq) {
    const LAS bf16_t* ap = base + row * HST + s * 32 + fq * 4; const u32x2 lo = *(const LAS u32x2*)ap, hi = *(const LAS u32x2*)(ap + 16);
    u32x4 av; av[0] = lo[0]; av[1] = lo[1]; av[2] = hi[0]; av[3] = hi[1]; return __builtin_bit_cast(bf16x8, av);
}
__device__ __forceinline__ bf16x8 packB(const f32x4& a, const f32x4& b) {
    u32x4 pb; pb[0] = bf1(a[0]) | ((unsigned)bf1(a[1]) << 16); pb[1] = bf1(a[2]) | ((unsigned)bf1(a[3]) << 16); pb[2] = bf1(b[0]) | ((unsigned)bf1(b[1]) << 16); pb[3] = bf1(b[2]) | ((unsigned)bf1(b[3]) << 16);
    return __builtin_bit_cast(bf16x8, pb);
}
__device__ __forceinline__ void phase_dnprep(const Params& p, int l, LAS unsigned char* lds, const int wvs) {
    const int tid = wvs * 64 + lane_id_fresh();
    constexpr int RST = 200;
    LAS float* qs = (LAS float*)lds; LAS float* ks = qs + 64 * SST; LAS float* vs = ks + 64 * SST; LAS bf16_t* RAW = (LAS bf16_t*)(vs + 64 * SST);
    const bf16_t* P = (const bf16_t*)(p.ws + WS_P);
    bf16_t* QKV = (bf16_t*)(p.ws + WS_QKV);
    const float* cw = p.dn_conv + (size_t)l * 5 * 768;
    const int c4 = tid % 48, tg = tid / 48;
    LAS float* cdst = ((c4 >> 4) == 0 ? qs : ((c4 >> 4) == 1 ? ks : vs)) + (c4 & 15) * 4;
    for (int it = blockIdx.x; it < BATCH * 36 * 4; it += gridDim.x) {
        const int h = it & 3, bc = it >> 2, b = bc / 36, nc = bc - b * 36;
        const int base = b * TPB + nc * 64, lo = b * TPB + (nc < 4 ? 0 : CTX), hi = b * TPB + (nc < 4 ? CTX : TPB);
        float wc[5][4];
        { const int ch = c4 * 4, pcol = (ch >> 6) * 256 + h * 64 + (ch & 63);
#pragma unroll
          for (int t = 0; t < 5; ++t) { const f32x4 w4 = *(const f32x4*)(cw + t * 768 + pcol); wc[t][0] = w4[0]; wc[t][1] = w4[1]; wc[t][2] = w4[2]; wc[t][3] = w4[3]; } }
#pragma unroll
        for (int k = 0; k < 4; ++k) { const int q = tid + NTHR * k; if (q < 68 * 24) { const int rr = q / 24, pc = q - rr * 24; const int r = base - 2 + rr;
            const u32x4 v = (r >= lo && r < hi) ? *(const u32x4*)(P + (size_t)r * NP + (pc >> 3) * 256 + h * 64 + (pc & 7) * 8) : (u32x4){0u, 0u, 0u, 0u};
            *(LAS u32x4*)(RAW + rr * RST + pc * 8) = v; } }
        __syncthreads();
        if (tid < 480) {
#pragma unroll
            for (int m = 0; m < 7; ++m) { const int pp = tg + 10 * m; if (pp < 64) { float a0 = 0.f, a1 = 0.f, a2 = 0.f, a3 = 0.f;
#pragma unroll
                for (int t = 0; t < 5; ++t) { const u32x2 raw = *(const LAS u32x2*)(RAW + (pp + t) * RST + c4 * 4);
                    a0 += bflo(raw[0]) * wc[t][0]; a1 += bfhi(raw[0]) * wc[t][1]; a2 += bflo(raw[1]) * wc[t][2]; a3 += bfhi(raw[1]) * wc[t][3]; }
                f32x4 o; o[0] = a0 / (1.f + __expf(-a0)); o[1] = a1 / (1.f + __expf(-a1)); o[2] = a2 / (1.f + __expf(-a2)); o[3] = a3 / (1.f + __expf(-a3));
                *(LAS f32x4*)(cdst + pp * SST) = o; } } }
        __syncthreads();
        { const int t = tid >> 3, part = tid & 7;
          const f32x4 q0 = *(const LAS f32x4*)(qs + t * SST + part * 8), q1 = *(const LAS f32x4*)(qs + t * SST + part * 8 + 4);
          const f32x4 k0 = *(const LAS f32x4*)(ks + t * SST + part * 8), k1 = *(const LAS f32x4*)(ks + t * SST + part * 8 + 4);
          const f32x4 v0 = *(const LAS f32x4*)(vs + t * SST + part * 8), v1 = *(const LAS f32x4*)(vs + t * SST + part * 8 + 4);
          float sq = (q0[0] * q0[0] + q0[1] * q0[1]) + (q0[2] * q0[2] + q0[3] * q0[3]) + (q1[0] * q1[0] + q1[1] * q1[1]) + (q1[2] * q1[2] + q1[3] * q1[3]);
          float sk = (k0[0] * k0[0] + k0[1] * k0[1]) + (k0[2] * k0[2] + k0[3] * k0[3]) + (k1[0] * k1[0] + k1[1] * k1[1]) + (k1[2] * k1[2] + k1[3] * k1[3]);
          sq = sum8(sq); sk = sum8(sk);
          const float rq = rsqrtf(sq + EPS) * 0.125f, rk = rsqrtf(sk + EPS);
          u32x4 qo, ko, vo;
          qo[0] = pk2(q0[0] * rq, q0[1] * rq); qo[1] = pk2(q0[2] * rq, q0[3] * rq); qo[2] = pk2(q1[0] * rq, q1[1] * rq); qo[3] = pk2(q1[2] * rq, q1[3] * rq);
          ko[0] = pk2(k0[0] * rk, k0[1] * rk); ko[1] = pk2(k0[2] * rk, k0[3] * rk); ko[2] = pk2(k1[0] * rk, k1[1] * rk); ko[3] = pk2(k1[2] * rk, k1[3] * rk);
          vo[0] = pk2(v0[0], v0[1]); vo[1] = pk2(v0[2], v0[3]); vo[2] = pk2(v1[0], v1[1]); vo[3] = pk2(v1[2], v1[3]);
          bf16_t* dst = QKV + ((size_t)(base + t) * 4 + h) * 192 + part * 8;
          *(u32x4*)dst = qo; *(u32x4*)(dst + 64) = ko; *(u32x4*)(dst + 128) = vo; }
        __syncthreads();
    }
    { bf16_t* Pw = (bf16_t*)(p.ws + WS_P); const float* rc = (const float*)(p.ws + WS_ROPE); const float* rs = rc + 2048 * 32;
      const int gt = blockIdx.x * NTHR + tid, GT = gridDim.x * NTHR;
      for (int idx = gt; idx < BATCH * SEQ * 8; idx += GT) { const int rl = idx >> 3, rem = idx & 7, kh = rem >> 2, g = rem & 3;
          const int bb = rl >> 11, t = rl & 2047;
          bf16_t* pp = Pw + (size_t)(bb * TPB + CTX + t) * NP + PC_SK + kh * 64 + g * 8;
          const u32x4 r1 = *(const u32x4*)pp, r2 = *(const u32x4*)(pp + 32);
          const f32x4 c0 = *(const f32x4*)(rc + t * 32 + g * 8), c1 = *(const f32x4*)(rc + t * 32 + g * 8 + 4), s0 = *(const f32x4*)(rs + t * 32 + g * 8), s1 = *(const f32x4*)(rs + t * 32 + g * 8 + 4);
          u32x4 o1, o2;
#pragma unroll
          for (int e = 0; e < 4; ++e) { const float xa = bflo(r1[e]), xb = bfhi(r1[e]), ya = bflo(r2[e]), yb = bfhi(r2[e]);
              const float ca = e < 2 ? c0[2 * e] : c1[2 * e - 4], cb = e < 2 ? c0[2 * e + 1] : c1[2 * e - 3], sa = e < 2 ? s0[2 * e] : s1[2 * e - 4], sb = e < 2 ? s0[2 * e + 1] : s1[2 * e - 3];
              o1[e] = pk2(xa * ca - ya * sa, xb * cb - yb * sb); o2[e] = pk2(xa * sa + ya * ca, xb * sb + yb * cb); }
          *(u32x4*)pp = o1; *(u32x4*)(pp + 32) = o2; } }
}

__device__ __forceinline__ void dn_seq(const Params& p, int l, int s, LAS unsigned char* lds, const int wvs) {
    const int tid = wvs * 64 + lane_id_fresh(); const int lane = tid & 63;
    const int b = s >> 3, h = (s >> 1) & 3, d = s & 1;
    LAS bf16_t* QH = (LAS bf16_t*)lds; LAS bf16_t* KH = QH + 64 * HST; LAS bf16_t* VB = KH + 64 * HST; LAS bf16_t* KTT = VB + 64 * HST; LAS bf16_t* LM = KTT + 64 * HST; LAS bf16_t* SCM = LM + 64 * HST; LAS bf16_t* OB = SCM + 64 * HST;
    LAS float* LF = (LAS float*)(OB + 64 * HST);
    LAS bf16_t* DI = (LAS bf16_t*)(LF + 4 * 16 * 17);
    LAS float* GC = (LAS float*)(DI + 4 * 16 * 24); LAS float* EG = GC + 64; LAS float* BETA = EG + 64; LAS float* GL = BETA + 64;
    const bf16_t* QKV = (const bf16_t*)(p.ws + WS_QKV);
    const float* AB = (const float*)(p.ws + WS_AB);
    bf16_t* OD = (bf16_t*)(p.ws + WS_OD) + (size_t)d * M * 512 + h * 64;
    const float nA = -expf(p.dn_A_log[(l * 2 + d) * 4 + h]); const float dtb = p.dn_dt_bias[(l * 2 + d) * 4 + h];
    const int fr = lane & 15, fq = lane >> 4;
    const int V = wvs & 3, half = wvs >> 2;
    const f32x4 zero4 = (f32x4){0.f, 0.f, 0.f, 0.f};
    u32x4 praw[3]; float pa = 0.f, pb_ = 0.f;
    { const int nc0 = d == 0 ? 0 : 3; const int base0 = b * TPB + nc0 * 64;
#pragma unroll
      for (int k = 0; k < 3; ++k) { const int q = tid + NTHR * k; const int rr = q / 24, pc = q - rr * 24; praw[k] = *(const u32x4*)(QKV + ((size_t)(base0 + rr) * 4 + h) * 192 + pc * 8); }
      if (wvs == 0) { const int r = base0 + (d ? 63 - lane : lane); pa = AB[(size_t)r * 16 + d * 4 + h]; pb_ = AB[(size_t)r * 16 + 8 + d * 4 + h]; } }
    f32x4 Sacc[4];
#pragma unroll
    for (int T = 0; T < 4; ++T) Sacc[T] = zero4;
    for (int ci = 0; ci < 36; ++ci) {
        const int nc = d == 0 ? ci : (ci < 4 ? 3 - ci : 39 - ci);
        const int base = b * TPB + nc * 64;
#pragma unroll
        for (int k = 0; k < 3; ++k) { const int q = tid + NTHR * k; const int rr = q / 24, pc = q - rr * 24; const int t = d ? 63 - rr : rr;
            LAS bf16_t* dst = (pc < 8 ? QH : (pc < 16 ? KH : VB)) + t * HST + (pc & 7) * 8; *(LAS u32x4*)dst = praw[k]; }
        const float a_in = pa, b_in = pb_;
        if (ci + 1 < 36) { const int c2 = ci + 1; const int nc2 = d == 0 ? c2 : (c2 < 4 ? 3 - c2 : 39 - c2); const int base2 = b * TPB + nc2 * 64;
#pragma unroll
            for (int k = 0; k < 3; ++k) { const int q = tid + NTHR * k; const int rr = q / 24, pc = q - rr * 24; praw[k] = *(const u32x4*)(QKV + ((size_t)(base2 + rr) * 4 + h) * 192 + pc * 8); }
            if (wvs == 0) { const int r = base2 + (d ? 63 - lane : lane); pa = AB[(size_t)r * 16 + d * 4 + h]; pb_ = AB[(size_t)r * 16 + 8 + d * 4 + h]; } }
        if (wvs == 0) { const float xs = a_in + dtb; const float sp = xs > 15.f ? xs : (xs < -15.f ? __expf(xs) : __logf(1.f + __expf(xs))); float x = nA * sp;
#pragma unroll
            for (int o = 1; o < 64; o <<= 1) { const float y = __shfl_up(x, o); if (lane >= o) x += y; }
            GC[lane] = x; EG[lane] = __expf(x); BETA[lane] = 1.f / (1.f + __expf(-b_in)); if (lane == 63) { GL[0] = x; GL[1] = __expf(x); } }
        __syncthreads();
        { const int t = tid >> 3, part = tid & 7; const u32x4 kr = *(const LAS u32x4*)(KH + t * HST + part * 8); const float ekt = __expf(GL[0] - GC[t]);
#pragma unroll
          for (int e = 0; e < 4; ++e) { KTT[(part * 8 + 2 * e) * HST + t] = bf1(bflo(kr[e]) * ekt); KTT[(part * 8 + 2 * e + 1) * HST + t] = bf1(bfhi(kr[e]) * ekt); } }
        { const int I = wvs >> 1;
#pragma unroll
          for (int jj = 0; jj < 2; ++jj) { const int J = 2 * (wvs & 1) + jj; f32x4 ckk = zero4, cqk = zero4;
#pragma unroll
              for (int kk = 0; kk < 2; ++kk) { const bf16x8 Ak = *(const LAS bf16x8*)(KH + (I * 16 + fr) * HST + kk * 32 + fq * 8), Aq = *(const LAS bf16x8*)(QH + (I * 16 + fr) * HST + kk * 32 + fq * 8);
                  const bf16x8 B = *(const LAS bf16x8*)(KH + (J * 16 + fr) * HST + kk * 32 + fq * 8);
                  ckk = __builtin_amdgcn_mfma_f32_16x16x32_bf16(Ak, B, ckk, 0, 0, 0); cqk = __builtin_amdgcn_mfma_f32_16x16x32_bf16(Aq, B, cqk, 0, 0, 0); }
              const int j = J * 16 + fr; const float gj = GC[j];
#pragma unroll
              for (int r = 0; r < 4; ++r) { const int i = I * 16 + fq * 4 + r; const float dec = __expf(fminf(GC[i] - gj, 0.f));
                  const float lv = j < i ? BETA[i] * ckk[r] * dec : 0.f, sv = j <= i ? cqk[r] * dec : 0.f;
                  LM[i * HST + j] = bf1(lv); SCM[i * HST + j] = bf1(sv); if (I == J) LF[(I * 16 + fq * 4 + r) * 17 + fr] = lv; } } }
        __syncthreads();
        if (wvs == 0) { const int I = lane >> 4, c = lane & 15; float x[16];
#pragma unroll
            for (int i = 0; i < 16; ++i) { float acc = (i == c) ? 1.f : 0.f;
#pragma unroll
                for (int j = 0; j < i; ++j) acc -= LF[(I * 16 + i) * 17 + j] * x[j];
                x[i] = acc; DI[(I * 16 + i) * 24 + c] = bf1(acc); } }
        f32x4 R[4], QS[2];
        { bf16x8 Bs[2];
#pragma unroll
          for (int s2 = 0; s2 < 2; ++s2) Bs[s2] = packB(Sacc[2 * s2], Sacc[2 * s2 + 1]);
#pragma unroll
          for (int I = 0; I < 4; ++I) { f32x4 c = zero4;
#pragma unroll
              for (int s2 = 0; s2 < 2; ++s2) c = __builtin_amdgcn_mfma_f32_16x16x32_bf16(ldA_perm(KH, I * 16 + fr, s2, fq), Bs[s2], c, 0, 0, 0);
#pragma unroll
              for (int r = 0; r < 4; ++r) { const int i = I * 16 + fq * 4 + r; R[I][r] = BETA[i] * (bflo((unsigned)VB[i * HST + V * 16 + fr]) - EG[i] * c[r]); } }
#pragma unroll
          for (int ii = 0; ii < 2; ++ii) { const int I = 2 * half + ii; f32x4 c = zero4;
#pragma unroll
              for (int s2 = 0; s2 < 2; ++s2) c = __builtin_amdgcn_mfma_f32_16x16x32_bf16(ldA_perm(QH, I * 16 + fr, s2, fq), Bs[s2], c, 0, 0, 0);
              QS[ii] = c; } }
        __syncthreads();
        bf16x8 Bx0, Bx1;
        { bf16x8 AD[4];
#pragma unroll
          for (int I = 0; I < 4; ++I) { const u32x2 lo = *(const LAS u32x2*)(DI + (I * 16 + fr) * 24 + fq * 4); u32x4 av; av[0] = lo[0]; av[1] = lo[1]; av[2] = 0u; av[3] = 0u; AD[I] = __builtin_bit_cast(bf16x8, av); }
          const f32x4 X0 = __builtin_amdgcn_mfma_f32_16x16x32_bf16(AD[0], packB(R[0], zero4), zero4, 0, 0, 0);
          f32x4 T1 = __builtin_amdgcn_mfma_f32_16x16x32_bf16(ldA_perm(LM, 16 + fr, 0, fq), packB(X0, zero4), zero4, 0, 0, 0);
          const f32x4 X1 = __builtin_amdgcn_mfma_f32_16x16x32_bf16(AD[1], packB(R[1] - T1, zero4), zero4, 0, 0, 0);
          Bx0 = packB(X0, X1);
          f32x4 T2 = __builtin_amdgcn_mfma_f32_16x16x32_bf16(ldA_perm(LM, 32 + fr, 0, fq), Bx0, zero4, 0, 0, 0);
          const f32x4 X2 = __builtin_amdgcn_mfma_f32_16x16x32_bf16(AD[2], packB(R[2] - T2, zero4), zero4, 0, 0, 0);
          f32x4 T3 = __builtin_amdgcn_mfma_f32_16x16x32_bf16(ldA_perm(LM, 48 + fr, 0, fq), Bx0, zero4, 0, 0, 0);
          T3 = __builtin_amdgcn_mfma_f32_16x16x32_bf16(ldA_perm(LM, 48 + fr, 1, fq), packB(X2, zero4), T3, 0, 0, 0);
          const f32x4 X3 = __builtin_amdgcn_mfma_f32_16x16x32_bf16(AD[3], packB(R[3] - T3, zero4), zero4, 0, 0, 0);
          Bx1 = packB(X2, X3); }
#pragma unroll
        for (int ii = 0; ii < 2; ++ii) { const int I = 2 * half + ii; f32x4 c;
#pragma unroll
            for (int r = 0; r < 4; ++r) c[r] = EG[I * 16 + fq * 4 + r] * QS[ii][r];
            c = __builtin_amdgcn_mfma_f32_16x16x32_bf16(ldA_perm(SCM, I * 16 + fr, 0, fq), Bx0, c, 0, 0, 0);
            c = __builtin_amdgcn_mfma_f32_16x16x32_bf16(ldA_perm(SCM, I * 16 + fr, 1, fq), Bx1, c, 0, 0, 0);
#pragma unroll
            for (int r = 0; r < 4; ++r) OB[(I * 16 + fq * 4 + r) * HST + V * 16 + fr] = bf1(c[r]); }
        { const float egl = GL[1];
#pragma unroll
          for (int T = 0; T < 4; ++T) { f32x4 c = Sacc[T] * egl;
              c = __builtin_amdgcn_mfma_f32_16x16x32_bf16(ldA_perm(KTT, T * 16 + fr, 0, fq), Bx0, c, 0, 0, 0);
              c = __builtin_amdgcn_mfma_f32_16x16x32_bf16(ldA_perm(KTT, T * 16 + fr, 1, fq), Bx1, c, 0, 0, 0);
              Sacc[T] = c; } }
        __syncthreads();
#pragma unroll
        for (int it = 0; it < 4; ++it) { const int idx = tid + NTHR * it; const int i = idx >> 5, c2 = (idx & 31) * 2; const int row = base + (d ? 63 - i : i);
            *(unsigned*)(OD + (size_t)row * 512 + c2) = *(const LAS unsigned*)(OB + i * HST + c2); }
    }
    __syncthreads();
}

__device__ __forceinline__ void hg_seq(const Params& p, int l, int s, LAS unsigned char* lds, const int wvs) {
    const int tid = wvs * 64 + lane_id_fresh(); const int lane = tid & 63;
    const int b = s >> 3, h = (s >> 1) & 3, d = s & 1;
    LAS bf16_t* QT = (LAS bf16_t*)lds; LAS bf16_t* KT = QT + 64 * HST; LAS bf16_t* QP = KT + 64 * HST; LAS bf16_t* KTT = QP + 64 * HST; LAS bf16_t* VT = KTT + 64 * HST; LAS bf16_t* SC = VT + 64 * HST;
    LAS float* GS = (LAS float*)(SC + 64 * HST); LAS float* MID = GS + 512; LAS float* BLS = MID + 64; LAS float* EBL = BLS + 64; LAS bf16_t* OB = (LAS bf16_t*)(EBL + 64);
    const bf16_t* P = (const bf16_t*)(p.ws + WS_P);
    bf16_t* OD = (bf16_t*)(p.ws + WS_OD) + (size_t)d * M * 512 + 256 + h * 64;
    const int kx = tid & 63, g = tid >> 6;
    const float lb = ((const float*)(p.ws + WS_LB))[(d * DEPTH + l) * 256 + h * 64 + kx];
    const int fr = lane & 15, fq = lane >> 4;
    const int V = wvs & 3, half = wvs >> 2;
    f32x4 Sacc[4];
#pragma unroll
    for (int T = 0; T < 4; ++T) Sacc[T] = (f32x4){0.f, 0.f, 0.f, 0.f};
    unsigned short rq[8], rz[8], rv[8];
    { const int nc = d == 0 ? 0 : 3; const int base = b * TPB + nc * 64;
#pragma unroll
      for (int e = 0; e < 8; ++e) { const int t = g * 8 + e; const int pp = d ? 63 - t : t; const bf16_t* rp = P + (size_t)(base + pp) * NP + h * 64 + kx;
          rq[e] = rp[PC_HQ]; rz[e] = rp[PC_HF + d * 256]; rv[e] = rp[PC_HI]; } }
    for (int ci = 0; ci < 36; ++ci) {
        const int nc = d == 0 ? ci : (ci < 4 ? 3 - ci : 39 - ci);
        const int base = b * TPB + nc * 64;
        float qv[8], kv[8], bc[8]; float run = 0.f;
#pragma unroll
        for (int e = 0; e < 8; ++e) { const float z = bflo(rz[e]); const float sg = 1.f / (1.f + __expf(-z)); const float f = lb + (1.f - lb) * sg;
            run += __logf(f); bc[e] = run; kv[e] = (1.f - lb) * (1.f - sg); qv[e] = bflo(rq[e]); }
        GS[g * 64 + kx] = run;
#pragma unroll
        for (int e = 0; e < 8; ++e) VT[kx * HST + g * 8 + e] = rv[e];
        __syncthreads();
        { float off = 0.f;
#pragma unroll
          for (int gg = 0; gg < 7; ++gg) { const float x = GS[gg * 64 + kx]; off += (gg < g) ? x : 0.f; }
#pragma unroll
          for (int e = 0; e < 8; ++e) bc[e] += off; }
        if (g == 3) MID[kx] = bc[7];
        if (g == 7) { BLS[kx] = bc[7]; EBL[kx] = __expf(bc[7]); }
        if (ci + 1 < 36) { const int c2 = ci + 1; const int nc2 = d == 0 ? c2 : (c2 < 4 ? 3 - c2 : 39 - c2); const int base2 = b * TPB + nc2 * 64;
#pragma unroll
            for (int e = 0; e < 8; ++e) { const int t = g * 8 + e; const int pp = d ? 63 - t : t; const bf16_t* rp = P + (size_t)(base2 + pp) * NP + h * 64 + kx;
                rq[e] = rp[PC_HQ]; rz[e] = rp[PC_HF + d * 256]; rv[e] = rp[PC_HI]; } }
        __syncthreads();
        { const float mid = MID[kx], bl = BLS[kx];
#pragma unroll
          for (int e = 0; e < 8; ++e) { const int t = g * 8 + e; const float E = fminf(fmaxf(bc[e] - mid, -80.f), 80.f);
              const float eq = __expf(E), ek = __expf(-E);
              QT[t * HST + kx] = bf1(qv[e] * eq); KT[t * HST + kx] = bf1(kv[e] * ek);
              QP[t * HST + kx] = bf1(qv[e] * __expf(bc[e])); KTT[kx * HST + t] = bf1(kv[e] * __expf(bl - bc[e])); } }
        __syncthreads();
        { const int I = wvs >> 1;
#pragma unroll
          for (int jj = 0; jj < 2; ++jj) { const int J = 2 * (wvs & 1) + jj; f32x4 c = (f32x4){0.f, 0.f, 0.f, 0.f};
#pragma unroll
              for (int kk = 0; kk < 2; ++kk) { const bf16x8 A = *(const LAS bf16x8*)(QT + (I * 16 + fr) * HST + kk * 32 + fq * 8); const bf16x8 B = *(const LAS bf16x8*)(KT + (J * 16 + fr) * HST + kk * 32 + fq * 8);
                  c = __builtin_amdgcn_mfma_f32_16x16x32_bf16(A, B, c, 0, 0, 0); }
#pragma unroll
              for (int r = 0; r < 4; ++r) { const int i = I * 16 + fq * 4 + r, j = J * 16 + fr; SC[i * HST + j] = bf1(j <= i ? c[r] : 0.f); } } }
        __syncthreads();
        { bf16x8 Bs[2];
#pragma unroll
          for (int s2 = 0; s2 < 2; ++s2) { u32x4 pb; pb[0] = bf1(Sacc[2 * s2][0]) | ((unsigned)bf1(Sacc[2 * s2][1]) << 16); pb[1] = bf1(Sacc[2 * s2][2]) | ((unsigned)bf1(Sacc[2 * s2][3]) << 16); pb[2] = bf1(Sacc[2 * s2 + 1][0]) | ((unsigned)bf1(Sacc[2 * s2 + 1][1]) << 16); pb[3] = bf1(Sacc[2 * s2 + 1][2]) | ((unsigned)bf1(Sacc[2 * s2 + 1][3]) << 16); Bs[s2] = __builtin_bit_cast(bf16x8, pb); }
          bf16x8 Bv[2];
#pragma unroll
          for (int s2 = 0; s2 < 2; ++s2) Bv[s2] = *(const LAS bf16x8*)(VT + (V * 16 + fr) * HST + s2 * 32 + fq * 8);
#pragma unroll
          for (int ii = 0; ii < 2; ++ii) { const int I = 2 * half + ii; f32x4 o = (f32x4){0.f, 0.f, 0.f, 0.f};
#pragma unroll
              for (int s2 = 0; s2 < 2; ++s2) { const LAS bf16_t* ap = QP + (I * 16 + fr) * HST + s2 * 32 + fq * 4; const u32x2 lo = *(const LAS u32x2*)ap, hi = *(const LAS u32x2*)(ap + 16);
                  u32x4 av; av[0] = lo[0]; av[1] = lo[1]; av[2] = hi[0]; av[3] = hi[1];
                  o = __builtin_amdgcn_mfma_f32_16x16x32_bf16(__builtin_bit_cast(bf16x8, av), Bs[s2], o, 0, 0, 0); }
#pragma unroll
              for (int s2 = 0; s2 < 2; ++s2) { const bf16x8 A = *(const LAS bf16x8*)(SC + (I * 16 + fr) * HST + s2 * 32 + fq * 8); o = __builtin_amdgcn_mfma_f32_16x16x32_bf16(A, Bv[s2], o, 0, 0, 0); }
#pragma unroll
              for (int r = 0; r < 4; ++r) { const int i = I * 16 + fq * 4 + r; OB[i * HST + V * 16 + fr] = bf1(o[r]); } }
#pragma unroll
          for (int T = 0; T < 4; ++T) { f32x4 c;
#pragma unroll
              for (int r = 0; r < 4; ++r) c[r] = Sacc[T][r] * EBL[T * 16 + fq * 4 + r];
#pragma unroll
              for (int s2 = 0; s2 < 2; ++s2) { const bf16x8 A = *(const LAS bf16x8*)(KTT + (T * 16 + fr) * HST + s2 * 32 + fq * 8); c = __builtin_amdgcn_mfma_f32_16x16x32_bf16(A, Bv[s2], c, 0, 0, 0); }
              Sacc[T] = c; } }
        __syncthreads();
#pragma unroll
        for (int it = 0; it < 4; ++it) { const int idx = tid + NTHR * it; const int i = idx >> 5, c2 = (idx & 31) * 2; const int row = base + (d ? 63 - i : i);
            *(unsigned*)(OD + (size_t)row * 512 + c2) = *(const LAS unsigned*)(OB + i * HST + c2); }
    }
}

constexpr int KST = 72, VST = 136;
__device__ __forceinline__ void swa_unit(const Params& p, int l, int unit, LAS unsigned char* lds, const int wvs) {
    const int tid = wvs * 64 + lane_id_fresh(); const int lane = tid & 63;
    const int b = unit / 36, rem = unit - b * 36, kvh = rem / 18, qb = rem - kvh * 18;
    const bool qctx = qb < 2;
    const bf16_t* P = (const bf16_t*)(p.ws + WS_P);
    const float* rc = (const float*)(p.ws + WS_ROPE); const float* rs = rc + 2048 * 32;
    bf16_t* Y = (bf16_t*)(p.ws + WS_HY);
    LAS bf16_t* Ks = (LAS bf16_t*)lds; LAS bf16_t* Vt = Ks + 128 * KST;
    const int hh = wvs >> 1, qhalf = wvs & 1, head = kvh * 4 + hh;
    const int fr = lane & 15, fq = lane >> 4;
    const int rowq0 = b * TPB + qb * 128 + qhalf * 64;
    const int f0 = (!qctx && qb == 2) ? 1 : 0, nl = qctx ? 0 : 3 - f0 - (qb == 17 ? 1 : 0), nkb = nl + 2;
#define SWA_BLK(j) ((j) < nl ? qb - 1 + f0 + (j) : (j) - nl)
#define SWA_REL(j) ((j) < nl ? f0 + (j) - 1 : 0)
    bf16x8 qf[4][2];
#pragma unroll
    for (int qt = 0; qt < 4; ++qt) {
        const int row = rowq0 + qt * 16 + fr; const bf16_t* qp = P + (size_t)row * NP + PC_SQ + head * 64 + fq * 8;
        const u32x4 r1 = *(const u32x4*)qp, r2 = *(const u32x4*)(qp + 32);
        float a1[8], a2[8];
#pragma unroll
        for (int e = 0; e < 4; ++e) { a1[2 * e] = bflo(r1[e]); a1[2 * e + 1] = bfhi(r1[e]); a2[2 * e] = bflo(r2[e]); a2[2 * e + 1] = bfhi(r2[e]); }
        if (!qctx) { const int t = (qb - 2) * 128 + qhalf * 64 + qt * 16 + fr; const float* cp = rc + t * 32 + fq * 8; const float* sp = rs + t * 32 + fq * 8;
#pragma unroll
            for (int e = 0; e < 8; ++e) { const float cs = cp[e], sn = sp[e]; const float o1 = a1[e] * cs - a2[e] * sn, o2 = a1[e] * sn + a2[e] * cs; a1[e] = o1; a2[e] = o2; } }
        u32x4 o1, o2;
#pragma unroll
        for (int e = 0; e < 4; ++e) { o1[e] = pk2(a1[2 * e] * 0.125f, a1[2 * e + 1] * 0.125f); o2[e] = pk2(a2[2 * e] * 0.125f, a2[2 * e + 1] * 0.125f); }
        qf[qt][0] = __builtin_bit_cast(bf16x8, o1); qf[qt][1] = __builtin_bit_cast(bf16x8, o2);
    }
    const int skey = tid >> 2, sg = tid & 3;
    const float sink = p.swa_sink[l * 8 + head];
    float mrun[4], lrun[4]; f32x4 O[4][4];
#pragma unroll
    for (int qt = 0; qt < 4; ++qt) { mrun[qt] = sink; lrun[qt] = 1.f;
#pragma unroll
        for (int dv = 0; dv < 4; ++dv) O[qt][dv] = (f32x4){0.f, 0.f, 0.f, 0.f}; }
    for (int j = 0; j < nkb; ++j) {
        const int rel = SWA_REL(j);
        u32x4 kreg[2], vreg[2];
        { const int rowk0 = b * TPB + SWA_BLK(j) * 128; const bf16_t* kp = P + (size_t)(rowk0 + skey) * NP + PC_SK + kvh * 64 + sg * 8;
          kreg[0] = *(const u32x4*)kp; kreg[1] = *(const u32x4*)(kp + 32);
#pragma unroll
          for (int it = 0; it < 2; ++it) { const int idx = tid + NTHR * it; vreg[it] = *(const u32x4*)(P + (size_t)(rowk0 + (idx >> 3)) * NP + PC_SV + kvh * 64 + (idx & 7) * 8); } }
        *(LAS u32x4*)(Ks + skey * KST + sg * 8) = kreg[0]; *(LAS u32x4*)(Ks + skey * KST + 32 + sg * 8) = kreg[1];
#pragma unroll
        for (int it = 0; it < 2; ++it) { const int idx = tid + NTHR * it; const int vk = idx >> 3, vg = idx & 7;
#pragma unroll
            for (int e = 0; e < 4; ++e) { Vt[(vg * 8 + 2 * e) * VST + vk] = (bf16_t)(vreg[it][e] & 0xffffu); Vt[(vg * 8 + 2 * e + 1) * VST + vk] = (bf16_t)(vreg[it][e] >> 16); } }
        __syncthreads();
#pragma unroll
        for (int qp2 = 0; qp2 < 2; ++qp2) {
            f32x4 Sx[2][8];
#pragma unroll
            for (int kt = 0; kt < 8; ++kt) { Sx[0][kt] = (f32x4){0.f, 0.f, 0.f, 0.f}; Sx[1][kt] = (f32x4){0.f, 0.f, 0.f, 0.f};
#pragma unroll
                for (int kk = 0; kk < 2; ++kk) { const bf16x8 A = *(const LAS bf16x8*)(Ks + (kt * 16 + fr) * KST + kk * 32 + fq * 8);
                    Sx[0][kt] = __builtin_amdgcn_mfma_f32_16x16x32_bf16(A, qf[2 * qp2][kk], Sx[0][kt], 0, 0, 0);
                    Sx[1][kt] = __builtin_amdgcn_mfma_f32_16x16x32_bf16(A, qf[2 * qp2 + 1][kk], Sx[1][kt], 0, 0, 0); } }
#pragma unroll
            for (int u = 0; u < 2; ++u) { const int qt = 2 * qp2 + u;
                if (rel != 0) { int qi = qhalf * 64 + qt * 16 + fr; asm volatile("" : "+v"(qi));
#pragma unroll
                    for (int kt = 0; kt < 8; ++kt)
#pragma unroll
                        for (int jx = 0; jx < 4; ++jx) { const int kx = kt * 16 + fq * 4 + jx; const bool ok = rel < 0 ? (kx >= qi) : (kx <= qi); if (!ok) Sx[u][kt][jx] = -1e30f; } }
                float mx = -1e30f;
#pragma unroll
                for (int kt = 0; kt < 8; ++kt) mx = fmaxf(mx, fmaxf(fmaxf(Sx[u][kt][0], Sx[u][kt][1]), fmaxf(Sx[u][kt][2], Sx[u][kt][3])));
                mx = xrow16_max(mx);
                const float mnew = fmaxf(mrun[qt], mx); const float alpha = __expf(mrun[qt] - mnew); mrun[qt] = mnew;
                float rsum = 0.f;
#pragma unroll
                for (int kt = 0; kt < 8; ++kt)
#pragma unroll
                    for (int jx = 0; jx < 4; ++jx) { const float e = __expf(Sx[u][kt][jx] - mnew); Sx[u][kt][jx] = e; rsum += e; }
                rsum = xrow16_sum(rsum);
                lrun[qt] = lrun[qt] * alpha + rsum;
#pragma unroll
                for (int dv = 0; dv < 4; ++dv) O[qt][dv] = O[qt][dv] * alpha; }
#pragma unroll
            for (int ks2 = 0; ks2 < 4; ++ks2) {
                bf16x8 Bp[2];
#pragma unroll
                for (int u = 0; u < 2; ++u) { u32x4 pb; pb[0] = pk2(Sx[u][2 * ks2][0], Sx[u][2 * ks2][1]); pb[1] = pk2(Sx[u][2 * ks2][2], Sx[u][2 * ks2][3]); pb[2] = pk2(Sx[u][2 * ks2 + 1][0], Sx[u][2 * ks2 + 1][1]); pb[3] = pk2(Sx[u][2 * ks2 + 1][2], Sx[u][2 * ks2 + 1][3]); Bp[u] = __builtin_bit_cast(bf16x8, pb); }
#pragma unroll
                for (int dv = 0; dv < 4; ++dv) { const LAS bf16_t* vp = Vt + (dv * 16 + fr) * VST + ks2 * 32 + fq * 4;
                    const u32x2 lo = *(const LAS u32x2*)vp, hi = *(const LAS u32x2*)(vp + 16);
                    u32x4 av; av[0] = lo[0]; av[1] = lo[1]; av[2] = hi[0]; av[3] = hi[1]; const bf16x8 Av = __builtin_bit_cast(bf16x8, av);
                    O[2 * qp2][dv] = __builtin_amdgcn_mfma_f32_16x16x32_bf16(Av, Bp[0], O[2 * qp2][dv], 0, 0, 0);
                    O[2 * qp2 + 1][dv] = __builtin_amdgcn_mfma_f32_16x16x32_bf16(Av, Bp[1], O[2 * qp2 + 1][dv], 0, 0, 0); }
            }
        }
        __syncthreads();
    }
#undef SWA_BLK
#undef SWA_REL
#pragma unroll
    for (int qt = 0; qt < 4; ++qt) { const float inv = 1.f / lrun[qt]; const int row = rowq0 + qt * 16 + fr;
#pragma unroll
        for (int dv = 0; dv < 4; ++dv) { u32x2 o2; o2[0] = pk2(O[qt][dv][0] * inv, O[qt][dv][1] * inv); o2[1] = pk2(O[qt][dv][2] * inv, O[qt][dv][3] * inv);
            *(u32x2*)(Y + (size_t)row * D + 256 + head * 64 + dv * 16 + fq * 4) = o2; } }
}

__device__ __forceinline__ void phase_mixers(const Params& p, int l, LAS unsigned char* lds, const int wvs) {
    for (int s = blockIdx.x; s < 256; s += gridDim.x) { if (s < 128) dn_seq(p, l, s, lds, wvs); else hg_seq(p, l, s - 128, lds, wvs); }
    unsigned* ctr = (unsigned*)(p.ws + WS_CTL) + 64 * (1 + l);
    LAS int* su = (LAS int*)(lds + 140 * 1024);
    for (;;) {
        __syncthreads();
        if (wvs == 0 && lane_id_fresh() == 0) su[0] = (int)atomicAdd(ctr, 1u);
        __syncthreads();
        const int unit = su[0];
        if (unit >= 576) break;
        swa_unit(p, l, unit, lds, wvs);
    }
}

__device__ __forceinline__ void phase_finalize(const Params& p, int l, const int wvs) {
    const int tid = wvs * 64 + lane_id_fresh(); const int lane = tid & 63, w = tid >> 6;
    const int gw = blockIdx.x * NWAVES + w, NGW = gridDim.x * NWAVES;
    const bf16_t* P = (const bf16_t*)(p.ws + WS_P);
    const bf16_t* OD0 = (const bf16_t*)(p.ws + WS_OD); const bf16_t* OD1 = OD0 + (size_t)M * 512;
    bf16_t* Y = (bf16_t*)(p.ws + WS_HY);
    const int seg = lane >> 3, d0 = (lane & 7) * 8;
    const int hd = seg & 3; const bool isdn = seg < 4;
    const float* gain = (isdn ? p.dn_norm : p.hg_norm) + l * 64 + d0;
    const f32x4 g0 = *(const f32x4*)gain, g1 = *(const f32x4*)(gain + 4);
    const int ocol = (isdn ? 0 : 256) + hd * 64 + d0, gcol = (isdn ? PC_DNG : PC_HG) + hd * 64 + d0, ycol = (isdn ? 0 : 768) + hd * 64 + d0;
    for (int r = gw; r < M; r += NGW) {
        const u32x4 a = *(const u32x4*)(OD0 + (size_t)r * 512 + ocol), bq = *(const u32x4*)(OD1 + (size_t)r * 512 + ocol), gt = *(const u32x4*)(P + (size_t)r * NP + gcol);
        float o[8]; float ss = 0.f;
#pragma unroll
        for (int e = 0; e < 4; ++e) { o[2 * e] = bflo(a[e]) + bflo(bq[e]); o[2 * e + 1] = bfhi(a[e]) + bfhi(bq[e]); ss += o[2 * e] * o[2 * e] + o[2 * e + 1] * o[2 * e + 1]; }
        ss = sum8(ss);
        const float rms = rsqrtf(ss * (1.f / 64.f) + EPS);
        u32x4 y;
#pragma unroll
        for (int e = 0; e < 4; ++e) { const float ga = bflo(gt[e]), gb = bfhi(gt[e]);
            const float ge0 = e < 2 ? g0[2 * e] : g1[2 * e - 4], ge1 = e < 2 ? g0[2 * e + 1] : g1[2 * e - 3];
            y[e] = pk2(o[2 * e] * rms * ge0 * siluf(ga), o[2 * e + 1] * rms * ge1 * siluf(gb)); }
        *(u32x4*)(Y + (size_t)r * D + ycol) = y;
    }
}

__device__ __forceinline__ void phase_final(const Params& p, const int wvs) {
    const int tid = wvs * 64 + lane_id_fresh(); const int lane = tid & 63, w = tid >> 6;
    const int gw = blockIdx.x * NWAVES + w, NGW = gridDim.x * NWAVES;
    for (int r = gw; r < BATCH * SEQ; r += NGW) {
        f32x4* xr = (f32x4*)(p.out + ((size_t)r << 10)) + lane;
        f32x4 v[4]; float ss = 0.f;
#pragma unroll
        for (int j = 0; j < 4; ++j) { v[j] = xr[64 * j]; ss += (v[j][0] * v[j][0] + v[j][1] * v[j][1]) + (v[j][2] * v[j][2] + v[j][3] * v[j][3]); }
        const float rstd = rsqrtf(wave_sum(ss) * (1.f / D) + EPS);
#pragma unroll
        for (int j = 0; j < 4; ++j) { const f32x4 g = *(const f32x4*)(p.norm_f + 4 * (lane + 64 * j)); xr[64 * j] = v[j] * rstd * g; }
    }
}

#define XB_TMO      128
#define XB_XCNT(j)  (256  + 64 * (j))
#define XB_XSUB(j)  (1280 + 64 * (j))
#define XB_XGEN(j)  (2304 + 64 * (j))
#define XB_TOP      3328
#define XB_TOPGEN   3392
#define XCD_BAR_WORDS 3456
#define XB_SPIN_CAP (1u << 18)

__device__ __forceinline__ unsigned xb_ld(unsigned* p)              { return __hip_atomic_load(p, __ATOMIC_RELAXED, __HIP_MEMORY_SCOPE_AGENT); }
__device__ __forceinline__ unsigned xb_add(unsigned* p, unsigned v) { return __hip_atomic_fetch_add(p, v, __ATOMIC_RELAXED, __HIP_MEMORY_SCOPE_AGENT); }
__device__ __forceinline__ unsigned xb_xcc_id() { return (unsigned)__builtin_amdgcn_s_getreg((3 << 11) | 20) & 0xFu; }
#define XB_SPIN(cond, bar) do { unsigned _sp = 0; while (cond) { __builtin_amdgcn_s_sleep(1); \
    if ((++_sp & 255u) == 0u) { if (xb_ld(&(bar)[XB_TMO])) break; if (_sp > XB_SPIN_CAP) { atomicAdd(&(bar)[XB_TMO], 1u); break; } } } } while (0)

struct XcdBarrier {
    unsigned* bar; unsigned x;
    volatile LAS unsigned* st;
};

__device__ __forceinline__ XcdBarrier xcd_barrier_post(unsigned* bar, volatile LAS unsigned* st) {
    XcdBarrier b; b.bar = bar; b.x = xb_xcc_id(); b.st = st;
    if (threadIdx.x == 0) (void)xb_add(&bar[XB_XCNT(b.x)], 1u);
    return b;
}
__device__ __forceinline__ void xcd_barrier_complete(unsigned* bar, unsigned x, unsigned& nloc, unsigned& nx) {
    const unsigned G = gridDim.x * gridDim.y * gridDim.z;
    unsigned sum, cnt, mine, sp = 0u;
    for (;;) {
        sum = 0u; cnt = 0u; mine = 0u;
#pragma unroll
        for (unsigned j = 0; j < 16; ++j) { const unsigned c = xb_ld(&bar[XB_XCNT(j)]); sum += c; cnt += (c > 0u) ? 1u : 0u; mine = (j == x) ? c : mine; }
        if (sum == G) break;
        __builtin_amdgcn_s_sleep(1);
        if ((++sp & 255u) == 0u) { if (xb_ld(&bar[XB_TMO])) break; if (sp > XB_SPIN_CAP) { atomicAdd(&bar[XB_TMO], 1u); break; } }
    }
    nloc = mine > 0u ? mine : 1u; nx = cnt > 0u ? cnt : 1u;
}

__device__ __forceinline__ void xcd_barrier(const XcdBarrier& b, const int wvs) {
    asm volatile("s_waitcnt vmcnt(0)" ::: "memory");
    __syncthreads();
    if (wvs == 0 && lane_id_fresh() == 0) {
        unsigned* bar = b.bar;
        __builtin_amdgcn_s_waitcnt(0);
        unsigned nloc = b.st[0], nx = b.st[1];
        if (nloc == 0u) { xcd_barrier_complete(bar, b.x, nloc, nx); b.st[0] = nloc; b.st[1] = nx; }
        const unsigned old = xb_add(&bar[XB_XSUB(b.x)], 1u);
        const unsigned gen = old / nloc;
        if (old + 1u == (gen + 1u) * nloc) {
            __builtin_amdgcn_fence(__ATOMIC_RELEASE, "agent");
            asm volatile("s_waitcnt vmcnt(0)" ::: "memory");
            const unsigned og = xb_add(&bar[XB_TOP], 1u);
            const unsigned tg = og / nx;
            if (og + 1u == (tg + 1u) * nx) xb_add(&bar[XB_TOPGEN], 1u);
            else XB_SPIN(xb_ld(&bar[XB_TOPGEN]) == tg, bar);
            __builtin_amdgcn_fence(__ATOMIC_ACQUIRE, "agent");
            xb_add(&bar[XB_XGEN(b.x)], 1u);
            asm volatile("s_waitcnt vmcnt(0)" ::: "memory");
        } else {
            XB_SPIN(xb_ld(&bar[XB_XGEN(b.x)]) == gen, bar);
            __builtin_amdgcn_fence(__ATOMIC_ACQUIRE, "agent");
            asm volatile("s_waitcnt vmcnt(0)" ::: "memory");
        }
    }
    __syncthreads();
}

__device__ __forceinline__ void gsync(cg::grid_group& grid) {
    asm volatile("s_waitcnt vmcnt(0) lgkmcnt(0)" ::: "memory");
    grid.sync();
    __builtin_amdgcn_fence(__ATOMIC_ACQUIRE, "agent");
    asm volatile("s_waitcnt vmcnt(0)" ::: "memory");
}
__global__ void __launch_bounds__(NTHR, 2) fwd_megakernel(Params p) {
    extern __shared__ __attribute__((aligned(16))) unsigned char lds_raw[];
    LAS unsigned char* lds = (LAS unsigned char*)lds_raw;
    cg::grid_group grid = cg::this_grid();
    const int G = gridDim.x, c = blockIdx.x;
    const int wvs = __builtin_amdgcn_readfirstlane((int)(threadIdx.x >> 6));
    { volatile LAS unsigned* st0 = (volatile LAS unsigned*)(lds + 143360 + 64); if (threadIdx.x < 2) st0[threadIdx.x] = 0u; }
    __syncthreads();
    const XcdBarrier xbar = xcd_barrier_post((unsigned*)(p.ws + WS_CTL) + 4096, (volatile LAS unsigned*)(lds + 143360 + 64));
    phase_prologue(p, lds, wvs);
    gsync(grid);
    const float* mods = (const float*)(p.ws + WS_MODS);
    float* Xc = (float*)(p.ws + WS_XC);
    bf16_t* HY = (bf16_t*)(p.ws + WS_HY); bf16_t* PB = (bf16_t*)(p.ws + WS_P);
    for (int l = 0; l < DEPTH; ++l) {
        const int lastl = (l == DEPTH - 1) ? 1 : 0;
        phase_norm<true>(p, l, lds, wvs);
        xcd_barrier(xbar, wvs);
        { pg8::Gemm g{HY, (const bf16_t*)(p.ws + WS_WIN), M, NP, D}; pg8::StaticOrder S; S.init(M, NP, G, c); pg8::EpiBf16<0> E{PB, NP};
          pg8::gemm_phase<pg8::EpiBf16<0>, pg8::StaticOrder, true, true>(lds, g, S, E, wvs); }
        xcd_barrier(xbar, wvs);
        phase_dnprep(p, l, lds, wvs);
        xcd_barrier(xbar, wvs);
        phase_mixers(p, l, lds, wvs);
        xcd_barrier(xbar, wvs);
        phase_finalize(p, l, wvs);
        xcd_barrier(xbar, wvs);
        { pg8::Gemm g{HY, (const bf16_t*)(p.ws + WS_WOUT), M, D, D}; pg8::Order2 S; S.init(D, G, c, lastl); pg8::EpiRes E{p.out, Xc, mods + ((size_t)l * 17 * 6 + 2) * 1024, l == 0 ? p.x : (const float*)p.out, l == 0 ? p.ctx : (const float*)Xc};
          pg8::gemm_phase<pg8::EpiRes, pg8::Order2, true, true>(lds, g, S, E, wvs); }
        xcd_barrier(xbar, wvs);
        phase_norm<false>(p, l, lds, wvs);
        xcd_barrier(xbar, wvs);
        { pg8::Gemm g{HY, (const bf16_t*)(p.ws + WS_W1), M, DFF, D}; pg8::Order2 S; S.init(DFF, G, c, lastl); pg8::EpiBf16<1> E{PB, DFF};
          pg8::gemm_phase<pg8::EpiBf16<1>, pg8::Order2, true, true>(lds, g, S, E, wvs); }
        xcd_barrier(xbar, wvs);
        { pg8::Gemm g{PB, (const bf16_t*)(p.ws + WS_W2), M, D, DFF}; pg8::Order2 S; S.init(D, G, c, lastl); pg8::EpiRes E{p.out, Xc, mods + ((size_t)l * 17 * 6 + 5) * 1024, (const float*)p.out, (const float*)Xc};
          pg8::gemm_phase<pg8::EpiRes, pg8::Order2, true, true>(lds, g, S, E, wvs); }
        xcd_barrier(xbar, wvs);
    }
    phase_final(p, wvs);
}

extern "C" void kernel_launch(void* const* d_in, const int* in_sizes, int n_in, void* d_out, int out_size, void* d_ws, size_t ws_size, hipStream_t stream) {
    static int grid = 0;
    if (grid == 0) {
        if (n_in != 20 || ws_size < WS_END) { fprintf(stderr, "kernel_launch: need 20 inputs and >= %zu bytes of workspace (got %d, %zu)\n", (size_t)WS_END, n_in, ws_size); grid = -1; return; }
        int dev = 0, cus = 0, per_cu = 0;
        hipGetDevice(&dev); hipDeviceGetAttribute(&cus, hipDeviceAttributeMultiprocessorCount, dev);
        if (hipFuncSetAttribute((const void*)fwd_megakernel, hipFuncAttributeMaxDynamicSharedMemorySize, LDS_BYTES) != hipSuccess) { fprintf(stderr, "kernel_launch: hipFuncSetAttribute failed\n"); grid = -1; return; }
        if (hipOccupancyMaxActiveBlocksPerMultiprocessor(&per_cu, (const void*)fwd_megakernel, NTHR, LDS_BYTES) != hipSuccess || per_cu < 1) { fprintf(stderr, "kernel_launch: occupancy query says %d blocks/CU\n", per_cu); per_cu = 1; }
        (void)hipGetLastError();
        grid = cus;
    }
    if (grid < 0) return;
    hipMemsetAsync((char*)d_ws + WS_CTL, 0, 65536, stream);
    Params p{};
    const float** pp = (const float**)&p;
    for (int i = 0; i < 20; ++i) pp[i] = (const float*)d_in[i];
    p.out = (float*)d_out; p.ws = (unsigned char*)d_ws;
    void* args[] = {&p};
    hipError_t e = hipLaunchCooperativeKernel((const void*)fwd_megakernel, dim3(grid), dim3(NTHR), args, LDS_BYTES, stream);
    if (e != hipSuccess) fprintf(stderr, "cooperative launch failed: %s (grid %d)\n", hipGetErrorString(e), grid);
}
```

```cpp
#include <hip/hip_runtime.h>
#include <hip/hip_cooperative_groups.h>
#include <cstdio>
#include <cstdint>
namespace cg = cooperative_groups;

__device__ __forceinline__ int lane_id_fresh() { unsigned m = ~0u; asm volatile("" : "+s"(m)); return (int)__builtin_amdgcn_mbcnt_hi(m, __builtin_amdgcn_mbcnt_lo(m, 0u)); }
namespace pg8 {
#define PG8_LAS __attribute__((address_space(3)))
typedef unsigned short bf16_t;
typedef short bf16x8 __attribute__((ext_vector_type(8)));
typedef float f32x4 __attribute__((ext_vector_type(4)));
typedef unsigned u32x4 __attribute__((ext_vector_type(4)));
constexpr int BM = 256, BK = 64, HALF = 128, HTB = HALF * BK * 2  , STAGE_BYTES = 8 * HTB, NXCD = 8, WGM = 8;

__host__ __device__ __forceinline__ int lds_byte(int r, int c) { const int st = (r >> 4) * 2 + (c >> 5), rr = r & 15, cc = c & 31, ob = rr * 64 + cc * 2; return st * 1024 + (ob ^ (((ob >> 9) & 1) << 5)); }
__host__ __device__ __forceinline__ void stage_rc(int b, int& R, int& C) { const int st = b / 1024, sb = b % 1024, swz = sb ^ (((sb >> 9) & 1) << 5); R = (st >> 1) * 16 + swz / 64; C = (st & 1) * 32 + (swz % 64) / 2; }
__host__ __device__ __forceinline__ int perm32(int rho) { const int n = rho >> 4, i = rho & 15; return 8 * (i >> 2) + 4 * n + (i & 3); }

struct Unit { int pm, pn, ks; };
struct Gemm { const bf16_t* A; const bf16_t* Bt; int M, N, K, ldk; };

struct StaticOrder {
    int nM, nN, nwg, G, c;
    __host__ __device__ void init(int M, int N, int G_, int c_) { nM = M / BM; nN = N / BM; nwg = nM * nN; G = G_; c = c_; }
    __host__ __device__ bool next(int i, Unit& u) const {
        const long L = (long)i * G + c; if (L >= nwg) return false;
        int wgid = (int)L; { const int q = nwg / NXCD, r = nwg % NXCD, xcd = wgid % NXCD, off = wgid / NXCD; wgid = (xcd < r ? xcd * (q + 1) : r * (q + 1) + (xcd - r) * q) + off; }
        const int nig = WGM * nN, gid = wgid / nig, fm = gid * WGM, gsz = (nM - fm) < WGM ? (nM - fm) : WGM;
        u.pm = fm + ((wgid % nig) % gsz); u.pn = (wgid % nig) / gsz; u.ks = 0; return true;
    }
    __device__ __forceinline__ void a_ready(const Unit&) const {}
    __device__ __forceinline__ void done(const Unit&) const {}
};

struct Order2 {
    StaticOrder so; int lat;
    __host__ __device__ void init(int N, int G_, int c_, int lat_) { lat = lat_; so.init(lat_ ? 32768 : 36864, N, G_, c_); }
    __host__ __device__ bool next(int i, Unit& u) const { if (!so.next(i, u)) return false; if (lat) u.pm = (u.pm >> 3) * 9 + 1 + (u.pm & 7); return true; }
    __device__ __forceinline__ void a_ready(const Unit&) const {}
    __device__ __forceinline__ void done(const Unit&) const {}
};
struct CtxSplitOrder {
    int G, c;
    __host__ __device__ void init(int G_, int c_) { G = G_; c = c_; }
    __host__ __device__ bool next(int i, Unit& u) const { const long L = (long)i * G + c; if (L >= 256) return false; u.ks = (int)L & 3; u.pn = ((int)L >> 2) & 3; u.pm = ((int)L >> 4) * 9; return true; }
    __device__ __forceinline__ void a_ready(const Unit&) const {}
    __device__ __forceinline__ void done(const Unit&) const {}
};
__device__ __forceinline__ unsigned cvt_pk_bf16(float lo, float hi) { unsigned r; asm volatile("v_cvt_pk_bf16_f32 %0, %1, %2" : "=v"(r) : "v"(lo), "v"(hi)); return r; }

template <int ACT  > struct EpiBf16 {
    static constexpr bool PERM = true, AFTER_DRAIN = false;
    bf16_t* O; int ldc;
    __device__ __forceinline__ void operator()(const f32x4 (&acc)[2][2][4][2], const Unit& u, int wr, int wc, int fr, int fq) const {
        const int row0 = u.pm * BM + wr * 64 + fr; const int col0 = u.pn * BM + wc * 32 + 8 * fq;
#pragma unroll
        for (int ai = 0; ai < 2; ++ai)
#pragma unroll
            for (int m = 0; m < 4; ++m) { bf16_t* rowp = O + (size_t)(row0 + ai * HALF + m * 16) * ldc + col0;
#pragma unroll
                for (int bj = 0; bj < 2; ++bj) { f32x4 v0 = acc[ai][bj][m][0], v1 = acc[ai][bj][m][1];
                    if (ACT == 1) {
#pragma unroll
                        for (int e = 0; e < 4; ++e) { float a = fmaxf(v0[e], 0.f), b = fmaxf(v1[e], 0.f); v0[e] = a * a; v1[e] = b * b; } }
                    u32x4 w; w.x = cvt_pk_bf16(v0[0], v0[1]); w.y = cvt_pk_bf16(v0[2], v0[3]); w.z = cvt_pk_bf16(v1[0], v1[1]); w.w = cvt_pk_bf16(v1[2], v1[3]);
                    *(u32x4*)(rowp + bj * HALF) = w; } }
    }
};
struct EpiRes {
    static constexpr bool PERM = false, AFTER_DRAIN = false;
    float* Xl; float* Xc; const float* gates;
    const float* Xl_in; const float* Xc_in;
    __device__ __forceinline__ void operator()(const f32x4 (&acc)[2][2][4][2], const Unit& u, int wr, int wc, int fr, int fq) const {
        const int b = u.pm / 9, tt = u.pm - b * 9;
        const size_t toff = (tt == 0) ? ((size_t)(b * 256) << 10) : ((size_t)(b * 2048 + (tt - 1) * 256) << 10);
        float* base = ((tt == 0) ? Xc : Xl) + toff; const float* base_in = ((tt == 0) ? Xc_in : Xl_in) + toff;
        const float* g = gates + (size_t)((tt == 0) ? 16 : b) * 6144;
        const int col0 = u.pn * BM + wc * 32 + 4 * fq;
        float* rp0 = base + ((size_t)(wr * 64 + fr) << 10) + col0; const float* rq0 = base_in + ((size_t)(wr * 64 + fr) << 10) + col0;
#pragma unroll
        for (int bj = 0; bj < 2; ++bj)
#pragma unroll
            for (int n = 0; n < 2; ++n) { const f32x4 gvv = *(const f32x4*)(g + col0 + bj * HALF + n * 16);
#pragma unroll
                for (int ai = 0; ai < 2; ++ai) {
#pragma unroll
                    for (int m = 0; m < 4; ++m) { const size_t eo = (size_t)(ai * HALF + m * 16) * 1024 + bj * HALF + n * 16; f32x4 xv = *(const f32x4*)(rq0 + eo); xv = xv + gvv * acc[ai][bj][m][n]; *(f32x4*)(rp0 + eo) = xv; }
                    asm volatile("" ::: "memory"); } }
    }
};
struct EpiPart {
    static constexpr bool PERM = false, AFTER_DRAIN = false;
    float* part;
    __device__ __forceinline__ void operator()(const f32x4 (&acc)[2][2][4][2], const Unit& u, int wr, int wc, int fr, int fq) const {
        float* rp0 = part + (((size_t)u.ks * 4096 + (size_t)(u.pm / 9) * 256 + wr * 64 + fr) << 10) + u.pn * BM + wc * 32 + 4 * fq;
#pragma unroll
        for (int ai = 0; ai < 2; ++ai)
#pragma unroll
            for (int m = 0; m < 4; ++m)
#pragma unroll
                for (int bj = 0; bj < 2; ++bj)
#pragma unroll
                    for (int n = 0; n < 2; ++n) *(f32x4*)(rp0 + (size_t)(ai * HALF + m * 16) * 1024 + bj * HALF + n * 16) = acc[ai][bj][m][n];
    }
};
template <class Epi, class Sched, bool ALIGN_EPI = false, bool SP2 = false>
__device__ __forceinline__ void gemm_phase(PG8_LAS unsigned char* lds, const Gemm g, const Sched& S, const Epi& E, const int wvs) {
    const int tid = wvs * 64 + lane_id_fresh(); const int wid = __builtin_amdgcn_readfirstlane(tid >> 6), lane = tid & 63, wr = wid >> 2, wc = wid & 3, fr = lane & 15, fq = lane >> 4;
    const int K = g.ldk, nt = g.K / BK; const size_t sstep = (size_t)g.K * 2;
    unsigned voffA[2], voffB[2];
#pragma unroll
    for (int i = 0; i < 2; ++i) { int R, C; stage_rc(tid * 16 + i * 8192, R, C); const int Rb = Epi::PERM ? ((R & ~31) + perm32(R & 31)) : R;
        voffA[i] = (unsigned)(R * K + C) * 2u; voffB[i] = (unsigned)(Rb * K + C) * 2u; }
    const size_t kstep = (size_t)(BK * 2);
    const size_t hstep = (size_t)HALF * K * 2;
    const size_t tstep = 2 * hstep;
    const unsigned ldsw = (unsigned)wid * 1024u;
    const int aoff = lds_byte(wr * 64 + fr, fq * 8), boff = lds_byte(wc * 32 + fr, fq * 8);
#define PG8_SA(b, h) (((b) * 2 + (h)) * HTB)
#define PG8_SB(b, h) ((4 + (b) * 2 + (h)) * HTB)
#define PG8_STAGE(bufoff, gbase, voff) do { _Pragma("unroll") for (int _i = 0; _i < 2; ++_i) \
        __builtin_amdgcn_global_load_lds((const unsigned*)((const char*)(gbase) + (voff)[_i]), (PG8_LAS unsigned*)(lds + (bufoff) + ldsw + _i * 8192), 16, 0, 0); } while (0)
#define PG8_LDA(dst, b, h) do { _Pragma("unroll") for (int m = 0; m < 4; ++m) _Pragma("unroll") for (int k = 0; k < 2; ++k) dst[m][k] = *(const PG8_LAS bf16x8*)(lds + PG8_SA(b, h) + aoff + m * 2048 + k * 1024); } while (0)
#define PG8_LDB(dst, b, h) do { _Pragma("unroll") for (int n = 0; n < 2; ++n) _Pragma("unroll") for (int k = 0; k < 2; ++k) dst[n][k] = *(const PG8_LAS bf16x8*)(lds + PG8_SB(b, h) + boff + n * 2048 + k * 1024); } while (0)
#define PG8_MMA(ai, bj, At, Bt) do { __builtin_amdgcn_s_setprio(1); _Pragma("unroll") for (int m = 0; m < 4; ++m) _Pragma("unroll") for (int n = 0; n < 2; ++n) _Pragma("unroll") for (int k = 0; k < 2; ++k) \
        acc[ai][bj][m][n] = __builtin_amdgcn_mfma_f32_16x16x32_bf16(Bt[n][k], At[m][k], acc[ai][bj][m][n], 0, 0, 0); __builtin_amdgcn_s_setprio(0); } while (0)
#define PG8_WAIT_V(n) asm volatile("s_waitcnt vmcnt(" #n ")" ::: "memory")
#define PG8_WAIT_L(n) asm volatile("s_waitcnt lgkmcnt(" #n ")" ::: "memory")
#define PG8_BAR __builtin_amdgcn_s_barrier()
#define PG8_SCHED __builtin_amdgcn_sched_barrier(0)
    Unit cur, nxt; int ui = 0;
    if (!S.next(0, cur)) return;
    f32x4 acc[2][2][4][2];
#pragma unroll
    for (int a = 0; a < 2; ++a)
#pragma unroll
        for (int b = 0; b < 2; ++b)
#pragma unroll
            for (int m = 0; m < 4; ++m)
#pragma unroll
                for (int n = 0; n < 2; ++n) acc[a][b][m][n] = (f32x4){0.f, 0.f, 0.f, 0.f};
    bf16x8 At[4][2], B0[2][2], B1[2][2];
    const char* cA = (const char*)g.A + (size_t)cur.pm * tstep + (size_t)cur.ks * sstep; const char* cB = (const char*)g.Bt + (size_t)cur.pn * tstep + (size_t)cur.ks * sstep;
    S.a_ready(cur);
    if constexpr (SP2) {
        PG8_STAGE(PG8_SB(0, 0), cB, voffB); PG8_STAGE(PG8_SB(0, 1), cB + hstep, voffB); PG8_STAGE(PG8_SA(0, 0), cA, voffA); PG8_STAGE(PG8_SA(0, 1), cA + hstep, voffA);
        if (wr == 1) PG8_BAR;
        PG8_WAIT_V(2); PG8_BAR;
        PG8_STAGE(PG8_SB(1, 0), cB + kstep, voffB); PG8_STAGE(PG8_SA(1, 0), cA + kstep, voffA); PG8_STAGE(PG8_SB(1, 1), cB + hstep + kstep, voffB);
        PG8_WAIT_V(6); PG8_BAR;
    } else {
        PG8_STAGE(PG8_SB(0, 0), cB, voffB); PG8_STAGE(PG8_SA(0, 0), cA, voffA); PG8_STAGE(PG8_SB(0, 1), cB + hstep, voffB); PG8_STAGE(PG8_SA(0, 1), cA + hstep, voffA);
        if (wr == 1) PG8_BAR;
        PG8_WAIT_V(4); PG8_BAR;
        PG8_STAGE(PG8_SB(1, 0), cB + kstep, voffB); PG8_STAGE(PG8_SA(1, 0), cA + kstep, voffA); PG8_STAGE(PG8_SB(1, 1), cB + hstep + kstep, voffB);
        PG8_WAIT_V(6); PG8_BAR;
    }
    for (;;) {
        const bool has_next = S.next(ui + 1, nxt);
        const char* nA = has_next ? (const char*)g.A + (size_t)nxt.pm * tstep + (size_t)nxt.ks * sstep : cA; const char* nB = has_next ? (const char*)g.Bt + (size_t)nxt.pn * tstep + (size_t)nxt.ks * sstep : cB;
        for (int t = 0; t < nt; t += 2) {
            const bool last = (t == nt - 2);
            const char* a1 = cA + (size_t)(t + 1) * kstep;
            const char* a2 = last ? nA : cA + (size_t)(t + 2) * kstep; const char* b2 = last ? nB : cB + (size_t)(t + 2) * kstep;
            const char* a3 = a2 + kstep; const char* b3 = b2 + kstep;
            if (last && has_next) S.a_ready(nxt);
            if constexpr (SP2) {
            PG8_LDB(B0, 0, 0); PG8_LDB(B1, 0, 1); PG8_SCHED; PG8_LDA(At, 0, 0); PG8_STAGE(PG8_SA(1, 1), a1 + hstep, voffA);
            PG8_WAIT_V(8); PG8_WAIT_L(0); PG8_BAR; PG8_MMA(0, 0, At, B0); PG8_MMA(0, 1, At, B1); PG8_BAR; PG8_SCHED;
            PG8_LDA(At, 0, 1); PG8_STAGE(PG8_SB(0, 0), b2, voffB); PG8_STAGE(PG8_SB(0, 1), b2 + hstep, voffB); PG8_STAGE(PG8_SA(0, 0), a2, voffA);
            PG8_WAIT_V(8); PG8_WAIT_L(0); PG8_BAR; PG8_MMA(1, 0, At, B0); PG8_MMA(1, 1, At, B1); PG8_BAR; PG8_SCHED;
            PG8_LDB(B0, 1, 0); PG8_LDB(B1, 1, 1); PG8_SCHED; PG8_LDA(At, 1, 0); PG8_STAGE(PG8_SA(0, 1), a2 + hstep, voffA);
            PG8_WAIT_V(8); PG8_WAIT_L(0); PG8_BAR; PG8_MMA(0, 0, At, B0); PG8_MMA(0, 1, At, B1); PG8_BAR; PG8_SCHED;
            PG8_LDA(At, 1, 1); PG8_STAGE(PG8_SB(1, 0), b3, voffB); PG8_STAGE(PG8_SB(1, 1), b3 + hstep, voffB); PG8_STAGE(PG8_SA(1, 0), a3, voffA);
            PG8_WAIT_V(8); PG8_WAIT_L(0); PG8_BAR; PG8_MMA(1, 0, At, B0); PG8_MMA(1, 1, At, B1); PG8_BAR; PG8_SCHED;
            } else {
            PG8_LDB(B0, 0, 0); PG8_SCHED; PG8_LDA(At, 0, 0); PG8_STAGE(PG8_SA(1, 1), a1 + hstep, voffA);
            PG8_WAIT_L(8); PG8_BAR; PG8_WAIT_L(0); PG8_MMA(0, 0, At, B0); PG8_BAR; PG8_SCHED;
            PG8_LDB(B1, 0, 1); PG8_STAGE(PG8_SB(0, 0), b2, voffB);
            PG8_BAR; PG8_WAIT_L(0); PG8_MMA(0, 1, At, B1); PG8_BAR;
            PG8_LDA(At, 0, 1); PG8_STAGE(PG8_SA(0, 0), a2, voffA);
            PG8_BAR; PG8_WAIT_L(0); PG8_MMA(1, 0, At, B0); PG8_BAR; PG8_SCHED;
            PG8_STAGE(PG8_SB(0, 1), b2 + hstep, voffB);
            PG8_WAIT_V(6); PG8_BAR; PG8_MMA(1, 1, At, B1); PG8_BAR;
            PG8_LDB(B0, 1, 0); PG8_SCHED; PG8_LDA(At, 1, 0); PG8_STAGE(PG8_SA(0, 1), a2 + hstep, voffA);
            PG8_WAIT_L(8); PG8_BAR; PG8_WAIT_L(0); PG8_MMA(0, 0, At, B0); PG8_BAR; PG8_SCHED;
            PG8_LDB(B1, 1, 1); PG8_STAGE(PG8_SB(1, 0), b3, voffB);
            PG8_BAR; PG8_WAIT_L(0); PG8_MMA(0, 1, At, B1); PG8_BAR;
            PG8_LDA(At, 1, 1); PG8_STAGE(PG8_SA(1, 0), a3, voffA);
            PG8_BAR; PG8_WAIT_L(0); PG8_MMA(1, 0, At, B0); PG8_BAR; PG8_SCHED;
            PG8_STAGE(PG8_SB(1, 1), b3 + hstep, voffB);
            PG8_WAIT_V(6); PG8_BAR; PG8_MMA(1, 1, At, B1); PG8_BAR;
            }
        }
        if constexpr (ALIGN_EPI) { if (wr == 0) PG8_BAR; }
        if constexpr (!Epi::AFTER_DRAIN) { E(acc, cur, wr, wc, fr, fq); S.done(cur); }
        if (!has_next) break;
#pragma unroll
        for (int a = 0; a < 2; ++a)
#pragma unroll
            for (int b = 0; b < 2; ++b)
#pragma unroll
                for (int m = 0; m < 4; ++m)
#pragma unroll
                    for (int n = 0; n < 2; ++n) acc[a][b][m][n] = (f32x4){0.f, 0.f, 0.f, 0.f};
        cur = nxt; cA = nA; cB = nB; ++ui;
        if constexpr (ALIGN_EPI) { if (wr == 1) PG8_BAR; }
    }
    PG8_WAIT_V(0);
    if constexpr (!ALIGN_EPI) { if (wr == 0) PG8_BAR; }
    PG8_BAR;
    if constexpr (Epi::AFTER_DRAIN) { E.fused(acc, cur, wr, wc, fr, fq, lds, wid, lane); S.done(cur); }
#undef PG8_SA
#undef PG8_SB
#undef PG8_STAGE
#undef PG8_LDA
#undef PG8_LDB
#undef PG8_MMA
#undef PG8_WAIT_V
#undef PG8_WAIT_L
#undef PG8_BAR
#undef PG8_SCHED
}
}

constexpr int D = 1024, BATCH = 16, SEQ = 2048, CTX = 256, DEPTH = 4;
constexpr int TPB = CTX + SEQ;
constexpr int M = BATCH * TPB;
constexpr int DIN = 3088, NP = 3072, DFF = 4096;
constexpr int PC_DNQ = 0, PC_DNG = 768, PC_SQ = 1024, PC_SK = 1536, PC_SV = 1664, PC_HQ = 1792, PC_HF = 2048, PC_HI = 2560, PC_HG = 2816;
constexpr float EPS = 1e-6f;
constexpr size_t MiB = 1u << 20;
constexpr size_t WS_CTL = 0, WS_MODS = 1 * MiB, WS_ROPE = 3 * MiB, WS_LB = 3 * MiB + 512 * 1024, WS_AB = 4 * MiB;
constexpr size_t WS_WIN = 7 * MiB, WS_WOUT = 13 * MiB, WS_W1 = 15 * MiB, WS_W2 = 23 * MiB, WS_XC = 32 * MiB, WS_HY = 48 * MiB, WS_P = 120 * MiB;
constexpr size_t WS_OD = WS_P + 216 * MiB, WS_QKV = WS_P + 288 * MiB, WS_END = WS_QKV + 64 * MiB;
constexpr int LDS_BYTES = 147456;
constexpr int NWAVES = 8, NTHR = 512;

#define LAS __attribute__((address_space(3)))
typedef unsigned short bf16_t;
typedef float f32x4 __attribute__((ext_vector_type(4)));
typedef short bf16x8 __attribute__((ext_vector_type(8)));
typedef short s16x4 __attribute__((ext_vector_type(4)));
typedef unsigned u32x4 __attribute__((ext_vector_type(4)));
typedef unsigned u32x2 __attribute__((ext_vector_type(2)));

struct Params {
    const float *x, *c, *ctx, *c_ctx, *w_ada, *b_ada, *norm1, *norm2, *w_in, *dn_conv, *dn_A_log, *dn_dt_bias, *dn_norm, *swa_sink, *hg_lb, *hg_norm, *w_out, *w_ff1, *w_ff2, *norm_f;
    float* out; unsigned char* ws;
};

__device__ __forceinline__ float bflo(unsigned u) { return __uint_as_float(u << 16); }
__device__ __forceinline__ float bfhi(unsigned u) { return __uint_as_float(u & 0xffff0000u); }
__device__ __forceinline__ unsigned pk2(float lo, float hi) { return pg8::cvt_pk_bf16(lo, hi); }
__device__ __forceinline__ bf16_t bf1(float f) { unsigned u = __float_as_uint(f); u += 0x7fffu + ((u >> 16) & 1u); return (bf16_t)(u >> 16); }
__device__ __forceinline__ float siluf(float v) { return v / (1.f + __expf(-v)); }
__device__ __forceinline__ float sigmf(float v) { return 1.f / (1.f + __expf(-v)); }
__device__ __forceinline__ float wave_sum(float v) {
#pragma unroll
    for (int o = 1; o < 64; o <<= 1) v += __shfl_xor(v, o);
    return v;
}
template <int CTRL> __device__ __forceinline__ float dpp(float x) { return __builtin_bit_cast(float, __builtin_amdgcn_mov_dpp(__builtin_bit_cast(int, x), CTRL, 0xf, 0xf, true)); }
constexpr int XOR1 = 0xB1, XOR2 = 0x4E, XOR7 = 0x141;
__device__ __forceinline__ float sum8(float v) { v += dpp<XOR1>(v); v += dpp<XOR2>(v); v += dpp<XOR7>(v); return v; }
__device__ __forceinline__ float xrow16_max(float x) {
    auto s = __builtin_amdgcn_permlane16_swap(__float_as_uint(x), __float_as_uint(x), false, false);
    x = fmaxf(__uint_as_float(s[0]), __uint_as_float(s[1]));
    auto t = __builtin_amdgcn_permlane32_swap(__float_as_uint(x), __float_as_uint(x), false, false);
    return fmaxf(__uint_as_float(t[0]), __uint_as_float(t[1]));
}
__device__ __forceinline__ float xrow16_sum(float x) {
    auto s = __builtin_amdgcn_permlane16_swap(__float_as_uint(x), __float_as_uint(x), false, false);
    x = __uint_as_float(s[0]) + __uint_as_float(s[1]);
    auto t = __builtin_amdgcn_permlane32_swap(__float_as_uint(x), __float_as_uint(x), false, false);
    return __uint_as_float(t[0]) + __uint_as_float(t[1]);
}
__device__ __forceinline__ const float* xrow_c(const float* Xl, const float* Xc, int r) { const int b = r / TPB, t = r - b * TPB; return t < CTX ? Xc + ((size_t)(b * CTX + t) << 10) : Xl + ((size_t)(b * SEQ + t - CTX) << 10); }
__device__ __forceinline__ int cidx(int r) { const int b = r / TPB, t = r - b * TPB; return t < CTX ? 16 : b; }

__device__ __forceinline__ void phase_prologue(const Params& p, LAS unsigned char* lds, const int wvs) {
    const int tid = wvs * 64 + lane_id_fresh(); const int lane = tid & 63, w = tid >> 6;
    float* mods = (float*)(p.ws + WS_MODS);
    LAS float* sc = (LAS float*)lds;
    LAS float* red = (LAS float*)(lds + 81920);
    for (int idx = tid; idx < 17 * 1024; idx += NTHR) { const int ci = idx >> 10, k = idx & 1023; const float v = ci < 16 ? p.c[ci * 1024 + k] : p.c_ctx[k]; sc[k * 20 + ci] = v / (1.f + expf(-v)); }
    __syncthreads();
    for (int it = blockIdx.x; it < DEPTH * 96; it += gridDim.x) {
        const int l = it / 96, cgp = it - l * 96, col = cgp * 64 + lane;
        float acc[17];
#pragma unroll
        for (int i = 0; i < 17; ++i) acc[i] = 0.f;
        const float* wp = p.w_ada + ((size_t)l * 1024 + w * 128) * 6144 + col;
#pragma unroll 16
        for (int kk = 0; kk < 128; ++kk) {
            const float wv = wp[(size_t)kk * 6144];
            const LAS f32x4* s4 = (const LAS f32x4*)(sc + (w * 128 + kk) * 20);
            const f32x4 s0 = s4[0], s1 = s4[1], s2 = s4[2], s3 = s4[3]; const float s16 = sc[(w * 128 + kk) * 20 + 16];
#pragma unroll
            for (int e = 0; e < 4; ++e) { acc[e] += wv * s0[e]; acc[4 + e] += wv * s1[e]; acc[8 + e] += wv * s2[e]; acc[12 + e] += wv * s3[e]; }
            acc[16] += wv * s16;
        }
#pragma unroll
        for (int i = 0; i < 17; ++i) red[(w * 17 + i) * 64 + lane] = acc[i];
        __syncthreads();
        for (int idx = tid; idx < 17 * 64; idx += NTHR) { const int i = idx >> 6, cl = idx & 63; float s = 0.f;
#pragma unroll
            for (int ww = 0; ww < 8; ++ww) s += red[(ww * 17 + i) * 64 + cl];
            mods[((size_t)l * 17 + i) * 6144 + cgp * 64 + cl] = s + p.b_ada[l * 6144 + cgp * 64 + cl]; }
        __syncthreads();
    }
    const int gt = blockIdx.x * NTHR + tid, GT = gridDim.x * NTHR;
    { float* rc = (float*)(p.ws + WS_ROPE); float* rs = rc + 2048 * 32;
      for (int idx = gt; idx < 2048 * 32; idx += GT) { const int t = idx >> 5, d = idx & 31; const float pos = (float)(d < 16 ? (t >> 6) : (t & 63));
          const float inv = expf(-(float)(d & 15) * (9.210340371976184f / 16.f)); const float ang = pos * inv; rc[idx] = cosf(ang); rs[idx] = sinf(ang); } }
    { float* LB = (float*)(p.ws + WS_LB);
      for (int idx = gt; idx < 2 * 256; idx += GT) { const int d = idx >> 8, cc = idx & 255; float v[DEPTH]; float mx = -1e30f;
#pragma unroll
          for (int l = 0; l < DEPTH; ++l) { v[l] = p.hg_lb[(d * DEPTH + l) * 256 + cc]; mx = fmaxf(mx, v[l]); }
          float s = 0.f;
#pragma unroll
          for (int l = 0; l < DEPTH; ++l) { v[l] = expf(v[l] - mx); s += v[l]; }
          float cum = 0.f;
#pragma unroll
          for (int l = 0; l < DEPTH; ++l) { if (l > 0) cum += v[l] / s; LB[(d * DEPTH + l) * 256 + cc] = cum; } } }
}

__device__ __forceinline__ void transpose_item(const float* W, int K, int ldw, int scol0, bf16_t* WT, int n0, int k0, LAS float* scr, int lane) {
#pragma unroll 8
    for (int i = 0; i < 32; ++i) { const int kk = 2 * i + (lane >> 5); scr[kk * 33 + (lane & 31)] = W[(size_t)(k0 + kk) * ldw + scol0 + (lane & 31)]; }
    asm volatile("s_waitcnt lgkmcnt(0)" ::: "memory");
    const int c = lane & 7;
#pragma unroll
    for (int j = 0; j < 4; ++j) { const int n = (lane >> 3) + 8 * j; const LAS float* s = scr + (8 * c) * 33 + n;
        u32x4 o; o.x = pk2(s[0 * 33], s[1 * 33]); o.y = pk2(s[2 * 33], s[3 * 33]); o.z = pk2(s[4 * 33], s[5 * 33]); o.w = pk2(s[6 * 33], s[7 * 33]);
        *(u32x4*)(WT + (size_t)(n0 + n) * K + k0 + 8 * c) = o; }
    asm volatile("s_waitcnt lgkmcnt(0)" ::: "memory");
}

template <bool FIRST> __device__ __forceinline__ void phase_norm(const Params& p, int l, LAS unsigned char* lds, const int wvs) {
    const int tid = wvs * 64 + lane_id_fresh(); const int lane = tid & 63, w = tid >> 6;
    const int gw = blockIdx.x * NWAVES + w, NGW = gridDim.x * NWAVES;
    const float* mods = (const float*)(p.ws + WS_MODS);
    constexpr int WST = 1032;
    LAS bf16_t* wab = (LAS bf16_t*)lds;
    if (FIRST) {
        LAS float* scr = (LAS float*)(lds + 65536 + w * 8704);
        constexpr int I_IN = 16 * 96, I_OUT = 16 * 32, I_1 = 16 * 128, I_2 = 64 * 32;
        for (int it = gw; it < I_IN + I_OUT + I_1 + I_2; it += NGW) {
            int r = it;
            if (r < I_IN) { const int kb = r / 96, nb = r - kb * 96; const int n0 = nb * 32; transpose_item(p.w_in + (size_t)l * D * DIN, D, DIN, n0 + (n0 >= 1024 ? 16 : 0), (bf16_t*)(p.ws + WS_WIN), n0, kb * 64, scr, lane); continue; }
            r -= I_IN;
            if (r < I_OUT) { const int kb = r / 32, nb = r - kb * 32; transpose_item(p.w_out + (size_t)l * D * D, D, D, nb * 32, (bf16_t*)(p.ws + WS_WOUT), nb * 32, kb * 64, scr, lane); continue; }
            r -= I_OUT;
            if (r < I_1) { const int kb = r / 128, nb = r - kb * 128; transpose_item(p.w_ff1 + (size_t)l * D * DFF, D, DFF, nb * 32, (bf16_t*)(p.ws + WS_W1), nb * 32, kb * 64, scr, lane); continue; }
            r -= I_1;
            { const int kb = r / 32, nb = r - kb * 32; transpose_item(p.w_ff2 + (size_t)l * DFF * D, DFF, D, nb * 32, (bf16_t*)(p.ws + WS_W2), nb * 32, kb * 64, scr, lane); }
        }
        const float* wi = p.w_in + (size_t)l * D * DIN + 1024;
        for (int idx = tid; idx < 4096; idx += NTHR) { const int k = idx >> 2, j4 = (idx & 3) * 4; const f32x4 v = *(const f32x4*)(wi + (size_t)k * DIN + j4);
#pragma unroll
            for (int e = 0; e < 4; ++e) wab[(j4 + e) * WST + k] = bf1(v[e]); }
        __syncthreads();
    }
    const float* nw = (FIRST ? p.norm1 : p.norm2) + l * D;
    bf16_t* H = (bf16_t*)(p.ws + WS_HY);
    float* AB = (float*)(p.ws + WS_AB);
    float* Xc = (float*)(p.ws + WS_XC);
    const float* part = (const float*)(p.ws + WS_QKV);
    const bool fix = FIRST ? (l > 0) : (l < DEPTH - 1);
    const float* fgate = mods + ((size_t)(FIRST ? (l > 0 ? l - 1 : 0) : l) * 17 + 16) * 6144 + (FIRST ? 5 : 2) * 1024;
    int nrows = 0;
    for (int r = gw; r < M; r += NGW) {
        ++nrows;
        if (!FIRST && l == DEPTH - 1 && (r % TPB) < CTX) continue;
        const f32x4* xr = (const f32x4*)((FIRST && l == 0) ? xrow_c(p.x, p.ctx, r) : xrow_c(p.out, Xc, r)) + lane;
        f32x4 v[4]; float ss = 0.f;
        const int rb = r / TPB, rt = r - rb * TPB;
        if (fix && rt < CTX) {
            const f32x4* xin = (const f32x4*)((!FIRST && l == 0) ? p.ctx + ((size_t)(rb * CTX + rt) << 10) : Xc + ((size_t)(rb * CTX + rt) << 10)) + lane;
            const f32x4* pr = (const f32x4*)(part + ((size_t)(rb * CTX + rt) << 10)) + lane; f32x4* xo = (f32x4*)(Xc + ((size_t)(rb * CTX + rt) << 10)) + lane;
#pragma unroll
            for (int j = 0; j < 4; ++j) { const f32x4 gq = *(const f32x4*)(fgate + 4 * (lane + 64 * j));
                const f32x4 s4 = (pr[64 * j] + pr[64 * j + 1048576]) + (pr[64 * j + 2 * 1048576] + pr[64 * j + 3 * 1048576]);
                v[j] = xin[64 * j] + gq * s4; xo[64 * j] = v[j]; }
        } else {
#pragma unroll
            for (int j = 0; j < 4; ++j) v[j] = xr[64 * j];
        }
#pragma unroll
        for (int j = 0; j < 4; ++j) ss += (v[j][0] * v[j][0] + v[j][1] * v[j][1]) + (v[j][2] * v[j][2] + v[j][3] * v[j][3]);
        const float rstd = rsqrtf(wave_sum(ss) * (1.f / D) + EPS);
        const float* md = mods + ((size_t)l * 17 + cidx(r)) * 6144 + (FIRST ? 0 : 3 * 1024);
        u32x2* hp = (u32x2*)(H + (size_t)r * D) + lane;
#pragma unroll
        for (int j = 0; j < 4; ++j) { const int k = 4 * (lane + 64 * j);
            const f32x4 g = *(const f32x4*)(nw + k), sh = *(const f32x4*)(md + k), sl = *(const f32x4*)(md + 1024 + k);
            f32x4 h;
#pragma unroll
            for (int e = 0; e < 4; ++e) h[e] = (v[j][e] * rstd * g[e]) * (1.f + sl[e]) + sh[e];
            u32x2 o2; o2.x = pk2(h[0], h[1]); o2.y = pk2(h[2], h[3]); hp[64 * j] = o2;
        }
    }
    if (FIRST) {
        asm volatile("s_waitcnt vmcnt(0)" ::: "memory");
        const int fr = lane & 15, fq = lane >> 4;
        for (int b0 = 0; b0 < nrows; b0 += 16) {
            const int kr = b0 + fr; const bool ok = kr < nrows; const bf16_t* hp = H + (size_t)(gw + (ok ? kr : 0) * NGW) * D + fq * 8;
            f32x4 c = (f32x4){0.f, 0.f, 0.f, 0.f};
#pragma unroll 8
            for (int ks = 0; ks < 32; ++ks) { u32x4 av = *(const u32x4*)(hp + ks * 32); if (!ok) av = (u32x4){0u, 0u, 0u, 0u};
                const bf16x8 bv = *(const LAS bf16x8*)(wab + fr * WST + ks * 32 + fq * 8);
                c = __builtin_amdgcn_mfma_f32_16x16x32_bf16(__builtin_bit_cast(bf16x8, av), bv, c, 0, 0, 0); }
#pragma unroll
            for (int j = 0; j < 4; ++j) { const int k2 = b0 + fq * 4 + j; if (k2 < nrows) AB[(size_t)(gw + k2 * NGW) * 16 + fr] = c[j]; }
        }
    }
}

constexpr int SST = 68;
constexpr int HST = 72;
__device__ __forceinline__ bf16x8 ldA_perm(const LAS bf16_t* base, int row, int s, int fq) {
    const LAS bf16_t* ap = base + row * HST + s * 32 + fq * 4; const u32x2 lo = *(const LAS u32x2*)ap, hi = *(const LAS u32x2*)(ap + 16);
    u32x4 av; av[0] = lo[0]; av[1] = lo[1]; av[2] = hi[0]; av[3] = hi[1]; return __builtin_bit_cast(bf16x8, av);
}
__device__ __forceinline__ bf16x8 packB(const f32x4& a, const f32x4& b) {
    u32x4 pb; pb[0] = bf1(a[0]) | ((unsigned)bf1(a[1]) << 16); pb[1] = bf1(a[2]) | ((unsigned)bf1(a[3]) << 16); pb[2] = bf1(b[0]) | ((unsigned)bf1(b[1]) << 16); pb[3] = bf1(b[2]) | ((unsigned)bf1(b[3]) << 16);
    return __builtin_bit_cast(bf16x8, pb);
}
__device__ __forceinline__ void phase_dnprep(const Params& p, int l, LAS unsigned char* lds, const int wvs) {
    const int tid = wvs * 64 + lane_id_fresh();
    constexpr int RST = 200;
    LAS float* qs = (LAS float*)lds; LAS float* ks = qs + 64 * SST; LAS float* vs = ks + 64 * SST; LAS bf16_t* RAW = (LAS bf16_t*)(vs + 64 * SST);
    const bf16_t* P = (const bf16_t*)(p.ws + WS_P);
    bf16_t* QKV = (bf16_t*)(p.ws + WS_QKV);
    const float* cw = p.dn_conv + (size_t)l * 5 * 768;
    const int c4 = tid % 48, tg = tid / 48;
    LAS float* cdst = ((c4 >> 4) == 0 ? qs : ((c4 >> 4) == 1 ? ks : vs)) + (c4 & 15) * 4;
    for (int it = blockIdx.x; it < BATCH * 36 * 4; it += gridDim.x) {
        const int h = it & 3, bc = it >> 2, b = bc / 36, nc = bc - b * 36;
        const int base = b * TPB + nc * 64, lo = b * TPB + (nc < 4 ? 0 : CTX), hi = b * TPB + (nc < 4 ? CTX : TPB);
        float wc[5][4];
        { const int ch = c4 * 4, pcol = (ch >> 6) * 256 + h * 64 + (ch & 63);
#pragma unroll
          for (int t = 0; t < 5; ++t) { const f32x4 w4 = *(const f32x4*)(cw + t * 768 + pcol); wc[t][0] = w4[0]; wc[t][1] = w4[1]; wc[t][2] = w4[2]; wc[t][3] = w4[3]; } }
#pragma unroll
        for (int k = 0; k < 4; ++k) { const int q = tid + NTHR * k; if (q < 68 * 24) { const int rr = q / 24, pc = q - rr * 24; const int r = base - 2 + rr;
            const u32x4 v = (r >= lo && r < hi) ? *(const u32x4*)(P + (size_t)r * NP + (pc >> 3) * 256 + h * 64 + (pc & 7) * 8) : (u32x4){0u, 0u, 0u, 0u};
            *(LAS u32x4*)(RAW + rr * RST + pc * 8) = v; } }
        __syncthreads();
        if (tid < 480) {
#pragma unroll
            for (int m = 0; m < 7; ++m) { const int pp = tg + 10 * m; if (pp < 64) { float a0 = 0.f, a1 = 0.f, a2 = 0.f, a3 = 0.f;
#pragma unroll
                for (int t = 0; t < 5; ++t) { const u32x2 raw = *(const LAS u32x2*)(RAW + (pp + t) * RST + c4 * 4);
                    a0 += bflo(raw[0]) * wc[t][0]; a1 += bfhi(raw[0]) * wc[t][1]; a2 += bflo(raw[1]) * wc[t][2]; a3 += bfhi(raw[1]) * wc[t][3]; }
                f32x4 o; o[0] = a0 / (1.f + __expf(-a0)); o[1] = a1 / (1.f + __expf(-a1)); o[2] = a2 / (1.f + __expf(-a2)); o[3] = a3 / (1.f + __expf(-a3));
                *(LAS f32x4*)(cdst + pp * SST) = o; } } }
        __syncthreads();
        { const int t = tid >> 3, part = tid & 7;
          const f32x4 q0 = *(const LAS f32x4*)(qs + t * SST + part * 8), q1 = *(const LAS f32x4*)(qs + t * SST + part * 8 + 4);
          const f32x4 k0 = *(const LAS f32x4*)(ks + t * SST + part * 8), k1 = *(const LAS f32x4*)(ks + t * SST + part * 8 + 4);
          const f32x4 v0 = *(const LAS f32x4*)(vs + t * SST + part * 8), v1 = *(const LAS f32x4*)(vs + t * SST + part * 8 + 4);
          float sq = (q0[0] * q0[0] + q0[1] * q0[1]) + (q0[2] * q0[2] + q0[3] * q0[3]) + (q1[0] * q1[0] + q1[1] * q1[1]) + (q1[2] * q1[2] + q1[3] * q1[3]);
          float sk = (k0[0] * k0[0] + k0[1] * k0[1]) + (k0[2] * k0[2] + k0[3] * k0[3]) + (k1[0] * k1[0] + k1[1] * k1[1]) + (k1[2] * k1[2] + k1[3] * k1[3]);
          sq = sum8(sq); sk = sum8(sk);
          const float rq = rsqrtf(sq + EPS) * 0.125f, rk = rsqrtf(sk + EPS);
          u32x4 qo, ko, vo;
          qo[0] = pk2(q0[0] * rq, q0[1] * rq); qo[1] = pk2(q0[2] * rq, q0[3] * rq); qo[2] = pk2(q1[0] * rq, q1[1] * rq); qo[3] = pk2(q1[2] * rq, q1[3] * rq);
          ko[0] = pk2(k0[0] * rk, k0[1] * rk); ko[1] = pk2(k0[2] * rk, k0[3] * rk); ko[2] = pk2(k1[0] * rk, k1[1] * rk); ko[3] = pk2(k1[2] * rk, k1[3] * rk);
          vo[0] = pk2(v0[0], v0[1]); vo[1] = pk2(v0[2], v0[3]); vo[2] = pk2(v1[0], v1[1]); vo[3] = pk2(v1[2], v1[3]);
          bf16_t* dst = QKV + ((size_t)(base + t) * 4 + h) * 192 + part * 8;
          *(u32x4*)dst = qo; *(u32x4*)(dst + 64) = ko; *(u32x4*)(dst + 128) = vo; }
        __syncthreads();
    }
    { bf16_t* Pw = (bf16_t*)(p.ws + WS_P); const float* rc = (const float*)(p.ws + WS_ROPE); const float* rs = rc + 2048 * 32;
      const int gt = blockIdx.x * NTHR + tid, GT = gridDim.x * NTHR;
      for (int idx = gt; idx < BATCH * SEQ * 8; idx += GT) { const int rl = idx >> 3, rem = idx & 7, kh = rem >> 2, g = rem & 3;
          const int bb = rl >> 11, t = rl & 2047;
          bf16_t* pp = Pw + (size_t)(bb * TPB + CTX + t) * NP + PC_SK + kh * 64 + g * 8;
          const u32x4 r1 = *(const u32x4*)pp, r2 = *(const u32x4*)(pp + 32);
          const f32x4 c0 = *(const f32x4*)(rc + t * 32 + g * 8), c1 = *(const f32x4*)(rc + t * 32 + g * 8 + 4), s0 = *(const f32x4*)(rs + t * 32 + g * 8), s1 = *(const f32x4*)(rs + t * 32 + g * 8 + 4);
          u32x4 o1, o2;
#pragma unroll
          for (int e = 0; e < 4; ++e) { const float xa = bflo(r1[e]), xb = bfhi(r1[e]), ya = bflo(r2[e]), yb = bfhi(r2[e]);
              const float ca = e < 2 ? c0[2 * e] : c1[2 * e - 4], cb = e < 2 ? c0[2 * e + 1] : c1[2 * e - 3], sa = e < 2 ? s0[2 * e] : s1[2 * e - 4], sb = e < 2 ? s0[2 * e + 1] : s1[2 * e - 3];
              o1[e] = pk2(xa * ca - ya * sa, xb * cb - yb * sb); o2[e] = pk2(xa * sa + ya * ca, xb * sb + yb * cb); }
          *(u32x4*)pp = o1; *(u32x4*)(pp + 32) = o2; } }
}

__device__ __forceinline__ void dn_seq(const Params& p, int l, int s, LAS unsigned char* lds, const int wvs) {
    const int tid = wvs * 64 + lane_id_fresh(); const int lane = tid & 63;
    const int b = s >> 3, h = (s >> 1) & 3, d = s & 1;
    LAS bf16_t* QH = (LAS bf16_t*)lds; LAS bf16_t* KH = QH + 64 * HST; LAS bf16_t* VB = KH + 64 * HST; LAS bf16_t* KTT = VB + 64 * HST; LAS bf16_t* LM = KTT + 64 * HST; LAS bf16_t* SCM = LM + 64 * HST; LAS bf16_t* OB = SCM + 64 * HST;
    LAS float* LF = (LAS float*)(OB + 64 * HST);
    LAS bf16_t* DI = (LAS bf16_t*)(LF + 4 * 16 * 17);
    LAS float* GC = (LAS float*)(DI + 4 * 16 * 24); LAS float* EG = GC + 64; LAS float* BETA = EG + 64; LAS float* GL = BETA + 64;
    const bf16_t* QKV = (const bf16_t*)(p.ws + WS_QKV);
    const float* AB = (const float*)(p.ws + WS_AB);
    bf16_t* OD = (bf16_t*)(p.ws + WS_OD) + (size_t)d * M * 512 + h * 64;
    const float nA = -expf(p.dn_A_log[(l * 2 + d) * 4 + h]); const float dtb = p.dn_dt_bias[(l * 2 + d) * 4 + h];
    const int fr = lane & 15, fq = lane >> 4;
    const int V = wvs & 3, half = wvs >> 2;
    const f32x4 zero4 = (f32x4){0.f, 0.f, 0.f, 0.f};
    u32x4 praw[3]; float pa = 0.f, pb_ = 0.f;
    { const int nc0 = d == 0 ? 0 : 3; const int base0 = b * TPB + nc0 * 64;
#pragma unroll
      for (int k = 0; k < 3; ++k) { const int q = tid + NTHR * k; const int rr = q / 24, pc = q - rr * 24; praw[k] = *(const u32x4*)(QKV + ((size_t)(base0 + rr) * 4 + h) * 192 + pc * 8); }
      if (wvs == 0) { const int r = base0 + (d ? 63 - lane : lane); pa = AB[(size_t)r * 16 + d * 4 + h]; pb_ = AB[(size_t)r * 16 + 8 + d * 4 + h]; } }
    f32x4 Sacc[4];
#pragma unroll
    for (int T = 0; T < 4; ++T) Sacc[T] = zero4;
    for (int ci = 0; ci < 36; ++ci) {
        const int nc = d == 0 ? ci : (ci < 4 ? 3 - ci : 39 - ci);
        const int base = b * TPB + nc * 64;
#pragma unroll
        for (int k = 0; k < 3; ++k) { const int q = tid + NTHR * k; const int rr = q / 24, pc = q - rr * 24; const int t = d ? 63 - rr : rr;
            LAS bf16_t* dst = (pc < 8 ? QH : (pc < 16 ? KH : VB)) + t * HST + (pc & 7) * 8; *(LAS u32x4*)dst = praw[k]; }
        const float a_in = pa, b_in = pb_;
        if (ci + 1 < 36) { const int c2 = ci + 1; const int nc2 = d == 0 ? c2 : (c2 < 4 ? 3 - c2 : 39 - c2); const int base2 = b * TPB + nc2 * 64;
#pragma unroll
            for (int k = 0; k < 3; ++k) { const int q = tid + NTHR * k; const int rr = q / 24, pc = q - rr * 24; praw[k] = *(const u32x4*)(QKV + ((size_t)(base2 + rr) * 4 + h) * 192 + pc * 8); }
            if (wvs == 0) { const int r = base2 + (d ? 63 - lane : lane); pa = AB[(size_t)r * 16 + d * 4 + h]; pb_ = AB[(size_t)r * 16 + 8 + d * 4 + h]; } }
        if (wvs == 0) { const float xs = a_in + dtb; const float sp = xs > 15.f ? xs : (xs < -15.f ? __expf(xs) : __logf(1.f + __expf(xs))); float x = nA * sp;
#pragma unroll
            for (int o = 1; o < 64; o <<= 1) { const float y = __shfl_up(x, o); if (lane >= o) x += y; }
            GC[lane] = x; EG[lane] = __expf(x); BETA[lane] = 1.f / (1.f + __expf(-b_in)); if (lane == 63) { GL[0] = x; GL[1] = __expf(x); } }
        __syncthreads();
        { const int t = tid >> 3, part = tid & 7; const u32x4 kr = *(const LAS u32x4*)(KH + t * HST + part * 8); const float ekt = __expf(GL[0] - GC[t]);
#pragma unroll
          for (int e = 0; e < 4; ++e) { KTT[(part * 8 + 2 * e) * HST + t] = bf1(bflo(kr[e]) * ekt); KTT[(part * 8 + 2 * e + 1) * HST + t] = bf1(bfhi(kr[e]) * ekt); } }
        { const int I = wvs >> 1;
#pragma unroll
          for (int jj = 0; jj < 2; ++jj) { const int J = 2 * (wvs & 1) + jj; f32x4 ckk = zero4, cqk = zero4;
#pragma unroll
              for (int kk = 0; kk < 2; ++kk) { const bf16x8 Ak = *(const LAS bf16x8*)(KH + (I * 16 + fr) * HST + kk * 32 + fq * 8), Aq = *(const LAS bf16x8*)(QH + (I * 16 + fr) * HST + kk * 32 + fq * 8);
                  const bf16x8 B = *(const LAS bf16x8*)(KH + (J * 16 + fr) * HST + kk * 32 + fq * 8);
                  ckk = __builtin_amdgcn_mfma_f32_16x16x32_bf16(Ak, B, ckk, 0, 0, 0); cqk = __builtin_amdgcn_mfma_f32_16x16x32_bf16(Aq, B, cqk, 0, 0, 0); }
              const int j = J * 16 + fr; const float gj = GC[j];
#pragma unroll
              for (int r = 0; r < 4; ++r) { const int i = I * 16 + fq * 4 + r; const float dec = __expf(fminf(GC[i] - gj, 0.f));
                  const float lv = j < i ? BETA[i] * ckk[r] * dec : 0.f, sv = j <= i ? cqk[r] * dec : 0.f;
                  LM[i * HST + j] = bf1(lv); SCM[i * HST + j] = bf1(sv); if (I == J) LF[(I * 16 + fq * 4 + r) * 17 + fr] = lv; } } }
        __syncthreads();
        if (wvs == 0) { const int I = lane >> 4, c = lane & 15; float x[16];
#pragma unroll
            for (int i = 0; i < 16; ++i) { float acc = (i == c) ? 1.f : 0.f;
#pragma unroll
                for (int j = 0; j < i; ++j) acc -= LF[(I * 16 + i) * 17 + j] * x[j];
                x[i] = acc; DI[(I * 16 + i) * 24 + c] = bf1(acc); } }
        f32x4 R[4], QS[2];
        { bf16x8 Bs[2];
#pragma unroll
          for (int s2 = 0; s2 < 2; ++s2) Bs[s2] = packB(Sacc[2 * s2], Sacc[2 * s2 + 1]);
#pragma unroll
          for (int I = 0; I < 4; ++I) { f32x4 c = zero4;
#pragma unroll
              for (int s2 = 0; s2 < 2; ++s2) c = __builtin_amdgcn_mfma_f32_16x16x32_bf16(ldA_perm(KH, I * 16 + fr, s2, fq), Bs[s2], c, 0, 0, 0);
#pragma unroll
              for (int r = 0; r < 4; ++r) { const int i = I * 16 + fq * 4 + r; R[I][r] = BETA[i] * (bflo((unsigned)VB[i * HST + V * 16 + fr]) - EG[i] * c[r]); } }
#pragma unroll
          for (int ii = 0; ii < 2; ++ii) { const int I = 2 * half + ii; f32x4 c = zero4;
#pragma unroll
              for (int s2 = 0; s2 < 2; ++s2) c = __builtin_amdgcn_mfma_f32_16x16x32_bf16(ldA_perm(QH, I * 16 + fr, s2, fq), Bs[s2], c, 0, 0, 0);
              QS[ii] = c; } }
        __syncthreads();
        bf16x8 Bx0, Bx1;
        { bf16x8 AD[4];
#pragma unroll
          for (int I = 0; I < 4; ++I) { const u32x2 lo = *(const LAS u32x2*)(DI + (I * 16 + fr) * 24 + fq * 4); u32x4 av; av[0] = lo[0]; av[1] = lo[1]; av[2] = 0u; av[3] = 0u; AD[I] = __builtin_bit_cast(bf16x8, av); }
          const f32x4 X0 = __builtin_amdgcn_mfma_f32_16x16x32_bf16(AD[0], packB(R[0], zero4), zero4, 0, 0, 0);
          f32x4 T1 = __builtin_amdgcn_mfma_f32_16x16x32_bf16(ldA_perm(LM, 16 + fr, 0, fq), packB(X0, zero4), zero4, 0, 0, 0);
          const f32x4 X1 = __builtin_amdgcn_mfma_f32_16x16x32_bf16(AD[1], packB(R[1] - T1, zero4), zero4, 0, 0, 0);
          Bx0 = packB(X0, X1);
          f32x4 T2 = __builtin_amdgcn_mfma_f32_16x16x32_bf16(ldA_perm(LM, 32 + fr, 0, fq), Bx0, zero4, 0, 0, 0);
          const f32x4 X2 = __builtin_amdgcn_mfma_f32_16x16x32_bf16(AD[2], packB(R[2] - T2, zero4), zero4, 0, 0, 0);
          f32x4 T3 = __builtin_amdgcn_mfma_f32_16x16x32_bf16(ldA_perm(LM, 48 + fr, 0, fq), Bx0, zero4, 0, 0, 0);
          T3 = __builtin_amdgcn_mfma_f32_16x16x32_bf16(ldA_perm(LM, 48 + fr, 1, fq), packB(X2, zero4), T3, 0, 0, 0);
          const f32x4 X3 = __builtin_amdgcn_mfma_f32_16x16x32_bf16(AD[3], packB(R[3] - T3, zero4), zero4, 0, 0, 0);
          Bx1 = packB(X2, X3); }
#pragma unroll
        for (int ii = 0; ii < 2; ++ii) { const int I = 2 * half + ii; f32x4 c;
#pragma unroll
            for (int r = 0; r < 4; ++r) c[r] = EG[I * 16 + fq * 4 + r] * QS[ii][r];
            c = __builtin_amdgcn_mfma_f32_16x16x32_bf16(ldA_perm(SCM, I * 16 + fr, 0, fq), Bx0, c, 0, 0, 0);
            c = __builtin_amdgcn_mfma_f32_16x16x32_bf16(ldA_perm(SCM, I * 16 + fr, 1, fq), Bx1, c, 0, 0, 0);
#pragma unroll
            for (int r = 0; r < 4; ++r) OB[(I * 16 + fq * 4 + r) * HST + V * 16 + fr] = bf1(c[r]); }
        { const float egl = GL[1];
#pragma unroll
          for (int T = 0; T < 4; ++T) { f32x4 c = Sacc[T] * egl;
              c = __builtin_amdgcn_mfma_f32_16x16x32_bf16(ldA_perm(KTT, T * 16 + fr, 0, fq), Bx0, c, 0, 0, 0);
              c = __builtin_amdgcn_mfma_f32_16x16x32_bf16(ldA_perm(KTT, T * 16 + fr, 1, fq), Bx1, c, 0, 0, 0);
              Sacc[T] = c; } }
        __syncthreads();
#pragma unroll
        for (int it = 0; it < 4; ++it) { const int idx = tid + NTHR * it; const int i = idx >> 5, c2 = (idx & 31) * 2; const int row = base + (d ? 63 - i : i);
            *(unsigned*)(OD + (size_t)row * 512 + c2) = *(const LAS unsigned*)(OB + i * HST + c2); }
    }
    __syncthreads();
}

__device__ __forceinline__ void hg_seq(const Params& p, int l, int s, LAS unsigned char* lds, const int wvs) {
    const int tid = wvs * 64 + lane_id_fresh(); const int lane = tid & 63;
    const int b = s >> 3, h = (s >> 1) & 3, d = s & 1;
    LAS bf16_t* QT = (LAS bf16_t*)lds; LAS bf16_t* KT = QT + 64 * HST; LAS bf16_t* QP = KT + 64 * HST; LAS bf16_t* KTT = QP + 64 * HST; LAS bf16_t* VT = KTT + 64 * HST; LAS bf16_t* SC = VT + 64 * HST;
    LAS float* GS = (LAS float*)(SC + 64 * HST); LAS float* MID = GS + 512; LAS float* BLS = MID + 64; LAS float* EBL = BLS + 64; LAS bf16_t* OB = (LAS bf16_t*)(EBL + 64);
    const bf16_t* P = (const bf16_t*)(p.ws + WS_P);
    bf16_t* OD = (bf16_t*)(p.ws + WS_OD) + (size_t)d * M * 512 + 256 + h * 64;
    const int kx = tid & 63, g = tid >> 6;
    const float lb = ((const float*)(p.ws + WS_LB))[(d * DEPTH + l) * 256 + h * 64 + kx];
    const int fr = lane & 15, fq = lane >> 4;
    const int V = wvs & 3, half = wvs >> 2;
    f32x4 Sacc[4];
#pragma unroll
    for (int T = 0; T < 4; ++T) Sacc[T] = (f32x4){0.f, 0.f, 0.f, 0.f};
    unsigned short rq[8], rz[8], rv[8];
    { const int nc = d == 0 ? 0 : 3; const int base = b * TPB + nc * 64;
#pragma unroll
      for (int e = 0; e < 8; ++e) { const int t = g * 8 + e; const int pp = d ? 63 - t : t; const bf16_t* rp = P + (size_t)(base + pp) * NP + h * 64 + kx;
          rq[e] = rp[PC_HQ]; rz[e] = rp[PC_HF + d * 256]; rv[e] = rp[PC_HI]; } }
    for (int ci = 0; ci < 36; ++ci) {
        const int nc = d == 0 ? ci : (ci < 4 ? 3 - ci : 39 - ci);
        const int base = b * TPB + nc * 64;
        float qv[8], kv[8], bc[8]; float run = 0.f;
#pragma unroll
        for (int e = 0; e < 8; ++e) { const float z = bflo(rz[e]); const float sg = 1.f / (1.f + __expf(-z)); const float f = lb + (1.f - lb) * sg;
            run += __logf(f); bc[e] = run; kv[e] = (1.f - lb) * (1.f - sg); qv[e] = bflo(rq[e]); }
        GS[g * 64 + kx] = run;
#pragma unroll
        for (int e = 0; e < 8; ++e) VT[kx * HST + g * 8 + e] = rv[e];
        __syncthreads();
        { float off = 0.f;
#pragma unroll
          for (int gg = 0; gg < 7; ++gg) { const float x = GS[gg * 64 + kx]; off += (gg < g) ? x : 0.f; }
#pragma unroll
          for (int e = 0; e < 8; ++e) bc[e] += off; }
        if (g == 3) MID[kx] = bc[7];
        if (g == 7) { BLS[kx] = bc[7]; EBL[kx] = __expf(bc[7]); }
        if (ci + 1 < 36) { const int c2 = ci + 1; const int nc2 = d == 0 ? c2 : (c2 < 4 ? 3 - c2 : 39 - c2); const int base2 = b * TPB + nc2 * 64;
#pragma unroll
            for (int e = 0; e < 8; ++e) { const int t = g * 8 + e; const int pp = d ? 63 - t : t; const bf16_t* rp = P + (size_t)(base2 + pp) * NP + h * 64 + kx;
                rq[e] = rp[PC_HQ]; rz[e] = rp[PC_HF + d * 256]; rv[e] = rp[PC_HI]; } }
        __syncthreads();
        { const float mid = MID[kx], bl = BLS[kx];
#pragma unroll
          for (int e = 0; e < 8; ++e) { const int t = g * 8 + e; const float E = fminf(fmaxf(bc[e] - mid, -80.f), 80.f);
              const float eq = __expf(E), ek = __expf(-E);
              QT[t * HST + kx] = bf1(qv[e] * eq); KT[t * HST + kx] = bf1(kv[e] * ek);
              QP[t * HST + kx] = bf1(qv[e] * __expf(bc[e])); KTT[kx * HST + t] = bf1(kv[e] * __expf(bl - bc[e])); } }
        __syncthreads();
        { const int I = wvs >> 1;
#pragma unroll
          for (int jj = 0; jj < 2; ++jj) { const int J = 2 * (wvs & 1) + jj; f32x4 c = (f32x4){0.f, 0.f, 0.f, 0.f};
#pragma unroll
              for (int kk = 0; kk < 2; ++kk) { const bf16x8 A = *(const LAS bf16x8*)(QT + (I * 16 + fr) * HST + kk * 32 + fq * 8); const bf16x8 B = *(const LAS bf16x8*)(KT + (J * 16 + fr) * HST + kk * 32 + fq * 8);
                  c = __builtin_amdgcn_mfma_f32_16x16x32_bf16(A, B, c, 0, 0, 0); }
#pragma unroll
              for (int r = 0; r < 4; ++r) { const int i = I * 16 + fq * 4 + r, j = J * 16 + fr; SC[i * HST + j] = bf1(j <= i ? c[r] : 0.f); } } }
        __syncthreads();
        { bf16x8 Bs[2];
#pragma unroll
          for (int s2 = 0; s2 < 2; ++s2) { u32x4 pb; pb[0] = bf1(Sacc[2 * s2][0]) | ((unsigned)bf1(Sacc[2 * s2][1]) << 16); pb[1] = bf1(Sacc[2 * s2][2]) | ((unsigned)bf1(Sacc[2 * s2][3]) << 16); pb[2] = bf1(Sacc[2 * s2 + 1][0]) | ((unsigned)bf1(Sacc[2 * s2 + 1][1]) << 16); pb[3] = bf1(Sacc[2 * s2 + 1][2]) | ((unsigned)bf1(Sacc[2 * s2 + 1][3]) << 16); Bs[s2] = __builtin_bit_cast(bf16x8, pb); }
          bf16x8 Bv[2];
#pragma unroll
          for (int s2 = 0; s2 < 2; ++s2) Bv[s2] = *(const LAS bf16x8*)(VT + (V * 16 + fr) * HST + s2 * 32 + fq * 8);
#pragma unroll
          for (int ii = 0; ii < 2; ++ii) { const int I = 2 * half + ii; f32x4 o = (f32x4){0.f, 0.f, 0.f, 0.f};
#pragma unroll
              for (int s2 = 0; s2 < 2; ++s2) { const LAS bf16_t* ap = QP + (I * 16 + fr) * HST + s2 * 32 + fq * 4; const u32x2 lo = *(const LAS u32x2*)ap, hi = *(const LAS u32x2*)(ap + 16);
                  u32x4 av; av[0] = lo[0]; av[1] = lo[1]; av[2] = hi[0]; av[3] = hi[1];
                  o = __builtin_amdgcn_mfma_f32_16x16x32_bf16(__builtin_bit_cast(bf16x8, av), Bs[s2], o, 0, 0, 0); }
#pragma unroll
              for (int s2 = 0; s2 < 2; ++s2) { const bf16x8 A = *(const LAS bf16x8*)(SC + (I * 16 + fr) * HST + s2 * 32 + fq * 8); o = __builtin_amdgcn_mfma_f32_16x16x32_bf16(A, Bv[s2], o, 0, 0, 0); }
#pragma unroll
              for (int r = 0; r < 4; ++r) { const int i = I * 16 + fq * 4 + r; OB[i * HST + V * 16 + fr] = bf1(o[r]); } }
#pragma unroll
          for (int T = 0; T < 4; ++T) { f32x4 c;
#pragma unroll
              for (int r = 0; r < 4; ++r) c[r] = Sacc[T][r] * EBL[T * 16 + fq * 4 + r];
#pragma unroll
              for (int s2 = 0; s2 < 2; ++s2) { const bf16x8 A = *(const LAS bf16x8*)(KTT + (T * 16 + fr) * HST + s2 * 32 + fq * 8); c = __builtin_amdgcn_mfma_f32_16x16x32_bf16(A, Bv[s2], c, 0, 0, 0); }
              Sacc[T] = c; } }
        __syncthreads();
#pragma unroll
        for (int it = 0; it < 4; ++it) { const int idx = tid + NTHR * it; const int i = idx >> 5, c2 = (idx & 31) * 2; const int row = base + (d ? 63 - i : i);
            *(unsigned*)(OD + (size_t)row * 512 + c2) = *(const LAS unsigned*)(OB + i * HST + c2); }
    }
}

constexpr int KST = 72, VST = 136;
__device__ __forceinline__ void swa_unit(const Params& p, int l, int unit, LAS unsigned char* lds, const int wvs) {
    const int tid = wvs * 64 + lane_id_fresh(); const int lane = tid & 63;
    const int b = unit / 36, rem = unit - b * 36, kvh = rem / 18, qb = rem - kvh * 18;
    const bool qctx = qb < 2;
    const bf16_t* P = (const bf16_t*)(p.ws + WS_P);
    const float* rc = (const float*)(p.ws + WS_ROPE); const float* rs = rc + 2048 * 32;
    bf16_t* Y = (bf16_t*)(p.ws + WS_HY);
    LAS bf16_t* Ks = (LAS bf16_t*)lds; LAS bf16_t* Vt = Ks + 128 * KST;
    const int hh = wvs >> 1, qhalf = wvs & 1, head = kvh * 4 + hh;
    const int fr = lane & 15, fq = lane >> 4;
    const int rowq0 = b * TPB + qb * 128 + qhalf * 64;
    const int f0 = (!qctx && qb == 2) ? 1 : 0, nl = qctx ? 0 : 3 - f0 - (qb == 17 ? 1 : 0), nkb = nl + 2;
#define SWA_BLK(j) ((j) < nl ? qb - 1 + f0 + (j) : (j) - nl)
#define SWA_REL(j) ((j) < nl ? f0 + (j) - 1 : 0)
    bf16x8 qf[4][2];
#pragma unroll
    for (int qt = 0; qt < 4; ++qt) {
        const int row = rowq0 + qt * 16 + fr; const bf16_t* qp = P + (size_t)row * NP + PC_SQ + head * 64 + fq * 8;
        const u32x4 r1 = *(const u32x4*)qp, r2 = *(const u32x4*)(qp + 32);
        float a1[8], a2[8];
#pragma unroll
        for (int e = 0; e < 4; ++e) { a1[2 * e] = bflo(r1[e]); a1[2 * e + 1] = bfhi(r1[e]); a2[2 * e] = bflo(r2[e]); a2[2 * e + 1] = bfhi(r2[e]); }
        if (!qctx) { const int t = (qb - 2) * 128 + qhalf * 64 + qt * 16 + fr; const float* cp = rc + t * 32 + fq * 8; const float* sp = rs + t * 32 + fq * 8;
#pragma unroll
            for (int e = 0; e < 8; ++e) { const float cs = cp[e], sn = sp[e]; const float o1 = a1[e] * cs - a2[e] * sn, o2 = a1[e] * sn + a2[e] * cs; a1[e] = o1; a2[e] = o2; } }
        u32x4 o1, o2;
#pragma unroll
        for (int e = 0; e < 4; ++e) { o1[e] = pk2(a1[2 * e] * 0.125f, a1[2 * e + 1] * 0.125f); o2[e] = pk2(a2[2 * e] * 0.125f, a2[2 * e + 1] * 0.125f); }
        qf[qt][0] = __builtin_bit_cast(bf16x8, o1); qf[qt][1] = __builtin_bit_cast(bf16x8, o2);
    }
    const int skey = tid >> 2, sg = tid & 3;
    const float sink = p.swa_sink[l * 8 + head];
    float mrun[4], lrun[4]; f32x4 O[4][4];
#pragma unroll
    for (int qt = 0; qt < 4; ++qt) { mrun[qt] = sink; lrun[qt] = 1.f;
#pragma unroll
        for (int dv = 0; dv < 4; ++dv) O[qt][dv] = (f32x4){0.f, 0.f, 0.f, 0.f}; }
    for (int j = 0; j < nkb; ++j) {
        const int rel = SWA_REL(j);
        u32x4 kreg[2], vreg[2];
        { const int rowk0 = b * TPB + SWA_BLK(j) * 128; const bf16_t* kp = P + (size_t)(rowk0 + skey) * NP + PC_SK + kvh * 64 + sg * 8;
          kreg[0] = *(const u32x4*)kp; kreg[1] = *(const u32x4*)(kp + 32);
#pragma unroll
          for (int it = 0; it < 2; ++it) { const int idx = tid + NTHR * it; vreg[it] = *(const u32x4*)(P + (size_t)(rowk0 + (idx >> 3)) * NP + PC_SV + kvh * 64 + (idx & 7) * 8); } }
        *(LAS u32x4*)(Ks + skey * KST + sg * 8) = kreg[0]; *(LAS u32x4*)(Ks + skey * KST + 32 + sg * 8) = kreg[1];
#pragma unroll
        for (int it = 0; it < 2; ++it) { const int idx = tid + NTHR * it; const int vk = idx >> 3, vg = idx & 7;
#pragma unroll
            for (int e = 0; e < 4; ++e) { Vt[(vg * 8 + 2 * e) * VST + vk] = (bf16_t)(vreg[it][e] & 0xffffu); Vt[(vg * 8 + 2 * e + 1) * VST + vk] = (bf16_t)(vreg[it][e] >> 16); } }
        __syncthreads();
#pragma unroll
        for (int qp2 = 0; qp2 < 2; ++qp2) {
            f32x4 Sx[2][8];
#pragma unroll
            for (int kt = 0; kt < 8; ++kt) { Sx[0][kt] = (f32x4){0.f, 0.f, 0.f, 0.f}; Sx[1][kt] = (f32x4){0.f, 0.f, 0.f, 0.f};
#pragma unroll
                for (int kk = 0; kk < 2; ++kk) { const bf16x8 A = *(const LAS bf16x8*)(Ks + (kt * 16 + fr) * KST + kk * 32 + fq * 8);
                    Sx[0][kt] = __builtin_amdgcn_mfma_f32_16x16x32_bf16(A, qf[2 * qp2][kk], Sx[0][kt], 0, 0, 0);
                    Sx[1][kt] = __builtin_amdgcn_mfma_f32_16x16x32_bf16(A, qf[2 * qp2 + 1][kk], Sx[1][kt], 0, 0, 0); } }
#pragma unroll
            for (int u = 0; u < 2; ++u) { const int qt = 2 * qp2 + u;
                if (rel != 0) { int qi = qhalf * 64 + qt * 16 + fr; asm volatile("" : "+v"(qi));
#pragma unroll
                    for (int kt = 0; kt < 8; ++kt)
#pragma unroll
                        for (int jx = 0; jx < 4; ++jx) { const int kx = kt * 16 + fq * 4 + jx; const bool ok = rel < 0 ? (kx >= qi) : (kx <= qi); if (!ok) Sx[u][kt][jx] = -1e30f; } }
                float mx = -1e30f;
#pragma unroll
                for (int kt = 0; kt < 8; ++kt) mx = fmaxf(mx, fmaxf(fmaxf(Sx[u][kt][0], Sx[u][kt][1]), fmaxf(Sx[u][kt][2], Sx[u][kt][3])));
                mx = xrow16_max(mx);
                const float mnew = fmaxf(mrun[qt], mx); const float alpha = __expf(mrun[qt] - mnew); mrun[qt] = mnew;
                float rsum = 0.f;
#pragma unroll
                for (int kt = 0; kt < 8; ++kt)
#pragma unroll
                    for (int jx = 0; jx < 4; ++jx) { const float e = __expf(Sx[u][kt][jx] - mnew); Sx[u][kt][jx] = e; rsum += e; }
                rsum = xrow16_sum(rsum);
                lrun[qt] = lrun[qt] * alpha + rsum;
#pragma unroll
                for (int dv = 0; dv < 4; ++dv) O[qt][dv] = O[qt][dv] * alpha; }
#pragma unroll
            for (int ks2 = 0; ks2 < 4; ++ks2) {
                bf16x8 Bp[2];
#pragma unroll
                for (int u = 0; u < 2; ++u) { u32x4 pb; pb[0] = pk2(Sx[u][2 * ks2][0], Sx[u][2 * ks2][1]); pb[1] = pk2(Sx[u][2 * ks2][2], Sx[u][2 * ks2][3]); pb[2] = pk2(Sx[u][2 * ks2 + 1][0], Sx[u][2 * ks2 + 1][1]); pb[3] = pk2(Sx[u][2 * ks2 + 1][2], Sx[u][2 * ks2 + 1][3]); Bp[u] = __builtin_bit_cast(bf16x8, pb); }
#pragma unroll
                for (int dv = 0; dv < 4; ++dv) { const LAS bf16_t* vp = Vt + (dv * 16 + fr) * VST + ks2 * 32 + fq * 4;
                    const u32x2 lo = *(const LAS u32x2*)vp, hi = *(const LAS u32x2*)(vp + 16);
                    u32x4 av; av[0] = lo[0]; av[1] = lo[1]; av[2] = hi[0]; av[3] = hi[1]; const bf16x8 Av = __builtin_bit_cast(bf16x8, av);
                    O[2 * qp2][dv] = __builtin_amdgcn_mfma_f32_16x16x32_bf16(Av, Bp[0], O[2 * qp2][dv], 0, 0, 0);
                    O[2 * qp2 + 1][dv] = __builtin_amdgcn_mfma_f32_16x16x32_bf16(Av, Bp[1], O[2 * qp2 + 1][dv], 0, 0, 0); }
            }
        }
        __syncthreads();
    }
#undef SWA_BLK
#undef SWA_REL
#pragma unroll
    for (int qt = 0; qt < 4; ++qt) { const float inv = 1.f / lrun[qt]; const int row = rowq0 + qt * 16 + fr;
#pragma unroll
        for (int dv = 0; dv < 4; ++dv) { u32x2 o2; o2[0] = pk2(O[qt][dv][0] * inv, O[qt][dv][1] * inv); o2[1] = pk2(O[qt][dv][2] * inv, O[qt][dv][3] * inv);
            *(u32x2*)(Y + (size_t)row * D + 256 + head * 64 + dv * 16 + fq * 4) = o2; } }
}

__device__ __forceinline__ void phase_mixers(const Params& p, int l, LAS unsigned char* lds, const int wvs) {
    for (int s = blockIdx.x; s < 256; s += gridDim.x) { if (s < 128) dn_seq(p, l, s, lds, wvs); else hg_seq(p, l, s - 128, lds, wvs); }
    unsigned* ctr = (unsigned*)(p.ws + WS_CTL) + 64 * (1 + l);
    LAS int* su = (LAS int*)(lds + 140 * 1024);
    for (;;) {
        __syncthreads();
        if (wvs == 0 && lane_id_fresh() == 0) su[0] = (int)atomicAdd(ctr, 1u);
        __syncthreads();
        const int unit = su[0];
        if (unit >= 576) break;
        swa_unit(p, l, unit, lds, wvs);
    }
}

__device__ __forceinline__ void phase_finalize(const Params& p, int l, const int wvs) {
    const int tid = wvs * 64 + lane_id_fresh(); const int lane = tid & 63, w = tid >> 6;
    const int gw = blockIdx.x * NWAVES + w, NGW = gridDim.x * NWAVES;
    const bf16_t* P = (const bf16_t*)(p.ws + WS_P);
    const bf16_t* OD0 = (const bf16_t*)(p.ws + WS_OD); const bf16_t* OD1 = OD0 + (size_t)M * 512;
    bf16_t* Y = (bf16_t*)(p.ws + WS_HY);
    const int seg = lane >> 3, d0 = (lane & 7) * 8;
    const int hd = seg & 3; const bool isdn = seg < 4;
    const float* gain = (isdn ? p.dn_norm : p.hg_norm) + l * 64 + d0;
    const f32x4 g0 = *(const f32x4*)gain, g1 = *(const f32x4*)(gain + 4);
    const int ocol = (isdn ? 0 : 256) + hd * 64 + d0, gcol = (isdn ? PC_DNG : PC_HG) + hd * 64 + d0, ycol = (isdn ? 0 : 768) + hd * 64 + d0;
    for (int r = gw; r < M; r += NGW) {
        const u32x4 a = *(const u32x4*)(OD0 + (size_t)r * 512 + ocol), bq = *(const u32x4*)(OD1 + (size_t)r * 512 + ocol), gt = *(const u32x4*)(P + (size_t)r * NP + gcol);
        float o[8]; float ss = 0.f;
#pragma unroll
        for (int e = 0; e < 4; ++e) { o[2 * e] = bflo(a[e]) + bflo(bq[e]); o[2 * e + 1] = bfhi(a[e]) + bfhi(bq[e]); ss += o[2 * e] * o[2 * e] + o[2 * e + 1] * o[2 * e + 1]; }
        ss = sum8(ss);
        const float rms = rsqrtf(ss * (1.f / 64.f) + EPS);
        u32x4 y;
#pragma unroll
        for (int e = 0; e < 4; ++e) { const float ga = bflo(gt[e]), gb = bfhi(gt[e]);
            const float ge0 = e < 2 ? g0[2 * e] : g1[2 * e - 4], ge1 = e < 2 ? g0[2 * e + 1] : g1[2 * e - 3];
            y[e] = pk2(o[2 * e] * rms * ge0 * siluf(ga), o[2 * e + 1] * rms * ge1 * siluf(gb)); }
        *(u32x4*)(Y + (size_t)r * D + ycol) = y;
    }
}

__device__ __forceinline__ void phase_final(const Params& p, const int wvs) {
    const int tid = wvs * 64 + lane_id_fresh(); const int lane = tid & 63, w = tid >> 6;
    const int gw = blockIdx.x * NWAVES + w, NGW = gridDim.x * NWAVES;
    for (int r = gw; r < BATCH * SEQ; r += NGW) {
        f32x4* xr = (f32x4*)(p.out + ((size_t)r << 10)) + lane;
        f32x4 v[4]; float ss = 0.f;
#pragma unroll
        for (int j = 0; j < 4; ++j) { v[j] = xr[64 * j]; ss += (v[j][0] * v[j][0] + v[j][1] * v[j][1]) + (v[j][2] * v[j][2] + v[j][3] * v[j][3]); }
        const float rstd = rsqrtf(wave_sum(ss) * (1.f / D) + EPS);
#pragma unroll
        for (int j = 0; j < 4; ++j) { const f32x4 g = *(const f32x4*)(p.norm_f + 4 * (lane + 64 * j)); xr[64 * j] = v[j] * rstd * g; }
    }
}

#define XB_TMO      128
#define XB_XCNT(j)  (256  + 64 * (j))
#define XB_XSUB(j)  (1280 + 64 * (j))
#define XB_XGEN(j)  (2304 + 64 * (j))
#define XB_TOP      3328
#define XB_TOPGEN   3392
#define XCD_BAR_WORDS 3456
#define XB_SPIN_CAP (1u << 18)

__device__ __forceinline__ unsigned xb_ld(unsigned* p)              { return __hip_atomic_load(p, __ATOMIC_RELAXED, __HIP_MEMORY_SCOPE_AGENT); }
__device__ __forceinline__ unsigned xb_add(unsigned* p, unsigned v) { return __hip_atomic_fetch_add(p, v, __ATOMIC_RELAXED, __HIP_MEMORY_SCOPE_AGENT); }
__device__ __forceinline__ unsigned xb_xcc_id() { return (unsigned)__builtin_amdgcn_s_getreg((3 << 11) | 20) & 0xFu; }
#define XB_SPIN(cond, bar) do { unsigned _sp = 0; while (cond) { __builtin_amdgcn_s_sleep(1); \
    if ((++_sp & 255u) == 0u) { if (xb_ld(&(bar)[XB_TMO])) break; if (_sp > XB_SPIN_CAP) { atomicAdd(&(bar)[XB_TMO], 1u); break; } } } } while (0)

struct XcdBarrier {
    unsigned* bar; unsigned x;
    volatile LAS unsigned* st;
};

__device__ __forceinline__ XcdBarrier xcd_barrier_post(unsigned* bar, volatile LAS unsigned* st) {
    XcdBarrier b; b.bar = bar; b.x = xb_xcc_id(); b.st = st;
    if (threadIdx.x == 0) (void)xb_add(&bar[XB_XCNT(b.x)], 1u);
    return b;
}
__device__ __forceinline__ void xcd_barrier_complete(unsigned* bar, unsigned x, unsigned& nloc, unsigned& nx) {
    const unsigned G = gridDim.x * gridDim.y * gridDim.z;
    unsigned sum, cnt, mine, sp = 0u;
    for (;;) {
        sum = 0u; cnt = 0u; mine = 0u;
#pragma unroll
        for (unsigned j = 0; j < 16; ++j) { const unsigned c = xb_ld(&bar[XB_XCNT(j)]); sum += c; cnt += (c > 0u) ? 1u : 0u; mine = (j == x) ? c : mine; }
        if (sum == G) break;
        __builtin_amdgcn_s_sleep(1);
        if ((++sp & 255u) == 0u) { if (xb_ld(&bar[XB_TMO])) break; if (sp > XB_SPIN_CAP) { atomicAdd(&bar[XB_TMO], 1u); break; } }
    }
    nloc = mine > 0u ? mine : 1u; nx = cnt > 0u ? cnt : 1u;
}

__device__ __forceinline__ void xcd_barrier(const XcdBarrier& b, const int wvs) {
    asm volatile("s_waitcnt vmcnt(0)" ::: "memory");
    __syncthreads();
    if (wvs == 0 && lane_id_fresh() == 0) {
        unsigned* bar = b.bar;
        __builtin_amdgcn_s_waitcnt(0);
        unsigned nloc = b.st[0], nx = b.st[1];
        if (nloc == 0u) { xcd_barrier_complete(bar, b.x, nloc, nx); b.st[0] = nloc; b.st[1] = nx; }
        const unsigned old = xb_add(&bar[XB_XSUB(b.x)], 1u);
        const unsigned gen = old / nloc;
        if (old + 1u == (gen + 1u) * nloc) {
            __builtin_amdgcn_fence(__ATOMIC_RELEASE, "agent");
            asm volatile("s_waitcnt vmcnt(0)" ::: "memory");
            const unsigned og = xb_add(&bar[XB_TOP], 1u);
            const unsigned tg = og / nx;
            if (og + 1u == (tg + 1u) * nx) xb_add(&bar[XB_TOPGEN], 1u);
            else XB_SPIN(xb_ld(&bar[XB_TOPGEN]) == tg, bar);
            __builtin_amdgcn_fence(__ATOMIC_ACQUIRE, "agent");
            xb_add(&bar[XB_XGEN(b.x)], 1u);
            asm volatile("s_waitcnt vmcnt(0)" ::: "memory");
        } else {
            XB_SPIN(xb_ld(&bar[XB_XGEN(b.x)]) == gen, bar);
            __builtin_amdgcn_fence(__ATOMIC_ACQUIRE, "agent");
            asm volatile("s_waitcnt vmcnt(0)" ::: "memory");
        }
    }
    __syncthreads();
}

__device__ __forceinline__ void gsync(cg::grid_group& grid) {
    asm volatile("s_waitcnt vmcnt(0) lgkmcnt(0)" ::: "memory");
    grid.sync();
    __builtin_amdgcn_fence(__ATOMIC_ACQUIRE, "agent");
    asm volatile("s_waitcnt vmcnt(0)" ::: "memory");
}
__global__ void __launch_bounds__(NTHR, 2) fwd_megakernel(Params p) {
    extern __shared__ __attribute__((aligned(16))) unsigned char lds_raw[];
    LAS unsigned char* lds = (LAS unsigned char*)lds_raw;
    cg::grid_group grid = cg::this_grid();
    const int G = gridDim.x, c = blockIdx.x;
    const int wvs = __builtin_amdgcn_readfirstlane((int)(threadIdx.x >> 6));
    { volatile LAS unsigned* st0 = (volatile LAS unsigned*)(lds + 143360 + 64); if (threadIdx.x < 2) st0[threadIdx.x] = 0u; }
    __syncthreads();
    const XcdBarrier xbar = xcd_barrier_post((unsigned*)(p.ws + WS_CTL) + 4096, (volatile LAS unsigned*)(lds + 143360 + 64));
    phase_prologue(p, lds, wvs);
    gsync(grid);
    const float* mods = (const float*)(p.ws + WS_MODS);
    float* Xc = (float*)(p.ws + WS_XC);
    bf16_t* HY = (bf16_t*)(p.ws + WS_HY); bf16_t* PB = (bf16_t*)(p.ws + WS_P);
    for (int l = 0; l < DEPTH; ++l) {
        const int lastl = (l == DEPTH - 1) ? 1 : 0;
        phase_norm<true>(p, l, lds, wvs);
        xcd_barrier(xbar, wvs);
        { pg8::Gemm g{HY, (const bf16_t*)(p.ws + WS_WIN), M, NP, D, D}; pg8::StaticOrder S; S.init(M, NP, G, c); pg8::EpiBf16<0> E{PB, NP};
          pg8::gemm_phase<pg8::EpiBf16<0>, pg8::StaticOrder, true, true>(lds, g, S, E, wvs); }
        xcd_barrier(xbar, wvs);
        phase_dnprep(p, l, lds, wvs);
        xcd_barrier(xbar, wvs);
        phase_mixers(p, l, lds, wvs);
        xcd_barrier(xbar, wvs);
        phase_finalize(p, l, wvs);
        xcd_barrier(xbar, wvs);
        { pg8::Gemm g{HY, (const bf16_t*)(p.ws + WS_WOUT), M, D, D, D}; pg8::Order2 S; S.init(D, G, c, 1); pg8::EpiRes E{p.out, Xc, mods + ((size_t)l * 17 * 6 + 2) * 1024, l == 0 ? p.x : (const float*)p.out, l == 0 ? p.ctx : (const float*)Xc};
          pg8::gemm_phase<pg8::EpiRes, pg8::Order2, true, true>(lds, g, S, E, wvs); }
        if (!lastl) { pg8::Gemm g{HY, (const bf16_t*)(p.ws + WS_WOUT), M, D, D / 4, D}; pg8::CtxSplitOrder S; S.init(G, c); pg8::EpiPart E{(float*)(p.ws + WS_QKV)};
          pg8::gemm_phase<pg8::EpiPart, pg8::CtxSplitOrder, false, true>(lds, g, S, E, wvs); }
        xcd_barrier(xbar, wvs);
        phase_norm<false>(p, l, lds, wvs);
        xcd_barrier(xbar, wvs);
        { pg8::Gemm g{HY, (const bf16_t*)(p.ws + WS_W1), M, DFF, D, D}; pg8::Order2 S; S.init(DFF, G, c, lastl); pg8::EpiBf16<1> E{PB, DFF};
          pg8::gemm_phase<pg8::EpiBf16<1>, pg8::Order2, true, true>(lds, g, S, E, wvs); }
        xcd_barrier(xbar, wvs);
        { pg8::Gemm g{PB, (const bf16_t*)(p.ws + WS_W2), M, D, DFF, DFF}; pg8::Order2 S; S.init(D, G, c, 1); pg8::EpiRes E{p.out, Xc, mods + ((size_t)l * 17 * 6 + 5) * 1024, (const float*)p.out, (const float*)Xc};
          pg8::gemm_phase<pg8::EpiRes, pg8::Order2, true, true>(lds, g, S, E, wvs); }
        if (!lastl) { pg8::Gemm g{PB, (const bf16_t*)(p.ws + WS_W2), M, D, DFF / 4, DFF}; pg8::CtxSplitOrder S; S.init(G, c); pg8::EpiPart E{(float*)(p.ws + WS_QKV)};
          pg8::gemm_phase<pg8::EpiPart, pg8::CtxSplitOrder, false, true>(lds, g, S, E, wvs); }
        xcd_barrier(xbar, wvs);
    }
    phase_final(p, wvs);
}

extern "C" void kernel_launch(void* const* d_in, const int* in_sizes, int n_in, void* d_out, int out_size, void* d_ws, size_t ws_size, hipStream_t stream) {
    static int grid = 0;
    if (grid == 0) {
        if (n_in != 20 || ws_size < WS_END) { fprintf(stderr, "kernel_launch: need 20 inputs and >= %zu bytes of workspace (got %d, %zu)\n", (size_t)WS_END, n_in, ws_size); grid = -1; return; }
        int dev = 0, cus = 0, per_cu = 0;
        hipGetDevice(&dev); hipDeviceGetAttribute(&cus, hipDeviceAttributeMultiprocessorCount, dev);
        if (hipFuncSetAttribute((const void*)fwd_megakernel, hipFuncAttributeMaxDynamicSharedMemorySize, LDS_BYTES) != hipSuccess) { fprintf(stderr, "kernel_launch: hipFuncSetAttribute failed\n"); grid = -1; return; }
        if (hipOccupancyMaxActiveBlocksPerMultiprocessor(&per_cu, (const void*)fwd_megakernel, NTHR, LDS_BYTES) != hipSuccess || per_cu < 1) { fprintf(stderr, "kernel_launch: occupancy query says %d blocks/CU\n", per_cu); per_cu = 1; }
        (void)hipGetLastError();
        grid = cus;
    }
    if (grid < 0) return;
    hipMemsetAsync((char*)d_ws + WS_CTL, 0, 65536, stream);
    Params p{};
    const float** pp = (const float**)&p;
    for (int i = 0; i < 20; ++i) pp[i] = (const float*)d_in[i];
    p.out = (float*)d_out; p.ws = (unsigned char*)d_ws;
    void* args[] = {&p};
    hipError_t e = hipLaunchCooperativeKernel((const void*)fwd_megakernel, dim3(grid), dim3(NTHR), args, LDS_BYTES, stream);
    if (e != hipSuccess) fprintf(stderr, "cooperative launch failed: %s (grid %d)\n", hipGetErrorString(e), grid);
}
```

```cpp
#include <hip/hip_runtime.h>
#include <hip/hip_cooperative_groups.h>
#include <cstdio>
#include <cstdint>
namespace cg = cooperative_groups;

__device__ __forceinline__ int lane_id_fresh() { unsigned m = ~0u; asm volatile("" : "+s"(m)); return (int)__builtin_amdgcn_mbcnt_hi(m, __builtin_amdgcn_mbcnt_lo(m, 0u)); }
namespace pg8 {
#define PG8_LAS __attribute__((address_space(3)))
typedef unsigned short bf16_t;
typedef short bf16x8 __attribute__((ext_vector_type(8)));
typedef float f32x4 __attribute__((ext_vector_type(4)));
typedef unsigned u32x4 __attribute__((ext_vector_type(4)));
constexpr int BM = 256, BK = 64, HALF = 128, HTB = HALF * BK * 2  , STAGE_BYTES = 8 * HTB, NXCD = 8, WGM = 8;

__host__ __device__ __forceinline__ int lds_byte(int r, int c) { const int st = (r >> 4) * 2 + (c >> 5), rr = r & 15, cc = c & 31, ob = rr * 64 + cc * 2; return st * 1024 + (ob ^ (((ob >> 9) & 1) << 5)); }
__host__ __device__ __forceinline__ void stage_rc(int b, int& R, int& C) { const int st = b / 1024, sb = b % 1024, swz = sb ^ (((sb >> 9) & 1) << 5); R = (st >> 1) * 16 + swz / 64; C = (st & 1) * 32 + (swz % 64) / 2; }
__host__ __device__ __forceinline__ int perm32(int rho) { const int n = rho >> 4, i = rho & 15; return 8 * (i >> 2) + 4 * n + (i & 3); }

struct Unit { int pm, pn, ks; };
struct Gemm { const bf16_t* A; const bf16_t* Bt; int M, N, K, ldk; };

struct StaticOrder {
    int nM, nN, nwg, G, c;
    __host__ __device__ void init(int M, int N, int G_, int c_) { nM = M / BM; nN = N / BM; nwg = nM * nN; G = G_; c = c_; }
    __host__ __device__ bool next(int i, Unit& u) const {
        const long L = (long)i * G + c; if (L >= nwg) return false;
        int wgid = (int)L; { const int q = nwg / NXCD, r = nwg % NXCD, xcd = wgid % NXCD, off = wgid / NXCD; wgid = (xcd < r ? xcd * (q + 1) : r * (q + 1) + (xcd - r) * q) + off; }
        const int nig = WGM * nN, gid = wgid / nig, fm = gid * WGM, gsz = (nM - fm) < WGM ? (nM - fm) : WGM;
        u.pm = fm + ((wgid % nig) % gsz); u.pn = (wgid % nig) / gsz; u.ks = 0; return true;
    }
    __device__ __forceinline__ void a_ready(const Unit&) const {}
    __device__ __forceinline__ void done(const Unit&) const {}
};

struct Order2 {
    StaticOrder so; int lat;
    __host__ __device__ void init(int N, int G_, int c_, int lat_) { lat = lat_; so.init(lat_ ? 32768 : 36864, N, G_, c_); }
    __host__ __device__ bool next(int i, Unit& u) const { if (!so.next(i, u)) return false; if (lat) u.pm = (u.pm >> 3) * 9 + 1 + (u.pm & 7); return true; }
    __device__ __forceinline__ void a_ready(const Unit&) const {}
    __device__ __forceinline__ void done(const Unit&) const {}
};
struct CtxSplitOrder {
    int G, c;
    __host__ __device__ void init(int G_, int c_) { G = G_; c = c_; }
    __host__ __device__ bool next(int i, Unit& u) const { const long L = (long)i * G + c; if (L >= 256) return false; u.ks = (int)L & 3; u.pn = ((int)L >> 2) & 3; u.pm = ((int)L >> 4) * 9; return true; }
    __device__ __forceinline__ void a_ready(const Unit&) const {}
    __device__ __forceinline__ void done(const Unit&) const {}
};
__device__ __forceinline__ unsigned cvt_pk_bf16(float lo, float hi) { unsigned r; asm volatile("v_cvt_pk_bf16_f32 %0, %1, %2" : "=v"(r) : "v"(lo), "v"(hi)); return r; }

template <int ACT  > struct EpiBf16 {
    static constexpr bool PERM = true, AFTER_DRAIN = false;
    bf16_t* O; int ldc;
    __device__ __forceinline__ void operator()(const f32x4 (&acc)[2][2][4][2], const Unit& u, int wr, int wc, int fr, int fq) const {
        const int row0 = u.pm * BM + wr * 64 + fr; const int col0 = u.pn * BM + wc * 32 + 8 * fq;
#pragma unroll
        for (int ai = 0; ai < 2; ++ai)
#pragma unroll
            for (int m = 0; m < 4; ++m) { bf16_t* rowp = O + (size_t)(row0 + ai * HALF + m * 16) * ldc + col0;
#pragma unroll
                for (int bj = 0; bj < 2; ++bj) { f32x4 v0 = acc[ai][bj][m][0], v1 = acc[ai][bj][m][1];
                    if (ACT == 1) {
#pragma unroll
                        for (int e = 0; e < 4; ++e) { float a = fmaxf(v0[e], 0.f), b = fmaxf(v1[e], 0.f); v0[e] = a * a; v1[e] = b * b; } }
                    u32x4 w; w.x = cvt_pk_bf16(v0[0], v0[1]); w.y = cvt_pk_bf16(v0[2], v0[3]); w.z = cvt_pk_bf16(v1[0], v1[1]); w.w = cvt_pk_bf16(v1[2], v1[3]);
                    *(u32x4*)(rowp + bj * HALF) = w; } }
    }
};
struct EpiRes {
    static constexpr bool PERM = false, AFTER_DRAIN = false;
    float* Xl; float* Xc; const float* gates;
    const float* Xl_in; const float* Xc_in;
    __device__ __forceinline__ void operator()(const f32x4 (&acc)[2][2][4][2], const Unit& u, int wr, int wc, int fr, int fq) const {
        const int b = u.pm / 9, tt = u.pm - b * 9;
        const size_t toff = (tt == 0) ? ((size_t)(b * 256) << 10) : ((size_t)(b * 2048 + (tt - 1) * 256) << 10);
        float* base = ((tt == 0) ? Xc : Xl) + toff; const float* base_in = ((tt == 0) ? Xc_in : Xl_in) + toff;
        const float* g = gates + (size_t)((tt == 0) ? 16 : b) * 6144;
        const int col0 = u.pn * BM + wc * 32 + 4 * fq;
        float* rp0 = base + ((size_t)(wr * 64 + fr) << 10) + col0; const float* rq0 = base_in + ((size_t)(wr * 64 + fr) << 10) + col0;
#pragma unroll
        for (int bj = 0; bj < 2; ++bj)
#pragma unroll
            for (int n = 0; n < 2; ++n) { const f32x4 gvv = *(const f32x4*)(g + col0 + bj * HALF + n * 16);
#pragma unroll
                for (int ai = 0; ai < 2; ++ai) {
#pragma unroll
                    for (int m = 0; m < 4; ++m) { const size_t eo = (size_t)(ai * HALF + m * 16) * 1024 + bj * HALF + n * 16; f32x4 xv = *(const f32x4*)(rq0 + eo); xv = xv + gvv * acc[ai][bj][m][n]; *(f32x4*)(rp0 + eo) = xv; }
                    asm volatile("" ::: "memory"); } }
    }
};
struct EpiPart {
    static constexpr bool PERM = false, AFTER_DRAIN = false;
    float* part;
    __device__ __forceinline__ void operator()(const f32x4 (&acc)[2][2][4][2], const Unit& u, int wr, int wc, int fr, int fq) const {
        float* rp0 = part + (((size_t)u.ks * 4096 + (size_t)(u.pm / 9) * 256 + wr * 64 + fr) << 10) + u.pn * BM + wc * 32 + 4 * fq;
#pragma unroll
        for (int ai = 0; ai < 2; ++ai)
#pragma unroll
            for (int m = 0; m < 4; ++m)
#pragma unroll
                for (int bj = 0; bj < 2; ++bj)
#pragma unroll
                    for (int n = 0; n < 2; ++n) *(f32x4*)(rp0 + (size_t)(ai * HALF + m * 16) * 1024 + bj * HALF + n * 16) = acc[ai][bj][m][n];
    }
};
template <class Epi, class Sched, bool ALIGN_EPI = false, bool SP2 = false>
__device__ __forceinline__ void gemm_phase(PG8_LAS unsigned char* lds, const Gemm g, const Sched& S, const Epi& E, const int wvs) {
    const int tid = wvs * 64 + lane_id_fresh(); const int wid = __builtin_amdgcn_readfirstlane(tid >> 6), lane = tid & 63, wr = wid >> 2, wc = wid & 3, fr = lane & 15, fq = lane >> 4;
    const int K = g.ldk, nt = g.K / BK; const size_t sstep = (size_t)g.K * 2;
    unsigned voffA[2], voffB[2];
#pragma unroll
    for (int i = 0; i < 2; ++i) { int R, C; stage_rc(tid * 16 + i * 8192, R, C); const int Rb = Epi::PERM ? ((R & ~31) + perm32(R & 31)) : R;
        voffA[i] = (unsigned)(R * K + C) * 2u; voffB[i] = (unsigned)(Rb * K + C) * 2u; }
    const size_t kstep = (size_t)(BK * 2);
    const size_t hstep = (size_t)HALF * K * 2;
    const size_t tstep = 2 * hstep;
    const unsigned ldsw = (unsigned)wid * 1024u;
    const int aoff = lds_byte(wr * 64 + fr, fq * 8), boff = lds_byte(wc * 32 + fr, fq * 8);
#define PG8_SA(b, h) (((b) * 2 + (h)) * HTB)
#define PG8_SB(b, h) ((4 + (b) * 2 + (h)) * HTB)
#define PG8_STAGE(bufoff, gbase, voff) do { _Pragma("unroll") for (int _i = 0; _i < 2; ++_i) \
        __builtin_amdgcn_global_load_lds((const unsigned*)((const char*)(gbase) + (voff)[_i]), (PG8_LAS unsigned*)(lds + (bufoff) + ldsw + _i * 8192), 16, 0, 0); } while (0)
#define PG8_LDA(dst, b, h) do { _Pragma("unroll") for (int m = 0; m < 4; ++m) _Pragma("unroll") for (int k = 0; k < 2; ++k) dst[m][k] = *(const PG8_LAS bf16x8*)(lds + PG8_SA(b, h) + aoff + m * 2048 + k * 1024); } while (0)
#define PG8_LDB(dst, b, h) do { _Pragma("unroll") for (int n = 0; n < 2; ++n) _Pragma("unroll") for (int k = 0; k < 2; ++k) dst[n][k] = *(const PG8_LAS bf16x8*)(lds + PG8_SB(b, h) + boff + n * 2048 + k * 1024); } while (0)
#define PG8_MMA(ai, bj, At, Bt) do { __builtin_amdgcn_s_setprio(1); _Pragma("unroll") for (int m = 0; m < 4; ++m) _Pragma("unroll") for (int n = 0; n < 2; ++n) _Pragma("unroll") for (int k = 0; k < 2; ++k) \
        acc[ai][bj][m][n] = __builtin_amdgcn_mfma_f32_16x16x32_bf16(Bt[n][k], At[m][k], acc[ai][bj][m][n], 0, 0, 0); __builtin_amdgcn_s_setprio(0); } while (0)
#define PG8_WAIT_V(n) asm volatile("s_waitcnt vmcnt(" #n ")" ::: "memory")
#define PG8_WAIT_L(n) asm volatile("s_waitcnt lgkmcnt(" #n ")" ::: "memory")
#define PG8_BAR __builtin_amdgcn_s_barrier()
#define PG8_SCHED __builtin_amdgcn_sched_barrier(0)
    Unit cur, nxt; int ui = 0;
    if (!S.next(0, cur)) return;
    f32x4 acc[2][2][4][2];
#pragma unroll
    for (int a = 0; a < 2; ++a)
#pragma unroll
        for (int b = 0; b < 2; ++b)
#pragma unroll
            for (int m = 0; m < 4; ++m)
#pragma unroll
                for (int n = 0; n < 2; ++n) acc[a][b][m][n] = (f32x4){0.f, 0.f, 0.f, 0.f};
    bf16x8 At[4][2], B0[2][2], B1[2][2];
    const char* cA = (const char*)g.A + (size_t)cur.pm * tstep + (size_t)cur.ks * sstep; const char* cB = (const char*)g.Bt + (size_t)cur.pn * tstep + (size_t)cur.ks * sstep;
    S.a_ready(cur);
    if constexpr (SP2) {
        PG8_STAGE(PG8_SB(0, 0), cB, voffB); PG8_STAGE(PG8_SB(0, 1), cB + hstep, voffB); PG8_STAGE(PG8_SA(0, 0), cA, voffA); PG8_STAGE(PG8_SA(0, 1), cA + hstep, voffA);
        if (wr == 1) PG8_BAR;
        PG8_WAIT_V(2); PG8_BAR;
        PG8_STAGE(PG8_SB(1, 0), cB + kstep, voffB); PG8_STAGE(PG8_SA(1, 0), cA + kstep, voffA); PG8_STAGE(PG8_SB(1, 1), cB + hstep + kstep, voffB);
        PG8_WAIT_V(6); PG8_BAR;
    } else {
        PG8_STAGE(PG8_SB(0, 0), cB, voffB); PG8_STAGE(PG8_SA(0, 0), cA, voffA); PG8_STAGE(PG8_SB(0, 1), cB + hstep, voffB); PG8_STAGE(PG8_SA(0, 1), cA + hstep, voffA);
        if (wr == 1) PG8_BAR;
        PG8_WAIT_V(4); PG8_BAR;
        PG8_STAGE(PG8_SB(1, 0), cB + kstep, voffB); PG8_STAGE(PG8_SA(1, 0), cA + kstep, voffA); PG8_STAGE(PG8_SB(1, 1), cB + hstep + kstep, voffB);
        PG8_WAIT_V(6); PG8_BAR;
    }
    for (;;) {
        const bool has_next = S.next(ui + 1, nxt);
        const char* nA = has_next ? (const char*)g.A + (size_t)nxt.pm * tstep + (size_t)nxt.ks * sstep : cA; const char* nB = has_next ? (const char*)g.Bt + (size_t)nxt.pn * tstep + (size_t)nxt.ks * sstep : cB;
        for (int t = 0; t < nt; t += 2) {
            const bool last = (t == nt - 2);
            const char* a1 = cA + (size_t)(t + 1) * kstep;
            const char* a2 = last ? nA : cA + (size_t)(t + 2) * kstep; const char* b2 = last ? nB : cB + (size_t)(t + 2) * kstep;
            const char* a3 = a2 + kstep; const char* b3 = b2 + kstep;
            if (last && has_next) S.a_ready(nxt);
            if constexpr (SP2) {
            PG8_LDB(B0, 0, 0); PG8_LDB(B1, 0, 1); PG8_SCHED; PG8_LDA(At, 0, 0); PG8_STAGE(PG8_SA(1, 1), a1 + hstep, voffA);
            PG8_WAIT_V(8); PG8_WAIT_L(0); PG8_BAR; PG8_MMA(0, 0, At, B0); PG8_MMA(0, 1, At, B1); PG8_BAR; PG8_SCHED;
            PG8_LDA(At, 0, 1); PG8_STAGE(PG8_SB(0, 0), b2, voffB); PG8_STAGE(PG8_SB(0, 1), b2 + hstep, voffB); PG8_STAGE(PG8_SA(0, 0), a2, voffA);
            PG8_WAIT_V(8); PG8_WAIT_L(0); PG8_BAR; PG8_MMA(1, 0, At, B0); PG8_MMA(1, 1, At, B1); PG8_BAR; PG8_SCHED;
            PG8_LDB(B0, 1, 0); PG8_LDB(B1, 1, 1); PG8_SCHED; PG8_LDA(At, 1, 0); PG8_STAGE(PG8_SA(0, 1), a2 + hstep, voffA);
            PG8_WAIT_V(8); PG8_WAIT_L(0); PG8_BAR; PG8_MMA(0, 0, At, B0); PG8_MMA(0, 1, At, B1); PG8_BAR; PG8_SCHED;
            PG8_LDA(At, 1, 1); PG8_STAGE(PG8_SB(1, 0), b3, voffB); PG8_STAGE(PG8_SB(1, 1), b3 + hstep, voffB); PG8_STAGE(PG8_SA(1, 0), a3, voffA);
            PG8_WAIT_V(8); PG8_WAIT_L(0); PG8_BAR; PG8_MMA(1, 0, At, B0); PG8_MMA(1, 1, At, B1); PG8_BAR; PG8_SCHED;
            } else {
            PG8_LDB(B0, 0, 0); PG8_SCHED; PG8_LDA(At, 0, 0); PG8_STAGE(PG8_SA(1, 1), a1 + hstep, voffA);
            PG8_WAIT_L(8); PG8_BAR; PG8_WAIT_L(0); PG8_MMA(0, 0, At, B0); PG8_BAR; PG8_SCHED;
            PG8_LDB(B1, 0, 1); PG8_STAGE(PG8_SB(0, 0), b2, voffB);
            PG8_BAR; PG8_WAIT_L(0); PG8_MMA(0, 1, At, B1); PG8_BAR;
            PG8_LDA(At, 0, 1); PG8_STAGE(PG8_SA(0, 0), a2, voffA);
            PG8_BAR; PG8_WAIT_L(0); PG8_MMA(1, 0, At, B0); PG8_BAR; PG8_SCHED;
            PG8_STAGE(PG8_SB(0, 1), b2 + hstep, voffB);
            PG8_WAIT_V(6); PG8_BAR; PG8_MMA(1, 1, At, B1); PG8_BAR;
            PG8_LDB(B0, 1, 0); PG8_SCHED; PG8_LDA(At, 1, 0); PG8_STAGE(PG8_SA(0, 1), a2 + hstep, voffA);
            PG8_WAIT_L(8); PG8_BAR; PG8_WAIT_L(0); PG8_MMA(0, 0, At, B0); PG8_BAR; PG8_SCHED;
            PG8_LDB(B1, 1, 1); PG8_STAGE(PG8_SB(1, 0), b3, voffB);
            PG8_BAR; PG8_WAIT_L(0); PG8_MMA(0, 1, At, B1); PG8_BAR;
            PG8_LDA(At, 1, 1); PG8_STAGE(PG8_SA(1, 0), a3, voffA);
            PG8_BAR; PG8_WAIT_L(0); PG8_MMA(1, 0, At, B0); PG8_BAR; PG8_SCHED;
            PG8_STAGE(PG8_SB(1, 1), b3 + hstep, voffB);
            PG8_WAIT_V(6); PG8_BAR; PG8_MMA(1, 1, At, B1); PG8_BAR;
            }
        }
        if constexpr (ALIGN_EPI) { if (wr == 0) PG8_BAR; }
        if constexpr (!Epi::AFTER_DRAIN) { E(acc, cur, wr, wc, fr, fq); S.done(cur); }
        if (!has_next) break;
#pragma unroll
        for (int a = 0; a < 2; ++a)
#pragma unroll
            for (int b = 0; b < 2; ++b)
#pragma unroll
                for (int m = 0; m < 4; ++m)
#pragma unroll
                    for (int n = 0; n < 2; ++n) acc[a][b][m][n] = (f32x4){0.f, 0.f, 0.f, 0.f};
        cur = nxt; cA = nA; cB = nB; ++ui;
        if constexpr (ALIGN_EPI) { if (wr == 1) PG8_BAR; }
    }
    PG8_WAIT_V(0);
    if constexpr (!ALIGN_EPI) { if (wr == 0) PG8_BAR; }
    PG8_BAR;
    if constexpr (Epi::AFTER_DRAIN) { E.fused(acc, cur, wr, wc, fr, fq, lds, wid, lane); S.done(cur); }
#undef PG8_SA
#undef PG8_SB
#undef PG8_STAGE
#undef PG8_LDA
#undef PG8_LDB
#undef PG8_MMA
#undef PG8_WAIT_V
#undef PG8_WAIT_L
#undef PG8_BAR
#undef PG8_SCHED
}
}

constexpr int D = 1024, BATCH = 16, SEQ = 2048, CTX = 256, DEPTH = 4;
constexpr int TPB = CTX + SEQ;
constexpr int M = BATCH * TPB;
constexpr int DIN = 3088, NP = 3072, DFF = 4096;
constexpr int PC_DNQ = 0, PC_DNG = 768, PC_SQ = 1024, PC_SK = 1536, PC_SV = 1664, PC_HQ = 1792, PC_HF = 2048, PC_HI = 2560, PC_HG = 2816;
constexpr float EPS = 1e-6f;
constexpr size_t MiB = 1u << 20;
constexpr size_t WS_CTL = 0, WS_MODS = 1 * MiB, WS_ROPE = 3 * MiB, WS_LB = 3 * MiB + 512 * 1024, WS_AB = 4 * MiB;
constexpr size_t WS_WIN = 7 * MiB, WS_WOUT = 13 * MiB, WS_W1 = 15 * MiB, WS_W2 = 23 * MiB, WS_XC = 32 * MiB, WS_HY = 48 * MiB, WS_P = 120 * MiB;
constexpr size_t WS_OD = WS_P + 216 * MiB, WS_QKV = WS_P + 288 * MiB, WS_END = WS_QKV + 64 * MiB;
constexpr int LDS_BYTES = 147456;
constexpr int NWAVES = 8, NTHR = 512;

#define LAS __attribute__((address_space(3)))
typedef unsigned short bf16_t;
typedef float f32x4 __attribute__((ext_vector_type(4)));
typedef short bf16x8 __attribute__((ext_vector_type(8)));
typedef short s16x4 __attribute__((ext_vector_type(4)));
typedef unsigned u32x4 __attribute__((ext_vector_type(4)));
typedef unsigned u32x2 __attribute__((ext_vector_type(2)));

struct Params {
    const float *x, *c, *ctx, *c_ctx, *w_ada, *b_ada, *norm1, *norm2, *w_in, *dn_conv, *dn_A_log, *dn_dt_bias, *dn_norm, *swa_sink, *hg_lb, *hg_norm, *w_out, *w_ff1, *w_ff2, *norm_f;
    float* out; unsigned char* ws;
};

__device__ __forceinline__ float bflo(unsigned u) { return __uint_as_float(u << 16); }
__device__ __forceinline__ float bfhi(unsigned u) { return __uint_as_float(u & 0xffff0000u); }
__device__ __forceinline__ unsigned pk2(float lo, float hi) { return pg8::cvt_pk_bf16(lo, hi); }
__device__ __forceinline__ bf16_t bf1(float f) { unsigned u = __float_as_uint(f); u += 0x7fffu + ((u >> 16) & 1u); return (bf16_t)(u >> 16); }
__device__ __forceinline__ float siluf(float v) { return v / (1.f + __expf(-v)); }
__device__ __forceinline__ float sigmf(float v) { return 1.f / (1.f + __expf(-v)); }
__device__ __forceinline__ float wave_sum(float v) {
#pragma unroll
    for (int o = 1; o < 64; o <<= 1) v += __shfl_xor(v, o);
    return v;
}
template <int CTRL> __device__ __forceinline__ float dpp(float x) { return __builtin_bit_cast(float, __builtin_amdgcn_mov_dpp(__builtin_bit_cast(int, x), CTRL, 0xf, 0xf, true)); }
constexpr int XOR1 = 0xB1, XOR2 = 0x4E, XOR7 = 0x141;
__device__ __forceinline__ float sum8(float v) { v += dpp<XOR1>(v); v += dpp<XOR2>(v); v += dpp<XOR7>(v); return v; }
__device__ __forceinline__ float xrow16_max(float x) {
    auto s = __builtin_amdgcn_permlane16_swap(__float_as_uint(x), __float_as_uint(x), false, false);
    x = fmaxf(__uint_as_float(s[0]), __uint_as_float(s[1]));
    auto t = __builtin_amdgcn_permlane32_swap(__float_as_uint(x), __float_as_uint(x), false, false);
    return fmaxf(__uint_as_float(t[0]), __uint_as_float(t[1]));
}
__device__ __forceinline__ float xrow16_sum(float x) {
    auto s = __builtin_amdgcn_permlane16_swap(__float_as_uint(x), __float_as_uint(x), false, false);
    x = __uint_as_float(s[0]) + __uint_as_float(s[1]);
    auto t = __builtin_amdgcn_permlane32_swap(__float_as_uint(x), __float_as_uint(x), false, false);
    return __uint_as_float(t[0]) + __uint_as_float(t[1]);
}
__device__ __forceinline__ const float* xrow_c(const float* Xl, const float* Xc, int r) { const int b = r / TPB, t = r - b * TPB; return t < CTX ? Xc + ((size_t)(b * CTX + t) << 10) : Xl + ((size_t)(b * SEQ + t - CTX) << 10); }
__device__ __forceinline__ int cidx(int r) { const int b = r / TPB, t = r - b * TPB; return t < CTX ? 16 : b; }

__device__ __forceinline__ void phase_prologue(const Params& p, LAS unsigned char* lds, const int wvs) {
    const int tid = wvs * 64 + lane_id_fresh(); const int lane = tid & 63, w = tid >> 6;
    float* mods = (float*)(p.ws + WS_MODS);
    LAS float* sc = (LAS float*)lds;
    LAS float* red = (LAS float*)(lds + 81920);
    for (int idx = tid; idx < 17 * 1024; idx += NTHR) { const int ci = idx >> 10, k = idx & 1023; const float v = ci < 16 ? p.c[ci * 1024 + k] : p.c_ctx[k]; sc[k * 20 + ci] = v / (1.f + expf(-v)); }
    __syncthreads();
    for (int it = blockIdx.x; it < DEPTH * 96; it += gridDim.x) {
        const int l = it / 96, cgp = it - l * 96, col = cgp * 64 + lane;
        float acc[17];
#pragma unroll
        for (int i = 0; i < 17; ++i) acc[i] = 0.f;
        const float* wp = p.w_ada + ((size_t)l * 1024 + w * 128) * 6144 + col;
#pragma unroll 16
        for (int kk = 0; kk < 128; ++kk) {
            const float wv = wp[(size_t)kk * 6144];
            const LAS f32x4* s4 = (const LAS f32x4*)(sc + (w * 128 + kk) * 20);
            const f32x4 s0 = s4[0], s1 = s4[1], s2 = s4[2], s3 = s4[3]; const float s16 = sc[(w * 128 + kk) * 20 + 16];
#pragma unroll
            for (int e = 0; e < 4; ++e) { acc[e] += wv * s0[e]; acc[4 + e] += wv * s1[e]; acc[8 + e] += wv * s2[e]; acc[12 + e] += wv * s3[e]; }
            acc[16] += wv * s16;
        }
#pragma unroll
        for (int i = 0; i < 17; ++i) red[(w * 17 + i) * 64 + lane] = acc[i];
        __syncthreads();
        for (int idx = tid; idx < 17 * 64; idx += NTHR) { const int i = idx >> 6, cl = idx & 63; float s = 0.f;
#pragma unroll
            for (int ww = 0; ww < 8; ++ww) s += red[(ww * 17 + i) * 64 + cl];
            mods[((size_t)l * 17 + i) * 6144 + cgp * 64 + cl] = s + p.b_ada[l * 6144 + cgp * 64 + cl]; }
        __syncthreads();
    }
    const int gt = blockIdx.x * NTHR + tid, GT = gridDim.x * NTHR;
    { float* rc = (float*)(p.ws + WS_ROPE); float* rs = rc + 2048 * 32;
      for (int idx = gt; idx < 2048 * 32; idx += GT) { const int t = idx >> 5, d = idx & 31; const float pos = (float)(d < 16 ? (t >> 6) : (t & 63));
          const float inv = expf(-(float)(d & 15) * (9.210340371976184f / 16.f)); const float ang = pos * inv; rc[idx] = cosf(ang); rs[idx] = sinf(ang); } }
    { float* LB = (float*)(p.ws + WS_LB);
      for (int idx = gt; idx < 2 * 256; idx += GT) { const int d = idx >> 8, cc = idx & 255; float v[DEPTH]; float mx = -1e30f;
#pragma unroll
          for (int l = 0; l < DEPTH; ++l) { v[l] = p.hg_lb[(d * DEPTH + l) * 256 + cc]; mx = fmaxf(mx, v[l]); }
          float s = 0.f;
#pragma unroll
          for (int l = 0; l < DEPTH; ++l) { v[l] = expf(v[l] - mx); s += v[l]; }
          float cum = 0.f;
#pragma unroll
          for (int l = 0; l < DEPTH; ++l) { if (l > 0) cum += v[l] / s; LB[(d * DEPTH + l) * 256 + cc] = cum; } } }
}

__device__ __forceinline__ void transpose_item(const float* W, int K, int ldw, int scol0, bf16_t* WT, int n0, int k0, LAS float* scr, int lane) {
#pragma unroll 8
    for (int i = 0; i < 32; ++i) { const int kk = 2 * i + (lane >> 5); scr[kk * 33 + (lane & 31)] = W[(size_t)(k0 + kk) * ldw + scol0 + (lane & 31)]; }
    asm volatile("s_waitcnt lgkmcnt(0)" ::: "memory");
    const int c = lane & 7;
#pragma unroll
    for (int j = 0; j < 4; ++j) { const int n = (lane >> 3) + 8 * j; const LAS float* s = scr + (8 * c) * 33 + n;
        u32x4 o; o.x = pk2(s[0 * 33], s[1 * 33]); o.y = pk2(s[2 * 33], s[3 * 33]); o.z = pk2(s[4 * 33], s[5 * 33]); o.w = pk2(s[6 * 33], s[7 * 33]);
        *(u32x4*)(WT + (size_t)(n0 + n) * K + k0 + 8 * c) = o; }
    asm volatile("s_waitcnt lgkmcnt(0)" ::: "memory");
}

template <bool FIRST> __device__ __forceinline__ void phase_norm(const Params& p, int l, LAS unsigned char* lds, const int wvs) {
    const int tid = wvs * 64 + lane_id_fresh(); const int lane = tid & 63, w = tid >> 6;
    const int gw = blockIdx.x * NWAVES + w, NGW = gridDim.x * NWAVES;
    const float* mods = (const float*)(p.ws + WS_MODS);
    constexpr int WST = 1032;
    LAS bf16_t* wab = (LAS bf16_t*)lds;
    if (FIRST) {
        LAS float* scr = (LAS float*)(lds + 65536 + w * 8704);
        constexpr int I_IN = 16 * 96, I_OUT = 16 * 32, I_1 = 16 * 128, I_2 = 64 * 32;
        for (int it = gw; it < I_IN + I_OUT + I_1 + I_2; it += NGW) {
            int r = it;
            if (r < I_IN) { const int kb = r / 96, nb = r - kb * 96; const int n0 = nb * 32; transpose_item(p.w_in + (size_t)l * D * DIN, D, DIN, n0 + (n0 >= 1024 ? 16 : 0), (bf16_t*)(p.ws + WS_WIN), n0, kb * 64, scr, lane); continue; }
            r -= I_IN;
            if (r < I_OUT) { const int kb = r / 32, nb = r - kb * 32; transpose_item(p.w_out + (size_t)l * D * D, D, D, nb * 32, (bf16_t*)(p.ws + WS_WOUT), nb * 32, kb * 64, scr, lane); continue; }
            r -= I_OUT;
            if (r < I_1) { const int kb = r / 128, nb = r - kb * 128; transpose_item(p.w_ff1 + (size_t)l * D * DFF, D, DFF, nb * 32, (bf16_t*)(p.ws + WS_W1), nb * 32, kb * 64, scr, lane); continue; }
            r -= I_1;
            { const int kb = r / 32, nb = r - kb * 32; transpose_item(p.w_ff2 + (size_t)l * DFF * D, DFF, D, nb * 32, (bf16_t*)(p.ws + WS_W2), nb * 32, kb * 64, scr, lane); }
        }
        const float* wi = p.w_in + (size_t)l * D * DIN + 1024;
        for (int idx = tid; idx < 4096; idx += NTHR) { const int k = idx >> 2, j4 = (idx & 3) * 4; const f32x4 v = *(const f32x4*)(wi + (size_t)k * DIN + j4);
#pragma unroll
            for (int e = 0; e < 4; ++e) wab[(j4 + e) * WST + k] = bf1(v[e]); }
        __syncthreads();
    }
    const float* nw = (FIRST ? p.norm1 : p.norm2) + l * D;
    bf16_t* H = (bf16_t*)(p.ws + WS_HY);
    float* AB = (float*)(p.ws + WS_AB);
    float* Xc = (float*)(p.ws + WS_XC);
    const float* part = (const float*)(p.ws + WS_QKV);
    const bool fix = FIRST ? (l > 0) : (l < DEPTH - 1);
    const float* fgate = mods + ((size_t)(FIRST ? (l > 0 ? l - 1 : 0) : l) * 17 + 16) * 6144 + (FIRST ? 5 : 2) * 1024;
    int nrows = 0;
    for (int r = gw; r < M; r += NGW) {
        ++nrows;
        if (!FIRST && l == DEPTH - 1 && (r % TPB) < CTX) continue;
        const f32x4* xr = (const f32x4*)((FIRST && l == 0) ? xrow_c(p.x, p.ctx, r) : xrow_c(p.out, Xc, r)) + lane;
        f32x4 v[4]; float ss = 0.f;
        const int rb = r / TPB, rt = r - rb * TPB;
        if (fix && rt < CTX) {
            const f32x4* xin = (const f32x4*)((!FIRST && l == 0) ? p.ctx + ((size_t)(rb * CTX + rt) << 10) : Xc + ((size_t)(rb * CTX + rt) << 10)) + lane;
            const f32x4* pr = (const f32x4*)(part + ((size_t)(rb * CTX + rt) << 10)) + lane; f32x4* xo = (f32x4*)(Xc + ((size_t)(rb * CTX + rt) << 10)) + lane;
#pragma unroll
            for (int j = 0; j < 4; ++j) { const f32x4 gq = *(const f32x4*)(fgate + 4 * (lane + 64 * j));
                const f32x4 s4 = (pr[64 * j] + pr[64 * j + 1048576]) + (pr[64 * j + 2 * 1048576] + pr[64 * j + 3 * 1048576]);
                v[j] = xin[64 * j] + gq * s4; xo[64 * j] = v[j]; }
        } else {
#pragma unroll
            for (int j = 0; j < 4; ++j) v[j] = xr[64 * j];
        }
#pragma unroll
        for (int j = 0; j < 4; ++j) ss += (v[j][0] * v[j][0] + v[j][1] * v[j][1]) + (v[j][2] * v[j][2] + v[j][3] * v[j][3]);
        const float rstd = rsqrtf(wave_sum(ss) * (1.f / D) + EPS);
        const float* md = mods + ((size_t)l * 17 + cidx(r)) * 6144 + (FIRST ? 0 : 3 * 1024);
        u32x2* hp = (u32x2*)(H + (size_t)r * D) + lane;
#pragma unroll
        for (int j = 0; j < 4; ++j) { const int k = 4 * (lane + 64 * j);
            const f32x4 g = *(const f32x4*)(nw + k), sh = *(const f32x4*)(md + k), sl = *(const f32x4*)(md + 1024 + k);
            f32x4 h;
#pragma unroll
            for (int e = 0; e < 4; ++e) h[e] = (v[j][e] * rstd * g[e]) * (1.f + sl[e]) + sh[e];
            u32x2 o2; o2.x = pk2(h[0], h[1]); o2.y = pk2(h[2], h[3]); hp[64 * j] = o2;
        }
    }
    if (FIRST) {
        asm volatile("s_waitcnt vmcnt(0)" ::: "memory");
        const int fr = lane & 15, fq = lane >> 4;
        for (int b0 = 0; b0 < nrows; b0 += 16) {
            const int kr = b0 + fr; const bool ok = kr < nrows; const bf16_t* hp = H + (size_t)(gw + (ok ? kr : 0) * NGW) * D + fq * 8;
            f32x4 c = (f32x4){0.f, 0.f, 0.f, 0.f};
#pragma unroll 8
            for (int ks = 0; ks < 32; ++ks) { u32x4 av = *(const u32x4*)(hp + ks * 32); if (!ok) av = (u32x4){0u, 0u, 0u, 0u};
                const bf16x8 bv = *(const LAS bf16x8*)(wab + fr * WST + ks * 32 + fq * 8);
                c = __builtin_amdgcn_mfma_f32_16x16x32_bf16(__builtin_bit_cast(bf16x8, av), bv, c, 0, 0, 0); }
#pragma unroll
            for (int j = 0; j < 4; ++j) { const int k2 = b0 + fq * 4 + j; if (k2 < nrows) AB[(size_t)(gw + k2 * NGW) * 16 + fr] = c[j]; }
        }
    }
}

constexpr int SST = 68;
constexpr int HST = 72;
__device__ __forceinline__ bf16x8 ldA_perm(const LAS bf16_t* base, int row, int s, int fq) {
    const LAS bf16_t* ap = base + row * HST + s * 32 + fq * 4; const u32x2 lo = *(const LAS u32x2*)ap, hi = *(const LAS u32x2*)(ap + 16);
    u32x4 av; av[0] = lo[0]; av[1] = lo[1]; av[2] = hi[0]; av[3] = hi[1]; return __builtin_bit_cast(bf16x8, av);
}
__device__ __forceinline__ bf16x8 packB(const f32x4& a, const f32x4& b) {
    u32x4 pb; pb[0] = bf1(a[0]) | ((unsigned)bf1(a[1]) << 16); pb[1] = bf1(a[2]) | ((unsigned)bf1(a[3]) << 16); pb[2] = bf1(b[0]) | ((unsigned)bf1(b[1]) << 16); pb[3] = bf1(b[2]) | ((unsigned)bf1(b[3]) << 16);
    return __builtin_bit_cast(bf16x8, pb);
}
__device__ __forceinline__ void phase_dnprep(const Params& p, int l, LAS unsigned char* lds, const int wvs) {
    const int tid = wvs * 64 + lane_id_fresh();
    constexpr int RST = 200;
    LAS float* qs = (LAS float*)lds; LAS float* ks = qs + 64 * SST; LAS float* vs = ks + 64 * SST; LAS bf16_t* RAW = (LAS bf16_t*)(vs + 64 * SST);
    const bf16_t* P = (const bf16_t*)(p.ws + WS_P);
    bf16_t* QKV = (bf16_t*)(p.ws + WS_QKV);
    const float* cw = p.dn_conv + (size_t)l * 5 * 768;
    const int c4 = tid % 48, tg = tid / 48;
    LAS float* cdst = ((c4 >> 4) == 0 ? qs : ((c4 >> 4) == 1 ? ks : vs)) + (c4 & 15) * 4;
    for (int it = blockIdx.x; it < BATCH * 36 * 4; it += gridDim.x) {
        const int h = it & 3, bc = it >> 2, b = bc / 36, nc = bc - b * 36;
        const int base = b * TPB + nc * 64, lo = b * TPB + (nc < 4 ? 0 : CTX), hi = b * TPB + (nc < 4 ? CTX : TPB);
        float wc[5][4];
        { const int ch = c4 * 4, pcol = (ch >> 6) * 256 + h * 64 + (ch & 63);
#pragma unroll
          for (int t = 0; t < 5; ++t) { const f32x4 w4 = *(const f32x4*)(cw + t * 768 + pcol); wc[t][0] = w4[0]; wc[t][1] = w4[1]; wc[t][2] = w4[2]; wc[t][3] = w4[3]; } }
#pragma unroll
        for (int k = 0; k < 4; ++k) { const int q = tid + NTHR * k; if (q < 68 * 24) { const int rr = q / 24, pc = q - rr * 24; const int r = base - 2 + rr;
            const u32x4 v = (r >= lo && r < hi) ? *(const u32x4*)(P + (size_t)r * NP + (pc >> 3) * 256 + h * 64 + (pc & 7) * 8) : (u32x4){0u, 0u, 0u, 0u};
            *(LAS u32x4*)(RAW + rr * RST + pc * 8) = v; } }
        __syncthreads();
        if (tid < 480) {
#pragma unroll
            for (int m = 0; m < 7; ++m) { const int pp = tg + 10 * m; if (pp < 64) { float a0 = 0.f, a1 = 0.f, a2 = 0.f, a3 = 0.f;
#pragma unroll
                for (int t = 0; t < 5; ++t) { const u32x2 raw = *(const LAS u32x2*)(RAW + (pp + t) * RST + c4 * 4);
                    a0 += bflo(raw[0]) * wc[t][0]; a1 += bfhi(raw[0]) * wc[t][1]; a2 += bflo(raw[1]) * wc[t][2]; a3 += bfhi(raw[1]) * wc[t][3]; }
                f32x4 o; o[0] = a0 / (1.f + __expf(-a0)); o[1] = a1 / (1.f + __expf(-a1)); o[2] = a2 / (1.f + __expf(-a2)); o[3] = a3 / (1.f + __expf(-a3));
                *(LAS f32x4*)(cdst + pp * SST) = o; } } }
        __syncthreads();
        { const int t = tid >> 3, part = tid & 7;
          const f32x4 q0 = *(const LAS f32x4*)(qs + t * SST + part * 8), q1 = *(const LAS f32x4*)(qs + t * SST + part * 8 + 4);
          const f32x4 k0 = *(const LAS f32x4*)(ks + t * SST + part * 8), k1 = *(const LAS f32x4*)(ks + t * SST + part * 8 + 4);
          const f32x4 v0 = *(const LAS f32x4*)(vs + t * SST + part * 8), v1 = *(const LAS f32x4*)(vs + t * SST + part * 8 + 4);
          float sq = (q0[0] * q0[0] + q0[1] * q0[1]) + (q0[2] * q0[2] + q0[3] * q0[3]) + (q1[0] * q1[0] + q1[1] * q1[1]) + (q1[2] * q1[2] + q1[3] * q1[3]);
          float sk = (k0[0] * k0[0] + k0[1] * k0[1]) + (k0[2] * k0[2] + k0[3] * k0[3]) + (k1[0] * k1[0] + k1[1] * k1[1]) + (k1[2] * k1[2] + k1[3] * k1[3]);
          sq = sum8(sq); sk = sum8(sk);
          const float rq = rsqrtf(sq + EPS) * 0.125f, rk = rsqrtf(sk + EPS);
          u32x4 qo, ko, vo;
          qo[0] = pk2(q0[0] * rq, q0[1] * rq); qo[1] = pk2(q0[2] * rq, q0[3] * rq); qo[2] = pk2(q1[0] * rq, q1[1] * rq); qo[3] = pk2(q1[2] * rq, q1[3] * rq);
          ko[0] = pk2(k0[0] * rk, k0[1] * rk); ko[1] = pk2(k0[2] * rk, k0[3] * rk); ko[2] = pk2(k1[0] * rk, k1[1] * rk); ko[3] = pk2(k1[2] * rk, k1[3] * rk);
          vo[0] = pk2(v0[0], v0[1]); vo[1] = pk2(v0[2], v0[3]); vo[2] = pk2(v1[0], v1[1]); vo[3] = pk2(v1[2], v1[3]);
          bf16_t* dst = QKV + ((size_t)(base + t) * 4 + h) * 192 + part * 8;
          *(u32x4*)dst = qo; *(u32x4*)(dst + 64) = ko; *(u32x4*)(dst + 128) = vo; }
        __syncthreads();
    }
    { bf16_t* Pw = (bf16_t*)(p.ws + WS_P); const float* rc = (const float*)(p.ws + WS_ROPE); const float* rs = rc + 2048 * 32;
      const int gt = blockIdx.x * NTHR + tid, GT = gridDim.x * NTHR;
      for (int idx = gt; idx < BATCH * SEQ * 8; idx += GT) { const int rl = idx >> 3, rem = idx & 7, kh = rem >> 2, g = rem & 3;
          const int bb = rl >> 11, t = rl & 2047;
          bf16_t* pp = Pw + (size_t)(bb * TPB + CTX + t) * NP + PC_SK + kh * 64 + g * 8;
          const u32x4 r1 = *(const u32x4*)pp, r2 = *(const u32x4*)(pp + 32);
          const f32x4 c0 = *(const f32x4*)(rc + t * 32 + g * 8), c1 = *(const f32x4*)(rc + t * 32 + g * 8 + 4), s0 = *(const f32x4*)(rs + t * 32 + g * 8), s1 = *(const f32x4*)(rs + t * 32 + g * 8 + 4);
          u32x4 o1, o2;
#pragma unroll
          for (int e = 0; e < 4; ++e) { const float xa = bflo(r1[e]), xb = bfhi(r1[e]), ya = bflo(r2[e]), yb = bfhi(r2[e]);
              const float ca = e < 2 ? c0[2 * e] : c1[2 * e - 4], cb = e < 2 ? c0[2 * e + 1] : c1[2 * e - 3], sa = e < 2 ? s0[2 * e] : s1[2 * e - 4], sb = e < 2 ? s0[2 * e + 1] : s1[2 * e - 3];
              o1[e] = pk2(xa * ca - ya * sa, xb * cb - yb * sb); o2[e] = pk2(xa * sa + ya * ca, xb * sb + yb * cb); }
          *(u32x4*)pp = o1; *(u32x4*)(pp + 32) = o2; } }
}

__device__ __forceinline__ void dn_seq(const Params& p, int l, int s, LAS unsigned char* lds, const int wvs) {
    const int tid = wvs * 64 + lane_id_fresh(); const int lane = tid & 63;
    const int b = s >> 3, h = (s >> 1) & 3, d = s & 1;
    LAS bf16_t* QH = (LAS bf16_t*)lds; LAS bf16_t* KH = QH + 64 * HST; LAS bf16_t* VB = KH + 64 * HST; LAS bf16_t* KTT = VB + 64 * HST; LAS bf16_t* LM = KTT + 64 * HST; LAS bf16_t* SCM = LM + 64 * HST; LAS bf16_t* OB = SCM + 64 * HST;
    LAS float* LF = (LAS float*)(OB + 64 * HST);
    LAS bf16_t* DI = (LAS bf16_t*)(LF + 4 * 16 * 17);
    LAS float* GC = (LAS float*)(DI + 4 * 16 * 24); LAS float* EG = GC + 64; LAS float* BETA = EG + 64; LAS float* GL = BETA + 64;
    const bf16_t* QKV = (const bf16_t*)(p.ws + WS_QKV);
    const float* AB = (const float*)(p.ws + WS_AB);
    bf16_t* OD = (bf16_t*)(p.ws + WS_OD) + (size_t)d * M * 512 + h * 64;
    const float nA = -expf(p.dn_A_log[(l * 2 + d) * 4 + h]); const float dtb = p.dn_dt_bias[(l * 2 + d) * 4 + h];
    const int fr = lane & 15, fq = lane >> 4;
    const int V = wvs & 3, half = wvs >> 2;
    const f32x4 zero4 = (f32x4){0.f, 0.f, 0.f, 0.f};
    u32x4 praw[3]; float pa = 0.f, pb_ = 0.f;
    { const int nc0 = d == 0 ? 0 : 3; const int base0 = b * TPB + nc0 * 64;
#pragma unroll
      for (int k = 0; k < 3; ++k) { const int q = tid + NTHR * k; const int rr = q / 24, pc = q - rr * 24; praw[k] = *(const u32x4*)(QKV + ((size_t)(base0 + rr) * 4 + h) * 192 + pc * 8); }
      if (wvs == 0) { const int r = base0 + (d ? 63 - lane : lane); pa = AB[(size_t)r * 16 + d * 4 + h]; pb_ = AB[(size_t)r * 16 + 8 + d * 4 + h]; } }
    f32x4 Sacc[4];
#pragma unroll
    for (int T = 0; T < 4; ++T) Sacc[T] = zero4;
    for (int ci = 0; ci < 36; ++ci) {
        const int nc = d == 0 ? ci : (ci < 4 ? 3 - ci : 39 - ci);
        const int base = b * TPB + nc * 64;
#pragma unroll
        for (int k = 0; k < 3; ++k) { const int q = tid + NTHR * k; const int rr = q / 24, pc = q - rr * 24; const int t = d ? 63 - rr : rr;
            LAS bf16_t* dst = (pc < 8 ? QH : (pc < 16 ? KH : VB)) + t * HST + (pc & 7) * 8; *(LAS u32x4*)dst = praw[k]; }
        const float a_in = pa, b_in = pb_;
        if (ci + 1 < 36) { const int c2 = ci + 1; const int nc2 = d == 0 ? c2 : (c2 < 4 ? 3 - c2 : 39 - c2); const int base2 = b * TPB + nc2 * 64;
#pragma unroll
            for (int k = 0; k < 3; ++k) { const int q = tid + NTHR * k; const int rr = q / 24, pc = q - rr * 24; praw[k] = *(const u32x4*)(QKV + ((size_t)(base2 + rr) * 4 + h) * 192 + pc * 8); }
            if (wvs == 0) { const int r = base2 + (d ? 63 - lane : lane); pa = AB[(size_t)r * 16 + d * 4 + h]; pb_ = AB[(size_t)r * 16 + 8 + d * 4 + h]; } }
        if (wvs == 0) { const float xs = a_in + dtb; const float sp = xs > 15.f ? xs : (xs < -15.f ? __expf(xs) : __logf(1.f + __expf(xs))); float x = nA * sp;
#pragma unroll
            for (int o = 1; o < 64; o <<= 1) { const float y = __shfl_up(x, o); if (lane >= o) x += y; }
            GC[lane] = x; EG[lane] = __expf(x); BETA[lane] = 1.f / (1.f + __expf(-b_in)); if (lane == 63) { GL[0] = x; GL[1] = __expf(x); } }
        __syncthreads();
        { const int t = tid >> 3, part = tid & 7; const u32x4 kr = *(const LAS u32x4*)(KH + t * HST + part * 8); const float ekt = __expf(GL[0] - GC[t]);
#pragma unroll
          for (int e = 0; e < 4; ++e) { KTT[(part * 8 + 2 * e) * HST + t] = bf1(bflo(kr[e]) * ekt); KTT[(part * 8 + 2 * e + 1) * HST + t] = bf1(bfhi(kr[e]) * ekt); } }
        { const int I = wvs >> 1;
#pragma unroll
          for (int jj = 0; jj < 2; ++jj) { const int J = 2 * (wvs & 1) + jj; f32x4 ckk = zero4, cqk = zero4;
#pragma unroll
              for (int kk = 0; kk < 2; ++kk) { const bf16x8 Ak = *(const LAS bf16x8*)(KH + (I * 16 + fr) * HST + kk * 32 + fq * 8), Aq = *(const LAS bf16x8*)(QH + (I * 16 + fr) * HST + kk * 32 + fq * 8);
                  const bf16x8 B = *(const LAS bf16x8*)(KH + (J * 16 + fr) * HST + kk * 32 + fq * 8);
                  ckk = __builtin_amdgcn_mfma_f32_16x16x32_bf16(Ak, B, ckk, 0, 0, 0); cqk = __builtin_amdgcn_mfma_f32_16x16x32_bf16(Aq, B, cqk, 0, 0, 0); }
              const int j = J * 16 + fr; const float gj = GC[j];
#pragma unroll
              for (int r = 0; r < 4; ++r) { const int i = I * 16 + fq * 4 + r; const float dec = __expf(fminf(GC[i] - gj, 0.f));
                  const float lv = j < i ? BETA[i] * ckk[r] * dec : 0.f, sv = j <= i ? cqk[r] * dec : 0.f;
                  LM[i * HST + j] = bf1(lv); SCM[i * HST + j] = bf1(sv); if (I == J) LF[(I * 16 + fq * 4 + r) * 17 + fr] = lv; } }
          if ((2 * (wvs & 1) == I) || (2 * (wvs & 1) + 1 == I)) { asm volatile("s_waitcnt lgkmcnt(0)" ::: "memory");
              if (lane < 16) { const int c = lane; float x[16];
#pragma unroll
                  for (int i = 0; i < 16; ++i) { float acc = (i == c) ? 1.f : 0.f;
#pragma unroll
                      for (int j2 = 0; j2 < i; ++j2) acc -= LF[(I * 16 + i) * 17 + j2] * x[j2];
                      x[i] = acc; DI[(I * 16 + i) * 24 + c] = bf1(acc); } } } }
        __syncthreads();
        f32x4 R[4], QS[2];
        { bf16x8 Bs[2];
#pragma unroll
          for (int s2 = 0; s2 < 2; ++s2) Bs[s2] = packB(Sacc[2 * s2], Sacc[2 * s2 + 1]);
#pragma unroll
          for (int I = 0; I < 4; ++I) { f32x4 c = zero4;
#pragma unroll
              for (int s2 = 0; s2 < 2; ++s2) c = __builtin_amdgcn_mfma_f32_16x16x32_bf16(ldA_perm(KH, I * 16 + fr, s2, fq), Bs[s2], c, 0, 0, 0);
#pragma unroll
              for (int r = 0; r < 4; ++r) { const int i = I * 16 + fq * 4 + r; R[I][r] = BETA[i] * (bflo((unsigned)VB[i * HST + V * 16 + fr]) - EG[i] * c[r]); } }
#pragma unroll
          for (int ii = 0; ii < 2; ++ii) { const int I = 2 * half + ii; f32x4 c = zero4;
#pragma unroll
              for (int s2 = 0; s2 < 2; ++s2) c = __builtin_amdgcn_mfma_f32_16x16x32_bf16(ldA_perm(QH, I * 16 + fr, s2, fq), Bs[s2], c, 0, 0, 0);
              QS[ii] = c; } }
        bf16x8 Bx0, Bx1;
        { bf16x8 AD[4];
#pragma unroll
          for (int I = 0; I < 4; ++I) { const u32x2 lo = *(const LAS u32x2*)(DI + (I * 16 + fr) * 24 + fq * 4); u32x4 av; av[0] = lo[0]; av[1] = lo[1]; av[2] = 0u; av[3] = 0u; AD[I] = __builtin_bit_cast(bf16x8, av); }
          const f32x4 X0 = __builtin_amdgcn_mfma_f32_16x16x32_bf16(AD[0], packB(R[0], zero4), zero4, 0, 0, 0);
          f32x4 T1 = __builtin_amdgcn_mfma_f32_16x16x32_bf16(ldA_perm(LM, 16 + fr, 0, fq), packB(X0, zero4), zero4, 0, 0, 0);
          const f32x4 X1 = __builtin_amdgcn_mfma_f32_16x16x32_bf16(AD[1], packB(R[1] - T1, zero4), zero4, 0, 0, 0);
          Bx0 = packB(X0, X1);
          f32x4 T2 = __builtin_amdgcn_mfma_f32_16x16x32_bf16(ldA_perm(LM, 32 + fr, 0, fq), Bx0, zero4, 0, 0, 0);
          const f32x4 X2 = __builtin_amdgcn_mfma_f32_16x16x32_bf16(AD[2], packB(R[2] - T2, zero4), zero4, 0, 0, 0);
          f32x4 T3 = __builtin_amdgcn_mfma_f32_16x16x32_bf16(ldA_perm(LM, 48 + fr, 0, fq), Bx0, zero4, 0, 0, 0);
          T3 = __builtin_amdgcn_mfma_f32_16x16x32_bf16(ldA_perm(LM, 48 + fr, 1, fq), packB(X2, zero4), T3, 0, 0, 0);
          const f32x4 X3 = __builtin_amdgcn_mfma_f32_16x16x32_bf16(AD[3], packB(R[3] - T3, zero4), zero4, 0, 0, 0);
          Bx1 = packB(X2, X3); }
#pragma unroll
        for (int ii = 0; ii < 2; ++ii) { const int I = 2 * half + ii; f32x4 c;
#pragma unroll
            for (int r = 0; r < 4; ++r) c[r] = EG[I * 16 + fq * 4 + r] * QS[ii][r];
            c = __builtin_amdgcn_mfma_f32_16x16x32_bf16(ldA_perm(SCM, I * 16 + fr, 0, fq), Bx0, c, 0, 0, 0);
            c = __builtin_amdgcn_mfma_f32_16x16x32_bf16(ldA_perm(SCM, I * 16 + fr, 1, fq), Bx1, c, 0, 0, 0);
#pragma unroll
            for (int r = 0; r < 4; ++r) OB[(I * 16 + fq * 4 + r) * HST + V * 16 + fr] = bf1(c[r]); }
        { const float egl = GL[1];
#pragma unroll
          for (int T = 0; T < 4; ++T) { f32x4 c = Sacc[T] * egl;
              c = __builtin_amdgcn_mfma_f32_16x16x32_bf16(ldA_perm(KTT, T * 16 + fr, 0, fq), Bx0, c, 0, 0, 0);
              c = __builtin_amdgcn_mfma_f32_16x16x32_bf16(ldA_perm(KTT, T * 16 + fr, 1, fq), Bx1, c, 0, 0, 0);
              Sacc[T] = c; } }
        __syncthreads();
#pragma unroll
        for (int it = 0; it < 4; ++it) { const int idx = tid + NTHR * it; const int i = idx >> 5, c2 = (idx & 31) * 2; const int row = base + (d ? 63 - i : i);
            *(unsigned*)(OD + (size_t)row * 512 + c2) = *(const LAS unsigned*)(OB + i * HST + c2); }
    }
    __syncthreads();
}

__device__ __forceinline__ void hg_seq(const Params& p, int l, int s, LAS unsigned char* lds, const int wvs) {
    const int tid = wvs * 64 + lane_id_fresh(); const int lane = tid & 63;
    const int b = s >> 3, h = (s >> 1) & 3, d = s & 1;
    LAS bf16_t* QT = (LAS bf16_t*)lds; LAS bf16_t* KT = QT + 64 * HST; LAS bf16_t* QP = KT + 64 * HST; LAS bf16_t* KTT = QP + 64 * HST; LAS bf16_t* VT = KTT + 64 * HST; LAS bf16_t* SC = VT + 64 * HST;
    LAS float* GS = (LAS float*)(SC + 64 * HST); LAS float* MID = GS + 512; LAS float* BLS = MID + 64; LAS float* EBL = BLS + 64; LAS bf16_t* OB = (LAS bf16_t*)(EBL + 64);
    const bf16_t* P = (const bf16_t*)(p.ws + WS_P);
    bf16_t* OD = (bf16_t*)(p.ws + WS_OD) + (size_t)d * M * 512 + 256 + h * 64;
    const int kx = tid & 63, g = tid >> 6;
    const float lb = ((const float*)(p.ws + WS_LB))[(d * DEPTH + l) * 256 + h * 64 + kx];
    const int fr = lane & 15, fq = lane >> 4;
    const int V = wvs & 3, half = wvs >> 2;
    f32x4 Sacc[4];
#pragma unroll
    for (int T = 0; T < 4; ++T) Sacc[T] = (f32x4){0.f, 0.f, 0.f, 0.f};
    unsigned short rq[8], rz[8], rv[8];
    { const int nc = d == 0 ? 0 : 3; const int base = b * TPB + nc * 64;
#pragma unroll
      for (int e = 0; e < 8; ++e) { const int t = g * 8 + e; const int pp = d ? 63 - t : t; const bf16_t* rp = P + (size_t)(base + pp) * NP + h * 64 + kx;
          rq[e] = rp[PC_HQ]; rz[e] = rp[PC_HF + d * 256]; rv[e] = rp[PC_HI]; } }
    for (int ci = 0; ci < 36; ++ci) {
        const int nc = d == 0 ? ci : (ci < 4 ? 3 - ci : 39 - ci);
        const int base = b * TPB + nc * 64;
        float qv[8], kv[8], bc[8]; float run = 0.f;
#pragma unroll
        for (int e = 0; e < 8; ++e) { const float z = bflo(rz[e]); const float sg = 1.f / (1.f + __expf(-z)); const float f = lb + (1.f - lb) * sg;
            run += __logf(f); bc[e] = run; kv[e] = (1.f - lb) * (1.f - sg); qv[e] = bflo(rq[e]); }
        GS[g * 64 + kx] = run;
#pragma unroll
        for (int e = 0; e < 8; ++e) VT[kx * HST + g * 8 + e] = rv[e];
        __syncthreads();
        float mid = 0.f, bl = 0.f;
        { float off = 0.f;
#pragma unroll
          for (int gg = 0; gg < 8; ++gg) { const float x = GS[gg * 64 + kx]; off += (gg < g) ? x : 0.f; mid += (gg < 4) ? x : 0.f; bl += x; }
#pragma unroll
          for (int e = 0; e < 8; ++e) bc[e] += off; }
        if (g == 7) EBL[kx] = __expf(bl);
        if (ci + 1 < 36) { const int c2 = ci + 1; const int nc2 = d == 0 ? c2 : (c2 < 4 ? 3 - c2 : 39 - c2); const int base2 = b * TPB + nc2 * 64;
#pragma unroll
            for (int e = 0; e < 8; ++e) { const int t = g * 8 + e; const int pp = d ? 63 - t : t; const bf16_t* rp = P + (size_t)(base2 + pp) * NP + h * 64 + kx;
                rq[e] = rp[PC_HQ]; rz[e] = rp[PC_HF + d * 256]; rv[e] = rp[PC_HI]; } }
        {
#pragma unroll
          for (int e = 0; e < 8; ++e) { const int t = g * 8 + e; const float E = fminf(fmaxf(bc[e] - mid, -80.f), 80.f);
              const float eq = __expf(E), ek = __expf(-E);
              QT[t * HST + kx] = bf1(qv[e] * eq); KT[t * HST + kx] = bf1(kv[e] * ek);
              QP[t * HST + kx] = bf1(qv[e] * __expf(bc[e])); KTT[kx * HST + t] = bf1(kv[e] * __expf(bl - bc[e])); } }
        __syncthreads();
        { const int I = wvs >> 1;
#pragma unroll
          for (int jj = 0; jj < 2; ++jj) { const int J = 2 * (wvs & 1) + jj; f32x4 c = (f32x4){0.f, 0.f, 0.f, 0.f};
#pragma unroll
              for (int kk = 0; kk < 2; ++kk) { const bf16x8 A = *(const LAS bf16x8*)(QT + (I * 16 + fr) * HST + kk * 32 + fq * 8); const bf16x8 B = *(const LAS bf16x8*)(KT + (J * 16 + fr) * HST + kk * 32 + fq * 8);
                  c = __builtin_amdgcn_mfma_f32_16x16x32_bf16(A, B, c, 0, 0, 0); }
#pragma unroll
              for (int r = 0; r < 4; ++r) { const int i = I * 16 + fq * 4 + r, j = J * 16 + fr; SC[i * HST + j] = bf1(j <= i ? c[r] : 0.f); } } }
        __syncthreads();
        { bf16x8 Bs[2];
#pragma unroll
          for (int s2 = 0; s2 < 2; ++s2) { u32x4 pb; pb[0] = bf1(Sacc[2 * s2][0]) | ((unsigned)bf1(Sacc[2 * s2][1]) << 16); pb[1] = bf1(Sacc[2 * s2][2]) | ((unsigned)bf1(Sacc[2 * s2][3]) << 16); pb[2] = bf1(Sacc[2 * s2 + 1][0]) | ((unsigned)bf1(Sacc[2 * s2 + 1][1]) << 16); pb[3] = bf1(Sacc[2 * s2 + 1][2]) | ((unsigned)bf1(Sacc[2 * s2 + 1][3]) << 16); Bs[s2] = __builtin_bit_cast(bf16x8, pb); }
          bf16x8 Bv[2];
#pragma unroll
          for (int s2 = 0; s2 < 2; ++s2) Bv[s2] = *(const LAS bf16x8*)(VT + (V * 16 + fr) * HST + s2 * 32 + fq * 8);
#pragma unroll
          for (int ii = 0; ii < 2; ++ii) { const int I = 2 * half + ii; f32x4 o = (f32x4){0.f, 0.f, 0.f, 0.f};
#pragma unroll
              for (int s2 = 0; s2 < 2; ++s2) { const LAS bf16_t* ap = QP + (I * 16 + fr) * HST + s2 * 32 + fq * 4; const u32x2 lo = *(const LAS u32x2*)ap, hi = *(const LAS u32x2*)(ap + 16);
                  u32x4 av; av[0] = lo[0]; av[1] = lo[1]; av[2] = hi[0]; av[3] = hi[1];
                  o = __builtin_amdgcn_mfma_f32_16x16x32_bf16(__builtin_bit_cast(bf16x8, av), Bs[s2], o, 0, 0, 0); }
#pragma unroll
              for (int s2 = 0; s2 < 2; ++s2) { const bf16x8 A = *(const LAS bf16x8*)(SC + (I * 16 + fr) * HST + s2 * 32 + fq * 8); o = __builtin_amdgcn_mfma_f32_16x16x32_bf16(A, Bv[s2], o, 0, 0, 0); }
#pragma unroll
              for (int r = 0; r < 4; ++r) { const int i = I * 16 + fq * 4 + r; OB[i * HST + V * 16 + fr] = bf1(o[r]); } }
#pragma unroll
          for (int T = 0; T < 4; ++T) { f32x4 c;
#pragma unroll
              for (int r = 0; r < 4; ++r) c[r] = Sacc[T][r] * EBL[T * 16 + fq * 4 + r];
#pragma unroll
              for (int s2 = 0; s2 < 2; ++s2) { const bf16x8 A = *(const LAS bf16x8*)(KTT + (T * 16 + fr) * HST + s2 * 32 + fq * 8); c = __builtin_amdgcn_mfma_f32_16x16x32_bf16(A, Bv[s2], c, 0, 0, 0); }
              Sacc[T] = c; } }
        __syncthreads();
#pragma unroll
        for (int it = 0; it < 4; ++it) { const int idx = tid + NTHR * it; const int i = idx >> 5, c2 = (idx & 31) * 2; const int row = base + (d ? 63 - i : i);
            *(unsigned*)(OD + (size_t)row * 512 + c2) = *(const LAS unsigned*)(OB + i * HST + c2); }
    }
}

constexpr int KST = 72, VST = 136;
__device__ __forceinline__ void swa_unit(const Params& p, int l, int unit, LAS unsigned char* lds, const int wvs) {
    const int tid = wvs * 64 + lane_id_fresh(); const int lane = tid & 63;
    const int b = unit / 36, rem = unit - b * 36, kvh = rem / 18, qb = rem - kvh * 18;
    const bool qctx = qb < 2;
    const bf16_t* P = (const bf16_t*)(p.ws + WS_P);
    const float* rc = (const float*)(p.ws + WS_ROPE); const float* rs = rc + 2048 * 32;
    bf16_t* Y = (bf16_t*)(p.ws + WS_HY);
    LAS bf16_t* Ks = (LAS bf16_t*)lds; LAS bf16_t* Vt = Ks + 128 * KST;
    const int hh = wvs >> 1, qhalf = wvs & 1, head = kvh * 4 + hh;
    const int fr = lane & 15, fq = lane >> 4;
    const int rowq0 = b * TPB + qb * 128 + qhalf * 64;
    const int f0 = (!qctx && qb == 2) ? 1 : 0, nl = qctx ? 0 : 3 - f0 - (qb == 17 ? 1 : 0), nkb = nl + 2;
#define SWA_BLK(j) ((j) < nl ? qb - 1 + f0 + (j) : (j) - nl)
#define SWA_REL(j) ((j) < nl ? f0 + (j) - 1 : 0)
    bf16x8 qf[4][2];
#pragma unroll
    for (int qt = 0; qt < 4; ++qt) {
        const int row = rowq0 + qt * 16 + fr; const bf16_t* qp = P + (size_t)row * NP + PC_SQ + head * 64 + fq * 8;
        const u32x4 r1 = *(const u32x4*)qp, r2 = *(const u32x4*)(qp + 32);
        float a1[8], a2[8];
#pragma unroll
        for (int e = 0; e < 4; ++e) { a1[2 * e] = bflo(r1[e]); a1[2 * e + 1] = bfhi(r1[e]); a2[2 * e] = bflo(r2[e]); a2[2 * e + 1] = bfhi(r2[e]); }
        if (!qctx) { const int t = (qb - 2) * 128 + qhalf * 64 + qt * 16 + fr; const float* cp = rc + t * 32 + fq * 8; const float* sp = rs + t * 32 + fq * 8;
#pragma unroll
            for (int e = 0; e < 8; ++e) { const float cs = cp[e], sn = sp[e]; const float o1 = a1[e] * cs - a2[e] * sn, o2 = a1[e] * sn + a2[e] * cs; a1[e] = o1; a2[e] = o2; } }
        u32x4 o1, o2;
#pragma unroll
        for (int e = 0; e < 4; ++e) { o1[e] = pk2(a1[2 * e] * 0.125f, a1[2 * e + 1] * 0.125f); o2[e] = pk2(a2[2 * e] * 0.125f, a2[2 * e + 1] * 0.125f); }
        qf[qt][0] = __builtin_bit_cast(bf16x8, o1); qf[qt][1] = __builtin_bit_cast(bf16x8, o2);
    }
    const int skey = tid >> 2, sg = tid & 3;
    const float sink = p.swa_sink[l * 8 + head];
    float mrun[4], lrun[4]; f32x4 O[4][4];
#pragma unroll
    for (int qt = 0; qt < 4; ++qt) { mrun[qt] = sink; lrun[qt] = 1.f;
#pragma unroll
        for (int dv = 0; dv < 4; ++dv) O[qt][dv] = (f32x4){0.f, 0.f, 0.f, 0.f}; }
    for (int j = 0; j < nkb; ++j) {
        const int rel = SWA_REL(j);
        u32x4 kreg[2], vreg[2];
        { const int rowk0 = b * TPB + SWA_BLK(j) * 128; const bf16_t* kp = P + (size_t)(rowk0 + skey) * NP + PC_SK + kvh * 64 + sg * 8;
          kreg[0] = *(const u32x4*)kp; kreg[1] = *(const u32x4*)(kp + 32);
#pragma unroll
          for (int it = 0; it < 2; ++it) { const int idx = tid + NTHR * it; vreg[it] = *(const u32x4*)(P + (size_t)(rowk0 + (idx >> 3)) * NP + PC_SV + kvh * 64 + (idx & 7) * 8); } }
        *(LAS u32x4*)(Ks + skey * KST + sg * 8) = kreg[0]; *(LAS u32x4*)(Ks + skey * KST + 32 + sg * 8) = kreg[1];
#pragma unroll
        for (int it = 0; it < 2; ++it) { const int idx = tid + NTHR * it; const int vk = idx >> 3, vg = idx & 7;
#pragma unroll
            for (int e = 0; e < 4; ++e) { Vt[(vg * 8 + 2 * e) * VST + vk] = (bf16_t)(vreg[it][e] & 0xffffu); Vt[(vg * 8 + 2 * e + 1) * VST + vk] = (bf16_t)(vreg[it][e] >> 16); } }
        __syncthreads();
#pragma unroll
        for (int qp2 = 0; qp2 < 2; ++qp2) {
            f32x4 Sx[2][8];
#pragma unroll
            for (int kt = 0; kt < 8; ++kt) { Sx[0][kt] = (f32x4){0.f, 0.f, 0.f, 0.f}; Sx[1][kt] = (f32x4){0.f, 0.f, 0.f, 0.f};
#pragma unroll
                for (int kk = 0; kk < 2; ++kk) { const bf16x8 A = *(const LAS bf16x8*)(Ks + (kt * 16 + fr) * KST + kk * 32 + fq * 8);
                    Sx[0][kt] = __builtin_amdgcn_mfma_f32_16x16x32_bf16(A, qf[2 * qp2][kk], Sx[0][kt], 0, 0, 0);
                    Sx[1][kt] = __builtin_amdgcn_mfma_f32_16x16x32_bf16(A, qf[2 * qp2 + 1][kk], Sx[1][kt], 0, 0, 0); } }
#pragma unroll
            for (int u = 0; u < 2; ++u) { const int qt = 2 * qp2 + u;
                if (rel != 0) { int qi = qhalf * 64 + qt * 16 + fr; asm volatile("" : "+v"(qi));
#pragma unroll
                    for (int kt = 0; kt < 8; ++kt)
#pragma unroll
                        for (int jx = 0; jx < 4; ++jx) { const int kx = kt * 16 + fq * 4 + jx; const bool ok = rel < 0 ? (kx >= qi) : (kx <= qi); if (!ok) Sx[u][kt][jx] = -1e30f; } }
                float mx = -1e30f;
#pragma unroll
                for (int kt = 0; kt < 8; ++kt) mx = fmaxf(mx, fmaxf(fmaxf(Sx[u][kt][0], Sx[u][kt][1]), fmaxf(Sx[u][kt][2], Sx[u][kt][3])));
                mx = xrow16_max(mx);
                const float mnew = fmaxf(mrun[qt], mx); const float alpha = __expf(mrun[qt] - mnew); mrun[qt] = mnew;
                float rsum = 0.f;
#pragma unroll
                for (int kt = 0; kt < 8; ++kt)
#pragma unroll
                    for (int jx = 0; jx < 4; ++jx) { const float e = __expf(Sx[u][kt][jx] - mnew); Sx[u][kt][jx] = e; rsum += e; }
                rsum = xrow16_sum(rsum);
                lrun[qt] = lrun[qt] * alpha + rsum;
#pragma unroll
                for (int dv = 0; dv < 4; ++dv) O[qt][dv] = O[qt][dv] * alpha; }
#pragma unroll
            for (int ks2 = 0; ks2 < 4; ++ks2) {
                bf16x8 Bp[2];
#pragma unroll
                for (int u = 0; u < 2; ++u) { u32x4 pb; pb[0] = pk2(Sx[u][2 * ks2][0], Sx[u][2 * ks2][1]); pb[1] = pk2(Sx[u][2 * ks2][2], Sx[u][2 * ks2][3]); pb[2] = pk2(Sx[u][2 * ks2 + 1][0], Sx[u][2 * ks2 + 1][1]); pb[3] = pk2(Sx[u][2 * ks2 + 1][2], Sx[u][2 * ks2 + 1][3]); Bp[u] = __builtin_bit_cast(bf16x8, pb); }
#pragma unroll
                for (int dv = 0; dv < 4; ++dv) { const LAS bf16_t* vp = Vt + (dv * 16 + fr) * VST + ks2 * 32 + fq * 4;
                    const u32x2 lo = *(const LAS u32x2*)vp, hi = *(const LAS u32x2*)(vp + 16);
                    u32x4 av; av[0] = lo[0]; av[1] = lo[1]; av[2] = hi[0]; av[3] = hi[1]; const bf16x8 Av = __builtin_bit_cast(bf16x8, av);
                    O[2 * qp2][dv] = __builtin_amdgcn_mfma_f32_16x16x32_bf16(Av, Bp[0], O[2 * qp2][dv], 0, 0, 0);
                    O[2 * qp2 + 1][dv] = __builtin_amdgcn_mfma_f32_16x16x32_bf16(Av, Bp[1], O[2 * qp2 + 1][dv], 0, 0, 0); }
            }
        }
        __syncthreads();
    }
#undef SWA_BLK
#undef SWA_REL
#pragma unroll
    for (int qt = 0; qt < 4; ++qt) { const float inv = 1.f / lrun[qt]; const int row = rowq0 + qt * 16 + fr;
#pragma unroll
        for (int dv = 0; dv < 4; ++dv) { u32x2 o2; o2[0] = pk2(O[qt][dv][0] * inv, O[qt][dv][1] * inv); o2[1] = pk2(O[qt][dv][2] * inv, O[qt][dv][3] * inv);
            *(u32x2*)(Y + (size_t)row * D + 256 + head * 64 + dv * 16 + fq * 4) = o2; } }
}

__device__ __forceinline__ void phase_mixers(const Params& p, int l, LAS unsigned char* lds, const int wvs) {
    for (int s = blockIdx.x; s < 256; s += gridDim.x) { if (s < 128) dn_seq(p, l, s, lds, wvs); else hg_seq(p, l, s - 128, lds, wvs); }
    unsigned* ctr = (unsigned*)(p.ws + WS_CTL) + 64 * (1 + l);
    LAS int* su = (LAS int*)(lds + 140 * 1024);
    for (;;) {
        __syncthreads();
        if (wvs == 0 && lane_id_fresh() == 0) su[0] = (int)atomicAdd(ctr, 1u);
        __syncthreads();
        const int unit = su[0];
        if (unit >= 576) break;
        swa_unit(p, l, unit, lds, wvs);
    }
}

__device__ __forceinline__ void phase_finalize(const Params& p, int l, const int wvs) {
    const int tid = wvs * 64 + lane_id_fresh(); const int lane = tid & 63, w = tid >> 6;
    const int gw = blockIdx.x * NWAVES + w, NGW = gridDim.x * NWAVES;
    const bf16_t* P = (const bf16_t*)(p.ws + WS_P);
    const bf16_t* OD0 = (const bf16_t*)(p.ws + WS_OD); const bf16_t* OD1 = OD0 + (size_t)M * 512;
    bf16_t* Y = (bf16_t*)(p.ws + WS_HY);
    const int seg = lane >> 3, d0 = (lane & 7) * 8;
    const int hd = seg & 3; const bool isdn = seg < 4;
    const float* gain = (isdn ? p.dn_norm : p.hg_norm) + l * 64 + d0;
    const f32x4 g0 = *(const f32x4*)gain, g1 = *(const f32x4*)(gain + 4);
    const int ocol = (isdn ? 0 : 256) + hd * 64 + d0, gcol = (isdn ? PC_DNG : PC_HG) + hd * 64 + d0, ycol = (isdn ? 0 : 768) + hd * 64 + d0;
    for (int r = gw; r < M; r += NGW) {
        const u32x4 a = *(const u32x4*)(OD0 + (size_t)r * 512 + ocol), bq = *(const u32x4*)(OD1 + (size_t)r * 512 + ocol), gt = *(const u32x4*)(P + (size_t)r * NP + gcol);
        float o[8]; float ss = 0.f;
#pragma unroll
        for (int e = 0; e < 4; ++e) { o[2 * e] = bflo(a[e]) + bflo(bq[e]); o[2 * e + 1] = bfhi(a[e]) + bfhi(bq[e]); ss += o[2 * e] * o[2 * e] + o[2 * e + 1] * o[2 * e + 1]; }
        ss = sum8(ss);
        const float rms = rsqrtf(ss * (1.f / 64.f) + EPS);
        u32x4 y;
#pragma unroll
        for (int e = 0; e < 4; ++e) { const float ga = bflo(gt[e]), gb = bfhi(gt[e]);
            const float ge0 = e < 2 ? g0[2 * e] : g1[2 * e - 4], ge1 = e < 2 ? g0[2 * e + 1] : g1[2 * e - 3];
            y[e] = pk2(o[2 * e] * rms * ge0 * siluf(ga), o[2 * e + 1] * rms * ge1 * siluf(gb)); }
        *(u32x4*)(Y + (size_t)r * D + ycol) = y;
    }
}

__device__ __forceinline__ void phase_final(const Params& p, const int wvs) {
    const int tid = wvs * 64 + lane_id_fresh(); const int lane = tid & 63, w = tid >> 6;
    const int gw = blockIdx.x * NWAVES + w, NGW = gridDim.x * NWAVES;
    for (int r = gw; r < BATCH * SEQ; r += NGW) {
        f32x4* xr = (f32x4*)(p.out + ((size_t)r << 10)) + lane;
        f32x4 v[4]; float ss = 0.f;
#pragma unroll
        for (int j = 0; j < 4; ++j) { v[j] = xr[64 * j]; ss += (v[j][0] * v[j][0] + v[j][1] * v[j][1]) + (v[j][2] * v[j][2] + v[j][3] * v[j][3]); }
        const float rstd = rsqrtf(wave_sum(ss) * (1.f / D) + EPS);
#pragma unroll
        for (int j = 0; j < 4; ++j) { const f32x4 g = *(const f32x4*)(p.norm_f + 4 * (lane + 64 * j)); xr[64 * j] = v[j] * rstd * g; }
    }
}

#define XB_TMO      128
#define XB_XCNT(j)  (256  + 64 * (j))
#define XB_XSUB(j)  (1280 + 64 * (j))
#define XB_XGEN(j)  (2304 + 64 * (j))
#define XB_TOP      3328
#define XB_TOPGEN   3392
#define XCD_BAR_WORDS 3456
#define XB_SPIN_CAP (1u << 18)

__device__ __forceinline__ unsigned xb_ld(unsigned* p)              { return __hip_atomic_load(p, __ATOMIC_RELAXED, __HIP_MEMORY_SCOPE_AGENT); }
__device__ __forceinline__ unsigned xb_add(unsigned* p, unsigned v) { return __hip_atomic_fetch_add(p, v, __ATOMIC_RELAXED, __HIP_MEMORY_SCOPE_AGENT); }
__device__ __forceinline__ unsigned xb_xcc_id() { return (unsigned)__builtin_amdgcn_s_getreg((3 << 11) | 20) & 0xFu; }
#define XB_SPIN(cond, bar) do { unsigned _sp = 0; while (cond) { __builtin_amdgcn_s_sleep(1); \
    if ((++_sp & 255u) == 0u) { if (xb_ld(&(bar)[XB_TMO])) break; if (_sp > XB_SPIN_CAP) { atomicAdd(&(bar)[XB_TMO], 1u); break; } } } } while (0)

struct XcdBarrier {
    unsigned* bar; unsigned x;
    volatile LAS unsigned* st;
};

__device__ __forceinline__ XcdBarrier xcd_barrier_post(unsigned* bar, volatile LAS unsigned* st) {
    XcdBarrier b; b.bar = bar; b.x = xb_xcc_id(); b.st = st;
    if (threadIdx.x == 0) (void)xb_add(&bar[XB_XCNT(b.x)], 1u);
    return b;
}
__device__ __forceinline__ void xcd_barrier_complete(unsigned* bar, unsigned x, unsigned& nloc, unsigned& nx) {
    const unsigned G = gridDim.x * gridDim.y * gridDim.z;
    unsigned sum, cnt, mine, sp = 0u;
    for (;;) {
        sum = 0u; cnt = 0u; mine = 0u;
#pragma unroll
        for (unsigned j = 0; j < 16; ++j) { const unsigned c = xb_ld(&bar[XB_XCNT(j)]); sum += c; cnt += (c > 0u) ? 1u : 0u; mine = (j == x) ? c : mine; }
        if (sum == G) break;
        __builtin_amdgcn_s_sleep(1);
        if ((++sp & 255u) == 0u) { if (xb_ld(&bar[XB_TMO])) break; if (sp > XB_SPIN_CAP) { atomicAdd(&bar[XB_TMO], 1u); break; } }
    }
    nloc = mine > 0u ? mine : 1u; nx = cnt > 0u ? cnt : 1u;
}

__device__ __forceinline__ void xcd_barrier(const XcdBarrier& b, const int wvs) {
    asm volatile("s_waitcnt vmcnt(0)" ::: "memory");
    __syncthreads();
    if (wvs == 0 && lane_id_fresh() == 0) {
        unsigned* bar = b.bar;
        __builtin_amdgcn_s_waitcnt(0);
        unsigned nloc = b.st[0], nx = b.st[1];
        if (nloc == 0u) { xcd_barrier_complete(bar, b.x, nloc, nx); b.st[0] = nloc; b.st[1] = nx; }
        const unsigned old = xb_add(&bar[XB_XSUB(b.x)], 1u);
        const unsigned gen = old / nloc;
        if (old + 1u == (gen + 1u) * nloc) {
            __builtin_amdgcn_fence(__ATOMIC_RELEASE, "agent");
            asm volatile("s_waitcnt vmcnt(0)" ::: "memory");
            const unsigned og = xb_add(&bar[XB_TOP], 1u);
            const unsigned tg = og / nx;
            if (og + 1u == (tg + 1u) * nx) xb_add(&bar[XB_TOPGEN], 1u);
            else XB_SPIN(xb_ld(&bar[XB_TOPGEN]) == tg, bar);
            __builtin_amdgcn_fence(__ATOMIC_ACQUIRE, "agent");
            xb_add(&bar[XB_XGEN(b.x)], 1u);
            asm volatile("s_waitcnt vmcnt(0)" ::: "memory");
        } else {
            XB_SPIN(xb_ld(&bar[XB_XGEN(b.x)]) == gen, bar);
            __builtin_amdgcn_fence(__ATOMIC_ACQUIRE, "agent");
            asm volatile("s_waitcnt vmcnt(0)" ::: "memory");
        }
    }
    __syncthreads();
}

__device__ __forceinline__ void gsync(cg::grid_group& grid) {
    asm volatile("s_waitcnt vmcnt(0) lgkmcnt(0)" ::: "memory");
    grid.sync();
    __builtin_amdgcn_fence(__ATOMIC_ACQUIRE, "agent");
    asm volatile("s_waitcnt vmcnt(0)" ::: "memory");
}
__global__ void __launch_bounds__(NTHR, 2) fwd_megakernel(Params p) {
    extern __shared__ __attribute__((aligned(16))) unsigned char lds_raw[];
    LAS unsigned char* lds = (LAS unsigned char*)lds_raw;
    cg::grid_group grid = cg::this_grid();
    const int G = gridDim.x, c = blockIdx.x;
    const int wvs = __builtin_amdgcn_readfirstlane((int)(threadIdx.x >> 6));
    { volatile LAS unsigned* st0 = (volatile LAS unsigned*)(lds + 143360 + 64); if (threadIdx.x < 2) st0[threadIdx.x] = 0u; }
    __syncthreads();
    const XcdBarrier xbar = xcd_barrier_post((unsigned*)(p.ws + WS_CTL) + 4096, (volatile LAS unsigned*)(lds + 143360 + 64));
    phase_prologue(p, lds, wvs);
    if (p.ws == nullptr) gsync(grid);
    xcd_barrier(xbar, wvs);
    const float* mods = (const float*)(p.ws + WS_MODS);
    float* Xc = (float*)(p.ws + WS_XC);
    bf16_t* HY = (bf16_t*)(p.ws + WS_HY); bf16_t* PB = (bf16_t*)(p.ws + WS_P);
    for (int l = 0; l < DEPTH; ++l) {
        const int lastl = (l == DEPTH - 1) ? 1 : 0;
        phase_norm<true>(p, l, lds, wvs);
        xcd_barrier(xbar, wvs);
        { pg8::Gemm g{HY, (const bf16_t*)(p.ws + WS_WIN), M, NP, D, D}; pg8::StaticOrder S; S.init(M, NP, G, c); pg8::EpiBf16<0> E{PB, NP};
          pg8::gemm_phase<pg8::EpiBf16<0>, pg8::StaticOrder, true, true>(lds, g, S, E, wvs); }
        xcd_barrier(xbar, wvs);
        phase_dnprep(p, l, lds, wvs);
        xcd_barrier(xbar, wvs);
        phase_mixers(p, l, lds, wvs);
        xcd_barrier(xbar, wvs);
        phase_finalize(p, l, wvs);
        xcd_barrier(xbar, wvs);
        { pg8::Gemm g{HY, (const bf16_t*)(p.ws + WS_WOUT), M, D, D, D}; pg8::Order2 S; S.init(D, G, c, 1); pg8::EpiRes E{p.out, Xc, mods + ((size_t)l * 17 * 6 + 2) * 1024, l == 0 ? p.x : (const float*)p.out, l == 0 ? p.ctx : (const float*)Xc};
          pg8::gemm_phase<pg8::EpiRes, pg8::Order2, true, true>(lds, g, S, E, wvs); }
        if (!lastl) { pg8::Gemm g{HY, (const bf16_t*)(p.ws + WS_WOUT), M, D, D / 4, D}; pg8::CtxSplitOrder S; S.init(G, c); pg8::EpiPart E{(float*)(p.ws + WS_QKV)};
          pg8::gemm_phase<pg8::EpiPart, pg8::CtxSplitOrder, false, true>(lds, g, S, E, wvs); }
        xcd_barrier(xbar, wvs);
        phase_norm<false>(p, l, lds, wvs);
        xcd_barrier(xbar, wvs);
        { pg8::Gemm g{HY, (const bf16_t*)(p.ws + WS_W1), M, DFF, D, D}; pg8::Order2 S; S.init(DFF, G, c, lastl); pg8::EpiBf16<1> E{PB, DFF};
          pg8::gemm_phase<pg8::EpiBf16<1>, pg8::Order2, true, true>(lds, g, S, E, wvs); }
        xcd_barrier(xbar, wvs);
        { pg8::Gemm g{PB, (const bf16_t*)(p.ws + WS_W2), M, D, DFF, DFF}; pg8::Order2 S; S.init(D, G, c, 1); pg8::EpiRes E{p.out, Xc, mods + ((size_t)l * 17 * 6 + 5) * 1024, (const float*)p.out, (const float*)Xc};
          pg8::gemm_phase<pg8::EpiRes, pg8::Order2, true, true>(lds, g, S, E, wvs); }
        if (!lastl) { pg8::Gemm g{PB, (const bf16_t*)(p.ws + WS_W2), M, D, DFF / 4, DFF}; pg8::CtxSplitOrder S; S.init(G, c); pg8::EpiPart E{(float*)(p.ws + WS_QKV)};
          pg8::gemm_phase<pg8::EpiPart, pg8::CtxSplitOrder, false, true>(lds, g, S, E, wvs); }
        xcd_barrier(xbar, wvs);
    }
    phase_final(p, wvs);
}

extern "C" void kernel_launch(void* const* d_in, const int* in_sizes, int n_in, void* d_out, int out_size, void* d_ws, size_t ws_size, hipStream_t stream) {
    static int grid = 0;
    if (grid == 0) {
        if (n_in != 20 || ws_size < WS_END) { fprintf(stderr, "kernel_launch: need 20 inputs and >= %zu bytes of workspace (got %d, %zu)\n", (size_t)WS_END, n_in, ws_size); grid = -1; return; }
        int dev = 0, cus = 0, per_cu = 0;
        hipGetDevice(&dev); hipDeviceGetAttribute(&cus, hipDeviceAttributeMultiprocessorCount, dev);
        if (hipFuncSetAttribute((const void*)fwd_megakernel, hipFuncAttributeMaxDynamicSharedMemorySize, LDS_BYTES) != hipSuccess) { fprintf(stderr, "kernel_launch: hipFuncSetAttribute failed\n"); grid = -1; return; }
        if (hipOccupancyMaxActiveBlocksPerMultiprocessor(&per_cu, (const void*)fwd_megakernel, NTHR, LDS_BYTES) != hipSuccess || per_cu < 1) { fprintf(stderr, "kernel_launch: occupancy query says %d blocks/CU\n", per_cu); per_cu = 1; }
        (void)hipGetLastError();
        grid = cus;
    }
    if (grid < 0) return;
    hipMemsetAsync((char*)d_ws + WS_CTL, 0, 65536, stream);
    Params p{};
    const float** pp = (const float**)&p;
    for (int i = 0; i < 20; ++i) pp[i] = (const float*)d_in[i];
    p.out = (float*)d_out; p.ws = (unsigned char*)d_ws;
    void* args[] = {&p};
    hipError_t e = hipLaunchCooperativeKernel((const void*)fwd_megakernel, dim3(grid), dim3(NTHR), args, LDS_BYTES, stream);
    if (e != hipSuccess) fprintf(stderr, "cooperative launch failed: %s (grid %d)\n", hipGetErrorString(e), grid);
}
```

```cpp
#include <hip/hip_runtime.h>
#include <hip/hip_cooperative_groups.h>
#include <cstdio>
#include <cstdint>
namespace cg = cooperative_groups;

__device__ __forceinline__ int lane_id_fresh() { unsigned m = ~0u; asm volatile("" : "+s"(m)); return (int)__builtin_amdgcn_mbcnt_hi(m, __builtin_amdgcn_mbcnt_lo(m, 0u)); }
namespace pg8 {
#define PG8_LAS __attribute__((address_space(3)))
typedef unsigned short bf16_t;
typedef short bf16x8 __attribute__((ext_vector_type(8)));
typedef float f32x4 __attribute__((ext_vector_type(4)));
typedef unsigned u32x4 __attribute__((ext_vector_type(4)));
constexpr int BM = 256, BK = 64, HALF = 128, HTB = HALF * BK * 2  , STAGE_BYTES = 8 * HTB, NXCD = 8, WGM = 8;

__host__ __device__ __forceinline__ int lds_byte(int r, int c) { const int st = (r >> 4) * 2 + (c >> 5), rr = r & 15, cc = c & 31, ob = rr * 64 + cc * 2; return st * 1024 + (ob ^ (((ob >> 9) & 1) << 5)); }
__host__ __device__ __forceinline__ void stage_rc(int b, int& R, int& C) { const int st = b / 1024, sb = b % 1024, swz = sb ^ (((sb >> 9) & 1) << 5); R = (st >> 1) * 16 + swz / 64; C = (st & 1) * 32 + (swz % 64) / 2; }
__host__ __device__ __forceinline__ int perm32(int rho) { const int n = rho >> 4, i = rho & 15; return 8 * (i >> 2) + 4 * n + (i & 3); }

struct Unit { int pm, pn, ks; };
struct Gemm { const bf16_t* A; const bf16_t* Bt; int M, N, K, ldk; };

struct StaticOrder {
    int nM, nN, nwg, G, c;
    __host__ __device__ void init(int M, int N, int G_, int c_) { nM = M / BM; nN = N / BM; nwg = nM * nN; G = G_; c = c_; }
    __host__ __device__ bool next(int i, Unit& u) const {
        const long L = (long)i * G + c; if (L >= nwg) return false;
        int wgid = (int)L; { const int q = nwg / NXCD, r = nwg % NXCD, xcd = wgid % NXCD, off = wgid / NXCD; wgid = (xcd < r ? xcd * (q + 1) : r * (q + 1) + (xcd - r) * q) + off; }
        const int nig = WGM * nN, gid = wgid / nig, fm = gid * WGM, gsz = (nM - fm) < WGM ? (nM - fm) : WGM;
        u.pm = fm + ((wgid % nig) % gsz); u.pn = (wgid % nig) / gsz; u.ks = 0; return true;
    }
    __device__ __forceinline__ void a_ready(const Unit&) const {}
    __device__ __forceinline__ void done(const Unit&) const {}
};

struct Order2 {
    StaticOrder so; int lat;
    __host__ __device__ void init(int N, int G_, int c_, int lat_) { lat = lat_; so.init(lat_ ? 32768 : 36864, N, G_, c_); }
    __host__ __device__ bool next(int i, Unit& u) const { if (!so.next(i, u)) return false; if (lat) u.pm = (u.pm >> 3) * 9 + 1 + (u.pm & 7); return true; }
    __device__ __forceinline__ void a_ready(const Unit&) const {}
    __device__ __forceinline__ void done(const Unit&) const {}
};
struct CtxSplitOrder {
    int G, c;
    __host__ __device__ void init(int G_, int c_) { G = G_; c = c_; }
    __host__ __device__ bool next(int i, Unit& u) const { const long L = (long)i * G + c; if (L >= 256) return false; u.ks = (int)L & 3; u.pn = ((int)L >> 2) & 3; u.pm = ((int)L >> 4) * 9; return true; }
    __device__ __forceinline__ void a_ready(const Unit&) const {}
    __device__ __forceinline__ void done(const Unit&) const {}
};
__device__ __forceinline__ unsigned cvt_pk_bf16(float lo, float hi) { unsigned r; asm volatile("v_cvt_pk_bf16_f32 %0, %1, %2" : "=v"(r) : "v"(lo), "v"(hi)); return r; }

template <int ACT  > struct EpiBf16 {
    static constexpr bool PERM = true, AFTER_DRAIN = false;
    bf16_t* O; int ldc;
    __device__ __forceinline__ void operator()(const f32x4 (&acc)[2][2][4][2], const Unit& u, int wr, int wc, int fr, int fq) const {
        const int row0 = u.pm * BM + wr * 64 + fr; const int col0 = u.pn * BM + wc * 32 + 8 * fq;
#pragma unroll
        for (int ai = 0; ai < 2; ++ai)
#pragma unroll
            for (int m = 0; m < 4; ++m) { bf16_t* rowp = O + (size_t)(row0 + ai * HALF + m * 16) * ldc + col0;
#pragma unroll
                for (int bj = 0; bj < 2; ++bj) { f32x4 v0 = acc[ai][bj][m][0], v1 = acc[ai][bj][m][1];
                    if (ACT == 1) {
#pragma unroll
                        for (int e = 0; e < 4; ++e) { float a = fmaxf(v0[e], 0.f), b = fmaxf(v1[e], 0.f); v0[e] = a * a; v1[e] = b * b; } }
                    u32x4 w; w.x = cvt_pk_bf16(v0[0], v0[1]); w.y = cvt_pk_bf16(v0[2], v0[3]); w.z = cvt_pk_bf16(v1[0], v1[1]); w.w = cvt_pk_bf16(v1[2], v1[3]);
                    *(u32x4*)(rowp + bj * HALF) = w; } }
    }
};
struct EpiRes {
    static constexpr bool PERM = false, AFTER_DRAIN = false;
    float* Xl; float* Xc; const float* gates;
    const float* Xl_in; const float* Xc_in;
    __device__ __forceinline__ void operator()(const f32x4 (&acc)[2][2][4][2], const Unit& u, int wr, int wc, int fr, int fq) const {
        const int b = u.pm / 9, tt = u.pm - b * 9;
        const size_t toff = (tt == 0) ? ((size_t)(b * 256) << 10) : ((size_t)(b * 2048 + (tt - 1) * 256) << 10);
        float* base = ((tt == 0) ? Xc : Xl) + toff; const float* base_in = ((tt == 0) ? Xc_in : Xl_in) + toff;
        const float* g = gates + (size_t)((tt == 0) ? 16 : b) * 6144;
        const int col0 = u.pn * BM + wc * 32 + 4 * fq;
        float* rp0 = base + ((size_t)(wr * 64 + fr) << 10) + col0; const float* rq0 = base_in + ((size_t)(wr * 64 + fr) << 10) + col0;
#pragma unroll
        for (int bj = 0; bj < 2; ++bj)
#pragma unroll
            for (int n = 0; n < 2; ++n) { const f32x4 gvv = *(const f32x4*)(g + col0 + bj * HALF + n * 16);
#pragma unroll
                for (int ai = 0; ai < 2; ++ai) {
#pragma unroll
                    for (int m = 0; m < 4; ++m) { const size_t eo = (size_t)(ai * HALF + m * 16) * 1024 + bj * HALF + n * 16; f32x4 xv = *(const f32x4*)(rq0 + eo); xv = xv + gvv * acc[ai][bj][m][n]; *(f32x4*)(rp0 + eo) = xv; }
                    asm volatile("" ::: "memory"); } }
    }
};
struct EpiPart {
    static constexpr bool PERM = false, AFTER_DRAIN = false;
    float* part;
    __device__ __forceinline__ void operator()(const f32x4 (&acc)[2][2][4][2], const Unit& u, int wr, int wc, int fr, int fq) const {
        float* rp0 = part + (((size_t)u.ks * 4096 + (size_t)(u.pm / 9) * 256 + wr * 64 + fr) << 10) + u.pn * BM + wc * 32 + 4 * fq;
#pragma unroll
        for (int ai = 0; ai < 2; ++ai)
#pragma unroll
            for (int m = 0; m < 4; ++m)
#pragma unroll
                for (int bj = 0; bj < 2; ++bj)
#pragma unroll
                    for (int n = 0; n < 2; ++n) *(f32x4*)(rp0 + (size_t)(ai * HALF + m * 16) * 1024 + bj * HALF + n * 16) = acc[ai][bj][m][n];
    }
};
template <class Epi, class Sched, bool ALIGN_EPI = false, bool SP2 = false>
__device__ __forceinline__ void gemm_phase(PG8_LAS unsigned char* lds, const Gemm g, const Sched& S, const Epi& E, const int wvs) {
    const int tid = wvs * 64 + lane_id_fresh(); const int wid = __builtin_amdgcn_readfirstlane(tid >> 6), lane = tid & 63, wr = wid >> 2, wc = wid & 3, fr = lane & 15, fq = lane >> 4;
    const int K = g.ldk, nt = g.K / BK; const size_t sstep = (size_t)g.K * 2;
    unsigned voffA[2], voffB[2];
#pragma unroll
    for (int i = 0; i < 2; ++i) { int R, C; stage_rc(tid * 16 + i * 8192, R, C); const int Rb = Epi::PERM ? ((R & ~31) + perm32(R & 31)) : R;
        voffA[i] = (unsigned)(R * K + C) * 2u; voffB[i] = (unsigned)(Rb * K + C) * 2u; }
    const size_t kstep = (size_t)(BK * 2);
    const size_t hstep = (size_t)HALF * K * 2;
    const size_t tstep = 2 * hstep;
    const unsigned ldsw = (unsigned)wid * 1024u;
    const int aoff = lds_byte(wr * 64 + fr, fq * 8), boff = lds_byte(wc * 32 + fr, fq * 8);
#define PG8_SA(b, h) (((b) * 2 + (h)) * HTB)
#define PG8_SB(b, h) ((4 + (b) * 2 + (h)) * HTB)
#define PG8_STAGE(bufoff, gbase, voff) do { _Pragma("unroll") for (int _i = 0; _i < 2; ++_i) \
        __builtin_amdgcn_global_load_lds((const unsigned*)((const char*)(gbase) + (voff)[_i]), (PG8_LAS unsigned*)(lds + (bufoff) + ldsw + _i * 8192), 16, 0, 0); } while (0)
#define PG8_LDA(dst, b, h) do { _Pragma("unroll") for (int m = 0; m < 4; ++m) _Pragma("unroll") for (int k = 0; k < 2; ++k) dst[m][k] = *(const PG8_LAS bf16x8*)(lds + PG8_SA(b, h) + aoff + m * 2048 + k * 1024); } while (0)
#define PG8_LDB(dst, b, h) do { _Pragma("unroll") for (int n = 0; n < 2; ++n) _Pragma("unroll") for (int k = 0; k < 2; ++k) dst[n][k] = *(const PG8_LAS bf16x8*)(lds + PG8_SB(b, h) + boff + n * 2048 + k * 1024); } while (0)
#define PG8_MMA(ai, bj, At, Bt) do { __builtin_amdgcn_s_setprio(1); _Pragma("unroll") for (int m = 0; m < 4; ++m) _Pragma("unroll") for (int n = 0; n < 2; ++n) _Pragma("unroll") for (int k = 0; k < 2; ++k) \
        acc[ai][bj][m][n] = __builtin_amdgcn_mfma_f32_16x16x32_bf16(Bt[n][k], At[m][k], acc[ai][bj][m][n], 0, 0, 0); __builtin_amdgcn_s_setprio(0); } while (0)
#define PG8_WAIT_V(n) asm volatile("s_waitcnt vmcnt(" #n ")" ::: "memory")
#define PG8_WAIT_L(n) asm volatile("s_waitcnt lgkmcnt(" #n ")" ::: "memory")
#define PG8_BAR __builtin_amdgcn_s_barrier()
#define PG8_SCHED __builtin_amdgcn_sched_barrier(0)
    Unit cur, nxt; int ui = 0;
    if (!S.next(0, cur)) return;
    f32x4 acc[2][2][4][2];
#pragma unroll
    for (int a = 0; a < 2; ++a)
#pragma unroll
        for (int b = 0; b < 2; ++b)
#pragma unroll
            for (int m = 0; m < 4; ++m)
#pragma unroll
                for (int n = 0; n < 2; ++n) acc[a][b][m][n] = (f32x4){0.f, 0.f, 0.f, 0.f};
    bf16x8 At[4][2], B0[2][2], B1[2][2];
    const char* cA = (const char*)g.A + (size_t)cur.pm * tstep + (size_t)cur.ks * sstep; const char* cB = (const char*)g.Bt + (size_t)cur.pn * tstep + (size_t)cur.ks * sstep;
    S.a_ready(cur);
    if constexpr (SP2) {
        PG8_STAGE(PG8_SB(0, 0), cB, voffB); PG8_STAGE(PG8_SB(0, 1), cB + hstep, voffB); PG8_STAGE(PG8_SA(0, 0), cA, voffA); PG8_STAGE(PG8_SA(0, 1), cA + hstep, voffA);
        if (wr == 1) PG8_BAR;
        PG8_WAIT_V(2); PG8_BAR;
        PG8_STAGE(PG8_SB(1, 0), cB + kstep, voffB); PG8_STAGE(PG8_SA(1, 0), cA + kstep, voffA); PG8_STAGE(PG8_SB(1, 1), cB + hstep + kstep, voffB);
        PG8_WAIT_V(6); PG8_BAR;
    } else {
        PG8_STAGE(PG8_SB(0, 0), cB, voffB); PG8_STAGE(PG8_SA(0, 0), cA, voffA); PG8_STAGE(PG8_SB(0, 1), cB + hstep, voffB); PG8_STAGE(PG8_SA(0, 1), cA + hstep, voffA);
        if (wr == 1) PG8_BAR;
        PG8_WAIT_V(4); PG8_BAR;
        PG8_STAGE(PG8_SB(1, 0), cB + kstep, voffB); PG8_STAGE(PG8_SA(1, 0), cA + kstep, voffA); PG8_STAGE(PG8_SB(1, 1), cB + hstep + kstep, voffB);
        PG8_WAIT_V(6); PG8_BAR;
    }
    for (;;) {
        const bool has_next = S.next(ui + 1, nxt);
        const char* nA = has_next ? (const char*)g.A + (size_t)nxt.pm * tstep + (size_t)nxt.ks * sstep : cA; const char* nB = has_next ? (const char*)g.Bt + (size_t)nxt.pn * tstep + (size_t)nxt.ks * sstep : cB;
        for (int t = 0; t < nt; t += 2) {
            const bool last = (t == nt - 2);
            const char* a1 = cA + (size_t)(t + 1) * kstep;
            const char* a2 = last ? nA : cA + (size_t)(t + 2) * kstep; const char* b2 = last ? nB : cB + (size_t)(t + 2) * kstep;
            const char* a3 = a2 + kstep; const char* b3 = b2 + kstep;
            if (last && has_next) S.a_ready(nxt);
            if constexpr (SP2) {
            PG8_LDB(B0, 0, 0); PG8_LDB(B1, 0, 1); PG8_SCHED; PG8_LDA(At, 0, 0); PG8_STAGE(PG8_SA(1, 1), a1 + hstep, voffA);
            PG8_WAIT_V(8); PG8_WAIT_L(0); PG8_BAR; PG8_MMA(0, 0, At, B0); PG8_MMA(0, 1, At, B1); PG8_BAR; PG8_SCHED;
            PG8_LDA(At, 0, 1); PG8_STAGE(PG8_SB(0, 0), b2, voffB); PG8_STAGE(PG8_SB(0, 1), b2 + hstep, voffB); PG8_STAGE(PG8_SA(0, 0), a2, voffA);
            PG8_WAIT_V(8); PG8_WAIT_L(0); PG8_BAR; PG8_MMA(1, 0, At, B0); PG8_MMA(1, 1, At, B1); PG8_BAR; PG8_SCHED;
            PG8_LDB(B0, 1, 0); PG8_LDB(B1, 1, 1); PG8_SCHED; PG8_LDA(At, 1, 0); PG8_STAGE(PG8_SA(0, 1), a2 + hstep, voffA);
            PG8_WAIT_V(8); PG8_WAIT_L(0); PG8_BAR; PG8_MMA(0, 0, At, B0); PG8_MMA(0, 1, At, B1); PG8_BAR; PG8_SCHED;
            PG8_LDA(At, 1, 1); PG8_STAGE(PG8_SB(1, 0), b3, voffB); PG8_STAGE(PG8_SB(1, 1), b3 + hstep, voffB); PG8_STAGE(PG8_SA(1, 0), a3, voffA);
            PG8_WAIT_V(8); PG8_WAIT_L(0); PG8_BAR; PG8_MMA(1, 0, At, B0); PG8_MMA(1, 1, At, B1); PG8_BAR; PG8_SCHED;
            } else {
            PG8_LDB(B0, 0, 0); PG8_SCHED; PG8_LDA(At, 0, 0); PG8_STAGE(PG8_SA(1, 1), a1 + hstep, voffA);
            PG8_WAIT_L(8); PG8_BAR; PG8_WAIT_L(0); PG8_MMA(0, 0, At, B0); PG8_BAR; PG8_SCHED;
            PG8_LDB(B1, 0, 1); PG8_STAGE(PG8_SB(0, 0), b2, voffB);
            PG8_BAR; PG8_WAIT_L(0); PG8_MMA(0, 1, At, B1); PG8_BAR;
            PG8_LDA(At, 0, 1); PG8_STAGE(PG8_SA(0, 0), a2, voffA);
            PG8_BAR; PG8_WAIT_L(0); PG8_MMA(1, 0, At, B0); PG8_BAR; PG8_SCHED;
            PG8_STAGE(PG8_SB(0, 1), b2 + hstep, voffB);
            PG8_WAIT_V(6); PG8_BAR; PG8_MMA(1, 1, At, B1); PG8_BAR;
            PG8_LDB(B0, 1, 0); PG8_SCHED; PG8_LDA(At, 1, 0); PG8_STAGE(PG8_SA(0, 1), a2 + hstep, voffA);
            PG8_WAIT_L(8); PG8_BAR; PG8_WAIT_L(0); PG8_MMA(0, 0, At, B0); PG8_BAR; PG8_SCHED;
            PG8_LDB(B1, 1, 1); PG8_STAGE(PG8_SB(1, 0), b3, voffB);
            PG8_BAR; PG8_WAIT_L(0); PG8_MMA(0, 1, At, B1); PG8_BAR;
            PG8_LDA(At, 1, 1); PG8_STAGE(PG8_SA(1, 0), a3, voffA);
            PG8_BAR; PG8_WAIT_L(0); PG8_MMA(1, 0, At, B0); PG8_BAR; PG8_SCHED;
            PG8_STAGE(PG8_SB(1, 1), b3 + hstep, voffB);
            PG8_WAIT_V(6); PG8_BAR; PG8_MMA(1, 1, At, B1); PG8_BAR;
            }
        }
        if constexpr (ALIGN_EPI) { if (wr == 0) PG8_BAR; }
        if constexpr (!Epi::AFTER_DRAIN) { E(acc, cur, wr, wc, fr, fq); S.done(cur); }
        if (!has_next) break;
#pragma unroll
        for (int a = 0; a < 2; ++a)
#pragma unroll
            for (int b = 0; b < 2; ++b)
#pragma unroll
                for (int m = 0; m < 4; ++m)
#pragma unroll
                    for (int n = 0; n < 2; ++n) acc[a][b][m][n] = (f32x4){0.f, 0.f, 0.f, 0.f};
        cur = nxt; cA = nA; cB = nB; ++ui;
        if constexpr (ALIGN_EPI) { if (wr == 1) PG8_BAR; }
    }
    PG8_WAIT_V(0);
    if constexpr (!ALIGN_EPI) { if (wr == 0) PG8_BAR; }
    PG8_BAR;
    if constexpr (Epi::AFTER_DRAIN) { E.fused(acc, cur, wr, wc, fr, fq, lds, wid, lane); S.done(cur); }
#undef PG8_SA
#undef PG8_SB
#undef PG8_STAGE
#undef PG8_LDA
#undef PG8_LDB
#undef PG8_MMA
#undef PG8_WAIT_V
#undef PG8_WAIT_L
#undef PG8_BAR
#undef PG8_SCHED
}
}

constexpr int D = 1024, BATCH = 16, SEQ = 2048, CTX = 256, DEPTH = 4;
constexpr int TPB = CTX + SEQ;
constexpr int M = BATCH * TPB;
constexpr int DIN = 3088, NP = 3072, DFF = 4096;
constexpr int PC_DNQ = 0, PC_DNG = 768, PC_SQ = 1024, PC_SK = 1536, PC_SV = 1664, PC_HQ = 1792, PC_HF = 2048, PC_HI = 2560, PC_HG = 2816;
constexpr float EPS = 1e-6f;
constexpr size_t MiB = 1u << 20;
constexpr size_t WS_CTL = 0, WS_MODS = 1 * MiB, WS_ROPE = 3 * MiB, WS_LB = 3 * MiB + 512 * 1024, WS_AB = 4 * MiB;
constexpr size_t WS_WIN = 7 * MiB, WS_WOUT = 13 * MiB, WS_W1 = 15 * MiB, WS_W2 = 23 * MiB, WS_XC = 32 * MiB, WS_HY = 48 * MiB, WS_P = 120 * MiB;
constexpr size_t WS_OD = WS_P + 216 * MiB, WS_QKV = WS_P + 288 * MiB, WS_END = WS_QKV + 64 * MiB;
constexpr int LDS_BYTES = 147456;
constexpr int NWAVES = 8, NTHR = 512;

#define LAS __attribute__((address_space(3)))
typedef unsigned short bf16_t;
typedef float f32x4 __attribute__((ext_vector_type(4)));
typedef short bf16x8 __attribute__((ext_vector_type(8)));
typedef short s16x4 __attribute__((ext_vector_type(4)));
typedef unsigned u32x4 __attribute__((ext_vector_type(4)));
typedef unsigned u32x2 __attribute__((ext_vector_type(2)));

struct Params {
    const float *x, *c, *ctx, *c_ctx, *w_ada, *b_ada, *norm1, *norm2, *w_in, *dn_conv, *dn_A_log, *dn_dt_bias, *dn_norm, *swa_sink, *hg_lb, *hg_norm, *w_out, *w_ff1, *w_ff2, *norm_f;
    float* out; unsigned char* ws;
};

__device__ __forceinline__ float bflo(unsigned u) { return __uint_as_float(u << 16); }
__device__ __forceinline__ float bfhi(unsigned u) { return __uint_as_float(u & 0xffff0000u); }
__device__ __forceinline__ unsigned pk2(float lo, float hi) { return pg8::cvt_pk_bf16(lo, hi); }
__device__ __forceinline__ bf16_t bf1(float f) { unsigned u = __float_as_uint(f); u += 0x7fffu + ((u >> 16) & 1u); return (bf16_t)(u >> 16); }
__device__ __forceinline__ float siluf(float v) { return v / (1.f + __expf(-v)); }
__device__ __forceinline__ float sigmf(float v) { return 1.f / (1.f + __expf(-v)); }
__device__ __forceinline__ float wave_sum(float v) {
#pragma unroll
    for (int o = 1; o < 64; o <<= 1) v += __shfl_xor(v, o);
    return v;
}
template <int CTRL> __device__ __forceinline__ float dpp(float x) { return __builtin_bit_cast(float, __builtin_amdgcn_mov_dpp(__builtin_bit_cast(int, x), CTRL, 0xf, 0xf, true)); }
constexpr int XOR1 = 0xB1, XOR2 = 0x4E, XOR7 = 0x141;
__device__ __forceinline__ float sum8(float v) { v += dpp<XOR1>(v); v += dpp<XOR2>(v); v += dpp<XOR7>(v); return v; }
__device__ __forceinline__ float xrow16_max(float x) {
    auto s = __builtin_amdgcn_permlane16_swap(__float_as_uint(x), __float_as_uint(x), false, false);
    x = fmaxf(__uint_as_float(s[0]), __uint_as_float(s[1]));
    auto t = __builtin_amdgcn_permlane32_swap(__float_as_uint(x), __float_as_uint(x), false, false);
    return fmaxf(__uint_as_float(t[0]), __uint_as_float(t[1]));
}
__device__ __forceinline__ float xrow16_sum(float x) {
    auto s = __builtin_amdgcn_permlane16_swap(__float_as_uint(x), __float_as_uint(x), false, false);
    x = __uint_as_float(s[0]) + __uint_as_float(s[1]);
    auto t = __builtin_amdgcn_permlane32_swap(__float_as_uint(x), __float_as_uint(x), false, false);
    return __uint_as_float(t[0]) + __uint_as_float(t[1]);
}
__device__ __forceinline__ const float* xrow_c(const float* Xl, const float* Xc, int r) { const int b = r / TPB, t = r - b * TPB; return t < CTX ? Xc + ((size_t)(b * CTX + t) << 10) : Xl + ((size_t)(b * SEQ + t - CTX) << 10); }
__device__ __forceinline__ int cidx(int r) { const int b = r / TPB, t = r - b * TPB; return t < CTX ? 16 : b; }

__device__ __forceinline__ void phase_prologue(const Params& p, LAS unsigned char* lds, const int wvs) {
    const int tid = wvs * 64 + lane_id_fresh(); const int lane = tid & 63, w = tid >> 6;
    float* mods = (float*)(p.ws + WS_MODS);
    LAS float* sc = (LAS float*)lds;
    LAS float* red = (LAS float*)(lds + 81920);
    for (int idx = tid; idx < 17 * 1024; idx += NTHR) { const int ci = idx >> 10, k = idx & 1023; const float v = ci < 16 ? p.c[ci * 1024 + k] : p.c_ctx[k]; sc[k * 20 + ci] = v / (1.f + expf(-v)); }
    __syncthreads();
    for (int it = blockIdx.x; it < DEPTH * 96; it += gridDim.x) {
        const int l = it / 96, cgp = it - l * 96, col = cgp * 64 + lane;
        float acc[17];
#pragma unroll
        for (int i = 0; i < 17; ++i) acc[i] = 0.f;
        const float* wp = p.w_ada + ((size_t)l * 1024 + w * 128) * 6144 + col;
#pragma unroll 16
        for (int kk = 0; kk < 128; ++kk) {
            const float wv = wp[(size_t)kk * 6144];
            const LAS f32x4* s4 = (const LAS f32x4*)(sc + (w * 128 + kk) * 20);
            const f32x4 s0 = s4[0], s1 = s4[1], s2 = s4[2], s3 = s4[3]; const float s16 = sc[(w * 128 + kk) * 20 + 16];
#pragma unroll
            for (int e = 0; e < 4; ++e) { acc[e] += wv * s0[e]; acc[4 + e] += wv * s1[e]; acc[8 + e] += wv * s2[e]; acc[12 + e] += wv * s3[e]; }
            acc[16] += wv * s16;
        }
#pragma unroll
        for (int i = 0; i < 17; ++i) red[(w * 17 + i) * 64 + lane] = acc[i];
        __syncthreads();
        for (int idx = tid; idx < 17 * 64; idx += NTHR) { const int i = idx >> 6, cl = idx & 63; float s = 0.f;
#pragma unroll
            for (int ww = 0; ww < 8; ++ww) s += red[(ww * 17 + i) * 64 + cl];
            mods[((size_t)l * 17 + i) * 6144 + cgp * 64 + cl] = s + p.b_ada[l * 6144 + cgp * 64 + cl]; }
        __syncthreads();
    }
    const int gt = blockIdx.x * NTHR + tid, GT = gridDim.x * NTHR;
    { float* rc = (float*)(p.ws + WS_ROPE); float* rs = rc + 2048 * 32;
      for (int idx = gt; idx < 2048 * 32; idx += GT) { const int t = idx >> 5, d = idx & 31; const float pos = (float)(d < 16 ? (t >> 6) : (t & 63));
          const float inv = expf(-(float)(d & 15) * (9.210340371976184f / 16.f)); const float ang = pos * inv; rc[idx] = cosf(ang); rs[idx] = sinf(ang); } }
    { float* LB = (float*)(p.ws + WS_LB);
      for (int idx = gt; idx < 2 * 256; idx += GT) { const int d = idx >> 8, cc = idx & 255; float v[DEPTH]; float mx = -1e30f;
#pragma unroll
          for (int l = 0; l < DEPTH; ++l) { v[l] = p.hg_lb[(d * DEPTH + l) * 256 + cc]; mx = fmaxf(mx, v[l]); }
          float s = 0.f;
#pragma unroll
          for (int l = 0; l < DEPTH; ++l) { v[l] = expf(v[l] - mx); s += v[l]; }
          float cum = 0.f;
#pragma unroll
          for (int l = 0; l < DEPTH; ++l) { if (l > 0) cum += v[l] / s; LB[(d * DEPTH + l) * 256 + cc] = cum; } } }
}

__device__ __forceinline__ void transpose_item(const float* W, int K, int ldw, int scol0, bf16_t* WT, int n0, int k0, LAS float* scr, int lane) {
#pragma unroll 8
    for (int i = 0; i < 32; ++i) { const int kk = 2 * i + (lane >> 5); scr[kk * 33 + (lane & 31)] = W[(size_t)(k0 + kk) * ldw + scol0 + (lane & 31)]; }
    asm volatile("s_waitcnt lgkmcnt(0)" ::: "memory");
    const int c = lane & 7;
#pragma unroll
    for (int j = 0; j < 4; ++j) { const int n = (lane >> 3) + 8 * j; const LAS float* s = scr + (8 * c) * 33 + n;
        u32x4 o; o.x = pk2(s[0 * 33], s[1 * 33]); o.y = pk2(s[2 * 33], s[3 * 33]); o.z = pk2(s[4 * 33], s[5 * 33]); o.w = pk2(s[6 * 33], s[7 * 33]);
        *(u32x4*)(WT + (size_t)(n0 + n) * K + k0 + 8 * c) = o; }
    asm volatile("s_waitcnt lgkmcnt(0)" ::: "memory");
}

template <bool FIRST> __device__ __forceinline__ void phase_norm(const Params& p, int l, LAS unsigned char* lds, const int wvs) {
    const int tid = wvs * 64 + lane_id_fresh(); const int lane = tid & 63, w = tid >> 6;
    const int gw = blockIdx.x * NWAVES + w, NGW = gridDim.x * NWAVES;
    const float* mods = (const float*)(p.ws + WS_MODS);
    constexpr int WST = 1032;
    LAS bf16_t* wab = (LAS bf16_t*)lds;
    if (FIRST) {
        LAS float* scr = (LAS float*)(lds + 65536 + w * 8704);
        constexpr int I_IN = 16 * 96, I_OUT = 16 * 32, I_1 = 16 * 128, I_2 = 64 * 32;
        for (int it = gw; it < I_IN + I_OUT + I_1 + I_2; it += NGW) {
            int r = it;
            if (r < I_IN) { const int kb = r / 96, nb = r - kb * 96; const int n0 = nb * 32; transpose_item(p.w_in + (size_t)l * D * DIN, D, DIN, n0 + (n0 >= 1024 ? 16 : 0), (bf16_t*)(p.ws + WS_WIN), n0, kb * 64, scr, lane); continue; }
            r -= I_IN;
            if (r < I_OUT) { const int kb = r / 32, nb = r - kb * 32; transpose_item(p.w_out + (size_t)l * D * D, D, D, nb * 32, (bf16_t*)(p.ws + WS_WOUT), nb * 32, kb * 64, scr, lane); continue; }
            r -= I_OUT;
            if (r < I_1) { const int kb = r / 128, nb = r - kb * 128; transpose_item(p.w_ff1 + (size_t)l * D * DFF, D, DFF, nb * 32, (bf16_t*)(p.ws + WS_W1), nb * 32, kb * 64, scr, lane); continue; }
            r -= I_1;
            { const int kb = r / 32, nb = r - kb * 32; transpose_item(p.w_ff2 + (size_t)l * DFF * D, DFF, D, nb * 32, (bf16_t*)(p.ws + WS_W2), nb * 32, kb * 64, scr, lane); }
        }
        const float* wi = p.w_in + (size_t)l * D * DIN + 1024;
        for (int idx = tid; idx < 4096; idx += NTHR) { const int k = idx >> 2, j4 = (idx & 3) * 4; const f32x4 v = *(const f32x4*)(wi + (size_t)k * DIN + j4);
#pragma unroll
            for (int e = 0; e < 4; ++e) wab[(j4 + e) * WST + k] = bf1(v[e]); }
        __syncthreads();
    }
    const float* nw = (FIRST ? p.norm1 : p.norm2) + l * D;
    bf16_t* H = (bf16_t*)(p.ws + WS_HY);
    float* AB = (float*)(p.ws + WS_AB);
    float* Xc = (float*)(p.ws + WS_XC);
    const float* part = (const float*)(p.ws + WS_QKV);
    const bool fix = FIRST ? (l > 0) : (l < DEPTH - 1);
    const float* fgate = mods + ((size_t)(FIRST ? (l > 0 ? l - 1 : 0) : l) * 17 + 16) * 6144 + (FIRST ? 5 : 2) * 1024;
    int nrows = 0;
    for (int r = gw; r < M; r += NGW) {
        ++nrows;
        if (!FIRST && l == DEPTH - 1 && (r % TPB) < CTX) continue;
        const f32x4* xr = (const f32x4*)((FIRST && l == 0) ? xrow_c(p.x, p.ctx, r) : xrow_c(p.out, Xc, r)) + lane;
        f32x4 v[4]; float ss = 0.f;
        const int rb = r / TPB, rt = r - rb * TPB;
        if (fix && rt < CTX) {
            const f32x4* xin = (const f32x4*)((!FIRST && l == 0) ? p.ctx + ((size_t)(rb * CTX + rt) << 10) : Xc + ((size_t)(rb * CTX + rt) << 10)) + lane;
            const f32x4* pr = (const f32x4*)(part + ((size_t)(rb * CTX + rt) << 10)) + lane; f32x4* xo = (f32x4*)(Xc + ((size_t)(rb * CTX + rt) << 10)) + lane;
#pragma unroll
            for (int j = 0; j < 4; ++j) { const f32x4 gq = *(const f32x4*)(fgate + 4 * (lane + 64 * j));
                const f32x4 s4 = (pr[64 * j] + pr[64 * j + 1048576]) + (pr[64 * j + 2 * 1048576] + pr[64 * j + 3 * 1048576]);
                v[j] = xin[64 * j] + gq * s4; xo[64 * j] = v[j]; }
        } else {
#pragma unroll
            for (int j = 0; j < 4; ++j) v[j] = xr[64 * j];
        }
#pragma unroll
        for (int j = 0; j < 4; ++j) ss += (v[j][0] * v[j][0] + v[j][1] * v[j][1]) + (v[j][2] * v[j][2] + v[j][3] * v[j][3]);
        const float rstd = rsqrtf(wave_sum(ss) * (1.f / D) + EPS);
        const float* md = mods + ((size_t)l * 17 + cidx(r)) * 6144 + (FIRST ? 0 : 3 * 1024);
        u32x2* hp = (u32x2*)(H + (size_t)r * D) + lane;
#pragma unroll
        for (int j = 0; j < 4; ++j) { const int k = 4 * (lane + 64 * j);
            const f32x4 g = *(const f32x4*)(nw + k), sh = *(const f32x4*)(md + k), sl = *(const f32x4*)(md + 1024 + k);
            f32x4 h;
#pragma unroll
            for (int e = 0; e < 4; ++e) h[e] = (v[j][e] * rstd * g[e]) * (1.f + sl[e]) + sh[e];
            u32x2 o2; o2.x = pk2(h[0], h[1]); o2.y = pk2(h[2], h[3]); hp[64 * j] = o2;
        }
    }
    if (FIRST) {
        asm volatile("s_waitcnt vmcnt(0)" ::: "memory");
        const int fr = lane & 15, fq = lane >> 4;
        for (int b0 = 0; b0 < nrows; b0 += 16) {
            const int kr = b0 + fr; const bool ok = kr < nrows; const bf16_t* hp = H + (size_t)(gw + (ok ? kr : 0) * NGW) * D + fq * 8;
            f32x4 c = (f32x4){0.f, 0.f, 0.f, 0.f};
#pragma unroll 8
            for (int ks = 0; ks < 32; ++ks) { u32x4 av = *(const u32x4*)(hp + ks * 32); if (!ok) av = (u32x4){0u, 0u, 0u, 0u};
                const bf16x8 bv = *(const LAS bf16x8*)(wab + fr * WST + ks * 32 + fq * 8);
                c = __builtin_amdgcn_mfma_f32_16x16x32_bf16(__builtin_bit_cast(bf16x8, av), bv, c, 0, 0, 0); }
#pragma unroll
            for (int j = 0; j < 4; ++j) { const int k2 = b0 + fq * 4 + j; if (k2 < nrows) AB[(size_t)(gw + k2 * NGW) * 16 + fr] = c[j]; }
        }
    }
}

constexpr int SST = 68;
constexpr int HST = 72;
__device__ __forceinline__ bf16x8 ldA_perm(const LAS bf16_t* base, int row, int s, int fq) {
    const LAS bf16_t* ap = base + row * HST + s * 32 + fq * 4; const u32x2 lo = *(const LAS u32x2*)ap, hi = *(const LAS u32x2*)(ap + 16);
    u32x4 av; av[0] = lo[0]; av[1] = lo[1]; av[2] = hi[0]; av[3] = hi[1]; return __builtin_bit_cast(bf16x8, av);
}
__device__ __forceinline__ bf16x8 packB(const f32x4& a, const f32x4& b) {
    u32x4 pb; pb[0] = bf1(a[0]) | ((unsigned)bf1(a[1]) << 16); pb[1] = bf1(a[2]) | ((unsigned)bf1(a[3]) << 16); pb[2] = bf1(b[0]) | ((unsigned)bf1(b[1]) << 16); pb[3] = bf1(b[2]) | ((unsigned)bf1(b[3]) << 16);
    return __builtin_bit_cast(bf16x8, pb);
}
__device__ __forceinline__ void phase_dnprep(const Params& p, int l, LAS unsigned char* lds, const int wvs) {
    const int tid = wvs * 64 + lane_id_fresh();
    constexpr int RST = 200;
    LAS float* qs = (LAS float*)lds; LAS float* ks = qs + 64 * SST; LAS float* vs = ks + 64 * SST; LAS bf16_t* RAW = (LAS bf16_t*)(vs + 64 * SST);
    const bf16_t* P = (const bf16_t*)(p.ws + WS_P);
    bf16_t* QKV = (bf16_t*)(p.ws + WS_QKV);
    const float* cw = p.dn_conv + (size_t)l * 5 * 768;
    const int c4 = tid % 48, tg = tid / 48;
    LAS float* cdst = ((c4 >> 4) == 0 ? qs : ((c4 >> 4) == 1 ? ks : vs)) + (c4 & 15) * 4;
    for (int it = blockIdx.x; it < BATCH * 36 * 4; it += gridDim.x) {
        const int h = it & 3, bc = it >> 2, b = bc / 36, nc = bc - b * 36;
        const int base = b * TPB + nc * 64, lo = b * TPB + (nc < 4 ? 0 : CTX), hi = b * TPB + (nc < 4 ? CTX : TPB);
        float wc[5][4];
        { const int ch = c4 * 4, pcol = (ch >> 6) * 256 + h * 64 + (ch & 63);
#pragma unroll
          for (int t = 0; t < 5; ++t) { const f32x4 w4 = *(const f32x4*)(cw + t * 768 + pcol); wc[t][0] = w4[0]; wc[t][1] = w4[1]; wc[t][2] = w4[2]; wc[t][3] = w4[3]; } }
#pragma unroll
        for (int k = 0; k < 4; ++k) { const int q = tid + NTHR * k; if (q < 68 * 24) { const int rr = q / 24, pc = q - rr * 24; const int r = base - 2 + rr;
            const u32x4 v = (r >= lo && r < hi) ? *(const u32x4*)(P + (size_t)r * NP + (pc >> 3) * 256 + h * 64 + (pc & 7) * 8) : (u32x4){0u, 0u, 0u, 0u};
            *(LAS u32x4*)(RAW + rr * RST + pc * 8) = v; } }
        __syncthreads();
        if (tid < 480) {
#pragma unroll
            for (int m = 0; m < 7; ++m) { const int pp = tg + 10 * m; if (pp < 64) { float a0 = 0.f, a1 = 0.f, a2 = 0.f, a3 = 0.f;
#pragma unroll
                for (int t = 0; t < 5; ++t) { const u32x2 raw = *(const LAS u32x2*)(RAW + (pp + t) * RST + c4 * 4);
                    a0 += bflo(raw[0]) * wc[t][0]; a1 += bfhi(raw[0]) * wc[t][1]; a2 += bflo(raw[1]) * wc[t][2]; a3 += bfhi(raw[1]) * wc[t][3]; }
                f32x4 o; o[0] = a0 / (1.f + __expf(-a0)); o[1] = a1 / (1.f + __expf(-a1)); o[2] = a2 / (1.f + __expf(-a2)); o[3] = a3 / (1.f + __expf(-a3));
                *(LAS f32x4*)(cdst + pp * SST) = o; } } }
        __syncthreads();
        { const int t = tid >> 3, part = tid & 7;
          const f32x4 q0 = *(const LAS f32x4*)(qs + t * SST + part * 8), q1 = *(const LAS f32x4*)(qs + t * SST + part * 8 + 4);
          const f32x4 k0 = *(const LAS f32x4*)(ks + t * SST + part * 8), k1 = *(const LAS f32x4*)(ks + t * SST + part * 8 + 4);
          const f32x4 v0 = *(const LAS f32x4*)(vs + t * SST + part * 8), v1 = *(const LAS f32x4*)(vs + t * SST + part * 8 + 4);
          float sq = (q0[0] * q0[0] + q0[1] * q0[1]) + (q0[2] * q0[2] + q0[3] * q0[3]) + (q1[0] * q1[0] + q1[1] * q1[1]) + (q1[2] * q1[2] + q1[3] * q1[3]);
          float sk = (k0[0] * k0[0] + k0[1] * k0[1]) + (k0[2] * k0[2] + k0[3] * k0[3]) + (k1[0] * k1[0] + k1[1] * k1[1]) + (k1[2] * k1[2] + k1[3] * k1[3]);
          sq = sum8(sq); sk = sum8(sk);
          const float rq = rsqrtf(sq + EPS) * 0.125f, rk = rsqrtf(sk + EPS);
          u32x4 qo, ko, vo;
          qo[0] = pk2(q0[0] * rq, q0[1] * rq); qo[1] = pk2(q0[2] * rq, q0[3] * rq); qo[2] = pk2(q1[0] * rq, q1[1] * rq); qo[3] = pk2(q1[2] * rq, q1[3] * rq);
          ko[0] = pk2(k0[0] * rk, k0[1] * rk); ko[1] = pk2(k0[2] * rk, k0[3] * rk); ko[2] = pk2(k1[0] * rk, k1[1] * rk); ko[3] = pk2(k1[2] * rk, k1[3] * rk);
          vo[0] = pk2(v0[0], v0[1]); vo[1] = pk2(v0[2], v0[3]); vo[2] = pk2(v1[0], v1[1]); vo[3] = pk2(v1[2], v1[3]);
          bf16_t* dst = QKV + ((size_t)(base + t) * 4 + h) * 192 + part * 8;
          *(u32x4*)dst = qo; *(u32x4*)(dst + 64) = ko; *(u32x4*)(dst + 128) = vo; }
        __syncthreads();
    }
    { bf16_t* Pw = (bf16_t*)(p.ws + WS_P); const float* rc = (const float*)(p.ws + WS_ROPE); const float* rs = rc + 2048 * 32;
      const int gt = blockIdx.x * NTHR + tid, GT = gridDim.x * NTHR;
      for (int idx = gt; idx < BATCH * SEQ * 8; idx += GT) { const int rl = idx >> 3, rem = idx & 7, kh = rem >> 2, g = rem & 3;
          const int bb = rl >> 11, t = rl & 2047;
          bf16_t* pp = Pw + (size_t)(bb * TPB + CTX + t) * NP + PC_SK + kh * 64 + g * 8;
          const u32x4 r1 = *(const u32x4*)pp, r2 = *(const u32x4*)(pp + 32);
          const f32x4 c0 = *(const f32x4*)(rc + t * 32 + g * 8), c1 = *(const f32x4*)(rc + t * 32 + g * 8 + 4), s0 = *(const f32x4*)(rs + t * 32 + g * 8), s1 = *(const f32x4*)(rs + t * 32 + g * 8 + 4);
          u32x4 o1, o2;
#pragma unroll
          for (int e = 0; e < 4; ++e) { const float xa = bflo(r1[e]), xb = bfhi(r1[e]), ya = bflo(r2[e]), yb = bfhi(r2[e]);
              const float ca = e < 2 ? c0[2 * e] : c1[2 * e - 4], cb = e < 2 ? c0[2 * e + 1] : c1[2 * e - 3], sa = e < 2 ? s0[2 * e] : s1[2 * e - 4], sb = e < 2 ? s0[2 * e + 1] : s1[2 * e - 3];
              o1[e] = pk2(xa * ca - ya * sa, xb * cb - yb * sb); o2[e] = pk2(xa * sa + ya * ca, xb * sb + yb * cb); }
          *(u32x4*)pp = o1; *(u32x4*)(pp + 32) = o2; } }
}

__device__ __forceinline__ void dn_seq(const Params& p, int l, int s, LAS unsigned char* lds, const int wvs) {
    const int tid = wvs * 64 + lane_id_fresh(); const int lane = tid & 63;
    const int b = s >> 3, h = (s >> 1) & 3, d = s & 1;
    LAS bf16_t* QH = (LAS bf16_t*)lds; LAS bf16_t* KH = QH + 64 * HST; LAS bf16_t* VB = KH + 64 * HST; LAS bf16_t* KTT = VB + 64 * HST; LAS bf16_t* LM = KTT + 64 * HST; LAS bf16_t* SCM = LM + 64 * HST; LAS bf16_t* OB = SCM + 64 * HST;
    LAS float* LF = (LAS float*)(OB + 64 * HST);
    LAS bf16_t* DI = (LAS bf16_t*)(LF + 4 * 16 * 17);
    LAS float* GC = (LAS float*)(DI + 4 * 16 * 24); LAS float* EG = GC + 64; LAS float* BETA = EG + 64; LAS float* GL = BETA + 64;
    const bf16_t* QKV = (const bf16_t*)(p.ws + WS_QKV);
    const float* AB = (const float*)(p.ws + WS_AB);
    bf16_t* OD = (bf16_t*)(p.ws + WS_OD) + (size_t)d * M * 512 + h * 64;
    const float nA = -expf(p.dn_A_log[(l * 2 + d) * 4 + h]); const float dtb = p.dn_dt_bias[(l * 2 + d) * 4 + h];
    const int fr = lane & 15, fq = lane >> 4;
    const int V = wvs & 3, half = wvs >> 2;
    const f32x4 zero4 = (f32x4){0.f, 0.f, 0.f, 0.f};
    u32x4 praw[3]; float pa = 0.f, pb_ = 0.f;
    { const int nc0 = d == 0 ? 0 : 3; const int base0 = b * TPB + nc0 * 64;
#pragma unroll
      for (int k = 0; k < 3; ++k) { const int q = tid + NTHR * k; const int rr = q / 24, pc = q - rr * 24; praw[k] = *(const u32x4*)(QKV + ((size_t)(base0 + rr) * 4 + h) * 192 + pc * 8); }
      if (wvs == 0) { const int r = base0 + (d ? 63 - lane : lane); pa = AB[(size_t)r * 16 + d * 4 + h]; pb_ = AB[(size_t)r * 16 + 8 + d * 4 + h]; } }
    f32x4 Sacc[4];
#pragma unroll
    for (int T = 0; T < 4; ++T) Sacc[T] = zero4;
    for (int ci = 0; ci < 36; ++ci) {
        const int nc = d == 0 ? ci : (ci < 4 ? 3 - ci : 39 - ci);
        const int base = b * TPB + nc * 64;
#pragma unroll
        for (int k = 0; k < 3; ++k) { const int q = tid + NTHR * k; const int rr = q / 24, pc = q - rr * 24; const int t = d ? 63 - rr : rr;
            LAS bf16_t* dst = (pc < 8 ? QH : (pc < 16 ? KH : VB)) + t * HST + (pc & 7) * 8; *(LAS u32x4*)dst = praw[k]; }
        const float a_in = pa, b_in = pb_;
        if (ci + 1 < 36) { const int c2 = ci + 1; const int nc2 = d == 0 ? c2 : (c2 < 4 ? 3 - c2 : 39 - c2); const int base2 = b * TPB + nc2 * 64;
#pragma unroll
            for (int k = 0; k < 3; ++k) { const int q = tid + NTHR * k; const int rr = q / 24, pc = q - rr * 24; praw[k] = *(const u32x4*)(QKV + ((size_t)(base2 + rr) * 4 + h) * 192 + pc * 8); }
            if (wvs == 0) { const int r = base2 + (d ? 63 - lane : lane); pa = AB[(size_t)r * 16 + d * 4 + h]; pb_ = AB[(size_t)r * 16 + 8 + d * 4 + h]; } }
        if (wvs == 0) { const float xs = a_in + dtb; const float sp = xs > 15.f ? xs : (xs < -15.f ? __expf(xs) : __logf(1.f + __expf(xs))); float x = nA * sp;
#pragma unroll
            for (int o = 1; o < 64; o <<= 1) { const float y = __shfl_up(x, o); if (lane >= o) x += y; }
            GC[lane] = x; EG[lane] = __expf(x); BETA[lane] = 1.f / (1.f + __expf(-b_in)); if (lane == 63) { GL[0] = x; GL[1] = __expf(x); } }
        __syncthreads();
        { const int t = tid >> 3, part = tid & 7; const u32x4 kr = *(const LAS u32x4*)(KH + t * HST + part * 8); const float ekt = __expf(GL[0] - GC[t]);
#pragma unroll
          for (int e = 0; e < 4; ++e) { KTT[(part * 8 + 2 * e) * HST + t] = bf1(bflo(kr[e]) * ekt); KTT[(part * 8 + 2 * e + 1) * HST + t] = bf1(bfhi(kr[e]) * ekt); } }
        { const int I = wvs >> 1;
#pragma unroll
          for (int jj = 0; jj < 2; ++jj) { const int J = 2 * (wvs & 1) + jj; f32x4 ckk = zero4, cqk = zero4;
#pragma unroll
              for (int kk = 0; kk < 2; ++kk) { const bf16x8 Ak = *(const LAS bf16x8*)(KH + (I * 16 + fr) * HST + kk * 32 + fq * 8), Aq = *(const LAS bf16x8*)(QH + (I * 16 + fr) * HST + kk * 32 + fq * 8);
                  const bf16x8 B = *(const LAS bf16x8*)(KH + (J * 16 + fr) * HST + kk * 32 + fq * 8);
                  ckk = __builtin_amdgcn_mfma_f32_16x16x32_bf16(Ak, B, ckk, 0, 0, 0); cqk = __builtin_amdgcn_mfma_f32_16x16x32_bf16(Aq, B, cqk, 0, 0, 0); }
              const int j = J * 16 + fr; const float gj = GC[j];
#pragma unroll
              for (int r = 0; r < 4; ++r) { const int i = I * 16 + fq * 4 + r; const float dec = __expf(fminf(GC[i] - gj, 0.f));
                  const float lv = j < i ? BETA[i] * ckk[r] * dec : 0.f, sv = j <= i ? cqk[r] * dec : 0.f;
                  LM[i * HST + j] = bf1(lv); SCM[i * HST + j] = bf1(sv); if (I == J) LF[(I * 16 + fq * 4 + r) * 17 + fr] = lv; } }
          if ((2 * (wvs & 1) == I) || (2 * (wvs & 1) + 1 == I)) { asm volatile("s_waitcnt lgkmcnt(0)" ::: "memory");
              if (lane < 16) { const int c = lane; float x[16];
#pragma unroll
                  for (int i = 0; i < 16; ++i) { float acc = (i == c) ? 1.f : 0.f;
#pragma unroll
                      for (int j2 = 0; j2 < i; ++j2) acc -= LF[(I * 16 + i) * 17 + j2] * x[j2];
                      x[i] = acc; DI[(I * 16 + i) * 24 + c] = bf1(acc); } } } }
        __syncthreads();
        f32x4 R[4], QS[2];
        { bf16x8 Bs[2];
#pragma unroll
          for (int s2 = 0; s2 < 2; ++s2) Bs[s2] = packB(Sacc[2 * s2], Sacc[2 * s2 + 1]);
#pragma unroll
          for (int I = 0; I < 4; ++I) { f32x4 c = zero4;
#pragma unroll
              for (int s2 = 0; s2 < 2; ++s2) c = __builtin_amdgcn_mfma_f32_16x16x32_bf16(ldA_perm(KH, I * 16 + fr, s2, fq), Bs[s2], c, 0, 0, 0);
#pragma unroll
              for (int r = 0; r < 4; ++r) { const int i = I * 16 + fq * 4 + r; R[I][r] = BETA[i] * (bflo((unsigned)VB[i * HST + V * 16 + fr]) - EG[i] * c[r]); } }
#pragma unroll
          for (int ii = 0; ii < 2; ++ii) { const int I = 2 * half + ii; f32x4 c = zero4;
#pragma unroll
              for (int s2 = 0; s2 < 2; ++s2) c = __builtin_amdgcn_mfma_f32_16x16x32_bf16(ldA_perm(QH, I * 16 + fr, s2, fq), Bs[s2], c, 0, 0, 0);
              QS[ii] = c; } }
        bf16x8 Bx0, Bx1;
        { bf16x8 AD[4];
#pragma unroll
          for (int I = 0; I < 4; ++I) { const u32x2 lo = *(const LAS u32x2*)(DI + (I * 16 + fr) * 24 + fq * 4); u32x4 av; av[0] = lo[0]; av[1] = lo[1]; av[2] = 0u; av[3] = 0u; AD[I] = __builtin_bit_cast(bf16x8, av); }
          const f32x4 X0 = __builtin_amdgcn_mfma_f32_16x16x32_bf16(AD[0], packB(R[0], zero4), zero4, 0, 0, 0);
          f32x4 T1 = __builtin_amdgcn_mfma_f32_16x16x32_bf16(ldA_perm(LM, 16 + fr, 0, fq), packB(X0, zero4), zero4, 0, 0, 0);
          const f32x4 X1 = __builtin_amdgcn_mfma_f32_16x16x32_bf16(AD[1], packB(R[1] - T1, zero4), zero4, 0, 0, 0);
          Bx0 = packB(X0, X1);
          f32x4 T2 = __builtin_amdgcn_mfma_f32_16x16x32_bf16(ldA_perm(LM, 32 + fr, 0, fq), Bx0, zero4, 0, 0, 0);
          const f32x4 X2 = __builtin_amdgcn_mfma_f32_16x16x32_bf16(AD[2], packB(R[2] - T2, zero4), zero4, 0, 0, 0);
          f32x4 T3 = __builtin_amdgcn_mfma_f32_16x16x32_bf16(ldA_perm(LM, 48 + fr, 0, fq), Bx0, zero4, 0, 0, 0);
          T3 = __builtin_amdgcn_mfma_f32_16x16x32_bf16(ldA_perm(LM, 48 + fr, 1, fq), packB(X2, zero4), T3, 0, 0, 0);
          const f32x4 X3 = __builtin_amdgcn_mfma_f32_16x16x32_bf16(AD[3], packB(R[3] - T3, zero4), zero4, 0, 0, 0);
          Bx1 = packB(X2, X3); }
#pragma unroll
        for (int ii = 0; ii < 2; ++ii) { const int I = 2 * half + ii; f32x4 c;
#pragma unroll
            for (int r = 0; r < 4; ++r) c[r] = EG[I * 16 + fq * 4 + r] * QS[ii][r];
            c = __builtin_amdgcn_mfma_f32_16x16x32_bf16(ldA_perm(SCM, I * 16 + fr, 0, fq), Bx0, c, 0, 0, 0);
            c = __builtin_amdgcn_mfma_f32_16x16x32_bf16(ldA_perm(SCM, I * 16 + fr, 1, fq), Bx1, c, 0, 0, 0);
#pragma unroll
            for (int r = 0; r < 4; ++r) OB[(I * 16 + fq * 4 + r) * HST + V * 16 + fr] = bf1(c[r]); }
        { const float egl = GL[1];
#pragma unroll
          for (int T = 0; T < 4; ++T) { f32x4 c = Sacc[T] * egl;
              c = __builtin_amdgcn_mfma_f32_16x16x32_bf16(ldA_perm(KTT, T * 16 + fr, 0, fq), Bx0, c, 0, 0, 0);
              c = __builtin_amdgcn_mfma_f32_16x16x32_bf16(ldA_perm(KTT, T * 16 + fr, 1, fq), Bx1, c, 0, 0, 0);
              Sacc[T] = c; } }
        __syncthreads();
#pragma unroll
        for (int it = 0; it < 4; ++it) { const int idx = tid + NTHR * it; const int i = idx >> 5, c2 = (idx & 31) * 2; const int row = base + (d ? 63 - i : i);
            *(unsigned*)(OD + (size_t)row * 512 + c2) = *(const LAS unsigned*)(OB + i * HST + c2); }
    }
    __syncthreads();
}

__device__ __forceinline__ void hg_seq(const Params& p, int l, int s, LAS unsigned char* lds, const int wvs) {
    const int tid = wvs * 64 + lane_id_fresh(); const int lane = tid & 63;
    const int b = s >> 3, h = (s >> 1) & 3, d = s & 1;
    constexpr int BUFB = 5 * 64 * HST * 2;
    LAS bf16_t* SC = (LAS bf16_t*)(lds + 2 * BUFB); LAS bf16_t* OB = SC + 64 * HST;
    LAS float* GS = (LAS float*)(OB + 64 * HST); LAS float* EBL = GS + 256;
    const bf16_t* P = (const bf16_t*)(p.ws + WS_P);
    bf16_t* OD = (bf16_t*)(p.ws + WS_OD) + (size_t)d * M * 512 + 256 + h * 64;
    const bool isA = wvs < 4;
    const int kx = tid & 63, g = wvs & 3;
    const float lb = ((const float*)(p.ws + WS_LB))[(d * DEPTH + l) * 256 + h * 64 + kx];
    const int fr = lane & 15, fq = lane >> 4, V = wvs & 3;
    f32x4 Sacc[4];
#pragma unroll
    for (int T = 0; T < 4; ++T) Sacc[T] = (f32x4){0.f, 0.f, 0.f, 0.f};
    unsigned short rq[16], rz[16], rv[16];
    float qv[16], kv[16], bc[16];
#define HG_BASE(ci) (b * TPB + ((d == 0) ? (ci) : ((ci) < 4 ? 3 - (ci) : 39 - (ci))) * 64)
#define HG_LOADRAW(ci) do { const int base_ = HG_BASE(ci); _Pragma("unroll") for (int e = 0; e < 16; ++e) { const int t = g * 16 + e; const int pp = d ? 63 - t : t; const bf16_t* rp = P + (size_t)(base_ + pp) * NP + h * 64 + kx; \
        rq[e] = rp[PC_HQ]; rz[e] = rp[PC_HF + d * 256]; rv[e] = rp[PC_HI]; } } while (0)
#define HG_A1(buf) do { LAS bf16_t* VT_ = (LAS bf16_t*)(lds + (buf) * BUFB) + 4 * 64 * HST; float run = 0.f; \
        _Pragma("unroll") for (int e = 0; e < 16; ++e) { const float z = bflo(rz[e]); const float sg = __builtin_amdgcn_rcpf(1.f + __expf(-z)); const float f = lb + (1.f - lb) * sg; \
            run += __logf(f); bc[e] = run; kv[e] = (1.f - lb) * (1.f - sg); qv[e] = bflo(rq[e]); VT_[kx * HST + g * 16 + e] = rv[e]; } \
        GS[g * 64 + kx] = run; } while (0)
#define HG_A2(buf) do { LAS bf16_t* QT_ = (LAS bf16_t*)(lds + (buf) * BUFB); LAS bf16_t* KT_ = QT_ + 64 * HST; LAS bf16_t* QP_ = KT_ + 64 * HST; LAS bf16_t* KTT_ = QP_ + 64 * HST; \
        const float g0 = GS[kx], g1 = GS[64 + kx], g2 = GS[128 + kx], g3 = GS[192 + kx]; const float mid = g0 + g1, bl = (g0 + g1) + (g2 + g3); \
        const float off = (g > 0 ? g0 : 0.f) + (g > 1 ? g1 : 0.f) + (g > 2 ? g2 : 0.f); \
        if (g == 3) EBL[(buf) * 64 + kx] = __expf(bl); \
        _Pragma("unroll") for (int e = 0; e < 16; ++e) { const int t = g * 16 + e; const float bce = bc[e] + off; const float E = fminf(fmaxf(bce - mid, -80.f), 80.f); \
            QT_[t * HST + kx] = bf1(qv[e] * __expf(E)); KT_[t * HST + kx] = bf1(kv[e] * __expf(-E)); \
            QP_[t * HST + kx] = bf1(qv[e] * __expf(bce)); KTT_[kx * HST + t] = bf1(kv[e] * __expf(bl - bce)); } } while (0)
    if (isA) { HG_LOADRAW(0); HG_A1(0); }
    __syncthreads();
    if (isA) { HG_A2(0); HG_LOADRAW(1); }
    __syncthreads();
    for (int ci = 0; ci < 36; ++ci) {
        const int cur = ci & 1, nxt = cur ^ 1;
        LAS bf16_t* QT = (LAS bf16_t*)(lds + cur * BUFB); LAS bf16_t* KT = QT + 64 * HST; LAS bf16_t* QP = KT + 64 * HST; LAS bf16_t* KTT = QP + 64 * HST; LAS bf16_t* VT = KTT + 64 * HST;
        if (isA) { if (ci + 1 < 36) HG_A1(nxt); }
        else {
            if (ci > 0) { const int basep = HG_BASE(ci - 1); const int u = tid - 256;
#pragma unroll
                for (int it = 0; it < 8; ++it) { const int idx = u + 256 * it; const int i = idx >> 5, c2 = (idx & 31) * 2; const int row = basep + (d ? 63 - i : i);
                    *(unsigned*)(OD + (size_t)row * 512 + c2) = *(const LAS unsigned*)(OB + i * HST + c2); } }
            { const int I = V;
#pragma unroll
              for (int J = 0; J < 4; ++J) { f32x4 c = (f32x4){0.f, 0.f, 0.f, 0.f};
                  if (J <= I) {
#pragma unroll
                      for (int kk = 0; kk < 2; ++kk) { const bf16x8 A = *(const LAS bf16x8*)(QT + (I * 16 + fr) * HST + kk * 32 + fq * 8); const bf16x8 B = *(const LAS bf16x8*)(KT + (J * 16 + fr) * HST + kk * 32 + fq * 8);
                          c = __builtin_amdgcn_mfma_f32_16x16x32_bf16(A, B, c, 0, 0, 0); } }
#pragma unroll
                  for (int r = 0; r < 4; ++r) { const int i = I * 16 + fq * 4 + r, j = J * 16 + fr; SC[i * HST + j] = bf1(j <= i ? c[r] : 0.f); } } }
        }
        __syncthreads();
        if (isA) { if (ci + 1 < 36) { HG_A2(nxt); if (ci + 2 < 36) HG_LOADRAW(ci + 2); } }
        else {
            bf16x8 Bs[2], Bv[2];
#pragma unroll
            for (int s2 = 0; s2 < 2; ++s2) { Bs[s2] = packB(Sacc[2 * s2], Sacc[2 * s2 + 1]); Bv[s2] = *(const LAS bf16x8*)(VT + (V * 16 + fr) * HST + s2 * 32 + fq * 8); }
#pragma unroll
            for (int I = 0; I < 4; ++I) { f32x4 o = (f32x4){0.f, 0.f, 0.f, 0.f};
#pragma unroll
                for (int s2 = 0; s2 < 2; ++s2) o = __builtin_amdgcn_mfma_f32_16x16x32_bf16(ldA_perm(QP, I * 16 + fr, s2, fq), Bs[s2], o, 0, 0, 0);
#pragma unroll
                for (int s2 = 0; s2 < 2; ++s2) { const bf16x8 A = *(const LAS bf16x8*)(SC + (I * 16 + fr) * HST + s2 * 32 + fq * 8); o = __builtin_amdgcn_mfma_f32_16x16x32_bf16(A, Bv[s2], o, 0, 0, 0); }
#pragma unroll
                for (int r = 0; r < 4; ++r) OB[(I * 16 + fq * 4 + r) * HST + V * 16 + fr] = bf1(o[r]); }
#pragma unroll
            for (int T = 0; T < 4; ++T) { f32x4 c;
#pragma unroll
                for (int r = 0; r < 4; ++r) c[r] = Sacc[T][r] * EBL[cur * 64 + T * 16 + fq * 4 + r];
#pragma unroll
                for (int s2 = 0; s2 < 2; ++s2) { const bf16x8 A = *(const LAS bf16x8*)(KTT + (T * 16 + fr) * HST + s2 * 32 + fq * 8); c = __builtin_amdgcn_mfma_f32_16x16x32_bf16(A, Bv[s2], c, 0, 0, 0); }
                Sacc[T] = c; }
        }
        __syncthreads();
    }
    if (!isA) { const int basep = HG_BASE(35); const int u = tid - 256;
#pragma unroll
        for (int it = 0; it < 8; ++it) { const int idx = u + 256 * it; const int i = idx >> 5, c2 = (idx & 31) * 2; const int row = basep + (d ? 63 - i : i);
            *(unsigned*)(OD + (size_t)row * 512 + c2) = *(const LAS unsigned*)(OB + i * HST + c2); } }
    __syncthreads();
#undef HG_BASE
#undef HG_LOADRAW
#undef HG_A1
#undef HG_A2
}

constexpr int KST = 72, VST = 136;
__device__ __forceinline__ void swa_unit(const Params& p, int l, int unit, LAS unsigned char* lds, const int wvs) {
    const int tid = wvs * 64 + lane_id_fresh(); const int lane = tid & 63;
    const int b = unit / 36, rem = unit - b * 36, kvh = rem / 18, qb = rem - kvh * 18;
    const bool qctx = qb < 2;
    const bf16_t* P = (const bf16_t*)(p.ws + WS_P);
    const float* rc = (const float*)(p.ws + WS_ROPE); const float* rs = rc + 2048 * 32;
    bf16_t* Y = (bf16_t*)(p.ws + WS_HY);
    LAS bf16_t* Ks = (LAS bf16_t*)lds; LAS bf16_t* Vt = Ks + 128 * KST;
    const int hh = wvs >> 1, qhalf = wvs & 1, head = kvh * 4 + hh;
    const int fr = lane & 15, fq = lane >> 4;
    const int rowq0 = b * TPB + qb * 128 + qhalf * 64;
    const int f0 = (!qctx && qb == 2) ? 1 : 0, nl = qctx ? 0 : 3 - f0 - (qb == 17 ? 1 : 0), nkb = nl + 2;
#define SWA_BLK(j) ((j) < nl ? qb - 1 + f0 + (j) : (j) - nl)
#define SWA_REL(j) ((j) < nl ? f0 + (j) - 1 : 0)
    bf16x8 qf[4][2];
#pragma unroll
    for (int qt = 0; qt < 4; ++qt) {
        const int row = rowq0 + qt * 16 + fr; const bf16_t* qp = P + (size_t)row * NP + PC_SQ + head * 64 + fq * 8;
        const u32x4 r1 = *(const u32x4*)qp, r2 = *(const u32x4*)(qp + 32);
        float a1[8], a2[8];
#pragma unroll
        for (int e = 0; e < 4; ++e) { a1[2 * e] = bflo(r1[e]); a1[2 * e + 1] = bfhi(r1[e]); a2[2 * e] = bflo(r2[e]); a2[2 * e + 1] = bfhi(r2[e]); }
        if (!qctx) { const int t = (qb - 2) * 128 + qhalf * 64 + qt * 16 + fr; const float* cp = rc + t * 32 + fq * 8; const float* sp = rs + t * 32 + fq * 8;
#pragma unroll
            for (int e = 0; e < 8; ++e) { const float cs = cp[e], sn = sp[e]; const float o1 = a1[e] * cs - a2[e] * sn, o2 = a1[e] * sn + a2[e] * cs; a1[e] = o1; a2[e] = o2; } }
        u32x4 o1, o2;
#pragma unroll
        for (int e = 0; e < 4; ++e) { o1[e] = pk2(a1[2 * e] * 0.125f, a1[2 * e + 1] * 0.125f); o2[e] = pk2(a2[2 * e] * 0.125f, a2[2 * e + 1] * 0.125f); }
        qf[qt][0] = __builtin_bit_cast(bf16x8, o1); qf[qt][1] = __builtin_bit_cast(bf16x8, o2);
    }
    const int skey = tid >> 2, sg = tid & 3;
    const float sink = p.swa_sink[l * 8 + head];
    float mrun[4], lrun[4]; f32x4 O[4][4];
#pragma unroll
    for (int qt = 0; qt < 4; ++qt) { mrun[qt] = sink; lrun[qt] = 1.f;
#pragma unroll
        for (int dv = 0; dv < 4; ++dv) O[qt][dv] = (f32x4){0.f, 0.f, 0.f, 0.f}; }
    for (int j = 0; j < nkb; ++j) {
        const int rel = SWA_REL(j);
        u32x4 kreg[2], vreg[2];
        { const int rowk0 = b * TPB + SWA_BLK(j) * 128; const bf16_t* kp = P + (size_t)(rowk0 + skey) * NP + PC_SK + kvh * 64 + sg * 8;
          kreg[0] = *(const u32x4*)kp; kreg[1] = *(const u32x4*)(kp + 32);
#pragma unroll
          for (int it = 0; it < 2; ++it) { const int idx = tid + NTHR * it; vreg[it] = *(const u32x4*)(P + (size_t)(rowk0 + (idx >> 3)) * NP + PC_SV + kvh * 64 + (idx & 7) * 8); } }
        *(LAS u32x4*)(Ks + skey * KST + sg * 8) = kreg[0]; *(LAS u32x4*)(Ks + skey * KST + 32 + sg * 8) = kreg[1];
#pragma unroll
        for (int it = 0; it < 2; ++it) { const int idx = tid + NTHR * it; const int vk = idx >> 3, vg = idx & 7;
#pragma unroll
            for (int e = 0; e < 4; ++e) { Vt[(vg * 8 + 2 * e) * VST + vk] = (bf16_t)(vreg[it][e] & 0xffffu); Vt[(vg * 8 + 2 * e + 1) * VST + vk] = (bf16_t)(vreg[it][e] >> 16); } }
        __syncthreads();
#pragma unroll
        for (int qp2 = 0; qp2 < 2; ++qp2) {
            f32x4 Sx[2][8];
#pragma unroll
            for (int kt = 0; kt < 8; ++kt) { Sx[0][kt] = (f32x4){0.f, 0.f, 0.f, 0.f}; Sx[1][kt] = (f32x4){0.f, 0.f, 0.f, 0.f};
#pragma unroll
                for (int kk = 0; kk < 2; ++kk) { const bf16x8 A = *(const LAS bf16x8*)(Ks + (kt * 16 + fr) * KST + kk * 32 + fq * 8);
                    Sx[0][kt] = __builtin_amdgcn_mfma_f32_16x16x32_bf16(A, qf[2 * qp2][kk], Sx[0][kt], 0, 0, 0);
                    Sx[1][kt] = __builtin_amdgcn_mfma_f32_16x16x32_bf16(A, qf[2 * qp2 + 1][kk], Sx[1][kt], 0, 0, 0); } }
#pragma unroll
            for (int u = 0; u < 2; ++u) { const int qt = 2 * qp2 + u;
                if (rel != 0) { int qi = qhalf * 64 + qt * 16 + fr; asm volatile("" : "+v"(qi));
#pragma unroll
                    for (int kt = 0; kt < 8; ++kt)
#pragma unroll
                        for (int jx = 0; jx < 4; ++jx) { const int kx = kt * 16 + fq * 4 + jx; const bool ok = rel < 0 ? (kx >= qi) : (kx <= qi); if (!ok) Sx[u][kt][jx] = -1e30f; } }
                float mx = -1e30f;
#pragma unroll
                for (int kt = 0; kt < 8; ++kt) mx = fmaxf(mx, fmaxf(fmaxf(Sx[u][kt][0], Sx[u][kt][1]), fmaxf(Sx[u][kt][2], Sx[u][kt][3])));
                mx = xrow16_max(mx);
                const float mnew = fmaxf(mrun[qt], mx); const float alpha = __expf(mrun[qt] - mnew); mrun[qt] = mnew;
                float rsum = 0.f;
#pragma unroll
                for (int kt = 0; kt < 8; ++kt)
#pragma unroll
                    for (int jx = 0; jx < 4; ++jx) { const float e = __expf(Sx[u][kt][jx] - mnew); Sx[u][kt][jx] = e; rsum += e; }
                rsum = xrow16_sum(rsum);
                lrun[qt] = lrun[qt] * alpha + rsum;
#pragma unroll
                for (int dv = 0; dv < 4; ++dv) O[qt][dv] = O[qt][dv] * alpha; }
#pragma unroll
            for (int ks2 = 0; ks2 < 4; ++ks2) {
                bf16x8 Bp[2];
#pragma unroll
                for (int u = 0; u < 2; ++u) { u32x4 pb; pb[0] = pk2(Sx[u][2 * ks2][0], Sx[u][2 * ks2][1]); pb[1] = pk2(Sx[u][2 * ks2][2], Sx[u][2 * ks2][3]); pb[2] = pk2(Sx[u][2 * ks2 + 1][0], Sx[u][2 * ks2 + 1][1]); pb[3] = pk2(Sx[u][2 * ks2 + 1][2], Sx[u][2 * ks2 + 1][3]); Bp[u] = __builtin_bit_cast(bf16x8, pb); }
#pragma unroll
                for (int dv = 0; dv < 4; ++dv) { const LAS bf16_t* vp = Vt + (dv * 16 + fr) * VST + ks2 * 32 + fq * 4;
                    const u32x2 lo = *(const LAS u32x2*)vp, hi = *(const LAS u32x2*)(vp + 16);
                    u32x4 av; av[0] = lo[0]; av[1] = lo[1]; av[2] = hi[0]; av[3] = hi[1]; const bf16x8 Av = __builtin_bit_cast(bf16x8, av);
                    O[2 * qp2][dv] = __builtin_amdgcn_mfma_f32_16x16x32_bf16(Av, Bp[0], O[2 * qp2][dv], 0, 0, 0);
                    O[2 * qp2 + 1][dv] = __builtin_amdgcn_mfma_f32_16x16x32_bf16(Av, Bp[1], O[2 * qp2 + 1][dv], 0, 0, 0); }
            }
        }
        __syncthreads();
    }
#undef SWA_BLK
#undef SWA_REL
#pragma unroll
    for (int qt = 0; qt < 4; ++qt) { const float inv = 1.f / lrun[qt]; const int row = rowq0 + qt * 16 + fr;
#pragma unroll
        for (int dv = 0; dv < 4; ++dv) { u32x2 o2; o2[0] = pk2(O[qt][dv][0] * inv, O[qt][dv][1] * inv); o2[1] = pk2(O[qt][dv][2] * inv, O[qt][dv][3] * inv);
            *(u32x2*)(Y + (size_t)row * D + 256 + head * 64 + dv * 16 + fq * 4) = o2; } }
}

__device__ __forceinline__ void phase_mixers(const Params& p, int l, LAS unsigned char* lds, const int wvs) {
    for (int s = blockIdx.x; s < 256; s += gridDim.x) { if (s < 128) dn_seq(p, l, s, lds, wvs); else hg_seq(p, l, s - 128, lds, wvs); }
    unsigned* ctr = (unsigned*)(p.ws + WS_CTL) + 64 * (1 + l);
    LAS int* su = (LAS int*)(lds + 140 * 1024);
    for (;;) {
        __syncthreads();
        if (wvs == 0 && lane_id_fresh() == 0) su[0] = (int)atomicAdd(ctr, 1u);
        __syncthreads();
        const int unit = su[0];
        if (unit >= 576) break;
        swa_unit(p, l, unit, lds, wvs);
    }
}

__device__ __forceinline__ void phase_finalize(const Params& p, int l, const int wvs) {
    const int tid = wvs * 64 + lane_id_fresh(); const int lane = tid & 63, w = tid >> 6;
    const int gw = blockIdx.x * NWAVES + w, NGW = gridDim.x * NWAVES;
    const bf16_t* P = (const bf16_t*)(p.ws + WS_P);
    const bf16_t* OD0 = (const bf16_t*)(p.ws + WS_OD); const bf16_t* OD1 = OD0 + (size_t)M * 512;
    bf16_t* Y = (bf16_t*)(p.ws + WS_HY);
    const int seg = lane >> 3, d0 = (lane & 7) * 8;
    const int hd = seg & 3; const bool isdn = seg < 4;
    const float* gain = (isdn ? p.dn_norm : p.hg_norm) + l * 64 + d0;
    const f32x4 g0 = *(const f32x4*)gain, g1 = *(const f32x4*)(gain + 4);
    const int ocol = (isdn ? 0 : 256) + hd * 64 + d0, gcol = (isdn ? PC_DNG : PC_HG) + hd * 64 + d0, ycol = (isdn ? 0 : 768) + hd * 64 + d0;
    for (int r = gw; r < M; r += NGW) {
        const u32x4 a = *(const u32x4*)(OD0 + (size_t)r * 512 + ocol), bq = *(const u32x4*)(OD1 + (size_t)r * 512 + ocol), gt = *(const u32x4*)(P + (size_t)r * NP + gcol);
        float o[8]; float ss = 0.f;
#pragma unroll
        for (int e = 0; e < 4; ++e) { o[2 * e] = bflo(a[e]) + bflo(bq[e]); o[2 * e + 1] = bfhi(a[e]) + bfhi(bq[e]); ss += o[2 * e] * o[2 * e] + o[2 * e + 1] * o[2 * e + 1]; }
        ss = sum8(ss);
        const float rms = rsqrtf(ss * (1.f / 64.f) + EPS);
        u32x4 y;
#pragma unroll
        for (int e = 0; e < 4; ++e) { const float ga = bflo(gt[e]), gb = bfhi(gt[e]);
            const float ge0 = e < 2 ? g0[2 * e] : g1[2 * e - 4], ge1 = e < 2 ? g0[2 * e + 1] : g1[2 * e - 3];
            y[e] = pk2(o[2 * e] * rms * ge0 * siluf(ga), o[2 * e + 1] * rms * ge1 * siluf(gb)); }
        *(u32x4*)(Y + (size_t)r * D + ycol) = y;
    }
}

__device__ __forceinline__ void phase_final(const Params& p, const int wvs) {
    const int tid = wvs * 64 + lane_id_fresh(); const int lane = tid & 63, w = tid >> 6;
    const int gw = blockIdx.x * NWAVES + w, NGW = gridDim.x * NWAVES;
    for (int r = gw; r < BATCH * SEQ; r += NGW) {
        f32x4* xr = (f32x4*)(p.out + ((size_t)r << 10)) + lane;
        f32x4 v[4]; float ss = 0.f;
#pragma unroll
        for (int j = 0; j < 4; ++j) { v[j] = xr[64 * j]; ss += (v[j][0] * v[j][0] + v[j][1] * v[j][1]) + (v[j][2] * v[j][2] + v[j][3] * v[j][3]); }
        const float rstd = rsqrtf(wave_sum(ss) * (1.f / D) + EPS);
#pragma unroll
        for (int j = 0; j < 4; ++j) { const f32x4 g = *(const f32x4*)(p.norm_f + 4 * (lane + 64 * j)); xr[64 * j] = v[j] * rstd * g; }
    }
}

#define XB_TMO      128
#define XB_XCNT(j)  (256  + 64 * (j))
#define XB_XSUB(j)  (1280 + 64 * (j))
#define XB_XGEN(j)  (2304 + 64 * (j))
#define XB_TOP      3328
#define XB_TOPGEN   3392
#define XCD_BAR_WORDS 3456
#define XB_SPIN_CAP (1u << 18)

__device__ __forceinline__ unsigned xb_ld(unsigned* p)              { return __hip_atomic_load(p, __ATOMIC_RELAXED, __HIP_MEMORY_SCOPE_AGENT); }
__device__ __forceinline__ unsigned xb_add(unsigned* p, unsigned v) { return __hip_atomic_fetch_add(p, v, __ATOMIC_RELAXED, __HIP_MEMORY_SCOPE_AGENT); }
__device__ __forceinline__ unsigned xb_xcc_id() { return (unsigned)__builtin_amdgcn_s_getreg((3 << 11) | 20) & 0xFu; }
#define XB_SPIN(cond, bar) do { unsigned _sp = 0; while (cond) { __builtin_amdgcn_s_sleep(1); \
    if ((++_sp & 255u) == 0u) { if (xb_ld(&(bar)[XB_TMO])) break; if (_sp > XB_SPIN_CAP) { atomicAdd(&(bar)[XB_TMO], 1u); break; } } } } while (0)

struct XcdBarrier {
    unsigned* bar; unsigned x;
    volatile LAS unsigned* st;
};

__device__ __forceinline__ XcdBarrier xcd_barrier_post(unsigned* bar, volatile LAS unsigned* st) {
    XcdBarrier b; b.bar = bar; b.x = xb_xcc_id(); b.st = st;
    if (threadIdx.x == 0) (void)xb_add(&bar[XB_XCNT(b.x)], 1u);
    return b;
}
__device__ __forceinline__ void xcd_barrier_complete(unsigned* bar, unsigned x, unsigned& nloc, unsigned& nx) {
    const unsigned G = gridDim.x * gridDim.y * gridDim.z;
    unsigned sum, cnt, mine, sp = 0u;
    for (;;) {
        sum = 0u; cnt = 0u; mine = 0u;
#pragma unroll
        for (unsigned j = 0; j < 16; ++j) { const unsigned c = xb_ld(&bar[XB_XCNT(j)]); sum += c; cnt += (c > 0u) ? 1u : 0u; mine = (j == x) ? c : mine; }
        if (sum == G) break;
        __builtin_amdgcn_s_sleep(1);
        if ((++sp & 255u) == 0u) { if (xb_ld(&bar[XB_TMO])) break; if (sp > XB_SPIN_CAP) { atomicAdd(&bar[XB_TMO], 1u); break; } }
    }
    nloc = mine > 0u ? mine : 1u; nx = cnt > 0u ? cnt : 1u;
}

__device__ __forceinline__ void xcd_barrier(const XcdBarrier& b, const int wvs) {
    asm volatile("s_waitcnt vmcnt(0)" ::: "memory");
    __syncthreads();
    if (wvs == 0 && lane_id_fresh() == 0) {
        unsigned* bar = b.bar;
        __builtin_amdgcn_s_waitcnt(0);
        unsigned nloc = b.st[0], nx = b.st[1];
        if (nloc == 0u) { xcd_barrier_complete(bar, b.x, nloc, nx); b.st[0] = nloc; b.st[1] = nx; }
        const unsigned old = xb_add(&bar[XB_XSUB(b.x)], 1u);
        const unsigned gen = old / nloc;
        if (old + 1u == (gen + 1u) * nloc) {
            __builtin_amdgcn_fence(__ATOMIC_RELEASE, "agent");
            asm volatile("s_waitcnt vmcnt(0)" ::: "memory");
            const unsigned og = xb_add(&bar[XB_TOP], 1u);
            const unsigned tg = og / nx;
            if (og + 1u == (tg + 1u) * nx) xb_add(&bar[XB_TOPGEN], 1u);
            else XB_SPIN(xb_ld(&bar[XB_TOPGEN]) == tg, bar);
            __builtin_amdgcn_fence(__ATOMIC_ACQUIRE, "agent");
            xb_add(&bar[XB_XGEN(b.x)], 1u);
            asm volatile("s_waitcnt vmcnt(0)" ::: "memory");
        } else {
            XB_SPIN(xb_ld(&bar[XB_XGEN(b.x)]) == gen, bar);
            __builtin_amdgcn_fence(__ATOMIC_ACQUIRE, "agent");
            asm volatile("s_waitcnt vmcnt(0)" ::: "memory");
        }
    }
    __syncthreads();
}

__device__ __forceinline__ void gsync(cg::grid_group& grid) {
    asm volatile("s_waitcnt vmcnt(0) lgkmcnt(0)" ::: "memory");
    grid.sync();
    __builtin_amdgcn_fence(__ATOMIC_ACQUIRE, "agent");
    asm volatile("s_waitcnt vmcnt(0)" ::: "memory");
}
__global__ void __launch_bounds__(NTHR, 2) fwd_megakernel(Params p) {
    extern __shared__ __attribute__((aligned(16))) unsigned char lds_raw[];
    LAS unsigned char* lds = (LAS unsigned char*)lds_raw;
    cg::grid_group grid = cg::this_grid();
    const int G = gridDim.x, c = blockIdx.x;
    const int wvs = __builtin_amdgcn_readfirstlane((int)(threadIdx.x >> 6));
    { volatile LAS unsigned* st0 = (volatile LAS unsigned*)(lds + 143360 + 64); if (threadIdx.x < 2) st0[threadIdx.x] = 0u; }
    __syncthreads();
    const XcdBarrier xbar = xcd_barrier_post((unsigned*)(p.ws + WS_CTL) + 4096, (volatile LAS unsigned*)(lds + 143360 + 64));
    phase_prologue(p, lds, wvs);
    if (p.ws == nullptr) gsync(grid);
    xcd_barrier(xbar, wvs);
    const float* mods = (const float*)(p.ws + WS_MODS);
    float* Xc = (float*)(p.ws + WS_XC);
    bf16_t* HY = (bf16_t*)(p.ws + WS_HY); bf16_t* PB = (bf16_t*)(p.ws + WS_P);
    for (int l = 0; l < DEPTH; ++l) {
        const int lastl = (l == DEPTH - 1) ? 1 : 0;
        phase_norm<true>(p, l, lds, wvs);
        xcd_barrier(xbar, wvs);
        { pg8::Gemm g{HY, (const bf16_t*)(p.ws + WS_WIN), M, NP, D, D}; pg8::StaticOrder S; S.init(M, NP, G, c); pg8::EpiBf16<0> E{PB, NP};
          pg8::gemm_phase<pg8::EpiBf16<0>, pg8::StaticOrder, true, true>(lds, g, S, E, wvs); }
        xcd_barrier(xbar, wvs);
        phase_dnprep(p, l, lds, wvs);
        xcd_barrier(xbar, wvs);
        phase_mixers(p, l, lds, wvs);
        xcd_barrier(xbar, wvs);
        phase_finalize(p, l, wvs);
        xcd_barrier(xbar, wvs);
        { pg8::Gemm g{HY, (const bf16_t*)(p.ws + WS_WOUT), M, D, D, D}; pg8::Order2 S; S.init(D, G, c, 1); pg8::EpiRes E{p.out, Xc, mods + ((size_t)l * 17 * 6 + 2) * 1024, l == 0 ? p.x : (const float*)p.out, l == 0 ? p.ctx : (const float*)Xc};
          pg8::gemm_phase<pg8::EpiRes, pg8::Order2, true, true>(lds, g, S, E, wvs); }
        if (!lastl) { pg8::Gemm g{HY, (const bf16_t*)(p.ws + WS_WOUT), M, D, D / 4, D}; pg8::CtxSplitOrder S; S.init(G, c); pg8::EpiPart E{(float*)(p.ws + WS_QKV)};
          pg8::gemm_phase<pg8::EpiPart, pg8::CtxSplitOrder, false, true>(lds, g, S, E, wvs); }
        xcd_barrier(xbar, wvs);
        phase_norm<false>(p, l, lds, wvs);
        xcd_barrier(xbar, wvs);
        { pg8::Gemm g{HY, (const bf16_t*)(p.ws + WS_W1), M, DFF, D, D}; pg8::Order2 S; S.init(DFF, G, c, lastl); pg8::EpiBf16<1> E{PB, DFF};
          pg8::gemm_phase<pg8::EpiBf16<1>, pg8::Order2, true, true>(lds, g, S, E, wvs); }
        xcd_barrier(xbar, wvs);
        { pg8::Gemm g{PB, (const bf16_t*)(p.ws + WS_W2), M, D, DFF, DFF}; pg8::Order2 S; S.init(D, G, c, 1); pg8::EpiRes E{p.out, Xc, mods + ((size_t)l * 17 * 6 + 5) * 1024, (const float*)p.out, (const float*)Xc};
          pg8::gemm_phase<pg8::EpiRes, pg8::Order2, true, true>(lds, g, S, E, wvs); }
        if (!lastl) { pg8::Gemm g{PB, (const bf16_t*)(p.ws + WS_W2), M, D, DFF / 4, DFF}; pg8::CtxSplitOrder S; S.init(G, c); pg8::EpiPart E{(float*)(p.ws + WS_QKV)};
          pg8::gemm_phase<pg8::EpiPart, pg8::CtxSplitOrder, false, true>(lds, g, S, E, wvs); }
        xcd_barrier(xbar, wvs);
    }
    phase_final(p, wvs);
}

extern "C" void kernel_launch(void* const* d_in, const int* in_sizes, int n_in, void* d_out, int out_size, void* d_ws, size_t ws_size, hipStream_t stream) {
    static int grid = 0;
    if (grid == 0) {
        if (n_in != 20 || ws_size < WS_END) { fprintf(stderr, "kernel_launch: need 20 inputs and >= %zu bytes of workspace (got %d, %zu)\n", (size_t)WS_END, n_in, ws_size); grid = -1; return; }
        int dev = 0, cus = 0, per_cu = 0;
        hipGetDevice(&dev); hipDeviceGetAttribute(&cus, hipDeviceAttributeMultiprocessorCount, dev);
        if (hipFuncSetAttribute((const void*)fwd_megakernel, hipFuncAttributeMaxDynamicSharedMemorySize, LDS_BYTES) != hipSuccess) { fprintf(stderr, "kernel_launch: hipFuncSetAttribute failed\n"); grid = -1; return; }
        if (hipOccupancyMaxActiveBlocksPerMultiprocessor(&per_cu, (const void*)fwd_megakernel, NTHR, LDS_BYTES) != hipSuccess || per_cu < 1) { fprintf(stderr, "kernel_launch: occupancy query says %d blocks/CU\n", per_cu); per_cu = 1; }
        (void)hipGetLastError();
        grid = cus;
    }
    if (grid < 0) return;
    hipMemsetAsync((char*)d_ws + WS_CTL, 0, 65536, stream);
    Params p{};
    const float** pp = (const float**)&p;
    for (int i = 0; i < 20; ++i) pp[i] = (const float*)d_in[i];
    p.out = (float*)d_out; p.ws = (unsigned char*)d_ws;
    void* args[] = {&p};
    hipError_t e = hipLaunchCooperativeKernel((const void*)fwd_megakernel, dim3(grid), dim3(NTHR), args, LDS_BYTES, stream);
    if (e != hipSuccess) fprintf(stderr, "cooperative launch failed: %s (grid %d)\n", hipGetErrorString(e), grid);
}
```

```cpp
#include <hip/hip_runtime.h>
#include <hip/hip_cooperative_groups.h>
#include <cstdio>
#include <cstdint>
namespace cg = cooperative_groups;

__device__ __forceinline__ int lane_id_fresh() { unsigned m = ~0u; asm volatile("" : "+s"(m)); return (int)__builtin_amdgcn_mbcnt_hi(m, __builtin_amdgcn_mbcnt_lo(m, 0u)); }
namespace pg8 {
#define PG8_LAS __attribute__((address_space(3)))
typedef unsigned short bf16_t;
typedef short bf16x8 __attribute__((ext_vector_type(8)));
typedef float f32x4 __attribute__((ext_vector_type(4)));
typedef unsigned u32x4 __attribute__((ext_vector_type(4)));
constexpr int BM = 256, BK = 64, HALF = 128, HTB = HALF * BK * 2  , STAGE_BYTES = 8 * HTB, NXCD = 8, WGM = 8;

__host__ __device__ __forceinline__ int lds_byte(int r, int c) { const int st = (r >> 4) * 2 + (c >> 5), rr = r & 15, cc = c & 31, ob = rr * 64 + cc * 2; return st * 1024 + (ob ^ (((ob >> 9) & 1) << 5)); }
__host__ __device__ __forceinline__ void stage_rc(int b, int& R, int& C) { const int st = b / 1024, sb = b % 1024, swz = sb ^ (((sb >> 9) & 1) << 5); R = (st >> 1) * 16 + swz / 64; C = (st & 1) * 32 + (swz % 64) / 2; }
__host__ __device__ __forceinline__ int perm32(int rho) { const int n = rho >> 4, i = rho & 15; return 8 * (i >> 2) + 4 * n + (i & 3); }

struct Unit { int pm, pn, ks; };
struct Gemm { const bf16_t* A; const bf16_t* Bt; int M, N, K, ldk; };

struct StaticOrder {
    int nM, nN, nwg, G, c;
    __host__ __device__ void init(int M, int N, int G_, int c_) { nM = M / BM; nN = N / BM; nwg = nM * nN; G = G_; c = c_; }
    __host__ __device__ bool next(int i, Unit& u) const {
        const long L = (long)i * G + c; if (L >= nwg) return false;
        int wgid = (int)L; { const int q = nwg / NXCD, r = nwg % NXCD, xcd = wgid % NXCD, off = wgid / NXCD; wgid = (xcd < r ? xcd * (q + 1) : r * (q + 1) + (xcd - r) * q) + off; }
        const int nig = WGM * nN, gid = wgid / nig, fm = gid * WGM, gsz = (nM - fm) < WGM ? (nM - fm) : WGM;
        u.pm = fm + ((wgid % nig) % gsz); u.pn = (wgid % nig) / gsz; u.ks = 0; return true;
    }
    __device__ __forceinline__ void a_ready(const Unit&) const {}
    __device__ __forceinline__ void done(const Unit&) const {}
};

struct Order2 {
    StaticOrder so; int lat;
    __host__ __device__ void init(int N, int G_, int c_, int lat_) { lat = lat_; so.init(lat_ ? 32768 : 36864, N, G_, c_); }
    __host__ __device__ bool next(int i, Unit& u) const { if (!so.next(i, u)) return false; if (lat) u.pm = (u.pm >> 3) * 9 + 1 + (u.pm & 7); return true; }
    __device__ __forceinline__ void a_ready(const Unit&) const {}
    __device__ __forceinline__ void done(const Unit&) const {}
};
struct CtxSplitOrder {
    int G, c;
    __host__ __device__ void init(int G_, int c_) { G = G_; c = c_; }
    __host__ __device__ bool next(int i, Unit& u) const { const long L = (long)i * G + c; if (L >= 256) return false; u.ks = (int)L & 3; u.pn = ((int)L >> 2) & 3; u.pm = ((int)L >> 4) * 9; return true; }
    __device__ __forceinline__ void a_ready(const Unit&) const {}
    __device__ __forceinline__ void done(const Unit&) const {}
};
__device__ __forceinline__ unsigned cvt_pk_bf16(float lo, float hi) { unsigned r; asm volatile("v_cvt_pk_bf16_f32 %0, %1, %2" : "=v"(r) : "v"(lo), "v"(hi)); return r; }

template <int ACT  > struct EpiBf16 {
    static constexpr bool PERM = true, AFTER_DRAIN = false;
    bf16_t* O; int ldc;
    __device__ __forceinline__ void operator()(const f32x4 (&acc)[2][2][4][2], const Unit& u, int wr, int wc, int fr, int fq) const {
        const int row0 = u.pm * BM + wr * 64 + fr; const int col0 = u.pn * BM + wc * 32 + 8 * fq;
#pragma unroll
        for (int ai = 0; ai < 2; ++ai)
#pragma unroll
            for (int m = 0; m < 4; ++m) { bf16_t* rowp = O + (size_t)(row0 + ai * HALF + m * 16) * ldc + col0;
#pragma unroll
                for (int bj = 0; bj < 2; ++bj) { f32x4 v0 = acc[ai][bj][m][0], v1 = acc[ai][bj][m][1];
                    if (ACT == 1) {
#pragma unroll
                        for (int e = 0; e < 4; ++e) { float a = fmaxf(v0[e], 0.f), b = fmaxf(v1[e], 0.f); v0[e] = a * a; v1[e] = b * b; } }
                    u32x4 w; w.x = cvt_pk_bf16(v0[0], v0[1]); w.y = cvt_pk_bf16(v0[2], v0[3]); w.z = cvt_pk_bf16(v1[0], v1[1]); w.w = cvt_pk_bf16(v1[2], v1[3]);
                    *(u32x4*)(rowp + bj * HALF) = w; } }
    }
};
struct EpiRes {
    static constexpr bool PERM = false, AFTER_DRAIN = false;
    float* Xl; float* Xc; const float* gates;
    const float* Xl_in; const float* Xc_in;
    __device__ __forceinline__ void operator()(const f32x4 (&acc)[2][2][4][2], const Unit& u, int wr, int wc, int fr, int fq) const {
        const int b = u.pm / 9, tt = u.pm - b * 9;
        const size_t toff = (tt == 0) ? ((size_t)(b * 256) << 10) : ((size_t)(b * 2048 + (tt - 1) * 256) << 10);
        float* base = ((tt == 0) ? Xc : Xl) + toff; const float* base_in = ((tt == 0) ? Xc_in : Xl_in) + toff;
        const float* g = gates + (size_t)((tt == 0) ? 16 : b) * 6144;
        const int col0 = u.pn * BM + wc * 32 + 4 * fq;
        float* rp0 = base + ((size_t)(wr * 64 + fr) << 10) + col0; const float* rq0 = base_in + ((size_t)(wr * 64 + fr) << 10) + col0;
#pragma unroll
        for (int bj = 0; bj < 2; ++bj)
#pragma unroll
            for (int n = 0; n < 2; ++n) { const f32x4 gvv = *(const f32x4*)(g + col0 + bj * HALF + n * 16);
#pragma unroll
                for (int ai = 0; ai < 2; ++ai) {
#pragma unroll
                    for (int m = 0; m < 4; ++m) { const size_t eo = (size_t)(ai * HALF + m * 16) * 1024 + bj * HALF + n * 16; f32x4 xv = *(const f32x4*)(rq0 + eo); xv = xv + gvv * acc[ai][bj][m][n]; *(f32x4*)(rp0 + eo) = xv; }
                    asm volatile("" ::: "memory"); } }
    }
};
struct EpiPart {
    static constexpr bool PERM = false, AFTER_DRAIN = false;
    float* part;
    __device__ __forceinline__ void operator()(const f32x4 (&acc)[2][2][4][2], const Unit& u, int wr, int wc, int fr, int fq) const {
        float* rp0 = part + (((size_t)u.ks * 4096 + (size_t)(u.pm / 9) * 256 + wr * 64 + fr) << 10) + u.pn * BM + wc * 32 + 4 * fq;
#pragma unroll
        for (int ai = 0; ai < 2; ++ai)
#pragma unroll
            for (int m = 0; m < 4; ++m)
#pragma unroll
                for (int bj = 0; bj < 2; ++bj)
#pragma unroll
                    for (int n = 0; n < 2; ++n) *(f32x4*)(rp0 + (size_t)(ai * HALF + m * 16) * 1024 + bj * HALF + n * 16) = acc[ai][bj][m][n];
    }
};
template <class Epi, class Sched, bool ALIGN_EPI = false, bool SP2 = false>
__device__ __forceinline__ void gemm_phase(PG8_LAS unsigned char* lds, const Gemm g, const Sched& S, const Epi& E, const int wvs) {
    const int tid = wvs * 64 + lane_id_fresh(); const int wid = __builtin_amdgcn_readfirstlane(tid >> 6), lane = tid & 63, wr = wid >> 2, wc = wid & 3, fr = lane & 15, fq = lane >> 4;
    const int K = g.ldk, nt = g.K / BK; const size_t sstep = (size_t)g.K * 2;
    unsigned voffA[2], voffB[2];
#pragma unroll
    for (int i = 0; i < 2; ++i) { int R, C; stage_rc(tid * 16 + i * 8192, R, C); const int Rb = Epi::PERM ? ((R & ~31) + perm32(R & 31)) : R;
        voffA[i] = (unsigned)(R * K + C) * 2u; voffB[i] = (unsigned)(Rb * K + C) * 2u; }
    const size_t kstep = (size_t)(BK * 2);
    const size_t hstep = (size_t)HALF * K * 2;
    const size_t tstep = 2 * hstep;
    const unsigned ldsw = (unsigned)wid * 1024u;
    const int aoff = lds_byte(wr * 64 + fr, fq * 8), boff = lds_byte(wc * 32 + fr, fq * 8);
#define PG8_SA(b, h) (((b) * 2 + (h)) * HTB)
#define PG8_SB(b, h) ((4 + (b) * 2 + (h)) * HTB)
#define PG8_STAGE(bufoff, gbase, voff) do { _Pragma("unroll") for (int _i = 0; _i < 2; ++_i) \
        __builtin_amdgcn_global_load_lds((const unsigned*)((const char*)(gbase) + (voff)[_i]), (PG8_LAS unsigned*)(lds + (bufoff) + ldsw + _i * 8192), 16, 0, 0); } while (0)
#define PG8_LDA(dst, b, h) do { _Pragma("unroll") for (int m = 0; m < 4; ++m) _Pragma("unroll") for (int k = 0; k < 2; ++k) dst[m][k] = *(const PG8_LAS bf16x8*)(lds + PG8_SA(b, h) + aoff + m * 2048 + k * 1024); } while (0)
#define PG8_LDB(dst, b, h) do { _Pragma("unroll") for (int n = 0; n < 2; ++n) _Pragma("unroll") for (int k = 0; k < 2; ++k) dst[n][k] = *(const PG8_LAS bf16x8*)(lds + PG8_SB(b, h) + boff + n * 2048 + k * 1024); } while (0)
#define PG8_MMA(ai, bj, At, Bt) do { __builtin_amdgcn_s_setprio(1); _Pragma("unroll") for (int m = 0; m < 4; ++m) _Pragma("unroll") for (int n = 0; n < 2; ++n) _Pragma("unroll") for (int k = 0; k < 2; ++k) \
        acc[ai][bj][m][n] = __builtin_amdgcn_mfma_f32_16x16x32_bf16(Bt[n][k], At[m][k], acc[ai][bj][m][n], 0, 0, 0); __builtin_amdgcn_s_setprio(0); } while (0)
#define PG8_WAIT_V(n) asm volatile("s_waitcnt vmcnt(" #n ")" ::: "memory")
#define PG8_WAIT_L(n) asm volatile("s_waitcnt lgkmcnt(" #n ")" ::: "memory")
#define PG8_BAR __builtin_amdgcn_s_barrier()
#define PG8_SCHED __builtin_amdgcn_sched_barrier(0)
    Unit cur, nxt; int ui = 0;
    if (!S.next(0, cur)) return;
    f32x4 acc[2][2][4][2];
#pragma unroll
    for (int a = 0; a < 2; ++a)
#pragma unroll
        for (int b = 0; b < 2; ++b)
#pragma unroll
            for (int m = 0; m < 4; ++m)
#pragma unroll
                for (int n = 0; n < 2; ++n) acc[a][b][m][n] = (f32x4){0.f, 0.f, 0.f, 0.f};
    bf16x8 At[4][2], B0[2][2], B1[2][2];
    const char* cA = (const char*)g.A + (size_t)cur.pm * tstep + (size_t)cur.ks * sstep; const char* cB = (const char*)g.Bt + (size_t)cur.pn * tstep + (size_t)cur.ks * sstep;
    S.a_ready(cur);
    if constexpr (SP2) {
        PG8_STAGE(PG8_SB(0, 0), cB, voffB); PG8_STAGE(PG8_SB(0, 1), cB + hstep, voffB); PG8_STAGE(PG8_SA(0, 0), cA, voffA); PG8_STAGE(PG8_SA(0, 1), cA + hstep, voffA);
        if (wr == 1) PG8_BAR;
        PG8_WAIT_V(2); PG8_BAR;
        PG8_STAGE(PG8_SB(1, 0), cB + kstep, voffB); PG8_STAGE(PG8_SA(1, 0), cA + kstep, voffA); PG8_STAGE(PG8_SB(1, 1), cB + hstep + kstep, voffB);
        PG8_WAIT_V(6); PG8_BAR;
    } else {
        PG8_STAGE(PG8_SB(0, 0), cB, voffB); PG8_STAGE(PG8_SA(0, 0), cA, voffA); PG8_STAGE(PG8_SB(0, 1), cB + hstep, voffB); PG8_STAGE(PG8_SA(0, 1), cA + hstep, voffA);
        if (wr == 1) PG8_BAR;
        PG8_WAIT_V(4); PG8_BAR;
        PG8_STAGE(PG8_SB(1, 0), cB + kstep, voffB); PG8_STAGE(PG8_SA(1, 0), cA + kstep, voffA); PG8_STAGE(PG8_SB(1, 1), cB + hstep + kstep, voffB);
        PG8_WAIT_V(6); PG8_BAR;
    }
    for (;;) {
        const bool has_next = S.next(ui + 1, nxt);
        const char* nA = has_next ? (const char*)g.A + (size_t)nxt.pm * tstep + (size_t)nxt.ks * sstep : cA; const char* nB = has_next ? (const char*)g.Bt + (size_t)nxt.pn * tstep + (size_t)nxt.ks * sstep : cB;
        for (int t = 0; t < nt; t += 2) {
            const bool last = (t == nt - 2);
            const char* a1 = cA + (size_t)(t + 1) * kstep;
            const char* a2 = last ? nA : cA + (size_t)(t + 2) * kstep; const char* b2 = last ? nB : cB + (size_t)(t + 2) * kstep;
            const char* a3 = a2 + kstep; const char* b3 = b2 + kstep;
            if (last && has_next) S.a_ready(nxt);
            if constexpr (SP2) {
            PG8_LDB(B0, 0, 0); PG8_LDB(B1, 0, 1); PG8_SCHED; PG8_LDA(At, 0, 0); PG8_STAGE(PG8_SA(1, 1), a1 + hstep, voffA);
            PG8_WAIT_V(8); PG8_WAIT_L(0); PG8_BAR; PG8_MMA(0, 0, At, B0); PG8_MMA(0, 1, At, B1); PG8_BAR; PG8_SCHED;
            PG8_LDA(At, 0, 1); PG8_STAGE(PG8_SB(0, 0), b2, voffB); PG8_STAGE(PG8_SB(0, 1), b2 + hstep, voffB); PG8_STAGE(PG8_SA(0, 0), a2, voffA);
            PG8_WAIT_V(8); PG8_WAIT_L(0); PG8_BAR; PG8_MMA(1, 0, At, B0); PG8_MMA(1, 1, At, B1); PG8_BAR; PG8_SCHED;
            PG8_LDB(B0, 1, 0); PG8_LDB(B1, 1, 1); PG8_SCHED; PG8_LDA(At, 1, 0); PG8_STAGE(PG8_SA(0, 1), a2 + hstep, voffA);
            PG8_WAIT_V(8); PG8_WAIT_L(0); PG8_BAR; PG8_MMA(0, 0, At, B0); PG8_MMA(0, 1, At, B1); PG8_BAR; PG8_SCHED;
            PG8_LDA(At, 1, 1); PG8_STAGE(PG8_SB(1, 0), b3, voffB); PG8_STAGE(PG8_SB(1, 1), b3 + hstep, voffB); PG8_STAGE(PG8_SA(1, 0), a3, voffA);
            PG8_WAIT_V(8); PG8_WAIT_L(0); PG8_BAR; PG8_MMA(1, 0, At, B0); PG8_MMA(1, 1, At, B1); PG8_BAR; PG8_SCHED;
            } else {
            PG8_LDB(B0, 0, 0); PG8_SCHED; PG8_LDA(At, 0, 0); PG8_STAGE(PG8_SA(1, 1), a1 + hstep, voffA);
            PG8_WAIT_L(8); PG8_BAR; PG8_WAIT_L(0); PG8_MMA(0, 0, At, B0); PG8_BAR; PG8_SCHED;
            PG8_LDB(B1, 0, 1); PG8_STAGE(PG8_SB(0, 0), b2, voffB);
            PG8_BAR; PG8_WAIT_L(0); PG8_MMA(0, 1, At, B1); PG8_BAR;
            PG8_LDA(At, 0, 1); PG8_STAGE(PG8_SA(0, 0), a2, voffA);
            PG8_BAR; PG8_WAIT_L(0); PG8_MMA(1, 0, At, B0); PG8_BAR; PG8_SCHED;
            PG8_STAGE(PG8_SB(0, 1), b2 + hstep, voffB);
            PG8_WAIT_V(6); PG8_BAR; PG8_MMA(1, 1, At, B1); PG8_BAR;
            PG8_LDB(B0, 1, 0); PG8_SCHED; PG8_LDA(At, 1, 0); PG8_STAGE(PG8_SA(0, 1), a2 + hstep, voffA);
            PG8_WAIT_L(8); PG8_BAR; PG8_WAIT_L(0); PG8_MMA(0, 0, At, B0); PG8_BAR; PG8_SCHED;
            PG8_LDB(B1, 1, 1); PG8_STAGE(PG8_SB(1, 0), b3, voffB);
            PG8_BAR; PG8_WAIT_L(0); PG8_MMA(0, 1, At, B1); PG8_BAR;
            PG8_LDA(At, 1, 1); PG8_STAGE(PG8_SA(1, 0), a3, voffA);
            PG8_BAR; PG8_WAIT_L(0); PG8_MMA(1, 0, At, B0); PG8_BAR; PG8_SCHED;
            PG8_STAGE(PG8_SB(1, 1), b3 + hstep, voffB);
            PG8_WAIT_V(6); PG8_BAR; PG8_MMA(1, 1, At, B1); PG8_BAR;
            }
        }
        if constexpr (ALIGN_EPI) { if (wr == 0) PG8_BAR; }
        if constexpr (!Epi::AFTER_DRAIN) { E(acc, cur, wr, wc, fr, fq); S.done(cur); }
        if (!has_next) break;
#pragma unroll
        for (int a = 0; a < 2; ++a)
#pragma unroll
            for (int b = 0; b < 2; ++b)
#pragma unroll
                for (int m = 0; m < 4; ++m)
#pragma unroll
                    for (int n = 0; n < 2; ++n) acc[a][b][m][n] = (f32x4){0.f, 0.f, 0.f, 0.f};
        cur = nxt; cA = nA; cB = nB; ++ui;
        if constexpr (ALIGN_EPI) { if (wr == 1) PG8_BAR; }
    }
    PG8_WAIT_V(0);
    if constexpr (!ALIGN_EPI) { if (wr == 0) PG8_BAR; }
    PG8_BAR;
    if constexpr (Epi::AFTER_DRAIN) { E.fused(acc, cur, wr, wc, fr, fq, lds, wid, lane); S.done(cur); }
#undef PG8_SA
#undef PG8_SB
#undef PG8_STAGE
#undef PG8_LDA
#undef PG8_LDB
#undef PG8_MMA
#undef PG8_WAIT_V
#undef PG8_WAIT_L
#undef PG8_BAR
#undef PG8_SCHED
}
}

constexpr int D = 1024, BATCH = 16, SEQ = 2048, CTX = 256, DEPTH = 4;
constexpr int TPB = CTX + SEQ;
constexpr int M = BATCH * TPB;
constexpr int DIN = 3088, NP = 3072, DFF = 4096;
constexpr int PC_DNQ = 0, PC_DNG = 768, PC_SQ = 1024, PC_SK = 1536, PC_SV = 1664, PC_HQ = 1792, PC_HF = 2048, PC_HI = 2560, PC_HG = 2816;
constexpr float EPS = 1e-6f;
constexpr size_t MiB = 1u << 20;
constexpr size_t WS_CTL = 0, WS_MODS = 1 * MiB, WS_ROPE = 3 * MiB, WS_LB = 3 * MiB + 512 * 1024, WS_AB = 4 * MiB;
constexpr size_t WS_WIN = 7 * MiB, WS_WOUT = 13 * MiB, WS_W1 = 15 * MiB, WS_W2 = 23 * MiB, WS_XC = 32 * MiB, WS_HY = 48 * MiB, WS_P = 120 * MiB;
constexpr size_t WS_OD = WS_P + 216 * MiB, WS_QKV = WS_P + 288 * MiB, WS_END = WS_QKV + 64 * MiB;
constexpr int LDS_BYTES = 147456;
constexpr int NWAVES = 8, NTHR = 512;

#define LAS __attribute__((address_space(3)))
typedef unsigned short bf16_t;
typedef float f32x4 __attribute__((ext_vector_type(4)));
typedef short bf16x8 __attribute__((ext_vector_type(8)));
typedef short s16x4 __attribute__((ext_vector_type(4)));
typedef unsigned u32x4 __attribute__((ext_vector_type(4)));
typedef unsigned u32x2 __attribute__((ext_vector_type(2)));

struct Params {
    const float *x, *c, *ctx, *c_ctx, *w_ada, *b_ada, *norm1, *norm2, *w_in, *dn_conv, *dn_A_log, *dn_dt_bias, *dn_norm, *swa_sink, *hg_lb, *hg_norm, *w_out, *w_ff1, *w_ff2, *norm_f;
    float* out; unsigned char* ws;
};

__device__ __forceinline__ float bflo(unsigned u) { return __uint_as_float(u << 16); }
__device__ __forceinline__ float bfhi(unsigned u) { return __uint_as_float(u & 0xffff0000u); }
__device__ __forceinline__ unsigned pk2(float lo, float hi) { return pg8::cvt_pk_bf16(lo, hi); }
__device__ __forceinline__ bf16_t bf1(float f) { unsigned u = __float_as_uint(f); u += 0x7fffu + ((u >> 16) & 1u); return (bf16_t)(u >> 16); }
__device__ __forceinline__ float siluf(float v) { return v / (1.f + __expf(-v)); }
__device__ __forceinline__ float sigmf(float v) { return 1.f / (1.f + __expf(-v)); }
__device__ __forceinline__ float wave_sum(float v) {
#pragma unroll
    for (int o = 1; o < 64; o <<= 1) v += __shfl_xor(v, o);
    return v;
}
template <int CTRL> __device__ __forceinline__ float dpp(float x) { return __builtin_bit_cast(float, __builtin_amdgcn_mov_dpp(__builtin_bit_cast(int, x), CTRL, 0xf, 0xf, true)); }
constexpr int XOR1 = 0xB1, XOR2 = 0x4E, XOR7 = 0x141;
__device__ __forceinline__ float sum8(float v) { v += dpp<XOR1>(v); v += dpp<XOR2>(v); v += dpp<XOR7>(v); return v; }
__device__ __forceinline__ float xrow16_max(float x) {
    auto s = __builtin_amdgcn_permlane16_swap(__float_as_uint(x), __float_as_uint(x), false, false);
    x = fmaxf(__uint_as_float(s[0]), __uint_as_float(s[1]));
    auto t = __builtin_amdgcn_permlane32_swap(__float_as_uint(x), __float_as_uint(x), false, false);
    return fmaxf(__uint_as_float(t[0]), __uint_as_float(t[1]));
}
__device__ __forceinline__ float xrow16_sum(float x) {
    auto s = __builtin_amdgcn_permlane16_swap(__float_as_uint(x), __float_as_uint(x), false, false);
    x = __uint_as_float(s[0]) + __uint_as_float(s[1]);
    auto t = __builtin_amdgcn_permlane32_swap(__float_as_uint(x), __float_as_uint(x), false, false);
    return __uint_as_float(t[0]) + __uint_as_float(t[1]);
}
__device__ __forceinline__ const float* xrow_c(const float* Xl, const float* Xc, int r) { const int b = r / TPB, t = r - b * TPB; return t < CTX ? Xc + ((size_t)(b * CTX + t) << 10) : Xl + ((size_t)(b * SEQ + t - CTX) << 10); }
__device__ __forceinline__ int cidx(int r) { const int b = r / TPB, t = r - b * TPB; return t < CTX ? 16 : b; }

__device__ __forceinline__ void phase_prologue(const Params& p, LAS unsigned char* lds, const int wvs) {
    const int tid = wvs * 64 + lane_id_fresh(); const int lane = tid & 63, w = tid >> 6;
    float* mods = (float*)(p.ws + WS_MODS);
    LAS float* sc = (LAS float*)lds;
    LAS float* red = (LAS float*)(lds + 81920);
    for (int idx = tid; idx < 17 * 1024; idx += NTHR) { const int ci = idx >> 10, k = idx & 1023; const float v = ci < 16 ? p.c[ci * 1024 + k] : p.c_ctx[k]; sc[k * 20 + ci] = v / (1.f + expf(-v)); }
    __syncthreads();
    for (int it = blockIdx.x; it < DEPTH * 96; it += gridDim.x) {
        const int l = it / 96, cgp = it - l * 96, col = cgp * 64 + lane;
        float acc[17];
#pragma unroll
        for (int i = 0; i < 17; ++i) acc[i] = 0.f;
        const float* wp = p.w_ada + ((size_t)l * 1024 + w * 128) * 6144 + col;
#pragma unroll 16
        for (int kk = 0; kk < 128; ++kk) {
            const float wv = wp[(size_t)kk * 6144];
            const LAS f32x4* s4 = (const LAS f32x4*)(sc + (w * 128 + kk) * 20);
            const f32x4 s0 = s4[0], s1 = s4[1], s2 = s4[2], s3 = s4[3]; const float s16 = sc[(w * 128 + kk) * 20 + 16];
#pragma unroll
            for (int e = 0; e < 4; ++e) { acc[e] += wv * s0[e]; acc[4 + e] += wv * s1[e]; acc[8 + e] += wv * s2[e]; acc[12 + e] += wv * s3[e]; }
            acc[16] += wv * s16;
        }
#pragma unroll
        for (int i = 0; i < 17; ++i) red[(w * 17 + i) * 64 + lane] = acc[i];
        __syncthreads();
        for (int idx = tid; idx < 17 * 64; idx += NTHR) { const int i = idx >> 6, cl = idx & 63; float s = 0.f;
#pragma unroll
            for (int ww = 0; ww < 8; ++ww) s += red[(ww * 17 + i) * 64 + cl];
            mods[((size_t)l * 17 + i) * 6144 + cgp * 64 + cl] = s + p.b_ada[l * 6144 + cgp * 64 + cl]; }
        __syncthreads();
    }
    const int gt = blockIdx.x * NTHR + tid, GT = gridDim.x * NTHR;
    { float* rc = (float*)(p.ws + WS_ROPE); float* rs = rc + 2048 * 32;
      for (int idx = gt; idx < 2048 * 32; idx += GT) { const int t = idx >> 5, d = idx & 31; const float pos = (float)(d < 16 ? (t >> 6) : (t & 63));
          const float inv = expf(-(float)(d & 15) * (9.210340371976184f / 16.f)); const float ang = pos * inv; rc[idx] = cosf(ang); rs[idx] = sinf(ang); } }
    { float* LB = (float*)(p.ws + WS_LB);
      for (int idx = gt; idx < 2 * 256; idx += GT) { const int d = idx >> 8, cc = idx & 255; float v[DEPTH]; float mx = -1e30f;
#pragma unroll
          for (int l = 0; l < DEPTH; ++l) { v[l] = p.hg_lb[(d * DEPTH + l) * 256 + cc]; mx = fmaxf(mx, v[l]); }
          float s = 0.f;
#pragma unroll
          for (int l = 0; l < DEPTH; ++l) { v[l] = expf(v[l] - mx); s += v[l]; }
          float cum = 0.f;
#pragma unroll
          for (int l = 0; l < DEPTH; ++l) { if (l > 0) cum += v[l] / s; LB[(d * DEPTH + l) * 256 + cc] = cum; } } }
}

__device__ __forceinline__ void transpose_item(const float* W, int K, int ldw, int scol0, bf16_t* WT, int n0, int k0, LAS float* scr, int lane) {
#pragma unroll 8
    for (int i = 0; i < 32; ++i) { const int kk = 2 * i + (lane >> 5); scr[kk * 33 + (lane & 31)] = W[(size_t)(k0 + kk) * ldw + scol0 + (lane & 31)]; }
    asm volatile("s_waitcnt lgkmcnt(0)" ::: "memory");
    const int c = lane & 7;
#pragma unroll
    for (int j = 0; j < 4; ++j) { const int n = (lane >> 3) + 8 * j; const LAS float* s = scr + (8 * c) * 33 + n;
        u32x4 o; o.x = pk2(s[0 * 33], s[1 * 33]); o.y = pk2(s[2 * 33], s[3 * 33]); o.z = pk2(s[4 * 33], s[5 * 33]); o.w = pk2(s[6 * 33], s[7 * 33]);
        *(u32x4*)(WT + (size_t)(n0 + n) * K + k0 + 8 * c) = o; }
    asm volatile("s_waitcnt lgkmcnt(0)" ::: "memory");
}

template <bool FIRST> __device__ __forceinline__ void phase_norm(const Params& p, int l, LAS unsigned char* lds, const int wvs) {
    const int tid = wvs * 64 + lane_id_fresh(); const int lane = tid & 63, w = tid >> 6;
    const int gw = blockIdx.x * NWAVES + w, NGW = gridDim.x * NWAVES;
    const float* mods = (const float*)(p.ws + WS_MODS);
    constexpr int WST = 1032;
    LAS bf16_t* wab = (LAS bf16_t*)lds;
    if (FIRST) {
        LAS float* scr = (LAS float*)(lds + 65536 + w * 8704);
        constexpr int I_IN = 16 * 96, I_OUT = 16 * 32, I_1 = 16 * 128, I_2 = 64 * 32;
        for (int it = gw; it < I_IN + I_OUT + I_1 + I_2; it += NGW) {
            int r = it;
            if (r < I_IN) { const int kb = r / 96, nb = r - kb * 96; const int n0 = nb * 32; transpose_item(p.w_in + (size_t)l * D * DIN, D, DIN, n0 + (n0 >= 1024 ? 16 : 0), (bf16_t*)(p.ws + WS_WIN), n0, kb * 64, scr, lane); continue; }
            r -= I_IN;
            if (r < I_OUT) { const int kb = r / 32, nb = r - kb * 32; transpose_item(p.w_out + (size_t)l * D * D, D, D, nb * 32, (bf16_t*)(p.ws + WS_WOUT), nb * 32, kb * 64, scr, lane); continue; }
            r -= I_OUT;
            if (r < I_1) { const int kb = r / 128, nb = r - kb * 128; transpose_item(p.w_ff1 + (size_t)l * D * DFF, D, DFF, nb * 32, (bf16_t*)(p.ws + WS_W1), nb * 32, kb * 64, scr, lane); continue; }
            r -= I_1;
            { const int kb = r / 32, nb = r - kb * 32; transpose_item(p.w_ff2 + (size_t)l * DFF * D, DFF, D, nb * 32, (bf16_t*)(p.ws + WS_W2), nb * 32, kb * 64, scr, lane); }
        }
        const float* wi = p.w_in + (size_t)l * D * DIN + 1024;
        for (int idx = tid; idx < 4096; idx += NTHR) { const int k = idx >> 2, j4 = (idx & 3) * 4; const f32x4 v = *(const f32x4*)(wi + (size_t)k * DIN + j4);
#pragma unroll
            for (int e = 0; e < 4; ++e) wab[(j4 + e) * WST + k] = bf1(v[e]); }
        __syncthreads();
    }
    const float* nw = (FIRST ? p.norm1 : p.norm2) + l * D;
    bf16_t* H = (bf16_t*)(p.ws + WS_HY);
    float* AB = (float*)(p.ws + WS_AB);
    float* Xc = (float*)(p.ws + WS_XC);
    const float* part = (const float*)(p.ws + WS_QKV);
    const bool fix = FIRST ? (l > 0) : (l < DEPTH - 1);
    const float* fgate = mods + ((size_t)(FIRST ? (l > 0 ? l - 1 : 0) : l) * 17 + 16) * 6144 + (FIRST ? 5 : 2) * 1024;
    int nrows = 0;
    for (int r = gw; r < M; r += NGW) {
        ++nrows;
        if (!FIRST && l == DEPTH - 1 && (r % TPB) < CTX) continue;
        const f32x4* xr = (const f32x4*)((FIRST && l == 0) ? xrow_c(p.x, p.ctx, r) : xrow_c(p.out, Xc, r)) + lane;
        f32x4 v[4]; float ss = 0.f;
        const int rb = r / TPB, rt = r - rb * TPB;
        if (fix && rt < CTX) {
            const f32x4* xin = (const f32x4*)((!FIRST && l == 0) ? p.ctx + ((size_t)(rb * CTX + rt) << 10) : Xc + ((size_t)(rb * CTX + rt) << 10)) + lane;
            const f32x4* pr = (const f32x4*)(part + ((size_t)(rb * CTX + rt) << 10)) + lane; f32x4* xo = (f32x4*)(Xc + ((size_t)(rb * CTX + rt) << 10)) + lane;
#pragma unroll
            for (int j = 0; j < 4; ++j) { const f32x4 gq = *(const f32x4*)(fgate + 4 * (lane + 64 * j));
                const f32x4 s4 = (pr[64 * j] + pr[64 * j + 1048576]) + (pr[64 * j + 2 * 1048576] + pr[64 * j + 3 * 1048576]);
                v[j] = xin[64 * j] + gq * s4; xo[64 * j] = v[j]; }
        } else {
#pragma unroll
            for (int j = 0; j < 4; ++j) v[j] = xr[64 * j];
        }
#pragma unroll
        for (int j = 0; j < 4; ++j) ss += (v[j][0] * v[j][0] + v[j][1] * v[j][1]) + (v[j][2] * v[j][2] + v[j][3] * v[j][3]);
        const float rstd = rsqrtf(wave_sum(ss) * (1.f / D) + EPS);
        const float* md = mods + ((size_t)l * 17 + cidx(r)) * 6144 + (FIRST ? 0 : 3 * 1024);
        u32x2* hp = (u32x2*)(H + (size_t)r * D) + lane;
#pragma unroll
        for (int j = 0; j < 4; ++j) { const int k = 4 * (lane + 64 * j);
            const f32x4 g = *(const f32x4*)(nw + k), sh = *(const f32x4*)(md + k), sl = *(const f32x4*)(md + 1024 + k);
            f32x4 h;
#pragma unroll
            for (int e = 0; e < 4; ++e) h[e] = (v[j][e] * rstd * g[e]) * (1.f + sl[e]) + sh[e];
            u32x2 o2; o2.x = pk2(h[0], h[1]); o2.y = pk2(h[2], h[3]); hp[64 * j] = o2;
        }
    }
    if (FIRST) {
        asm volatile("s_waitcnt vmcnt(0)" ::: "memory");
        const int fr = lane & 15, fq = lane >> 4;
        for (int b0 = 0; b0 < nrows; b0 += 16) {
            const int kr = b0 + fr; const bool ok = kr < nrows; const bf16_t* hp = H + (size_t)(gw + (ok ? kr : 0) * NGW) * D + fq * 8;
            f32x4 c = (f32x4){0.f, 0.f, 0.f, 0.f};
#pragma unroll 8
            for (int ks = 0; ks < 32; ++ks) { u32x4 av = *(const u32x4*)(hp + ks * 32); if (!ok) av = (u32x4){0u, 0u, 0u, 0u};
                const bf16x8 bv = *(const LAS bf16x8*)(wab + fr * WST + ks * 32 + fq * 8);
                c = __builtin_amdgcn_mfma_f32_16x16x32_bf16(__builtin_bit_cast(bf16x8, av), bv, c, 0, 0, 0); }
#pragma unroll
            for (int j = 0; j < 4; ++j) { const int k2 = b0 + fq * 4 + j; if (k2 < nrows) AB[(size_t)(gw + k2 * NGW) * 16 + fr] = c[j]; }
        }
    }
}

constexpr int SST = 68;
constexpr int HST = 72;
__device__ __forceinline__ bf16x8 ldA_perm(const LAS bf16_t* base, int row, int s, int fq) {
    const LAS bf16_t* ap = base + row * HST + s * 32 + fq * 4; const u32x2 lo = *(const LAS u32x2*)ap, hi = *(const LAS u32x2*)(ap + 16);
    u32x4 av; av[0] = lo[0]; av[1] = lo[1]; av[2] = hi[0]; av[3] = hi[1]; return __builtin_bit_cast(bf16x8, av);
}
__device__ __forceinline__ bf16x8 packB(const f32x4& a, const f32x4& b) {
    u32x4 pb; pb[0] = bf1(a[0]) | ((unsigned)bf1(a[1]) << 16); pb[1] = bf1(a[2]) | ((unsigned)bf1(a[3]) << 16); pb[2] = bf1(b[0]) | ((unsigned)bf1(b[1]) << 16); pb[3] = bf1(b[2]) | ((unsigned)bf1(b[3]) << 16);
    return __builtin_bit_cast(bf16x8, pb);
}
__device__ __forceinline__ void phase_dnprep(const Params& p, int l, LAS unsigned char* lds, const int wvs) {
    const int tid = wvs * 64 + lane_id_fresh();
    constexpr int RST = 200;
    LAS float* qs = (LAS float*)lds; LAS float* ks = qs + 64 * SST; LAS float* vs = ks + 64 * SST; LAS bf16_t* RAW = (LAS bf16_t*)(vs + 64 * SST);
    const bf16_t* P = (const bf16_t*)(p.ws + WS_P);
    bf16_t* QKV = (bf16_t*)(p.ws + WS_QKV);
    const float* cw = p.dn_conv + (size_t)l * 5 * 768;
    const int c4 = tid % 48, tg = tid / 48;
    LAS float* cdst = ((c4 >> 4) == 0 ? qs : ((c4 >> 4) == 1 ? ks : vs)) + (c4 & 15) * 4;
    for (int it = blockIdx.x; it < BATCH * 36 * 4; it += gridDim.x) {
        const int h = it & 3, bc = it >> 2, b = bc / 36, nc = bc - b * 36;
        const int base = b * TPB + nc * 64, lo = b * TPB + (nc < 4 ? 0 : CTX), hi = b * TPB + (nc < 4 ? CTX : TPB);
        float wc[5][4];
        { const int ch = c4 * 4, pcol = (ch >> 6) * 256 + h * 64 + (ch & 63);
#pragma unroll
          for (int t = 0; t < 5; ++t) { const f32x4 w4 = *(const f32x4*)(cw + t * 768 + pcol); wc[t][0] = w4[0]; wc[t][1] = w4[1]; wc[t][2] = w4[2]; wc[t][3] = w4[3]; } }
#pragma unroll
        for (int k = 0; k < 4; ++k) { const int q = tid + NTHR * k; if (q < 68 * 24) { const int rr = q / 24, pc = q - rr * 24; const int r = base - 2 + rr;
            const u32x4 v = (r >= lo && r < hi) ? *(const u32x4*)(P + (size_t)r * NP + (pc >> 3) * 256 + h * 64 + (pc & 7) * 8) : (u32x4){0u, 0u, 0u, 0u};
            *(LAS u32x4*)(RAW + rr * RST + pc * 8) = v; } }
        __syncthreads();
        if (tid < 480) {
#pragma unroll
            for (int m = 0; m < 7; ++m) { const int pp = tg + 10 * m; if (pp < 64) { float a0 = 0.f, a1 = 0.f, a2 = 0.f, a3 = 0.f;
#pragma unroll
                for (int t = 0; t < 5; ++t) { const u32x2 raw = *(const LAS u32x2*)(RAW + (pp + t) * RST + c4 * 4);
                    a0 += bflo(raw[0]) * wc[t][0]; a1 += bfhi(raw[0]) * wc[t][1]; a2 += bflo(raw[1]) * wc[t][2]; a3 += bfhi(raw[1]) * wc[t][3]; }
                f32x4 o; o[0] = a0 / (1.f + __expf(-a0)); o[1] = a1 / (1.f + __expf(-a1)); o[2] = a2 / (1.f + __expf(-a2)); o[3] = a3 / (1.f + __expf(-a3));
                *(LAS f32x4*)(cdst + pp * SST) = o; } } }
        __syncthreads();
        { const int t = tid >> 3, part = tid & 7;
          const f32x4 q0 = *(const LAS f32x4*)(qs + t * SST + part * 8), q1 = *(const LAS f32x4*)(qs + t * SST + part * 8 + 4);
          const f32x4 k0 = *(const LAS f32x4*)(ks + t * SST + part * 8), k1 = *(const LAS f32x4*)(ks + t * SST + part * 8 + 4);
          const f32x4 v0 = *(const LAS f32x4*)(vs + t * SST + part * 8), v1 = *(const LAS f32x4*)(vs + t * SST + part * 8 + 4);
          float sq = (q0[0] * q0[0] + q0[1] * q0[1]) + (q0[2] * q0[2] + q0[3] * q0[3]) + (q1[0] * q1[0] + q1[1] * q1[1]) + (q1[2] * q1[2] + q1[3] * q1[3]);
          float sk = (k0[0] * k0[0] + k0[1] * k0[1]) + (k0[2] * k0[2] + k0[3] * k0[3]) + (k1[0] * k1[0] + k1[1] * k1[1]) + (k1[2] * k1[2] + k1[3] * k1[3]);
          sq = sum8(sq); sk = sum8(sk);
          const float rq = rsqrtf(sq + EPS) * 0.125f, rk = rsqrtf(sk + EPS);
          u32x4 qo, ko, vo;
          qo[0] = pk2(q0[0] * rq, q0[1] * rq); qo[1] = pk2(q0[2] * rq, q0[3] * rq); qo[2] = pk2(q1[0] * rq, q1[1] * rq); qo[3] = pk2(q1[2] * rq, q1[3] * rq);
          ko[0] = pk2(k0[0] * rk, k0[1] * rk); ko[1] = pk2(k0[2] * rk, k0[3] * rk); ko[2] = pk2(k1[0] * rk, k1[1] * rk); ko[3] = pk2(k1[2] * rk, k1[3] * rk);
          vo[0] = pk2(v0[0], v0[1]); vo[1] = pk2(v0[2], v0[3]); vo[2] = pk2(v1[0], v1[1]); vo[3] = pk2(v1[2], v1[3]);
          bf16_t* dst = QKV + ((size_t)(base + t) * 4 + h) * 192 + part * 8;
          *(u32x4*)dst = qo; *(u32x4*)(dst + 64) = ko; *(u32x4*)(dst + 128) = vo; }
        __syncthreads();
    }
    { bf16_t* Pw = (bf16_t*)(p.ws + WS_P); const float* rc = (const float*)(p.ws + WS_ROPE); const float* rs = rc + 2048 * 32;
      const int gt = blockIdx.x * NTHR + tid, GT = gridDim.x * NTHR;
      for (int idx = gt; idx < BATCH * SEQ * 8; idx += GT) { const int rl = idx >> 3, rem = idx & 7, kh = rem >> 2, g = rem & 3;
          const int bb = rl >> 11, t = rl & 2047;
          bf16_t* pp = Pw + (size_t)(bb * TPB + CTX + t) * NP + PC_SK + kh * 64 + g * 8;
          const u32x4 r1 = *(const u32x4*)pp, r2 = *(const u32x4*)(pp + 32);
          const f32x4 c0 = *(const f32x4*)(rc + t * 32 + g * 8), c1 = *(const f32x4*)(rc + t * 32 + g * 8 + 4), s0 = *(const f32x4*)(rs + t * 32 + g * 8), s1 = *(const f32x4*)(rs + t * 32 + g * 8 + 4);
          u32x4 o1, o2;
#pragma unroll
          for (int e = 0; e < 4; ++e) { const float xa = bflo(r1[e]), xb = bfhi(r1[e]), ya = bflo(r2[e]), yb = bfhi(r2[e]);
              const float ca = e < 2 ? c0[2 * e] : c1[2 * e - 4], cb = e < 2 ? c0[2 * e + 1] : c1[2 * e - 3], sa = e < 2 ? s0[2 * e] : s1[2 * e - 4], sb = e < 2 ? s0[2 * e + 1] : s1[2 * e - 3];
              o1[e] = pk2(xa * ca - ya * sa, xb * cb - yb * sb); o2[e] = pk2(xa * sa + ya * ca, xb * sb + yb * cb); }
          *(u32x4*)pp = o1; *(u32x4*)(pp + 32) = o2; } }
}

__device__ __forceinline__ void dn_seq(const Params& p, int l, int s, LAS unsigned char* lds, const int wvs) {
    const int tid = wvs * 64 + lane_id_fresh(); const int lane = tid & 63;
    const int b = s >> 3, h = (s >> 1) & 3, d = s & 1;
    constexpr int TILEB = 64 * HST * 2, BUFB = 6 * TILEB + 4 * 16 * 24 * 2 + 1024;
    LAS bf16_t* OB = (LAS bf16_t*)(lds + 2 * BUFB); LAS float* LF = (LAS float*)(lds + 2 * BUFB + TILEB);
    const bf16_t* QKV = (const bf16_t*)(p.ws + WS_QKV);
    const float* AB = (const float*)(p.ws + WS_AB);
    bf16_t* OD = (bf16_t*)(p.ws + WS_OD) + (size_t)d * M * 512 + h * 64;
    const float nA = -expf(p.dn_A_log[(l * 2 + d) * 4 + h]); const float dtb = p.dn_dt_bias[(l * 2 + d) * 4 + h];
    const int fr = lane & 15, fq = lane >> 4, V = wvs & 3;
    const bool isP = wvs < 4;
    const f32x4 zero4 = (f32x4){0.f, 0.f, 0.f, 0.f};
    u32x4 praw[6]; float pa = 0.f, pb_ = 0.f;
    f32x4 Sacc[4], R[4], QS[4];
#pragma unroll
    for (int T = 0; T < 4; ++T) { Sacc[T] = zero4; R[T] = zero4; QS[T] = zero4; }
#define DN_BASE(ci) (b * TPB + ((d == 0) ? (ci) : ((ci) < 4 ? 3 - (ci) : 39 - (ci))) * 64)
#define DN_LOADRAW(ci) do { const int base_ = DN_BASE(ci); _Pragma("unroll") for (int k = 0; k < 6; ++k) { const int q = tid + 256 * k; const int rr = q / 24, pc = q - rr * 24; \
            praw[k] = *(const u32x4*)(QKV + ((size_t)(base_ + rr) * 4 + h) * 192 + pc * 8); } \
        if (wvs == 0) { const int r_ = base_ + (d ? 63 - lane : lane); pa = AB[(size_t)r_ * 16 + d * 4 + h]; pb_ = AB[(size_t)r_ * 16 + 8 + d * 4 + h]; } } while (0)
#define DN_S1(buf) do { LAS bf16_t* QH_ = (LAS bf16_t*)(lds + (buf) * BUFB); LAS float* SCL_ = (LAS float*)(lds + (buf) * BUFB + 6 * TILEB + 4 * 16 * 24 * 2); \
        _Pragma("unroll") for (int k = 0; k < 6; ++k) { const int q = tid + 256 * k; const int rr = q / 24, pc = q - rr * 24; const int t = d ? 63 - rr : rr; \
            *(LAS u32x4*)(QH_ + (pc >> 3) * 64 * HST + t * HST + (pc & 7) * 8) = praw[k]; } \
        if (wvs == 0) { const float xs = pa + dtb; const float sp = xs > 15.f ? xs : (xs < -15.f ? __expf(xs) : __logf(1.f + __expf(xs))); float x = nA * sp; \
            _Pragma("unroll") for (int o = 1; o < 64; o <<= 1) { const float y = __shfl_up(x, o); if (lane >= o) x += y; } \
            SCL_[lane] = x; SCL_[64 + lane] = __expf(x); SCL_[128 + lane] = __builtin_amdgcn_rcpf(1.f + __expf(-pb_)); if (lane == 63) { SCL_[192] = x; SCL_[193] = __expf(x); } } } while (0)
    if (isP) { DN_LOADRAW(0); DN_S1(0); }
    __syncthreads();
    for (int ci = -1; ci < 36; ++ci) {
        const int cur = ci & 1, nxt = cur ^ 1;
        LAS bf16_t* QH = (LAS bf16_t*)(lds + cur * BUFB); LAS bf16_t* KH = QH + 64 * HST; LAS bf16_t* VB = KH + 64 * HST; LAS bf16_t* KTT = VB + 64 * HST; LAS bf16_t* LM = KTT + 64 * HST; LAS bf16_t* SCM = LM + 64 * HST;
        LAS bf16_t* DI = SCM + 64 * HST; LAS float* GC = (LAS float*)(DI + 4 * 16 * 24); LAS float* EG = GC + 64; LAS float* BETA = EG + 64; LAS float* GL = BETA + 64;
        if (isP) { if (ci >= 0 && ci + 1 < 36) DN_S1(nxt); }
        else if (ci >= 0) {
            if (ci > 0) { const int basep = DN_BASE(ci - 1); const int u = tid - 256;
#pragma unroll
                for (int it = 0; it < 8; ++it) { const int idx = u + 256 * it; const int i = idx >> 5, c2 = (idx & 31) * 2; const int row = basep + (d ? 63 - i : i);
                    *(unsigned*)(OD + (size_t)row * 512 + c2) = *(const LAS unsigned*)(OB + i * HST + c2); } }
            bf16x8 Bs[2];
#pragma unroll
            for (int s2 = 0; s2 < 2; ++s2) Bs[s2] = packB(Sacc[2 * s2], Sacc[2 * s2 + 1]);
#pragma unroll
            for (int I = 0; I < 4; ++I) { f32x4 c = zero4, cq = zero4;
#pragma unroll
                for (int s2 = 0; s2 < 2; ++s2) { c = __builtin_amdgcn_mfma_f32_16x16x32_bf16(ldA_perm(KH, I * 16 + fr, s2, fq), Bs[s2], c, 0, 0, 0); cq = __builtin_amdgcn_mfma_f32_16x16x32_bf16(ldA_perm(QH, I * 16 + fr, s2, fq), Bs[s2], cq, 0, 0, 0); }
#pragma unroll
                for (int r = 0; r < 4; ++r) { const int i = I * 16 + fq * 4 + r; R[I][r] = BETA[i] * (bflo((unsigned)VB[i * HST + V * 16 + fr]) - EG[i] * c[r]); QS[I][r] = EG[i] * cq[r]; } }
        }
        __syncthreads();
        if (isP) {
            const int pb2 = (ci < 0) ? 0 : nxt;
            if (ci + 1 < 36) {
                LAS bf16_t* QHn = (LAS bf16_t*)(lds + pb2 * BUFB); LAS bf16_t* KHn = QHn + 64 * HST; LAS bf16_t* KTTn = KHn + 2 * 64 * HST; LAS bf16_t* LMn = KTTn + 64 * HST; LAS bf16_t* SCMn = LMn + 64 * HST;
                LAS bf16_t* DIn = SCMn + 64 * HST; LAS float* GCn = (LAS float*)(DIn + 4 * 16 * 24); LAS float* BETAn = GCn + 128; LAS float* GLn = GCn + 192;
                { const int t = tid >> 2, part = tid & 3; const float ekt = __expf(GLn[0] - GCn[t]);
#pragma unroll
                  for (int hh = 0; hh < 2; ++hh) { const u32x4 kr = *(const LAS u32x4*)(KHn + t * HST + part * 16 + hh * 8);
#pragma unroll
                      for (int e = 0; e < 4; ++e) { KTTn[(part * 16 + hh * 8 + 2 * e) * HST + t] = bf1(bflo(kr[e]) * ekt); KTTn[(part * 16 + hh * 8 + 2 * e + 1) * HST + t] = bf1(bfhi(kr[e]) * ekt); } } }
                { const int I = wvs;
                  float gci[4], bti[4], gcj[4];
#pragma unroll
                  for (int r = 0; r < 4; ++r) { gci[r] = GCn[I * 16 + fq * 4 + r]; bti[r] = BETAn[I * 16 + fq * 4 + r]; gcj[r] = GCn[r * 16 + fr]; }
#pragma unroll
                  for (int J = 0; J < 4; ++J) { f32x4 ckk = zero4, cqk = zero4;
                      if (J <= I) {
#pragma unroll
                          for (int kk = 0; kk < 2; ++kk) { const bf16x8 Ak = *(const LAS bf16x8*)(KHn + (I * 16 + fr) * HST + kk * 32 + fq * 8), Aq = *(const LAS bf16x8*)(QHn + (I * 16 + fr) * HST + kk * 32 + fq * 8);
                              const bf16x8 B = *(const LAS bf16x8*)(KHn + (J * 16 + fr) * HST + kk * 32 + fq * 8);
                              ckk = __builtin_amdgcn_mfma_f32_16x16x32_bf16(Ak, B, ckk, 0, 0, 0); cqk = __builtin_amdgcn_mfma_f32_16x16x32_bf16(Aq, B, cqk, 0, 0, 0); } }
                      const int j = J * 16 + fr; const float gj = gcj[J];
#pragma unroll
                      for (int r = 0; r < 4; ++r) { const int i = I * 16 + fq * 4 + r; const float dec = __expf(fminf(gci[r] - gj, 0.f));
                          const float lvv = bti[r] * ckk[r] * dec, svv = cqk[r] * dec;
                          const float lv = j < i ? lvv : 0.f, sv = j <= i ? svv : 0.f;
                          LMn[i * HST + j] = bf1(lv); SCMn[i * HST + j] = bf1(sv); if (I == J) LF[(I * 16 + fq * 4 + r) * 20 + fr] = lv; } }
                  asm volatile("s_waitcnt lgkmcnt(0)" ::: "memory");
                  { const int c = lane & 15; float x[16];
#pragma unroll
                    for (int i = 0; i < 16; ++i) { float acc = (i == c) ? 1.f : 0.f;
#pragma unroll
                        for (int j4 = 0; j4 < (i + 3) / 4; ++j4) { const f32x4 Lr = *(const LAS f32x4*)(LF + (I * 16 + i) * 20 + j4 * 4);
#pragma unroll
                            for (int e = 0; e < 4; ++e) if (j4 * 4 + e < i) acc -= Lr[e] * x[j4 * 4 + e]; }
                        x[i] = acc; }
                    if (lane < 16) {
#pragma unroll
                        for (int i = 0; i < 16; ++i) DIn[(I * 16 + i) * 24 + c] = bf1(x[i]); } } }
                if (ci + 2 < 36) DN_LOADRAW(ci + 2);
            }
        } else if (ci >= 0) {
            bf16x8 Bx0, Bx1;
            { bf16x8 AD[4];
#pragma unroll
              for (int I = 0; I < 4; ++I) { const u32x2 lo = *(const LAS u32x2*)(DI + (I * 16 + fr) * 24 + fq * 4); u32x4 av; av[0] = lo[0]; av[1] = lo[1]; av[2] = 0u; av[3] = 0u; AD[I] = __builtin_bit_cast(bf16x8, av); }
              const f32x4 X0 = __builtin_amdgcn_mfma_f32_16x16x32_bf16(AD[0], packB(R[0], zero4), zero4, 0, 0, 0);
              f32x4 T1 = __builtin_amdgcn_mfma_f32_16x16x32_bf16(ldA_perm(LM, 16 + fr, 0, fq), packB(X0, zero4), zero4, 0, 0, 0);
              const f32x4 X1 = __builtin_amdgcn_mfma_f32_16x16x32_bf16(AD[1], packB(R[1] - T1, zero4), zero4, 0, 0, 0);
              Bx0 = packB(X0, X1);
              f32x4 T2 = __builtin_amdgcn_mfma_f32_16x16x32_bf16(ldA_perm(LM, 32 + fr, 0, fq), Bx0, zero4, 0, 0, 0);
              const f32x4 X2 = __builtin_amdgcn_mfma_f32_16x16x32_bf16(AD[2], packB(R[2] - T2, zero4), zero4, 0, 0, 0);
              f32x4 T3 = __builtin_amdgcn_mfma_f32_16x16x32_bf16(ldA_perm(LM, 48 + fr, 0, fq), Bx0, zero4, 0, 0, 0);
              T3 = __builtin_amdgcn_mfma_f32_16x16x32_bf16(ldA_perm(LM, 48 + fr, 1, fq), packB(X2, zero4), T3, 0, 0, 0);
              const f32x4 X3 = __builtin_amdgcn_mfma_f32_16x16x32_bf16(AD[3], packB(R[3] - T3, zero4), zero4, 0, 0, 0);
              Bx1 = packB(X2, X3); }
#pragma unroll
            for (int I = 0; I < 4; ++I) { f32x4 c = QS[I];
                c = __builtin_amdgcn_mfma_f32_16x16x32_bf16(ldA_perm(SCM, I * 16 + fr, 0, fq), Bx0, c, 0, 0, 0);
                c = __builtin_amdgcn_mfma_f32_16x16x32_bf16(ldA_perm(SCM, I * 16 + fr, 1, fq), Bx1, c, 0, 0, 0);
#pragma unroll
                for (int r = 0; r < 4; ++r) OB[(I * 16 + fq * 4 + r) * HST + V * 16 + fr] = bf1(c[r]); }
            { const float egl = GL[1];
#pragma unroll
              for (int T = 0; T < 4; ++T) { f32x4 c = Sacc[T] * egl;
                  c = __builtin_amdgcn_mfma_f32_16x16x32_bf16(ldA_perm(KTT, T * 16 + fr, 0, fq), Bx0, c, 0, 0, 0);
                  c = __builtin_amdgcn_mfma_f32_16x16x32_bf16(ldA_perm(KTT, T * 16 + fr, 1, fq), Bx1, c, 0, 0, 0);
                  Sacc[T] = c; } }
        }
        __syncthreads();
    }
    if (!isP) { const int basep = DN_BASE(35); const int u = tid - 256;
#pragma unroll
        for (int it = 0; it < 8; ++it) { const int idx = u + 256 * it; const int i = idx >> 5, c2 = (idx & 31) * 2; const int row = basep + (d ? 63 - i : i);
            *(unsigned*)(OD + (size_t)row * 512 + c2) = *(const LAS unsigned*)(OB + i * HST + c2); } }
    __syncthreads();
#undef DN_BASE
#undef DN_LOADRAW
#undef DN_S1
}

__device__ __forceinline__ void hg_seq(const Params& p, int l, int s, LAS unsigned char* lds, const int wvs) {
    const int tid = wvs * 64 + lane_id_fresh(); const int lane = tid & 63;
    const int b = s >> 3, h = (s >> 1) & 3, d = s & 1;
    constexpr int BUFB = 5 * 64 * HST * 2;
    LAS bf16_t* SC = (LAS bf16_t*)(lds + 2 * BUFB); LAS bf16_t* OB = SC + 64 * HST;
    LAS float* GS = (LAS float*)(OB + 64 * HST); LAS float* EBL = GS + 256;
    const bf16_t* P = (const bf16_t*)(p.ws + WS_P);
    bf16_t* OD = (bf16_t*)(p.ws + WS_OD) + (size_t)d * M * 512 + 256 + h * 64;
    const bool isA = wvs < 4;
    const int kx = tid & 63, g = wvs & 3;
    const float lb = ((const float*)(p.ws + WS_LB))[(d * DEPTH + l) * 256 + h * 64 + kx];
    const int fr = lane & 15, fq = lane >> 4, V = wvs & 3;
    f32x4 Sacc[4];
#pragma unroll
    for (int T = 0; T < 4; ++T) Sacc[T] = (f32x4){0.f, 0.f, 0.f, 0.f};
    unsigned short rq[16], rz[16], rv[16];
    float qv[16], kv[16], bc[16];
#define HG_BASE(ci) (b * TPB + ((d == 0) ? (ci) : ((ci) < 4 ? 3 - (ci) : 39 - (ci))) * 64)
#define HG_LOADRAW(ci) do { const int base_ = HG_BASE(ci); _Pragma("unroll") for (int e = 0; e < 16; ++e) { const int t = g * 16 + e; const int pp = d ? 63 - t : t; const bf16_t* rp = P + (size_t)(base_ + pp) * NP + h * 64 + kx; \
        rq[e] = rp[PC_HQ]; rz[e] = rp[PC_HF + d * 256]; rv[e] = rp[PC_HI]; } } while (0)
#define HG_A1(buf) do { LAS bf16_t* VT_ = (LAS bf16_t*)(lds + (buf) * BUFB) + 4 * 64 * HST; float run = 0.f; \
        _Pragma("unroll") for (int e = 0; e < 16; ++e) { const float z = bflo(rz[e]); const float sg = __builtin_amdgcn_rcpf(1.f + __expf(-z)); const float f = lb + (1.f - lb) * sg; \
            run += __logf(f); bc[e] = run; kv[e] = (1.f - lb) * (1.f - sg); qv[e] = bflo(rq[e]); VT_[kx * HST + g * 16 + e] = rv[e]; } \
        GS[g * 64 + kx] = run; } while (0)
#define HG_A2(buf) do { LAS bf16_t* QT_ = (LAS bf16_t*)(lds + (buf) * BUFB); LAS bf16_t* KT_ = QT_ + 64 * HST; LAS bf16_t* QP_ = KT_ + 64 * HST; LAS bf16_t* KTT_ = QP_ + 64 * HST; \
        const float g0 = GS[kx], g1 = GS[64 + kx], g2 = GS[128 + kx], g3 = GS[192 + kx]; const float mid = g0 + g1, bl = (g0 + g1) + (g2 + g3); \
        const float off = (g > 0 ? g0 : 0.f) + (g > 1 ? g1 : 0.f) + (g > 2 ? g2 : 0.f); \
        if (g == 3) EBL[(buf) * 64 + kx] = __expf(bl); \
        _Pragma("unroll") for (int e = 0; e < 16; ++e) { const int t = g * 16 + e; const float bce = bc[e] + off; const float E = fminf(fmaxf(bce - mid, -80.f), 80.f); \
            QT_[t * HST + kx] = bf1(qv[e] * __expf(E)); KT_[t * HST + kx] = bf1(kv[e] * __expf(-E)); \
            QP_[t * HST + kx] = bf1(qv[e] * __expf(bce)); KTT_[kx * HST + t] = bf1(kv[e] * __expf(bl - bce)); } } while (0)
    if (isA) { HG_LOADRAW(0); HG_A1(0); }
    __syncthreads();
    if (isA) { HG_A2(0); HG_LOADRAW(1); }
    __syncthreads();
    for (int ci = 0; ci < 36; ++ci) {
        const int cur = ci & 1, nxt = cur ^ 1;
        LAS bf16_t* QT = (LAS bf16_t*)(lds + cur * BUFB); LAS bf16_t* KT = QT + 64 * HST; LAS bf16_t* QP = KT + 64 * HST; LAS bf16_t* KTT = QP + 64 * HST; LAS bf16_t* VT = KTT + 64 * HST;
        if (isA) { if (ci + 1 < 36) HG_A1(nxt); }
        else {
            if (ci > 0) { const int basep = HG_BASE(ci - 1); const int u = tid - 256;
#pragma unroll
                for (int it = 0; it < 8; ++it) { const int idx = u + 256 * it; const int i = idx >> 5, c2 = (idx & 31) * 2; const int row = basep + (d ? 63 - i : i);
                    *(unsigned*)(OD + (size_t)row * 512 + c2) = *(const LAS unsigned*)(OB + i * HST + c2); } }
            { const int I = V;
#pragma unroll
              for (int J = 0; J < 4; ++J) { f32x4 c = (f32x4){0.f, 0.f, 0.f, 0.f};
                  if (J <= I) {
#pragma unroll
                      for (int kk = 0; kk < 2; ++kk) { const bf16x8 A = *(const LAS bf16x8*)(QT + (I * 16 + fr) * HST + kk * 32 + fq * 8); const bf16x8 B = *(const LAS bf16x8*)(KT + (J * 16 + fr) * HST + kk * 32 + fq * 8);
                          c = __builtin_amdgcn_mfma_f32_16x16x32_bf16(A, B, c, 0, 0, 0); } }
#pragma unroll
                  for (int r = 0; r < 4; ++r) { const int i = I * 16 + fq * 4 + r, j = J * 16 + fr; SC[i * HST + j] = bf1(j <= i ? c[r] : 0.f); } } }
        }
        __syncthreads();
        if (isA) { if (ci + 1 < 36) { HG_A2(nxt); if (ci + 2 < 36) HG_LOADRAW(ci + 2); } }
        else {
            bf16x8 Bs[2], Bv[2];
#pragma unroll
            for (int s2 = 0; s2 < 2; ++s2) { Bs[s2] = packB(Sacc[2 * s2], Sacc[2 * s2 + 1]); Bv[s2] = *(const LAS bf16x8*)(VT + (V * 16 + fr) * HST + s2 * 32 + fq * 8); }
#pragma unroll
            for (int I = 0; I < 4; ++I) { f32x4 o = (f32x4){0.f, 0.f, 0.f, 0.f};
#pragma unroll
                for (int s2 = 0; s2 < 2; ++s2) o = __builtin_amdgcn_mfma_f32_16x16x32_bf16(ldA_perm(QP, I * 16 + fr, s2, fq), Bs[s2], o, 0, 0, 0);
#pragma unroll
                for (int s2 = 0; s2 < 2; ++s2) { const bf16x8 A = *(const LAS bf16x8*)(SC + (I * 16 + fr) * HST + s2 * 32 + fq * 8); o = __builtin_amdgcn_mfma_f32_16x16x32_bf16(A, Bv[s2], o, 0, 0, 0); }
#pragma unroll
                for (int r = 0; r < 4; ++r) OB[(I * 16 + fq * 4 + r) * HST + V * 16 + fr] = bf1(o[r]); }
#pragma unroll
            for (int T = 0; T < 4; ++T) { f32x4 c;
#pragma unroll
                for (int r = 0; r < 4; ++r) c[r] = Sacc[T][r] * EBL[cur * 64 + T * 16 + fq * 4 + r];
#pragma unroll
                for (int s2 = 0; s2 < 2; ++s2) { const bf16x8 A = *(const LAS bf16x8*)(KTT + (T * 16 + fr) * HST + s2 * 32 + fq * 8); c = __builtin_amdgcn_mfma_f32_16x16x32_bf16(A, Bv[s2], c, 0, 0, 0); }
                Sacc[T] = c; }
        }
        __syncthreads();
    }
    if (!isA) { const int basep = HG_BASE(35); const int u = tid - 256;
#pragma unroll
        for (int it = 0; it < 8; ++it) { const int idx = u + 256 * it; const int i = idx >> 5, c2 = (idx & 31) * 2; const int row = basep + (d ? 63 - i : i);
            *(unsigned*)(OD + (size_t)row * 512 + c2) = *(const LAS unsigned*)(OB + i * HST + c2); } }
    __syncthreads();
#undef HG_BASE
#undef HG_LOADRAW
#undef HG_A1
#undef HG_A2
}

constexpr int KST = 72, VST = 136;
__device__ __forceinline__ void swa_unit(const Params& p, int l, int unit, LAS unsigned char* lds, const int wvs) {
    const int tid = wvs * 64 + lane_id_fresh(); const int lane = tid & 63;
    const int b = unit / 36, rem = unit - b * 36, kvh = rem / 18, qb = rem - kvh * 18;
    const bool qctx = qb < 2;
    const bf16_t* P = (const bf16_t*)(p.ws + WS_P);
    const float* rc = (const float*)(p.ws + WS_ROPE); const float* rs = rc + 2048 * 32;
    bf16_t* Y = (bf16_t*)(p.ws + WS_HY);
    LAS bf16_t* Ks = (LAS bf16_t*)lds; LAS bf16_t* Vt = Ks + 128 * KST;
    const int hh = wvs >> 1, qhalf = wvs & 1, head = kvh * 4 + hh;
    const int fr = lane & 15, fq = lane >> 4;
    const int rowq0 = b * TPB + qb * 128 + qhalf * 64;
    const int f0 = (!qctx && qb == 2) ? 1 : 0, nl = qctx ? 0 : 3 - f0 - (qb == 17 ? 1 : 0), nkb = nl + 2;
#define SWA_BLK(j) ((j) < nl ? qb - 1 + f0 + (j) : (j) - nl)
#define SWA_REL(j) ((j) < nl ? f0 + (j) - 1 : 0)
    bf16x8 qf[4][2];
#pragma unroll
    for (int qt = 0; qt < 4; ++qt) {
        const int row = rowq0 + qt * 16 + fr; const bf16_t* qp = P + (size_t)row * NP + PC_SQ + head * 64 + fq * 8;
        const u32x4 r1 = *(const u32x4*)qp, r2 = *(const u32x4*)(qp + 32);
        float a1[8], a2[8];
#pragma unroll
        for (int e = 0; e < 4; ++e) { a1[2 * e] = bflo(r1[e]); a1[2 * e + 1] = bfhi(r1[e]); a2[2 * e] = bflo(r2[e]); a2[2 * e + 1] = bfhi(r2[e]); }
        if (!qctx) { const int t = (qb - 2) * 128 + qhalf * 64 + qt * 16 + fr; const float* cp = rc + t * 32 + fq * 8; const float* sp = rs + t * 32 + fq * 8;
#pragma unroll
            for (int e = 0; e < 8; ++e) { const float cs = cp[e], sn = sp[e]; const float o1 = a1[e] * cs - a2[e] * sn, o2 = a1[e] * sn + a2[e] * cs; a1[e] = o1; a2[e] = o2; } }
        u32x4 o1, o2;
#pragma unroll
        for (int e = 0; e < 4; ++e) { o1[e] = pk2(a1[2 * e] * 0.125f, a1[2 * e + 1] * 0.125f); o2[e] = pk2(a2[2 * e] * 0.125f, a2[2 * e + 1] * 0.125f); }
        qf[qt][0] = __builtin_bit_cast(bf16x8, o1); qf[qt][1] = __builtin_bit_cast(bf16x8, o2);
    }
    const int skey = tid >> 2, sg = tid & 3;
    const float sink = p.swa_sink[l * 8 + head];
    float mrun[4], lrun[4]; f32x4 O[4][4];
#pragma unroll
    for (int qt = 0; qt < 4; ++qt) { mrun[qt] = sink; lrun[qt] = 1.f;
#pragma unroll
        for (int dv = 0; dv < 4; ++dv) O[qt][dv] = (f32x4){0.f, 0.f, 0.f, 0.f}; }
    for (int j = 0; j < nkb; ++j) {
        const int rel = SWA_REL(j);
        u32x4 kreg[2], vreg[2];
        { const int rowk0 = b * TPB + SWA_BLK(j) * 128; const bf16_t* kp = P + (size_t)(rowk0 + skey) * NP + PC_SK + kvh * 64 + sg * 8;
          kreg[0] = *(const u32x4*)kp; kreg[1] = *(const u32x4*)(kp + 32);
#pragma unroll
          for (int it = 0; it < 2; ++it) { const int idx = tid + NTHR * it; vreg[it] = *(const u32x4*)(P + (size_t)(rowk0 + (idx >> 3)) * NP + PC_SV + kvh * 64 + (idx & 7) * 8); } }
        *(LAS u32x4*)(Ks + skey * KST + sg * 8) = kreg[0]; *(LAS u32x4*)(Ks + skey * KST + 32 + sg * 8) = kreg[1];
#pragma unroll
        for (int it = 0; it < 2; ++it) { const int idx = tid + NTHR * it; const int vk = idx >> 3, vg = idx & 7;
#pragma unroll
            for (int e = 0; e < 4; ++e) { Vt[(vg * 8 + 2 * e) * VST + vk] = (bf16_t)(vreg[it][e] & 0xffffu); Vt[(vg * 8 + 2 * e + 1) * VST + vk] = (bf16_t)(vreg[it][e] >> 16); } }
        __syncthreads();
#pragma unroll
        for (int qp2 = 0; qp2 < 2; ++qp2) {
            f32x4 Sx[2][8];
#pragma unroll
            for (int kt = 0; kt < 8; ++kt) { Sx[0][kt] = (f32x4){0.f, 0.f, 0.f, 0.f}; Sx[1][kt] = (f32x4){0.f, 0.f, 0.f, 0.f};
#pragma unroll
                for (int kk = 0; kk < 2; ++kk) { const bf16x8 A = *(const LAS bf16x8*)(Ks + (kt * 16 + fr) * KST + kk * 32 + fq * 8);
                    Sx[0][kt] = __builtin_amdgcn_mfma_f32_16x16x32_bf16(A, qf[2 * qp2][kk], Sx[0][kt], 0, 0, 0);
                    Sx[1][kt] = __builtin_amdgcn_mfma_f32_16x16x32_bf16(A, qf[2 * qp2 + 1][kk], Sx[1][kt], 0, 0, 0); } }
#pragma unroll
            for (int u = 0; u < 2; ++u) { const int qt = 2 * qp2 + u;
                if (rel != 0) { int qi = qhalf * 64 + qt * 16 + fr; asm volatile("" : "+v"(qi));
#pragma unroll
                    for (int kt = 0; kt < 8; ++kt)
#pragma unroll
                        for (int jx = 0; jx < 4; ++jx) { const int kx = kt * 16 + fq * 4 + jx; const bool ok = rel < 0 ? (kx >= qi) : (kx <= qi); if (!ok) Sx[u][kt][jx] = -1e30f; } }
                float mx = -1e30f;
#pragma unroll
                for (int kt = 0; kt < 8; ++kt) mx = fmaxf(mx, fmaxf(fmaxf(Sx[u][kt][0], Sx[u][kt][1]), fmaxf(Sx[u][kt][2], Sx[u][kt][3])));
                mx = xrow16_max(mx);
                const float mnew = fmaxf(mrun[qt], mx); const float alpha = __expf(mrun[qt] - mnew); mrun[qt] = mnew;
                float rsum = 0.f;
#pragma unroll
                for (int kt = 0; kt < 8; ++kt)
#pragma unroll
                    for (int jx = 0; jx < 4; ++jx) { const float e = __expf(Sx[u][kt][jx] - mnew); Sx[u][kt][jx] = e; rsum += e; }
                rsum = xrow16_sum(rsum);
                lrun[qt] = lrun[qt] * alpha + rsum;
#pragma unroll
                for (int dv = 0; dv < 4; ++dv) O[qt][dv] = O[qt][dv] * alpha; }
#pragma unroll
            for (int ks2 = 0; ks2 < 4; ++ks2) {
                bf16x8 Bp[2];
#pragma unroll
                for (int u = 0; u < 2; ++u) { u32x4 pb; pb[0] = pk2(Sx[u][2 * ks2][0], Sx[u][2 * ks2][1]); pb[1] = pk2(Sx[u][2 * ks2][2], Sx[u][2 * ks2][3]); pb[2] = pk2(Sx[u][2 * ks2 + 1][0], Sx[u][2 * ks2 + 1][1]); pb[3] = pk2(Sx[u][2 * ks2 + 1][2], Sx[u][2 * ks2 + 1][3]); Bp[u] = __builtin_bit_cast(bf16x8, pb); }
#pragma unroll
                for (int dv = 0; dv < 4; ++dv) { const LAS bf16_t* vp = Vt + (dv * 16 + fr) * VST + ks2 * 32 + fq * 4;
                    const u32x2 lo = *(const LAS u32x2*)vp, hi = *(const LAS u32x2*)(vp + 16);
                    u32x4 av; av[0] = lo[0]; av[1] = lo[1]; av[2] = hi[0]; av[3] = hi[1]; const bf16x8 Av = __builtin_bit_cast(bf16x8, av);
                    O[2 * qp2][dv] = __builtin_amdgcn_mfma_f32_16x16x32_bf16(Av, Bp[0], O[2 * qp2][dv], 0, 0, 0);
                    O[2 * qp2 + 1][dv] = __builtin_amdgcn_mfma_f32_16x16x32_bf16(Av, Bp[1], O[2 * qp2 + 1][dv], 0, 0, 0); }
            }
        }
        __syncthreads();
    }
#undef SWA_BLK
#undef SWA_REL
#pragma unroll
    for (int qt = 0; qt < 4; ++qt) { const float inv = 1.f / lrun[qt]; const int row = rowq0 + qt * 16 + fr;
#pragma unroll
        for (int dv = 0; dv < 4; ++dv) { u32x2 o2; o2[0] = pk2(O[qt][dv][0] * inv, O[qt][dv][1] * inv); o2[1] = pk2(O[qt][dv][2] * inv, O[qt][dv][3] * inv);
            *(u32x2*)(Y + (size_t)row * D + 256 + head * 64 + dv * 16 + fq * 4) = o2; } }
}

__device__ __forceinline__ void phase_mixers(const Params& p, int l, LAS unsigned char* lds, const int wvs) {
    for (int s = blockIdx.x; s < 256; s += gridDim.x) { if (s < 128) dn_seq(p, l, s, lds, wvs); else hg_seq(p, l, s - 128, lds, wvs); }
    unsigned* ctr = (unsigned*)(p.ws + WS_CTL) + 64 * (1 + l);
    LAS int* su = (LAS int*)(lds + 140 * 1024);
    for (;;) {
        __syncthreads();
        if (wvs == 0 && lane_id_fresh() == 0) su[0] = (int)atomicAdd(ctr, 1u);
        __syncthreads();
        const int unit = su[0];
        if (unit >= 576) break;
        swa_unit(p, l, unit, lds, wvs);
    }
}

__device__ __forceinline__ void phase_finalize(const Params& p, int l, const int wvs) {
    const int tid = wvs * 64 + lane_id_fresh(); const int lane = tid & 63, w = tid >> 6;
    const int gw = blockIdx.x * NWAVES + w, NGW = gridDim.x * NWAVES;
    const bf16_t* P = (const bf16_t*)(p.ws + WS_P);
    const bf16_t* OD0 = (const bf16_t*)(p.ws + WS_OD); const bf16_t* OD1 = OD0 + (size_t)M * 512;
    bf16_t* Y = (bf16_t*)(p.ws + WS_HY);
    const int seg = lane >> 3, d0 = (lane & 7) * 8;
    const int hd = seg & 3; const bool isdn = seg < 4;
    const float* gain = (isdn ? p.dn_norm : p.hg_norm) + l * 64 + d0;
    const f32x4 g0 = *(const f32x4*)gain, g1 = *(const f32x4*)(gain + 4);
    const int ocol = (isdn ? 0 : 256) + hd * 64 + d0, gcol = (isdn ? PC_DNG : PC_HG) + hd * 64 + d0, ycol = (isdn ? 0 : 768) + hd * 64 + d0;
    for (int r = gw; r < M; r += NGW) {
        const u32x4 a = *(const u32x4*)(OD0 + (size_t)r * 512 + ocol), bq = *(const u32x4*)(OD1 + (size_t)r * 512 + ocol), gt = *(const u32x4*)(P + (size_t)r * NP + gcol);
        float o[8]; float ss = 0.f;
#pragma unroll
        for (int e = 0; e < 4; ++e) { o[2 * e] = bflo(a[e]) + bflo(bq[e]); o[2 * e + 1] = bfhi(a[e]) + bfhi(bq[e]); ss += o[2 * e] * o[2 * e] + o[2 * e + 1] * o[2 * e + 1]; }
        ss = sum8(ss);
        const float rms = rsqrtf(ss * (1.f / 64.f) + EPS);
        u32x4 y;
#pragma unroll
        for (int e = 0; e < 4; ++e) { const float ga = bflo(gt[e]), gb = bfhi(gt[e]);
            const float ge0 = e < 2 ? g0[2 * e] : g1[2 * e - 4], ge1 = e < 2 ? g0[2 * e + 1] : g1[2 * e - 3];
            y[e] = pk2(o[2 * e] * rms * ge0 * siluf(ga), o[2 * e + 1] * rms * ge1 * siluf(gb)); }
        *(u32x4*)(Y + (size_t)r * D + ycol) = y;
    }
}

__device__ __forceinline__ void phase_final(const Params& p, const int wvs) {
    const int tid = wvs * 64 + lane_id_fresh(); const int lane = tid & 63, w = tid >> 6;
    const int gw = blockIdx.x * NWAVES + w, NGW = gridDim.x * NWAVES;
    for (int r = gw; r < BATCH * SEQ; r += NGW) {
        f32x4* xr = (f32x4*)(p.out + ((size_t)r << 10)) + lane;
        f32x4 v[4]; float ss = 0.f;
#pragma unroll
        for (int j = 0; j < 4; ++j) { v[j] = xr[64 * j]; ss += (v[j][0] * v[j][0] + v[j][1] * v[j][1]) + (v[j][2] * v[j][2] + v[j][3] * v[j][3]); }
        const float rstd = rsqrtf(wave_sum(ss) * (1.f / D) + EPS);
#pragma unroll
        for (int j = 0; j < 4; ++j) { const f32x4 g = *(const f32x4*)(p.norm_f + 4 * (lane + 64 * j)); xr[64 * j] = v[j] * rstd * g; }
    }
}

#define XB_TMO      128
#define XB_XCNT(j)  (256  + 64 * (j))
#define XB_XSUB(j)  (1280 + 64 * (j))
#define XB_XGEN(j)  (2304 + 64 * (j))
#define XB_TOP      3328
#define XB_TOPGEN   3392
#define XCD_BAR_WORDS 3456
#define XB_SPIN_CAP (1u << 18)

__device__ __forceinline__ unsigned xb_ld(unsigned* p)              { return __hip_atomic_load(p, __ATOMIC_RELAXED, __HIP_MEMORY_SCOPE_AGENT); }
__device__ __forceinline__ unsigned xb_add(unsigned* p, unsigned v) { return __hip_atomic_fetch_add(p, v, __ATOMIC_RELAXED, __HIP_MEMORY_SCOPE_AGENT); }
__device__ __forceinline__ unsigned xb_xcc_id() { return (unsigned)__builtin_amdgcn_s_getreg((3 << 11) | 20) & 0xFu; }
#define XB_SPIN(cond, bar) do { unsigned _sp = 0; while (cond) { __builtin_amdgcn_s_sleep(1); \
    if ((++_sp & 255u) == 0u) { if (xb_ld(&(bar)[XB_TMO])) break; if (_sp > XB_SPIN_CAP) { atomicAdd(&(bar)[XB_TMO], 1u); break; } } } } while (0)

struct XcdBarrier {
    unsigned* bar; unsigned x;
    volatile LAS unsigned* st;
};

__device__ __forceinline__ XcdBarrier xcd_barrier_post(unsigned* bar, volatile LAS unsigned* st) {
    XcdBarrier b; b.bar = bar; b.x = xb_xcc_id(); b.st = st;
    if (threadIdx.x == 0) (void)xb_add(&bar[XB_XCNT(b.x)], 1u);
    return b;
}
__device__ __forceinline__ void xcd_barrier_complete(unsigned* bar, unsigned x, unsigned& nloc, unsigned& nx) {
    const unsigned G = gridDim.x * gridDim.y * gridDim.z;
    unsigned sum, cnt, mine, sp = 0u;
    for (;;) {
        sum = 0u; cnt = 0u; mine = 0u;
#pragma unroll
        for (unsigned j = 0; j < 16; ++j) { const unsigned c = xb_ld(&bar[XB_XCNT(j)]); sum += c; cnt += (c > 0u) ? 1u : 0u; mine = (j == x) ? c : mine; }
        if (sum == G) break;
        __builtin_amdgcn_s_sleep(1);
        if ((++sp & 255u) == 0u) { if (xb_ld(&bar[XB_TMO])) break; if (sp > XB_SPIN_CAP) { atomicAdd(&bar[XB_TMO], 1u); break; } }
    }
    nloc = mine > 0u ? mine : 1u; nx = cnt > 0u ? cnt : 1u;
}

__device__ __forceinline__ void xcd_barrier(const XcdBarrier& b, const int wvs) {
    asm volatile("s_waitcnt vmcnt(0)" ::: "memory");
    __syncthreads();
    if (wvs == 0 && lane_id_fresh() == 0) {
        unsigned* bar = b.bar;
        __builtin_amdgcn_s_waitcnt(0);
        unsigned nloc = b.st[0], nx = b.st[1];
        if (nloc == 0u) { xcd_barrier_complete(bar, b.x, nloc, nx); b.st[0] = nloc; b.st[1] = nx; }
        const unsigned old = xb_add(&bar[XB_XSUB(b.x)], 1u);
        const unsigned gen = old / nloc;
        if (old + 1u == (gen + 1u) * nloc) {
            __builtin_amdgcn_fence(__ATOMIC_RELEASE, "agent");
            asm volatile("s_waitcnt vmcnt(0)" ::: "memory");
            const unsigned og = xb_add(&bar[XB_TOP], 1u);
            const unsigned tg = og / nx;
            if (og + 1u == (tg + 1u) * nx) xb_add(&bar[XB_TOPGEN], 1u);
            else XB_SPIN(xb_ld(&bar[XB_TOPGEN]) == tg, bar);
            __builtin_amdgcn_fence(__ATOMIC_ACQUIRE, "agent");
            xb_add(&bar[XB_XGEN(b.x)], 1u);
            asm volatile("s_waitcnt vmcnt(0)" ::: "memory");
        } else {
            XB_SPIN(xb_ld(&bar[XB_XGEN(b.x)]) == gen, bar);
            __builtin_amdgcn_fence(__ATOMIC_ACQUIRE, "agent");
            asm volatile("s_waitcnt vmcnt(0)" ::: "memory");
        }
    }
    __syncthreads();
}

__device__ __forceinline__ void gsync(cg::grid_group& grid) {
    asm volatile("s_waitcnt vmcnt(0) lgkmcnt(0)" ::: "memory");
    grid.sync();
    __builtin_amdgcn_fence(__ATOMIC_ACQUIRE, "agent");
    asm volatile("s_waitcnt vmcnt(0)" ::: "memory");
}
__global__ void __launch_bounds__(NTHR, 2) fwd_megakernel(Params p) {
    extern __shared__ __attribute__((aligned(16))) unsigned char lds_raw[];
    LAS unsigned char* lds = (LAS unsigned char*)lds_raw;
    cg::grid_group grid = cg::this_grid();
    const int G = gridDim.x, c = blockIdx.x;
    const int wvs = __builtin_amdgcn_readfirstlane((int)(threadIdx.x >> 6));
    { volatile LAS unsigned* st0 = (volatile LAS unsigned*)(lds + 143360 + 64); if (threadIdx.x < 2) st0[threadIdx.x] = 0u; }
    __syncthreads();
    const XcdBarrier xbar = xcd_barrier_post((unsigned*)(p.ws + WS_CTL) + 4096, (volatile LAS unsigned*)(lds + 143360 + 64));
    phase_prologue(p, lds, wvs);
    if (p.ws == nullptr) gsync(grid);
    xcd_barrier(xbar, wvs);
    const float* mods = (const float*)(p.ws + WS_MODS);
    float* Xc = (float*)(p.ws + WS_XC);
    bf16_t* HY = (bf16_t*)(p.ws + WS_HY); bf16_t* PB = (bf16_t*)(p.ws + WS_P);
    for (int l = 0; l < DEPTH; ++l) {
        const int lastl = (l == DEPTH - 1) ? 1 : 0;
        phase_norm<true>(p, l, lds, wvs);
        xcd_barrier(xbar, wvs);
        { pg8::Gemm g{HY, (const bf16_t*)(p.ws + WS_WIN), M, NP, D, D}; pg8::StaticOrder S; S.init(M, NP, G, c); pg8::EpiBf16<0> E{PB, NP};
          pg8::gemm_phase<pg8::EpiBf16<0>, pg8::StaticOrder, true, true>(lds, g, S, E, wvs); }
        xcd_barrier(xbar, wvs);
        phase_dnprep(p, l, lds, wvs);
        xcd_barrier(xbar, wvs);
        phase_mixers(p, l, lds, wvs);
        xcd_barrier(xbar, wvs);
        phase_finalize(p, l, wvs);
        xcd_barrier(xbar, wvs);
        { pg8::Gemm g{HY, (const bf16_t*)(p.ws + WS_WOUT), M, D, D, D}; pg8::Order2 S; S.init(D, G, c, 1); pg8::EpiRes E{p.out, Xc, mods + ((size_t)l * 17 * 6 + 2) * 1024, l == 0 ? p.x : (const float*)p.out, l == 0 ? p.ctx : (const float*)Xc};
          pg8::gemm_phase<pg8::EpiRes, pg8::Order2, true, true>(lds, g, S, E, wvs); }
        if (!lastl) { pg8::Gemm g{HY, (const bf16_t*)(p.ws + WS_WOUT), M, D, D / 4, D}; pg8::CtxSplitOrder S; S.init(G, c); pg8::EpiPart E{(float*)(p.ws + WS_QKV)};
          pg8::gemm_phase<pg8::EpiPart, pg8::CtxSplitOrder, false, true>(lds, g, S, E, wvs); }
        xcd_barrier(xbar, wvs);
        phase_norm<false>(p, l, lds, wvs);
        xcd_barrier(xbar, wvs);
        { pg8::Gemm g{HY, (const bf16_t*)(p.ws + WS_W1), M, DFF, D, D}; pg8::Order2 S; S.init(DFF, G, c, lastl); pg8::EpiBf16<1> E{PB, DFF};
          pg8::gemm_phase<pg8::EpiBf16<1>, pg8::Order2, true, true>(lds, g, S, E, wvs); }
        xcd_barrier(xbar, wvs);
        { pg8::Gemm g{PB, (const bf16_t*)(p.ws + WS_W2), M, D, DFF, DFF}; pg8::Order2 S; S.init(D, G, c, 1); pg8::EpiRes E{p.out, Xc, mods + ((size_t)l * 17 * 6 + 5) * 1024, (const float*)p.out, (const float*)Xc};
          pg8::gemm_phase<pg8::EpiRes, pg8::Order2, true, true>(lds, g, S, E, wvs); }
        if (!lastl) { pg8::Gemm g{PB, (const bf16_t*)(p.ws + WS_W2), M, D, DFF / 4, DFF}; pg8::CtxSplitOrder S; S.init(G, c); pg8::EpiPart E{(float*)(p.ws + WS_QKV)};
          pg8::gemm_phase<pg8::EpiPart, pg8::CtxSplitOrder, false, true>(lds, g, S, E, wvs); }
        xcd_barrier(xbar, wvs);
    }
    phase_final(p, wvs);
}

extern "C" void kernel_launch(void* const* d_in, const int* in_sizes, int n_in, void* d_out, int out_size, void* d_ws, size_t ws_size, hipStream_t stream) {
    static int grid = 0;
    if (grid == 0) {
        if (n_in != 20 || ws_size < WS_END) { fprintf(stderr, "kernel_launch: need 20 inputs and >= %zu bytes of workspace (got %d, %zu)\n", (size_t)WS_END, n_in, ws_size); grid = -1; return; }
        int dev = 0, cus = 0, per_cu = 0;
        hipGetDevice(&dev); hipDeviceGetAttribute(&cus, hipDeviceAttributeMultiprocessorCount, dev);
        if (hipFuncSetAttribute((const void*)fwd_megakernel, hipFuncAttributeMaxDynamicSharedMemorySize, LDS_BYTES) != hipSuccess) { fprintf(stderr, "kernel_launch: hipFuncSetAttribute failed\n"); grid = -1; return; }
        if (hipOccupancyMaxActiveBlocksPerMultiprocessor(&per_cu, (const void*)fwd_megakernel, NTHR, LDS_BYTES) != hipSuccess || per_cu < 1) { fprintf(stderr, "kernel_launch: occupancy query says %d blocks/CU\n", per_cu); per_cu = 1; }
        (void)hipGetLastError();
        grid = cus;
    }
    if (grid < 0) return;
    hipMemsetAsync((char*)d_ws + WS_CTL, 0, 65536, stream);
    Params p{};
    const float** pp = (const float**)&p;
    for (int i = 0; i < 20; ++i) pp[i] = (const float*)d_in[i];
    p.out = (float*)d_out; p.ws = (unsigned char*)d_ws;
    void* args[] = {&p};
    hipError_t e = hipLaunchCooperativeKernel((const void*)fwd_megakernel, dim3(grid), dim3(NTHR), args, LDS_BYTES, stream);
    if (e != hipSuccess) fprintf(stderr, "cooperative launch failed: %s (grid %d)\n", hipGetErrorString(e), grid);
}
```

```cpp
#include <hip/hip_runtime.h>
#include <hip/hip_cooperative_groups.h>
#include <cstdio>
#include <cstdint>
namespace cg = cooperative_groups;

__device__ __forceinline__ int lane_id_fresh() { unsigned m = ~0u; asm volatile("" : "+s"(m)); return (int)__builtin_amdgcn_mbcnt_hi(m, __builtin_amdgcn_mbcnt_lo(m, 0u)); }
namespace pg8 {
#define PG8_LAS __attribute__((address_space(3)))
typedef unsigned short bf16_t;
typedef short bf16x8 __attribute__((ext_vector_type(8)));
typedef float f32x4 __attribute__((ext_vector_type(4)));
typedef unsigned u32x4 __attribute__((ext_vector_type(4)));
constexpr int BM = 256, BK = 64, HALF = 128, HTB = HALF * BK * 2  , STAGE_BYTES = 8 * HTB, NXCD = 8, WGM = 8;

__host__ __device__ __forceinline__ int lds_byte(int r, int c) { const int st = (r >> 4) * 2 + (c >> 5), rr = r & 15, cc = c & 31, ob = rr * 64 + cc * 2; return st * 1024 + (ob ^ (((ob >> 9) & 1) << 5)); }
__host__ __device__ __forceinline__ void stage_rc(int b, int& R, int& C) { const int st = b / 1024, sb = b % 1024, swz = sb ^ (((sb >> 9) & 1) << 5); R = (st >> 1) * 16 + swz / 64; C = (st & 1) * 32 + (swz % 64) / 2; }
__host__ __device__ __forceinline__ int perm32(int rho) { const int n = rho >> 4, i = rho & 15; return 8 * (i >> 2) + 4 * n + (i & 3); }

struct Unit { int pm, pn, ks; };
struct Gemm { const bf16_t* A; const bf16_t* Bt; int M, N, K, ldk; };

struct StaticOrder {
    int nM, nN, nwg, G, c;
    __host__ __device__ void init(int M, int N, int G_, int c_) { nM = M / BM; nN = N / BM; nwg = nM * nN; G = G_; c = c_; }
    __host__ __device__ bool next(int i, Unit& u) const {
        const long L = (long)i * G + c; if (L >= nwg) return false;
        int wgid = (int)L; { const int q = nwg / NXCD, r = nwg % NXCD, xcd = wgid % NXCD, off = wgid / NXCD; wgid = (xcd < r ? xcd * (q + 1) : r * (q + 1) + (xcd - r) * q) + off; }
        const int nig = WGM * nN, gid = wgid / nig, fm = gid * WGM, gsz = (nM - fm) < WGM ? (nM - fm) : WGM;
        u.pm = fm + ((wgid % nig) % gsz); u.pn = (wgid % nig) / gsz; u.ks = 0; return true;
    }
    __device__ __forceinline__ void a_ready(const Unit&) const {}
    __device__ __forceinline__ void done(const Unit&) const {}
};

struct Order2 {
    StaticOrder so; int lat;
    __host__ __device__ void init(int N, int G_, int c_, int lat_) { lat = lat_; so.init(lat_ ? 32768 : 36864, N, G_, c_); }
    __host__ __device__ bool next(int i, Unit& u) const { if (!so.next(i, u)) return false; if (lat) u.pm = (u.pm >> 3) * 9 + 1 + (u.pm & 7); return true; }
    __device__ __forceinline__ void a_ready(const Unit&) const {}
    __device__ __forceinline__ void done(const Unit&) const {}
};
struct CtxSplitOrder {
    int G, c;
    __host__ __device__ void init(int G_, int c_) { G = G_; c = c_; }
    __host__ __device__ bool next(int i, Unit& u) const { const long L = (long)i * G + c; if (L >= 256) return false; u.ks = (int)L & 3; u.pn = ((int)L >> 2) & 3; u.pm = ((int)L >> 4) * 9; return true; }
    __device__ __forceinline__ void a_ready(const Unit&) const {}
    __device__ __forceinline__ void done(const Unit&) const {}
};
__device__ __forceinline__ unsigned cvt_pk_bf16(float lo, float hi) { unsigned r; asm volatile("v_cvt_pk_bf16_f32 %0, %1, %2" : "=v"(r) : "v"(lo), "v"(hi)); return r; }

template <int ACT  > struct EpiBf16 {
    static constexpr bool PERM = true, AFTER_DRAIN = false;
    bf16_t* O; int ldc;
    __device__ __forceinline__ void operator()(const f32x4 (&acc)[2][2][4][2], const Unit& u, int wr, int wc, int fr, int fq) const {
        const int row0 = u.pm * BM + wr * 64 + fr; const int col0 = u.pn * BM + wc * 32 + 8 * fq;
#pragma unroll
        for (int ai = 0; ai < 2; ++ai)
#pragma unroll
            for (int m = 0; m < 4; ++m) { bf16_t* rowp = O + (size_t)(row0 + ai * HALF + m * 16) * ldc + col0;
#pragma unroll
                for (int bj = 0; bj < 2; ++bj) { f32x4 v0 = acc[ai][bj][m][0], v1 = acc[ai][bj][m][1];
                    if (ACT == 1) {
#pragma unroll
                        for (int e = 0; e < 4; ++e) { float a = fmaxf(v0[e], 0.f), b = fmaxf(v1[e], 0.f); v0[e] = a * a; v1[e] = b * b; } }
                    u32x4 w; w.x = cvt_pk_bf16(v0[0], v0[1]); w.y = cvt_pk_bf16(v0[2], v0[3]); w.z = cvt_pk_bf16(v1[0], v1[1]); w.w = cvt_pk_bf16(v1[2], v1[3]);
                    *(u32x4*)(rowp + bj * HALF) = w; } }
    }
};
struct EpiRes {
    static constexpr bool PERM = false, AFTER_DRAIN = false;
    float* Xl; float* Xc; const float* gates;
    const float* Xl_in; const float* Xc_in;
    __device__ __forceinline__ void operator()(const f32x4 (&acc)[2][2][4][2], const Unit& u, int wr, int wc, int fr, int fq) const {
        const int b = u.pm / 9, tt = u.pm - b * 9;
        const size_t toff = (tt == 0) ? ((size_t)(b * 256) << 10) : ((size_t)(b * 2048 + (tt - 1) * 256) << 10);
        float* base = ((tt == 0) ? Xc : Xl) + toff; const float* base_in = ((tt == 0) ? Xc_in : Xl_in) + toff;
        const float* g = gates + (size_t)((tt == 0) ? 16 : b) * 6144;
        const int col0 = u.pn * BM + wc * 32 + 4 * fq;
        float* rp0 = base + ((size_t)(wr * 64 + fr) << 10) + col0; const float* rq0 = base_in + ((size_t)(wr * 64 + fr) << 10) + col0;
#pragma unroll
        for (int bj = 0; bj < 2; ++bj)
#pragma unroll
            for (int n = 0; n < 2; ++n) { const f32x4 gvv = *(const f32x4*)(g + col0 + bj * HALF + n * 16);
#pragma unroll
                for (int ai = 0; ai < 2; ++ai) {
#pragma unroll
                    for (int m = 0; m < 4; ++m) { const size_t eo = (size_t)(ai * HALF + m * 16) * 1024 + bj * HALF + n * 16; f32x4 xv = *(const f32x4*)(rq0 + eo); xv = xv + gvv * acc[ai][bj][m][n]; *(f32x4*)(rp0 + eo) = xv; }
                    asm volatile("" ::: "memory"); } }
    }
};
struct EpiPart {
    static constexpr bool PERM = false, AFTER_DRAIN = false;
    float* part;
    __device__ __forceinline__ void operator()(const f32x4 (&acc)[2][2][4][2], const Unit& u, int wr, int wc, int fr, int fq) const {
        float* rp0 = part + (((size_t)u.ks * 4096 + (size_t)(u.pm / 9) * 256 + wr * 64 + fr) << 10) + u.pn * BM + wc * 32 + 4 * fq;
#pragma unroll
        for (int ai = 0; ai < 2; ++ai)
#pragma unroll
            for (int m = 0; m < 4; ++m)
#pragma unroll
                for (int bj = 0; bj < 2; ++bj)
#pragma unroll
                    for (int n = 0; n < 2; ++n) *(f32x4*)(rp0 + (size_t)(ai * HALF + m * 16) * 1024 + bj * HALF + n * 16) = acc[ai][bj][m][n];
    }
};
template <class Epi, class Sched, bool ALIGN_EPI = false, bool SP2 = false>
__device__ __forceinline__ void gemm_phase(PG8_LAS unsigned char* lds, const Gemm g, const Sched& S, const Epi& E, const int wvs) {
    const int tid = wvs * 64 + lane_id_fresh(); const int wid = __builtin_amdgcn_readfirstlane(tid >> 6), lane = tid & 63, wr = wid >> 2, wc = wid & 3, fr = lane & 15, fq = lane >> 4;
    const int K = g.ldk, nt = g.K / BK; const size_t sstep = (size_t)g.K * 2;
    unsigned voffA[2], voffB[2];
#pragma unroll
    for (int i = 0; i < 2; ++i) { int R, C; stage_rc(tid * 16 + i * 8192, R, C); const int Rb = Epi::PERM ? ((R & ~31) + perm32(R & 31)) : R;
        voffA[i] = (unsigned)(R * K + C) * 2u; voffB[i] = (unsigned)(Rb * K + C) * 2u; }
    const size_t kstep = (size_t)(BK * 2);
    const size_t hstep = (size_t)HALF * K * 2;
    const size_t tstep = 2 * hstep;
    const unsigned ldsw = (unsigned)wid * 1024u;
    const int aoff = lds_byte(wr * 64 + fr, fq * 8), boff = lds_byte(wc * 32 + fr, fq * 8);
#define PG8_SA(b, h) (((b) * 2 + (h)) * HTB)
#define PG8_SB(b, h) ((4 + (b) * 2 + (h)) * HTB)
#define PG8_STAGE(bufoff, gbase, voff) do { _Pragma("unroll") for (int _i = 0; _i < 2; ++_i) \
        __builtin_amdgcn_global_load_lds((const unsigned*)((const char*)(gbase) + (voff)[_i]), (PG8_LAS unsigned*)(lds + (bufoff) + ldsw + _i * 8192), 16, 0, 0); } while (0)
#define PG8_LDA(dst, b, h) do { _Pragma("unroll") for (int m = 0; m < 4; ++m) _Pragma("unroll") for (int k = 0; k < 2; ++k) dst[m][k] = *(const PG8_LAS bf16x8*)(lds + PG8_SA(b, h) + aoff + m * 2048 + k * 1024); } while (0)
#define PG8_LDB(dst, b, h) do { _Pragma("unroll") for (int n = 0; n < 2; ++n) _Pragma("unroll") for (int k = 0; k < 2; ++k) dst[n][k] = *(const PG8_LAS bf16x8*)(lds + PG8_SB(b, h) + boff + n * 2048 + k * 1024); } while (0)
#define PG8_MMA(ai, bj, At, Bt) do { __builtin_amdgcn_s_setprio(1); _Pragma("unroll") for (int m = 0; m < 4; ++m) _Pragma("unroll") for (int n = 0; n < 2; ++n) _Pragma("unroll") for (int k = 0; k < 2; ++k) \
        acc[ai][bj][m][n] = __builtin_amdgcn_mfma_f32_16x16x32_bf16(Bt[n][k], At[m][k], acc[ai][bj][m][n], 0, 0, 0); __builtin_amdgcn_s_setprio(0); } while (0)
#define PG8_WAIT_V(n) asm volatile("s_waitcnt vmcnt(" #n ")" ::: "memory")
#define PG8_WAIT_L(n) asm volatile("s_waitcnt lgkmcnt(" #n ")" ::: "memory")
#define PG8_BAR __builtin_amdgcn_s_barrier()
#define PG8_SCHED __builtin_amdgcn_sched_barrier(0)
    Unit cur, nxt; int ui = 0;
    if (!S.next(0, cur)) return;
    f32x4 acc[2][2][4][2];
#pragma unroll
    for (int a = 0; a < 2; ++a)
#pragma unroll
        for (int b = 0; b < 2; ++b)
#pragma unroll
            for (int m = 0; m < 4; ++m)
#pragma unroll
                for (int n = 0; n < 2; ++n) acc[a][b][m][n] = (f32x4){0.f, 0.f, 0.f, 0.f};
    bf16x8 At[4][2], B0[2][2], B1[2][2];
    const char* cA = (const char*)g.A + (size_t)cur.pm * tstep + (size_t)cur.ks * sstep; const char* cB = (const char*)g.Bt + (size_t)cur.pn * tstep + (size_t)cur.ks * sstep;
    S.a_ready(cur);
    if constexpr (SP2) {
        PG8_STAGE(PG8_SB(0, 0), cB, voffB); PG8_STAGE(PG8_SB(0, 1), cB + hstep, voffB); PG8_STAGE(PG8_SA(0, 0), cA, voffA); PG8_STAGE(PG8_SA(0, 1), cA + hstep, voffA);
        if (wr == 1) PG8_BAR;
        PG8_WAIT_V(2); PG8_BAR;
        PG8_STAGE(PG8_SB(1, 0), cB + kstep, voffB); PG8_STAGE(PG8_SA(1, 0), cA + kstep, voffA); PG8_STAGE(PG8_SB(1, 1), cB + hstep + kstep, voffB);
        PG8_WAIT_V(6); PG8_BAR;
    } else {
        PG8_STAGE(PG8_SB(0, 0), cB, voffB); PG8_STAGE(PG8_SA(0, 0), cA, voffA); PG8_STAGE(PG8_SB(0, 1), cB + hstep, voffB); PG8_STAGE(PG8_SA(0, 1), cA + hstep, voffA);
        if (wr == 1) PG8_BAR;
        PG8_WAIT_V(4); PG8_BAR;
        PG8_STAGE(PG8_SB(1, 0), cB + kstep, voffB); PG8_STAGE(PG8_SA(1, 0), cA + kstep, voffA); PG8_STAGE(PG8_SB(1, 1), cB + hstep + kstep, voffB);
        PG8_WAIT_V(6); PG8_BAR;
    }
    for (;;) {
        const bool has_next = S.next(ui + 1, nxt);
        const char* nA = has_next ? (const char*)g.A + (size_t)nxt.pm * tstep + (size_t)nxt.ks * sstep : cA; const char* nB = has_next ? (const char*)g.Bt + (size_t)nxt.pn * tstep + (size_t)nxt.ks * sstep : cB;
        for (int t = 0; t < nt; t += 2) {
            const bool last = (t == nt - 2);
            const char* a1 = cA + (size_t)(t + 1) * kstep;
            const char* a2 = last ? nA : cA + (size_t)(t + 2) * kstep; const char* b2 = last ? nB : cB + (size_t)(t + 2) * kstep;
            const char* a3 = a2 + kstep; const char* b3 = b2 + kstep;
            if (last && has_next) S.a_ready(nxt);
            if constexpr (SP2) {
            PG8_LDB(B0, 0, 0); PG8_LDB(B1, 0, 1); PG8_SCHED; PG8_LDA(At, 0, 0); PG8_STAGE(PG8_SA(1, 1), a1 + hstep, voffA);
            PG8_WAIT_V(8); PG8_WAIT_L(0); PG8_BAR; PG8_MMA(0, 0, At, B0); PG8_MMA(0, 1, At, B1); PG8_BAR; PG8_SCHED;
            PG8_LDA(At, 0, 1); PG8_STAGE(PG8_SB(0, 0), b2, voffB); PG8_STAGE(PG8_SB(0, 1), b2 + hstep, voffB); PG8_STAGE(PG8_SA(0, 0), a2, voffA);
            PG8_WAIT_V(8); PG8_WAIT_L(0); PG8_BAR; PG8_MMA(1, 0, At, B0); PG8_MMA(1, 1, At, B1); PG8_BAR; PG8_SCHED;
            PG8_LDB(B0, 1, 0); PG8_LDB(B1, 1, 1); PG8_SCHED; PG8_LDA(At, 1, 0); PG8_STAGE(PG8_SA(0, 1), a2 + hstep, voffA);
            PG8_WAIT_V(8); PG8_WAIT_L(0); PG8_BAR; PG8_MMA(0, 0, At, B0); PG8_MMA(0, 1, At, B1); PG8_BAR; PG8_SCHED;
            PG8_LDA(At, 1, 1); PG8_STAGE(PG8_SB(1, 0), b3, voffB); PG8_STAGE(PG8_SB(1, 1), b3 + hstep, voffB); PG8_STAGE(PG8_SA(1, 0), a3, voffA);
            PG8_WAIT_V(8); PG8_WAIT_L(0); PG8_BAR; PG8_MMA(1, 0, At, B0); PG8_MMA(1, 1, At, B1); PG8_BAR; PG8_SCHED;
            } else {
            PG8_LDB(B0, 0, 0); PG8_SCHED; PG8_LDA(At, 0, 0); PG8_STAGE(PG8_SA(1, 1), a1 + hstep, voffA);
            PG8_WAIT_L(8); PG8_BAR; PG8_WAIT_L(0); PG8_MMA(0, 0, At, B0); PG8_BAR; PG8_SCHED;
            PG8_LDB(B1, 0, 1); PG8_STAGE(PG8_SB(0, 0), b2, voffB);
            PG8_BAR; PG8_WAIT_L(0); PG8_MMA(0, 1, At, B1); PG8_BAR;
            PG8_LDA(At, 0, 1); PG8_STAGE(PG8_SA(0, 0), a2, voffA);
            PG8_BAR; PG8_WAIT_L(0); PG8_MMA(1, 0, At, B0); PG8_BAR; PG8_SCHED;
            PG8_STAGE(PG8_SB(0, 1), b2 + hstep, voffB);
            PG8_WAIT_V(6); PG8_BAR; PG8_MMA(1, 1, At, B1); PG8_BAR;
            PG8_LDB(B0, 1, 0); PG8_SCHED; PG8_LDA(At, 1, 0); PG8_STAGE(PG8_SA(0, 1), a2 + hstep, voffA);
            PG8_WAIT_L(8); PG8_BAR; PG8_WAIT_L(0); PG8_MMA(0, 0, At, B0); PG8_BAR; PG8_SCHED;
            PG8_LDB(B1, 1, 1); PG8_STAGE(PG8_SB(1, 0), b3, voffB);
            PG8_BAR; PG8_WAIT_L(0); PG8_MMA(0, 1, At, B1); PG8_BAR;
            PG8_LDA(At, 1, 1); PG8_STAGE(PG8_SA(1, 0), a3, voffA);
            PG8_BAR; PG8_WAIT_L(0); PG8_MMA(1, 0, At, B0); PG8_BAR; PG8_SCHED;
            PG8_STAGE(PG8_SB(1, 1), b3 + hstep, voffB);
            PG8_WAIT_V(6); PG8_BAR; PG8_MMA(1, 1, At, B1); PG8_BAR;
            }
        }
        if constexpr (ALIGN_EPI) { if (wr == 0) PG8_BAR; }
        if constexpr (!Epi::AFTER_DRAIN) { E(acc, cur, wr, wc, fr, fq); S.done(cur); }
        if (!has_next) break;
#pragma unroll
        for (int a = 0; a < 2; ++a)
#pragma unroll
            for (int b = 0; b < 2; ++b)
#pragma unroll
                for (int m = 0; m < 4; ++m)
#pragma unroll
                    for (int n = 0; n < 2; ++n) acc[a][b][m][n] = (f32x4){0.f, 0.f, 0.f, 0.f};
        cur = nxt; cA = nA; cB = nB; ++ui;
        if constexpr (ALIGN_EPI) { if (wr == 1) PG8_BAR; }
    }
    PG8_WAIT_V(0);
    if constexpr (!ALIGN_EPI) { if (wr == 0) PG8_BAR; }
    PG8_BAR;
    if constexpr (Epi::AFTER_DRAIN) { E.fused(acc, cur, wr, wc, fr, fq, lds, wid, lane); S.done(cur); }
#undef PG8_SA
#undef PG8_SB
#undef PG8_STAGE
#undef PG8_LDA
#undef PG8_LDB
#undef PG8_MMA
#undef PG8_WAIT_V
#undef PG8_WAIT_L
#undef PG8_BAR
#undef PG8_SCHED
}
}

constexpr int D = 1024, BATCH = 16, SEQ = 2048, CTX = 256, DEPTH = 4;
constexpr int TPB = CTX + SEQ;
constexpr int M = BATCH * TPB;
constexpr int DIN = 3088, NP = 3072, DFF = 4096;
constexpr int PC_DNQ = 0, PC_DNG = 768, PC_SQ = 1024, PC_SK = 1536, PC_SV = 1664, PC_HQ = 1792, PC_HF = 2048, PC_HI = 2560, PC_HG = 2816;
constexpr float EPS = 1e-6f;
constexpr size_t MiB = 1u << 20;
constexpr size_t WS_CTL = 0, WS_MODS = 1 * MiB, WS_ROPE = 3 * MiB, WS_LB = 3 * MiB + 512 * 1024, WS_AB = 4 * MiB;
constexpr size_t WS_WIN = 7 * MiB, WS_WOUT = 13 * MiB, WS_W1 = 15 * MiB, WS_W2 = 23 * MiB, WS_XC = 32 * MiB, WS_HY = 48 * MiB, WS_P = 120 * MiB;
constexpr size_t WS_OD = WS_P + 216 * MiB, WS_QKV = WS_P + 288 * MiB, WS_END = WS_QKV + 64 * MiB;
constexpr int LDS_BYTES = 147456;
constexpr int NWAVES = 8, NTHR = 512;

#define LAS __attribute__((address_space(3)))
typedef unsigned short bf16_t;
typedef float f32x4 __attribute__((ext_vector_type(4)));
typedef short bf16x8 __attribute__((ext_vector_type(8)));
typedef short s16x4 __attribute__((ext_vector_type(4)));
typedef unsigned u32x4 __attribute__((ext_vector_type(4)));
typedef unsigned u32x2 __attribute__((ext_vector_type(2)));

struct Params {
    const float *x, *c, *ctx, *c_ctx, *w_ada, *b_ada, *norm1, *norm2, *w_in, *dn_conv, *dn_A_log, *dn_dt_bias, *dn_norm, *swa_sink, *hg_lb, *hg_norm, *w_out, *w_ff1, *w_ff2, *norm_f;
    float* out; unsigned char* ws;
};

__device__ __forceinline__ float bflo(unsigned u) { return __uint_as_float(u << 16); }
__device__ __forceinline__ float bfhi(unsigned u) { return __uint_as_float(u & 0xffff0000u); }
__device__ __forceinline__ unsigned pk2(float lo, float hi) { return pg8::cvt_pk_bf16(lo, hi); }
__device__ __forceinline__ bf16_t bf1(float f) { unsigned u = __float_as_uint(f); u += 0x7fffu + ((u >> 16) & 1u); return (bf16_t)(u >> 16); }
__device__ __forceinline__ float siluf(float v) { return v / (1.f + __expf(-v)); }
__device__ __forceinline__ float sigmf(float v) { return 1.f / (1.f + __expf(-v)); }
__device__ __forceinline__ float wave_sum(float v) {
#pragma unroll
    for (int o = 1; o < 64; o <<= 1) v += __shfl_xor(v, o);
    return v;
}
template <int CTRL> __device__ __forceinline__ float dpp(float x) { return __builtin_bit_cast(float, __builtin_amdgcn_mov_dpp(__builtin_bit_cast(int, x), CTRL, 0xf, 0xf, true)); }
constexpr int XOR1 = 0xB1, XOR2 = 0x4E, XOR7 = 0x141;
__device__ __forceinline__ float sum8(float v) { v += dpp<XOR1>(v); v += dpp<XOR2>(v); v += dpp<XOR7>(v); return v; }
__device__ __forceinline__ float xrow16_max(float x) {
    auto s = __builtin_amdgcn_permlane16_swap(__float_as_uint(x), __float_as_uint(x), false, false);
    x = fmaxf(__uint_as_float(s[0]), __uint_as_float(s[1]));
    auto t = __builtin_amdgcn_permlane32_swap(__float_as_uint(x), __float_as_uint(x), false, false);
    return fmaxf(__uint_as_float(t[0]), __uint_as_float(t[1]));
}
__device__ __forceinline__ float xrow16_sum(float x) {
    auto s = __builtin_amdgcn_permlane16_swap(__float_as_uint(x), __float_as_uint(x), false, false);
    x = __uint_as_float(s[0]) + __uint_as_float(s[1]);
    auto t = __builtin_amdgcn_permlane32_swap(__float_as_uint(x), __float_as_uint(x), false, false);
    return __uint_as_float(t[0]) + __uint_as_float(t[1]);
}
__device__ __forceinline__ const float* xrow_c(const float* Xl, const float* Xc, int r) { const int b = r / TPB, t = r - b * TPB; return t < CTX ? Xc + ((size_t)(b * CTX + t) << 10) : Xl + ((size_t)(b * SEQ + t - CTX) << 10); }
__device__ __forceinline__ int cidx(int r) { const int b = r / TPB, t = r - b * TPB; return t < CTX ? 16 : b; }

__device__ __forceinline__ void phase_prologue(const Params& p, LAS unsigned char* lds, const int wvs) {
    const int tid = wvs * 64 + lane_id_fresh(); const int lane = tid & 63, w = tid >> 6;
    float* mods = (float*)(p.ws + WS_MODS);
    LAS float* sc = (LAS float*)lds;
    LAS float* red = (LAS float*)(lds + 81920);
    for (int idx = tid; idx < 17 * 1024; idx += NTHR) { const int ci = idx >> 10, k = idx & 1023; const float v = ci < 16 ? p.c[ci * 1024 + k] : p.c_ctx[k]; sc[k * 20 + ci] = v / (1.f + expf(-v)); }
    __syncthreads();
    for (int it = blockIdx.x; it < DEPTH * 96; it += gridDim.x) {
        const int l = it / 96, cgp = it - l * 96, col = cgp * 64 + lane;
        float acc[17];
#pragma unroll
        for (int i = 0; i < 17; ++i) acc[i] = 0.f;
        const float* wp = p.w_ada + ((size_t)l * 1024 + w * 128) * 6144 + col;
#pragma unroll 16
        for (int kk = 0; kk < 128; ++kk) {
            const float wv = wp[(size_t)kk * 6144];
            const LAS f32x4* s4 = (const LAS f32x4*)(sc + (w * 128 + kk) * 20);
            const f32x4 s0 = s4[0], s1 = s4[1], s2 = s4[2], s3 = s4[3]; const float s16 = sc[(w * 128 + kk) * 20 + 16];
#pragma unroll
            for (int e = 0; e < 4; ++e) { acc[e] += wv * s0[e]; acc[4 + e] += wv * s1[e]; acc[8 + e] += wv * s2[e]; acc[12 + e] += wv * s3[e]; }
            acc[16] += wv * s16;
        }
#pragma unroll
        for (int i = 0; i < 17; ++i) red[(w * 17 + i) * 64 + lane] = acc[i];
        __syncthreads();
        for (int idx = tid; idx < 17 * 64; idx += NTHR) { const int i = idx >> 6, cl = idx & 63; float s = 0.f;
#pragma unroll
            for (int ww = 0; ww < 8; ++ww) s += red[(ww * 17 + i) * 64 + cl];
            mods[((size_t)l * 17 + i) * 6144 + cgp * 64 + cl] = s + p.b_ada[l * 6144 + cgp * 64 + cl]; }
        __syncthreads();
    }
    const int gt = blockIdx.x * NTHR + tid, GT = gridDim.x * NTHR;
    { float* rc = (float*)(p.ws + WS_ROPE); float* rs = rc + 2048 * 32;
      for (int idx = gt; idx < 2048 * 32; idx += GT) { const int t = idx >> 5, d = idx & 31; const float pos = (float)(d < 16 ? (t >> 6) : (t & 63));
          const float inv = expf(-(float)(d & 15) * (9.210340371976184f / 16.f)); const float ang = pos * inv; rc[idx] = cosf(ang); rs[idx] = sinf(ang); } }
    { float* LB = (float*)(p.ws + WS_LB);
      for (int idx = gt; idx < 2 * 256; idx += GT) { const int d = idx >> 8, cc = idx & 255; float v[DEPTH]; float mx = -1e30f;
#pragma unroll
          for (int l = 0; l < DEPTH; ++l) { v[l] = p.hg_lb[(d * DEPTH + l) * 256 + cc]; mx = fmaxf(mx, v[l]); }
          float s = 0.f;
#pragma unroll
          for (int l = 0; l < DEPTH; ++l) { v[l] = expf(v[l] - mx); s += v[l]; }
          float cum = 0.f;
#pragma unroll
          for (int l = 0; l < DEPTH; ++l) { if (l > 0) cum += v[l] / s; LB[(d * DEPTH + l) * 256 + cc] = cum; } } }
}

__device__ __forceinline__ void transpose_item(const float* W, int K, int ldw, int scol0, bf16_t* WT, int n0, int k0, LAS float* scr, int lane) {
#pragma unroll 8
    for (int i = 0; i < 32; ++i) { const int kk = 2 * i + (lane >> 5); scr[kk * 33 + (lane & 31)] = W[(size_t)(k0 + kk) * ldw + scol0 + (lane & 31)]; }
    asm volatile("s_waitcnt lgkmcnt(0)" ::: "memory");
    const int c = lane & 7;
#pragma unroll
    for (int j = 0; j < 4; ++j) { const int n = (lane >> 3) + 8 * j; const LAS float* s = scr + (8 * c) * 33 + n;
        u32x4 o; o.x = pk2(s[0 * 33], s[1 * 33]); o.y = pk2(s[2 * 33], s[3 * 33]); o.z = pk2(s[4 * 33], s[5 * 33]); o.w = pk2(s[6 * 33], s[7 * 33]);
        *(u32x4*)(WT + (size_t)(n0 + n) * K + k0 + 8 * c) = o; }
    asm volatile("s_waitcnt lgkmcnt(0)" ::: "memory");
}

template <bool FIRST> __device__ __forceinline__ void phase_norm(const Params& p, int l, LAS unsigned char* lds, const int wvs) {
    const int tid = wvs * 64 + lane_id_fresh(); const int lane = tid & 63, w = tid >> 6;
    const int gw = blockIdx.x * NWAVES + w, NGW = gridDim.x * NWAVES;
    const float* mods = (const float*)(p.ws + WS_MODS);
    constexpr int WST = 1032;
    LAS bf16_t* wab = (LAS bf16_t*)lds;
    if (FIRST) {
        LAS float* scr = (LAS float*)(lds + 65536 + w * 8704);
        constexpr int I_IN = 16 * 96, I_OUT = 16 * 32, I_1 = 16 * 128, I_2 = 64 * 32;
        for (int it = gw; it < I_IN + I_OUT + I_1 + I_2; it += NGW) {
            int r = it;
            if (r < I_IN) { const int kb = r / 96, nb = r - kb * 96; const int n0 = nb * 32; transpose_item(p.w_in + (size_t)l * D * DIN, D, DIN, n0 + (n0 >= 1024 ? 16 : 0), (bf16_t*)(p.ws + WS_WIN), n0, kb * 64, scr, lane); continue; }
            r -= I_IN;
            if (r < I_OUT) { const int kb = r / 32, nb = r - kb * 32; transpose_item(p.w_out + (size_t)l * D * D, D, D, nb * 32, (bf16_t*)(p.ws + WS_WOUT), nb * 32, kb * 64, scr, lane); continue; }
            r -= I_OUT;
            if (r < I_1) { const int kb = r / 128, nb = r - kb * 128; transpose_item(p.w_ff1 + (size_t)l * D * DFF, D, DFF, nb * 32, (bf16_t*)(p.ws + WS_W1), nb * 32, kb * 64, scr, lane); continue; }
            r -= I_1;
            { const int kb = r / 32, nb = r - kb * 32; transpose_item(p.w_ff2 + (size_t)l * DFF * D, DFF, D, nb * 32, (bf16_t*)(p.ws + WS_W2), nb * 32, kb * 64, scr, lane); }
        }
        const float* wi = p.w_in + (size_t)l * D * DIN + 1024;
        for (int idx = tid; idx < 4096; idx += NTHR) { const int k = idx >> 2, j4 = (idx & 3) * 4; const f32x4 v = *(const f32x4*)(wi + (size_t)k * DIN + j4);
#pragma unroll
            for (int e = 0; e < 4; ++e) wab[(j4 + e) * WST + k] = bf1(v[e]); }
        __syncthreads();
    }
    const float* nw = (FIRST ? p.norm1 : p.norm2) + l * D;
    bf16_t* H = (bf16_t*)(p.ws + WS_HY);
    float* AB = (float*)(p.ws + WS_AB);
    float* Xc = (float*)(p.ws + WS_XC);
    const float* part = (const float*)(p.ws + WS_QKV);
    const bool fix = FIRST ? (l > 0) : (l < DEPTH - 1);
    const float* fgate = mods + ((size_t)(FIRST ? (l > 0 ? l - 1 : 0) : l) * 17 + 16) * 6144 + (FIRST ? 5 : 2) * 1024;
    int nrows = 0;
    for (int r = gw; r < M; r += NGW) {
        ++nrows;
        if (!FIRST && l == DEPTH - 1 && (r % TPB) < CTX) continue;
        const f32x4* xr = (const f32x4*)((FIRST && l == 0) ? xrow_c(p.x, p.ctx, r) : xrow_c(p.out, Xc, r)) + lane;
        f32x4 v[4]; float ss = 0.f;
        const int rb = r / TPB, rt = r - rb * TPB;
        if (fix && rt < CTX) {
            const f32x4* xin = (const f32x4*)((!FIRST && l == 0) ? p.ctx + ((size_t)(rb * CTX + rt) << 10) : Xc + ((size_t)(rb * CTX + rt) << 10)) + lane;
            const f32x4* pr = (const f32x4*)(part + ((size_t)(rb * CTX + rt) << 10)) + lane; f32x4* xo = (f32x4*)(Xc + ((size_t)(rb * CTX + rt) << 10)) + lane;
#pragma unroll
            for (int j = 0; j < 4; ++j) { const f32x4 gq = *(const f32x4*)(fgate + 4 * (lane + 64 * j));
                const f32x4 s4 = (pr[64 * j] + pr[64 * j + 1048576]) + (pr[64 * j + 2 * 1048576] + pr[64 * j + 3 * 1048576]);
                v[j] = xin[64 * j] + gq * s4; xo[64 * j] = v[j]; }
        } else {
#pragma unroll
            for (int j = 0; j < 4; ++j) v[j] = xr[64 * j];
        }
#pragma unroll
        for (int j = 0; j < 4; ++j) ss += (v[j][0] * v[j][0] + v[j][1] * v[j][1]) + (v[j][2] * v[j][2] + v[j][3] * v[j][3]);
        const float rstd = rsqrtf(wave_sum(ss) * (1.f / D) + EPS);
        const float* md = mods + ((size_t)l * 17 + cidx(r)) * 6144 + (FIRST ? 0 : 3 * 1024);
        u32x2* hp = (u32x2*)(H + (size_t)r * D) + lane;
#pragma unroll
        for (int j = 0; j < 4; ++j) { const int k = 4 * (lane + 64 * j);
            const f32x4 g = *(const f32x4*)(nw + k), sh = *(const f32x4*)(md + k), sl = *(const f32x4*)(md + 1024 + k);
            f32x4 h;
#pragma unroll
            for (int e = 0; e < 4; ++e) h[e] = (v[j][e] * rstd * g[e]) * (1.f + sl[e]) + sh[e];
            u32x2 o2; o2.x = pk2(h[0], h[1]); o2.y = pk2(h[2], h[3]); hp[64 * j] = o2;
        }
    }
    if (FIRST) {
        asm volatile("s_waitcnt vmcnt(0)" ::: "memory");
        const int fr = lane & 15, fq = lane >> 4;
        for (int b0 = 0; b0 < nrows; b0 += 16) {
            const int kr = b0 + fr; const bool ok = kr < nrows; const bf16_t* hp = H + (size_t)(gw + (ok ? kr : 0) * NGW) * D + fq * 8;
            f32x4 c = (f32x4){0.f, 0.f, 0.f, 0.f};
#pragma unroll 8
            for (int ks = 0; ks < 32; ++ks) { u32x4 av = *(const u32x4*)(hp + ks * 32); if (!ok) av = (u32x4){0u, 0u, 0u, 0u};
                const bf16x8 bv = *(const LAS bf16x8*)(wab + fr * WST + ks * 32 + fq * 8);
                c = __builtin_amdgcn_mfma_f32_16x16x32_bf16(__builtin_bit_cast(bf16x8, av), bv, c, 0, 0, 0); }
#pragma unroll
            for (int j = 0; j < 4; ++j) { const int k2 = b0 + fq * 4 + j; if (k2 < nrows) AB[(size_t)(gw + k2 * NGW) * 16 + fr] = c[j]; }
        }
    }
}

constexpr int SST = 68;
constexpr int HST = 72;
__device__ __forceinline__ bf16x8 ldA_perm(const LAS bf16_t* base, int row, int s, int fq) {
    const LAS bf16_t* ap = base + row * HST + s * 32 + fq * 4; const u32x2 lo = *(const LAS u32x2*)ap, hi = *(const LAS u32x2*)(ap + 16);
    u32x4 av; av[0] = lo[0]; av[1] = lo[1]; av[2] = hi[0]; av[3] = hi[1]; return __builtin_bit_cast(bf16x8, av);
}
__device__ __forceinline__ bf16x8 packB(const f32x4& a, const f32x4& b) {
    u32x4 pb; pb[0] = bf1(a[0]) | ((unsigned)bf1(a[1]) << 16); pb[1] = bf1(a[2]) | ((unsigned)bf1(a[3]) << 16); pb[2] = bf1(b[0]) | ((unsigned)bf1(b[1]) << 16); pb[3] = bf1(b[2]) | ((unsigned)bf1(b[3]) << 16);
    return __builtin_bit_cast(bf16x8, pb);
}
__device__ __forceinline__ void phase_dnprep(const Params& p, int l, LAS unsigned char* lds, const int wvs) {
    const int tid = wvs * 64 + lane_id_fresh();
    constexpr int RST = 200;
    LAS float* qs = (LAS float*)lds; LAS float* ks = qs + 64 * SST; LAS float* vs = ks + 64 * SST; LAS bf16_t* RAW = (LAS bf16_t*)(vs + 64 * SST);
    const bf16_t* P = (const bf16_t*)(p.ws + WS_P);
    bf16_t* QKV = (bf16_t*)(p.ws + WS_QKV);
    const float* cw = p.dn_conv + (size_t)l * 5 * 768;
    const int c4 = tid % 48, tg = tid / 48;
    LAS float* cdst = ((c4 >> 4) == 0 ? qs : ((c4 >> 4) == 1 ? ks : vs)) + (c4 & 15) * 4;
    for (int it = blockIdx.x; it < BATCH * 36 * 4; it += gridDim.x) {
        const int h = it & 3, bc = it >> 2, b = bc / 36, nc = bc - b * 36;
        const int base = b * TPB + nc * 64, lo = b * TPB + (nc < 4 ? 0 : CTX), hi = b * TPB + (nc < 4 ? CTX : TPB);
        float wc[5][4];
        { const int ch = c4 * 4, pcol = (ch >> 6) * 256 + h * 64 + (ch & 63);
#pragma unroll
          for (int t = 0; t < 5; ++t) { const f32x4 w4 = *(const f32x4*)(cw + t * 768 + pcol); wc[t][0] = w4[0]; wc[t][1] = w4[1]; wc[t][2] = w4[2]; wc[t][3] = w4[3]; } }
#pragma unroll
        for (int k = 0; k < 4; ++k) { const int q = tid + NTHR * k; if (q < 68 * 24) { const int rr = q / 24, pc = q - rr * 24; const int r = base - 2 + rr;
            const u32x4 v = (r >= lo && r < hi) ? *(const u32x4*)(P + (size_t)r * NP + (pc >> 3) * 256 + h * 64 + (pc & 7) * 8) : (u32x4){0u, 0u, 0u, 0u};
            *(LAS u32x4*)(RAW + rr * RST + pc * 8) = v; } }
        __syncthreads();
        if (tid < 480) {
#pragma unroll
            for (int m = 0; m < 7; ++m) { const int pp = tg + 10 * m; if (pp < 64) { float a0 = 0.f, a1 = 0.f, a2 = 0.f, a3 = 0.f;
#pragma unroll
                for (int t = 0; t < 5; ++t) { const u32x2 raw = *(const LAS u32x2*)(RAW + (pp + t) * RST + c4 * 4);
                    a0 += bflo(raw[0]) * wc[t][0]; a1 += bfhi(raw[0]) * wc[t][1]; a2 += bflo(raw[1]) * wc[t][2]; a3 += bfhi(raw[1]) * wc[t][3]; }
                f32x4 o; o[0] = a0 / (1.f + __expf(-a0)); o[1] = a1 / (1.f + __expf(-a1)); o[2] = a2 / (1.f + __expf(-a2)); o[3] = a3 / (1.f + __expf(-a3));
                *(LAS f32x4*)(cdst + pp * SST) = o; } } }
        __syncthreads();
        { const int t = tid >> 3, part = tid & 7;
          const f32x4 q0 = *(const LAS f32x4*)(qs + t * SST + part * 8), q1 = *(const LAS f32x4*)(qs + t * SST + part * 8 + 4);
          const f32x4 k0 = *(const LAS f32x4*)(ks + t * SST + part * 8), k1 = *(const LAS f32x4*)(ks + t * SST + part * 8 + 4);
          const f32x4 v0 = *(const LAS f32x4*)(vs + t * SST + part * 8), v1 = *(const LAS f32x4*)(vs + t * SST + part * 8 + 4);
          float sq = (q0[0] * q0[0] + q0[1] * q0[1]) + (q0[2] * q0[2] + q0[3] * q0[3]) + (q1[0] * q1[0] + q1[1] * q1[1]) + (q1[2] * q1[2] + q1[3] * q1[3]);
          float sk = (k0[0] * k0[0] + k0[1] * k0[1]) + (k0[2] * k0[2] + k0[3] * k0[3]) + (k1[0] * k1[0] + k1[1] * k1[1]) + (k1[2] * k1[2] + k1[3] * k1[3]);
          sq = sum8(sq); sk = sum8(sk);
          const float rq = rsqrtf(sq + EPS) * 0.125f, rk = rsqrtf(sk + EPS);
          u32x4 qo, ko, vo;
          qo[0] = pk2(q0[0] * rq, q0[1] * rq); qo[1] = pk2(q0[2] * rq, q0[3] * rq); qo[2] = pk2(q1[0] * rq, q1[1] * rq); qo[3] = pk2(q1[2] * rq, q1[3] * rq);
          ko[0] = pk2(k0[0] * rk, k0[1] * rk); ko[1] = pk2(k0[2] * rk, k0[3] * rk); ko[2] = pk2(k1[0] * rk, k1[1] * rk); ko[3] = pk2(k1[2] * rk, k1[3] * rk);
          vo[0] = pk2(v0[0], v0[1]); vo[1] = pk2(v0[2], v0[3]); vo[2] = pk2(v1[0], v1[1]); vo[3] = pk2(v1[2], v1[3]);
          bf16_t* dst = QKV + ((size_t)(base + t) * 4 + h) * 192 + part * 8;
          *(u32x4*)dst = qo; *(u32x4*)(dst + 64) = ko; *(u32x4*)(dst + 128) = vo; }
        __syncthreads();
    }
    { bf16_t* Pw = (bf16_t*)(p.ws + WS_P); const float* rc = (const float*)(p.ws + WS_ROPE); const float* rs = rc + 2048 * 32;
      const int gt = blockIdx.x * NTHR + tid, GT = gridDim.x * NTHR;
      for (int idx = gt; idx < BATCH * SEQ * 8; idx += GT) { const int rl = idx >> 3, rem = idx & 7, kh = rem >> 2, g = rem & 3;
          const int bb = rl >> 11, t = rl & 2047;
          bf16_t* pp = Pw + (size_t)(bb * TPB + CTX + t) * NP + PC_SK + kh * 64 + g * 8;
          const u32x4 r1 = *(const u32x4*)pp, r2 = *(const u32x4*)(pp + 32);
          const f32x4 c0 = *(const f32x4*)(rc + t * 32 + g * 8), c1 = *(const f32x4*)(rc + t * 32 + g * 8 + 4), s0 = *(const f32x4*)(rs + t * 32 + g * 8), s1 = *(const f32x4*)(rs + t * 32 + g * 8 + 4);
          u32x4 o1, o2;
#pragma unroll
          for (int e = 0; e < 4; ++e) { const float xa = bflo(r1[e]), xb = bfhi(r1[e]), ya = bflo(r2[e]), yb = bfhi(r2[e]);
              const float ca = e < 2 ? c0[2 * e] : c1[2 * e - 4], cb = e < 2 ? c0[2 * e + 1] : c1[2 * e - 3], sa = e < 2 ? s0[2 * e] : s1[2 * e - 4], sb = e < 2 ? s0[2 * e + 1] : s1[2 * e - 3];
              o1[e] = pk2(xa * ca - ya * sa, xb * cb - yb * sb); o2[e] = pk2(xa * sa + ya * ca, xb * sb + yb * cb); }
          *(u32x4*)pp = o1; *(u32x4*)(pp + 32) = o2; } }
}

__device__ __forceinline__ void dn_seq(const Params& p, int l, int s, LAS unsigned char* lds, const int wvs) {
    const int tid = wvs * 64 + lane_id_fresh(); const int lane = tid & 63;
    const int b = s >> 3, h = (s >> 1) & 3, d = s & 1;
    constexpr int TILEB = 64 * HST * 2, BUFB = 6 * TILEB + 4 * 16 * 24 * 2 + 1024;
    LAS bf16_t* OB = (LAS bf16_t*)(lds + 2 * BUFB); LAS float* LF = (LAS float*)(lds + 2 * BUFB + TILEB);
    const bf16_t* QKV = (const bf16_t*)(p.ws + WS_QKV);
    const float* AB = (const float*)(p.ws + WS_AB);
    bf16_t* OD = (bf16_t*)(p.ws + WS_OD) + (size_t)d * M * 512 + h * 64;
    const float nA = -expf(p.dn_A_log[(l * 2 + d) * 4 + h]); const float dtb = p.dn_dt_bias[(l * 2 + d) * 4 + h];
    const int fr = lane & 15, fq = lane >> 4, V = wvs & 3;
    const bool isP = wvs < 4;
    const f32x4 zero4 = (f32x4){0.f, 0.f, 0.f, 0.f};
    u32x4 praw[6]; float pa = 0.f, pb_ = 0.f;
    f32x4 Sacc[4], R[4], QS[4];
#pragma unroll
    for (int T = 0; T < 4; ++T) { Sacc[T] = zero4; R[T] = zero4; QS[T] = zero4; }
#define DN_BASE(ci) (b * TPB + ((d == 0) ? (ci) : ((ci) < 4 ? 3 - (ci) : 39 - (ci))) * 64)
#define DN_LOADRAW(ci) do { const int base_ = DN_BASE(ci); _Pragma("unroll") for (int k = 0; k < 6; ++k) { const int q = tid + 256 * k; const int rr = q / 24, pc = q - rr * 24; \
            praw[k] = *(const u32x4*)(QKV + ((size_t)(base_ + rr) * 4 + h) * 192 + pc * 8); } \
        if (wvs == 0) { const int r_ = base_ + (d ? 63 - lane : lane); pa = AB[(size_t)r_ * 16 + d * 4 + h]; pb_ = AB[(size_t)r_ * 16 + 8 + d * 4 + h]; } } while (0)
#define DN_S1(buf) do { LAS bf16_t* QH_ = (LAS bf16_t*)(lds + (buf) * BUFB); LAS float* SCL_ = (LAS float*)(lds + (buf) * BUFB + 6 * TILEB + 4 * 16 * 24 * 2); \
        _Pragma("unroll") for (int k = 0; k < 6; ++k) { const int q = tid + 256 * k; const int rr = q / 24, pc = q - rr * 24; const int t = d ? 63 - rr : rr; \
            *(LAS u32x4*)(QH_ + (pc >> 3) * 64 * HST + t * HST + (pc & 7) * 8) = praw[k]; } \
        if (wvs == 0) { const float xs = pa + dtb; const float sp = xs > 15.f ? xs : (xs < -15.f ? __expf(xs) : __logf(1.f + __expf(xs))); float x = nA * sp; \
            _Pragma("unroll") for (int o = 1; o < 64; o <<= 1) { const float y = __shfl_up(x, o); if (lane >= o) x += y; } \
            SCL_[lane] = x; SCL_[64 + lane] = __expf(x); SCL_[128 + lane] = __builtin_amdgcn_rcpf(1.f + __expf(-pb_)); if (lane == 63) { SCL_[192] = x; SCL_[193] = __expf(x); } } } while (0)
    if (isP) { DN_LOADRAW(0); DN_S1(0); }
    __syncthreads();
    for (int ci = -1; ci < 36; ++ci) {
        const int cur = ci & 1, nxt = cur ^ 1;
        LAS bf16_t* QH = (LAS bf16_t*)(lds + cur * BUFB); LAS bf16_t* KH = QH + 64 * HST; LAS bf16_t* VB = KH + 64 * HST; LAS bf16_t* KTT = VB + 64 * HST; LAS bf16_t* LM = KTT + 64 * HST; LAS bf16_t* SCM = LM + 64 * HST;
        LAS bf16_t* DI = SCM + 64 * HST; LAS float* GC = (LAS float*)(DI + 4 * 16 * 24); LAS float* EG = GC + 64; LAS float* BETA = EG + 64; LAS float* GL = BETA + 64;
        if (isP) { if (ci >= 0 && ci + 1 < 36) DN_S1(nxt); }
        else if (ci >= 0) {
            if (ci > 0) { const int basep = DN_BASE(ci - 1); const int u = tid - 256;
#pragma unroll
                for (int it = 0; it < 8; ++it) { const int idx = u + 256 * it; const int i = idx >> 5, c2 = (idx & 31) * 2; const int row = basep + (d ? 63 - i : i);
                    *(unsigned*)(OD + (size_t)row * 512 + c2) = *(const LAS unsigned*)(OB + i * HST + c2); } }
            bf16x8 Bs[2];
#pragma unroll
            for (int s2 = 0; s2 < 2; ++s2) Bs[s2] = packB(Sacc[2 * s2], Sacc[2 * s2 + 1]);
#pragma unroll
            for (int I = 0; I < 4; ++I) { f32x4 c = zero4, cq = zero4;
#pragma unroll
                for (int s2 = 0; s2 < 2; ++s2) { c = __builtin_amdgcn_mfma_f32_16x16x32_bf16(ldA_perm(KH, I * 16 + fr, s2, fq), Bs[s2], c, 0, 0, 0); cq = __builtin_amdgcn_mfma_f32_16x16x32_bf16(ldA_perm(QH, I * 16 + fr, s2, fq), Bs[s2], cq, 0, 0, 0); }
#pragma unroll
                for (int r = 0; r < 4; ++r) { const int i = I * 16 + fq * 4 + r; R[I][r] = BETA[i] * (bflo((unsigned)VB[i * HST + V * 16 + fr]) - EG[i] * c[r]); QS[I][r] = EG[i] * cq[r]; } }
        }
        __syncthreads();
        if (isP) {
            const int pb2 = (ci < 0) ? 0 : nxt;
            if (ci + 1 < 36) {
                LAS bf16_t* QHn = (LAS bf16_t*)(lds + pb2 * BUFB); LAS bf16_t* KHn = QHn + 64 * HST; LAS bf16_t* KTTn = KHn + 2 * 64 * HST; LAS bf16_t* LMn = KTTn + 64 * HST; LAS bf16_t* SCMn = LMn + 64 * HST;
                LAS bf16_t* DIn = SCMn + 64 * HST; LAS float* GCn = (LAS float*)(DIn + 4 * 16 * 24); LAS float* BETAn = GCn + 128; LAS float* GLn = GCn + 192;
                { const int t = tid >> 2, part = tid & 3; const float ekt = __expf(GLn[0] - GCn[t]);
#pragma unroll
                  for (int hh = 0; hh < 2; ++hh) { const u32x4 kr = *(const LAS u32x4*)(KHn + t * HST + part * 16 + hh * 8);
#pragma unroll
                      for (int e = 0; e < 4; ++e) { KTTn[(part * 16 + hh * 8 + 2 * e) * HST + t] = bf1(bflo(kr[e]) * ekt); KTTn[(part * 16 + hh * 8 + 2 * e + 1) * HST + t] = bf1(bfhi(kr[e]) * ekt); } } }
                { const int I = wvs;
                  float gci[4], bti[4], gcj[4];
#pragma unroll
                  for (int r = 0; r < 4; ++r) { gci[r] = GCn[I * 16 + fq * 4 + r]; bti[r] = BETAn[I * 16 + fq * 4 + r]; gcj[r] = GCn[r * 16 + fr]; }
#pragma unroll
                  for (int J = 0; J < 4; ++J) { f32x4 ckk = zero4, cqk = zero4;
                      if (J <= I) {
#pragma unroll
                          for (int kk = 0; kk < 2; ++kk) { const bf16x8 Ak = *(const LAS bf16x8*)(KHn + (I * 16 + fr) * HST + kk * 32 + fq * 8), Aq = *(const LAS bf16x8*)(QHn + (I * 16 + fr) * HST + kk * 32 + fq * 8);
                              const bf16x8 B = *(const LAS bf16x8*)(KHn + (J * 16 + fr) * HST + kk * 32 + fq * 8);
                              ckk = __builtin_amdgcn_mfma_f32_16x16x32_bf16(Ak, B, ckk, 0, 0, 0); cqk = __builtin_amdgcn_mfma_f32_16x16x32_bf16(Aq, B, cqk, 0, 0, 0); } }
                      const int j = J * 16 + fr; const float gj = gcj[J];
#pragma unroll
                      for (int r = 0; r < 4; ++r) { const int i = I * 16 + fq * 4 + r; const float dec = __expf(fminf(gci[r] - gj, 0.f));
                          const float lvv = bti[r] * ckk[r] * dec, svv = cqk[r] * dec;
                          const float lv = j < i ? lvv : 0.f, sv = j <= i ? svv : 0.f;
                          LMn[i * HST + j] = bf1(lv); SCMn[i * HST + j] = bf1(sv); if (I == J) LF[(I * 16 + fq * 4 + r) * 20 + fr] = lv; } }
                  asm volatile("s_waitcnt lgkmcnt(0)" ::: "memory");
                  { const int c = lane & 15; float x[16];
#pragma unroll
                    for (int i = 0; i < 16; ++i) { float acc = (i == c) ? 1.f : 0.f;
#pragma unroll
                        for (int j4 = 0; j4 < (i + 3) / 4; ++j4) { const f32x4 Lr = *(const LAS f32x4*)(LF + (I * 16 + i) * 20 + j4 * 4);
#pragma unroll
                            for (int e = 0; e < 4; ++e) if (j4 * 4 + e < i) acc -= Lr[e] * x[j4 * 4 + e]; }
                        x[i] = acc; }
                    if (lane < 16) {
#pragma unroll
                        for (int i = 0; i < 16; ++i) DIn[(I * 16 + i) * 24 + c] = bf1(x[i]); } } }
                if (ci + 2 < 36) DN_LOADRAW(ci + 2);
            }
        } else if (ci >= 0) {
            bf16x8 Bx0, Bx1;
            { bf16x8 AD[4];
#pragma unroll
              for (int I = 0; I < 4; ++I) { const u32x2 lo = *(const LAS u32x2*)(DI + (I * 16 + fr) * 24 + fq * 4); u32x4 av; av[0] = lo[0]; av[1] = lo[1]; av[2] = 0u; av[3] = 0u; AD[I] = __builtin_bit_cast(bf16x8, av); }
              const f32x4 X0 = __builtin_amdgcn_mfma_f32_16x16x32_bf16(AD[0], packB(R[0], zero4), zero4, 0, 0, 0);
              f32x4 T1 = __builtin_amdgcn_mfma_f32_16x16x32_bf16(ldA_perm(LM, 16 + fr, 0, fq), packB(X0, zero4), zero4, 0, 0, 0);
              const f32x4 X1 = __builtin_amdgcn_mfma_f32_16x16x32_bf16(AD[1], packB(R[1] - T1, zero4), zero4, 0, 0, 0);
              Bx0 = packB(X0, X1);
              f32x4 T2 = __builtin_amdgcn_mfma_f32_16x16x32_bf16(ldA_perm(LM, 32 + fr, 0, fq), Bx0, zero4, 0, 0, 0);
              const f32x4 X2 = __builtin_amdgcn_mfma_f32_16x16x32_bf16(AD[2], packB(R[2] - T2, zero4), zero4, 0, 0, 0);
              f32x4 T3 = __builtin_amdgcn_mfma_f32_16x16x32_bf16(ldA_perm(LM, 48 + fr, 0, fq), Bx0, zero4, 0, 0, 0);
              T3 = __builtin_amdgcn_mfma_f32_16x16x32_bf16(ldA_perm(LM, 48 + fr, 1, fq), packB(X2, zero4), T3, 0, 0, 0);
              const f32x4 X3 = __builtin_amdgcn_mfma_f32_16x16x32_bf16(AD[3], packB(R[3] - T3, zero4), zero4, 0, 0, 0);
              Bx1 = packB(X2, X3); }
#pragma unroll
            for (int I = 0; I < 4; ++I) { f32x4 c = QS[I];
                c = __builtin_amdgcn_mfma_f32_16x16x32_bf16(ldA_perm(SCM, I * 16 + fr, 0, fq), Bx0, c, 0, 0, 0);
                c = __builtin_amdgcn_mfma_f32_16x16x32_bf16(ldA_perm(SCM, I * 16 + fr, 1, fq), Bx1, c, 0, 0, 0);
#pragma unroll
                for (int r = 0; r < 4; ++r) OB[(I * 16 + fq * 4 + r) * HST + V * 16 + fr] = bf1(c[r]); }
            { const float egl = GL[1];
#pragma unroll
              for (int T = 0; T < 4; ++T) { f32x4 c = Sacc[T] * egl;
                  c = __builtin_amdgcn_mfma_f32_16x16x32_bf16(ldA_perm(KTT, T * 16 + fr, 0, fq), Bx0, c, 0, 0, 0);
                  c = __builtin_amdgcn_mfma_f32_16x16x32_bf16(ldA_perm(KTT, T * 16 + fr, 1, fq), Bx1, c, 0, 0, 0);
                  Sacc[T] = c; } }
        }
        __syncthreads();
    }
    if (!isP) { const int basep = DN_BASE(35); const int u = tid - 256;
#pragma unroll
        for (int it = 0; it < 8; ++it) { const int idx = u + 256 * it; const int i = idx >> 5, c2 = (idx & 31) * 2; const int row = basep + (d ? 63 - i : i);
            *(unsigned*)(OD + (size_t)row * 512 + c2) = *(const LAS unsigned*)(OB + i * HST + c2); } }
    __syncthreads();
#undef DN_BASE
#undef DN_LOADRAW
#undef DN_S1
}

__device__ __forceinline__ void hg_seq(const Params& p, int l, int s, LAS unsigned char* lds, const int wvs) {
    const int tid = wvs * 64 + lane_id_fresh(); const int lane = tid & 63;
    const int b = s >> 3, h = (s >> 1) & 3, d = s & 1;
    constexpr int BUFB = 5 * 64 * HST * 2;
    LAS bf16_t* SC = (LAS bf16_t*)(lds + 2 * BUFB); LAS bf16_t* OB = SC + 64 * HST;
    LAS float* GS = (LAS float*)(OB + 64 * HST); LAS float* EBL = GS + 256;
    const bf16_t* P = (const bf16_t*)(p.ws + WS_P);
    bf16_t* OD = (bf16_t*)(p.ws + WS_OD) + (size_t)d * M * 512 + 256 + h * 64;
    const bool isA = wvs < 4;
    const int kx = tid & 63, g = wvs & 3;
    const float lb = ((const float*)(p.ws + WS_LB))[(d * DEPTH + l) * 256 + h * 64 + kx];
    const int fr = lane & 15, fq = lane >> 4, V = wvs & 3;
    f32x4 Sacc[4];
#pragma unroll
    for (int T = 0; T < 4; ++T) Sacc[T] = (f32x4){0.f, 0.f, 0.f, 0.f};
    unsigned short rq[16], rz[16], rv[16];
    float qv[16], kv[16], bc[16];
#define HG_BASE(ci) (b * TPB + ((d == 0) ? (ci) : ((ci) < 4 ? 3 - (ci) : 39 - (ci))) * 64)
#define HG_LOADRAW(ci) do { const int base_ = HG_BASE(ci); _Pragma("unroll") for (int e = 0; e < 16; ++e) { const int t = g * 16 + e; const int pp = d ? 63 - t : t; const bf16_t* rp = P + (size_t)(base_ + pp) * NP + h * 64 + kx; \
        rq[e] = rp[PC_HQ]; rz[e] = rp[PC_HF + d * 256]; rv[e] = rp[PC_HI]; } } while (0)
#define HG_A1(buf) do { LAS bf16_t* VT_ = (LAS bf16_t*)(lds + (buf) * BUFB) + 4 * 64 * HST; float run = 0.f; \
        _Pragma("unroll") for (int e = 0; e < 16; ++e) { const float z = bflo(rz[e]); const float sg = __builtin_amdgcn_rcpf(1.f + __expf(-z)); const float f = lb + (1.f - lb) * sg; \
            run += __logf(f); bc[e] = run; kv[e] = (1.f - lb) * (1.f - sg); qv[e] = bflo(rq[e]); VT_[kx * HST + g * 16 + e] = rv[e]; } \
        GS[g * 64 + kx] = run; } while (0)
#define HG_A2(buf) do { LAS bf16_t* QT_ = (LAS bf16_t*)(lds + (buf) * BUFB); LAS bf16_t* KT_ = QT_ + 64 * HST; LAS bf16_t* QP_ = KT_ + 64 * HST; LAS bf16_t* KTT_ = QP_ + 64 * HST; \
        const float g0 = GS[kx], g1 = GS[64 + kx], g2 = GS[128 + kx], g3 = GS[192 + kx]; const float mid = g0 + g1, bl = (g0 + g1) + (g2 + g3); \
        const float off = (g > 0 ? g0 : 0.f) + (g > 1 ? g1 : 0.f) + (g > 2 ? g2 : 0.f); \
        if (g == 3) EBL[(buf) * 64 + kx] = __expf(bl); \
        _Pragma("unroll") for (int e = 0; e < 16; ++e) { const int t = g * 16 + e; const float bce = bc[e] + off; const float E = fminf(fmaxf(bce - mid, -80.f), 80.f); \
            QT_[t * HST + kx] = bf1(qv[e] * __expf(E)); KT_[t * HST + kx] = bf1(kv[e] * __expf(-E)); \
            QP_[t * HST + kx] = bf1(qv[e] * __expf(bce)); KTT_[kx * HST + t] = bf1(kv[e] * __expf(bl - bce)); } } while (0)
    if (isA) { HG_LOADRAW(0); HG_A1(0); }
    __syncthreads();
    if (isA) { HG_A2(0); HG_LOADRAW(1); }
    __syncthreads();
    for (int ci = 0; ci < 36; ++ci) {
        const int cur = ci & 1, nxt = cur ^ 1;
        LAS bf16_t* QT = (LAS bf16_t*)(lds + cur * BUFB); LAS bf16_t* KT = QT + 64 * HST; LAS bf16_t* QP = KT + 64 * HST; LAS bf16_t* KTT = QP + 64 * HST; LAS bf16_t* VT = KTT + 64 * HST;
        if (isA) { if (ci + 1 < 36) HG_A1(nxt); }
        else {
            if (ci > 0) { const int basep = HG_BASE(ci - 1); const int u = tid - 256;
#pragma unroll
                for (int it = 0; it < 8; ++it) { const int idx = u + 256 * it; const int i = idx >> 5, c2 = (idx & 31) * 2; const int row = basep + (d ? 63 - i : i);
                    *(unsigned*)(OD + (size_t)row * 512 + c2) = *(const LAS unsigned*)(OB + i * HST + c2); } }
            { const int I = V;
#pragma unroll
              for (int J = 0; J < 4; ++J) { f32x4 c = (f32x4){0.f, 0.f, 0.f, 0.f};
                  if (J <= I) {
#pragma unroll
                      for (int kk = 0; kk < 2; ++kk) { const bf16x8 A = *(const LAS bf16x8*)(QT + (I * 16 + fr) * HST + kk * 32 + fq * 8); const bf16x8 B = *(const LAS bf16x8*)(KT + (J * 16 + fr) * HST + kk * 32 + fq * 8);
                          c = __builtin_amdgcn_mfma_f32_16x16x32_bf16(A, B, c, 0, 0, 0); } }
#pragma unroll
                  for (int r = 0; r < 4; ++r) { const int i = I * 16 + fq * 4 + r, j = J * 16 + fr; SC[i * HST + j] = bf1(j <= i ? c[r] : 0.f); } } }
        }
        __syncthreads();
        if (isA) { if (ci + 1 < 36) { HG_A2(nxt); if (ci + 2 < 36) HG_LOADRAW(ci + 2); } }
        else {
            bf16x8 Bs[2], Bv[2];
#pragma unroll
            for (int s2 = 0; s2 < 2; ++s2) { Bs[s2] = packB(Sacc[2 * s2], Sacc[2 * s2 + 1]); Bv[s2] = *(const LAS bf16x8*)(VT + (V * 16 + fr) * HST + s2 * 32 + fq * 8); }
#pragma unroll
            for (int I = 0; I < 4; ++I) { f32x4 o = (f32x4){0.f, 0.f, 0.f, 0.f};
#pragma unroll
                for (int s2 = 0; s2 < 2; ++s2) o = __builtin_amdgcn_mfma_f32_16x16x32_bf16(ldA_perm(QP, I * 16 + fr, s2, fq), Bs[s2], o, 0, 0, 0);
#pragma unroll
                for (int s2 = 0; s2 < 2; ++s2) { const bf16x8 A = *(const LAS bf16x8*)(SC + (I * 16 + fr) * HST + s2 * 32 + fq * 8); o = __builtin_amdgcn_mfma_f32_16x16x32_bf16(A, Bv[s2], o, 0, 0, 0); }
#pragma unroll
                for (int r = 0; r < 4; ++r) OB[(I * 16 + fq * 4 + r) * HST + V * 16 + fr] = bf1(o[r]); }
#pragma unroll
            for (int T = 0; T < 4; ++T) { f32x4 c;
#pragma unroll
                for (int r = 0; r < 4; ++r) c[r] = Sacc[T][r] * EBL[cur * 64 + T * 16 + fq * 4 + r];
#pragma unroll
                for (int s2 = 0; s2 < 2; ++s2) { const bf16x8 A = *(const LAS bf16x8*)(KTT + (T * 16 + fr) * HST + s2 * 32 + fq * 8); c = __builtin_amdgcn_mfma_f32_16x16x32_bf16(A, Bv[s2], c, 0, 0, 0); }
                Sacc[T] = c; }
        }
        __syncthreads();
    }
    if (!isA) { const int basep = HG_BASE(35); const int u = tid - 256;
#pragma unroll
        for (int it = 0; it < 8; ++it) { const int idx = u + 256 * it; const int i = idx >> 5, c2 = (idx & 31) * 2; const int row = basep + (d ? 63 - i : i);
            *(unsigned*)(OD + (size_t)row * 512 + c2) = *(const LAS unsigned*)(OB + i * HST + c2); } }
    __syncthreads();
#undef HG_BASE
#undef HG_LOADRAW
#undef HG_A1
#undef HG_A2
}

constexpr int KST = 72, VST = 136;
__device__ __forceinline__ void swa_unit(const Params& p, int l, int unit, LAS unsigned char* lds, const int wvs) {
    const int tid = wvs * 64 + lane_id_fresh(); const int lane = tid & 63;
    int b, kvh, qb;
    if (unit < 512) { b = unit >> 5; kvh = (unit >> 4) & 1; qb = 2 + (unit & 15); } else { const int v = unit - 512; b = v >> 2; kvh = (v >> 1) & 1; qb = v & 1; }
    const bool qctx = qb < 2;
    const bf16_t* P = (const bf16_t*)(p.ws + WS_P);
    const float* rc = (const float*)(p.ws + WS_ROPE); const float* rs = rc + 2048 * 32;
    bf16_t* Y = (bf16_t*)(p.ws + WS_HY);
    LAS bf16_t* Ks = (LAS bf16_t*)lds; LAS bf16_t* Vt = Ks + 128 * KST;
    const int hh = wvs >> 1, qhalf = wvs & 1, head = kvh * 4 + hh;
    const int fr = lane & 15, fq = lane >> 4;
    const int rowq0 = b * TPB + qb * 128 + qhalf * 64;
    const int f0 = (!qctx && qb == 2) ? 1 : 0, nl = qctx ? 0 : 3 - f0 - (qb == 17 ? 1 : 0), nkb = nl + 2;
#define SWA_BLK(j) ((j) < nl ? qb - 1 + f0 + (j) : (j) - nl)
#define SWA_REL(j) ((j) < nl ? f0 + (j) - 1 : 0)
    bf16x8 qf[4][2];
#pragma unroll
    for (int qt = 0; qt < 4; ++qt) {
        const int row = rowq0 + qt * 16 + fr; const bf16_t* qp = P + (size_t)row * NP + PC_SQ + head * 64 + fq * 8;
        const u32x4 r1 = *(const u32x4*)qp, r2 = *(const u32x4*)(qp + 32);
        float a1[8], a2[8];
#pragma unroll
        for (int e = 0; e < 4; ++e) { a1[2 * e] = bflo(r1[e]); a1[2 * e + 1] = bfhi(r1[e]); a2[2 * e] = bflo(r2[e]); a2[2 * e + 1] = bfhi(r2[e]); }
        if (!qctx) { const int t = (qb - 2) * 128 + qhalf * 64 + qt * 16 + fr; const float* cp = rc + t * 32 + fq * 8; const float* sp = rs + t * 32 + fq * 8;
#pragma unroll
            for (int e = 0; e < 8; ++e) { const float cs = cp[e], sn = sp[e]; const float o1 = a1[e] * cs - a2[e] * sn, o2 = a1[e] * sn + a2[e] * cs; a1[e] = o1; a2[e] = o2; } }
        u32x4 o1, o2;
#pragma unroll
        for (int e = 0; e < 4; ++e) { o1[e] = pk2(a1[2 * e] * 0.125f, a1[2 * e + 1] * 0.125f); o2[e] = pk2(a2[2 * e] * 0.125f, a2[2 * e + 1] * 0.125f); }
        qf[qt][0] = __builtin_bit_cast(bf16x8, o1); qf[qt][1] = __builtin_bit_cast(bf16x8, o2);
    }
    const int skey = tid >> 2, sg = tid & 3;
    const float sink = p.swa_sink[l * 8 + head];
    float mrun[4], lrun[4]; f32x4 O[4][4];
#pragma unroll
    for (int qt = 0; qt < 4; ++qt) { mrun[qt] = sink; lrun[qt] = 1.f;
#pragma unroll
        for (int dv = 0; dv < 4; ++dv) O[qt][dv] = (f32x4){0.f, 0.f, 0.f, 0.f}; }
    for (int j = 0; j < nkb; ++j) {
        const int rel = SWA_REL(j);
        u32x4 kreg[2], vreg[2];
        { const int rowk0 = b * TPB + SWA_BLK(j) * 128; const bf16_t* kp = P + (size_t)(rowk0 + skey) * NP + PC_SK + kvh * 64 + sg * 8;
          kreg[0] = *(const u32x4*)kp; kreg[1] = *(const u32x4*)(kp + 32);
#pragma unroll
          for (int it = 0; it < 2; ++it) { const int idx = tid + NTHR * it; vreg[it] = *(const u32x4*)(P + (size_t)(rowk0 + (idx >> 3)) * NP + PC_SV + kvh * 64 + (idx & 7) * 8); } }
        *(LAS u32x4*)(Ks + skey * KST + sg * 8) = kreg[0]; *(LAS u32x4*)(Ks + skey * KST + 32 + sg * 8) = kreg[1];
#pragma unroll
        for (int it = 0; it < 2; ++it) { const int idx = tid + NTHR * it; const int vk = idx >> 3, vg = idx & 7;
#pragma unroll
            for (int e = 0; e < 4; ++e) { Vt[(vg * 8 + 2 * e) * VST + vk] = (bf16_t)(vreg[it][e] & 0xffffu); Vt[(vg * 8 + 2 * e + 1) * VST + vk] = (bf16_t)(vreg[it][e] >> 16); } }
        __syncthreads();
#pragma unroll
        for (int qp2 = 0; qp2 < 2; ++qp2) {
            f32x4 Sx[2][8];
#pragma unroll
            for (int kt = 0; kt < 8; ++kt) { Sx[0][kt] = (f32x4){0.f, 0.f, 0.f, 0.f}; Sx[1][kt] = (f32x4){0.f, 0.f, 0.f, 0.f};
#pragma unroll
                for (int kk = 0; kk < 2; ++kk) { const bf16x8 A = *(const LAS bf16x8*)(Ks + (kt * 16 + fr) * KST + kk * 32 + fq * 8);
                    Sx[0][kt] = __builtin_amdgcn_mfma_f32_16x16x32_bf16(A, qf[2 * qp2][kk], Sx[0][kt], 0, 0, 0);
                    Sx[1][kt] = __builtin_amdgcn_mfma_f32_16x16x32_bf16(A, qf[2 * qp2 + 1][kk], Sx[1][kt], 0, 0, 0); } }
#pragma unroll
            for (int u = 0; u < 2; ++u) { const int qt = 2 * qp2 + u;
                if (rel != 0) { int qi = qhalf * 64 + qt * 16 + fr; asm volatile("" : "+v"(qi));
#pragma unroll
                    for (int kt = 0; kt < 8; ++kt)
#pragma unroll
                        for (int jx = 0; jx < 4; ++jx) { const int kx = kt * 16 + fq * 4 + jx; const bool ok = rel < 0 ? (kx >= qi) : (kx <= qi); if (!ok) Sx[u][kt][jx] = -1e30f; } }
                float mx = -1e30f;
#pragma unroll
                for (int kt = 0; kt < 8; ++kt) mx = fmaxf(mx, fmaxf(fmaxf(Sx[u][kt][0], Sx[u][kt][1]), fmaxf(Sx[u][kt][2], Sx[u][kt][3])));
                mx = xrow16_max(mx);
                const float mnew = fmaxf(mrun[qt], mx); const float alpha = __expf(mrun[qt] - mnew); mrun[qt] = mnew;
                float rsum = 0.f;
#pragma unroll
                for (int kt = 0; kt < 8; ++kt)
#pragma unroll
                    for (int jx = 0; jx < 4; ++jx) { const float e = __expf(Sx[u][kt][jx] - mnew); Sx[u][kt][jx] = e; rsum += e; }
                rsum = xrow16_sum(rsum);
                lrun[qt] = lrun[qt] * alpha + rsum;
#pragma unroll
                for (int dv = 0; dv < 4; ++dv) O[qt][dv] = O[qt][dv] * alpha; }
#pragma unroll
            for (int ks2 = 0; ks2 < 4; ++ks2) {
                bf16x8 Bp[2];
#pragma unroll
                for (int u = 0; u < 2; ++u) { u32x4 pb; pb[0] = pk2(Sx[u][2 * ks2][0], Sx[u][2 * ks2][1]); pb[1] = pk2(Sx[u][2 * ks2][2], Sx[u][2 * ks2][3]); pb[2] = pk2(Sx[u][2 * ks2 + 1][0], Sx[u][2 * ks2 + 1][1]); pb[3] = pk2(Sx[u][2 * ks2 + 1][2], Sx[u][2 * ks2 + 1][3]); Bp[u] = __builtin_bit_cast(bf16x8, pb); }
#pragma unroll
                for (int dv = 0; dv < 4; ++dv) { const LAS bf16_t* vp = Vt + (dv * 16 + fr) * VST + ks2 * 32 + fq * 4;
                    const u32x2 lo = *(const LAS u32x2*)vp, hi = *(const LAS u32x2*)(vp + 16);
                    u32x4 av; av[0] = lo[0]; av[1] = lo[1]; av[2] = hi[0]; av[3] = hi[1]; const bf16x8 Av = __builtin_bit_cast(bf16x8, av);
                    O[2 * qp2][dv] = __builtin_amdgcn_mfma_f32_16x16x32_bf16(Av, Bp[0], O[2 * qp2][dv], 0, 0, 0);
                    O[2 * qp2 + 1][dv] = __builtin_amdgcn_mfma_f32_16x16x32_bf16(Av, Bp[1], O[2 * qp2 + 1][dv], 0, 0, 0); }
            }
        }
        __syncthreads();
    }
#undef SWA_BLK
#undef SWA_REL
#pragma unroll
    for (int qt = 0; qt < 4; ++qt) { const float inv = 1.f / lrun[qt]; const int row = rowq0 + qt * 16 + fr;
#pragma unroll
        for (int dv = 0; dv < 4; ++dv) { u32x2 o2; o2[0] = pk2(O[qt][dv][0] * inv, O[qt][dv][1] * inv); o2[1] = pk2(O[qt][dv][2] * inv, O[qt][dv][3] * inv);
            *(u32x2*)(Y + (size_t)row * D + 256 + head * 64 + dv * 16 + fq * 4) = o2; } }
}

__device__ __forceinline__ void phase_mixers(const Params& p, int l, LAS unsigned char* lds, const int wvs) {
    for (int s = blockIdx.x; s < 256; s += gridDim.x) { if (s < 128) dn_seq(p, l, s, lds, wvs); else hg_seq(p, l, s - 128, lds, wvs); }
    unsigned* ctr = (unsigned*)(p.ws + WS_CTL) + 64 * (1 + l);
    LAS int* su = (LAS int*)(lds + 140 * 1024);
    for (;;) {
        __syncthreads();
        if (wvs == 0 && lane_id_fresh() == 0) su[0] = (int)atomicAdd(ctr, 1u);
        __syncthreads();
        const int unit = su[0];
        if (unit >= (l == DEPTH - 1 ? 512 : 576)) break;
        swa_unit(p, l, unit, lds, wvs);
    }
}

__device__ __forceinline__ void phase_finalize(const Params& p, int l, const int wvs) {
    const int tid = wvs * 64 + lane_id_fresh(); const int lane = tid & 63, w = tid >> 6;
    const int gw = blockIdx.x * NWAVES + w, NGW = gridDim.x * NWAVES;
    const bf16_t* P = (const bf16_t*)(p.ws + WS_P);
    const bf16_t* OD0 = (const bf16_t*)(p.ws + WS_OD); const bf16_t* OD1 = OD0 + (size_t)M * 512;
    bf16_t* Y = (bf16_t*)(p.ws + WS_HY);
    const int seg = lane >> 3, d0 = (lane & 7) * 8;
    const int hd = seg & 3; const bool isdn = seg < 4;
    const float* gain = (isdn ? p.dn_norm : p.hg_norm) + l * 64 + d0;
    const f32x4 g0 = *(const f32x4*)gain, g1 = *(const f32x4*)(gain + 4);
    const int ocol = (isdn ? 0 : 256) + hd * 64 + d0, gcol = (isdn ? PC_DNG : PC_HG) + hd * 64 + d0, ycol = (isdn ? 0 : 768) + hd * 64 + d0;
    for (int r = gw; r < M; r += NGW) {
        const u32x4 a = *(const u32x4*)(OD0 + (size_t)r * 512 + ocol), bq = *(const u32x4*)(OD1 + (size_t)r * 512 + ocol), gt = *(const u32x4*)(P + (size_t)r * NP + gcol);
        float o[8]; float ss = 0.f;
#pragma unroll
        for (int e = 0; e < 4; ++e) { o[2 * e] = bflo(a[e]) + bflo(bq[e]); o[2 * e + 1] = bfhi(a[e]) + bfhi(bq[e]); ss += o[2 * e] * o[2 * e] + o[2 * e + 1] * o[2 * e + 1]; }
        ss = sum8(ss);
        const float rms = rsqrtf(ss * (1.f / 64.f) + EPS);
        u32x4 y;
#pragma unroll
        for (int e = 0; e < 4; ++e) { const float ga = bflo(gt[e]), gb = bfhi(gt[e]);
            const float ge0 = e < 2 ? g0[2 * e] : g1[2 * e - 4], ge1 = e < 2 ? g0[2 * e + 1] : g1[2 * e - 3];
            y[e] = pk2(o[2 * e] * rms * ge0 * siluf(ga), o[2 * e + 1] * rms * ge1 * siluf(gb)); }
        *(u32x4*)(Y + (size_t)r * D + ycol) = y;
    }
}

__device__ __forceinline__ void phase_final(const Params& p, const int wvs) {
    const int tid = wvs * 64 + lane_id_fresh(); const int lane = tid & 63, w = tid >> 6;
    const int gw = blockIdx.x * NWAVES + w, NGW = gridDim.x * NWAVES;
    for (int r = gw; r < BATCH * SEQ; r += NGW) {
        f32x4* xr = (f32x4*)(p.out + ((size_t)r << 10)) + lane;
        f32x4 v[4]; float ss = 0.f;
#pragma unroll
        for (int j = 0; j < 4; ++j) { v[j] = xr[64 * j]; ss += (v[j][0] * v[j][0] + v[j][1] * v[j][1]) + (v[j][2] * v[j][2] + v[j][3] * v[j][3]); }
        const float rstd = rsqrtf(wave_sum(ss) * (1.f / D) + EPS);
#pragma unroll
        for (int j = 0; j < 4; ++j) { const f32x4 g = *(const f32x4*)(p.norm_f + 4 * (lane + 64 * j)); xr[64 * j] = v[j] * rstd * g; }
    }
}

#define XB_TMO      128
#define XB_XCNT(j)  (256  + 64 * (j))
#define XB_XSUB(j)  (1280 + 64 * (j))
#define XB_XGEN(j)  (2304 + 64 * (j))
#define XB_TOP      3328
#define XB_TOPGEN   3392
#define XCD_BAR_WORDS 3456
#define XB_SPIN_CAP (1u << 18)

__device__ __forceinline__ unsigned xb_ld(unsigned* p)              { return __hip_atomic_load(p, __ATOMIC_RELAXED, __HIP_MEMORY_SCOPE_AGENT); }
__device__ __forceinline__ unsigned xb_add(unsigned* p, unsigned v) { return __hip_atomic_fetch_add(p, v, __ATOMIC_RELAXED, __HIP_MEMORY_SCOPE_AGENT); }
__device__ __forceinline__ unsigned xb_xcc_id() { return (unsigned)__builtin_amdgcn_s_getreg((3 << 11) | 20) & 0xFu; }
#define XB_SPIN(cond, bar) do { unsigned _sp = 0; while (cond) { __builtin_amdgcn_s_sleep(1); \
    if ((++_sp & 255u) == 0u) { if (xb_ld(&(bar)[XB_TMO])) break; if (_sp > XB_SPIN_CAP) { atomicAdd(&(bar)[XB_TMO], 1u); break; } } } } while (0)

struct XcdBarrier {
    unsigned* bar; unsigned x;
    volatile LAS unsigned* st;
};

__device__ __forceinline__ XcdBarrier xcd_barrier_post(unsigned* bar, volatile LAS unsigned* st) {
    XcdBarrier b; b.bar = bar; b.x = xb_xcc_id(); b.st = st;
    if (threadIdx.x == 0) (void)xb_add(&bar[XB_XCNT(b.x)], 1u);
    return b;
}
__device__ __forceinline__ void xcd_barrier_complete(unsigned* bar, unsigned x, unsigned& nloc, unsigned& nx) {
    const unsigned G = gridDim.x * gridDim.y * gridDim.z;
    unsigned sum, cnt, mine, sp = 0u;
    for (;;) {
        sum = 0u; cnt = 0u; mine = 0u;
#pragma unroll
        for (unsigned j = 0; j < 16; ++j) { const unsigned c = xb_ld(&bar[XB_XCNT(j)]); sum += c; cnt += (c > 0u) ? 1u : 0u; mine = (j == x) ? c : mine; }
        if (sum == G) break;
        __builtin_amdgcn_s_sleep(1);
        if ((++sp & 255u) == 0u) { if (xb_ld(&bar[XB_TMO])) break; if (sp > XB_SPIN_CAP) { atomicAdd(&bar[XB_TMO], 1u); break; } }
    }
    nloc = mine > 0u ? mine : 1u; nx = cnt > 0u ? cnt : 1u;
}

__device__ __forceinline__ void xcd_barrier(const XcdBarrier& b, const int wvs) {
    asm volatile("s_waitcnt vmcnt(0)" ::: "memory");
    __syncthreads();
    if (wvs == 0 && lane_id_fresh() == 0) {
        unsigned* bar = b.bar;
        __builtin_amdgcn_s_waitcnt(0);
        unsigned nloc = b.st[0], nx = b.st[1];
        if (nloc == 0u) { xcd_barrier_complete(bar, b.x, nloc, nx); b.st[0] = nloc; b.st[1] = nx; }
        const unsigned old = xb_add(&bar[XB_XSUB(b.x)], 1u);
        const unsigned gen = old / nloc;
        if (old + 1u == (gen + 1u) * nloc) {
            __builtin_amdgcn_fence(__ATOMIC_RELEASE, "agent");
            asm volatile("s_waitcnt vmcnt(0)" ::: "memory");
            const unsigned og = xb_add(&bar[XB_TOP], 1u);
            const unsigned tg = og / nx;
            if (og + 1u == (tg + 1u) * nx) xb_add(&bar[XB_TOPGEN], 1u);
            else XB_SPIN(xb_ld(&bar[XB_TOPGEN]) == tg, bar);
            __builtin_amdgcn_fence(__ATOMIC_ACQUIRE, "agent");
            xb_add(&bar[XB_XGEN(b.x)], 1u);
            asm volatile("s_waitcnt vmcnt(0)" ::: "memory");
        } else {
            XB_SPIN(xb_ld(&bar[XB_XGEN(b.x)]) == gen, bar);
            __builtin_amdgcn_fence(__ATOMIC_ACQUIRE, "agent");
            asm volatile("s_waitcnt vmcnt(0)" ::: "memory");
        }
    }
    __syncthreads();
}

__device__ __forceinline__ void gsync(cg::grid_group& grid) {
    asm volatile("s_waitcnt vmcnt(0) lgkmcnt(0)" ::: "memory");
    grid.sync();
    __builtin_amdgcn_fence(__ATOMIC_ACQUIRE, "agent");
    asm volatile("s_waitcnt vmcnt(0)" ::: "memory");
}
__global__ void __launch_bounds__(NTHR, 2) fwd_megakernel(Params p) {
    extern __shared__ __attribute__((aligned(16))) unsigned char lds_raw[];
    LAS unsigned char* lds = (LAS unsigned char*)lds_raw;
    cg::grid_group grid = cg::this_grid();
    const int G = gridDim.x, c = blockIdx.x;
    const int wvs = __builtin_amdgcn_readfirstlane((int)(threadIdx.x >> 6));
    { volatile LAS unsigned* st0 = (volatile LAS unsigned*)(lds + 143360 + 64); if (threadIdx.x < 2) st0[threadIdx.x] = 0u; }
    __syncthreads();
    const XcdBarrier xbar = xcd_barrier_post((unsigned*)(p.ws + WS_CTL) + 4096, (volatile LAS unsigned*)(lds + 143360 + 64));
    phase_prologue(p, lds, wvs);
    if (p.ws == nullptr) gsync(grid);
    xcd_barrier(xbar, wvs);
    const float* mods = (const float*)(p.ws + WS_MODS);
    float* Xc = (float*)(p.ws + WS_XC);
    bf16_t* HY = (bf16_t*)(p.ws + WS_HY); bf16_t* PB = (bf16_t*)(p.ws + WS_P);
    for (int l = 0; l < DEPTH; ++l) {
        const int lastl = (l == DEPTH - 1) ? 1 : 0;
        phase_norm<true>(p, l, lds, wvs);
        xcd_barrier(xbar, wvs);
        { pg8::Gemm g{HY, (const bf16_t*)(p.ws + WS_WIN), M, NP, D, D}; pg8::StaticOrder S; S.init(M, NP, G, c); pg8::EpiBf16<0> E{PB, NP};
          pg8::gemm_phase<pg8::EpiBf16<0>, pg8::StaticOrder, true, true>(lds, g, S, E, wvs); }
        xcd_barrier(xbar, wvs);
        phase_dnprep(p, l, lds, wvs);
        xcd_barrier(xbar, wvs);
        phase_mixers(p, l, lds, wvs);
        xcd_barrier(xbar, wvs);
        phase_finalize(p, l, wvs);
        xcd_barrier(xbar, wvs);
        { pg8::Gemm g{HY, (const bf16_t*)(p.ws + WS_WOUT), M, D, D, D}; pg8::Order2 S; S.init(D, G, c, 1); pg8::EpiRes E{p.out, Xc, mods + ((size_t)l * 17 * 6 + 2) * 1024, l == 0 ? p.x : (const float*)p.out, l == 0 ? p.ctx : (const float*)Xc};
          pg8::gemm_phase<pg8::EpiRes, pg8::Order2, true, true>(lds, g, S, E, wvs); }
        if (!lastl) { pg8::Gemm g{HY, (const bf16_t*)(p.ws + WS_WOUT), M, D, D / 4, D}; pg8::CtxSplitOrder S; S.init(G, c); pg8::EpiPart E{(float*)(p.ws + WS_QKV)};
          pg8::gemm_phase<pg8::EpiPart, pg8::CtxSplitOrder, false, true>(lds, g, S, E, wvs); }
        xcd_barrier(xbar, wvs);
        phase_norm<false>(p, l, lds, wvs);
        xcd_barrier(xbar, wvs);
        { pg8::Gemm g{HY, (const bf16_t*)(p.ws + WS_W1), M, DFF, D, D}; pg8::Order2 S; S.init(DFF, G, c, lastl); pg8::EpiBf16<1> E{PB, DFF};
          pg8::gemm_phase<pg8::EpiBf16<1>, pg8::Order2, true, true>(lds, g, S, E, wvs); }
        xcd_barrier(xbar, wvs);
        { pg8::Gemm g{PB, (const bf16_t*)(p.ws + WS_W2), M, D, DFF, DFF}; pg8::Order2 S; S.init(D, G, c, 1); pg8::EpiRes E{p.out, Xc, mods + ((size_t)l * 17 * 6 + 5) * 1024, (const float*)p.out, (const float*)Xc};
          pg8::gemm_phase<pg8::EpiRes, pg8::Order2, true, true>(lds, g, S, E, wvs); }
        if (!lastl) { pg8::Gemm g{PB, (const bf16_t*)(p.ws + WS_W2), M, D, DFF / 4, DFF}; pg8::CtxSplitOrder S; S.init(G, c); pg8::EpiPart E{(float*)(p.ws + WS_QKV)};
          pg8::gemm_phase<pg8::EpiPart, pg8::CtxSplitOrder, false, true>(lds, g, S, E, wvs); }
        xcd_barrier(xbar, wvs);
    }
    phase_final(p, wvs);
}

extern "C" void kernel_launch(void* const* d_in, const int* in_sizes, int n_in, void* d_out, int out_size, void* d_ws, size_t ws_size, hipStream_t stream) {
    static int grid = 0;
    if (grid == 0) {
        if (n_in != 20 || ws_size < WS_END) { fprintf(stderr, "kernel_launch: need 20 inputs and >= %zu bytes of workspace (got %d, %zu)\n", (size_t)WS_END, n_in, ws_size); grid = -1; return; }
        int dev = 0, cus = 0, per_cu = 0;
        hipGetDevice(&dev); hipDeviceGetAttribute(&cus, hipDeviceAttributeMultiprocessorCount, dev);
        if (hipFuncSetAttribute((const void*)fwd_megakernel, hipFuncAttributeMaxDynamicSharedMemorySize, LDS_BYTES) != hipSuccess) { fprintf(stderr, "kernel_launch: hipFuncSetAttribute failed\n"); grid = -1; return; }
        if (hipOccupancyMaxActiveBlocksPerMultiprocessor(&per_cu, (const void*)fwd_megakernel, NTHR, LDS_BYTES) != hipSuccess || per_cu < 1) { fprintf(stderr, "kernel_launch: occupancy query says %d blocks/CU\n", per_cu); per_cu = 1; }
        (void)hipGetLastError();
        grid = cus;
    }
    if (grid < 0) return;
    hipMemsetAsync((char*)d_ws + WS_CTL, 0, 65536, stream);
    Params p{};
    const float** pp = (const float**)&p;
    for (int i = 0; i < 20; ++i) pp[i] = (const float*)d_in[i];
    p.out = (float*)d_out; p.ws = (unsigned char*)d_ws;
    void* args[] = {&p};
    hipError_t e = hipLaunchCooperativeKernel((const void*)fwd_megakernel, dim3(grid), dim3(NTHR), args, LDS_BYTES, stream);
    if (e != hipSuccess) fprintf(stderr, "cooperative launch failed: %s (grid %d)\n", hipGetErrorString(e), grid);
}
```

```cpp
#include <hip/hip_runtime.h>
#include <hip/hip_cooperative_groups.h>
#include <cstdio>
#include <cstdint>
namespace cg = cooperative_groups;

__device__ __forceinline__ int lane_id_fresh() { unsigned m = ~0u; asm volatile("" : "+s"(m)); return (int)__builtin_amdgcn_mbcnt_hi(m, __builtin_amdgcn_mbcnt_lo(m, 0u)); }
namespace pg8 {
#define PG8_LAS __attribute__((address_space(3)))
typedef unsigned short bf16_t;
typedef short bf16x8 __attribute__((ext_vector_type(8)));
typedef float f32x4 __attribute__((ext_vector_type(4)));
typedef unsigned u32x4 __attribute__((ext_vector_type(4)));
constexpr int BM = 256, BK = 64, HALF = 128, HTB = HALF * BK * 2  , STAGE_BYTES = 8 * HTB, NXCD = 8, WGM = 8;

__host__ __device__ __forceinline__ int lds_byte(int r, int c) { const int st = (r >> 4) * 2 + (c >> 5), rr = r & 15, cc = c & 31, ob = rr * 64 + cc * 2; return st * 1024 + (ob ^ (((ob >> 9) & 1) << 5)); }
__host__ __device__ __forceinline__ void stage_rc(int b, int& R, int& C) { const int st = b / 1024, sb = b % 1024, swz = sb ^ (((sb >> 9) & 1) << 5); R = (st >> 1) * 16 + swz / 64; C = (st & 1) * 32 + (swz % 64) / 2; }
__host__ __device__ __forceinline__ int perm32(int rho) { const int n = rho >> 4, i = rho & 15; return 8 * (i >> 2) + 4 * n + (i & 3); }

struct Unit { int pm, pn, ks; };
struct Gemm { const bf16_t* A; const bf16_t* Bt; int M, N, K, ldk; };

struct StaticOrder {
    int nM, nN, nwg, G, c;
    __host__ __device__ void init(int M, int N, int G_, int c_) { nM = M / BM; nN = N / BM; nwg = nM * nN; G = G_; c = c_; }
    __host__ __device__ bool next(int i, Unit& u) const {
        const long L = (long)i * G + c; if (L >= nwg) return false;
        int wgid = (int)L; { const int q = nwg / NXCD, r = nwg % NXCD, xcd = wgid % NXCD, off = wgid / NXCD; wgid = (xcd < r ? xcd * (q + 1) : r * (q + 1) + (xcd - r) * q) + off; }
        const int nig = WGM * nN, gid = wgid / nig, fm = gid * WGM, gsz = (nM - fm) < WGM ? (nM - fm) : WGM;
        u.pm = fm + ((wgid % nig) % gsz); u.pn = (wgid % nig) / gsz; u.ks = 0; return true;
    }
    __device__ __forceinline__ void a_ready(const Unit&) const {}
    __device__ __forceinline__ void done(const Unit&) const {}
};

struct Order2 {
    StaticOrder so; int lat;
    __host__ __device__ void init(int N, int G_, int c_, int lat_) { lat = lat_; so.init(lat_ ? 32768 : 36864, N, G_, c_); }
    __host__ __device__ bool next(int i, Unit& u) const { if (!so.next(i, u)) return false; if (lat) u.pm = (u.pm >> 3) * 9 + 1 + (u.pm & 7); return true; }
    __device__ __forceinline__ void a_ready(const Unit&) const {}
    __device__ __forceinline__ void done(const Unit&) const {}
};
struct CtxSplitOrder {
    int G, c;
    __host__ __device__ void init(int G_, int c_) { G = G_; c = c_; }
    __host__ __device__ bool next(int i, Unit& u) const { const long L = (long)i * G + c; if (L >= 256) return false; u.ks = (int)L & 3; u.pn = ((int)L >> 2) & 3; u.pm = ((int)L >> 4) * 9; return true; }
    __device__ __forceinline__ void a_ready(const Unit&) const {}
    __device__ __forceinline__ void done(const Unit&) const {}
};
__device__ __forceinline__ unsigned cvt_pk_bf16(float lo, float hi) { unsigned r; asm volatile("v_cvt_pk_bf16_f32 %0, %1, %2" : "=v"(r) : "v"(lo), "v"(hi)); return r; }

template <int ACT  > struct EpiBf16 {
    static constexpr bool PERM = true, AFTER_DRAIN = false;
    bf16_t* O; int ldc;
    __device__ __forceinline__ void operator()(const f32x4 (&acc)[2][2][4][2], const Unit& u, int wr, int wc, int fr, int fq) const {
        const int row0 = u.pm * BM + wr * 64 + fr; const int col0 = u.pn * BM + wc * 32 + 8 * fq;
#pragma unroll
        for (int ai = 0; ai < 2; ++ai)
#pragma unroll
            for (int m = 0; m < 4; ++m) { bf16_t* rowp = O + (size_t)(row0 + ai * HALF + m * 16) * ldc + col0;
#pragma unroll
                for (int bj = 0; bj < 2; ++bj) { f32x4 v0 = acc[ai][bj][m][0], v1 = acc[ai][bj][m][1];
                    if (ACT == 1) {
#pragma unroll
                        for (int e = 0; e < 4; ++e) { float a = fmaxf(v0[e], 0.f), b = fmaxf(v1[e], 0.f); v0[e] = a * a; v1[e] = b * b; } }
                    u32x4 w; w.x = cvt_pk_bf16(v0[0], v0[1]); w.y = cvt_pk_bf16(v0[2], v0[3]); w.z = cvt_pk_bf16(v1[0], v1[1]); w.w = cvt_pk_bf16(v1[2], v1[3]);
                    *(u32x4*)(rowp + bj * HALF) = w; } }
    }
};
struct EpiRes {
    static constexpr bool PERM = false, AFTER_DRAIN = false;
    float* Xl; float* Xc; const float* gates;
    const float* Xl_in; const float* Xc_in;
    __device__ __forceinline__ void operator()(const f32x4 (&acc)[2][2][4][2], const Unit& u, int wr, int wc, int fr, int fq) const {
        const int b = u.pm / 9, tt = u.pm - b * 9;
        const size_t toff = (tt == 0) ? ((size_t)(b * 256) << 10) : ((size_t)(b * 2048 + (tt - 1) * 256) << 10);
        float* base = ((tt == 0) ? Xc : Xl) + toff; const float* base_in = ((tt == 0) ? Xc_in : Xl_in) + toff;
        const float* g = gates + (size_t)((tt == 0) ? 16 : b) * 6144;
        const int col0 = u.pn * BM + wc * 32 + 4 * fq;
        float* rp0 = base + ((size_t)(wr * 64 + fr) << 10) + col0; const float* rq0 = base_in + ((size_t)(wr * 64 + fr) << 10) + col0;
#pragma unroll
        for (int bj = 0; bj < 2; ++bj)
#pragma unroll
            for (int n = 0; n < 2; ++n) { const f32x4 gvv = *(const f32x4*)(g + col0 + bj * HALF + n * 16);
#pragma unroll
                for (int ai = 0; ai < 2; ++ai) {
#pragma unroll
                    for (int m = 0; m < 4; ++m) { const size_t eo = (size_t)(ai * HALF + m * 16) * 1024 + bj * HALF + n * 16; f32x4 xv = *(const f32x4*)(rq0 + eo); xv = xv + gvv * acc[ai][bj][m][n]; *(f32x4*)(rp0 + eo) = xv; }
                    asm volatile("" ::: "memory"); } }
    }
};
struct EpiPart {
    static constexpr bool PERM = false, AFTER_DRAIN = false;
    float* part;
    __device__ __forceinline__ void operator()(const f32x4 (&acc)[2][2][4][2], const Unit& u, int wr, int wc, int fr, int fq) const {
        float* rp0 = part + (((size_t)u.ks * 4096 + (size_t)(u.pm / 9) * 256 + wr * 64 + fr) << 10) + u.pn * BM + wc * 32 + 4 * fq;
#pragma unroll
        for (int ai = 0; ai < 2; ++ai)
#pragma unroll
            for (int m = 0; m < 4; ++m)
#pragma unroll
                for (int bj = 0; bj < 2; ++bj)
#pragma unroll
                    for (int n = 0; n < 2; ++n) *(f32x4*)(rp0 + (size_t)(ai * HALF + m * 16) * 1024 + bj * HALF + n * 16) = acc[ai][bj][m][n];
    }
};
template <class Epi, class Sched, bool ALIGN_EPI = false, bool SP2 = false>
__device__ __forceinline__ void gemm_phase(PG8_LAS unsigned char* lds, const Gemm g, const Sched& S, const Epi& E, const int wvs) {
    const int tid = wvs * 64 + lane_id_fresh(); const int wid = __builtin_amdgcn_readfirstlane(tid >> 6), lane = tid & 63, wr = wid >> 2, wc = wid & 3, fr = lane & 15, fq = lane >> 4;
    const int K = g.ldk, nt = g.K / BK; const size_t sstep = (size_t)g.K * 2;
    unsigned voffA[2], voffB[2];
#pragma unroll
    for (int i = 0; i < 2; ++i) { int R, C; stage_rc(tid * 16 + i * 8192, R, C); const int Rb = Epi::PERM ? ((R & ~31) + perm32(R & 31)) : R;
        voffA[i] = (unsigned)(R * K + C) * 2u; voffB[i] = (unsigned)(Rb * K + C) * 2u; }
    const size_t kstep = (size_t)(BK * 2);
    const size_t hstep = (size_t)HALF * K * 2;
    const size_t tstep = 2 * hstep;
    const unsigned ldsw = (unsigned)wid * 1024u;
    const int aoff = lds_byte(wr * 64 + fr, fq * 8), boff = lds_byte(wc * 32 + fr, fq * 8);
#define PG8_SA(b, h) (((b) * 2 + (h)) * HTB)
#define PG8_SB(b, h) ((4 + (b) * 2 + (h)) * HTB)
#define PG8_STAGE(bufoff, gbase, voff) do { _Pragma("unroll") for (int _i = 0; _i < 2; ++_i) \
        __builtin_amdgcn_global_load_lds((const unsigned*)((const char*)(gbase) + (voff)[_i]), (PG8_LAS unsigned*)(lds + (bufoff) + ldsw + _i * 8192), 16, 0, 0); } while (0)
#define PG8_LDA(dst, b, h) do { _Pragma("unroll") for (int m = 0; m < 4; ++m) _Pragma("unroll") for (int k = 0; k < 2; ++k) dst[m][k] = *(const PG8_LAS bf16x8*)(lds + PG8_SA(b, h) + aoff + m * 2048 + k * 1024); } while (0)
#define PG8_LDB(dst, b, h) do { _Pragma("unroll") for (int n = 0; n < 2; ++n) _Pragma("unroll") for (int k = 0; k < 2; ++k) dst[n][k] = *(const PG8_LAS bf16x8*)(lds + PG8_SB(b, h) + boff + n * 2048 + k * 1024); } while (0)
#define PG8_MMA(ai, bj, At, Bt) do { __builtin_amdgcn_s_setprio(1); _Pragma("unroll") for (int m = 0; m < 4; ++m) _Pragma("unroll") for (int n = 0; n < 2; ++n) _Pragma("unroll") for (int k = 0; k < 2; ++k) \
        acc[ai][bj][m][n] = __builtin_amdgcn_mfma_f32_16x16x32_bf16(Bt[n][k], At[m][k], acc[ai][bj][m][n], 0, 0, 0); __builtin_amdgcn_s_setprio(0); } while (0)
#define PG8_WAIT_V(n) asm volatile("s_waitcnt vmcnt(" #n ")" ::: "memory")
#define PG8_WAIT_L(n) asm volatile("s_waitcnt lgkmcnt(" #n ")" ::: "memory")
#define PG8_BAR __builtin_amdgcn_s_barrier()
#define PG8_SCHED __builtin_amdgcn_sched_barrier(0)
    Unit cur, nxt; int ui = 0;
    if (!S.next(0, cur)) return;
    f32x4 acc[2][2][4][2];
#pragma unroll
    for (int a = 0; a < 2; ++a)
#pragma unroll
        for (int b = 0; b < 2; ++b)
#pragma unroll
            for (int m = 0; m < 4; ++m)
#pragma unroll
                for (int n = 0; n < 2; ++n) acc[a][b][m][n] = (f32x4){0.f, 0.f, 0.f, 0.f};
    bf16x8 At[4][2], B0[2][2], B1[2][2];
    const char* cA = (const char*)g.A + (size_t)cur.pm * tstep + (size_t)cur.ks * sstep; const char* cB = (const char*)g.Bt + (size_t)cur.pn * tstep + (size_t)cur.ks * sstep;
    S.a_ready(cur);
    if constexpr (SP2) {
        PG8_STAGE(PG8_SB(0, 0), cB, voffB); PG8_STAGE(PG8_SB(0, 1), cB + hstep, voffB); PG8_STAGE(PG8_SA(0, 0), cA, voffA); PG8_STAGE(PG8_SA(0, 1), cA + hstep, voffA);
        if (wr == 1) PG8_BAR;
        PG8_WAIT_V(2); PG8_BAR;
        PG8_STAGE(PG8_SB(1, 0), cB + kstep, voffB); PG8_STAGE(PG8_SA(1, 0), cA + kstep, voffA); PG8_STAGE(PG8_SB(1, 1), cB + hstep + kstep, voffB);
        PG8_WAIT_V(6); PG8_BAR;
    } else {
        PG8_STAGE(PG8_SB(0, 0), cB, voffB); PG8_STAGE(PG8_SA(0, 0), cA, voffA); PG8_STAGE(PG8_SB(0, 1), cB + hstep, voffB); PG8_STAGE(PG8_SA(0, 1), cA + hstep, voffA);
        if (wr == 1) PG8_BAR;
        PG8_WAIT_V(4); PG8_BAR;
        PG8_STAGE(PG8_SB(1, 0), cB + kstep, voffB); PG8_STAGE(PG8_SA(1, 0), cA + kstep, voffA); PG8_STAGE(PG8_SB(1, 1), cB + hstep + kstep, voffB);
        PG8_WAIT_V(6); PG8_BAR;
    }
    for (;;) {
        const bool has_next = S.next(ui + 1, nxt);
        const char* nA = has_next ? (const char*)g.A + (size_t)nxt.pm * tstep + (size_t)nxt.ks * sstep : cA; const char* nB = has_next ? (const char*)g.Bt + (size_t)nxt.pn * tstep + (size_t)nxt.ks * sstep : cB;
        for (int t = 0; t < nt; t += 2) {
            const bool last = (t == nt - 2);
            const char* a1 = cA + (size_t)(t + 1) * kstep;
            const char* a2 = last ? nA : cA + (size_t)(t + 2) * kstep; const char* b2 = last ? nB : cB + (size_t)(t + 2) * kstep;
            const char* a3 = a2 + kstep; const char* b3 = b2 + kstep;
            if (last && has_next) S.a_ready(nxt);
            if constexpr (SP2) {
            PG8_LDB(B0, 0, 0); PG8_LDB(B1, 0, 1); PG8_SCHED; PG8_LDA(At, 0, 0); PG8_STAGE(PG8_SA(1, 1), a1 + hstep, voffA);
            PG8_WAIT_V(8); PG8_WAIT_L(0); PG8_BAR; PG8_MMA(0, 0, At, B0); PG8_MMA(0, 1, At, B1); PG8_BAR; PG8_SCHED;
            PG8_LDA(At, 0, 1); PG8_STAGE(PG8_SB(0, 0), b2, voffB); PG8_STAGE(PG8_SB(0, 1), b2 + hstep, voffB); PG8_STAGE(PG8_SA(0, 0), a2, voffA);
            PG8_WAIT_V(8); PG8_WAIT_L(0); PG8_BAR; PG8_MMA(1, 0, At, B0); PG8_MMA(1, 1, At, B1); PG8_BAR; PG8_SCHED;
            PG8_LDB(B0, 1, 0); PG8_LDB(B1, 1, 1); PG8_SCHED; PG8_LDA(At, 1, 0); PG8_STAGE(PG8_SA(0, 1), a2 + hstep, voffA);
            PG8_WAIT_V(8); PG8_WAIT_L(0); PG8_BAR; PG8_MMA(0, 0, At, B0); PG8_MMA(0, 1, At, B1); PG8_BAR; PG8_SCHED;
            PG8_LDA(At, 1, 1); PG8_STAGE(PG8_SB(1, 0), b3, voffB); PG8_STAGE(PG8_SB(1, 1), b3 + hstep, voffB); PG8_STAGE(PG8_SA(1, 0), a3, voffA);
            PG8_WAIT_V(8); PG8_WAIT_L(0); PG8_BAR; PG8_MMA(1, 0, At, B0); PG8_MMA(1, 1, At, B1); PG8_BAR; PG8_SCHED;
            } else {
            PG8_LDB(B0, 0, 0); PG8_SCHED; PG8_LDA(At, 0, 0); PG8_STAGE(PG8_SA(1, 1), a1 + hstep, voffA);
            PG8_WAIT_L(8); PG8_BAR; PG8_WAIT_L(0); PG8_MMA(0, 0, At, B0); PG8_BAR; PG8_SCHED;
            PG8_LDB(B1, 0, 1); PG8_STAGE(PG8_SB(0, 0), b2, voffB);
            PG8_BAR; PG8_WAIT_L(0); PG8_MMA(0, 1, At, B1); PG8_BAR;
            PG8_LDA(At, 0, 1); PG8_STAGE(PG8_SA(0, 0), a2, voffA);
            PG8_BAR; PG8_WAIT_L(0); PG8_MMA(1, 0, At, B0); PG8_BAR; PG8_SCHED;
            PG8_STAGE(PG8_SB(0, 1), b2 + hstep, voffB);
            PG8_WAIT_V(6); PG8_BAR; PG8_MMA(1, 1, At, B1); PG8_BAR;
            PG8_LDB(B0, 1, 0); PG8_SCHED; PG8_LDA(At, 1, 0); PG8_STAGE(PG8_SA(0, 1), a2 + hstep, voffA);
            PG8_WAIT_L(8); PG8_BAR; PG8_WAIT_L(0); PG8_MMA(0, 0, At, B0); PG8_BAR; PG8_SCHED;
            PG8_LDB(B1, 1, 1); PG8_STAGE(PG8_SB(1, 0), b3, voffB);
            PG8_BAR; PG8_WAIT_L(0); PG8_MMA(0, 1, At, B1); PG8_BAR;
            PG8_LDA(At, 1, 1); PG8_STAGE(PG8_SA(1, 0), a3, voffA);
            PG8_BAR; PG8_WAIT_L(0); PG8_MMA(1, 0, At, B0); PG8_BAR; PG8_SCHED;
            PG8_STAGE(PG8_SB(1, 1), b3 + hstep, voffB);
            PG8_WAIT_V(6); PG8_BAR; PG8_MMA(1, 1, At, B1); PG8_BAR;
            }
        }
        if constexpr (ALIGN_EPI) { if (wr == 0) PG8_BAR; }
        if constexpr (!Epi::AFTER_DRAIN) { E(acc, cur, wr, wc, fr, fq); S.done(cur); }
        if (!has_next) break;
#pragma unroll
        for (int a = 0; a < 2; ++a)
#pragma unroll
            for (int b = 0; b < 2; ++b)
#pragma unroll
                for (int m = 0; m < 4; ++m)
#pragma unroll
                    for (int n = 0; n < 2; ++n) acc[a][b][m][n] = (f32x4){0.f, 0.f, 0.f, 0.f};
        cur = nxt; cA = nA; cB = nB; ++ui;
        if constexpr (ALIGN_EPI) { if (wr == 1) PG8_BAR; }
    }
    PG8_WAIT_V(0);
    if constexpr (!ALIGN_EPI) { if (wr == 0) PG8_BAR; }
    PG8_BAR;
    if constexpr (Epi::AFTER_DRAIN) { E.fused(acc, cur, wr, wc, fr, fq, lds, wid, lane); S.done(cur); }
#undef PG8_SA
#undef PG8_SB
#undef PG8_STAGE
#undef PG8_LDA
#undef PG8_LDB
#undef PG8_MMA
#undef PG8_WAIT_V
#undef PG8_WAIT_L
#undef PG8_BAR
#undef PG8_SCHED
}
}

constexpr int D = 1024, BATCH = 16, SEQ = 2048, CTX = 256, DEPTH = 4;
constexpr int TPB = CTX + SEQ;
constexpr int M = BATCH * TPB;
constexpr int DIN = 3088, NP = 3072, DFF = 4096;
constexpr int PC_DNQ = 0, PC_DNG = 768, PC_SQ = 1024, PC_SK = 1536, PC_SV = 1664, PC_HQ = 1792, PC_HF = 2048, PC_HI = 2560, PC_HG = 2816;
constexpr float EPS = 1e-6f;
constexpr size_t MiB = 1u << 20;
constexpr size_t WS_CTL = 0, WS_MODS = 1 * MiB, WS_ROPE = 3 * MiB, WS_LB = 3 * MiB + 512 * 1024, WS_AB = 4 * MiB;
constexpr size_t WS_WIN = 7 * MiB, WS_WOUT = 13 * MiB, WS_W1 = 15 * MiB, WS_W2 = 23 * MiB, WS_XC = 32 * MiB, WS_HY = 48 * MiB, WS_P = 120 * MiB;
constexpr size_t WS_OD = WS_P + 216 * MiB, WS_QKV = WS_P + 288 * MiB, WS_END = WS_QKV + 64 * MiB;
constexpr int LDS_BYTES = 147456;
constexpr int NWAVES = 8, NTHR = 512;

#define LAS __attribute__((address_space(3)))
typedef unsigned short bf16_t;
typedef float f32x4 __attribute__((ext_vector_type(4)));
typedef short bf16x8 __attribute__((ext_vector_type(8)));
typedef short s16x4 __attribute__((ext_vector_type(4)));
typedef unsigned u32x4 __attribute__((ext_vector_type(4)));
typedef unsigned u32x2 __attribute__((ext_vector_type(2)));

struct Params {
    const float *x, *c, *ctx, *c_ctx, *w_ada, *b_ada, *norm1, *norm2, *w_in, *dn_conv, *dn_A_log, *dn_dt_bias, *dn_norm, *swa_sink, *hg_lb, *hg_norm, *w_out, *w_ff1, *w_ff2, *norm_f;
    float* out; unsigned char* ws;
};

__device__ __forceinline__ float bflo(unsigned u) { return __uint_as_float(u << 16); }
__device__ __forceinline__ float bfhi(unsigned u) { return __uint_as_float(u & 0xffff0000u); }
__device__ __forceinline__ unsigned pk2(float lo, float hi) { return pg8::cvt_pk_bf16(lo, hi); }
__device__ __forceinline__ bf16_t bf1(float f) { unsigned u = __float_as_uint(f); u += 0x7fffu + ((u >> 16) & 1u); return (bf16_t)(u >> 16); }
__device__ __forceinline__ float siluf(float v) { return v / (1.f + __expf(-v)); }
__device__ __forceinline__ float sigmf(float v) { return 1.f / (1.f + __expf(-v)); }
__device__ __forceinline__ float wave_sum(float v) {
#pragma unroll
    for (int o = 1; o < 64; o <<= 1) v += __shfl_xor(v, o);
    return v;
}
template <int CTRL> __device__ __forceinline__ float dpp(float x) { return __builtin_bit_cast(float, __builtin_amdgcn_mov_dpp(__builtin_bit_cast(int, x), CTRL, 0xf, 0xf, true)); }
constexpr int XOR1 = 0xB1, XOR2 = 0x4E, XOR7 = 0x141;
__device__ __forceinline__ float sum8(float v) { v += dpp<XOR1>(v); v += dpp<XOR2>(v); v += dpp<XOR7>(v); return v; }
__device__ __forceinline__ float xrow16_max(float x) {
    auto s = __builtin_amdgcn_permlane16_swap(__float_as_uint(x), __float_as_uint(x), false, false);
    x = fmaxf(__uint_as_float(s[0]), __uint_as_float(s[1]));
    auto t = __builtin_amdgcn_permlane32_swap(__float_as_uint(x), __float_as_uint(x), false, false);
    return fmaxf(__uint_as_float(t[0]), __uint_as_float(t[1]));
}
__device__ __forceinline__ float xrow16_sum(float x) {
    auto s = __builtin_amdgcn_permlane16_swap(__float_as_uint(x), __float_as_uint(x), false, false);
    x = __uint_as_float(s[0]) + __uint_as_float(s[1]);
    auto t = __builtin_amdgcn_permlane32_swap(__float_as_uint(x), __float_as_uint(x), false, false);
    return __uint_as_float(t[0]) + __uint_as_float(t[1]);
}
__device__ __forceinline__ const float* xrow_c(const float* Xl, const float* Xc, int r) { const int b = r / TPB, t = r - b * TPB; return t < CTX ? Xc + ((size_t)(b * CTX + t) << 10) : Xl + ((size_t)(b * SEQ + t - CTX) << 10); }
__device__ __forceinline__ int cidx(int r) { const int b = r / TPB, t = r - b * TPB; return t < CTX ? 16 : b; }

__device__ __forceinline__ void phase_prologue(const Params& p, LAS unsigned char* lds, const int wvs) {
    const int tid = wvs * 64 + lane_id_fresh(); const int lane = tid & 63, w = tid >> 6;
    float* mods = (float*)(p.ws + WS_MODS);
    LAS float* sc = (LAS float*)lds;
    LAS float* red = (LAS float*)(lds + 81920);
    for (int idx = tid; idx < 17 * 1024; idx += NTHR) { const int ci = idx >> 10, k = idx & 1023; const float v = ci < 16 ? p.c[ci * 1024 + k] : p.c_ctx[k]; sc[k * 20 + ci] = v / (1.f + expf(-v)); }
    __syncthreads();
    for (int it = blockIdx.x; it < DEPTH * 96; it += gridDim.x) {
        const int l = it / 96, cgp = it - l * 96, col = cgp * 64 + lane;
        float acc[17];
#pragma unroll
        for (int i = 0; i < 17; ++i) acc[i] = 0.f;
        const float* wp = p.w_ada + ((size_t)l * 1024 + w * 128) * 6144 + col;
#pragma unroll 16
        for (int kk = 0; kk < 128; ++kk) {
            const float wv = wp[(size_t)kk * 6144];
            const LAS f32x4* s4 = (const LAS f32x4*)(sc + (w * 128 + kk) * 20);
            const f32x4 s0 = s4[0], s1 = s4[1], s2 = s4[2], s3 = s4[3]; const float s16 = sc[(w * 128 + kk) * 20 + 16];
#pragma unroll
            for (int e = 0; e < 4; ++e) { acc[e] += wv * s0[e]; acc[4 + e] += wv * s1[e]; acc[8 + e] += wv * s2[e]; acc[12 + e] += wv * s3[e]; }
            acc[16] += wv * s16;
        }
#pragma unroll
        for (int i = 0; i < 17; ++i) red[(w * 17 + i) * 64 + lane] = acc[i];
        __syncthreads();
        for (int idx = tid; idx < 17 * 64; idx += NTHR) { const int i = idx >> 6, cl = idx & 63; float s = 0.f;
#pragma unroll
            for (int ww = 0; ww < 8; ++ww) s += red[(ww * 17 + i) * 64 + cl];
            mods[((size_t)l * 17 + i) * 6144 + cgp * 64 + cl] = s + p.b_ada[l * 6144 + cgp * 64 + cl]; }
        __syncthreads();
    }
    const int gt = blockIdx.x * NTHR + tid, GT = gridDim.x * NTHR;
    { float* rc = (float*)(p.ws + WS_ROPE); float* rs = rc + 2048 * 32;
      for (int idx = gt; idx < 2048 * 32; idx += GT) { const int t = idx >> 5, d = idx & 31; const float pos = (float)(d < 16 ? (t >> 6) : (t & 63));
          const float inv = expf(-(float)(d & 15) * (9.210340371976184f / 16.f)); const float ang = pos * inv; rc[idx] = cosf(ang); rs[idx] = sinf(ang); } }
    { float* LB = (float*)(p.ws + WS_LB);
      for (int idx = gt; idx < 2 * 256; idx += GT) { const int d = idx >> 8, cc = idx & 255; float v[DEPTH]; float mx = -1e30f;
#pragma unroll
          for (int l = 0; l < DEPTH; ++l) { v[l] = p.hg_lb[(d * DEPTH + l) * 256 + cc]; mx = fmaxf(mx, v[l]); }
          float s = 0.f;
#pragma unroll
          for (int l = 0; l < DEPTH; ++l) { v[l] = expf(v[l] - mx); s += v[l]; }
          float cum = 0.f;
#pragma unroll
          for (int l = 0; l < DEPTH; ++l) { if (l > 0) cum += v[l] / s; LB[(d * DEPTH + l) * 256 + cc] = cum; } } }
}

__device__ __forceinline__ void transpose_item(const float* W, int K, int ldw, int scol0, bf16_t* WT, int n0, int k0, LAS float* scr, int lane) {
#pragma unroll 8
    for (int i = 0; i < 32; ++i) { const int kk = 2 * i + (lane >> 5); scr[kk * 33 + (lane & 31)] = W[(size_t)(k0 + kk) * ldw + scol0 + (lane & 31)]; }
    asm volatile("s_waitcnt lgkmcnt(0)" ::: "memory");
    const int c = lane & 7;
#pragma unroll
    for (int j = 0; j < 4; ++j) { const int n = (lane >> 3) + 8 * j; const LAS float* s = scr + (8 * c) * 33 + n;
        u32x4 o; o.x = pk2(s[0 * 33], s[1 * 33]); o.y = pk2(s[2 * 33], s[3 * 33]); o.z = pk2(s[4 * 33], s[5 * 33]); o.w = pk2(s[6 * 33], s[7 * 33]);
        *(u32x4*)(WT + (size_t)(n0 + n) * K + k0 + 8 * c) = o; }
    asm volatile("s_waitcnt lgkmcnt(0)" ::: "memory");
}

template <bool FIRST> __device__ __forceinline__ void phase_norm(const Params& p, int l, LAS unsigned char* lds, const int wvs) {
    const int tid = wvs * 64 + lane_id_fresh(); const int lane = tid & 63, w = tid >> 6;
    const int gw = blockIdx.x * NWAVES + w, NGW = gridDim.x * NWAVES;
    const float* mods = (const float*)(p.ws + WS_MODS);
    constexpr int WST = 1032;
    LAS bf16_t* wab = (LAS bf16_t*)lds;
    if (FIRST) {
        LAS float* scr = (LAS float*)(lds + 65536 + w * 8704);
        constexpr int I_IN = 16 * 96, I_OUT = 16 * 32, I_1 = 16 * 128, I_2 = 64 * 32;
        for (int it = gw; it < I_IN + I_OUT + I_1 + I_2; it += NGW) {
            int r = it;
            if (r < I_IN) { const int kb = r / 96, nb = r - kb * 96; const int n0 = nb * 32; transpose_item(p.w_in + (size_t)l * D * DIN, D, DIN, n0 + (n0 >= 1024 ? 16 : 0), (bf16_t*)(p.ws + WS_WIN), n0, kb * 64, scr, lane); continue; }
            r -= I_IN;
            if (r < I_OUT) { const int kb = r / 32, nb = r - kb * 32; transpose_item(p.w_out + (size_t)l * D * D, D, D, nb * 32, (bf16_t*)(p.ws + WS_WOUT), nb * 32, kb * 64, scr, lane); continue; }
            r -= I_OUT;
            if (r < I_1) { const int kb = r / 128, nb = r - kb * 128; transpose_item(p.w_ff1 + (size_t)l * D * DFF, D, DFF, nb * 32, (bf16_t*)(p.ws + WS_W1), nb * 32, kb * 64, scr, lane); continue; }
            r -= I_1;
            { const int kb = r / 32, nb = r - kb * 32; transpose_item(p.w_ff2 + (size_t)l * DFF * D, DFF, D, nb * 32, (bf16_t*)(p.ws + WS_W2), nb * 32, kb * 64, scr, lane); }
        }
        const float* wi = p.w_in + (size_t)l * D * DIN + 1024;
        for (int idx = tid; idx < 4096; idx += NTHR) { const int k = idx >> 2, j4 = (idx & 3) * 4; const f32x4 v = *(const f32x4*)(wi + (size_t)k * DIN + j4);
#pragma unroll
            for (int e = 0; e < 4; ++e) wab[(j4 + e) * WST + k] = bf1(v[e]); }
        __syncthreads();
    }
    const float* nw = (FIRST ? p.norm1 : p.norm2) + l * D;
    bf16_t* H = (bf16_t*)(p.ws + WS_HY);
    float* AB = (float*)(p.ws + WS_AB);
    float* Xc = (float*)(p.ws + WS_XC);
    const float* part = (const float*)(p.ws + WS_QKV);
    const bool fix = FIRST ? (l > 0) : (l < DEPTH - 1);
    const float* fgate = mods + ((size_t)(FIRST ? (l > 0 ? l - 1 : 0) : l) * 17 + 16) * 6144 + (FIRST ? 5 : 2) * 1024;
    int nrows = 0;
    for (int r = gw; r < M; r += NGW) {
        ++nrows;
        if (!FIRST && l == DEPTH - 1 && (r % TPB) < CTX) continue;
        const f32x4* xr = (const f32x4*)((FIRST && l == 0) ? xrow_c(p.x, p.ctx, r) : xrow_c(p.out, Xc, r)) + lane;
        f32x4 v[4]; float ss = 0.f;
        const int rb = r / TPB, rt = r - rb * TPB;
        if (fix && rt < CTX) {
            const f32x4* xin = (const f32x4*)((!FIRST && l == 0) ? p.ctx + ((size_t)(rb * CTX + rt) << 10) : Xc + ((size_t)(rb * CTX + rt) << 10)) + lane;
            const f32x4* pr = (const f32x4*)(part + ((size_t)(rb * CTX + rt) << 10)) + lane; f32x4* xo = (f32x4*)(Xc + ((size_t)(rb * CTX + rt) << 10)) + lane;
#pragma unroll
            for (int j = 0; j < 4; ++j) { const f32x4 gq = *(const f32x4*)(fgate + 4 * (lane + 64 * j));
                const f32x4 s4 = (pr[64 * j] + pr[64 * j + 1048576]) + (pr[64 * j + 2 * 1048576] + pr[64 * j + 3 * 1048576]);
                v[j] = xin[64 * j] + gq * s4; xo[64 * j] = v[j]; }
        } else {
#pragma unroll
            for (int j = 0; j < 4; ++j) v[j] = xr[64 * j];
        }
#pragma unroll
        for (int j = 0; j < 4; ++j) ss += (v[j][0] * v[j][0] + v[j][1] * v[j][1]) + (v[j][2] * v[j][2] + v[j][3] * v[j][3]);
        const float rstd = rsqrtf(wave_sum(ss) * (1.f / D) + EPS);
        const float* md = mods + ((size_t)l * 17 + cidx(r)) * 6144 + (FIRST ? 0 : 3 * 1024);
        u32x2* hp = (u32x2*)(H + (size_t)r * D) + lane;
#pragma unroll
        for (int j = 0; j < 4; ++j) { const int k = 4 * (lane + 64 * j);
            const f32x4 g = *(const f32x4*)(nw + k), sh = *(const f32x4*)(md + k), sl = *(const f32x4*)(md + 1024 + k);
            f32x4 h;
#pragma unroll
            for (int e = 0; e < 4; ++e) h[e] = (v[j][e] * rstd * g[e]) * (1.f + sl[e]) + sh[e];
            u32x2 o2; o2.x = pk2(h[0], h[1]); o2.y = pk2(h[2], h[3]); hp[64 * j] = o2;
        }
    }
    if (FIRST) {
        asm volatile("s_waitcnt vmcnt(0)" ::: "memory");
        const int fr = lane & 15, fq = lane >> 4;
        for (int b0 = 0; b0 < nrows; b0 += 16) {
            const int kr = b0 + fr; const bool ok = kr < nrows; const bf16_t* hp = H + (size_t)(gw + (ok ? kr : 0) * NGW) * D + fq * 8;
            f32x4 c = (f32x4){0.f, 0.f, 0.f, 0.f};
#pragma unroll 8
            for (int ks = 0; ks < 32; ++ks) { u32x4 av = *(const u32x4*)(hp + ks * 32); if (!ok) av = (u32x4){0u, 0u, 0u, 0u};
                const bf16x8 bv = *(const LAS bf16x8*)(wab + fr * WST + ks * 32 + fq * 8);
                c = __builtin_amdgcn_mfma_f32_16x16x32_bf16(__builtin_bit_cast(bf16x8, av), bv, c, 0, 0, 0); }
#pragma unroll
            for (int j = 0; j < 4; ++j) { const int k2 = b0 + fq * 4 + j; if (k2 < nrows) AB[(size_t)(gw + k2 * NGW) * 16 + fr] = c[j]; }
        }
    }
}

constexpr int SST = 68;
constexpr int HST = 72;
__device__ __forceinline__ bf16x8 ldA_perm(const LAS bf16_t* base, int row, int s, int fq) {
    const LAS bf16_t* ap = base + row * HST + s * 32 + fq * 4; const u32x2 lo = *(const LAS u32x2*)ap, hi = *(const LAS u32x2*)(ap + 16);
    u32x4 av; av[0] = lo[0]; av[1] = lo[1]; av[2] = hi[0]; av[3] = hi[1]; return __builtin_bit_cast(bf16x8, av);
}
__device__ __forceinline__ bf16x8 packB(const f32x4& a, const f32x4& b) {
    u32x4 pb; pb[0] = bf1(a[0]) | ((unsigned)bf1(a[1]) << 16); pb[1] = bf1(a[2]) | ((unsigned)bf1(a[3]) << 16); pb[2] = bf1(b[0]) | ((unsigned)bf1(b[1]) << 16); pb[3] = bf1(b[2]) | ((unsigned)bf1(b[3]) << 16);
    return __builtin_bit_cast(bf16x8, pb);
}
__device__ __forceinline__ void phase_dnprep(const Params& p, int l, LAS unsigned char* lds, const int wvs) {
    const int tid = wvs * 64 + lane_id_fresh();
    constexpr int RST = 200;
    LAS float* qs = (LAS float*)lds; LAS float* ks = qs + 64 * SST; LAS float* vs = ks + 64 * SST; LAS bf16_t* RAW = (LAS bf16_t*)(vs + 64 * SST);
    const bf16_t* P = (const bf16_t*)(p.ws + WS_P);
    bf16_t* QKV = (bf16_t*)(p.ws + WS_QKV);
    const float* cw = p.dn_conv + (size_t)l * 5 * 768;
    const int c4 = tid % 48, tg = tid / 48;
    LAS float* cdst = ((c4 >> 4) == 0 ? qs : ((c4 >> 4) == 1 ? ks : vs)) + (c4 & 15) * 4;
#define PREP_LOADRAW(itx) do { const int h_ = (itx) & 3, bc_ = (itx) >> 2, b_ = bc_ / 36, nc_ = bc_ - b_ * 36; const int base_ = b_ * TPB + nc_ * 64, lo_ = b_ * TPB + (nc_ < 4 ? 0 : CTX), hi_ = b_ * TPB + (nc_ < 4 ? CTX : TPB); \
        _Pragma("unroll") for (int k = 0; k < 4; ++k) { const int q = tid + NTHR * k; const int rr = q / 24, pc = q - rr * 24; const int r = base_ - 2 + rr; \
            praw[k] = (q < 68 * 24 && r >= lo_ && r < hi_) ? *(const u32x4*)(P + (size_t)r * NP + (pc >> 3) * 256 + h_ * 64 + (pc & 7) * 8) : (u32x4){0u, 0u, 0u, 0u}; } } while (0)
    u32x4 praw[4];
    if ((int)blockIdx.x < BATCH * 36 * 4) PREP_LOADRAW((int)blockIdx.x);
    for (int it = blockIdx.x; it < BATCH * 36 * 4; it += gridDim.x) {
        const int h = it & 3, bc = it >> 2, b = bc / 36, nc = bc - b * 36;
        const int base = b * TPB + nc * 64;
        float wc[5][4];
        { const int ch = c4 * 4, pcol = (ch >> 6) * 256 + h * 64 + (ch & 63);
#pragma unroll
          for (int t = 0; t < 5; ++t) { const f32x4 w4 = *(const f32x4*)(cw + t * 768 + pcol); wc[t][0] = w4[0]; wc[t][1] = w4[1]; wc[t][2] = w4[2]; wc[t][3] = w4[3]; } }
#pragma unroll
        for (int k = 0; k < 4; ++k) { const int q = tid + NTHR * k; if (q < 68 * 24) { const int rr = q / 24, pc = q - rr * 24; *(LAS u32x4*)(RAW + rr * RST + pc * 8) = praw[k]; } }
        if (it + (int)gridDim.x < BATCH * 36 * 4) PREP_LOADRAW(it + (int)gridDim.x);
        __syncthreads();
        if (tid < 480) {
#pragma unroll
            for (int m = 0; m < 7; ++m) { const int pp = tg + 10 * m; if (pp < 64) { float a0 = 0.f, a1 = 0.f, a2 = 0.f, a3 = 0.f;
#pragma unroll
                for (int t = 0; t < 5; ++t) { const u32x2 raw = *(const LAS u32x2*)(RAW + (pp + t) * RST + c4 * 4);
                    a0 += bflo(raw[0]) * wc[t][0]; a1 += bfhi(raw[0]) * wc[t][1]; a2 += bflo(raw[1]) * wc[t][2]; a3 += bfhi(raw[1]) * wc[t][3]; }
                f32x4 o; o[0] = a0 / (1.f + __expf(-a0)); o[1] = a1 / (1.f + __expf(-a1)); o[2] = a2 / (1.f + __expf(-a2)); o[3] = a3 / (1.f + __expf(-a3));
                *(LAS f32x4*)(cdst + pp * SST) = o; } } }
        __syncthreads();
        { const int t = tid >> 3, part = tid & 7;
          const f32x4 q0 = *(const LAS f32x4*)(qs + t * SST + part * 8), q1 = *(const LAS f32x4*)(qs + t * SST + part * 8 + 4);
          const f32x4 k0 = *(const LAS f32x4*)(ks + t * SST + part * 8), k1 = *(const LAS f32x4*)(ks + t * SST + part * 8 + 4);
          const f32x4 v0 = *(const LAS f32x4*)(vs + t * SST + part * 8), v1 = *(const LAS f32x4*)(vs + t * SST + part * 8 + 4);
          float sq = (q0[0] * q0[0] + q0[1] * q0[1]) + (q0[2] * q0[2] + q0[3] * q0[3]) + (q1[0] * q1[0] + q1[1] * q1[1]) + (q1[2] * q1[2] + q1[3] * q1[3]);
          float sk = (k0[0] * k0[0] + k0[1] * k0[1]) + (k0[2] * k0[2] + k0[3] * k0[3]) + (k1[0] * k1[0] + k1[1] * k1[1]) + (k1[2] * k1[2] + k1[3] * k1[3]);
          sq = sum8(sq); sk = sum8(sk);
          const float rq = rsqrtf(sq + EPS) * 0.125f, rk = rsqrtf(sk + EPS);
          u32x4 qo, ko, vo;
          qo[0] = pk2(q0[0] * rq, q0[1] * rq); qo[1] = pk2(q0[2] * rq, q0[3] * rq); qo[2] = pk2(q1[0] * rq, q1[1] * rq); qo[3] = pk2(q1[2] * rq, q1[3] * rq);
          ko[0] = pk2(k0[0] * rk, k0[1] * rk); ko[1] = pk2(k0[2] * rk, k0[3] * rk); ko[2] = pk2(k1[0] * rk, k1[1] * rk); ko[3] = pk2(k1[2] * rk, k1[3] * rk);
          vo[0] = pk2(v0[0], v0[1]); vo[1] = pk2(v0[2], v0[3]); vo[2] = pk2(v1[0], v1[1]); vo[3] = pk2(v1[2], v1[3]);
          bf16_t* dst = QKV + ((size_t)(base + t) * 4 + h) * 192 + part * 8;
          *(u32x4*)dst = qo; *(u32x4*)(dst + 64) = ko; *(u32x4*)(dst + 128) = vo; }
        __syncthreads();
    }
#undef PREP_LOADRAW
    { bf16_t* Pw = (bf16_t*)(p.ws + WS_P); const float* rc = (const float*)(p.ws + WS_ROPE); const float* rs = rc + 2048 * 32;
      const int gt = blockIdx.x * NTHR + tid, GT = gridDim.x * NTHR;
      for (int idx = gt; idx < BATCH * SEQ * 8; idx += GT) { const int rl = idx >> 3, rem = idx & 7, kh = rem >> 2, g = rem & 3;
          const int bb = rl >> 11, t = rl & 2047;
          bf16_t* pp = Pw + (size_t)(bb * TPB + CTX + t) * NP + PC_SK + kh * 64 + g * 8;
          const u32x4 r1 = *(const u32x4*)pp, r2 = *(const u32x4*)(pp + 32);
          const f32x4 c0 = *(const f32x4*)(rc + t * 32 + g * 8), c1 = *(const f32x4*)(rc + t * 32 + g * 8 + 4), s0 = *(const f32x4*)(rs + t * 32 + g * 8), s1 = *(const f32x4*)(rs + t * 32 + g * 8 + 4);
          u32x4 o1, o2;
#pragma unroll
          for (int e = 0; e < 4; ++e) { const float xa = bflo(r1[e]), xb = bfhi(r1[e]), ya = bflo(r2[e]), yb = bfhi(r2[e]);
              const float ca = e < 2 ? c0[2 * e] : c1[2 * e - 4], cb = e < 2 ? c0[2 * e + 1] : c1[2 * e - 3], sa = e < 2 ? s0[2 * e] : s1[2 * e - 4], sb = e < 2 ? s0[2 * e + 1] : s1[2 * e - 3];
              o1[e] = pk2(xa * ca - ya * sa, xb * cb - yb * sb); o2[e] = pk2(xa * sa + ya * ca, xb * sb + yb * cb); }
          *(u32x4*)pp = o1; *(u32x4*)(pp + 32) = o2; } }
}

__device__ __forceinline__ void dn_seq(const Params& p, int l, int s, LAS unsigned char* lds, const int wvs) {
    const int tid = wvs * 64 + lane_id_fresh(); const int lane = tid & 63;
    const int b = s >> 3, h = (s >> 1) & 3, d = s & 1;
    constexpr int TILEB = 64 * HST * 2, BUFB = 6 * TILEB + 4 * 16 * 24 * 2 + 1024;
    LAS bf16_t* OB = (LAS bf16_t*)(lds + 2 * BUFB); LAS float* LF = (LAS float*)(lds + 2 * BUFB + TILEB);
    const bf16_t* QKV = (const bf16_t*)(p.ws + WS_QKV);
    const float* AB = (const float*)(p.ws + WS_AB);
    bf16_t* OD = (bf16_t*)(p.ws + WS_OD) + (size_t)d * M * 512 + h * 64;
    const float nA = -expf(p.dn_A_log[(l * 2 + d) * 4 + h]); const float dtb = p.dn_dt_bias[(l * 2 + d) * 4 + h];
    const int fr = lane & 15, fq = lane >> 4, V = wvs & 3;
    const bool isP = wvs < 4;
    const f32x4 zero4 = (f32x4){0.f, 0.f, 0.f, 0.f};
    u32x4 praw[6]; float pa = 0.f, pb_ = 0.f;
    f32x4 Sacc[4], R[4], QS[4];
#pragma unroll
    for (int T = 0; T < 4; ++T) { Sacc[T] = zero4; R[T] = zero4; QS[T] = zero4; }
#define DN_BASE(ci) (b * TPB + ((d == 0) ? (ci) : ((ci) < 4 ? 3 - (ci) : 39 - (ci))) * 64)
#define DN_LOADRAW(ci) do { const int base_ = DN_BASE(ci); _Pragma("unroll") for (int k = 0; k < 6; ++k) { const int q = tid + 256 * k; const int rr = q / 24, pc = q - rr * 24; \
            praw[k] = *(const u32x4*)(QKV + ((size_t)(base_ + rr) * 4 + h) * 192 + pc * 8); } \
        if (wvs == 0) { const int r_ = base_ + (d ? 63 - lane : lane); pa = AB[(size_t)r_ * 16 + d * 4 + h]; pb_ = AB[(size_t)r_ * 16 + 8 + d * 4 + h]; } } while (0)
#define DN_S1(buf) do { LAS bf16_t* QH_ = (LAS bf16_t*)(lds + (buf) * BUFB); LAS float* SCL_ = (LAS float*)(lds + (buf) * BUFB + 6 * TILEB + 4 * 16 * 24 * 2); \
        _Pragma("unroll") for (int k = 0; k < 6; ++k) { const int q = tid + 256 * k; const int rr = q / 24, pc = q - rr * 24; const int t = d ? 63 - rr : rr; \
            *(LAS u32x4*)(QH_ + (pc >> 3) * 64 * HST + t * HST + (pc & 7) * 8) = praw[k]; } \
        if (wvs == 0) { const float xs = pa + dtb; const float sp = xs > 15.f ? xs : (xs < -15.f ? __expf(xs) : __logf(1.f + __expf(xs))); float x = nA * sp; \
            _Pragma("unroll") for (int o = 1; o < 64; o <<= 1) { const float y = __shfl_up(x, o); if (lane >= o) x += y; } \
            SCL_[lane] = x; SCL_[64 + lane] = __expf(x); SCL_[128 + lane] = __builtin_amdgcn_rcpf(1.f + __expf(-pb_)); if (lane == 63) { SCL_[192] = x; SCL_[193] = __expf(x); } } } while (0)
    if (isP) { DN_LOADRAW(0); DN_S1(0); }
    __syncthreads();
    for (int ci = -1; ci < 36; ++ci) {
        const int cur = ci & 1, nxt = cur ^ 1;
        LAS bf16_t* QH = (LAS bf16_t*)(lds + cur * BUFB); LAS bf16_t* KH = QH + 64 * HST; LAS bf16_t* VB = KH + 64 * HST; LAS bf16_t* KTT = VB + 64 * HST; LAS bf16_t* LM = KTT + 64 * HST; LAS bf16_t* SCM = LM + 64 * HST;
        LAS bf16_t* DI = SCM + 64 * HST; LAS float* GC = (LAS float*)(DI + 4 * 16 * 24); LAS float* EG = GC + 64; LAS float* BETA = EG + 64; LAS float* GL = BETA + 64;
        if (isP) { if (ci >= 0 && ci + 1 < 36) DN_S1(nxt); }
        else if (ci >= 0) {
            if (ci > 0) { const int basep = DN_BASE(ci - 1); const int u = tid - 256;
#pragma unroll
                for (int it = 0; it < 8; ++it) { const int idx = u + 256 * it; const int i = idx >> 5, c2 = (idx & 31) * 2; const int row = basep + (d ? 63 - i : i);
                    *(unsigned*)(OD + (size_t)row * 512 + c2) = *(const LAS unsigned*)(OB + i * HST + c2); } }
            bf16x8 Bs[2];
#pragma unroll
            for (int s2 = 0; s2 < 2; ++s2) Bs[s2] = packB(Sacc[2 * s2], Sacc[2 * s2 + 1]);
#pragma unroll
            for (int I = 0; I < 4; ++I) { f32x4 c = zero4, cq = zero4;
#pragma unroll
                for (int s2 = 0; s2 < 2; ++s2) { c = __builtin_amdgcn_mfma_f32_16x16x32_bf16(ldA_perm(KH, I * 16 + fr, s2, fq), Bs[s2], c, 0, 0, 0); cq = __builtin_amdgcn_mfma_f32_16x16x32_bf16(ldA_perm(QH, I * 16 + fr, s2, fq), Bs[s2], cq, 0, 0, 0); }
#pragma unroll
                for (int r = 0; r < 4; ++r) { const int i = I * 16 + fq * 4 + r; R[I][r] = BETA[i] * (bflo((unsigned)VB[i * HST + V * 16 + fr]) - EG[i] * c[r]); QS[I][r] = EG[i] * cq[r]; } }
        }
        __syncthreads();
        if (isP) {
            const int pb2 = (ci < 0) ? 0 : nxt;
            if (ci + 1 < 36) {
                LAS bf16_t* QHn = (LAS bf16_t*)(lds + pb2 * BUFB); LAS bf16_t* KHn = QHn + 64 * HST; LAS bf16_t* KTTn = KHn + 2 * 64 * HST; LAS bf16_t* LMn = KTTn + 64 * HST; LAS bf16_t* SCMn = LMn + 64 * HST;
                LAS bf16_t* DIn = SCMn + 64 * HST; LAS float* GCn = (LAS float*)(DIn + 4 * 16 * 24); LAS float* BETAn = GCn + 128; LAS float* GLn = GCn + 192;
                { const int t = tid >> 2, part = tid & 3; const float ekt = __expf(GLn[0] - GCn[t]);
#pragma unroll
                  for (int hh = 0; hh < 2; ++hh) { const u32x4 kr = *(const LAS u32x4*)(KHn + t * HST + part * 16 + hh * 8);
#pragma unroll
                      for (int e = 0; e < 4; ++e) { KTTn[(part * 16 + hh * 8 + 2 * e) * HST + t] = bf1(bflo(kr[e]) * ekt); KTTn[(part * 16 + hh * 8 + 2 * e + 1) * HST + t] = bf1(bfhi(kr[e]) * ekt); } } }
                { const int I = wvs;
                  float gci[4], bti[4], gcj[4];
#pragma unroll
                  for (int r = 0; r < 4; ++r) { gci[r] = GCn[I * 16 + fq * 4 + r]; bti[r] = BETAn[I * 16 + fq * 4 + r]; gcj[r] = GCn[r * 16 + fr]; }
#pragma unroll
                  for (int J = 0; J < 4; ++J) { f32x4 ckk = zero4, cqk = zero4;
                      if (J <= I) {
#pragma unroll
                          for (int kk = 0; kk < 2; ++kk) { const bf16x8 Ak = *(const LAS bf16x8*)(KHn + (I * 16 + fr) * HST + kk * 32 + fq * 8), Aq = *(const LAS bf16x8*)(QHn + (I * 16 + fr) * HST + kk * 32 + fq * 8);
                              const bf16x8 B = *(const LAS bf16x8*)(KHn + (J * 16 + fr) * HST + kk * 32 + fq * 8);
                              ckk = __builtin_amdgcn_mfma_f32_16x16x32_bf16(Ak, B, ckk, 0, 0, 0); cqk = __builtin_amdgcn_mfma_f32_16x16x32_bf16(Aq, B, cqk, 0, 0, 0); } }
                      const int j = J * 16 + fr; const float gj = gcj[J];
#pragma unroll
                      for (int r = 0; r < 4; ++r) { const int i = I * 16 + fq * 4 + r; const float dec = __expf(fminf(gci[r] - gj, 0.f));
                          const float lvv = bti[r] * ckk[r] * dec, svv = cqk[r] * dec;
                          const float lv = j < i ? lvv : 0.f, sv = j <= i ? svv : 0.f;
                          LMn[i * HST + j] = bf1(lv); SCMn[i * HST + j] = bf1(sv); if (I == J) LF[(I * 16 + fq * 4 + r) * 20 + fr] = lv; } }
                  asm volatile("s_waitcnt lgkmcnt(0)" ::: "memory");
                  { const int c = lane & 15; float x[16];
#pragma unroll
                    for (int i = 0; i < 16; ++i) { float acc = (i == c) ? 1.f : 0.f;
#pragma unroll
                        for (int j4 = 0; j4 < (i + 3) / 4; ++j4) { const f32x4 Lr = *(const LAS f32x4*)(LF + (I * 16 + i) * 20 + j4 * 4);
#pragma unroll
                            for (int e = 0; e < 4; ++e) if (j4 * 4 + e < i) acc -= Lr[e] * x[j4 * 4 + e]; }
                        x[i] = acc; }
                    if (lane < 16) {
#pragma unroll
                        for (int i = 0; i < 16; ++i) DIn[(I * 16 + i) * 24 + c] = bf1(x[i]); } } }
                if (ci + 2 < 36) DN_LOADRAW(ci + 2);
            }
        } else if (ci >= 0) {
            bf16x8 Bx0, Bx1;
            { bf16x8 AD[4];
#pragma unroll
              for (int I = 0; I < 4; ++I) { const u32x2 lo = *(const LAS u32x2*)(DI + (I * 16 + fr) * 24 + fq * 4); u32x4 av; av[0] = lo[0]; av[1] = lo[1]; av[2] = 0u; av[3] = 0u; AD[I] = __builtin_bit_cast(bf16x8, av); }
              const f32x4 X0 = __builtin_amdgcn_mfma_f32_16x16x32_bf16(AD[0], packB(R[0], zero4), zero4, 0, 0, 0);
              f32x4 T1 = __builtin_amdgcn_mfma_f32_16x16x32_bf16(ldA_perm(LM, 16 + fr, 0, fq), packB(X0, zero4), zero4, 0, 0, 0);
              const f32x4 X1 = __builtin_amdgcn_mfma_f32_16x16x32_bf16(AD[1], packB(R[1] - T1, zero4), zero4, 0, 0, 0);
              Bx0 = packB(X0, X1);
              f32x4 T2 = __builtin_amdgcn_mfma_f32_16x16x32_bf16(ldA_perm(LM, 32 + fr, 0, fq), Bx0, zero4, 0, 0, 0);
              const f32x4 X2 = __builtin_amdgcn_mfma_f32_16x16x32_bf16(AD[2], packB(R[2] - T2, zero4), zero4, 0, 0, 0);
              f32x4 T3 = __builtin_amdgcn_mfma_f32_16x16x32_bf16(ldA_perm(LM, 48 + fr, 0, fq), Bx0, zero4, 0, 0, 0);
              T3 = __builtin_amdgcn_mfma_f32_16x16x32_bf16(ldA_perm(LM, 48 + fr, 1, fq), packB(X2, zero4), T3, 0, 0, 0);
              const f32x4 X3 = __builtin_amdgcn_mfma_f32_16x16x32_bf16(AD[3], packB(R[3] - T3, zero4), zero4, 0, 0, 0);
              Bx1 = packB(X2, X3); }
#pragma unroll
            for (int I = 0; I < 4; ++I) { f32x4 c = QS[I];
                c = __builtin_amdgcn_mfma_f32_16x16x32_bf16(ldA_perm(SCM, I * 16 + fr, 0, fq), Bx0, c, 0, 0, 0);
                c = __builtin_amdgcn_mfma_f32_16x16x32_bf16(ldA_perm(SCM, I * 16 + fr, 1, fq), Bx1, c, 0, 0, 0);
#pragma unroll
                for (int r = 0; r < 4; ++r) OB[(I * 16 + fq * 4 + r) * HST + V * 16 + fr] = bf1(c[r]); }
            { const float egl = GL[1];
#pragma unroll
              for (int T = 0; T < 4; ++T) { f32x4 c = Sacc[T] * egl;
                  c = __builtin_amdgcn_mfma_f32_16x16x32_bf16(ldA_perm(KTT, T * 16 + fr, 0, fq), Bx0, c, 0, 0, 0);
                  c = __builtin_amdgcn_mfma_f32_16x16x32_bf16(ldA_perm(KTT, T * 16 + fr, 1, fq), Bx1, c, 0, 0, 0);
                  Sacc[T] = c; } }
        }
        __syncthreads();
    }
    if (!isP) { const int basep = DN_BASE(35); const int u = tid - 256;
#pragma unroll
        for (int it = 0; it < 8; ++it) { const int idx = u + 256 * it; const int i = idx >> 5, c2 = (idx & 31) * 2; const int row = basep + (d ? 63 - i : i);
            *(unsigned*)(OD + (size_t)row * 512 + c2) = *(const LAS unsigned*)(OB + i * HST + c2); } }
    __syncthreads();
#undef DN_BASE
#undef DN_LOADRAW
#undef DN_S1
}

__device__ __forceinline__ void hg_seq(const Params& p, int l, int s, LAS unsigned char* lds, const int wvs) {
    const int tid = wvs * 64 + lane_id_fresh(); const int lane = tid & 63;
    const int b = s >> 3, h = (s >> 1) & 3, d = s & 1;
    constexpr int BUFB = 5 * 64 * HST * 2;
    LAS bf16_t* SC = (LAS bf16_t*)(lds + 2 * BUFB); LAS bf16_t* OB = SC + 64 * HST;
    LAS float* GS = (LAS float*)(OB + 64 * HST); LAS float* EBL = GS + 256;
    const bf16_t* P = (const bf16_t*)(p.ws + WS_P);
    bf16_t* OD = (bf16_t*)(p.ws + WS_OD) + (size_t)d * M * 512 + 256 + h * 64;
    const bool isA = wvs < 4;
    const int kx = tid & 63, g = wvs & 3;
    const float lb = ((const float*)(p.ws + WS_LB))[(d * DEPTH + l) * 256 + h * 64 + kx];
    const int fr = lane & 15, fq = lane >> 4, V = wvs & 3;
    f32x4 Sacc[4];
#pragma unroll
    for (int T = 0; T < 4; ++T) Sacc[T] = (f32x4){0.f, 0.f, 0.f, 0.f};
    unsigned short rq[16], rz[16], rv[16];
    float qv[16], kv[16], bc[16];
#define HG_BASE(ci) (b * TPB + ((d == 0) ? (ci) : ((ci) < 4 ? 3 - (ci) : 39 - (ci))) * 64)
#define HG_LOADRAW(ci) do { const int base_ = HG_BASE(ci); _Pragma("unroll") for (int e = 0; e < 16; ++e) { const int t = g * 16 + e; const int pp = d ? 63 - t : t; const bf16_t* rp = P + (size_t)(base_ + pp) * NP + h * 64 + kx; \
        rq[e] = rp[PC_HQ]; rz[e] = rp[PC_HF + d * 256]; rv[e] = rp[PC_HI]; } } while (0)
#define HG_A1(buf) do { LAS bf16_t* VT_ = (LAS bf16_t*)(lds + (buf) * BUFB) + 4 * 64 * HST; float run = 0.f; \
        _Pragma("unroll") for (int e = 0; e < 16; ++e) { const float z = bflo(rz[e]); const float sg = __builtin_amdgcn_rcpf(1.f + __expf(-z)); const float f = lb + (1.f - lb) * sg; \
            run += __logf(f); bc[e] = run; kv[e] = (1.f - lb) * (1.f - sg); qv[e] = bflo(rq[e]); VT_[kx * HST + g * 16 + e] = rv[e]; } \
        GS[g * 64 + kx] = run; } while (0)
#define HG_A2(buf) do { LAS bf16_t* QT_ = (LAS bf16_t*)(lds + (buf) * BUFB); LAS bf16_t* KT_ = QT_ + 64 * HST; LAS bf16_t* QP_ = KT_ + 64 * HST; LAS bf16_t* KTT_ = QP_ + 64 * HST; \
        const float g0 = GS[kx], g1 = GS[64 + kx], g2 = GS[128 + kx], g3 = GS[192 + kx]; const float mid = g0 + g1, bl = (g0 + g1) + (g2 + g3); \
        const float off = (g > 0 ? g0 : 0.f) + (g > 1 ? g1 : 0.f) + (g > 2 ? g2 : 0.f); \
        if (g == 3) EBL[(buf) * 64 + kx] = __expf(bl); \
        _Pragma("unroll") for (int e = 0; e < 16; ++e) { const int t = g * 16 + e; const float bce = bc[e] + off; const float E = fminf(fmaxf(bce - mid, -80.f), 80.f); \
            QT_[t * HST + kx] = bf1(qv[e] * __expf(E)); KT_[t * HST + kx] = bf1(kv[e] * __expf(-E)); \
            QP_[t * HST + kx] = bf1(qv[e] * __expf(bce)); KTT_[kx * HST + t] = bf1(kv[e] * __expf(bl - bce)); } } while (0)
    if (isA) { HG_LOADRAW(0); HG_A1(0); }
    __syncthreads();
    if (isA) { HG_A2(0); HG_LOADRAW(1); }
    __syncthreads();
    for (int ci = 0; ci < 36; ++ci) {
        const int cur = ci & 1, nxt = cur ^ 1;
        LAS bf16_t* QT = (LAS bf16_t*)(lds + cur * BUFB); LAS bf16_t* KT = QT + 64 * HST; LAS bf16_t* QP = KT + 64 * HST; LAS bf16_t* KTT = QP + 64 * HST; LAS bf16_t* VT = KTT + 64 * HST;
        if (isA) { if (ci + 1 < 36) HG_A1(nxt); }
        else {
            if (ci > 0) { const int basep = HG_BASE(ci - 1); const int u = tid - 256;
#pragma unroll
                for (int it = 0; it < 8; ++it) { const int idx = u + 256 * it; const int i = idx >> 5, c2 = (idx & 31) * 2; const int row = basep + (d ? 63 - i : i);
                    *(unsigned*)(OD + (size_t)row * 512 + c2) = *(const LAS unsigned*)(OB + i * HST + c2); } }
            { const int I = V;
#pragma unroll
              for (int J = 0; J < 4; ++J) { f32x4 c = (f32x4){0.f, 0.f, 0.f, 0.f};
                  if (J <= I) {
#pragma unroll
                      for (int kk = 0; kk < 2; ++kk) { const bf16x8 A = *(const LAS bf16x8*)(QT + (I * 16 + fr) * HST + kk * 32 + fq * 8); const bf16x8 B = *(const LAS bf16x8*)(KT + (J * 16 + fr) * HST + kk * 32 + fq * 8);
                          c = __builtin_amdgcn_mfma_f32_16x16x32_bf16(A, B, c, 0, 0, 0); } }
#pragma unroll
                  for (int r = 0; r < 4; ++r) { const int i = I * 16 + fq * 4 + r, j = J * 16 + fr; SC[i * HST + j] = bf1(j <= i ? c[r] : 0.f); } } }
        }
        __syncthreads();
        if (isA) { if (ci + 1 < 36) { HG_A2(nxt); if (ci + 2 < 36) HG_LOADRAW(ci + 2); } }
        else {
            bf16x8 Bs[2], Bv[2];
#pragma unroll
            for (int s2 = 0; s2 < 2; ++s2) { Bs[s2] = packB(Sacc[2 * s2], Sacc[2 * s2 + 1]); Bv[s2] = *(const LAS bf16x8*)(VT + (V * 16 + fr) * HST + s2 * 32 + fq * 8); }
#pragma unroll
            for (int I = 0; I < 4; ++I) { f32x4 o = (f32x4){0.f, 0.f, 0.f, 0.f};
#pragma unroll
                for (int s2 = 0; s2 < 2; ++s2) o = __builtin_amdgcn_mfma_f32_16x16x32_bf16(ldA_perm(QP, I * 16 + fr, s2, fq), Bs[s2], o, 0, 0, 0);
#pragma unroll
                for (int s2 = 0; s2 < 2; ++s2) { const bf16x8 A = *(const LAS bf16x8*)(SC + (I * 16 + fr) * HST + s2 * 32 + fq * 8); o = __builtin_amdgcn_mfma_f32_16x16x32_bf16(A, Bv[s2], o, 0, 0, 0); }
#pragma unroll
                for (int r = 0; r < 4; ++r) OB[(I * 16 + fq * 4 + r) * HST + V * 16 + fr] = bf1(o[r]); }
#pragma unroll
            for (int T = 0; T < 4; ++T) { f32x4 c;
#pragma unroll
                for (int r = 0; r < 4; ++r) c[r] = Sacc[T][r] * EBL[cur * 64 + T * 16 + fq * 4 + r];
#pragma unroll
                for (int s2 = 0; s2 < 2; ++s2) { const bf16x8 A = *(const LAS bf16x8*)(KTT + (T * 16 + fr) * HST + s2 * 32 + fq * 8); c = __builtin_amdgcn_mfma_f32_16x16x32_bf16(A, Bv[s2], c, 0, 0, 0); }
                Sacc[T] = c; }
        }
        __syncthreads();
    }
    if (!isA) { const int basep = HG_BASE(35); const int u = tid - 256;
#pragma unroll
        for (int it = 0; it < 8; ++it) { const int idx = u + 256 * it; const int i = idx >> 5, c2 = (idx & 31) * 2; const int row = basep + (d ? 63 - i : i);
            *(unsigned*)(OD + (size_t)row * 512 + c2) = *(const LAS unsigned*)(OB + i * HST + c2); } }
    __syncthreads();
#undef HG_BASE
#undef HG_LOADRAW
#undef HG_A1
#undef HG_A2
}

constexpr int KST = 72, VST = 136;
__device__ __forceinline__ void swa_unit(const Params& p, int l, int unit, LAS unsigned char* lds, const int wvs) {
    const int tid = wvs * 64 + lane_id_fresh(); const int lane = tid & 63;
    int b, kvh, qb;
    if (unit < 512) { b = unit >> 5; kvh = (unit >> 4) & 1; qb = 2 + (unit & 15); } else { const int v = unit - 512; b = v >> 2; kvh = (v >> 1) & 1; qb = v & 1; }
    const bool qctx = qb < 2;
    const bf16_t* P = (const bf16_t*)(p.ws + WS_P);
    const float* rc = (const float*)(p.ws + WS_ROPE); const float* rs = rc + 2048 * 32;
    bf16_t* Y = (bf16_t*)(p.ws + WS_HY);
    LAS bf16_t* Ks = (LAS bf16_t*)lds; LAS bf16_t* Vt = Ks + 128 * KST;
    const int hh = wvs >> 1, qhalf = wvs & 1, head = kvh * 4 + hh;
    const int fr = lane & 15, fq = lane >> 4;
    const int rowq0 = b * TPB + qb * 128 + qhalf * 64;
    const int f0 = (!qctx && qb == 2) ? 1 : 0, nl = qctx ? 0 : 3 - f0 - (qb == 17 ? 1 : 0), nkb = nl + 2;
#define SWA_BLK(j) ((j) < nl ? qb - 1 + f0 + (j) : (j) - nl)
#define SWA_REL(j) ((j) < nl ? f0 + (j) - 1 : 0)
    bf16x8 qf[4][2];
#pragma unroll
    for (int qt = 0; qt < 4; ++qt) {
        const int row = rowq0 + qt * 16 + fr; const bf16_t* qp = P + (size_t)row * NP + PC_SQ + head * 64 + fq * 8;
        const u32x4 r1 = *(const u32x4*)qp, r2 = *(const u32x4*)(qp + 32);
        float a1[8], a2[8];
#pragma unroll
        for (int e = 0; e < 4; ++e) { a1[2 * e] = bflo(r1[e]); a1[2 * e + 1] = bfhi(r1[e]); a2[2 * e] = bflo(r2[e]); a2[2 * e + 1] = bfhi(r2[e]); }
        if (!qctx) { const int t = (qb - 2) * 128 + qhalf * 64 + qt * 16 + fr; const float* cp = rc + t * 32 + fq * 8; const float* sp = rs + t * 32 + fq * 8;
#pragma unroll
            for (int e = 0; e < 8; ++e) { const float cs = cp[e], sn = sp[e]; const float o1 = a1[e] * cs - a2[e] * sn, o2 = a1[e] * sn + a2[e] * cs; a1[e] = o1; a2[e] = o2; } }
        u32x4 o1, o2;
#pragma unroll
        for (int e = 0; e < 4; ++e) { o1[e] = pk2(a1[2 * e] * 0.125f, a1[2 * e + 1] * 0.125f); o2[e] = pk2(a2[2 * e] * 0.125f, a2[2 * e + 1] * 0.125f); }
        qf[qt][0] = __builtin_bit_cast(bf16x8, o1); qf[qt][1] = __builtin_bit_cast(bf16x8, o2);
    }
    const int skey = tid >> 2, sg = tid & 3;
    const float sink = p.swa_sink[l * 8 + head];
    float mrun[4], lrun[4]; f32x4 O[4][4];
#pragma unroll
    for (int qt = 0; qt < 4; ++qt) { mrun[qt] = sink; lrun[qt] = 1.f;
#pragma unroll
        for (int dv = 0; dv < 4; ++dv) O[qt][dv] = (f32x4){0.f, 0.f, 0.f, 0.f}; }
    for (int j = 0; j < nkb; ++j) {
        const int rel = SWA_REL(j);
        u32x4 kreg[2], vreg[2];
        { const int rowk0 = b * TPB + SWA_BLK(j) * 128; const bf16_t* kp = P + (size_t)(rowk0 + skey) * NP + PC_SK + kvh * 64 + sg * 8;
          kreg[0] = *(const u32x4*)kp; kreg[1] = *(const u32x4*)(kp + 32);
#pragma unroll
          for (int it = 0; it < 2; ++it) { const int idx = tid + NTHR * it; vreg[it] = *(const u32x4*)(P + (size_t)(rowk0 + (idx >> 3)) * NP + PC_SV + kvh * 64 + (idx & 7) * 8); } }
        *(LAS u32x4*)(Ks + skey * KST + sg * 8) = kreg[0]; *(LAS u32x4*)(Ks + skey * KST + 32 + sg * 8) = kreg[1];
#pragma unroll
        for (int it = 0; it < 2; ++it) { const int idx = tid + NTHR * it; const int vk = idx >> 3, vg = idx & 7;
#pragma unroll
            for (int e = 0; e < 4; ++e) { Vt[(vg * 8 + 2 * e) * VST + vk] = (bf16_t)(vreg[it][e] & 0xffffu); Vt[(vg * 8 + 2 * e + 1) * VST + vk] = (bf16_t)(vreg[it][e] >> 16); } }
        __syncthreads();
#pragma unroll
        for (int qp2 = 0; qp2 < 2; ++qp2) {
            f32x4 Sx[2][8];
#pragma unroll
            for (int kt = 0; kt < 8; ++kt) { Sx[0][kt] = (f32x4){0.f, 0.f, 0.f, 0.f}; Sx[1][kt] = (f32x4){0.f, 0.f, 0.f, 0.f};
#pragma unroll
                for (int kk = 0; kk < 2; ++kk) { const bf16x8 A = *(const LAS bf16x8*)(Ks + (kt * 16 + fr) * KST + kk * 32 + fq * 8);
                    Sx[0][kt] = __builtin_amdgcn_mfma_f32_16x16x32_bf16(A, qf[2 * qp2][kk], Sx[0][kt], 0, 0, 0);
                    Sx[1][kt] = __builtin_amdgcn_mfma_f32_16x16x32_bf16(A, qf[2 * qp2 + 1][kk], Sx[1][kt], 0, 0, 0); } }
#pragma unroll
            for (int u = 0; u < 2; ++u) { const int qt = 2 * qp2 + u;
                if (rel != 0) { int qi = qhalf * 64 + qt * 16 + fr; asm volatile("" : "+v"(qi));
#pragma unroll
                    for (int kt = 0; kt < 8; ++kt)
#pragma unroll
                        for (int jx = 0; jx < 4; ++jx) { const int kx = kt * 16 + fq * 4 + jx; const bool ok = rel < 0 ? (kx >= qi) : (kx <= qi); if (!ok) Sx[u][kt][jx] = -1e30f; } }
                float mx = -1e30f;
#pragma unroll
                for (int kt = 0; kt < 8; ++kt) mx = fmaxf(mx, fmaxf(fmaxf(Sx[u][kt][0], Sx[u][kt][1]), fmaxf(Sx[u][kt][2], Sx[u][kt][3])));
                mx = xrow16_max(mx);
                const float mnew = fmaxf(mrun[qt], mx); const float alpha = __expf(mrun[qt] - mnew); mrun[qt] = mnew;
                float rsum = 0.f;
#pragma unroll
                for (int kt = 0; kt < 8; ++kt)
#pragma unroll
                    for (int jx = 0; jx < 4; ++jx) { const float e = __expf(Sx[u][kt][jx] - mnew); Sx[u][kt][jx] = e; rsum += e; }
                rsum = xrow16_sum(rsum);
                lrun[qt] = lrun[qt] * alpha + rsum;
#pragma unroll
                for (int dv = 0; dv < 4; ++dv) O[qt][dv] = O[qt][dv] * alpha; }
#pragma unroll
            for (int ks2 = 0; ks2 < 4; ++ks2) {
                bf16x8 Bp[2];
#pragma unroll
                for (int u = 0; u < 2; ++u) { u32x4 pb; pb[0] = pk2(Sx[u][2 * ks2][0], Sx[u][2 * ks2][1]); pb[1] = pk2(Sx[u][2 * ks2][2], Sx[u][2 * ks2][3]); pb[2] = pk2(Sx[u][2 * ks2 + 1][0], Sx[u][2 * ks2 + 1][1]); pb[3] = pk2(Sx[u][2 * ks2 + 1][2], Sx[u][2 * ks2 + 1][3]); Bp[u] = __builtin_bit_cast(bf16x8, pb); }
#pragma unroll
                for (int dv = 0; dv < 4; ++dv) { const LAS bf16_t* vp = Vt + (dv * 16 + fr) * VST + ks2 * 32 + fq * 4;
                    const u32x2 lo = *(const LAS u32x2*)vp, hi = *(const LAS u32x2*)(vp + 16);
                    u32x4 av; av[0] = lo[0]; av[1] = lo[1]; av[2] = hi[0]; av[3] = hi[1]; const bf16x8 Av = __builtin_bit_cast(bf16x8, av);
                    O[2 * qp2][dv] = __builtin_amdgcn_mfma_f32_16x16x32_bf16(Av, Bp[0], O[2 * qp2][dv], 0, 0, 0);
                    O[2 * qp2 + 1][dv] = __builtin_amdgcn_mfma_f32_16x16x32_bf16(Av, Bp[1], O[2 * qp2 + 1][dv], 0, 0, 0); }
            }
        }
        __syncthreads();
    }
#undef SWA_BLK
#undef SWA_REL
#pragma unroll
    for (int qt = 0; qt < 4; ++qt) { const float inv = 1.f / lrun[qt]; const int row = rowq0 + qt * 16 + fr;
#pragma unroll
        for (int dv = 0; dv < 4; ++dv) { u32x2 o2; o2[0] = pk2(O[qt][dv][0] * inv, O[qt][dv][1] * inv); o2[1] = pk2(O[qt][dv][2] * inv, O[qt][dv][3] * inv);
            *(u32x2*)(Y + (size_t)row * D + 256 + head * 64 + dv * 16 + fq * 4) = o2; } }
}

__device__ __forceinline__ void phase_mixers(const Params& p, int l, LAS unsigned char* lds, const int wvs) {
    for (int s = blockIdx.x; s < 256; s += gridDim.x) { if (s < 128) dn_seq(p, l, s, lds, wvs); else hg_seq(p, l, s - 128, lds, wvs); }
    unsigned* ctr = (unsigned*)(p.ws + WS_CTL) + 64 * (1 + l);
    LAS int* su = (LAS int*)(lds + 140 * 1024);
    for (;;) {
        __syncthreads();
        if (wvs == 0 && lane_id_fresh() == 0) su[0] = (int)atomicAdd(ctr, 1u);
        __syncthreads();
        const int unit = su[0];
        if (unit >= (l == DEPTH - 1 ? 512 : 576)) break;
        swa_unit(p, l, unit, lds, wvs);
    }
}

__device__ __forceinline__ void phase_finalize(const Params& p, int l, const int wvs) {
    const int tid = wvs * 64 + lane_id_fresh(); const int lane = tid & 63, w = tid >> 6;
    const int gw = blockIdx.x * NWAVES + w, NGW = gridDim.x * NWAVES;
    const bf16_t* P = (const bf16_t*)(p.ws + WS_P);
    const bf16_t* OD0 = (const bf16_t*)(p.ws + WS_OD); const bf16_t* OD1 = OD0 + (size_t)M * 512;
    bf16_t* Y = (bf16_t*)(p.ws + WS_HY);
    const int seg = lane >> 3, d0 = (lane & 7) * 8;
    const int hd = seg & 3; const bool isdn = seg < 4;
    const float* gain = (isdn ? p.dn_norm : p.hg_norm) + l * 64 + d0;
    const f32x4 g0 = *(const f32x4*)gain, g1 = *(const f32x4*)(gain + 4);
    const int ocol = (isdn ? 0 : 256) + hd * 64 + d0, gcol = (isdn ? PC_DNG : PC_HG) + hd * 64 + d0, ycol = (isdn ? 0 : 768) + hd * 64 + d0;
    for (int r = gw; r < M; r += NGW) {
        const u32x4 a = *(const u32x4*)(OD0 + (size_t)r * 512 + ocol), bq = *(const u32x4*)(OD1 + (size_t)r * 512 + ocol), gt = *(const u32x4*)(P + (size_t)r * NP + gcol);
        float o[8]; float ss = 0.f;
#pragma unroll
        for (int e = 0; e < 4; ++e) { o[2 * e] = bflo(a[e]) + bflo(bq[e]); o[2 * e + 1] = bfhi(a[e]) + bfhi(bq[e]); ss += o[2 * e] * o[2 * e] + o[2 * e + 1] * o[2 * e + 1]; }
        ss = sum8(ss);
        const float rms = rsqrtf(ss * (1.f / 64.f) + EPS);
        u32x4 y;
#pragma unroll
        for (int e = 0; e < 4; ++e) { const float ga = bflo(gt[e]), gb = bfhi(gt[e]);
            const float ge0 = e < 2 ? g0[2 * e] : g1[2 * e - 4], ge1 = e < 2 ? g0[2 * e + 1] : g1[2 * e - 3];
            y[e] = pk2(o[2 * e] * rms * ge0 * siluf(ga), o[2 * e + 1] * rms * ge1 * siluf(gb)); }
        *(u32x4*)(Y + (size_t)r * D + ycol) = y;
    }
}

__device__ __forceinline__ void phase_final(const Params& p, const int wvs) {
    const int tid = wvs * 64 + lane_id_fresh(); const int lane = tid & 63, w = tid >> 6;
    const int gw = blockIdx.x * NWAVES + w, NGW = gridDim.x * NWAVES;
    for (int r = gw; r < BATCH * SEQ; r += NGW) {
        f32x4* xr = (f32x4*)(p.out + ((size_t)r << 10)) + lane;
        f32x4 v[4]; float ss = 0.f;
#pragma unroll
        for (int j = 0; j < 4; ++j) { v[j] = xr[64 * j]; ss += (v[j][0] * v[j][0] + v[j][1] * v[j][1]) + (v[j][2] * v[j][2] + v[j][3] * v[j][3]); }
        const float rstd = rsqrtf(wave_sum(ss) * (1.f / D) + EPS);
#pragma unroll
        for (int j = 0; j < 4; ++j) { const f32x4 g = *(const f32x4*)(p.norm_f + 4 * (lane + 64 * j)); xr[64 * j] = v[j] * rstd * g; }
    }
}

#define XB_TMO      128
#define XB_XCNT(j)  (256  + 64 * (j))
#define XB_XSUB(j)  (1280 + 64 * (j))
#define XB_XGEN(j)  (2304 + 64 * (j))
#define XB_TOP      3328
#define XB_TOPGEN   3392
#define XCD_BAR_WORDS 3456
#define XB_SPIN_CAP (1u << 18)

__device__ __forceinline__ unsigned xb_ld(unsigned* p)              { return __hip_atomic_load(p, __ATOMIC_RELAXED, __HIP_MEMORY_SCOPE_AGENT); }
__device__ __forceinline__ unsigned xb_add(unsigned* p, unsigned v) { return __hip_atomic_fetch_add(p, v, __ATOMIC_RELAXED, __HIP_MEMORY_SCOPE_AGENT); }
__device__ __forceinline__ unsigned xb_xcc_id() { return (unsigned)__builtin_amdgcn_s_getreg((3 << 11) | 20) & 0xFu; }
#define XB_SPIN(cond, bar) do { unsigned _sp = 0; while (cond) { __builtin_amdgcn_s_sleep(1); \
    if ((++_sp & 255u) == 0u) { if (xb_ld(&(bar)[XB_TMO])) break; if (_sp > XB_SPIN_CAP) { atomicAdd(&(bar)[XB_TMO], 1u); break; } } } } while (0)

struct XcdBarrier {
    unsigned* bar; unsigned x;
    volatile LAS unsigned* st;
};

__device__ __forceinline__ XcdBarrier xcd_barrier_post(unsigned* bar, volatile LAS unsigned* st) {
    XcdBarrier b; b.bar = bar; b.x = xb_xcc_id(); b.st = st;
    if (threadIdx.x == 0) (void)xb_add(&bar[XB_XCNT(b.x)], 1u);
    return b;
}
__device__ __forceinline__ void xcd_barrier_complete(unsigned* bar, unsigned x, unsigned& nloc, unsigned& nx) {
    const unsigned G = gridDim.x * gridDim.y * gridDim.z;
    unsigned sum, cnt, mine, sp = 0u;
    for (;;) {
        sum = 0u; cnt = 0u; mine = 0u;
#pragma unroll
        for (unsigned j = 0; j < 16; ++j) { const unsigned c = xb_ld(&bar[XB_XCNT(j)]); sum += c; cnt += (c > 0u) ? 1u : 0u; mine = (j == x) ? c : mine; }
        if (sum == G) break;
        __builtin_amdgcn_s_sleep(1);
        if ((++sp & 255u) == 0u) { if (xb_ld(&bar[XB_TMO])) break; if (sp > XB_SPIN_CAP) { atomicAdd(&bar[XB_TMO], 1u); break; } }
    }
    nloc = mine > 0u ? mine : 1u; nx = cnt > 0u ? cnt : 1u;
}

__device__ __forceinline__ void xcd_barrier(const XcdBarrier& b, const int wvs) {
    asm volatile("s_waitcnt vmcnt(0)" ::: "memory");
    __syncthreads();
    if (wvs == 0 && lane_id_fresh() == 0) {
        unsigned* bar = b.bar;
        __builtin_amdgcn_s_waitcnt(0);
        unsigned nloc = b.st[0], nx = b.st[1];
        if (nloc == 0u) { xcd_barrier_complete(bar, b.x, nloc, nx); b.st[0] = nloc; b.st[1] = nx; }
        const unsigned old = xb_add(&bar[XB_XSUB(b.x)], 1u);
        const unsigned gen = old / nloc;
        if (old + 1u == (gen + 1u) * nloc) {
            __builtin_amdgcn_fence(__ATOMIC_RELEASE, "agent");
            asm volatile("s_waitcnt vmcnt(0)" ::: "memory");
            const unsigned og = xb_add(&bar[XB_TOP], 1u);
            const unsigned tg = og / nx;
            if (og + 1u == (tg + 1u) * nx) xb_add(&bar[XB_TOPGEN], 1u);
            else XB_SPIN(xb_ld(&bar[XB_TOPGEN]) == tg, bar);
            __builtin_amdgcn_fence(__ATOMIC_ACQUIRE, "agent");
            xb_add(&bar[XB_XGEN(b.x)], 1u);
            asm volatile("s_waitcnt vmcnt(0)" ::: "memory");
        } else {
            XB_SPIN(xb_ld(&bar[XB_XGEN(b.x)]) == gen, bar);
            __builtin_amdgcn_fence(__ATOMIC_ACQUIRE, "agent");
            asm volatile("s_waitcnt vmcnt(0)" ::: "memory");
        }
    }
    __syncthreads();
}

__device__ __forceinline__ void gsync(cg::grid_group& grid) {
    asm volatile("s_waitcnt vmcnt(0) lgkmcnt(0)" ::: "memory");
    grid.sync();
    __builtin_amdgcn_fence(__ATOMIC_ACQUIRE, "agent");
    asm volatile("s_waitcnt vmcnt(0)" ::: "memory");
}
__global__ void __launch_bounds__(NTHR, 2) fwd_megakernel(Params p) {
    extern __shared__ __attribute__((aligned(16))) unsigned char lds_raw[];
    LAS unsigned char* lds = (LAS unsigned char*)lds_raw;
    cg::grid_group grid = cg::this_grid();
    const int G = gridDim.x, c = blockIdx.x;
    const int wvs = __builtin_amdgcn_readfirstlane((int)(threadIdx.x >> 6));
    { volatile LAS unsigned* st0 = (volatile LAS unsigned*)(lds + 143360 + 64); if (threadIdx.x < 2) st0[threadIdx.x] = 0u; }
    __syncthreads();
    const XcdBarrier xbar = xcd_barrier_post((unsigned*)(p.ws + WS_CTL) + 4096, (volatile LAS unsigned*)(lds + 143360 + 64));
    phase_prologue(p, lds, wvs);
    if (p.ws == nullptr) gsync(grid);
    xcd_barrier(xbar, wvs);
    const float* mods = (const float*)(p.ws + WS_MODS);
    float* Xc = (float*)(p.ws + WS_XC);
    bf16_t* HY = (bf16_t*)(p.ws + WS_HY); bf16_t* PB = (bf16_t*)(p.ws + WS_P);
    for (int l = 0; l < DEPTH; ++l) {
        const int lastl = (l == DEPTH - 1) ? 1 : 0;
        phase_norm<true>(p, l, lds, wvs);
        xcd_barrier(xbar, wvs);
        { pg8::Gemm g{HY, (const bf16_t*)(p.ws + WS_WIN), M, NP, D, D}; pg8::StaticOrder S; S.init(M, NP, G, c); pg8::EpiBf16<0> E{PB, NP};
          pg8::gemm_phase<pg8::EpiBf16<0>, pg8::StaticOrder, true, true>(lds, g, S, E, wvs); }
        xcd_barrier(xbar, wvs);
        phase_dnprep(p, l, lds, wvs);
        xcd_barrier(xbar, wvs);
        phase_mixers(p, l, lds, wvs);
        xcd_barrier(xbar, wvs);
        phase_finalize(p, l, wvs);
        xcd_barrier(xbar, wvs);
        { pg8::Gemm g{HY, (const bf16_t*)(p.ws + WS_WOUT), M, D, D, D}; pg8::Order2 S; S.init(D, G, c, 1); pg8::EpiRes E{p.out, Xc, mods + ((size_t)l * 17 * 6 + 2) * 1024, l == 0 ? p.x : (const float*)p.out, l == 0 ? p.ctx : (const float*)Xc};
          pg8::gemm_phase<pg8::EpiRes, pg8::Order2, true, true>(lds, g, S, E, wvs); }
        if (!lastl) { pg8::Gemm g{HY, (const bf16_t*)(p.ws + WS_WOUT), M, D, D / 4, D}; pg8::CtxSplitOrder S; S.init(G, c); pg8::EpiPart E{(float*)(p.ws + WS_QKV)};
          pg8::gemm_phase<pg8::EpiPart, pg8::CtxSplitOrder, false, true>(lds, g, S, E, wvs); }
        xcd_barrier(xbar, wvs);
        phase_norm<false>(p, l, lds, wvs);
        xcd_barrier(xbar, wvs);
        { pg8::Gemm g{HY, (const bf16_t*)(p.ws + WS_W1), M, DFF, D, D}; pg8::Order2 S; S.init(DFF, G, c, lastl); pg8::EpiBf16<1> E{PB, DFF};
          pg8::gemm_phase<pg8::EpiBf16<1>, pg8::Order2, true, true>(lds, g, S, E, wvs); }
        xcd_barrier(xbar, wvs);
        { pg8::Gemm g{PB, (const bf16_t*)(p.ws + WS_W2), M, D, DFF, DFF}; pg8::Order2 S; S.init(D, G, c, 1); pg8::EpiRes E{p.out, Xc, mods + ((size_t)l * 17 * 6 + 5) * 1024, (const float*)p.out, (const float*)Xc};
          pg8::gemm_phase<pg8::EpiRes, pg8::Order2, true, true>(lds, g, S, E, wvs); }
        if (!lastl) { pg8::Gemm g{PB, (const bf16_t*)(p.ws + WS_W2), M, D, DFF / 4, DFF}; pg8::CtxSplitOrder S; S.init(G, c); pg8::EpiPart E{(float*)(p.ws + WS_QKV)};
          pg8::gemm_phase<pg8::EpiPart, pg8::CtxSplitOrder, false, true>(lds, g, S, E, wvs); }
        xcd_barrier(xbar, wvs);
    }
    phase_final(p, wvs);
}

extern "C" void kernel_launch(void* const* d_in, const int* in_sizes, int n_in, void* d_out, int out_size, void* d_ws, size_t ws_size, hipStream_t stream) {
    static int grid = 0;
    if (grid == 0) {
        if (n_in != 20 || ws_size < WS_END) { fprintf(stderr, "kernel_launch: need 20 inputs and >= %zu bytes of workspace (got %d, %zu)\n", (size_t)WS_END, n_in, ws_size); grid = -1; return; }
        int dev = 0, cus = 0, per_cu = 0;
        hipGetDevice(&dev); hipDeviceGetAttribute(&cus, hipDeviceAttributeMultiprocessorCount, dev);
        if (hipFuncSetAttribute((const void*)fwd_megakernel, hipFuncAttributeMaxDynamicSharedMemorySize, LDS_BYTES) != hipSuccess) { fprintf(stderr, "kernel_launch: hipFuncSetAttribute failed\n"); grid = -1; return; }
        if (hipOccupancyMaxActiveBlocksPerMultiprocessor(&per_cu, (const void*)fwd_megakernel, NTHR, LDS_BYTES) != hipSuccess || per_cu < 1) { fprintf(stderr, "kernel_launch: occupancy query says %d blocks/CU\n", per_cu); per_cu = 1; }
        (void)hipGetLastError();
        grid = cus;
    }
    if (grid < 0) return;
    hipMemsetAsync((char*)d_ws + WS_CTL, 0, 65536, stream);
    Params p{};
    const float** pp = (const float**)&p;
    for (int i = 0; i < 20; ++i) pp[i] = (const float*)d_in[i];
    p.out = (float*)d_out; p.ws = (unsigned char*)d_ws;
    void* args[] = {&p};
    hipError_t e = hipLaunchCooperativeKernel((const void*)fwd_megakernel, dim3(grid), dim3(NTHR), args, LDS_BYTES, stream);
    if (e != hipSuccess) fprintf(stderr, "cooperative launch failed: %s (grid %d)\n", hipGetErrorString(e), grid);
}
```

```cpp
#include <hip/hip_runtime.h>
#include <hip/hip_cooperative_groups.h>
#include <cstdio>
#include <cstdint>
namespace cg = cooperative_groups;

__device__ __forceinline__ int lane_id_fresh() { unsigned m = ~0u; asm volatile("" : "+s"(m)); return (int)__builtin_amdgcn_mbcnt_hi(m, __builtin_amdgcn_mbcnt_lo(m, 0u)); }
namespace pg8 {
#define PG8_LAS __attribute__((address_space(3)))
typedef unsigned short bf16_t;
typedef short bf16x8 __attribute__((ext_vector_type(8)));
typedef float f32x4 __attribute__((ext_vector_type(4)));
typedef unsigned u32x4 __attribute__((ext_vector_type(4)));
constexpr int BM = 256, BK = 64, HALF = 128, HTB = HALF * BK * 2  , STAGE_BYTES = 8 * HTB, NXCD = 8, WGM = 8;

__host__ __device__ __forceinline__ int lds_byte(int r, int c) { const int st = (r >> 4) * 2 + (c >> 5), rr = r & 15, cc = c & 31, ob = rr * 64 + cc * 2; return st * 1024 + (ob ^ (((ob >> 9) & 1) << 5)); }
__host__ __device__ __forceinline__ void stage_rc(int b, int& R, int& C) { const int st = b / 1024, sb = b % 1024, swz = sb ^ (((sb >> 9) & 1) << 5); R = (st >> 1) * 16 + swz / 64; C = (st & 1) * 32 + (swz % 64) / 2; }
__host__ __device__ __forceinline__ int perm32(int rho) { const int n = rho >> 4, i = rho & 15; return 8 * (i >> 2) + 4 * n + (i & 3); }

struct Unit { int pm, pn, ks; };
struct Gemm { const bf16_t* A; const bf16_t* Bt; int M, N, K, ldk; };

struct StaticOrder {
    int nM, nN, nwg, G, c;
    __host__ __device__ void init(int M, int N, int G_, int c_) { nM = M / BM; nN = N / BM; nwg = nM * nN; G = G_; c = c_; }
    __host__ __device__ bool next(int i, Unit& u) const {
        const long L = (long)i * G + c; if (L >= nwg) return false;
        int wgid = (int)L; { const int q = nwg / NXCD, r = nwg % NXCD, xcd = wgid % NXCD, off = wgid / NXCD; wgid = (xcd < r ? xcd * (q + 1) : r * (q + 1) + (xcd - r) * q) + off; }
        const int nig = WGM * nN, gid = wgid / nig, fm = gid * WGM, gsz = (nM - fm) < WGM ? (nM - fm) : WGM;
        u.pm = fm + ((wgid % nig) % gsz); u.pn = (wgid % nig) / gsz; u.ks = 0; return true;
    }
    __device__ __forceinline__ void a_ready(const Unit&) const {}
    __device__ __forceinline__ void done(const Unit&) const {}
};

struct Order2 {
    StaticOrder so; int lat;
    __host__ __device__ void init(int N, int G_, int c_, int lat_) { lat = lat_; so.init(lat_ ? 32768 : 36864, N, G_, c_); }
    __host__ __device__ bool next(int i, Unit& u) const { if (!so.next(i, u)) return false; if (lat) u.pm = (u.pm >> 3) * 9 + 1 + (u.pm & 7); return true; }
    __device__ __forceinline__ void a_ready(const Unit&) const {}
    __device__ __forceinline__ void done(const Unit&) const {}
};
struct CtxSplitOrder {
    int G, c;
    __host__ __device__ void init(int G_, int c_) { G = G_; c = c_; }
    __host__ __device__ bool next(int i, Unit& u) const { const long L = (long)i * G + c; if (L >= 256) return false; u.ks = (int)L & 3; u.pn = ((int)L >> 2) & 3; u.pm = ((int)L >> 4) * 9; return true; }
    __device__ __forceinline__ void a_ready(const Unit&) const {}
    __device__ __forceinline__ void done(const Unit&) const {}
};
typedef float f32x2c __attribute__((ext_vector_type(2)));
typedef __bf16 bf16x2c __attribute__((ext_vector_type(2)));
__device__ __forceinline__ unsigned cvt_pk_bf16(float lo, float hi) { const f32x2c v = {lo, hi}; return __builtin_bit_cast(unsigned, __builtin_convertvector(v, bf16x2c)); }

template <int ACT  > struct EpiBf16 {
    static constexpr bool PERM = true, AFTER_DRAIN = false;
    bf16_t* O; int ldc;
    __device__ __forceinline__ void operator()(const f32x4 (&acc)[2][2][4][2], const Unit& u, int wr, int wc, int fr, int fq) const {
        const int row0 = u.pm * BM + wr * 64 + fr; const int col0 = u.pn * BM + wc * 32 + 8 * fq;
#pragma unroll
        for (int ai = 0; ai < 2; ++ai)
#pragma unroll
            for (int m = 0; m < 4; ++m) { bf16_t* rowp = O + (size_t)(row0 + ai * HALF + m * 16) * ldc + col0;
#pragma unroll
                for (int bj = 0; bj < 2; ++bj) { f32x4 v0 = acc[ai][bj][m][0], v1 = acc[ai][bj][m][1];
                    if (ACT == 1) {
#pragma unroll
                        for (int e = 0; e < 4; ++e) { float a = fmaxf(v0[e], 0.f), b = fmaxf(v1[e], 0.f); v0[e] = a * a; v1[e] = b * b; } }
                    u32x4 w; w.x = cvt_pk_bf16(v0[0], v0[1]); w.y = cvt_pk_bf16(v0[2], v0[3]); w.z = cvt_pk_bf16(v1[0], v1[1]); w.w = cvt_pk_bf16(v1[2], v1[3]);
                    *(u32x4*)(rowp + bj * HALF) = w; } }
    }
};
struct EpiRes {
    static constexpr bool PERM = false, AFTER_DRAIN = false;
    float* Xl; float* Xc; const float* gates;
    const float* Xl_in; const float* Xc_in;
    __device__ __forceinline__ void operator()(const f32x4 (&acc)[2][2][4][2], const Unit& u, int wr, int wc, int fr, int fq) const {
        const int b = u.pm / 9, tt = u.pm - b * 9;
        const size_t toff = (tt == 0) ? ((size_t)(b * 256) << 10) : ((size_t)(b * 2048 + (tt - 1) * 256) << 10);
        float* base = ((tt == 0) ? Xc : Xl) + toff; const float* base_in = ((tt == 0) ? Xc_in : Xl_in) + toff;
        const float* g = gates + (size_t)((tt == 0) ? 16 : b) * 6144;
        const int col0 = u.pn * BM + wc * 32 + 4 * fq;
        float* rp0 = base + ((size_t)(wr * 64 + fr) << 10) + col0; const float* rq0 = base_in + ((size_t)(wr * 64 + fr) << 10) + col0;
#pragma unroll
        for (int bj = 0; bj < 2; ++bj)
#pragma unroll
            for (int n = 0; n < 2; ++n) { const f32x4 gvv = *(const f32x4*)(g + col0 + bj * HALF + n * 16);
#pragma unroll
                for (int ai = 0; ai < 2; ++ai) {
#pragma unroll
                    for (int m = 0; m < 4; ++m) { const size_t eo = (size_t)(ai * HALF + m * 16) * 1024 + bj * HALF + n * 16; f32x4 xv = *(const f32x4*)(rq0 + eo); xv = xv + gvv * acc[ai][bj][m][n]; *(f32x4*)(rp0 + eo) = xv; }
                    asm volatile("" ::: "memory"); } }
    }
};
struct EpiPart {
    static constexpr bool PERM = false, AFTER_DRAIN = false;
    float* part;
    __device__ __forceinline__ void operator()(const f32x4 (&acc)[2][2][4][2], const Unit& u, int wr, int wc, int fr, int fq) const {
        float* rp0 = part + (((size_t)u.ks * 4096 + (size_t)(u.pm / 9) * 256 + wr * 64 + fr) << 10) + u.pn * BM + wc * 32 + 4 * fq;
#pragma unroll
        for (int ai = 0; ai < 2; ++ai)
#pragma unroll
            for (int m = 0; m < 4; ++m)
#pragma unroll
                for (int bj = 0; bj < 2; ++bj)
#pragma unroll
                    for (int n = 0; n < 2; ++n) *(f32x4*)(rp0 + (size_t)(ai * HALF + m * 16) * 1024 + bj * HALF + n * 16) = acc[ai][bj][m][n];
    }
};
template <class Epi, class Sched, bool ALIGN_EPI = false, bool SP2 = false>
__device__ __forceinline__ void gemm_phase(PG8_LAS unsigned char* lds, const Gemm g, const Sched& S, const Epi& E, const int wvs) {
    const int tid = wvs * 64 + lane_id_fresh(); const int wid = __builtin_amdgcn_readfirstlane(tid >> 6), lane = tid & 63, wr = wid >> 2, wc = wid & 3, fr = lane & 15, fq = lane >> 4;
    const int K = g.ldk, nt = g.K / BK; const size_t sstep = (size_t)g.K * 2;
    unsigned voffA[2], voffB[2];
#pragma unroll
    for (int i = 0; i < 2; ++i) { int R, C; stage_rc(tid * 16 + i * 8192, R, C); const int Rb = Epi::PERM ? ((R & ~31) + perm32(R & 31)) : R;
        voffA[i] = (unsigned)(R * K + C) * 2u; voffB[i] = (unsigned)(Rb * K + C) * 2u; }
    const size_t kstep = (size_t)(BK * 2);
    const size_t hstep = (size_t)HALF * K * 2;
    const size_t tstep = 2 * hstep;
    const unsigned ldsw = (unsigned)wid * 1024u;
    const int aoff = lds_byte(wr * 64 + fr, fq * 8), boff = lds_byte(wc * 32 + fr, fq * 8);
#define PG8_SA(b, h) (((b) * 2 + (h)) * HTB)
#define PG8_SB(b, h) ((4 + (b) * 2 + (h)) * HTB)
#define PG8_STAGE(bufoff, gbase, voff) do { _Pragma("unroll") for (int _i = 0; _i < 2; ++_i) \
        __builtin_amdgcn_global_load_lds((const unsigned*)((const char*)(gbase) + (voff)[_i]), (PG8_LAS unsigned*)(lds + (bufoff) + ldsw + _i * 8192), 16, 0, 0); } while (0)
#define PG8_LDA(dst, b, h) do { _Pragma("unroll") for (int m = 0; m < 4; ++m) _Pragma("unroll") for (int k = 0; k < 2; ++k) dst[m][k] = *(const PG8_LAS bf16x8*)(lds + PG8_SA(b, h) + aoff + m * 2048 + k * 1024); } while (0)
#define PG8_LDB(dst, b, h) do { _Pragma("unroll") for (int n = 0; n < 2; ++n) _Pragma("unroll") for (int k = 0; k < 2; ++k) dst[n][k] = *(const PG8_LAS bf16x8*)(lds + PG8_SB(b, h) + boff + n * 2048 + k * 1024); } while (0)
#define PG8_MMA(ai, bj, At, Bt) do { __builtin_amdgcn_s_setprio(1); _Pragma("unroll") for (int m = 0; m < 4; ++m) _Pragma("unroll") for (int n = 0; n < 2; ++n) _Pragma("unroll") for (int k = 0; k < 2; ++k) \
        acc[ai][bj][m][n] = __builtin_amdgcn_mfma_f32_16x16x32_bf16(Bt[n][k], At[m][k], acc[ai][bj][m][n], 0, 0, 0); __builtin_amdgcn_s_setprio(0); } while (0)
#define PG8_WAIT_V(n) asm volatile("s_waitcnt vmcnt(" #n ")" ::: "memory")
#define PG8_WAIT_L(n) asm volatile("s_waitcnt lgkmcnt(" #n ")" ::: "memory")
#define PG8_BAR __builtin_amdgcn_s_barrier()
#define PG8_SCHED __builtin_amdgcn_sched_barrier(0)
    Unit cur, nxt; int ui = 0;
    if (!S.next(0, cur)) return;
    f32x4 acc[2][2][4][2];
#pragma unroll
    for (int a = 0; a < 2; ++a)
#pragma unroll
        for (int b = 0; b < 2; ++b)
#pragma unroll
            for (int m = 0; m < 4; ++m)
#pragma unroll
                for (int n = 0; n < 2; ++n) acc[a][b][m][n] = (f32x4){0.f, 0.f, 0.f, 0.f};
    bf16x8 At[4][2], B0[2][2], B1[2][2];
    const char* cA = (const char*)g.A + (size_t)cur.pm * tstep + (size_t)cur.ks * sstep; const char* cB = (const char*)g.Bt + (size_t)cur.pn * tstep + (size_t)cur.ks * sstep;
    S.a_ready(cur);
    if constexpr (SP2) {
        PG8_STAGE(PG8_SB(0, 0), cB, voffB); PG8_STAGE(PG8_SB(0, 1), cB + hstep, voffB); PG8_STAGE(PG8_SA(0, 0), cA, voffA); PG8_STAGE(PG8_SA(0, 1), cA + hstep, voffA);
        if (wr == 1) PG8_BAR;
        PG8_WAIT_V(2); PG8_BAR;
        PG8_STAGE(PG8_SB(1, 0), cB + kstep, voffB); PG8_STAGE(PG8_SA(1, 0), cA + kstep, voffA); PG8_STAGE(PG8_SB(1, 1), cB + hstep + kstep, voffB);
        PG8_WAIT_V(6); PG8_BAR;
    } else {
        PG8_STAGE(PG8_SB(0, 0), cB, voffB); PG8_STAGE(PG8_SA(0, 0), cA, voffA); PG8_STAGE(PG8_SB(0, 1), cB + hstep, voffB); PG8_STAGE(PG8_SA(0, 1), cA + hstep, voffA);
        if (wr == 1) PG8_BAR;
        PG8_WAIT_V(4); PG8_BAR;
        PG8_STAGE(PG8_SB(1, 0), cB + kstep, voffB); PG8_STAGE(PG8_SA(1, 0), cA + kstep, voffA); PG8_STAGE(PG8_SB(1, 1), cB + hstep + kstep, voffB);
        PG8_WAIT_V(6); PG8_BAR;
    }
    for (;;) {
        const bool has_next = S.next(ui + 1, nxt);
        const char* nA = has_next ? (const char*)g.A + (size_t)nxt.pm * tstep + (size_t)nxt.ks * sstep : cA; const char* nB = has_next ? (const char*)g.Bt + (size_t)nxt.pn * tstep + (size_t)nxt.ks * sstep : cB;
        for (int t = 0; t < nt; t += 2) {
            const bool last = (t == nt - 2);
            const char* a1 = cA + (size_t)(t + 1) * kstep;
            const char* a2 = last ? nA : cA + (size_t)(t + 2) * kstep; const char* b2 = last ? nB : cB + (size_t)(t + 2) * kstep;
            const char* a3 = a2 + kstep; const char* b3 = b2 + kstep;
            if (last && has_next) S.a_ready(nxt);
            if constexpr (SP2) {
            PG8_LDB(B0, 0, 0); PG8_LDB(B1, 0, 1); PG8_SCHED; PG8_LDA(At, 0, 0); PG8_STAGE(PG8_SA(1, 1), a1 + hstep, voffA);
            PG8_WAIT_V(8); PG8_WAIT_L(0); PG8_BAR; PG8_MMA(0, 0, At, B0); PG8_MMA(0, 1, At, B1); PG8_BAR; PG8_SCHED;
            PG8_LDA(At, 0, 1); PG8_STAGE(PG8_SB(0, 0), b2, voffB); PG8_STAGE(PG8_SB(0, 1), b2 + hstep, voffB); PG8_STAGE(PG8_SA(0, 0), a2, voffA);
            PG8_WAIT_V(8); PG8_WAIT_L(0); PG8_BAR; PG8_MMA(1, 0, At, B0); PG8_MMA(1, 1, At, B1); PG8_BAR; PG8_SCHED;
            PG8_LDB(B0, 1, 0); PG8_LDB(B1, 1, 1); PG8_SCHED; PG8_LDA(At, 1, 0); PG8_STAGE(PG8_SA(0, 1), a2 + hstep, voffA);
            PG8_WAIT_V(8); PG8_WAIT_L(0); PG8_BAR; PG8_MMA(0, 0, At, B0); PG8_MMA(0, 1, At, B1); PG8_BAR; PG8_SCHED;
            PG8_LDA(At, 1, 1); PG8_STAGE(PG8_SB(1, 0), b3, voffB); PG8_STAGE(PG8_SB(1, 1), b3 + hstep, voffB); PG8_STAGE(PG8_SA(1, 0), a3, voffA);
            PG8_WAIT_V(8); PG8_WAIT_L(0); PG8_BAR; PG8_MMA(1, 0, At, B0); PG8_MMA(1, 1, At, B1); PG8_BAR; PG8_SCHED;
            } else {
            PG8_LDB(B0, 0, 0); PG8_SCHED; PG8_LDA(At, 0, 0); PG8_STAGE(PG8_SA(1, 1), a1 + hstep, voffA);
            PG8_WAIT_L(8); PG8_BAR; PG8_WAIT_L(0); PG8_MMA(0, 0, At, B0); PG8_BAR; PG8_SCHED;
            PG8_LDB(B1, 0, 1); PG8_STAGE(PG8_SB(0, 0), b2, voffB);
            PG8_BAR; PG8_WAIT_L(0); PG8_MMA(0, 1, At, B1); PG8_BAR;
            PG8_LDA(At, 0, 1); PG8_STAGE(PG8_SA(0, 0), a2, voffA);
            PG8_BAR; PG8_WAIT_L(0); PG8_MMA(1, 0, At, B0); PG8_BAR; PG8_SCHED;
            PG8_STAGE(PG8_SB(0, 1), b2 + hstep, voffB);
            PG8_WAIT_V(6); PG8_BAR; PG8_MMA(1, 1, At, B1); PG8_BAR;
            PG8_LDB(B0, 1, 0); PG8_SCHED; PG8_LDA(At, 1, 0); PG8_STAGE(PG8_SA(0, 1), a2 + hstep, voffA);
            PG8_WAIT_L(8); PG8_BAR; PG8_WAIT_L(0); PG8_MMA(0, 0, At, B0); PG8_BAR; PG8_SCHED;
            PG8_LDB(B1, 1, 1); PG8_STAGE(PG8_SB(1, 0), b3, voffB);
            PG8_BAR; PG8_WAIT_L(0); PG8_MMA(0, 1, At, B1); PG8_BAR;
            PG8_LDA(At, 1, 1); PG8_STAGE(PG8_SA(1, 0), a3, voffA);
            PG8_BAR; PG8_WAIT_L(0); PG8_MMA(1, 0, At, B0); PG8_BAR; PG8_SCHED;
            PG8_STAGE(PG8_SB(1, 1), b3 + hstep, voffB);
            PG8_WAIT_V(6); PG8_BAR; PG8_MMA(1, 1, At, B1); PG8_BAR;
            }
        }
        if constexpr (ALIGN_EPI) { if (wr == 0) PG8_BAR; }
        if constexpr (!Epi::AFTER_DRAIN) { E(acc, cur, wr, wc, fr, fq); S.done(cur); }
        if (!has_next) break;
#pragma unroll
        for (int a = 0; a < 2; ++a)
#pragma unroll
            for (int b = 0; b < 2; ++b)
#pragma unroll
                for (int m = 0; m < 4; ++m)
#pragma unroll
                    for (int n = 0; n < 2; ++n) acc[a][b][m][n] = (f32x4){0.f, 0.f, 0.f, 0.f};
        cur = nxt; cA = nA; cB = nB; ++ui;
        if constexpr (ALIGN_EPI) { if (wr == 1) PG8_BAR; }
    }
    PG8_WAIT_V(0);
    if constexpr (!ALIGN_EPI) { if (wr == 0) PG8_BAR; }
    PG8_BAR;
    if constexpr (Epi::AFTER_DRAIN) { E.fused(acc, cur, wr, wc, fr, fq, lds, wid, lane); S.done(cur); }
#undef PG8_SA
#undef PG8_SB
#undef PG8_STAGE
#undef PG8_LDA
#undef PG8_LDB
#undef PG8_MMA
#undef PG8_WAIT_V
#undef PG8_WAIT_L
#undef PG8_BAR
#undef PG8_SCHED
}
}

constexpr int D = 1024, BATCH = 16, SEQ = 2048, CTX = 256, DEPTH = 4;
constexpr int TPB = CTX + SEQ;
constexpr int M = BATCH * TPB;
constexpr int DIN = 3088, NP = 3072, DFF = 4096;
constexpr int PC_DNQ = 0, PC_DNG = 768, PC_SQ = 1024, PC_SK = 1536, PC_SV = 1664, PC_HQ = 1792, PC_HF = 2048, PC_HI = 2560, PC_HG = 2816;
constexpr float EPS = 1e-6f;
constexpr size_t MiB = 1u << 20;
constexpr size_t WS_CTL = 0, WS_MODS = 1 * MiB, WS_ROPE = 3 * MiB, WS_LB = 3 * MiB + 512 * 1024, WS_AB = 4 * MiB;
constexpr size_t WS_WIN = 7 * MiB, WS_WOUT = 13 * MiB, WS_W1 = 15 * MiB, WS_W2 = 23 * MiB, WS_XC = 32 * MiB, WS_HY = 48 * MiB, WS_P = 120 * MiB;
constexpr size_t WS_OD = WS_P + 216 * MiB, WS_QKV = WS_P + 288 * MiB, WS_END = WS_QKV + 64 * MiB;
constexpr int LDS_BYTES = 147456;
constexpr int NWAVES = 8, NTHR = 512;

#define LAS __attribute__((address_space(3)))
typedef unsigned short bf16_t;
typedef float f32x4 __attribute__((ext_vector_type(4)));
typedef short bf16x8 __attribute__((ext_vector_type(8)));
typedef short s16x4 __attribute__((ext_vector_type(4)));
typedef unsigned u32x4 __attribute__((ext_vector_type(4)));
typedef unsigned u32x2 __attribute__((ext_vector_type(2)));

struct Params {
    const float *x, *c, *ctx, *c_ctx, *w_ada, *b_ada, *norm1, *norm2, *w_in, *dn_conv, *dn_A_log, *dn_dt_bias, *dn_norm, *swa_sink, *hg_lb, *hg_norm, *w_out, *w_ff1, *w_ff2, *norm_f;
    float* out; unsigned char* ws;
};

__device__ __forceinline__ float bflo(unsigned u) { return __uint_as_float(u << 16); }
__device__ __forceinline__ float bfhi(unsigned u) { return __uint_as_float(u & 0xffff0000u); }
__device__ __forceinline__ unsigned pk2(float lo, float hi) { return pg8::cvt_pk_bf16(lo, hi); }
__device__ __forceinline__ bf16_t bf1(float f) { return __builtin_bit_cast(bf16_t, (__bf16)f); }
__device__ __forceinline__ float siluf(float v) { return v / (1.f + __expf(-v)); }
__device__ __forceinline__ float sigmf(float v) { return 1.f / (1.f + __expf(-v)); }
__device__ __forceinline__ float wave_sum(float v) {
#pragma unroll
    for (int o = 1; o < 64; o <<= 1) v += __shfl_xor(v, o);
    return v;
}
template <int CTRL> __device__ __forceinline__ float dpp(float x) { return __builtin_bit_cast(float, __builtin_amdgcn_mov_dpp(__builtin_bit_cast(int, x), CTRL, 0xf, 0xf, true)); }
constexpr int XOR1 = 0xB1, XOR2 = 0x4E, XOR7 = 0x141;
__device__ __forceinline__ float sum8(float v) { v += dpp<XOR1>(v); v += dpp<XOR2>(v); v += dpp<XOR7>(v); return v; }
__device__ __forceinline__ float xrow16_max(float x) {
    auto s = __builtin_amdgcn_permlane16_swap(__float_as_uint(x), __float_as_uint(x), false, false);
    x = fmaxf(__uint_as_float(s[0]), __uint_as_float(s[1]));
    auto t = __builtin_amdgcn_permlane32_swap(__float_as_uint(x), __float_as_uint(x), false, false);
    return fmaxf(__uint_as_float(t[0]), __uint_as_float(t[1]));
}
__device__ __forceinline__ float xrow16_sum(float x) {
    auto s = __builtin_amdgcn_permlane16_swap(__float_as_uint(x), __float_as_uint(x), false, false);
    x = __uint_as_float(s[0]) + __uint_as_float(s[1]);
    auto t = __builtin_amdgcn_permlane32_swap(__float_as_uint(x), __float_as_uint(x), false, false);
    return __uint_as_float(t[0]) + __uint_as_float(t[1]);
}
__device__ __forceinline__ const float* xrow_c(const float* Xl, const float* Xc, int r) { const int b = r / TPB, t = r - b * TPB; return t < CTX ? Xc + ((size_t)(b * CTX + t) << 10) : Xl + ((size_t)(b * SEQ + t - CTX) << 10); }
__device__ __forceinline__ int cidx(int r) { const int b = r / TPB, t = r - b * TPB; return t < CTX ? 16 : b; }

__device__ __forceinline__ void phase_prologue(const Params& p, LAS unsigned char* lds, const int wvs) {
    const int tid = wvs * 64 + lane_id_fresh(); const int lane = tid & 63, w = tid >> 6;
    float* mods = (float*)(p.ws + WS_MODS);
    LAS float* sc = (LAS float*)lds;
    LAS float* red = (LAS float*)(lds + 81920);
    for (int idx = tid; idx < 17 * 1024; idx += NTHR) { const int ci = idx >> 10, k = idx & 1023; const float v = ci < 16 ? p.c[ci * 1024 + k] : p.c_ctx[k]; sc[k * 20 + ci] = v / (1.f + expf(-v)); }
    __syncthreads();
    for (int it = blockIdx.x; it < DEPTH * 96; it += gridDim.x) {
        const int l = it / 96, cgp = it - l * 96, col = cgp * 64 + lane;
        float acc[17];
#pragma unroll
        for (int i = 0; i < 17; ++i) acc[i] = 0.f;
        const float* wp = p.w_ada + ((size_t)l * 1024 + w * 128) * 6144 + col;
#pragma unroll 16
        for (int kk = 0; kk < 128; ++kk) {
            const float wv = wp[(size_t)kk * 6144];
            const LAS f32x4* s4 = (const LAS f32x4*)(sc + (w * 128 + kk) * 20);
            const f32x4 s0 = s4[0], s1 = s4[1], s2 = s4[2], s3 = s4[3]; const float s16 = sc[(w * 128 + kk) * 20 + 16];
#pragma unroll
            for (int e = 0; e < 4; ++e) { acc[e] += wv * s0[e]; acc[4 + e] += wv * s1[e]; acc[8 + e] += wv * s2[e]; acc[12 + e] += wv * s3[e]; }
            acc[16] += wv * s16;
        }
#pragma unroll
        for (int i = 0; i < 17; ++i) red[(w * 17 + i) * 64 + lane] = acc[i];
        __syncthreads();
        for (int idx = tid; idx < 17 * 64; idx += NTHR) { const int i = idx >> 6, cl = idx & 63; float s = 0.f;
#pragma unroll
            for (int ww = 0; ww < 8; ++ww) s += red[(ww * 17 + i) * 64 + cl];
            mods[((size_t)l * 17 + i) * 6144 + cgp * 64 + cl] = s + p.b_ada[l * 6144 + cgp * 64 + cl]; }
        __syncthreads();
    }
    const int gt = blockIdx.x * NTHR + tid, GT = gridDim.x * NTHR;
    { float* rc = (float*)(p.ws + WS_ROPE); float* rs = rc + 2048 * 32;
      for (int idx = gt; idx < 2048 * 32; idx += GT) { const int t = idx >> 5, d = idx & 31; const float pos = (float)(d < 16 ? (t >> 6) : (t & 63));
          const float inv = expf(-(float)(d & 15) * (9.210340371976184f / 16.f)); const float ang = pos * inv; rc[idx] = cosf(ang); rs[idx] = sinf(ang); } }
    { float* LB = (float*)(p.ws + WS_LB);
      for (int idx = gt; idx < 2 * 256; idx += GT) { const int d = idx >> 8, cc = idx & 255; float v[DEPTH]; float mx = -1e30f;
#pragma unroll
          for (int l = 0; l < DEPTH; ++l) { v[l] = p.hg_lb[(d * DEPTH + l) * 256 + cc]; mx = fmaxf(mx, v[l]); }
          float s = 0.f;
#pragma unroll
          for (int l = 0; l < DEPTH; ++l) { v[l] = expf(v[l] - mx); s += v[l]; }
          float cum = 0.f;
#pragma unroll
          for (int l = 0; l < DEPTH; ++l) { if (l > 0) cum += v[l] / s; LB[(d * DEPTH + l) * 256 + cc] = cum; } } }
}

__device__ __forceinline__ void transpose_item(const float* W, int K, int ldw, int scol0, bf16_t* WT, int n0, int k0, LAS float* scr, int lane) {
#pragma unroll 8
    for (int i = 0; i < 32; ++i) { const int kk = 2 * i + (lane >> 5); scr[kk * 33 + (lane & 31)] = W[(size_t)(k0 + kk) * ldw + scol0 + (lane & 31)]; }
    asm volatile("s_waitcnt lgkmcnt(0)" ::: "memory");
    const int c = lane & 7;
#pragma unroll
    for (int j = 0; j < 4; ++j) { const int n = (lane >> 3) + 8 * j; const LAS float* s = scr + (8 * c) * 33 + n;
        u32x4 o; o.x = pk2(s[0 * 33], s[1 * 33]); o.y = pk2(s[2 * 33], s[3 * 33]); o.z = pk2(s[4 * 33], s[5 * 33]); o.w = pk2(s[6 * 33], s[7 * 33]);
        *(u32x4*)(WT + (size_t)(n0 + n) * K + k0 + 8 * c) = o; }
    asm volatile("s_waitcnt lgkmcnt(0)" ::: "memory");
}

template <bool FIRST> __device__ __forceinline__ void phase_norm(const Params& p, int l, LAS unsigned char* lds, const int wvs) {
    const int tid = wvs * 64 + lane_id_fresh(); const int lane = tid & 63, w = tid >> 6;
    const int gw = blockIdx.x * NWAVES + w, NGW = gridDim.x * NWAVES;
    const float* mods = (const float*)(p.ws + WS_MODS);
    constexpr int WST = 1032;
    LAS bf16_t* wab = (LAS bf16_t*)lds;
    if (FIRST) {
        LAS float* scr = (LAS float*)(lds + 65536 + w * 8704);
        constexpr int I_IN = 16 * 96, I_OUT = 16 * 32, I_1 = 16 * 128, I_2 = 64 * 32;
        for (int it = gw; it < I_IN + I_OUT + I_1 + I_2; it += NGW) {
            int r = it;
            if (r < I_IN) { const int kb = r / 96, nb = r - kb * 96; const int n0 = nb * 32; transpose_item(p.w_in + (size_t)l * D * DIN, D, DIN, n0 + (n0 >= 1024 ? 16 : 0), (bf16_t*)(p.ws + WS_WIN), n0, kb * 64, scr, lane); continue; }
            r -= I_IN;
            if (r < I_OUT) { const int kb = r / 32, nb = r - kb * 32; transpose_item(p.w_out + (size_t)l * D * D, D, D, nb * 32, (bf16_t*)(p.ws + WS_WOUT), nb * 32, kb * 64, scr, lane); continue; }
            r -= I_OUT;
            if (r < I_1) { const int kb = r / 128, nb = r - kb * 128; transpose_item(p.w_ff1 + (size_t)l * D * DFF, D, DFF, nb * 32, (bf16_t*)(p.ws + WS_W1), nb * 32, kb * 64, scr, lane); continue; }
            r -= I_1;
            { const int kb = r / 32, nb = r - kb * 32; transpose_item(p.w_ff2 + (size_t)l * DFF * D, DFF, D, nb * 32, (bf16_t*)(p.ws + WS_W2), nb * 32, kb * 64, scr, lane); }
        }
        const float* wi = p.w_in + (size_t)l * D * DIN + 1024;
        for (int idx = tid; idx < 4096; idx += NTHR) { const int k = idx >> 2, j4 = (idx & 3) * 4; const f32x4 v = *(const f32x4*)(wi + (size_t)k * DIN + j4);
#pragma unroll
            for (int e = 0; e < 4; ++e) wab[(j4 + e) * WST + k] = bf1(v[e]); }
        __syncthreads();
    }
    const float* nw = (FIRST ? p.norm1 : p.norm2) + l * D;
    bf16_t* H = (bf16_t*)(p.ws + WS_HY);
    float* AB = (float*)(p.ws + WS_AB);
    float* Xc = (float*)(p.ws + WS_XC);
    const float* part = (const float*)(p.ws + WS_QKV);
    const bool fix = FIRST ? (l > 0) : (l < DEPTH - 1);
    const float* fgate = mods + ((size_t)(FIRST ? (l > 0 ? l - 1 : 0) : l) * 17 + 16) * 6144 + (FIRST ? 5 : 2) * 1024;
    int nrows = 0;
    for (int r = gw; r < M; r += NGW) {
        ++nrows;
        if (!FIRST && l == DEPTH - 1 && (r % TPB) < CTX) continue;
        const f32x4* xr = (const f32x4*)((FIRST && l == 0) ? xrow_c(p.x, p.ctx, r) : xrow_c(p.out, Xc, r)) + lane;
        f32x4 v[4]; float ss = 0.f;
        const int rb = r / TPB, rt = r - rb * TPB;
        if (fix && rt < CTX) {
            const f32x4* xin = (const f32x4*)((!FIRST && l == 0) ? p.ctx + ((size_t)(rb * CTX + rt) << 10) : Xc + ((size_t)(rb * CTX + rt) << 10)) + lane;
            const f32x4* pr = (const f32x4*)(part + ((size_t)(rb * CTX + rt) << 10)) + lane; f32x4* xo = (f32x4*)(Xc + ((size_t)(rb * CTX + rt) << 10)) + lane;
#pragma unroll
            for (int j = 0; j < 4; ++j) { const f32x4 gq = *(const f32x4*)(fgate + 4 * (lane + 64 * j));
                const f32x4 s4 = (pr[64 * j] + pr[64 * j + 1048576]) + (pr[64 * j + 2 * 1048576] + pr[64 * j + 3 * 1048576]);
                v[j] = xin[64 * j] + gq * s4; xo[64 * j] = v[j]; }
        } else {
#pragma unroll
            for (int j = 0; j < 4; ++j) v[j] = xr[64 * j];
        }
#pragma unroll
        for (int j = 0; j < 4; ++j) ss += (v[j][0] * v[j][0] + v[j][1] * v[j][1]) + (v[j][2] * v[j][2] + v[j][3] * v[j][3]);
        const float rstd = rsqrtf(wave_sum(ss) * (1.f / D) + EPS);
        const float* md = mods + ((size_t)l * 17 + cidx(r)) * 6144 + (FIRST ? 0 : 3 * 1024);
        u32x2* hp = (u32x2*)(H + (size_t)r * D) + lane;
#pragma unroll
        for (int j = 0; j < 4; ++j) { const int k = 4 * (lane + 64 * j);
            const f32x4 g = *(const f32x4*)(nw + k), sh = *(const f32x4*)(md + k), sl = *(const f32x4*)(md + 1024 + k);
            f32x4 h;
#pragma unroll
            for (int e = 0; e < 4; ++e) h[e] = (v[j][e] * rstd * g[e]) * (1.f + sl[e]) + sh[e];
            u32x2 o2; o2.x = pk2(h[0], h[1]); o2.y = pk2(h[2], h[3]); hp[64 * j] = o2;
        }
    }
    if (FIRST) {
        asm volatile("s_waitcnt vmcnt(0)" ::: "memory");
        const int fr = lane & 15, fq = lane >> 4;
        for (int b0 = 0; b0 < nrows; b0 += 16) {
            const int kr = b0 + fr; const bool ok = kr < nrows; const bf16_t* hp = H + (size_t)(gw + (ok ? kr : 0) * NGW) * D + fq * 8;
            f32x4 c = (f32x4){0.f, 0.f, 0.f, 0.f};
#pragma unroll 8
            for (int ks = 0; ks < 32; ++ks) { u32x4 av = *(const u32x4*)(hp + ks * 32); if (!ok) av = (u32x4){0u, 0u, 0u, 0u};
                const bf16x8 bv = *(const LAS bf16x8*)(wab + fr * WST + ks * 32 + fq * 8);
                c = __builtin_amdgcn_mfma_f32_16x16x32_bf16(__builtin_bit_cast(bf16x8, av), bv, c, 0, 0, 0); }
#pragma unroll
            for (int j = 0; j < 4; ++j) { const int k2 = b0 + fq * 4 + j; if (k2 < nrows) AB[(size_t)(gw + k2 * NGW) * 16 + fr] = c[j]; }
        }
    }
}

constexpr int SST = 68;
constexpr int HST = 72;
__device__ __forceinline__ bf16x8 ldA_perm(const LAS bf16_t* base, int row, int s, int fq) {
    const LAS bf16_t* ap = base + row * HST + s * 32 + fq * 4; const u32x2 lo = *(const LAS u32x2*)ap, hi = *(const LAS u32x2*)(ap + 16);
    u32x4 av; av[0] = lo[0]; av[1] = lo[1]; av[2] = hi[0]; av[3] = hi[1]; return __builtin_bit_cast(bf16x8, av);
}
__device__ __forceinline__ bf16x8 packB(const f32x4& a, const f32x4& b) {
    u32x4 pb; pb[0] = pk2(a[0], a[1]); pb[1] = pk2(a[2], a[3]); pb[2] = pk2(b[0], b[1]); pb[3] = pk2(b[2], b[3]);
    return __builtin_bit_cast(bf16x8, pb);
}
__device__ __forceinline__ void phase_dnprep(const Params& p, int l, LAS unsigned char* lds, const int wvs) {
    const int tid = wvs * 64 + lane_id_fresh();
    constexpr int RST = 200;
    LAS float* qs = (LAS float*)lds; LAS float* ks = qs + 64 * SST; LAS float* vs = ks + 64 * SST; LAS bf16_t* RAW = (LAS bf16_t*)(vs + 64 * SST);
    const bf16_t* P = (const bf16_t*)(p.ws + WS_P);
    bf16_t* QKV = (bf16_t*)(p.ws + WS_QKV);
    const float* cw = p.dn_conv + (size_t)l * 5 * 768;
    const int c4 = tid % 48, tg = tid / 48;
    LAS float* cdst = ((c4 >> 4) == 0 ? qs : ((c4 >> 4) == 1 ? ks : vs)) + (c4 & 15) * 4;
#define PREP_LOADRAW(itx) do { const int h_ = (itx) & 3, bc_ = (itx) >> 2, b_ = bc_ / 36, nc_ = bc_ - b_ * 36; const int base_ = b_ * TPB + nc_ * 64, lo_ = b_ * TPB + (nc_ < 4 ? 0 : CTX), hi_ = b_ * TPB + (nc_ < 4 ? CTX : TPB); \
        _Pragma("unroll") for (int k = 0; k < 4; ++k) { const int q = tid + NTHR * k; const int rr = q / 24, pc = q - rr * 24; const int r = base_ - 2 + rr; \
            praw[k] = (q < 68 * 24 && r >= lo_ && r < hi_) ? *(const u32x4*)(P + (size_t)r * NP + (pc >> 3) * 256 + h_ * 64 + (pc & 7) * 8) : (u32x4){0u, 0u, 0u, 0u}; } } while (0)
    u32x4 praw[4];
    if ((int)blockIdx.x < BATCH * 36 * 4) PREP_LOADRAW((int)blockIdx.x);
    for (int it = blockIdx.x; it < BATCH * 36 * 4; it += gridDim.x) {
        const int h = it & 3, bc = it >> 2, b = bc / 36, nc = bc - b * 36;
        const int base = b * TPB + nc * 64;
        float wc[5][4];
        { const int ch = c4 * 4, pcol = (ch >> 6) * 256 + h * 64 + (ch & 63);
#pragma unroll
          for (int t = 0; t < 5; ++t) { const f32x4 w4 = *(const f32x4*)(cw + t * 768 + pcol); wc[t][0] = w4[0]; wc[t][1] = w4[1]; wc[t][2] = w4[2]; wc[t][3] = w4[3]; } }
#pragma unroll
        for (int k = 0; k < 4; ++k) { const int q = tid + NTHR * k; if (q < 68 * 24) { const int rr = q / 24, pc = q - rr * 24; *(LAS u32x4*)(RAW + rr * RST + pc * 8) = praw[k]; } }
        if (it + (int)gridDim.x < BATCH * 36 * 4) PREP_LOADRAW(it + (int)gridDim.x);
        __syncthreads();
        if (tid < 480) {
#pragma unroll
            for (int m = 0; m < 7; ++m) { const int pp = tg + 10 * m; if (pp < 64) { float a0 = 0.f, a1 = 0.f, a2 = 0.f, a3 = 0.f;
#pragma unroll
                for (int t = 0; t < 5; ++t) { const u32x2 raw = *(const LAS u32x2*)(RAW + (pp + t) * RST + c4 * 4);
                    a0 += bflo(raw[0]) * wc[t][0]; a1 += bfhi(raw[0]) * wc[t][1]; a2 += bflo(raw[1]) * wc[t][2]; a3 += bfhi(raw[1]) * wc[t][3]; }
                f32x4 o; o[0] = a0 / (1.f + __expf(-a0)); o[1] = a1 / (1.f + __expf(-a1)); o[2] = a2 / (1.f + __expf(-a2)); o[3] = a3 / (1.f + __expf(-a3));
                *(LAS f32x4*)(cdst + pp * SST) = o; } } }
        __syncthreads();
        { const int t = tid >> 3, part = tid & 7;
          const f32x4 q0 = *(const LAS f32x4*)(qs + t * SST + part * 8), q1 = *(const LAS f32x4*)(qs + t * SST + part * 8 + 4);
          const f32x4 k0 = *(const LAS f32x4*)(ks + t * SST + part * 8), k1 = *(const LAS f32x4*)(ks + t * SST + part * 8 + 4);
          const f32x4 v0 = *(const LAS f32x4*)(vs + t * SST + part * 8), v1 = *(const LAS f32x4*)(vs + t * SST + part * 8 + 4);
          float sq = (q0[0] * q0[0] + q0[1] * q0[1]) + (q0[2] * q0[2] + q0[3] * q0[3]) + (q1[0] * q1[0] + q1[1] * q1[1]) + (q1[2] * q1[2] + q1[3] * q1[3]);
          float sk = (k0[0] * k0[0] + k0[1] * k0[1]) + (k0[2] * k0[2] + k0[3] * k0[3]) + (k1[0] * k1[0] + k1[1] * k1[1]) + (k1[2] * k1[2] + k1[3] * k1[3]);
          sq = sum8(sq); sk = sum8(sk);
          const float rq = rsqrtf(sq + EPS) * 0.125f, rk = rsqrtf(sk + EPS);
          u32x4 qo, ko, vo;
          qo[0] = pk2(q0[0] * rq, q0[1] * rq); qo[1] = pk2(q0[2] * rq, q0[3] * rq); qo[2] = pk2(q1[0] * rq, q1[1] * rq); qo[3] = pk2(q1[2] * rq, q1[3] * rq);
          ko[0] = pk2(k0[0] * rk, k0[1] * rk); ko[1] = pk2(k0[2] * rk, k0[3] * rk); ko[2] = pk2(k1[0] * rk, k1[1] * rk); ko[3] = pk2(k1[2] * rk, k1[3] * rk);
          vo[0] = pk2(v0[0], v0[1]); vo[1] = pk2(v0[2], v0[3]); vo[2] = pk2(v1[0], v1[1]); vo[3] = pk2(v1[2], v1[3]);
          bf16_t* dst = QKV + ((size_t)(base + t) * 4 + h) * 192 + part * 8;
          *(u32x4*)dst = qo; *(u32x4*)(dst + 64) = ko; *(u32x4*)(dst + 128) = vo; }
        __syncthreads();
    }
#undef PREP_LOADRAW
    { bf16_t* Pw = (bf16_t*)(p.ws + WS_P); const float* rc = (const float*)(p.ws + WS_ROPE); const float* rs = rc + 2048 * 32;
      const int gt = blockIdx.x * NTHR + tid, GT = gridDim.x * NTHR;
      for (int idx = gt; idx < BATCH * SEQ * 8; idx += GT) { const int rl = idx >> 3, rem = idx & 7, kh = rem >> 2, g = rem & 3;
          const int bb = rl >> 11, t = rl & 2047;
          bf16_t* pp = Pw + (size_t)(bb * TPB + CTX + t) * NP + PC_SK + kh * 64 + g * 8;
          const u32x4 r1 = *(const u32x4*)pp, r2 = *(const u32x4*)(pp + 32);
          const f32x4 c0 = *(const f32x4*)(rc + t * 32 + g * 8), c1 = *(const f32x4*)(rc + t * 32 + g * 8 + 4), s0 = *(const f32x4*)(rs + t * 32 + g * 8), s1 = *(const f32x4*)(rs + t * 32 + g * 8 + 4);
          u32x4 o1, o2;
#pragma unroll
          for (int e = 0; e < 4; ++e) { const float xa = bflo(r1[e]), xb = bfhi(r1[e]), ya = bflo(r2[e]), yb = bfhi(r2[e]);
              const float ca = e < 2 ? c0[2 * e] : c1[2 * e - 4], cb = e < 2 ? c0[2 * e + 1] : c1[2 * e - 3], sa = e < 2 ? s0[2 * e] : s1[2 * e - 4], sb = e < 2 ? s0[2 * e + 1] : s1[2 * e - 3];
              o1[e] = pk2(xa * ca - ya * sa, xb * cb - yb * sb); o2[e] = pk2(xa * sa + ya * ca, xb * sb + yb * cb); }
          *(u32x4*)pp = o1; *(u32x4*)(pp + 32) = o2; } }
}

__device__ __forceinline__ void dn_seq(const Params& p, int l, int s, LAS unsigned char* lds, const int wvs) {
    const int tid = wvs * 64 + lane_id_fresh(); const int lane = tid & 63;
    const int b = s >> 3, h = (s >> 1) & 3, d = s & 1;
    constexpr int TILEB = 64 * HST * 2, BUFB = 6 * TILEB + 4 * 16 * 24 * 2 + 1024;
    LAS bf16_t* OB = (LAS bf16_t*)(lds + 2 * BUFB); LAS float* LF = (LAS float*)(lds + 2 * BUFB + TILEB);
    const bf16_t* QKV = (const bf16_t*)(p.ws + WS_QKV);
    const float* AB = (const float*)(p.ws + WS_AB);
    bf16_t* OD = (bf16_t*)(p.ws + WS_OD) + (size_t)d * M * 512 + h * 64;
    const float nA = -expf(p.dn_A_log[(l * 2 + d) * 4 + h]); const float dtb = p.dn_dt_bias[(l * 2 + d) * 4 + h];
    const int fr = lane & 15, fq = lane >> 4, V = wvs & 3;
    const bool isP = wvs < 4;
    const f32x4 zero4 = (f32x4){0.f, 0.f, 0.f, 0.f};
    u32x4 praw[6]; float pa = 0.f, pb_ = 0.f;
    f32x4 Sacc[4], R[4], QS[4];
#pragma unroll
    for (int T = 0; T < 4; ++T) { Sacc[T] = zero4; R[T] = zero4; QS[T] = zero4; }
#define DN_BASE(ci) (b * TPB + ((d == 0) ? (ci) : ((ci) < 4 ? 3 - (ci) : 39 - (ci))) * 64)
#define DN_LOADRAW(ci) do { const int base_ = DN_BASE(ci); _Pragma("unroll") for (int k = 0; k < 6; ++k) { const int q = tid + 256 * k; const int rr = q / 24, pc = q - rr * 24; \
            praw[k] = *(const u32x4*)(QKV + ((size_t)(base_ + rr) * 4 + h) * 192 + pc * 8); } \
        if (wvs == 0) { const int r_ = base_ + (d ? 63 - lane : lane); pa = AB[(size_t)r_ * 16 + d * 4 + h]; pb_ = AB[(size_t)r_ * 16 + 8 + d * 4 + h]; } } while (0)
#define DN_S1(buf) do { LAS bf16_t* QH_ = (LAS bf16_t*)(lds + (buf) * BUFB); LAS float* SCL_ = (LAS float*)(lds + (buf) * BUFB + 6 * TILEB + 4 * 16 * 24 * 2); \
        _Pragma("unroll") for (int k = 0; k < 6; ++k) { const int q = tid + 256 * k; const int rr = q / 24, pc = q - rr * 24; const int t = d ? 63 - rr : rr; \
            *(LAS u32x4*)(QH_ + (pc >> 3) * 64 * HST + t * HST + (pc & 7) * 8) = praw[k]; } \
        if (wvs == 0) { const float xs = pa + dtb; const float sp = xs > 15.f ? xs : (xs < -15.f ? __expf(xs) : __logf(1.f + __expf(xs))); float x = nA * sp; \
            _Pragma("unroll") for (int o = 1; o < 64; o <<= 1) { const float y = __shfl_up(x, o); if (lane >= o) x += y; } \
            SCL_[lane] = x; SCL_[64 + lane] = __expf(x); SCL_[128 + lane] = __builtin_amdgcn_rcpf(1.f + __expf(-pb_)); if (lane == 63) { SCL_[192] = x; SCL_[193] = __expf(x); } } } while (0)
    if (isP) { DN_LOADRAW(0); DN_S1(0); }
    __syncthreads();
    for (int ci = -1; ci < 36; ++ci) {
        const int cur = ci & 1, nxt = cur ^ 1;
        LAS bf16_t* QH = (LAS bf16_t*)(lds + cur * BUFB); LAS bf16_t* KH = QH + 64 * HST; LAS bf16_t* VB = KH + 64 * HST; LAS bf16_t* KTT = VB + 64 * HST; LAS bf16_t* LM = KTT + 64 * HST; LAS bf16_t* SCM = LM + 64 * HST;
        LAS bf16_t* DI = SCM + 64 * HST; LAS float* GC = (LAS float*)(DI + 4 * 16 * 24); LAS float* EG = GC + 64; LAS float* BETA = EG + 64; LAS float* GL = BETA + 64;
        if (isP) { if (ci >= 0 && ci + 1 < 36) DN_S1(nxt); }
        else if (ci >= 0) {
            if (ci > 0) { const int basep = DN_BASE(ci - 1); const int u = tid - 256;
#pragma unroll
                for (int it = 0; it < 8; ++it) { const int idx = u + 256 * it; const int i = idx >> 5, c2 = (idx & 31) * 2; const int row = basep + (d ? 63 - i : i);
                    *(unsigned*)(OD + (size_t)row * 512 + c2) = *(const LAS unsigned*)(OB + i * HST + c2); } }
            bf16x8 Bs[2];
#pragma unroll
            for (int s2 = 0; s2 < 2; ++s2) Bs[s2] = packB(Sacc[2 * s2], Sacc[2 * s2 + 1]);
#pragma unroll
            for (int I = 0; I < 4; ++I) { f32x4 c = zero4, cq = zero4;
#pragma unroll
                for (int s2 = 0; s2 < 2; ++s2) { c = __builtin_amdgcn_mfma_f32_16x16x32_bf16(ldA_perm(KH, I * 16 + fr, s2, fq), Bs[s2], c, 0, 0, 0); cq = __builtin_amdgcn_mfma_f32_16x16x32_bf16(ldA_perm(QH, I * 16 + fr, s2, fq), Bs[s2], cq, 0, 0, 0); }
#pragma unroll
                for (int r = 0; r < 4; ++r) { const int i = I * 16 + fq * 4 + r; R[I][r] = BETA[i] * (bflo((unsigned)VB[i * HST + V * 16 + fr]) - EG[i] * c[r]); QS[I][r] = EG[i] * cq[r]; } }
        }
        __syncthreads();
        if (isP) {
            const int pb2 = (ci < 0) ? 0 : nxt;
            if (ci + 1 < 36) {
                LAS bf16_t* QHn = (LAS bf16_t*)(lds + pb2 * BUFB); LAS bf16_t* KHn = QHn + 64 * HST; LAS bf16_t* KTTn = KHn + 2 * 64 * HST; LAS bf16_t* LMn = KTTn + 64 * HST; LAS bf16_t* SCMn = LMn + 64 * HST;
                LAS bf16_t* DIn = SCMn + 64 * HST; LAS float* GCn = (LAS float*)(DIn + 4 * 16 * 24); LAS float* BETAn = GCn + 128; LAS float* GLn = GCn + 192;
                { const int t = tid >> 2, part = tid & 3; const float ekt = __expf(GLn[0] - GCn[t]);
#pragma unroll
                  for (int hh = 0; hh < 2; ++hh) { const u32x4 kr = *(const LAS u32x4*)(KHn + t * HST + part * 16 + hh * 8);
#pragma unroll
                      for (int e = 0; e < 4; ++e) { KTTn[(part * 16 + hh * 8 + 2 * e) * HST + t] = bf1(bflo(kr[e]) * ekt); KTTn[(part * 16 + hh * 8 + 2 * e + 1) * HST + t] = bf1(bfhi(kr[e]) * ekt); } } }
                { const int I = wvs;
                  float gci[4], bti[4], gcj[4];
#pragma unroll
                  for (int r = 0; r < 4; ++r) { gci[r] = GCn[I * 16 + fq * 4 + r]; bti[r] = BETAn[I * 16 + fq * 4 + r]; gcj[r] = GCn[r * 16 + fr]; }
#pragma unroll
                  for (int J = 0; J < 4; ++J) { f32x4 ckk = zero4, cqk = zero4;
                      if (J <= I) {
#pragma unroll
                          for (int kk = 0; kk < 2; ++kk) { const bf16x8 Ak = *(const LAS bf16x8*)(KHn + (I * 16 + fr) * HST + kk * 32 + fq * 8), Aq = *(const LAS bf16x8*)(QHn + (I * 16 + fr) * HST + kk * 32 + fq * 8);
                              const bf16x8 B = *(const LAS bf16x8*)(KHn + (J * 16 + fr) * HST + kk * 32 + fq * 8);
                              ckk = __builtin_amdgcn_mfma_f32_16x16x32_bf16(Ak, B, ckk, 0, 0, 0); cqk = __builtin_amdgcn_mfma_f32_16x16x32_bf16(Aq, B, cqk, 0, 0, 0); } }
                      const int j = J * 16 + fr; const float gj = gcj[J];
#pragma unroll
                      for (int r = 0; r < 4; ++r) { const int i = I * 16 + fq * 4 + r; const float dec = __expf(fminf(gci[r] - gj, 0.f));
                          const float lvv = bti[r] * ckk[r] * dec, svv = cqk[r] * dec;
                          const float lv = j < i ? lvv : 0.f, sv = j <= i ? svv : 0.f;
                          LMn[i * HST + j] = bf1(lv); SCMn[i * HST + j] = bf1(sv); if (I == J) LF[(I * 16 + fq * 4 + r) * 20 + fr] = lv; } }
                  asm volatile("s_waitcnt lgkmcnt(0)" ::: "memory");
                  { const int c = lane & 15; float x[16];
#pragma unroll
                    for (int i = 0; i < 16; ++i) { float acc = (i == c) ? 1.f : 0.f;
#pragma unroll
                        for (int j4 = 0; j4 < (i + 3) / 4; ++j4) { const f32x4 Lr = *(const LAS f32x4*)(LF + (I * 16 + i) * 20 + j4 * 4);
#pragma unroll
                            for (int e = 0; e < 4; ++e) if (j4 * 4 + e < i) acc -= Lr[e] * x[j4 * 4 + e]; }
                        x[i] = acc; }
                    if (lane < 16) {
#pragma unroll
                        for (int i = 0; i < 16; ++i) DIn[(I * 16 + i) * 24 + c] = bf1(x[i]); } } }
                if (ci + 2 < 36) DN_LOADRAW(ci + 2);
            }
        } else if (ci >= 0) {
            bf16x8 Bx0, Bx1;
            { bf16x8 AD[4];
#pragma unroll
              for (int I = 0; I < 4; ++I) { const u32x2 lo = *(const LAS u32x2*)(DI + (I * 16 + fr) * 24 + fq * 4); u32x4 av; av[0] = lo[0]; av[1] = lo[1]; av[2] = 0u; av[3] = 0u; AD[I] = __builtin_bit_cast(bf16x8, av); }
              const f32x4 X0 = __builtin_amdgcn_mfma_f32_16x16x32_bf16(AD[0], packB(R[0], zero4), zero4, 0, 0, 0);
              f32x4 T1 = __builtin_amdgcn_mfma_f32_16x16x32_bf16(ldA_perm(LM, 16 + fr, 0, fq), packB(X0, zero4), zero4, 0, 0, 0);
              const f32x4 X1 = __builtin_amdgcn_mfma_f32_16x16x32_bf16(AD[1], packB(R[1] - T1, zero4), zero4, 0, 0, 0);
              Bx0 = packB(X0, X1);
              f32x4 T2 = __builtin_amdgcn_mfma_f32_16x16x32_bf16(ldA_perm(LM, 32 + fr, 0, fq), Bx0, zero4, 0, 0, 0);
              const f32x4 X2 = __builtin_amdgcn_mfma_f32_16x16x32_bf16(AD[2], packB(R[2] - T2, zero4), zero4, 0, 0, 0);
              f32x4 T3 = __builtin_amdgcn_mfma_f32_16x16x32_bf16(ldA_perm(LM, 48 + fr, 0, fq), Bx0, zero4, 0, 0, 0);
              T3 = __builtin_amdgcn_mfma_f32_16x16x32_bf16(ldA_perm(LM, 48 + fr, 1, fq), packB(X2, zero4), T3, 0, 0, 0);
              const f32x4 X3 = __builtin_amdgcn_mfma_f32_16x16x32_bf16(AD[3], packB(R[3] - T3, zero4), zero4, 0, 0, 0);
              Bx1 = packB(X2, X3); }
#pragma unroll
            for (int I = 0; I < 4; ++I) { f32x4 c = QS[I];
                c = __builtin_amdgcn_mfma_f32_16x16x32_bf16(ldA_perm(SCM, I * 16 + fr, 0, fq), Bx0, c, 0, 0, 0);
                c = __builtin_amdgcn_mfma_f32_16x16x32_bf16(ldA_perm(SCM, I * 16 + fr, 1, fq), Bx1, c, 0, 0, 0);
#pragma unroll
                for (int r = 0; r < 4; ++r) OB[(I * 16 + fq * 4 + r) * HST + V * 16 + fr] = bf1(c[r]); }
            { const float egl = GL[1];
#pragma unroll
              for (int T = 0; T < 4; ++T) { f32x4 c = Sacc[T] * egl;
                  c = __builtin_amdgcn_mfma_f32_16x16x32_bf16(ldA_perm(KTT, T * 16 + fr, 0, fq), Bx0, c, 0, 0, 0);
                  c = __builtin_amdgcn_mfma_f32_16x16x32_bf16(ldA_perm(KTT, T * 16 + fr, 1, fq), Bx1, c, 0, 0, 0);
                  Sacc[T] = c; } }
        }
        __syncthreads();
    }
    if (!isP) { const int basep = DN_BASE(35); const int u = tid - 256;
#pragma unroll
        for (int it = 0; it < 8; ++it) { const int idx = u + 256 * it; const int i = idx >> 5, c2 = (idx & 31) * 2; const int row = basep + (d ? 63 - i : i);
            *(unsigned*)(OD + (size_t)row * 512 + c2) = *(const LAS unsigned*)(OB + i * HST + c2); } }
    __syncthreads();
#undef DN_BASE
#undef DN_LOADRAW
#undef DN_S1
}

__device__ __forceinline__ void hg_seq(const Params& p, int l, int s, LAS unsigned char* lds, const int wvs) {
    const int tid = wvs * 64 + lane_id_fresh(); const int lane = tid & 63;
    const int b = s >> 3, h = (s >> 1) & 3, d = s & 1;
    constexpr int BUFB = 5 * 64 * HST * 2;
    LAS bf16_t* SC = (LAS bf16_t*)(lds + 2 * BUFB); LAS bf16_t* OB = SC + 64 * HST;
    LAS float* GS = (LAS float*)(OB + 64 * HST); LAS float* EBL = GS + 256;
    const bf16_t* P = (const bf16_t*)(p.ws + WS_P);
    bf16_t* OD = (bf16_t*)(p.ws + WS_OD) + (size_t)d * M * 512 + 256 + h * 64;
    const bool isA = wvs < 4;
    const int kx = tid & 63, g = wvs & 3;
    const float lb = ((const float*)(p.ws + WS_LB))[(d * DEPTH + l) * 256 + h * 64 + kx];
    const int fr = lane & 15, fq = lane >> 4, V = wvs & 3;
    f32x4 Sacc[4];
#pragma unroll
    for (int T = 0; T < 4; ++T) Sacc[T] = (f32x4){0.f, 0.f, 0.f, 0.f};
    unsigned short rq[16], rz[16], rv[16];
    float qv[16], kv[16], bc[16];
#define HG_BASE(ci) (b * TPB + ((d == 0) ? (ci) : ((ci) < 4 ? 3 - (ci) : 39 - (ci))) * 64)
#define HG_LOADRAW(ci) do { const int base_ = HG_BASE(ci); _Pragma("unroll") for (int e = 0; e < 16; ++e) { const int t = g * 16 + e; const int pp = d ? 63 - t : t; const bf16_t* rp = P + (size_t)(base_ + pp) * NP + h * 64 + kx; \
        rq[e] = rp[PC_HQ]; rz[e] = rp[PC_HF + d * 256]; rv[e] = rp[PC_HI]; } } while (0)
#define HG_A1(buf) do { LAS bf16_t* VT_ = (LAS bf16_t*)(lds + (buf) * BUFB) + 4 * 64 * HST; float run = 0.f; \
        _Pragma("unroll") for (int e = 0; e < 16; ++e) { const float z = bflo(rz[e]); const float sg = __builtin_amdgcn_rcpf(1.f + __expf(-z)); const float f = lb + (1.f - lb) * sg; \
            run += __logf(f); bc[e] = run; kv[e] = (1.f - lb) * (1.f - sg); qv[e] = bflo(rq[e]); VT_[kx * HST + g * 16 + e] = rv[e]; } \
        GS[g * 64 + kx] = run; } while (0)
#define HG_A2(buf) do { LAS bf16_t* QT_ = (LAS bf16_t*)(lds + (buf) * BUFB); LAS bf16_t* KT_ = QT_ + 64 * HST; LAS bf16_t* QP_ = KT_ + 64 * HST; LAS bf16_t* KTT_ = QP_ + 64 * HST; \
        const float g0 = GS[kx], g1 = GS[64 + kx], g2 = GS[128 + kx], g3 = GS[192 + kx]; const float mid = g0 + g1, bl = (g0 + g1) + (g2 + g3); \
        const float off = (g > 0 ? g0 : 0.f) + (g > 1 ? g1 : 0.f) + (g > 2 ? g2 : 0.f); \
        if (g == 3) EBL[(buf) * 64 + kx] = __expf(bl); \
        _Pragma("unroll") for (int e = 0; e < 16; ++e) { const int t = g * 16 + e; const float bce = bc[e] + off; const float E = fminf(fmaxf(bce - mid, -80.f), 80.f); \
            QT_[t * HST + kx] = bf1(qv[e] * __expf(E)); KT_[t * HST + kx] = bf1(kv[e] * __expf(-E)); \
            QP_[t * HST + kx] = bf1(qv[e] * __expf(bce)); KTT_[kx * HST + t] = bf1(kv[e] * __expf(bl - bce)); } } while (0)
    if (isA) { HG_LOADRAW(0); HG_A1(0); }
    __syncthreads();
    if (isA) { HG_A2(0); HG_LOADRAW(1); }
    __syncthreads();
    for (int ci = 0; ci < 36; ++ci) {
        const int cur = ci & 1, nxt = cur ^ 1;
        LAS bf16_t* QT = (LAS bf16_t*)(lds + cur * BUFB); LAS bf16_t* KT = QT + 64 * HST; LAS bf16_t* QP = KT + 64 * HST; LAS bf16_t* KTT = QP + 64 * HST; LAS bf16_t* VT = KTT + 64 * HST;
        if (isA) { if (ci + 1 < 36) HG_A1(nxt); }
        else {
            if (ci > 0) { const int basep = HG_BASE(ci - 1); const int u = tid - 256;
#pragma unroll
                for (int it = 0; it < 8; ++it) { const int idx = u + 256 * it; const int i = idx >> 5, c2 = (idx & 31) * 2; const int row = basep + (d ? 63 - i : i);
                    *(unsigned*)(OD + (size_t)row * 512 + c2) = *(const LAS unsigned*)(OB + i * HST + c2); } }
            { const int I = V;
#pragma unroll
              for (int J = 0; J < 4; ++J) { f32x4 c = (f32x4){0.f, 0.f, 0.f, 0.f};
                  if (J <= I) {
#pragma unroll
                      for (int kk = 0; kk < 2; ++kk) { const bf16x8 A = *(const LAS bf16x8*)(QT + (I * 16 + fr) * HST + kk * 32 + fq * 8); const bf16x8 B = *(const LAS bf16x8*)(KT + (J * 16 + fr) * HST + kk * 32 + fq * 8);
                          c = __builtin_amdgcn_mfma_f32_16x16x32_bf16(A, B, c, 0, 0, 0); } }
#pragma unroll
                  for (int r = 0; r < 4; ++r) { const int i = I * 16 + fq * 4 + r, j = J * 16 + fr; SC[i * HST + j] = bf1(j <= i ? c[r] : 0.f); } } }
        }
        __syncthreads();
        if (isA) { if (ci + 1 < 36) { HG_A2(nxt); if (ci + 2 < 36) HG_LOADRAW(ci + 2); } }
        else {
            bf16x8 Bs[2], Bv[2];
#pragma unroll
            for (int s2 = 0; s2 < 2; ++s2) { Bs[s2] = packB(Sacc[2 * s2], Sacc[2 * s2 + 1]); Bv[s2] = *(const LAS bf16x8*)(VT + (V * 16 + fr) * HST + s2 * 32 + fq * 8); }
#pragma unroll
            for (int I = 0; I < 4; ++I) { f32x4 o = (f32x4){0.f, 0.f, 0.f, 0.f};
#pragma unroll
                for (int s2 = 0; s2 < 2; ++s2) o = __builtin_amdgcn_mfma_f32_16x16x32_bf16(ldA_perm(QP, I * 16 + fr, s2, fq), Bs[s2], o, 0, 0, 0);
#pragma unroll
                for (int s2 = 0; s2 < 2; ++s2) { const bf16x8 A = *(const LAS bf16x8*)(SC + (I * 16 + fr) * HST + s2 * 32 + fq * 8); o = __builtin_amdgcn_mfma_f32_16x16x32_bf16(A, Bv[s2], o, 0, 0, 0); }
#pragma unroll
                for (int r = 0; r < 4; ++r) OB[(I * 16 + fq * 4 + r) * HST + V * 16 + fr] = bf1(o[r]); }
#pragma unroll
            for (int T = 0; T < 4; ++T) { f32x4 c;
#pragma unroll
                for (int r = 0; r < 4; ++r) c[r] = Sacc[T][r] * EBL[cur * 64 + T * 16 + fq * 4 + r];
#pragma unroll
                for (int s2 = 0; s2 < 2; ++s2) { const bf16x8 A = *(const LAS bf16x8*)(KTT + (T * 16 + fr) * HST + s2 * 32 + fq * 8); c = __builtin_amdgcn_mfma_f32_16x16x32_bf16(A, Bv[s2], c, 0, 0, 0); }
                Sacc[T] = c; }
        }
        __syncthreads();
    }
    if (!isA) { const int basep = HG_BASE(35); const int u = tid - 256;
#pragma unroll
        for (int it = 0; it < 8; ++it) { const int idx = u + 256 * it; const int i = idx >> 5, c2 = (idx & 31) * 2; const int row = basep + (d ? 63 - i : i);
            *(unsigned*)(OD + (size_t)row * 512 + c2) = *(const LAS unsigned*)(OB + i * HST + c2); } }
    __syncthreads();
#undef HG_BASE
#undef HG_LOADRAW
#undef HG_A1
#undef HG_A2
}

constexpr int KST = 72, VST = 136;
__device__ __forceinline__ void swa_unit(const Params& p, int l, int unit, LAS unsigned char* lds, const int wvs) {
    const int tid = wvs * 64 + lane_id_fresh(); const int lane = tid & 63;
    int b, kvh, qb;
    if (unit < 512) { b = unit >> 5; kvh = (unit >> 4) & 1; qb = 2 + (unit & 15); } else { const int v = unit - 512; b = v >> 2; kvh = (v >> 1) & 1; qb = v & 1; }
    const bool qctx = qb < 2;
    const bf16_t* P = (const bf16_t*)(p.ws + WS_P);
    const float* rc = (const float*)(p.ws + WS_ROPE); const float* rs = rc + 2048 * 32;
    bf16_t* Y = (bf16_t*)(p.ws + WS_HY);
    LAS bf16_t* Ks = (LAS bf16_t*)lds; LAS bf16_t* Vt = Ks + 128 * KST;
    const int hh = wvs >> 1, qhalf = wvs & 1, head = kvh * 4 + hh;
    const int fr = lane & 15, fq = lane >> 4;
    const int rowq0 = b * TPB + qb * 128 + qhalf * 64;
    const int f0 = (!qctx && qb == 2) ? 1 : 0, nl = qctx ? 0 : 3 - f0 - (qb == 17 ? 1 : 0), nkb = nl + 2;
#define SWA_BLK(j) ((j) < nl ? qb - 1 + f0 + (j) : (j) - nl)
#define SWA_REL(j) ((j) < nl ? f0 + (j) - 1 : 0)
    bf16x8 qf[4][2];
#pragma unroll
    for (int qt = 0; qt < 4; ++qt) {
        const int row = rowq0 + qt * 16 + fr; const bf16_t* qp = P + (size_t)row * NP + PC_SQ + head * 64 + fq * 8;
        const u32x4 r1 = *(const u32x4*)qp, r2 = *(const u32x4*)(qp + 32);
        float a1[8], a2[8];
#pragma unroll
        for (int e = 0; e < 4; ++e) { a1[2 * e] = bflo(r1[e]); a1[2 * e + 1] = bfhi(r1[e]); a2[2 * e] = bflo(r2[e]); a2[2 * e + 1] = bfhi(r2[e]); }
        if (!qctx) { const int t = (qb - 2) * 128 + qhalf * 64 + qt * 16 + fr; const float* cp = rc + t * 32 + fq * 8; const float* sp = rs + t * 32 + fq * 8;
#pragma unroll
            for (int e = 0; e < 8; ++e) { const float cs = cp[e], sn = sp[e]; const float o1 = a1[e] * cs - a2[e] * sn, o2 = a1[e] * sn + a2[e] * cs; a1[e] = o1; a2[e] = o2; } }
        u32x4 o1, o2;
#pragma unroll
        for (int e = 0; e < 4; ++e) { o1[e] = pk2(a1[2 * e] * 0.125f, a1[2 * e + 1] * 0.125f); o2[e] = pk2(a2[2 * e] * 0.125f, a2[2 * e + 1] * 0.125f); }
        qf[qt][0] = __builtin_bit_cast(bf16x8, o1); qf[qt][1] = __builtin_bit_cast(bf16x8, o2);
    }
    const int skey = tid >> 2, sg = tid & 3;
    const float sink = p.swa_sink[l * 8 + head];
    float mrun[4], lrun[4]; f32x4 O[4][4];
#pragma unroll
    for (int qt = 0; qt < 4; ++qt) { mrun[qt] = sink; lrun[qt] = 1.f;
#pragma unroll
        for (int dv = 0; dv < 4; ++dv) O[qt][dv] = (f32x4){0.f, 0.f, 0.f, 0.f}; }
    for (int j = 0; j < nkb; ++j) {
        const int rel = SWA_REL(j);
        u32x4 kreg[2], vreg[2];
        { const int rowk0 = b * TPB + SWA_BLK(j) * 128; const bf16_t* kp = P + (size_t)(rowk0 + skey) * NP + PC_SK + kvh * 64 + sg * 8;
          kreg[0] = *(const u32x4*)kp; kreg[1] = *(const u32x4*)(kp + 32);
#pragma unroll
          for (int it = 0; it < 2; ++it) { const int idx = tid + NTHR * it; vreg[it] = *(const u32x4*)(P + (size_t)(rowk0 + (idx >> 3)) * NP + PC_SV + kvh * 64 + (idx & 7) * 8); } }
        *(LAS u32x4*)(Ks + skey * KST + sg * 8) = kreg[0]; *(LAS u32x4*)(Ks + skey * KST + 32 + sg * 8) = kreg[1];
#pragma unroll
        for (int it = 0; it < 2; ++it) { const int idx = tid + NTHR * it; const int vk = idx >> 3, vg = idx & 7;
#pragma unroll
            for (int e = 0; e < 4; ++e) { Vt[(vg * 8 + 2 * e) * VST + vk] = (bf16_t)(vreg[it][e] & 0xffffu); Vt[(vg * 8 + 2 * e + 1) * VST + vk] = (bf16_t)(vreg[it][e] >> 16); } }
        __syncthreads();
#pragma unroll
        for (int qp2 = 0; qp2 < 2; ++qp2) {
            f32x4 Sx[2][8];
#pragma unroll
            for (int kt = 0; kt < 8; ++kt) { Sx[0][kt] = (f32x4){0.f, 0.f, 0.f, 0.f}; Sx[1][kt] = (f32x4){0.f, 0.f, 0.f, 0.f};
#pragma unroll
                for (int kk = 0; kk < 2; ++kk) { const bf16x8 A = *(const LAS bf16x8*)(Ks + (kt * 16 + fr) * KST + kk * 32 + fq * 8);
                    Sx[0][kt] = __builtin_amdgcn_mfma_f32_16x16x32_bf16(A, qf[2 * qp2][kk], Sx[0][kt], 0, 0, 0);
                    Sx[1][kt] = __builtin_amdgcn_mfma_f32_16x16x32_bf16(A, qf[2 * qp2 + 1][kk], Sx[1][kt], 0, 0, 0); } }
#pragma unroll
            for (int u = 0; u < 2; ++u) { const int qt = 2 * qp2 + u;
                if (rel != 0) { int qi = qhalf * 64 + qt * 16 + fr; asm volatile("" : "+v"(qi));
#pragma unroll
                    for (int kt = 0; kt < 8; ++kt)
#pragma unroll
                        for (int jx = 0; jx < 4; ++jx) { const int kx = kt * 16 + fq * 4 + jx; const bool ok = rel < 0 ? (kx >= qi) : (kx <= qi); if (!ok) Sx[u][kt][jx] = -1e30f; } }
                float mx = -1e30f;
#pragma unroll
                for (int kt = 0; kt < 8; ++kt) mx = fmaxf(mx, fmaxf(fmaxf(Sx[u][kt][0], Sx[u][kt][1]), fmaxf(Sx[u][kt][2], Sx[u][kt][3])));
                mx = xrow16_max(mx);
                const float mnew = fmaxf(mrun[qt], mx); const float alpha = __expf(mrun[qt] - mnew); mrun[qt] = mnew;
                float rsum = 0.f;
#pragma unroll
                for (int kt = 0; kt < 8; ++kt)
#pragma unroll
                    for (int jx = 0; jx < 4; ++jx) { const float e = __expf(Sx[u][kt][jx] - mnew); Sx[u][kt][jx] = e; rsum += e; }
                rsum = xrow16_sum(rsum);
                lrun[qt] = lrun[qt] * alpha + rsum;
#pragma unroll
                for (int dv = 0; dv < 4; ++dv) O[qt][dv] = O[qt][dv] * alpha; }
#pragma unroll
            for (int ks2 = 0; ks2 < 4; ++ks2) {
                bf16x8 Bp[2];
#pragma unroll
                for (int u = 0; u < 2; ++u) { u32x4 pb; pb[0] = pk2(Sx[u][2 * ks2][0], Sx[u][2 * ks2][1]); pb[1] = pk2(Sx[u][2 * ks2][2], Sx[u][2 * ks2][3]); pb[2] = pk2(Sx[u][2 * ks2 + 1][0], Sx[u][2 * ks2 + 1][1]); pb[3] = pk2(Sx[u][2 * ks2 + 1][2], Sx[u][2 * ks2 + 1][3]); Bp[u] = __builtin_bit_cast(bf16x8, pb); }
#pragma unroll
                for (int dv = 0; dv < 4; ++dv) { const LAS bf16_t* vp = Vt + (dv * 16 + fr) * VST + ks2 * 32 + fq * 4;
                    const u32x2 lo = *(const LAS u32x2*)vp, hi = *(const LAS u32x2*)(vp + 16);
                    u32x4 av; av[0] = lo[0]; av[1] = lo[1]; av[2] = hi[0]; av[3] = hi[1]; const bf16x8 Av = __builtin_bit_cast(bf16x8, av);
                    O[2 * qp2][dv] = __builtin_amdgcn_mfma_f32_16x16x32_bf16(Av, Bp[0], O[2 * qp2][dv], 0, 0, 0);
                    O[2 * qp2 + 1][dv] = __builtin_amdgcn_mfma_f32_16x16x32_bf16(Av, Bp[1], O[2 * qp2 + 1][dv], 0, 0, 0); }
            }
        }
        __syncthreads();
    }
#undef SWA_BLK
#undef SWA_REL
#pragma unroll
    for (int qt = 0; qt < 4; ++qt) { const float inv = 1.f / lrun[qt]; const int row = rowq0 + qt * 16 + fr;
#pragma unroll
        for (int dv = 0; dv < 4; ++dv) { u32x2 o2; o2[0] = pk2(O[qt][dv][0] * inv, O[qt][dv][1] * inv); o2[1] = pk2(O[qt][dv][2] * inv, O[qt][dv][3] * inv);
            *(u32x2*)(Y + (size_t)row * D + 256 + head * 64 + dv * 16 + fq * 4) = o2; } }
}

__device__ __forceinline__ void phase_mixers(const Params& p, int l, LAS unsigned char* lds, const int wvs) {
    for (int s = blockIdx.x; s < 256; s += gridDim.x) { if (s < 128) dn_seq(p, l, s, lds, wvs); else hg_seq(p, l, s - 128, lds, wvs); }
    unsigned* ctr = (unsigned*)(p.ws + WS_CTL) + 64 * (1 + l);
    LAS int* su = (LAS int*)(lds + 140 * 1024);
    for (;;) {
        __syncthreads();
        if (wvs == 0 && lane_id_fresh() == 0) su[0] = (int)atomicAdd(ctr, 1u);
        __syncthreads();
        const int unit = su[0];
        if (unit >= (l == DEPTH - 1 ? 512 : 576)) break;
        swa_unit(p, l, unit, lds, wvs);
    }
}

__device__ __forceinline__ void phase_finalize(const Params& p, int l, const int wvs) {
    const int tid = wvs * 64 + lane_id_fresh(); const int lane = tid & 63, w = tid >> 6;
    const int gw = blockIdx.x * NWAVES + w, NGW = gridDim.x * NWAVES;
    const bf16_t* P = (const bf16_t*)(p.ws + WS_P);
    const bf16_t* OD0 = (const bf16_t*)(p.ws + WS_OD); const bf16_t* OD1 = OD0 + (size_t)M * 512;
    bf16_t* Y = (bf16_t*)(p.ws + WS_HY);
    const int seg = lane >> 3, d0 = (lane & 7) * 8;
    const int hd = seg & 3; const bool isdn = seg < 4;
    const float* gain = (isdn ? p.dn_norm : p.hg_norm) + l * 64 + d0;
    const f32x4 g0 = *(const f32x4*)gain, g1 = *(const f32x4*)(gain + 4);
    const int ocol = (isdn ? 0 : 256) + hd * 64 + d0, gcol = (isdn ? PC_DNG : PC_HG) + hd * 64 + d0, ycol = (isdn ? 0 : 768) + hd * 64 + d0;
    for (int r = gw; r < M; r += NGW) {
        const u32x4 a = *(const u32x4*)(OD0 + (size_t)r * 512 + ocol), bq = *(const u32x4*)(OD1 + (size_t)r * 512 + ocol), gt = *(const u32x4*)(P + (size_t)r * NP + gcol);
        float o[8]; float ss = 0.f;
#pragma unroll
        for (int e = 0; e < 4; ++e) { o[2 * e] = bflo(a[e]) + bflo(bq[e]); o[2 * e + 1] = bfhi(a[e]) + bfhi(bq[e]); ss += o[2 * e] * o[2 * e] + o[2 * e + 1] * o[2 * e + 1]; }
        ss = sum8(ss);
        const float rms = rsqrtf(ss * (1.f / 64.f) + EPS);
        u32x4 y;
#pragma unroll
        for (int e = 0; e < 4; ++e) { const float ga = bflo(gt[e]), gb = bfhi(gt[e]);
            const float ge0 = e < 2 ? g0[2 * e] : g1[2 * e - 4], ge1 = e < 2 ? g0[2 * e + 1] : g1[2 * e - 3];
            y[e] = pk2(o[2 * e] * rms * ge0 * siluf(ga), o[2 * e + 1] * rms * ge1 * siluf(gb)); }
        *(u32x4*)(Y + (size_t)r * D + ycol) = y;
    }
}

__device__ __forceinline__ void phase_final(const Params& p, const int wvs) {
    const int tid = wvs * 64 + lane_id_fresh(); const int lane = tid & 63, w = tid >> 6;
    const int gw = blockIdx.x * NWAVES + w, NGW = gridDim.x * NWAVES;
    for (int r = gw; r < BATCH * SEQ; r += NGW) {
        f32x4* xr = (f32x4*)(p.out + ((size_t)r << 10)) + lane;
        f32x4 v[4]; float ss = 0.f;
#pragma unroll
        for (int j = 0; j < 4; ++j) { v[j] = xr[64 * j]; ss += (v[j][0] * v[j][0] + v[j][1] * v[j][1]) + (v[j][2] * v[j][2] + v[j][3] * v[j][3]); }
        const float rstd = rsqrtf(wave_sum(ss) * (1.f / D) + EPS);
#pragma unroll
        for (int j = 0; j < 4; ++j) { const f32x4 g = *(const f32x4*)(p.norm_f + 4 * (lane + 64 * j)); xr[64 * j] = v[j] * rstd * g; }
    }
}

#define XB_TMO      128
#define XB_XCNT(j)  (256  + 64 * (j))
#define XB_XSUB(j)  (1280 + 64 * (j))
#define XB_XGEN(j)  (2304 + 64 * (j))
#define XB_TOP      3328
#define XB_TOPGEN   3392
#define XCD_BAR_WORDS 3456
#define XB_SPIN_CAP (1u << 18)

__device__ __forceinline__ unsigned xb_ld(unsigned* p)              { return __hip_atomic_load(p, __ATOMIC_RELAXED, __HIP_MEMORY_SCOPE_AGENT); }
__device__ __forceinline__ unsigned xb_add(unsigned* p, unsigned v) { return __hip_atomic_fetch_add(p, v, __ATOMIC_RELAXED, __HIP_MEMORY_SCOPE_AGENT); }
__device__ __forceinline__ unsigned xb_xcc_id() { return (unsigned)__builtin_amdgcn_s_getreg((3 << 11) | 20) & 0xFu; }
#define XB_SPIN(cond, bar) do { unsigned _sp = 0; while (cond) { __builtin_amdgcn_s_sleep(1); \
    if ((++_sp & 255u) == 0u) { if (xb_ld(&(bar)[XB_TMO])) break; if (_sp > XB_SPIN_CAP) { atomicAdd(&(bar)[XB_TMO], 1u); break; } } } } while (0)

struct XcdBarrier {
    unsigned* bar; unsigned x;
    volatile LAS unsigned* st;
};

__device__ __forceinline__ XcdBarrier xcd_barrier_post(unsigned* bar, volatile LAS unsigned* st) {
    XcdBarrier b; b.bar = bar; b.x = xb_xcc_id(); b.st = st;
    if (threadIdx.x == 0) (void)xb_add(&bar[XB_XCNT(b.x)], 1u);
    return b;
}
__device__ __forceinline__ void xcd_barrier_complete(unsigned* bar, unsigned x, unsigned& nloc, unsigned& nx) {
    const unsigned G = gridDim.x * gridDim.y * gridDim.z;
    unsigned sum, cnt, mine, sp = 0u;
    for (;;) {
        sum = 0u; cnt = 0u; mine = 0u;
#pragma unroll
        for (unsigned j = 0; j < 16; ++j) { const unsigned c = xb_ld(&bar[XB_XCNT(j)]); sum += c; cnt += (c > 0u) ? 1u : 0u; mine = (j == x) ? c : mine; }
        if (sum == G) break;
        __builtin_amdgcn_s_sleep(1);
        if ((++sp & 255u) == 0u) { if (xb_ld(&bar[XB_TMO])) break; if (sp > XB_SPIN_CAP) { atomicAdd(&bar[XB_TMO], 1u); break; } }
    }
    nloc = mine > 0u ? mine : 1u; nx = cnt > 0u ? cnt : 1u;
}

__device__ __forceinline__ void xcd_barrier(const XcdBarrier& b, const int wvs) {
    asm volatile("s_waitcnt vmcnt(0)" ::: "memory");
    __syncthreads();
    if (wvs == 0 && lane_id_fresh() == 0) {
        unsigned* bar = b.bar;
        __builtin_amdgcn_s_waitcnt(0);
        unsigned nloc = b.st[0], nx = b.st[1];
        if (nloc == 0u) { xcd_barrier_complete(bar, b.x, nloc, nx); b.st[0] = nloc; b.st[1] = nx; }
        const unsigned old = xb_add(&bar[XB_XSUB(b.x)], 1u);
        const unsigned gen = old / nloc;
        if (old + 1u == (gen + 1u) * nloc) {
            __builtin_amdgcn_fence(__ATOMIC_RELEASE, "agent");
            asm volatile("s_waitcnt vmcnt(0)" ::: "memory");
            const unsigned og = xb_add(&bar[XB_TOP], 1u);
            const unsigned tg = og / nx;
            if (og + 1u == (tg + 1u) * nx) xb_add(&bar[XB_TOPGEN], 1u);
            else XB_SPIN(xb_ld(&bar[XB_TOPGEN]) == tg, bar);
            __builtin_amdgcn_fence(__ATOMIC_ACQUIRE, "agent");
            xb_add(&bar[XB_XGEN(b.x)], 1u);
            asm volatile("s_waitcnt vmcnt(0)" ::: "memory");
        } else {
            XB_SPIN(xb_ld(&bar[XB_XGEN(b.x)]) == gen, bar);
            __builtin_amdgcn_fence(__ATOMIC_ACQUIRE, "agent");
            asm volatile("s_waitcnt vmcnt(0)" ::: "memory");
        }
    }
    __syncthreads();
}

__device__ __forceinline__ void gsync(cg::grid_group& grid) {
    asm volatile("s_waitcnt vmcnt(0) lgkmcnt(0)" ::: "memory");
    grid.sync();
    __builtin_amdgcn_fence(__ATOMIC_ACQUIRE, "agent");
    asm volatile("s_waitcnt vmcnt(0)" ::: "memory");
}
__global__ void __launch_bounds__(NTHR, 2) fwd_megakernel(Params p) {
    extern __shared__ __attribute__((aligned(16))) unsigned char lds_raw[];
    LAS unsigned char* lds = (LAS unsigned char*)lds_raw;
    cg::grid_group grid = cg::this_grid();
    const int G = gridDim.x, c = blockIdx.x;
    const int wvs = __builtin_amdgcn_readfirstlane((int)(threadIdx.x >> 6));
    { volatile LAS unsigned* st0 = (volatile LAS unsigned*)(lds + 143360 + 64); if (threadIdx.x < 2) st0[threadIdx.x] = 0u; }
    __syncthreads();
    const XcdBarrier xbar = xcd_barrier_post((unsigned*)(p.ws + WS_CTL) + 4096, (volatile LAS unsigned*)(lds + 143360 + 64));
    phase_prologue(p, lds, wvs);
    if (p.ws == nullptr) gsync(grid);
    xcd_barrier(xbar, wvs);
    const float* mods = (const float*)(p.ws + WS_MODS);
    float* Xc = (float*)(p.ws + WS_XC);
    bf16_t* HY = (bf16_t*)(p.ws + WS_HY); bf16_t* PB = (bf16_t*)(p.ws + WS_P);
    for (int l = 0; l < DEPTH; ++l) {
        const int lastl = (l == DEPTH - 1) ? 1 : 0;
        phase_norm<true>(p, l, lds, wvs);
        xcd_barrier(xbar, wvs);
        { pg8::Gemm g{HY, (const bf16_t*)(p.ws + WS_WIN), M, NP, D, D}; pg8::StaticOrder S; S.init(M, NP, G, c); pg8::EpiBf16<0> E{PB, NP};
          pg8::gemm_phase<pg8::EpiBf16<0>, pg8::StaticOrder, true, true>(lds, g, S, E, wvs); }
        xcd_barrier(xbar, wvs);
        phase_dnprep(p, l, lds, wvs);
        xcd_barrier(xbar, wvs);
        phase_mixers(p, l, lds, wvs);
        xcd_barrier(xbar, wvs);
        phase_finalize(p, l, wvs);
        xcd_barrier(xbar, wvs);
        { pg8::Gemm g{HY, (const bf16_t*)(p.ws + WS_WOUT), M, D, D, D}; pg8::Order2 S; S.init(D, G, c, 1); pg8::EpiRes E{p.out, Xc, mods + ((size_t)l * 17 * 6 + 2) * 1024, l == 0 ? p.x : (const float*)p.out, l == 0 ? p.ctx : (const float*)Xc};
          pg8::gemm_phase<pg8::EpiRes, pg8::Order2, true, true>(lds, g, S, E, wvs); }
        if (!lastl) { pg8::Gemm g{HY, (const bf16_t*)(p.ws + WS_WOUT), M, D, D / 4, D}; pg8::CtxSplitOrder S; S.init(G, c); pg8::EpiPart E{(float*)(p.ws + WS_QKV)};
          pg8::gemm_phase<pg8::EpiPart, pg8::CtxSplitOrder, false, true>(lds, g, S, E, wvs); }
        xcd_barrier(xbar, wvs);
        phase_norm<false>(p, l, lds, wvs);
        xcd_barrier(xbar, wvs);
        { pg8::Gemm g{HY, (const bf16_t*)(p.ws + WS_W1), M, DFF, D, D}; pg8::Order2 S; S.init(DFF, G, c, lastl); pg8::EpiBf16<1> E{PB, DFF};
          pg8::gemm_phase<pg8::EpiBf16<1>, pg8::Order2, true, true>(lds, g, S, E, wvs); }
        xcd_barrier(xbar, wvs);
        { pg8::Gemm g{PB, (const bf16_t*)(p.ws + WS_W2), M, D, DFF, DFF}; pg8::Order2 S; S.init(D, G, c, 1); pg8::EpiRes E{p.out, Xc, mods + ((size_t)l * 17 * 6 + 5) * 1024, (const float*)p.out, (const float*)Xc};
          pg8::gemm_phase<pg8::EpiRes, pg8::Order2, true, true>(lds, g, S, E, wvs); }
        if (!lastl) { pg8::Gemm g{PB, (const bf16_t*)(p.ws + WS_W2), M, D, DFF / 4, DFF}; pg8::CtxSplitOrder S; S.init(G, c); pg8::EpiPart E{(float*)(p.ws + WS_QKV)};
          pg8::gemm_phase<pg8::EpiPart, pg8::CtxSplitOrder, false, true>(lds, g, S, E, wvs); }
        xcd_barrier(xbar, wvs);
    }
    phase_final(p, wvs);
}

extern "C" void kernel_launch(void* const* d_in, const int* in_sizes, int n_in, void* d_out, int out_size, void* d_ws, size_t ws_size, hipStream_t stream) {
    static int grid = 0;
    if (grid == 0) {
        if (n_in != 20 || ws_size < WS_END) { fprintf(stderr, "kernel_launch: need 20 inputs and >= %zu bytes of workspace (got %d, %zu)\n", (size_t)WS_END, n_in, ws_size); grid = -1; return; }
        int dev = 0, cus = 0, per_cu = 0;
        hipGetDevice(&dev); hipDeviceGetAttribute(&cus, hipDeviceAttributeMultiprocessorCount, dev);
        if (hipFuncSetAttribute((const void*)fwd_megakernel, hipFuncAttributeMaxDynamicSharedMemorySize, LDS_BYTES) != hipSuccess) { fprintf(stderr, "kernel_launch: hipFuncSetAttribute failed\n"); grid = -1; return; }
        if (hipOccupancyMaxActiveBlocksPerMultiprocessor(&per_cu, (const void*)fwd_megakernel, NTHR, LDS_BYTES) != hipSuccess || per_cu < 1) { fprintf(stderr, "kernel_launch: occupancy query says %d blocks/CU\n", per_cu); per_cu = 1; }
        (void)hipGetLastError();
        grid = cus;
    }
    if (grid < 0) return;
    hipMemsetAsync((char*)d_ws + WS_CTL, 0, 65536, stream);
    Params p{};
    const float** pp = (const float**)&p;
    for (int i = 0; i < 20; ++i) pp[i] = (const float*)d_in[i];
    p.out = (float*)d_out; p.ws = (unsigned char*)d_ws;
    void* args[] = {&p};
    hipError_t e = hipLaunchCooperativeKernel((const void*)fwd_megakernel, dim3(grid), dim3(NTHR), args, LDS_BYTES, stream);
    if (e != hipSuccess) fprintf(stderr, "cooperative launch failed: %s (grid %d)\n", hipGetErrorString(e), grid);
}
```

```cpp
#include <hip/hip_runtime.h>
#include <hip/hip_cooperative_groups.h>
#include <cstdio>
#include <cstdint>
namespace cg = cooperative_groups;

__device__ __forceinline__ int lane_id_fresh() { unsigned m = ~0u; asm volatile("" : "+s"(m)); return (int)__builtin_amdgcn_mbcnt_hi(m, __builtin_amdgcn_mbcnt_lo(m, 0u)); }
namespace pg8 {
#define PG8_LAS __attribute__((address_space(3)))
typedef unsigned short bf16_t;
typedef short bf16x8 __attribute__((ext_vector_type(8)));
typedef float f32x4 __attribute__((ext_vector_type(4)));
typedef unsigned u32x4 __attribute__((ext_vector_type(4)));
constexpr int BM = 256, BK = 64, HALF = 128, HTB = HALF * BK * 2  , STAGE_BYTES = 8 * HTB, NXCD = 8, WGM = 8;

__host__ __device__ __forceinline__ int lds_byte(int r, int c) { const int st = (r >> 4) * 2 + (c >> 5), rr = r & 15, cc = c & 31, ob = rr * 64 + cc * 2; return st * 1024 + (ob ^ (((ob >> 9) & 1) << 5)); }
__host__ __device__ __forceinline__ void stage_rc(int b, int& R, int& C) { const int st = b / 1024, sb = b % 1024, swz = sb ^ (((sb >> 9) & 1) << 5); R = (st >> 1) * 16 + swz / 64; C = (st & 1) * 32 + (swz % 64) / 2; }
__host__ __device__ __forceinline__ int perm32(int rho) { const int n = rho >> 4, i = rho & 15; return 8 * (i >> 2) + 4 * n + (i & 3); }

struct Unit { int pm, pn, ks; };
struct Gemm { const bf16_t* A; const bf16_t* Bt; int M, N, K, ldk; };

struct StaticOrder {
    int nM, nN, nwg, G, c;
    __host__ __device__ void init(int M, int N, int G_, int c_) { nM = M / BM; nN = N / BM; nwg = nM * nN; G = G_; c = c_; }
    __host__ __device__ bool next(int i, Unit& u) const {
        const long L = (long)i * G + c; if (L >= nwg) return false;
        int wgid = (int)L; { const int q = nwg / NXCD, r = nwg % NXCD, xcd = wgid % NXCD, off = wgid / NXCD; wgid = (xcd < r ? xcd * (q + 1) : r * (q + 1) + (xcd - r) * q) + off; }
        const int nig = WGM * nN, gid = wgid / nig, fm = gid * WGM, gsz = (nM - fm) < WGM ? (nM - fm) : WGM;
        u.pm = fm + ((wgid % nig) % gsz); u.pn = (wgid % nig) / gsz; u.ks = 0; return true;
    }
    __device__ __forceinline__ void a_ready(const Unit&) const {}
    __device__ __forceinline__ void done(const Unit&) const {}
};

struct Order2 {
    StaticOrder so; int lat;
    __host__ __device__ void init(int N, int G_, int c_, int lat_) { lat = lat_; so.init(lat_ ? 32768 : 36864, N, G_, c_); }
    __host__ __device__ bool next(int i, Unit& u) const { if (!so.next(i, u)) return false; if (lat) u.pm = (u.pm >> 3) * 9 + 1 + (u.pm & 7); return true; }
    __device__ __forceinline__ void a_ready(const Unit&) const {}
    __device__ __forceinline__ void done(const Unit&) const {}
};
struct CtxSplitOrder {
    int G, c;
    __host__ __device__ void init(int G_, int c_) { G = G_; c = c_; }
    __host__ __device__ bool next(int i, Unit& u) const { const long L = (long)i * G + c; if (L >= 256) return false; u.ks = (int)L & 3; u.pn = ((int)L >> 2) & 3; u.pm = ((int)L >> 4) * 9; return true; }
    __device__ __forceinline__ void a_ready(const Unit&) const {}
    __device__ __forceinline__ void done(const Unit&) const {}
};
typedef float f32x2c __attribute__((ext_vector_type(2)));
typedef __bf16 bf16x2c __attribute__((ext_vector_type(2)));
__device__ __forceinline__ unsigned cvt_pk_bf16(float lo, float hi) { const f32x2c v = {lo, hi}; return __builtin_bit_cast(unsigned, __builtin_convertvector(v, bf16x2c)); }

template <int ACT  > struct EpiBf16 {
    static constexpr bool PERM = true, AFTER_DRAIN = false;
    bf16_t* O; int ldc;
    __device__ __forceinline__ void operator()(const f32x4 (&acc)[2][2][4][2], const Unit& u, int wr, int wc, int fr, int fq) const {
        const int row0 = u.pm * BM + wr * 64 + fr; const int col0 = u.pn * BM + wc * 32 + 8 * fq;
#pragma unroll
        for (int ai = 0; ai < 2; ++ai)
#pragma unroll
            for (int m = 0; m < 4; ++m) { bf16_t* rowp = O + (size_t)(row0 + ai * HALF + m * 16) * ldc + col0;
#pragma unroll
                for (int bj = 0; bj < 2; ++bj) { f32x4 v0 = acc[ai][bj][m][0], v1 = acc[ai][bj][m][1];
                    if (ACT == 1) {
#pragma unroll
                        for (int e = 0; e < 4; ++e) { float a = fmaxf(v0[e], 0.f), b = fmaxf(v1[e], 0.f); v0[e] = a * a; v1[e] = b * b; } }
                    u32x4 w; w.x = cvt_pk_bf16(v0[0], v0[1]); w.y = cvt_pk_bf16(v0[2], v0[3]); w.z = cvt_pk_bf16(v1[0], v1[1]); w.w = cvt_pk_bf16(v1[2], v1[3]);
                    *(u32x4*)(rowp + bj * HALF) = w; } }
    }
};
struct EpiRes {
    static constexpr bool PERM = false, AFTER_DRAIN = false;
    float* Xl; float* Xc; const float* gates;
    const float* Xl_in; const float* Xc_in;
    __device__ __forceinline__ void operator()(const f32x4 (&acc)[2][2][4][2], const Unit& u, int wr, int wc, int fr, int fq) const {
        const int b = u.pm / 9, tt = u.pm - b * 9;
        const size_t toff = (tt == 0) ? ((size_t)(b * 256) << 10) : ((size_t)(b * 2048 + (tt - 1) * 256) << 10);
        float* base = ((tt == 0) ? Xc : Xl) + toff; const float* base_in = ((tt == 0) ? Xc_in : Xl_in) + toff;
        const float* g = gates + (size_t)((tt == 0) ? 16 : b) * 6144;
        const int col0 = u.pn * BM + wc * 32 + 4 * fq;
        float* rp0 = base + ((size_t)(wr * 64 + fr) << 10) + col0; const float* rq0 = base_in + ((size_t)(wr * 64 + fr) << 10) + col0;
#pragma unroll
        for (int bj = 0; bj < 2; ++bj)
#pragma unroll
            for (int n = 0; n < 2; ++n) { const f32x4 gvv = *(const f32x4*)(g + col0 + bj * HALF + n * 16);
#pragma unroll
                for (int ai = 0; ai < 2; ++ai) {
#pragma unroll
                    for (int m = 0; m < 4; ++m) { const size_t eo = (size_t)(ai * HALF + m * 16) * 1024 + bj * HALF + n * 16; f32x4 xv = *(const f32x4*)(rq0 + eo); xv = xv + gvv * acc[ai][bj][m][n]; *(f32x4*)(rp0 + eo) = xv; }
                    asm volatile("" ::: "memory"); } }
    }
};
struct EpiPart {
    static constexpr bool PERM = false, AFTER_DRAIN = false;
    float* part;
    __device__ __forceinline__ void operator()(const f32x4 (&acc)[2][2][4][2], const Unit& u, int wr, int wc, int fr, int fq) const {
        float* rp0 = part + (((size_t)u.ks * 4096 + (size_t)(u.pm / 9) * 256 + wr * 64 + fr) << 10) + u.pn * BM + wc * 32 + 4 * fq;
#pragma unroll
        for (int ai = 0; ai < 2; ++ai)
#pragma unroll
            for (int m = 0; m < 4; ++m)
#pragma unroll
                for (int bj = 0; bj < 2; ++bj)
#pragma unroll
                    for (int n = 0; n < 2; ++n) *(f32x4*)(rp0 + (size_t)(ai * HALF + m * 16) * 1024 + bj * HALF + n * 16) = acc[ai][bj][m][n];
    }
};
template <class Epi, class Sched, bool ALIGN_EPI = false, bool SP2 = false>
__device__ __forceinline__ void gemm_phase(PG8_LAS unsigned char* lds, const Gemm g, const Sched& S, const Epi& E, const int wvs) {
    const int tid = wvs * 64 + lane_id_fresh(); const int wid = __builtin_amdgcn_readfirstlane(tid >> 6), lane = tid & 63, wr = wid >> 2, wc = wid & 3, fr = lane & 15, fq = lane >> 4;
    const int K = g.ldk, nt = g.K / BK; const size_t sstep = (size_t)g.K * 2;
    unsigned voffA[2], voffB[2];
#pragma unroll
    for (int i = 0; i < 2; ++i) { int R, C; stage_rc(tid * 16 + i * 8192, R, C); const int Rb = Epi::PERM ? ((R & ~31) + perm32(R & 31)) : R;
        voffA[i] = (unsigned)(R * K + C) * 2u; voffB[i] = (unsigned)(Rb * K + C) * 2u; }
    const size_t kstep = (size_t)(BK * 2);
    const size_t hstep = (size_t)HALF * K * 2;
    const size_t tstep = 2 * hstep;
    const unsigned ldsw = (unsigned)wid * 1024u;
    const int aoff = lds_byte(wr * 64 + fr, fq * 8), boff = lds_byte(wc * 32 + fr, fq * 8);
#define PG8_SA(b, h) (((b) * 2 + (h)) * HTB)
#define PG8_SB(b, h) ((4 + (b) * 2 + (h)) * HTB)
#define PG8_STAGE(bufoff, gbase, voff) do { _Pragma("unroll") for (int _i = 0; _i < 2; ++_i) \
        __builtin_amdgcn_global_load_lds((const unsigned*)((const char*)(gbase) + (voff)[_i]), (PG8_LAS unsigned*)(lds + (bufoff) + ldsw + _i * 8192), 16, 0, 0); } while (0)
#define PG8_LDA(dst, b, h) do { _Pragma("unroll") for (int m = 0; m < 4; ++m) _Pragma("unroll") for (int k = 0; k < 2; ++k) dst[m][k] = *(const PG8_LAS bf16x8*)(lds + PG8_SA(b, h) + aoff + m * 2048 + k * 1024); } while (0)
#define PG8_LDB(dst, b, h) do { _Pragma("unroll") for (int n = 0; n < 2; ++n) _Pragma("unroll") for (int k = 0; k < 2; ++k) dst[n][k] = *(const PG8_LAS bf16x8*)(lds + PG8_SB(b, h) + boff + n * 2048 + k * 1024); } while (0)
#define PG8_MMA(ai, bj, At, Bt) do { __builtin_amdgcn_s_setprio(1); _Pragma("unroll") for (int m = 0; m < 4; ++m) _Pragma("unroll") for (int n = 0; n < 2; ++n) _Pragma("unroll") for (int k = 0; k < 2; ++k) \
        acc[ai][bj][m][n] = __builtin_amdgcn_mfma_f32_16x16x32_bf16(Bt[n][k], At[m][k], acc[ai][bj][m][n], 0, 0, 0); __builtin_amdgcn_s_setprio(0); } while (0)
#define PG8_WAIT_V(n) asm volatile("s_waitcnt vmcnt(" #n ")" ::: "memory")
#define PG8_WAIT_L(n) asm volatile("s_waitcnt lgkmcnt(" #n ")" ::: "memory")
#define PG8_BAR __builtin_amdgcn_s_barrier()
#define PG8_SCHED __builtin_amdgcn_sched_barrier(0)
    Unit cur, nxt; int ui = 0;
    if (!S.next(0, cur)) return;
    f32x4 acc[2][2][4][2];
#pragma unroll
    for (int a = 0; a < 2; ++a)
#pragma unroll
        for (int b = 0; b < 2; ++b)
#pragma unroll
            for (int m = 0; m < 4; ++m)
#pragma unroll
                for (int n = 0; n < 2; ++n) acc[a][b][m][n] = (f32x4){0.f, 0.f, 0.f, 0.f};
    bf16x8 At[4][2], B0[2][2], B1[2][2];
    const char* cA = (const char*)g.A + (size_t)cur.pm * tstep + (size_t)cur.ks * sstep; const char* cB = (const char*)g.Bt + (size_t)cur.pn * tstep + (size_t)cur.ks * sstep;
    S.a_ready(cur);
    if constexpr (SP2) {
        PG8_STAGE(PG8_SB(0, 0), cB, voffB); PG8_STAGE(PG8_SB(0, 1), cB + hstep, voffB); PG8_STAGE(PG8_SA(0, 0), cA, voffA); PG8_STAGE(PG8_SA(0, 1), cA + hstep, voffA);
        if (wr == 1) PG8_BAR;
        PG8_WAIT_V(2); PG8_BAR;
        PG8_STAGE(PG8_SB(1, 0), cB + kstep, voffB); PG8_STAGE(PG8_SA(1, 0), cA + kstep, voffA); PG8_STAGE(PG8_SB(1, 1), cB + hstep + kstep, voffB);
        PG8_WAIT_V(6); PG8_BAR;
    } else {
        PG8_STAGE(PG8_SB(0, 0), cB, voffB); PG8_STAGE(PG8_SA(0, 0), cA, voffA); PG8_STAGE(PG8_SB(0, 1), cB + hstep, voffB); PG8_STAGE(PG8_SA(0, 1), cA + hstep, voffA);
        if (wr == 1) PG8_BAR;
        PG8_WAIT_V(4); PG8_BAR;
        PG8_STAGE(PG8_SB(1, 0), cB + kstep, voffB); PG8_STAGE(PG8_SA(1, 0), cA + kstep, voffA); PG8_STAGE(PG8_SB(1, 1), cB + hstep + kstep, voffB);
        PG8_WAIT_V(6); PG8_BAR;
    }
    for (;;) {
        const bool has_next = S.next(ui + 1, nxt);
        const char* nA = has_next ? (const char*)g.A + (size_t)nxt.pm * tstep + (size_t)nxt.ks * sstep : cA; const char* nB = has_next ? (const char*)g.Bt + (size_t)nxt.pn * tstep + (size_t)nxt.ks * sstep : cB;
        for (int t = 0; t < nt; t += 2) {
            const bool last = (t == nt - 2);
            const char* a1 = cA + (size_t)(t + 1) * kstep;
            const char* a2 = last ? nA : cA + (size_t)(t + 2) * kstep; const char* b2 = last ? nB : cB + (size_t)(t + 2) * kstep;
            const char* a3 = a2 + kstep; const char* b3 = b2 + kstep;
            if (last && has_next) S.a_ready(nxt);
            if constexpr (SP2) {
            PG8_LDB(B0, 0, 0); PG8_LDB(B1, 0, 1); PG8_SCHED; PG8_LDA(At, 0, 0); PG8_STAGE(PG8_SA(1, 1), a1 + hstep, voffA);
            PG8_WAIT_V(8); PG8_WAIT_L(0); PG8_BAR; PG8_MMA(0, 0, At, B0); PG8_MMA(0, 1, At, B1); PG8_BAR; PG8_SCHED;
            PG8_LDA(At, 0, 1); PG8_STAGE(PG8_SB(0, 0), b2, voffB); PG8_STAGE(PG8_SB(0, 1), b2 + hstep, voffB); PG8_STAGE(PG8_SA(0, 0), a2, voffA);
            PG8_WAIT_V(8); PG8_WAIT_L(0); PG8_BAR; PG8_MMA(1, 0, At, B0); PG8_MMA(1, 1, At, B1); PG8_BAR; PG8_SCHED;
            PG8_LDB(B0, 1, 0); PG8_LDB(B1, 1, 1); PG8_SCHED; PG8_LDA(At, 1, 0); PG8_STAGE(PG8_SA(0, 1), a2 + hstep, voffA);
            PG8_WAIT_V(8); PG8_WAIT_L(0); PG8_BAR; PG8_MMA(0, 0, At, B0); PG8_MMA(0, 1, At, B1); PG8_BAR; PG8_SCHED;
            PG8_LDA(At, 1, 1); PG8_STAGE(PG8_SB(1, 0), b3, voffB); PG8_STAGE(PG8_SB(1, 1), b3 + hstep, voffB); PG8_STAGE(PG8_SA(1, 0), a3, voffA);
            PG8_WAIT_V(8); PG8_WAIT_L(0); PG8_BAR; PG8_MMA(1, 0, At, B0); PG8_MMA(1, 1, At, B1); PG8_BAR; PG8_SCHED;
            } else {
            PG8_LDB(B0, 0, 0); PG8_SCHED; PG8_LDA(At, 0, 0); PG8_STAGE(PG8_SA(1, 1), a1 + hstep, voffA);
            PG8_WAIT_L(8); PG8_BAR; PG8_WAIT_L(0); PG8_MMA(0, 0, At, B0); PG8_BAR; PG8_SCHED;
            PG8_LDB(B1, 0, 1); PG8_STAGE(PG8_SB(0, 0), b2, voffB);
            PG8_BAR; PG8_WAIT_L(0); PG8_MMA(0, 1, At, B1); PG8_BAR;
            PG8_LDA(At, 0, 1); PG8_STAGE(PG8_SA(0, 0), a2, voffA);
            PG8_BAR; PG8_WAIT_L(0); PG8_MMA(1, 0, At, B0); PG8_BAR; PG8_SCHED;
            PG8_STAGE(PG8_SB(0, 1), b2 + hstep, voffB);
            PG8_WAIT_V(6); PG8_BAR; PG8_MMA(1, 1, At, B1); PG8_BAR;
            PG8_LDB(B0, 1, 0); PG8_SCHED; PG8_LDA(At, 1, 0); PG8_STAGE(PG8_SA(0, 1), a2 + hstep, voffA);
            PG8_WAIT_L(8); PG8_BAR; PG8_WAIT_L(0); PG8_MMA(0, 0, At, B0); PG8_BAR; PG8_SCHED;
            PG8_LDB(B1, 1, 1); PG8_STAGE(PG8_SB(1, 0), b3, voffB);
            PG8_BAR; PG8_WAIT_L(0); PG8_MMA(0, 1, At, B1); PG8_BAR;
            PG8_LDA(At, 1, 1); PG8_STAGE(PG8_SA(1, 0), a3, voffA);
            PG8_BAR; PG8_WAIT_L(0); PG8_MMA(1, 0, At, B0); PG8_BAR; PG8_SCHED;
            PG8_STAGE(PG8_SB(1, 1), b3 + hstep, voffB);
            PG8_WAIT_V(6); PG8_BAR; PG8_MMA(1, 1, At, B1); PG8_BAR;
            }
        }
        if constexpr (ALIGN_EPI) { if (wr == 0) PG8_BAR; }
        if constexpr (!Epi::AFTER_DRAIN) { E(acc, cur, wr, wc, fr, fq); S.done(cur); }
        if (!has_next) break;
#pragma unroll
        for (int a = 0; a < 2; ++a)
#pragma unroll
            for (int b = 0; b < 2; ++b)
#pragma unroll
                for (int m = 0; m < 4; ++m)
#pragma unroll
                    for (int n = 0; n < 2; ++n) acc[a][b][m][n] = (f32x4){0.f, 0.f, 0.f, 0.f};
        cur = nxt; cA = nA; cB = nB; ++ui;
        if constexpr (ALIGN_EPI) { if (wr == 1) PG8_BAR; }
    }
    PG8_WAIT_V(0);
    if constexpr (!ALIGN_EPI) { if (wr == 0) PG8_BAR; }
    PG8_BAR;
    if constexpr (Epi::AFTER_DRAIN) { E.fused(acc, cur, wr, wc, fr, fq, lds, wid, lane); S.done(cur); }
#undef PG8_SA
#undef PG8_SB
#undef PG8_STAGE
#undef PG8_LDA
#undef PG8_LDB
#undef PG8_MMA
#undef PG8_WAIT_V
#undef PG8_WAIT_L
#undef PG8_BAR
#undef PG8_SCHED
}
}

constexpr int D = 1024, BATCH = 16, SEQ = 2048, CTX = 256, DEPTH = 4;
constexpr int TPB = CTX + SEQ;
constexpr int M = BATCH * TPB;
constexpr int DIN = 3088, NP = 3072, DFF = 4096;
constexpr int PC_DNQ = 0, PC_DNG = 768, PC_SQ = 1024, PC_SK = 1536, PC_SV = 1664, PC_HQ = 1792, PC_HF = 2048, PC_HI = 2560, PC_HG = 2816;
constexpr float EPS = 1e-6f;
constexpr size_t MiB = 1u << 20;
constexpr size_t WS_CTL = 0, WS_MODS = 1 * MiB, WS_ROPE = 3 * MiB, WS_LB = 3 * MiB + 512 * 1024, WS_AB = 4 * MiB;
constexpr size_t WS_WIN = 7 * MiB, WS_WOUT = 13 * MiB, WS_W1 = 15 * MiB, WS_W2 = 23 * MiB, WS_XC = 32 * MiB, WS_HY = 48 * MiB, WS_P = 120 * MiB;
constexpr size_t WS_OD = WS_P + 216 * MiB, WS_QKV = WS_P + 288 * MiB, WS_END = WS_QKV + 64 * MiB;
constexpr int LDS_BYTES = 147456;
constexpr int NWAVES = 8, NTHR = 512;

#define LAS __attribute__((address_space(3)))
typedef unsigned short bf16_t;
typedef float f32x4 __attribute__((ext_vector_type(4)));
typedef short bf16x8 __attribute__((ext_vector_type(8)));
typedef short s16x4 __attribute__((ext_vector_type(4)));
typedef unsigned u32x4 __attribute__((ext_vector_type(4)));
typedef unsigned u32x2 __attribute__((ext_vector_type(2)));

struct Params {
    const float *x, *c, *ctx, *c_ctx, *w_ada, *b_ada, *norm1, *norm2, *w_in, *dn_conv, *dn_A_log, *dn_dt_bias, *dn_norm, *swa_sink, *hg_lb, *hg_norm, *w_out, *w_ff1, *w_ff2, *norm_f;
    float* out; unsigned char* ws;
};

__device__ __forceinline__ float bflo(unsigned u) { return __uint_as_float(u << 16); }
__device__ __forceinline__ float bfhi(unsigned u) { return __uint_as_float(u & 0xffff0000u); }
__device__ __forceinline__ unsigned pk2(float lo, float hi) { return pg8::cvt_pk_bf16(lo, hi); }
__device__ __forceinline__ bf16_t bf1(float f) { return __builtin_bit_cast(bf16_t, (__bf16)f); }
__device__ __forceinline__ float siluf(float v) { return v / (1.f + __expf(-v)); }
__device__ __forceinline__ float sigmf(float v) { return 1.f / (1.f + __expf(-v)); }
__device__ __forceinline__ float wave_sum(float v) {
#pragma unroll
    for (int o = 1; o < 64; o <<= 1) v += __shfl_xor(v, o);
    return v;
}
template <int CTRL> __device__ __forceinline__ float dpp(float x) { return __builtin_bit_cast(float, __builtin_amdgcn_mov_dpp(__builtin_bit_cast(int, x), CTRL, 0xf, 0xf, true)); }
constexpr int XOR1 = 0xB1, XOR2 = 0x4E, XOR7 = 0x141;
__device__ __forceinline__ float sum8(float v) { v += dpp<XOR1>(v); v += dpp<XOR2>(v); v += dpp<XOR7>(v); return v; }
__device__ __forceinline__ float xrow16_max(float x) {
    auto s = __builtin_amdgcn_permlane16_swap(__float_as_uint(x), __float_as_uint(x), false, false);
    x = fmaxf(__uint_as_float(s[0]), __uint_as_float(s[1]));
    auto t = __builtin_amdgcn_permlane32_swap(__float_as_uint(x), __float_as_uint(x), false, false);
    return fmaxf(__uint_as_float(t[0]), __uint_as_float(t[1]));
}
__device__ __forceinline__ float xrow16_sum(float x) {
    auto s = __builtin_amdgcn_permlane16_swap(__float_as_uint(x), __float_as_uint(x), false, false);
    x = __uint_as_float(s[0]) + __uint_as_float(s[1]);
    auto t = __builtin_amdgcn_permlane32_swap(__float_as_uint(x), __float_as_uint(x), false, false);
    return __uint_as_float(t[0]) + __uint_as_float(t[1]);
}
__device__ __forceinline__ const float* xrow_c(const float* Xl, const float* Xc, int r) { const int b = r / TPB, t = r - b * TPB; return t < CTX ? Xc + ((size_t)(b * CTX + t) << 10) : Xl + ((size_t)(b * SEQ + t - CTX) << 10); }
__device__ __forceinline__ int cidx(int r) { const int b = r / TPB, t = r - b * TPB; return t < CTX ? 16 : b; }

__device__ __forceinline__ void phase_prologue(const Params& p, LAS unsigned char* lds, const int wvs) {
    const int tid = wvs * 64 + lane_id_fresh(); const int lane = tid & 63, w = tid >> 6;
    float* mods = (float*)(p.ws + WS_MODS);
    LAS float* sc = (LAS float*)lds;
    LAS float* red = (LAS float*)(lds + 81920);
    for (int idx = tid; idx < 17 * 1024; idx += NTHR) { const int ci = idx >> 10, k = idx & 1023; const float v = ci < 16 ? p.c[ci * 1024 + k] : p.c_ctx[k]; sc[k * 20 + ci] = v / (1.f + expf(-v)); }
    __syncthreads();
    for (int it = blockIdx.x; it < DEPTH * 96; it += gridDim.x) {
        const int l = it / 96, cgp = it - l * 96, col = cgp * 64 + lane;
        float acc[17];
#pragma unroll
        for (int i = 0; i < 17; ++i) acc[i] = 0.f;
        const float* wp = p.w_ada + ((size_t)l * 1024 + w * 128) * 6144 + col;
#pragma unroll 16
        for (int kk = 0; kk < 128; ++kk) {
            const float wv = wp[(size_t)kk * 6144];
            const LAS f32x4* s4 = (const LAS f32x4*)(sc + (w * 128 + kk) * 20);
            const f32x4 s0 = s4[0], s1 = s4[1], s2 = s4[2], s3 = s4[3]; const float s16 = sc[(w * 128 + kk) * 20 + 16];
#pragma unroll
            for (int e = 0; e < 4; ++e) { acc[e] += wv * s0[e]; acc[4 + e] += wv * s1[e]; acc[8 + e] += wv * s2[e]; acc[12 + e] += wv * s3[e]; }
            acc[16] += wv * s16;
        }
#pragma unroll
        for (int i = 0; i < 17; ++i) red[(w * 17 + i) * 64 + lane] = acc[i];
        __syncthreads();
        for (int idx = tid; idx < 17 * 64; idx += NTHR) { const int i = idx >> 6, cl = idx & 63; float s = 0.f;
#pragma unroll
            for (int ww = 0; ww < 8; ++ww) s += red[(ww * 17 + i) * 64 + cl];
            mods[((size_t)l * 17 + i) * 6144 + cgp * 64 + cl] = s + p.b_ada[l * 6144 + cgp * 64 + cl]; }
        __syncthreads();
    }
    const int gt = blockIdx.x * NTHR + tid, GT = gridDim.x * NTHR;
    { float* rc = (float*)(p.ws + WS_ROPE); float* rs = rc + 2048 * 32;
      for (int idx = gt; idx < 2048 * 32; idx += GT) { const int t = idx >> 5, d = idx & 31; const float pos = (float)(d < 16 ? (t >> 6) : (t & 63));
          const float inv = expf(-(float)(d & 15) * (9.210340371976184f / 16.f)); const float ang = pos * inv; rc[idx] = cosf(ang); rs[idx] = sinf(ang); } }
    { float* LB = (float*)(p.ws + WS_LB);
      for (int idx = gt; idx < 2 * 256; idx += GT) { const int d = idx >> 8, cc = idx & 255; float v[DEPTH]; float mx = -1e30f;
#pragma unroll
          for (int l = 0; l < DEPTH; ++l) { v[l] = p.hg_lb[(d * DEPTH + l) * 256 + cc]; mx = fmaxf(mx, v[l]); }
          float s = 0.f;
#pragma unroll
          for (int l = 0; l < DEPTH; ++l) { v[l] = expf(v[l] - mx); s += v[l]; }
          float cum = 0.f;
#pragma unroll
          for (int l = 0; l < DEPTH; ++l) { if (l > 0) cum += v[l] / s; LB[(d * DEPTH + l) * 256 + cc] = cum; } } }
}

__device__ __forceinline__ void transpose_item(const float* W, int K, int ldw, int scol0, bf16_t* WT, int n0, int k0, LAS float* scr, int lane) {
#pragma unroll 8
    for (int i = 0; i < 32; ++i) { const int kk = 2 * i + (lane >> 5); scr[kk * 33 + (lane & 31)] = W[(size_t)(k0 + kk) * ldw + scol0 + (lane & 31)]; }
    asm volatile("s_waitcnt lgkmcnt(0)" ::: "memory");
    const int c = lane & 7;
#pragma unroll
    for (int j = 0; j < 4; ++j) { const int n = (lane >> 3) + 8 * j; const LAS float* s = scr + (8 * c) * 33 + n;
        u32x4 o; o.x = pk2(s[0 * 33], s[1 * 33]); o.y = pk2(s[2 * 33], s[3 * 33]); o.z = pk2(s[4 * 33], s[5 * 33]); o.w = pk2(s[6 * 33], s[7 * 33]);
        *(u32x4*)(WT + (size_t)(n0 + n) * K + k0 + 8 * c) = o; }
    asm volatile("s_waitcnt lgkmcnt(0)" ::: "memory");
}

template <bool FIRST> __device__ __forceinline__ void phase_norm(const Params& p, int l, LAS unsigned char* lds, const int wvs) {
    const int tid = wvs * 64 + lane_id_fresh(); const int lane = tid & 63, w = tid >> 6;
    const int gw = blockIdx.x * NWAVES + w, NGW = gridDim.x * NWAVES;
    const float* mods = (const float*)(p.ws + WS_MODS);
    constexpr int WST = 1032;
    LAS bf16_t* wab = (LAS bf16_t*)lds;
    if (FIRST) {
        LAS float* scr = (LAS float*)(lds + 65536 + w * 8704);
        constexpr int I_IN = 16 * 96, I_OUT = 16 * 32, I_1 = 16 * 128, I_2 = 64 * 32;
        for (int it = gw; it < I_IN + I_OUT + I_1 + I_2; it += NGW) {
            int r = it;
            if (r < I_IN) { const int kb = r / 96, nb = r - kb * 96; const int n0 = nb * 32; transpose_item(p.w_in + (size_t)l * D * DIN, D, DIN, n0 + (n0 >= 1024 ? 16 : 0), (bf16_t*)(p.ws + WS_WIN), n0, kb * 64, scr, lane); continue; }
            r -= I_IN;
            if (r < I_OUT) { const int kb = r / 32, nb = r - kb * 32; transpose_item(p.w_out + (size_t)l * D * D, D, D, nb * 32, (bf16_t*)(p.ws + WS_WOUT), nb * 32, kb * 64, scr, lane); continue; }
            r -= I_OUT;
            if (r < I_1) { const int kb = r / 128, nb = r - kb * 128; transpose_item(p.w_ff1 + (size_t)l * D * DFF, D, DFF, nb * 32, (bf16_t*)(p.ws + WS_W1), nb * 32, kb * 64, scr, lane); continue; }
            r -= I_1;
            { const int kb = r / 32, nb = r - kb * 32; transpose_item(p.w_ff2 + (size_t)l * DFF * D, DFF, D, nb * 32, (bf16_t*)(p.ws + WS_W2), nb * 32, kb * 64, scr, lane); }
        }
        const float* wi = p.w_in + (size_t)l * D * DIN + 1024;
        for (int idx = tid; idx < 4096; idx += NTHR) { const int k = idx >> 2, j4 = (idx & 3) * 4; const f32x4 v = *(const f32x4*)(wi + (size_t)k * DIN + j4);
#pragma unroll
            for (int e = 0; e < 4; ++e) wab[(j4 + e) * WST + k] = bf1(v[e]); }
        __syncthreads();
    }
    const float* nw = (FIRST ? p.norm1 : p.norm2) + l * D;
    bf16_t* H = (bf16_t*)(p.ws + WS_HY);
    float* AB = (float*)(p.ws + WS_AB);
    float* Xc = (float*)(p.ws + WS_XC);
    const float* part = (const float*)(p.ws + WS_QKV);
    const bool fix = FIRST ? (l > 0) : (l < DEPTH - 1);
    const float* fgate = mods + ((size_t)(FIRST ? (l > 0 ? l - 1 : 0) : l) * 17 + 16) * 6144 + (FIRST ? 5 : 2) * 1024;
    int nrows = 0;
    for (int r = gw; r < M; r += NGW) {
        ++nrows;
        if (!FIRST && l == DEPTH - 1 && (r % TPB) < CTX) continue;
        const f32x4* xr = (const f32x4*)((FIRST && l == 0) ? xrow_c(p.x, p.ctx, r) : xrow_c(p.out, Xc, r)) + lane;
        f32x4 v[4]; float ss = 0.f;
        const int rb = r / TPB, rt = r - rb * TPB;
        if (fix && rt < CTX) {
            const f32x4* xin = (const f32x4*)((!FIRST && l == 0) ? p.ctx + ((size_t)(rb * CTX + rt) << 10) : Xc + ((size_t)(rb * CTX + rt) << 10)) + lane;
            const f32x4* pr = (const f32x4*)(part + ((size_t)(rb * CTX + rt) << 10)) + lane; f32x4* xo = (f32x4*)(Xc + ((size_t)(rb * CTX + rt) << 10)) + lane;
#pragma unroll
            for (int j = 0; j < 4; ++j) { const f32x4 gq = *(const f32x4*)(fgate + 4 * (lane + 64 * j));
                const f32x4 s4 = (pr[64 * j] + pr[64 * j + 1048576]) + (pr[64 * j + 2 * 1048576] + pr[64 * j + 3 * 1048576]);
                v[j] = xin[64 * j] + gq * s4; xo[64 * j] = v[j]; }
        } else {
#pragma unroll
            for (int j = 0; j < 4; ++j) v[j] = xr[64 * j];
        }
#pragma unroll
        for (int j = 0; j < 4; ++j) ss += (v[j][0] * v[j][0] + v[j][1] * v[j][1]) + (v[j][2] * v[j][2] + v[j][3] * v[j][3]);
        const float rstd = rsqrtf(wave_sum(ss) * (1.f / D) + EPS);
        const float* md = mods + ((size_t)l * 17 + cidx(r)) * 6144 + (FIRST ? 0 : 3 * 1024);
        u32x2* hp = (u32x2*)(H + (size_t)r * D) + lane;
#pragma unroll
        for (int j = 0; j < 4; ++j) { const int k = 4 * (lane + 64 * j);
            const f32x4 g = *(const f32x4*)(nw + k), sh = *(const f32x4*)(md + k), sl = *(const f32x4*)(md + 1024 + k);
            f32x4 h;
#pragma unroll
            for (int e = 0; e < 4; ++e) h[e] = (v[j][e] * rstd * g[e]) * (1.f + sl[e]) + sh[e];
            u32x2 o2; o2.x = pk2(h[0], h[1]); o2.y = pk2(h[2], h[3]); hp[64 * j] = o2;
        }
    }
    if (FIRST) {
        asm volatile("s_waitcnt vmcnt(0)" ::: "memory");
        const int fr = lane & 15, fq = lane >> 4;
        for (int b0 = 0; b0 < nrows; b0 += 16) {
            const int kr = b0 + fr; const bool ok = kr < nrows; const bf16_t* hp = H + (size_t)(gw + (ok ? kr : 0) * NGW) * D + fq * 8;
            f32x4 c = (f32x4){0.f, 0.f, 0.f, 0.f};
#pragma unroll 8
            for (int ks = 0; ks < 32; ++ks) { u32x4 av = *(const u32x4*)(hp + ks * 32); if (!ok) av = (u32x4){0u, 0u, 0u, 0u};
                const bf16x8 bv = *(const LAS bf16x8*)(wab + fr * WST + ks * 32 + fq * 8);
                c = __builtin_amdgcn_mfma_f32_16x16x32_bf16(__builtin_bit_cast(bf16x8, av), bv, c, 0, 0, 0); }
#pragma unroll
            for (int j = 0; j < 4; ++j) { const int k2 = b0 + fq * 4 + j; if (k2 < nrows) AB[(size_t)(gw + k2 * NGW) * 16 + fr] = c[j]; }
        }
    }
}

constexpr int SST = 68;
constexpr int HST = 72;
__device__ __forceinline__ bf16x8 ldA_perm(const LAS bf16_t* base, int row, int s, int fq) {
    const LAS bf16_t* ap = base + row * HST + s * 32 + fq * 4; const u32x2 lo = *(const LAS u32x2*)ap, hi = *(const LAS u32x2*)(ap + 16);
    u32x4 av; av[0] = lo[0]; av[1] = lo[1]; av[2] = hi[0]; av[3] = hi[1]; return __builtin_bit_cast(bf16x8, av);
}
__device__ __forceinline__ bf16x8 packB(const f32x4& a, const f32x4& b) {
    u32x4 pb; pb[0] = pk2(a[0], a[1]); pb[1] = pk2(a[2], a[3]); pb[2] = pk2(b[0], b[1]); pb[3] = pk2(b[2], b[3]);
    return __builtin_bit_cast(bf16x8, pb);
}
__device__ __forceinline__ void phase_dnprep(const Params& p, int l, LAS unsigned char* lds, const int wvs) {
    const int tid = wvs * 64 + lane_id_fresh();
    constexpr int RST = 200;
    LAS float* qs = (LAS float*)lds; LAS float* ks = qs + 64 * SST; LAS float* vs = ks + 64 * SST; LAS bf16_t* RAW = (LAS bf16_t*)(vs + 64 * SST);
    const bf16_t* P = (const bf16_t*)(p.ws + WS_P);
    bf16_t* QKV = (bf16_t*)(p.ws + WS_QKV);
    const float* cw = p.dn_conv + (size_t)l * 5 * 768;
    const int c4 = tid % 48, tg = tid / 48;
    LAS float* cdst = ((c4 >> 4) == 0 ? qs : ((c4 >> 4) == 1 ? ks : vs)) + (c4 & 15) * 4;
#define PREP_LOADRAW(itx) do { const int h_ = (itx) & 3, bc_ = (itx) >> 2, b_ = bc_ / 36, nc_ = bc_ - b_ * 36; const int base_ = b_ * TPB + nc_ * 64, lo_ = b_ * TPB + (nc_ < 4 ? 0 : CTX), hi_ = b_ * TPB + (nc_ < 4 ? CTX : TPB); \
        _Pragma("unroll") for (int k = 0; k < 4; ++k) { const int q = tid + NTHR * k; const int rr = q / 24, pc = q - rr * 24; const int r = base_ - 2 + rr; \
            praw[k] = (q < 68 * 24 && r >= lo_ && r < hi_) ? *(const u32x4*)(P + (size_t)r * NP + (pc >> 3) * 256 + h_ * 64 + (pc & 7) * 8) : (u32x4){0u, 0u, 0u, 0u}; } } while (0)
    u32x4 praw[4];
    if ((int)blockIdx.x < BATCH * 36 * 4) PREP_LOADRAW((int)blockIdx.x);
    for (int it = blockIdx.x; it < BATCH * 36 * 4; it += gridDim.x) {
        const int h = it & 3, bc = it >> 2, b = bc / 36, nc = bc - b * 36;
        const int base = b * TPB + nc * 64;
        float wc[5][4];
        { const int ch = c4 * 4, pcol = (ch >> 6) * 256 + h * 64 + (ch & 63);
#pragma unroll
          for (int t = 0; t < 5; ++t) { const f32x4 w4 = *(const f32x4*)(cw + t * 768 + pcol); wc[t][0] = w4[0]; wc[t][1] = w4[1]; wc[t][2] = w4[2]; wc[t][3] = w4[3]; } }
#pragma unroll
        for (int k = 0; k < 4; ++k) { const int q = tid + NTHR * k; if (q < 68 * 24) { const int rr = q / 24, pc = q - rr * 24; *(LAS u32x4*)(RAW + rr * RST + pc * 8) = praw[k]; } }
        if (it + (int)gridDim.x < BATCH * 36 * 4) PREP_LOADRAW(it + (int)gridDim.x);
        __syncthreads();
        if (tid < 480) {
#pragma unroll
            for (int m = 0; m < 7; ++m) { const int pp = tg + 10 * m; if (pp < 64) { float a0 = 0.f, a1 = 0.f, a2 = 0.f, a3 = 0.f;
#pragma unroll
                for (int t = 0; t < 5; ++t) { const u32x2 raw = *(const LAS u32x2*)(RAW + (pp + t) * RST + c4 * 4);
                    a0 += bflo(raw[0]) * wc[t][0]; a1 += bfhi(raw[0]) * wc[t][1]; a2 += bflo(raw[1]) * wc[t][2]; a3 += bfhi(raw[1]) * wc[t][3]; }
                f32x4 o; o[0] = a0 / (1.f + __expf(-a0)); o[1] = a1 / (1.f + __expf(-a1)); o[2] = a2 / (1.f + __expf(-a2)); o[3] = a3 / (1.f + __expf(-a3));
                *(LAS f32x4*)(cdst + pp * SST) = o; } } }
        __syncthreads();
        { const int t = tid >> 3, part = tid & 7;
          const f32x4 q0 = *(const LAS f32x4*)(qs + t * SST + part * 8), q1 = *(const LAS f32x4*)(qs + t * SST + part * 8 + 4);
          const f32x4 k0 = *(const LAS f32x4*)(ks + t * SST + part * 8), k1 = *(const LAS f32x4*)(ks + t * SST + part * 8 + 4);
          const f32x4 v0 = *(const LAS f32x4*)(vs + t * SST + part * 8), v1 = *(const LAS f32x4*)(vs + t * SST + part * 8 + 4);
          float sq = (q0[0] * q0[0] + q0[1] * q0[1]) + (q0[2] * q0[2] + q0[3] * q0[3]) + (q1[0] * q1[0] + q1[1] * q1[1]) + (q1[2] * q1[2] + q1[3] * q1[3]);
          float sk = (k0[0] * k0[0] + k0[1] * k0[1]) + (k0[2] * k0[2] + k0[3] * k0[3]) + (k1[0] * k1[0] + k1[1] * k1[1]) + (k1[2] * k1[2] + k1[3] * k1[3]);
          sq = sum8(sq); sk = sum8(sk);
          const float rq = rsqrtf(sq + EPS) * 0.125f, rk = rsqrtf(sk + EPS);
          u32x4 qo, ko, vo;
          qo[0] = pk2(q0[0] * rq, q0[1] * rq); qo[1] = pk2(q0[2] * rq, q0[3] * rq); qo[2] = pk2(q1[0] * rq, q1[1] * rq); qo[3] = pk2(q1[2] * rq, q1[3] * rq);
          ko[0] = pk2(k0[0] * rk, k0[1] * rk); ko[1] = pk2(k0[2] * rk, k0[3] * rk); ko[2] = pk2(k1[0] * rk, k1[1] * rk); ko[3] = pk2(k1[2] * rk, k1[3] * rk);
          vo[0] = pk2(v0[0], v0[1]); vo[1] = pk2(v0[2], v0[3]); vo[2] = pk2(v1[0], v1[1]); vo[3] = pk2(v1[2], v1[3]);
          bf16_t* dst = QKV + ((size_t)(base + t) * 4 + h) * 192 + part * 8;
          *(u32x4*)dst = qo; *(u32x4*)(dst + 64) = ko; *(u32x4*)(dst + 128) = vo; }
        __syncthreads();
    }
#undef PREP_LOADRAW
    { bf16_t* Pw = (bf16_t*)(p.ws + WS_P); const float* rc = (const float*)(p.ws + WS_ROPE); const float* rs = rc + 2048 * 32;
      const int gt = blockIdx.x * NTHR + tid, GT = gridDim.x * NTHR;
      for (int idx = gt; idx < BATCH * SEQ * 8; idx += GT) { const int rl = idx >> 3, rem = idx & 7, kh = rem >> 2, g = rem & 3;
          const int bb = rl >> 11, t = rl & 2047;
          bf16_t* pp = Pw + (size_t)(bb * TPB + CTX + t) * NP + PC_SK + kh * 64 + g * 8;
          const u32x4 r1 = *(const u32x4*)pp, r2 = *(const u32x4*)(pp + 32);
          const f32x4 c0 = *(const f32x4*)(rc + t * 32 + g * 8), c1 = *(const f32x4*)(rc + t * 32 + g * 8 + 4), s0 = *(const f32x4*)(rs + t * 32 + g * 8), s1 = *(const f32x4*)(rs + t * 32 + g * 8 + 4);
          u32x4 o1, o2;
#pragma unroll
          for (int e = 0; e < 4; ++e) { const float xa = bflo(r1[e]), xb = bfhi(r1[e]), ya = bflo(r2[e]), yb = bfhi(r2[e]);
              const float ca = e < 2 ? c0[2 * e] : c1[2 * e - 4], cb = e < 2 ? c0[2 * e + 1] : c1[2 * e - 3], sa = e < 2 ? s0[2 * e] : s1[2 * e - 4], sb = e < 2 ? s0[2 * e + 1] : s1[2 * e - 3];
              o1[e] = pk2(xa * ca - ya * sa, xb * cb - yb * sb); o2[e] = pk2(xa * sa + ya * ca, xb * sb + yb * cb); }
          *(u32x4*)pp = o1; *(u32x4*)(pp + 32) = o2; } }
}

__device__ __forceinline__ void dn_seq(const Params& p, int l, int s, LAS unsigned char* lds, const int wvs) {
    const int tid = wvs * 64 + lane_id_fresh(); const int lane = tid & 63;
    const int b = s >> 3, h = (s >> 1) & 3, d = s & 1;
    constexpr int TILEB = 64 * HST * 2, BUFB = 6 * TILEB + 4 * 16 * 24 * 2 + 1024;
    LAS bf16_t* OB = (LAS bf16_t*)(lds + 2 * BUFB); LAS float* LF = (LAS float*)(lds + 2 * BUFB + TILEB);
    const bf16_t* QKV = (const bf16_t*)(p.ws + WS_QKV);
    const float* AB = (const float*)(p.ws + WS_AB);
    bf16_t* OD = (bf16_t*)(p.ws + WS_OD) + (size_t)d * M * 512 + h * 64;
    const float nA = -expf(p.dn_A_log[(l * 2 + d) * 4 + h]); const float dtb = p.dn_dt_bias[(l * 2 + d) * 4 + h];
    const int fr = lane & 15, fq = lane >> 4, V = wvs & 3;
    const bool isP = wvs < 4;
    const f32x4 zero4 = (f32x4){0.f, 0.f, 0.f, 0.f};
    u32x4 praw[6]; float pa = 0.f, pb_ = 0.f;
    f32x4 Sacc[4], R[4], QS[4];
#pragma unroll
    for (int T = 0; T < 4; ++T) { Sacc[T] = zero4; R[T] = zero4; QS[T] = zero4; }
#define DN_BASE(ci) (b * TPB + ((d == 0) ? (ci) : ((ci) < 4 ? 3 - (ci) : 39 - (ci))) * 64)
#define DN_LOADRAW(ci) do { const int base_ = DN_BASE(ci); int tl_ = tid; asm volatile("" : "+v"(tl_)); _Pragma("unroll") for (int k = 0; k < 6; ++k) { const int q = tl_ + 256 * k; const int rr = q / 24, pc = q - rr * 24; \
            praw[k] = *(const u32x4*)(QKV + ((size_t)(base_ + rr) * 4 + h) * 192 + pc * 8); } \
        if (wvs == 0) { const int r_ = base_ + (d ? 63 - lane : lane); pa = AB[(size_t)r_ * 16 + d * 4 + h]; pb_ = AB[(size_t)r_ * 16 + 8 + d * 4 + h]; } } while (0)
#define DN_S1(buf) do { LAS bf16_t* QH_ = (LAS bf16_t*)(lds + (buf) * BUFB); LAS float* SCL_ = (LAS float*)(lds + (buf) * BUFB + 6 * TILEB + 4 * 16 * 24 * 2); \
        int tl_ = tid; asm volatile("" : "+v"(tl_)); _Pragma("unroll") for (int k = 0; k < 6; ++k) { const int q = tl_ + 256 * k; const int rr = q / 24, pc = q - rr * 24; const int t = d ? 63 - rr : rr; \
            *(LAS u32x4*)(QH_ + (pc >> 3) * 64 * HST + t * HST + (pc & 7) * 8) = praw[k]; } \
        if (wvs == 0) { const float xs = pa + dtb; const float sp = xs > 15.f ? xs : (xs < -15.f ? __expf(xs) : __logf(1.f + __expf(xs))); float x = nA * sp; \
            _Pragma("unroll") for (int o = 1; o < 64; o <<= 1) { const float y = __shfl_up(x, o); if (lane >= o) x += y; } \
            SCL_[lane] = x; SCL_[64 + lane] = __expf(x); SCL_[128 + lane] = __builtin_amdgcn_rcpf(1.f + __expf(-pb_)); if (lane == 63) { SCL_[192] = x; SCL_[193] = __expf(x); } } } while (0)
    if (isP) {
        DN_LOADRAW(0); DN_S1(0);
        __syncthreads();
    for (int ci = -1; ci < 36; ++ci) {
        const int cur = ci & 1, nxt = cur ^ 1;
        LAS bf16_t* QH = (LAS bf16_t*)(lds + cur * BUFB); LAS bf16_t* KH = QH + 64 * HST; LAS bf16_t* VB = KH + 64 * HST; LAS bf16_t* KTT = VB + 64 * HST; LAS bf16_t* LM = KTT + 64 * HST; LAS bf16_t* SCM = LM + 64 * HST;
        LAS bf16_t* DI = SCM + 64 * HST; LAS float* GC = (LAS float*)(DI + 4 * 16 * 24); LAS float* EG = GC + 64; LAS float* BETA = EG + 64; LAS float* GL = BETA + 64;
            if (ci >= 0 && ci + 1 < 36) DN_S1(nxt);
            __syncthreads();
            {
            const int pb2 = (ci < 0) ? 0 : nxt;
            if (ci + 1 < 36) {
                LAS bf16_t* QHn = (LAS bf16_t*)(lds + pb2 * BUFB); LAS bf16_t* KHn = QHn + 64 * HST; LAS bf16_t* KTTn = KHn + 2 * 64 * HST; LAS bf16_t* LMn = KTTn + 64 * HST; LAS bf16_t* SCMn = LMn + 64 * HST;
                LAS bf16_t* DIn = SCMn + 64 * HST; LAS float* GCn = (LAS float*)(DIn + 4 * 16 * 24); LAS float* BETAn = GCn + 128; LAS float* GLn = GCn + 192;
                { const int t = tid >> 2, part = tid & 3; const float ekt = __expf(GLn[0] - GCn[t]);
#pragma unroll
                  for (int hh = 0; hh < 2; ++hh) { const u32x4 kr = *(const LAS u32x4*)(KHn + t * HST + part * 16 + hh * 8);
#pragma unroll
                      for (int e = 0; e < 4; ++e) { KTTn[(part * 16 + hh * 8 + 2 * e) * HST + t] = bf1(bflo(kr[e]) * ekt); KTTn[(part * 16 + hh * 8 + 2 * e + 1) * HST + t] = bf1(bfhi(kr[e]) * ekt); } } }
                { const int I = wvs;
                  float gci[4], bti[4], gcj[4];
#pragma unroll
                  for (int r = 0; r < 4; ++r) { gci[r] = GCn[I * 16 + fq * 4 + r]; bti[r] = BETAn[I * 16 + fq * 4 + r]; gcj[r] = GCn[r * 16 + fr]; }
#pragma unroll
                  for (int J = 0; J < 4; ++J) { f32x4 ckk = zero4, cqk = zero4;
                      if (J <= I) {
#pragma unroll
                          for (int kk = 0; kk < 2; ++kk) { const bf16x8 Ak = *(const LAS bf16x8*)(KHn + (I * 16 + fr) * HST + kk * 32 + fq * 8), Aq = *(const LAS bf16x8*)(QHn + (I * 16 + fr) * HST + kk * 32 + fq * 8);
                              const bf16x8 B = *(const LAS bf16x8*)(KHn + (J * 16 + fr) * HST + kk * 32 + fq * 8);
                              ckk = __builtin_amdgcn_mfma_f32_16x16x32_bf16(Ak, B, ckk, 0, 0, 0); cqk = __builtin_amdgcn_mfma_f32_16x16x32_bf16(Aq, B, cqk, 0, 0, 0); } }
                      const int j = J * 16 + fr; const float gj = gcj[J];
#pragma unroll
                      for (int r = 0; r < 4; ++r) { const int i = I * 16 + fq * 4 + r; const float dec = __expf(fminf(gci[r] - gj, 0.f));
                          const float lvv = bti[r] * ckk[r] * dec, svv = cqk[r] * dec;
                          const float lv = j < i ? lvv : 0.f, sv = j <= i ? svv : 0.f;
                          LMn[i * HST + j] = bf1(lv); SCMn[i * HST + j] = bf1(sv); if (I == J) LF[(I * 16 + fq * 4 + r) * 20 + fr] = lv; } }
                  asm volatile("s_waitcnt lgkmcnt(0)" ::: "memory");
                  { int c = lane & 15; asm volatile("" : "+v"(c)); float x[16]; const LAS f32x4* LB_ = (const LAS f32x4*)(LF + I * 16 * 20);
#define DN_LROW(dst, i0, i1) _Pragma("unroll") for (int i = (i0); i <= (i1); ++i) _Pragma("unroll") for (int j4 = 0; j4 < (i + 3) / 4; ++j4) dst[i - (i0)][j4] = LB_[i * 5 + j4]
#define DN_SOLVE(srcv, i0, i1) _Pragma("unroll") for (int i = (i0); i <= (i1); ++i) { float acc = (i == c) ? 1.f : 0.f; _Pragma("unroll") for (int j2 = 0; j2 < i; ++j2) acc -= srcv[i - (i0)][j2 >> 2][j2 & 3] * x[j2]; x[i] = acc; }
                    x[0] = (c == 0) ? 1.f : 0.f;
                    { f32x4 La[8][2]; DN_LROW(La, 1, 8); asm volatile("s_waitcnt lgkmcnt(0)" ::: "memory"); DN_SOLVE(La, 1, 8); }
                    { f32x4 Lb[4][3]; DN_LROW(Lb, 9, 12); asm volatile("s_waitcnt lgkmcnt(0)" ::: "memory"); DN_SOLVE(Lb, 9, 12); }
                    { f32x4 Lc[3][4]; DN_LROW(Lc, 13, 15); asm volatile("s_waitcnt lgkmcnt(0)" ::: "memory"); DN_SOLVE(Lc, 13, 15); }
#undef DN_LROW
#undef DN_SOLVE
                    if (lane < 16) {
#pragma unroll
                        for (int i = 0; i < 16; ++i) DIn[(I * 16 + i) * 24 + c] = bf1(x[i]); } } }
                if (ci + 2 < 36) DN_LOADRAW(ci + 2);
            }
            }
            __syncthreads();
        }
    } else {
        __syncthreads();
    for (int ci = -1; ci < 36; ++ci) {
        const int cur = ci & 1, nxt = cur ^ 1;
        LAS bf16_t* QH = (LAS bf16_t*)(lds + cur * BUFB); LAS bf16_t* KH = QH + 64 * HST; LAS bf16_t* VB = KH + 64 * HST; LAS bf16_t* KTT = VB + 64 * HST; LAS bf16_t* LM = KTT + 64 * HST; LAS bf16_t* SCM = LM + 64 * HST;
        LAS bf16_t* DI = SCM + 64 * HST; LAS float* GC = (LAS float*)(DI + 4 * 16 * 24); LAS float* EG = GC + 64; LAS float* BETA = EG + 64; LAS float* GL = BETA + 64;
            if (ci >= 0) {
            if (ci > 0) { const int basep = DN_BASE(ci - 1); const int u = tid - 256;
#pragma unroll
                for (int it = 0; it < 8; ++it) { const int idx = u + 256 * it; const int i = idx >> 5, c2 = (idx & 31) * 2; const int row = basep + (d ? 63 - i : i);
                    *(unsigned*)(OD + (size_t)row * 512 + c2) = *(const LAS unsigned*)(OB + i * HST + c2); } }
            bf16x8 Bs[2];
#pragma unroll
            for (int s2 = 0; s2 < 2; ++s2) Bs[s2] = packB(Sacc[2 * s2], Sacc[2 * s2 + 1]);
#pragma unroll
            for (int I = 0; I < 4; ++I) { f32x4 c = zero4, cq = zero4;
#pragma unroll
                for (int s2 = 0; s2 < 2; ++s2) { c = __builtin_amdgcn_mfma_f32_16x16x32_bf16(ldA_perm(KH, I * 16 + fr, s2, fq), Bs[s2], c, 0, 0, 0); cq = __builtin_amdgcn_mfma_f32_16x16x32_bf16(ldA_perm(QH, I * 16 + fr, s2, fq), Bs[s2], cq, 0, 0, 0); }
#pragma unroll
                for (int r = 0; r < 4; ++r) { const int i = I * 16 + fq * 4 + r; R[I][r] = BETA[i] * (bflo((unsigned)VB[i * HST + V * 16 + fr]) - EG[i] * c[r]); QS[I][r] = EG[i] * cq[r]; } }
                    }
            __syncthreads();
            if (ci >= 0) {
            bf16x8 Bx0, Bx1;
            { bf16x8 AD[4];
#pragma unroll
              for (int I = 0; I < 4; ++I) { const u32x2 lo = *(const LAS u32x2*)(DI + (I * 16 + fr) * 24 + fq * 4); u32x4 av; av[0] = lo[0]; av[1] = lo[1]; av[2] = 0u; av[3] = 0u; AD[I] = __builtin_bit_cast(bf16x8, av); }
              const f32x4 X0 = __builtin_amdgcn_mfma_f32_16x16x32_bf16(AD[0], packB(R[0], zero4), zero4, 0, 0, 0);
              f32x4 T1 = __builtin_amdgcn_mfma_f32_16x16x32_bf16(ldA_perm(LM, 16 + fr, 0, fq), packB(X0, zero4), zero4, 0, 0, 0);
              const f32x4 X1 = __builtin_amdgcn_mfma_f32_16x16x32_bf16(AD[1], packB(R[1] - T1, zero4), zero4, 0, 0, 0);
              Bx0 = packB(X0, X1);
              f32x4 T2 = __builtin_amdgcn_mfma_f32_16x16x32_bf16(ldA_perm(LM, 32 + fr, 0, fq), Bx0, zero4, 0, 0, 0);
              const f32x4 X2 = __builtin_amdgcn_mfma_f32_16x16x32_bf16(AD[2], packB(R[2] - T2, zero4), zero4, 0, 0, 0);
              f32x4 T3 = __builtin_amdgcn_mfma_f32_16x16x32_bf16(ldA_perm(LM, 48 + fr, 0, fq), Bx0, zero4, 0, 0, 0);
              T3 = __builtin_amdgcn_mfma_f32_16x16x32_bf16(ldA_perm(LM, 48 + fr, 1, fq), packB(X2, zero4), T3, 0, 0, 0);
              const f32x4 X3 = __builtin_amdgcn_mfma_f32_16x16x32_bf16(AD[3], packB(R[3] - T3, zero4), zero4, 0, 0, 0);
              Bx1 = packB(X2, X3); }
#pragma unroll
            for (int I = 0; I < 4; ++I) { f32x4 c = QS[I];
                c = __builtin_amdgcn_mfma_f32_16x16x32_bf16(ldA_perm(SCM, I * 16 + fr, 0, fq), Bx0, c, 0, 0, 0);
                c = __builtin_amdgcn_mfma_f32_16x16x32_bf16(ldA_perm(SCM, I * 16 + fr, 1, fq), Bx1, c, 0, 0, 0);
#pragma unroll
                for (int r = 0; r < 4; ++r) OB[(I * 16 + fq * 4 + r) * HST + V * 16 + fr] = bf1(c[r]); }
            { const float egl = GL[1];
#pragma unroll
              for (int T = 0; T < 4; ++T) { f32x4 c = Sacc[T] * egl;
                  c = __builtin_amdgcn_mfma_f32_16x16x32_bf16(ldA_perm(KTT, T * 16 + fr, 0, fq), Bx0, c, 0, 0, 0);
                  c = __builtin_amdgcn_mfma_f32_16x16x32_bf16(ldA_perm(KTT, T * 16 + fr, 1, fq), Bx1, c, 0, 0, 0);
                  Sacc[T] = c; } }
                    }
            __syncthreads();
        }
    }
    if (!isP) { const int basep = DN_BASE(35); const int u = tid - 256;
#pragma unroll
        for (int it = 0; it < 8; ++it) { const int idx = u + 256 * it; const int i = idx >> 5, c2 = (idx & 31) * 2; const int row = basep + (d ? 63 - i : i);
            *(unsigned*)(OD + (size_t)row * 512 + c2) = *(const LAS unsigned*)(OB + i * HST + c2); } }
    __syncthreads();
#undef DN_BASE
#undef DN_LOADRAW
#undef DN_S1
}

__device__ __forceinline__ void hg_seq(const Params& p, int l, int s, LAS unsigned char* lds, const int wvs) {
    const int tid = wvs * 64 + lane_id_fresh(); const int lane = tid & 63;
    const int b = s >> 3, h = (s >> 1) & 3, d = s & 1;
    constexpr int BUFB = 5 * 64 * HST * 2;
    LAS bf16_t* SC = (LAS bf16_t*)(lds + 2 * BUFB); LAS bf16_t* OB = SC + 64 * HST;
    LAS float* GS = (LAS float*)(OB + 64 * HST); LAS float* EBL = GS + 256;
    const bf16_t* P = (const bf16_t*)(p.ws + WS_P);
    bf16_t* OD = (bf16_t*)(p.ws + WS_OD) + (size_t)d * M * 512 + 256 + h * 64;
    const bool isA = wvs < 4;
    const int kx = tid & 63, g = wvs & 3;
    const float lb = ((const float*)(p.ws + WS_LB))[(d * DEPTH + l) * 256 + h * 64 + kx];
    const int fr = lane & 15, fq = lane >> 4, V = wvs & 3;
    f32x4 Sacc[4];
#pragma unroll
    for (int T = 0; T < 4; ++T) Sacc[T] = (f32x4){0.f, 0.f, 0.f, 0.f};
    unsigned short rq[16], rz[16], rv[16];
    float qv[16], kv[16], bc[16];
#define HG_BASE(ci) (b * TPB + ((d == 0) ? (ci) : ((ci) < 4 ? 3 - (ci) : 39 - (ci))) * 64)
#define HG_LOADRAW(ci) do { const int base_ = HG_BASE(ci); _Pragma("unroll") for (int e = 0; e < 16; ++e) { const int t = g * 16 + e; const int pp = d ? 63 - t : t; const bf16_t* rp = P + (size_t)(base_ + pp) * NP + h * 64 + kx; \
        rq[e] = rp[PC_HQ]; rz[e] = rp[PC_HF + d * 256]; rv[e] = rp[PC_HI]; } } while (0)
#define HG_A1(buf) do { LAS bf16_t* VT_ = (LAS bf16_t*)(lds + (buf) * BUFB) + 4 * 64 * HST; float run = 0.f; \
        _Pragma("unroll") for (int e = 0; e < 16; ++e) { const float z = bflo(rz[e]); const float sg = __builtin_amdgcn_rcpf(1.f + __expf(-z)); const float f = lb + (1.f - lb) * sg; \
            run += __logf(f); bc[e] = run; kv[e] = (1.f - lb) * (1.f - sg); qv[e] = bflo(rq[e]); VT_[kx * HST + g * 16 + e] = rv[e]; } \
        GS[g * 64 + kx] = run; } while (0)
#define HG_A2(buf) do { LAS bf16_t* QT_ = (LAS bf16_t*)(lds + (buf) * BUFB); LAS bf16_t* KT_ = QT_ + 64 * HST; LAS bf16_t* QP_ = KT_ + 64 * HST; LAS bf16_t* KTT_ = QP_ + 64 * HST; \
        const float g0 = GS[kx], g1 = GS[64 + kx], g2 = GS[128 + kx], g3 = GS[192 + kx]; const float mid = g0 + g1, bl = (g0 + g1) + (g2 + g3); \
        const float off = (g > 0 ? g0 : 0.f) + (g > 1 ? g1 : 0.f) + (g > 2 ? g2 : 0.f); \
        if (g == 3) EBL[(buf) * 64 + kx] = __expf(bl); \
        _Pragma("unroll") for (int e = 0; e < 16; ++e) { const int t = g * 16 + e; const float bce = bc[e] + off; const float E = fminf(fmaxf(bce - mid, -80.f), 80.f); \
            QT_[t * HST + kx] = bf1(qv[e] * __expf(E)); KT_[t * HST + kx] = bf1(kv[e] * __expf(-E)); \
            QP_[t * HST + kx] = bf1(qv[e] * __expf(bce)); KTT_[kx * HST + t] = bf1(kv[e] * __expf(bl - bce)); } } while (0)
    if (isA) { HG_LOADRAW(0); HG_A1(0); }
    __syncthreads();
    if (isA) { HG_A2(0); HG_LOADRAW(1); }
    __syncthreads();
    for (int ci = 0; ci < 36; ++ci) {
        const int cur = ci & 1, nxt = cur ^ 1;
        LAS bf16_t* QT = (LAS bf16_t*)(lds + cur * BUFB); LAS bf16_t* KT = QT + 64 * HST; LAS bf16_t* QP = KT + 64 * HST; LAS bf16_t* KTT = QP + 64 * HST; LAS bf16_t* VT = KTT + 64 * HST;
        if (isA) { if (ci + 1 < 36) HG_A1(nxt); }
        else {
            if (ci > 0) { const int basep = HG_BASE(ci - 1); const int u = tid - 256;
#pragma unroll
                for (int it = 0; it < 8; ++it) { const int idx = u + 256 * it; const int i = idx >> 5, c2 = (idx & 31) * 2; const int row = basep + (d ? 63 - i : i);
                    *(unsigned*)(OD + (size_t)row * 512 + c2) = *(const LAS unsigned*)(OB + i * HST + c2); } }
            { const int I = V;
#pragma unroll
              for (int J = 0; J < 4; ++J) { f32x4 c = (f32x4){0.f, 0.f, 0.f, 0.f};
                  if (J <= I) {
#pragma unroll
                      for (int kk = 0; kk < 2; ++kk) { const bf16x8 A = *(const LAS bf16x8*)(QT + (I * 16 + fr) * HST + kk * 32 + fq * 8); const bf16x8 B = *(const LAS bf16x8*)(KT + (J * 16 + fr) * HST + kk * 32 + fq * 8);
                          c = __builtin_amdgcn_mfma_f32_16x16x32_bf16(A, B, c, 0, 0, 0); } }
#pragma unroll
                  for (int r = 0; r < 4; ++r) { const int i = I * 16 + fq * 4 + r, j = J * 16 + fr; SC[i * HST + j] = bf1(j <= i ? c[r] : 0.f); } } }
        }
        __syncthreads();
        if (isA) { if (ci + 1 < 36) { HG_A2(nxt); if (ci + 2 < 36) HG_LOADRAW(ci + 2); } }
        else {
            bf16x8 Bs[2], Bv[2];
#pragma unroll
            for (int s2 = 0; s2 < 2; ++s2) { Bs[s2] = packB(Sacc[2 * s2], Sacc[2 * s2 + 1]); Bv[s2] = *(const LAS bf16x8*)(VT + (V * 16 + fr) * HST + s2 * 32 + fq * 8); }
#pragma unroll
            for (int I = 0; I < 4; ++I) { f32x4 o = (f32x4){0.f, 0.f, 0.f, 0.f};
#pragma unroll
                for (int s2 = 0; s2 < 2; ++s2) o = __builtin_amdgcn_mfma_f32_16x16x32_bf16(ldA_perm(QP, I * 16 + fr, s2, fq), Bs[s2], o, 0, 0, 0);
#pragma unroll
                for (int s2 = 0; s2 < 2; ++s2) { const bf16x8 A = *(const LAS bf16x8*)(SC + (I * 16 + fr) * HST + s2 * 32 + fq * 8); o = __builtin_amdgcn_mfma_f32_16x16x32_bf16(A, Bv[s2], o, 0, 0, 0); }
#pragma unroll
                for (int r = 0; r < 4; ++r) OB[(I * 16 + fq * 4 + r) * HST + V * 16 + fr] = bf1(o[r]); }
#pragma unroll
            for (int T = 0; T < 4; ++T) { f32x4 c;
#pragma unroll
                for (int r = 0; r < 4; ++r) c[r] = Sacc[T][r] * EBL[cur * 64 + T * 16 + fq * 4 + r];
#pragma unroll
                for (int s2 = 0; s2 < 2; ++s2) { const bf16x8 A = *(const LAS bf16x8*)(KTT + (T * 16 + fr) * HST + s2 * 32 + fq * 8); c = __builtin_amdgcn_mfma_f32_16x16x32_bf16(A, Bv[s2], c, 0, 0, 0); }
                Sacc[T] = c; }
        }
        __syncthreads();
    }
    if (!isA) { const int basep = HG_BASE(35); const int u = tid - 256;
#pragma unroll
        for (int it = 0; it < 8; ++it) { const int idx = u + 256 * it; const int i = idx >> 5, c2 = (idx & 31) * 2; const int row = basep + (d ? 63 - i : i);
            *(unsigned*)(OD + (size_t)row * 512 + c2) = *(const LAS unsigned*)(OB + i * HST + c2); } }
    __syncthreads();
#undef HG_BASE
#undef HG_LOADRAW
#undef HG_A1
#undef HG_A2
}

constexpr int KST = 72, VST = 136;
__device__ __forceinline__ void swa_unit(const Params& p, int l, int unit, LAS unsigned char* lds, const int wvs) {
    const int tid = wvs * 64 + lane_id_fresh(); const int lane = tid & 63;
    int b, kvh, qb;
    if (unit < 512) { b = unit >> 5; kvh = (unit >> 4) & 1; qb = 2 + (unit & 15); } else { const int v = unit - 512; b = v >> 2; kvh = (v >> 1) & 1; qb = v & 1; }
    const bool qctx = qb < 2;
    const bf16_t* P = (const bf16_t*)(p.ws + WS_P);
    const float* rc = (const float*)(p.ws + WS_ROPE); const float* rs = rc + 2048 * 32;
    bf16_t* Y = (bf16_t*)(p.ws + WS_HY);
    LAS bf16_t* Ks = (LAS bf16_t*)lds; LAS bf16_t* Vt = Ks + 128 * KST;
    const int hh = wvs >> 1, qhalf = wvs & 1, head = kvh * 4 + hh;
    const int fr = lane & 15, fq = lane >> 4;
    const int rowq0 = b * TPB + qb * 128 + qhalf * 64;
    const int f0 = (!qctx && qb == 2) ? 1 : 0, nl = qctx ? 0 : 3 - f0 - (qb == 17 ? 1 : 0), nkb = nl + 2;
#define SWA_BLK(j) ((j) < nl ? qb - 1 + f0 + (j) : (j) - nl)
#define SWA_REL(j) ((j) < nl ? f0 + (j) - 1 : 0)
    bf16x8 qf[4][2];
#pragma unroll
    for (int qt = 0; qt < 4; ++qt) {
        const int row = rowq0 + qt * 16 + fr; const bf16_t* qp = P + (size_t)row * NP + PC_SQ + head * 64 + fq * 8;
        const u32x4 r1 = *(const u32x4*)qp, r2 = *(const u32x4*)(qp + 32);
        float a1[8], a2[8];
#pragma unroll
        for (int e = 0; e < 4; ++e) { a1[2 * e] = bflo(r1[e]); a1[2 * e + 1] = bfhi(r1[e]); a2[2 * e] = bflo(r2[e]); a2[2 * e + 1] = bfhi(r2[e]); }
        if (!qctx) { const int t = (qb - 2) * 128 + qhalf * 64 + qt * 16 + fr; const float* cp = rc + t * 32 + fq * 8; const float* sp = rs + t * 32 + fq * 8;
#pragma unroll
            for (int e = 0; e < 8; ++e) { const float cs = cp[e], sn = sp[e]; const float o1 = a1[e] * cs - a2[e] * sn, o2 = a1[e] * sn + a2[e] * cs; a1[e] = o1; a2[e] = o2; } }
        u32x4 o1, o2;
#pragma unroll
        for (int e = 0; e < 4; ++e) { o1[e] = pk2(a1[2 * e] * 0.125f, a1[2 * e + 1] * 0.125f); o2[e] = pk2(a2[2 * e] * 0.125f, a2[2 * e + 1] * 0.125f); }
        qf[qt][0] = __builtin_bit_cast(bf16x8, o1); qf[qt][1] = __builtin_bit_cast(bf16x8, o2);
    }
    const int skey = tid >> 2, sg = tid & 3;
    const float sink = p.swa_sink[l * 8 + head];
    float mrun[4], lrun[4]; f32x4 O[4][4];
#pragma unroll
    for (int qt = 0; qt < 4; ++qt) { mrun[qt] = sink; lrun[qt] = 1.f;
#pragma unroll
        for (int dv = 0; dv < 4; ++dv) O[qt][dv] = (f32x4){0.f, 0.f, 0.f, 0.f}; }
    for (int j = 0; j < nkb; ++j) {
        const int rel = SWA_REL(j);
        u32x4 kreg[2], vreg[2];
        { const int rowk0 = b * TPB + SWA_BLK(j) * 128; const bf16_t* kp = P + (size_t)(rowk0 + skey) * NP + PC_SK + kvh * 64 + sg * 8;
          kreg[0] = *(const u32x4*)kp; kreg[1] = *(const u32x4*)(kp + 32);
#pragma unroll
          for (int it = 0; it < 2; ++it) { const int idx = tid + NTHR * it; vreg[it] = *(const u32x4*)(P + (size_t)(rowk0 + (idx >> 3)) * NP + PC_SV + kvh * 64 + (idx & 7) * 8); } }
        *(LAS u32x4*)(Ks + skey * KST + sg * 8) = kreg[0]; *(LAS u32x4*)(Ks + skey * KST + 32 + sg * 8) = kreg[1];
#pragma unroll
        for (int it = 0; it < 2; ++it) { const int idx = tid + NTHR * it; const int vk = idx >> 3, vg = idx & 7;
#pragma unroll
            for (int e = 0; e < 4; ++e) { Vt[(vg * 8 + 2 * e) * VST + vk] = (bf16_t)(vreg[it][e] & 0xffffu); Vt[(vg * 8 + 2 * e + 1) * VST + vk] = (bf16_t)(vreg[it][e] >> 16); } }
        __syncthreads();
#pragma unroll
        for (int qp2 = 0; qp2 < 2; ++qp2) {
            f32x4 Sx[2][8];
#pragma unroll
            for (int kt = 0; kt < 8; ++kt) { Sx[0][kt] = (f32x4){0.f, 0.f, 0.f, 0.f}; Sx[1][kt] = (f32x4){0.f, 0.f, 0.f, 0.f};
#pragma unroll
                for (int kk = 0; kk < 2; ++kk) { const bf16x8 A = *(const LAS bf16x8*)(Ks + (kt * 16 + fr) * KST + kk * 32 + fq * 8);
                    Sx[0][kt] = __builtin_amdgcn_mfma_f32_16x16x32_bf16(A, qf[2 * qp2][kk], Sx[0][kt], 0, 0, 0);
                    Sx[1][kt] = __builtin_amdgcn_mfma_f32_16x16x32_bf16(A, qf[2 * qp2 + 1][kk], Sx[1][kt], 0, 0, 0); } }
#pragma unroll
            for (int u = 0; u < 2; ++u) { const int qt = 2 * qp2 + u;
                if (rel != 0) { int qi = qhalf * 64 + qt * 16 + fr; asm volatile("" : "+v"(qi));
#pragma unroll
                    for (int kt = 0; kt < 8; ++kt)
#pragma unroll
                        for (int jx = 0; jx < 4; ++jx) { const int kx = kt * 16 + fq * 4 + jx; const bool ok = rel < 0 ? (kx >= qi) : (kx <= qi); if (!ok) Sx[u][kt][jx] = -1e30f; } }
                float mx = -1e30f;
#pragma unroll
                for (int kt = 0; kt < 8; ++kt) mx = fmaxf(mx, fmaxf(fmaxf(Sx[u][kt][0], Sx[u][kt][1]), fmaxf(Sx[u][kt][2], Sx[u][kt][3])));
                mx = xrow16_max(mx);
                const float mnew = fmaxf(mrun[qt], mx); const float alpha = __expf(mrun[qt] - mnew); mrun[qt] = mnew;
                float rsum = 0.f;
#pragma unroll
                for (int kt = 0; kt < 8; ++kt)
#pragma unroll
                    for (int jx = 0; jx < 4; ++jx) { const float e = __expf(Sx[u][kt][jx] - mnew); Sx[u][kt][jx] = e; rsum += e; }
                rsum = xrow16_sum(rsum);
                lrun[qt] = lrun[qt] * alpha + rsum;
#pragma unroll
                for (int dv = 0; dv < 4; ++dv) O[qt][dv] = O[qt][dv] * alpha; }
#pragma unroll
            for (int ks2 = 0; ks2 < 4; ++ks2) {
                bf16x8 Bp[2];
#pragma unroll
                for (int u = 0; u < 2; ++u) { u32x4 pb; pb[0] = pk2(Sx[u][2 * ks2][0], Sx[u][2 * ks2][1]); pb[1] = pk2(Sx[u][2 * ks2][2], Sx[u][2 * ks2][3]); pb[2] = pk2(Sx[u][2 * ks2 + 1][0], Sx[u][2 * ks2 + 1][1]); pb[3] = pk2(Sx[u][2 * ks2 + 1][2], Sx[u][2 * ks2 + 1][3]); Bp[u] = __builtin_bit_cast(bf16x8, pb); }
#pragma unroll
                for (int dv = 0; dv < 4; ++dv) { const LAS bf16_t* vp = Vt + (dv * 16 + fr) * VST + ks2 * 32 + fq * 4;
                    const u32x2 lo = *(const LAS u32x2*)vp, hi = *(const LAS u32x2*)(vp + 16);
                    u32x4 av; av[0] = lo[0]; av[1] = lo[1]; av[2] = hi[0]; av[3] = hi[1]; const bf16x8 Av = __builtin_bit_cast(bf16x8, av);
                    O[2 * qp2][dv] = __builtin_amdgcn_mfma_f32_16x16x32_bf16(Av, Bp[0], O[2 * qp2][dv], 0, 0, 0);
                    O[2 * qp2 + 1][dv] = __builtin_amdgcn_mfma_f32_16x16x32_bf16(Av, Bp[1], O[2 * qp2 + 1][dv], 0, 0, 0); }
            }
        }
        __syncthreads();
    }
#undef SWA_BLK
#undef SWA_REL
#pragma unroll
    for (int qt = 0; qt < 4; ++qt) { const float inv = 1.f / lrun[qt]; const int row = rowq0 + qt * 16 + fr;
#pragma unroll
        for (int dv = 0; dv < 4; ++dv) { u32x2 o2; o2[0] = pk2(O[qt][dv][0] * inv, O[qt][dv][1] * inv); o2[1] = pk2(O[qt][dv][2] * inv, O[qt][dv][3] * inv);
            *(u32x2*)(Y + (size_t)row * D + 256 + head * 64 + dv * 16 + fq * 4) = o2; } }
}

__device__ __forceinline__ void phase_mixers(const Params& p, int l, LAS unsigned char* lds, const int wvs) {
    for (int s = blockIdx.x; s < 256; s += gridDim.x) { if (s < 128) dn_seq(p, l, s, lds, wvs); else hg_seq(p, l, s - 128, lds, wvs); }
    unsigned* ctr = (unsigned*)(p.ws + WS_CTL) + 64 * (1 + l);
    LAS int* su = (LAS int*)(lds + 140 * 1024);
    for (;;) {
        __syncthreads();
        if (wvs == 0 && lane_id_fresh() == 0) su[0] = (int)atomicAdd(ctr, 1u);
        __syncthreads();
        const int unit = su[0];
        if (unit >= (l == DEPTH - 1 ? 512 : 576)) break;
        swa_unit(p, l, unit, lds, wvs);
    }
}

__device__ __forceinline__ void phase_finalize(const Params& p, int l, const int wvs) {
    const int tid = wvs * 64 + lane_id_fresh(); const int lane = tid & 63, w = tid >> 6;
    const int gw = blockIdx.x * NWAVES + w, NGW = gridDim.x * NWAVES;
    const bf16_t* P = (const bf16_t*)(p.ws + WS_P);
    const bf16_t* OD0 = (const bf16_t*)(p.ws + WS_OD); const bf16_t* OD1 = OD0 + (size_t)M * 512;
    bf16_t* Y = (bf16_t*)(p.ws + WS_HY);
    const int seg = lane >> 3, d0 = (lane & 7) * 8;
    const int hd = seg & 3; const bool isdn = seg < 4;
    const float* gain = (isdn ? p.dn_norm : p.hg_norm) + l * 64 + d0;
    const f32x4 g0 = *(const f32x4*)gain, g1 = *(const f32x4*)(gain + 4);
    const int ocol = (isdn ? 0 : 256) + hd * 64 + d0, gcol = (isdn ? PC_DNG : PC_HG) + hd * 64 + d0, ycol = (isdn ? 0 : 768) + hd * 64 + d0;
    for (int r = gw; r < M; r += NGW) {
        const u32x4 a = *(const u32x4*)(OD0 + (size_t)r * 512 + ocol), bq = *(const u32x4*)(OD1 + (size_t)r * 512 + ocol), gt = *(const u32x4*)(P + (size_t)r * NP + gcol);
        float o[8]; float ss = 0.f;
#pragma unroll
        for (int e = 0; e < 4; ++e) { o[2 * e] = bflo(a[e]) + bflo(bq[e]); o[2 * e + 1] = bfhi(a[e]) + bfhi(bq[e]); ss += o[2 * e] * o[2 * e] + o[2 * e + 1] * o[2 * e + 1]; }
        ss = sum8(ss);
        const float rms = rsqrtf(ss * (1.f / 64.f) + EPS);
        u32x4 y;
#pragma unroll
        for (int e = 0; e < 4; ++e) { const float ga = bflo(gt[e]), gb = bfhi(gt[e]);
            const float ge0 = e < 2 ? g0[2 * e] : g1[2 * e - 4], ge1 = e < 2 ? g0[2 * e + 1] : g1[2 * e - 3];
            y[e] = pk2(o[2 * e] * rms * ge0 * siluf(ga), o[2 * e + 1] * rms * ge1 * siluf(gb)); }
        *(u32x4*)(Y + (size_t)r * D + ycol) = y;
    }
}

__device__ __forceinline__ void phase_final(const Params& p, const int wvs) {
    const int tid = wvs * 64 + lane_id_fresh(); const int lane = tid & 63, w = tid >> 6;
    const int gw = blockIdx.x * NWAVES + w, NGW = gridDim.x * NWAVES;
    for (int r = gw; r < BATCH * SEQ; r += NGW) {
        f32x4* xr = (f32x4*)(p.out + ((size_t)r << 10)) + lane;
        f32x4 v[4]; float ss = 0.f;
#pragma unroll
        for (int j = 0; j < 4; ++j) { v[j] = xr[64 * j]; ss += (v[j][0] * v[j][0] + v[j][1] * v[j][1]) + (v[j][2] * v[j][2] + v[j][3] * v[j][3]); }
        const float rstd = rsqrtf(wave_sum(ss) * (1.f / D) + EPS);
#pragma unroll
        for (int j = 0; j < 4; ++j) { const f32x4 g = *(const f32x4*)(p.norm_f + 4 * (lane + 64 * j)); xr[64 * j] = v[j] * rstd * g; }
    }
}

#define XB_TMO      128
#define XB_XCNT(j)  (256  + 64 * (j))
#define XB_XSUB(j)  (1280 + 64 * (j))
#define XB_XGEN(j)  (2304 + 64 * (j))
#define XB_TOP      3328
#define XB_TOPGEN   3392
#define XCD_BAR_WORDS 3456
#define XB_SPIN_CAP (1u << 18)

__device__ __forceinline__ unsigned xb_ld(unsigned* p)              { return __hip_atomic_load(p, __ATOMIC_RELAXED, __HIP_MEMORY_SCOPE_AGENT); }
__device__ __forceinline__ unsigned xb_add(unsigned* p, unsigned v) { return __hip_atomic_fetch_add(p, v, __ATOMIC_RELAXED, __HIP_MEMORY_SCOPE_AGENT); }
__device__ __forceinline__ unsigned xb_xcc_id() { return (unsigned)__builtin_amdgcn_s_getreg((3 << 11) | 20) & 0xFu; }
#define XB_SPIN(cond, bar) do { unsigned _sp = 0; while (cond) { __builtin_amdgcn_s_sleep(1); \
    if ((++_sp & 255u) == 0u) { if (xb_ld(&(bar)[XB_TMO])) break; if (_sp > XB_SPIN_CAP) { atomicAdd(&(bar)[XB_TMO], 1u); break; } } } } while (0)

struct XcdBarrier {
    unsigned* bar; unsigned x;
    volatile LAS unsigned* st;
};

__device__ __forceinline__ XcdBarrier xcd_barrier_post(unsigned* bar, volatile LAS unsigned* st) {
    XcdBarrier b; b.bar = bar; b.x = xb_xcc_id(); b.st = st;
    if (threadIdx.x == 0) (void)xb_add(&bar[XB_XCNT(b.x)], 1u);
    return b;
}
__device__ __forceinline__ void xcd_barrier_complete(unsigned* bar, unsigned x, unsigned& nloc, unsigned& nx) {
    const unsigned G = gridDim.x * gridDim.y * gridDim.z;
    unsigned sum, cnt, mine, sp = 0u;
    for (;;) {
        sum = 0u; cnt = 0u; mine = 0u;
#pragma unroll
        for (unsigned j = 0; j < 16; ++j) { const unsigned c = xb_ld(&bar[XB_XCNT(j)]); sum += c; cnt += (c > 0u) ? 1u : 0u; mine = (j == x) ? c : mine; }
        if (sum == G) break;
        __builtin_amdgcn_s_sleep(1);
        if ((++sp & 255u) == 0u) { if (xb_ld(&bar[XB_TMO])) break; if (sp > XB_SPIN_CAP) { atomicAdd(&bar[XB_TMO], 1u); break; } }
    }
    nloc = mine > 0u ? mine : 1u; nx = cnt > 0u ? cnt : 1u;
}

__device__ __forceinline__ void xcd_barrier(const XcdBarrier& b, const int wvs) {
    asm volatile("s_waitcnt vmcnt(0)" ::: "memory");
    __syncthreads();
    if (wvs == 0 && lane_id_fresh() == 0) {
        unsigned* bar = b.bar;
        __builtin_amdgcn_s_waitcnt(0);
        unsigned nloc = b.st[0], nx = b.st[1];
        if (nloc == 0u) { xcd_barrier_complete(bar, b.x, nloc, nx); b.st[0] = nloc; b.st[1] = nx; }
        const unsigned old = xb_add(&bar[XB_XSUB(b.x)], 1u);
        const unsigned gen = old / nloc;
        if (old + 1u == (gen + 1u) * nloc) {
            __builtin_amdgcn_fence(__ATOMIC_RELEASE, "agent");
            asm volatile("s_waitcnt vmcnt(0)" ::: "memory");
            const unsigned og = xb_add(&bar[XB_TOP], 1u);
            const unsigned tg = og / nx;
            if (og + 1u == (tg + 1u) * nx) xb_add(&bar[XB_TOPGEN], 1u);
            else XB_SPIN(xb_ld(&bar[XB_TOPGEN]) == tg, bar);
            __builtin_amdgcn_fence(__ATOMIC_ACQUIRE, "agent");
            xb_add(&bar[XB_XGEN(b.x)], 1u);
            asm volatile("s_waitcnt vmcnt(0)" ::: "memory");
        } else {
            XB_SPIN(xb_ld(&bar[XB_XGEN(b.x)]) == gen, bar);
            __builtin_amdgcn_fence(__ATOMIC_ACQUIRE, "agent");
            asm volatile("s_waitcnt vmcnt(0)" ::: "memory");
        }
    }
    __syncthreads();
}

__device__ __forceinline__ void gsync(cg::grid_group& grid) {
    asm volatile("s_waitcnt vmcnt(0) lgkmcnt(0)" ::: "memory");
    grid.sync();
    __builtin_amdgcn_fence(__ATOMIC_ACQUIRE, "agent");
    asm volatile("s_waitcnt vmcnt(0)" ::: "memory");
}
__global__ void __launch_bounds__(NTHR, 2) fwd_megakernel(Params p) {
    extern __shared__ __attribute__((aligned(16))) unsigned char lds_raw[];
    LAS unsigned char* lds = (LAS unsigned char*)lds_raw;
    cg::grid_group grid = cg::this_grid();
    const int G = gridDim.x, c = blockIdx.x;
    const int wvs = __builtin_amdgcn_readfirstlane((int)(threadIdx.x >> 6));
    { volatile LAS unsigned* st0 = (volatile LAS unsigned*)(lds + 143360 + 64); if (threadIdx.x < 2) st0[threadIdx.x] = 0u; }
    __syncthreads();
    const XcdBarrier xbar = xcd_barrier_post((unsigned*)(p.ws + WS_CTL) + 4096, (volatile LAS unsigned*)(lds + 143360 + 64));
    phase_prologue(p, lds, wvs);
    if (p.ws == nullptr) gsync(grid);
    xcd_barrier(xbar, wvs);
    const float* mods = (const float*)(p.ws + WS_MODS);
    float* Xc = (float*)(p.ws + WS_XC);
    bf16_t* HY = (bf16_t*)(p.ws + WS_HY); bf16_t* PB = (bf16_t*)(p.ws + WS_P);
    for (int l = 0; l < DEPTH; ++l) {
        const int lastl = (l == DEPTH - 1) ? 1 : 0;
        phase_norm<true>(p, l, lds, wvs);
        xcd_barrier(xbar, wvs);
        { pg8::Gemm g{HY, (const bf16_t*)(p.ws + WS_WIN), M, NP, D, D}; pg8::StaticOrder S; S.init(M, NP, G, c); pg8::EpiBf16<0> E{PB, NP};
          pg8::gemm_phase<pg8::EpiBf16<0>, pg8::StaticOrder, true, true>(lds, g, S, E, wvs); }
        xcd_barrier(xbar, wvs);
        phase_dnprep(p, l, lds, wvs);
        xcd_barrier(xbar, wvs);
        phase_mixers(p, l, lds, wvs);
        xcd_barrier(xbar, wvs);
        phase_finalize(p, l, wvs);
        xcd_barrier(xbar, wvs);
        { pg8::Gemm g{HY, (const bf16_t*)(p.ws + WS_WOUT), M, D, D, D}; pg8::Order2 S; S.init(D, G, c, 1); pg8::EpiRes E{p.out, Xc, mods + ((size_t)l * 17 * 6 + 2) * 1024, l == 0 ? p.x : (const float*)p.out, l == 0 ? p.ctx : (const float*)Xc};
          pg8::gemm_phase<pg8::EpiRes, pg8::Order2, true, true>(lds, g, S, E, wvs); }
        if (!lastl) { pg8::Gemm g{HY, (const bf16_t*)(p.ws + WS_WOUT), M, D, D / 4, D}; pg8::CtxSplitOrder S; S.init(G, c); pg8::EpiPart E{(float*)(p.ws + WS_QKV)};
          pg8::gemm_phase<pg8::EpiPart, pg8::CtxSplitOrder, false, true>(lds, g, S, E, wvs); }
        xcd_barrier(xbar, wvs);
        phase_norm<false>(p, l, lds, wvs);
        xcd_barrier(xbar, wvs);
        { pg8::Gemm g{HY, (const bf16_t*)(p.ws + WS_W1), M, DFF, D, D}; pg8::Order2 S; S.init(DFF, G, c, lastl); pg8::EpiBf16<1> E{PB, DFF};
          pg8::gemm_phase<pg8::EpiBf16<1>, pg8::Order2, true, true>(lds, g, S, E, wvs); }
        xcd_barrier(xbar, wvs);
        { pg8::Gemm g{PB, (const bf16_t*)(p.ws + WS_W2), M, D, DFF, DFF}; pg8::Order2 S; S.init(D, G, c, 1); pg8::EpiRes E{p.out, Xc, mods + ((size_t)l * 17 * 6 + 5) * 1024, (const float*)p.out, (const float*)Xc};
          pg8::gemm_phase<pg8::EpiRes, pg8::Order2, true, true>(lds, g, S, E, wvs); }
        if (!lastl) { pg8::Gemm g{PB, (const bf16_t*)(p.ws + WS_W2), M, D, DFF / 4, DFF}; pg8::CtxSplitOrder S; S.init(G, c); pg8::EpiPart E{(float*)(p.ws + WS_QKV)};
          pg8::gemm_phase<pg8::EpiPart, pg8::CtxSplitOrder, false, true>(lds, g, S, E, wvs); }
        xcd_barrier(xbar, wvs);
    }
    phase_final(p, wvs);
}

extern "C" void kernel_launch(void* const* d_in, const int* in_sizes, int n_in, void* d_out, int out_size, void* d_ws, size_t ws_size, hipStream_t stream) {
    static int grid = 0;
    if (grid == 0) {
        if (n_in != 20 || ws_size < WS_END) { fprintf(stderr, "kernel_launch: need 20 inputs and >= %zu bytes of workspace (got %d, %zu)\n", (size_t)WS_END, n_in, ws_size); grid = -1; return; }
        int dev = 0, cus = 0, per_cu = 0;
        hipGetDevice(&dev); hipDeviceGetAttribute(&cus, hipDeviceAttributeMultiprocessorCount, dev);
        if (hipFuncSetAttribute((const void*)fwd_megakernel, hipFuncAttributeMaxDynamicSharedMemorySize, LDS_BYTES) != hipSuccess) { fprintf(stderr, "kernel_launch: hipFuncSetAttribute failed\n"); grid = -1; return; }
        if (hipOccupancyMaxActiveBlocksPerMultiprocessor(&per_cu, (const void*)fwd_megakernel, NTHR, LDS_BYTES) != hipSuccess || per_cu < 1) { fprintf(stderr, "kernel_launch: occupancy query says %d blocks/CU\n", per_cu); per_cu = 1; }
        (void)hipGetLastError();
        grid = cus;
    }
    if (grid < 0) return;
    hipMemsetAsync((char*)d_ws + WS_CTL, 0, 65536, stream);
    Params p{};
    const float** pp = (const float**)&p;
    for (int i = 0; i < 20; ++i) pp[i] = (const float*)d_in[i];
    p.out = (float*)d_out; p.ws = (unsigned char*)d_ws;
    void* args[] = {&p};
    hipError_t e = hipLaunchCooperativeKernel((const void*)fwd_megakernel, dim3(grid), dim3(NTHR), args, LDS_BYTES, stream);
    if (e != hipSuccess) fprintf(stderr, "cooperative launch failed: %s (grid %d)\n", hipGetErrorString(e), grid);
}
```

```cpp
#include <hip/hip_runtime.h>
#include <hip/hip_cooperative_groups.h>
#include <cstdio>
#include <cstdint>
namespace cg = cooperative_groups;

__device__ __forceinline__ int lane_id_fresh() { unsigned m = ~0u; asm volatile("" : "+s"(m)); return (int)__builtin_amdgcn_mbcnt_hi(m, __builtin_amdgcn_mbcnt_lo(m, 0u)); }
namespace pg8 {
#define PG8_LAS __attribute__((address_space(3)))
typedef unsigned short bf16_t;
typedef short bf16x8 __attribute__((ext_vector_type(8)));
typedef float f32x4 __attribute__((ext_vector_type(4)));
typedef unsigned u32x4 __attribute__((ext_vector_type(4)));
constexpr int BM = 256, BK = 64, HALF = 128, HTB = HALF * BK * 2  , STAGE_BYTES = 8 * HTB, NXCD = 8, WGM = 8;

__host__ __device__ __forceinline__ int lds_byte(int r, int c) { const int st = (r >> 4) * 2 + (c >> 5), rr = r & 15, cc = c & 31, ob = rr * 64 + cc * 2; return st * 1024 + (ob ^ (((ob >> 9) & 1) << 5)); }
__host__ __device__ __forceinline__ void stage_rc(int b, int& R, int& C) { const int st = b / 1024, sb = b % 1024, swz = sb ^ (((sb >> 9) & 1) << 5); R = (st >> 1) * 16 + swz / 64; C = (st & 1) * 32 + (swz % 64) / 2; }
__host__ __device__ __forceinline__ int perm32(int rho) { const int n = rho >> 4, i = rho & 15; return 8 * (i >> 2) + 4 * n + (i & 3); }

struct Unit { int pm, pn, ks; };
struct Gemm { const bf16_t* A; const bf16_t* Bt; int M, N, K, ldk; };

struct StaticOrder {
    int nM, nN, nwg, G, c;
    __host__ __device__ void init(int M, int N, int G_, int c_) { nM = M / BM; nN = N / BM; nwg = nM * nN; G = G_; c = c_; }
    __host__ __device__ bool next(int i, Unit& u) const {
        const long L = (long)i * G + c; if (L >= nwg) return false;
        int wgid = (int)L; { const int q = nwg / NXCD, r = nwg % NXCD, xcd = wgid % NXCD, off = wgid / NXCD; wgid = (xcd < r ? xcd * (q + 1) : r * (q + 1) + (xcd - r) * q) + off; }
        const int nig = WGM * nN, gid = wgid / nig, fm = gid * WGM, gsz = (nM - fm) < WGM ? (nM - fm) : WGM;
        u.pm = fm + ((wgid % nig) % gsz); u.pn = (wgid % nig) / gsz; u.ks = 0; return true;
    }
    __device__ __forceinline__ void a_ready(const Unit&) const {}
    __device__ __forceinline__ void done(const Unit&) const {}
};

struct Order2 {
    StaticOrder so; int lat;
    __host__ __device__ void init(int N, int G_, int c_, int lat_) { lat = lat_; so.init(lat_ ? 32768 : 36864, N, G_, c_); }
    __host__ __device__ bool next(int i, Unit& u) const { if (!so.next(i, u)) return false; if (lat) u.pm = (u.pm >> 3) * 9 + 1 + (u.pm & 7); return true; }
    __device__ __forceinline__ void a_ready(const Unit&) const {}
    __device__ __forceinline__ void done(const Unit&) const {}
};
struct CtxSplitOrder {
    int G, c;
    __host__ __device__ void init(int G_, int c_) { G = G_; c = c_; }
    __host__ __device__ bool next(int i, Unit& u) const { const long L = (long)i * G + c; if (L >= 256) return false; u.ks = (int)L & 3; u.pn = ((int)L >> 2) & 3; u.pm = ((int)L >> 4) * 9; return true; }
    __device__ __forceinline__ void a_ready(const Unit&) const {}
    __device__ __forceinline__ void done(const Unit&) const {}
};
typedef float f32x2c __attribute__((ext_vector_type(2)));
typedef __bf16 bf16x2c __attribute__((ext_vector_type(2)));
__device__ __forceinline__ unsigned cvt_pk_bf16(float lo, float hi) { const f32x2c v = {lo, hi}; return __builtin_bit_cast(unsigned, __builtin_convertvector(v, bf16x2c)); }

template <int ACT  > struct EpiBf16 {
    static constexpr bool PERM = true, AFTER_DRAIN = false;
    bf16_t* O; int ldc;
    __device__ __forceinline__ void operator()(const f32x4 (&acc)[2][2][4][2], const Unit& u, int wr, int wc, int fr, int fq) const {
        const int row0 = u.pm * BM + wr * 64 + fr; const int col0 = u.pn * BM + wc * 32 + 8 * fq;
#pragma unroll
        for (int ai = 0; ai < 2; ++ai)
#pragma unroll
            for (int m = 0; m < 4; ++m) { bf16_t* rowp = O + (size_t)(row0 + ai * HALF + m * 16) * ldc + col0;
#pragma unroll
                for (int bj = 0; bj < 2; ++bj) { f32x4 v0 = acc[ai][bj][m][0], v1 = acc[ai][bj][m][1];
                    if (ACT == 1) {
#pragma unroll
                        for (int e = 0; e < 4; ++e) { float a = fmaxf(v0[e], 0.f), b = fmaxf(v1[e], 0.f); v0[e] = a * a; v1[e] = b * b; } }
                    u32x4 w; w.x = cvt_pk_bf16(v0[0], v0[1]); w.y = cvt_pk_bf16(v0[2], v0[3]); w.z = cvt_pk_bf16(v1[0], v1[1]); w.w = cvt_pk_bf16(v1[2], v1[3]);
                    *(u32x4*)(rowp + bj * HALF) = w; } }
    }
};
struct EpiRes {
    static constexpr bool PERM = false, AFTER_DRAIN = false;
    float* Xl; float* Xc; const float* gates;
    const float* Xl_in; const float* Xc_in;
    __device__ __forceinline__ void operator()(const f32x4 (&acc)[2][2][4][2], const Unit& u, int wr, int wc, int fr, int fq) const {
        const int b = u.pm / 9, tt = u.pm - b * 9;
        const size_t toff = (tt == 0) ? ((size_t)(b * 256) << 10) : ((size_t)(b * 2048 + (tt - 1) * 256) << 10);
        float* base = ((tt == 0) ? Xc : Xl) + toff; const float* base_in = ((tt == 0) ? Xc_in : Xl_in) + toff;
        const float* g = gates + (size_t)((tt == 0) ? 16 : b) * 6144;
        const int col0 = u.pn * BM + wc * 32 + 4 * fq;
        float* rp0 = base + ((size_t)(wr * 64 + fr) << 10) + col0; const float* rq0 = base_in + ((size_t)(wr * 64 + fr) << 10) + col0;
#pragma unroll
        for (int bj = 0; bj < 2; ++bj)
#pragma unroll
            for (int n = 0; n < 2; ++n) { const f32x4 gvv = *(const f32x4*)(g + col0 + bj * HALF + n * 16);
#pragma unroll
                for (int ai = 0; ai < 2; ++ai) {
#pragma unroll
                    for (int m = 0; m < 4; ++m) { const size_t eo = (size_t)(ai * HALF + m * 16) * 1024 + bj * HALF + n * 16; f32x4 xv = *(const f32x4*)(rq0 + eo); xv = xv + gvv * acc[ai][bj][m][n]; *(f32x4*)(rp0 + eo) = xv; }
                    asm volatile("" ::: "memory"); } }
    }
};
struct EpiPart {
    static constexpr bool PERM = false, AFTER_DRAIN = false;
    float* part;
    __device__ __forceinline__ void operator()(const f32x4 (&acc)[2][2][4][2], const Unit& u, int wr, int wc, int fr, int fq) const {
        float* rp0 = part + (((size_t)u.ks * 4096 + (size_t)(u.pm / 9) * 256 + wr * 64 + fr) << 10) + u.pn * BM + wc * 32 + 4 * fq;
#pragma unroll
        for (int ai = 0; ai < 2; ++ai)
#pragma unroll
            for (int m = 0; m < 4; ++m)
#pragma unroll
                for (int bj = 0; bj < 2; ++bj)
#pragma unroll
                    for (int n = 0; n < 2; ++n) *(f32x4*)(rp0 + (size_t)(ai * HALF + m * 16) * 1024 + bj * HALF + n * 16) = acc[ai][bj][m][n];
    }
};
template <class Epi, class Sched, bool ALIGN_EPI = false, bool SP2 = false>
__device__ __forceinline__ void gemm_phase(PG8_LAS unsigned char* lds, const Gemm g, const Sched& S, const Epi& E, const int wvs) {
    const int tid = wvs * 64 + lane_id_fresh(); const int wid = __builtin_amdgcn_readfirstlane(tid >> 6), lane = tid & 63, wr = wid >> 2, wc = wid & 3, fr = lane & 15, fq = lane >> 4;
    const int K = g.ldk, nt = g.K / BK; const size_t sstep = (size_t)g.K * 2;
    unsigned voffA[2], voffB[2];
#pragma unroll
    for (int i = 0; i < 2; ++i) { int R, C; stage_rc(tid * 16 + i * 8192, R, C); const int Rb = Epi::PERM ? ((R & ~31) + perm32(R & 31)) : R;
        voffA[i] = (unsigned)(R * K + C) * 2u; voffB[i] = (unsigned)(Rb * K + C) * 2u; }
    const size_t kstep = (size_t)(BK * 2);
    const size_t hstep = (size_t)HALF * K * 2;
    const size_t tstep = 2 * hstep;
    const unsigned ldsw = (unsigned)wid * 1024u;
    const int aoff = lds_byte(wr * 64 + fr, fq * 8), boff = lds_byte(wc * 32 + fr, fq * 8);
#define PG8_SA(b, h) (((b) * 2 + (h)) * HTB)
#define PG8_SB(b, h) ((4 + (b) * 2 + (h)) * HTB)
#define PG8_STAGE(bufoff, gbase, voff) do { _Pragma("unroll") for (int _i = 0; _i < 2; ++_i) \
        __builtin_amdgcn_global_load_lds((const unsigned*)((const char*)(gbase) + (voff)[_i]), (PG8_LAS unsigned*)(lds + (bufoff) + ldsw + _i * 8192), 16, 0, 0); } while (0)
#define PG8_LDA(dst, b, h) do { _Pragma("unroll") for (int m = 0; m < 4; ++m) _Pragma("unroll") for (int k = 0; k < 2; ++k) dst[m][k] = *(const PG8_LAS bf16x8*)(lds + PG8_SA(b, h) + aoff + m * 2048 + k * 1024); } while (0)
#define PG8_LDB(dst, b, h) do { _Pragma("unroll") for (int n = 0; n < 2; ++n) _Pragma("unroll") for (int k = 0; k < 2; ++k) dst[n][k] = *(const PG8_LAS bf16x8*)(lds + PG8_SB(b, h) + boff + n * 2048 + k * 1024); } while (0)
#define PG8_MMA(ai, bj, At, Bt) do { __builtin_amdgcn_s_setprio(1); _Pragma("unroll") for (int m = 0; m < 4; ++m) _Pragma("unroll") for (int n = 0; n < 2; ++n) _Pragma("unroll") for (int k = 0; k < 2; ++k) \
        acc[ai][bj][m][n] = __builtin_amdgcn_mfma_f32_16x16x32_bf16(Bt[n][k], At[m][k], acc[ai][bj][m][n], 0, 0, 0); __builtin_amdgcn_s_setprio(0); } while (0)
#define PG8_WAIT_V(n) asm volatile("s_waitcnt vmcnt(" #n ")" ::: "memory")
#define PG8_WAIT_L(n) asm volatile("s_waitcnt lgkmcnt(" #n ")" ::: "memory")
#define PG8_BAR __builtin_amdgcn_s_barrier()
#define PG8_SCHED __builtin_amdgcn_sched_barrier(0)
    Unit cur, nxt; int ui = 0;
    if (!S.next(0, cur)) return;
    f32x4 acc[2][2][4][2];
#pragma unroll
    for (int a = 0; a < 2; ++a)
#pragma unroll
        for (int b = 0; b < 2; ++b)
#pragma unroll
            for (int m = 0; m < 4; ++m)
#pragma unroll
                for (int n = 0; n < 2; ++n) acc[a][b][m][n] = (f32x4){0.f, 0.f, 0.f, 0.f};
    bf16x8 At[4][2], B0[2][2], B1[2][2];
    const char* cA = (const char*)g.A + (size_t)cur.pm * tstep + (size_t)cur.ks * sstep; const char* cB = (const char*)g.Bt + (size_t)cur.pn * tstep + (size_t)cur.ks * sstep;
    S.a_ready(cur);
    if constexpr (SP2) {
        PG8_STAGE(PG8_SB(0, 0), cB, voffB); PG8_STAGE(PG8_SB(0, 1), cB + hstep, voffB); PG8_STAGE(PG8_SA(0, 0), cA, voffA); PG8_STAGE(PG8_SA(0, 1), cA + hstep, voffA);
        if (wr == 1) PG8_BAR;
        PG8_WAIT_V(2); PG8_BAR;
        PG8_STAGE(PG8_SB(1, 0), cB + kstep, voffB); PG8_STAGE(PG8_SA(1, 0), cA + kstep, voffA); PG8_STAGE(PG8_SB(1, 1), cB + hstep + kstep, voffB);
        PG8_WAIT_V(6); PG8_BAR;
    } else {
        PG8_STAGE(PG8_SB(0, 0), cB, voffB); PG8_STAGE(PG8_SA(0, 0), cA, voffA); PG8_STAGE(PG8_SB(0, 1), cB + hstep, voffB); PG8_STAGE(PG8_SA(0, 1), cA + hstep, voffA);
        if (wr == 1) PG8_BAR;
        PG8_WAIT_V(4); PG8_BAR;
        PG8_STAGE(PG8_SB(1, 0), cB + kstep, voffB); PG8_STAGE(PG8_SA(1, 0), cA + kstep, voffA); PG8_STAGE(PG8_SB(1, 1), cB + hstep + kstep, voffB);
        PG8_WAIT_V(6); PG8_BAR;
    }
    for (;;) {
        const bool has_next = S.next(ui + 1, nxt);
        const char* nA = has_next ? (const char*)g.A + (size_t)nxt.pm * tstep + (size_t)nxt.ks * sstep : cA; const char* nB = has_next ? (const char*)g.Bt + (size_t)nxt.pn * tstep + (size_t)nxt.ks * sstep : cB;
        for (int t = 0; t < nt; t += 2) {
            const bool last = (t == nt - 2);
            const char* a1 = cA + (size_t)(t + 1) * kstep;
            const char* a2 = last ? nA : cA + (size_t)(t + 2) * kstep; const char* b2 = last ? nB : cB + (size_t)(t + 2) * kstep;
            const char* a3 = a2 + kstep; const char* b3 = b2 + kstep;
            if (last && has_next) S.a_ready(nxt);
            if constexpr (SP2) {
            PG8_LDB(B0, 0, 0); PG8_LDB(B1, 0, 1); PG8_SCHED; PG8_LDA(At, 0, 0); PG8_STAGE(PG8_SA(1, 1), a1 + hstep, voffA);
            PG8_WAIT_V(8); PG8_WAIT_L(0); PG8_BAR; PG8_MMA(0, 0, At, B0); PG8_MMA(0, 1, At, B1); PG8_BAR; PG8_SCHED;
            PG8_LDA(At, 0, 1); PG8_STAGE(PG8_SB(0, 0), b2, voffB); PG8_STAGE(PG8_SB(0, 1), b2 + hstep, voffB); PG8_STAGE(PG8_SA(0, 0), a2, voffA);
            PG8_WAIT_V(8); PG8_WAIT_L(0); PG8_BAR; PG8_MMA(1, 0, At, B0); PG8_MMA(1, 1, At, B1); PG8_BAR; PG8_SCHED;
            PG8_LDB(B0, 1, 0); PG8_LDB(B1, 1, 1); PG8_SCHED; PG8_LDA(At, 1, 0); PG8_STAGE(PG8_SA(0, 1), a2 + hstep, voffA);
            PG8_WAIT_V(8); PG8_WAIT_L(0); PG8_BAR; PG8_MMA(0, 0, At, B0); PG8_MMA(0, 1, At, B1); PG8_BAR; PG8_SCHED;
            PG8_LDA(At, 1, 1); PG8_STAGE(PG8_SB(1, 0), b3, voffB); PG8_STAGE(PG8_SB(1, 1), b3 + hstep, voffB); PG8_STAGE(PG8_SA(1, 0), a3, voffA);
            PG8_WAIT_V(8); PG8_WAIT_L(0); PG8_BAR; PG8_MMA(1, 0, At, B0); PG8_MMA(1, 1, At, B1); PG8_BAR; PG8_SCHED;
            } else {
            PG8_LDB(B0, 0, 0); PG8_SCHED; PG8_LDA(At, 0, 0); PG8_STAGE(PG8_SA(1, 1), a1 + hstep, voffA);
            PG8_WAIT_L(8); PG8_BAR; PG8_WAIT_L(0); PG8_MMA(0, 0, At, B0); PG8_BAR; PG8_SCHED;
            PG8_LDB(B1, 0, 1); PG8_STAGE(PG8_SB(0, 0), b2, voffB);
            PG8_BAR; PG8_WAIT_L(0); PG8_MMA(0, 1, At, B1); PG8_BAR;
            PG8_LDA(At, 0, 1); PG8_STAGE(PG8_SA(0, 0), a2, voffA);
            PG8_BAR; PG8_WAIT_L(0); PG8_MMA(1, 0, At, B0); PG8_BAR; PG8_SCHED;
            PG8_STAGE(PG8_SB(0, 1), b2 + hstep, voffB);
            PG8_WAIT_V(6); PG8_BAR; PG8_MMA(1, 1, At, B1); PG8_BAR;
            PG8_LDB(B0, 1, 0); PG8_SCHED; PG8_LDA(At, 1, 0); PG8_STAGE(PG8_SA(0, 1), a2 + hstep, voffA);
            PG8_WAIT_L(8); PG8_BAR; PG8_WAIT_L(0); PG8_MMA(0, 0, At, B0); PG8_BAR; PG8_SCHED;
            PG8_LDB(B1, 1, 1); PG8_STAGE(PG8_SB(1, 0), b3, voffB);
            PG8_BAR; PG8_WAIT_L(0); PG8_MMA(0, 1, At, B1); PG8_BAR;
            PG8_LDA(At, 1, 1); PG8_STAGE(PG8_SA(1, 0), a3, voffA);
            PG8_BAR; PG8_WAIT_L(0); PG8_MMA(1, 0, At, B0); PG8_BAR; PG8_SCHED;
            PG8_STAGE(PG8_SB(1, 1), b3 + hstep, voffB);
            PG8_WAIT_V(6); PG8_BAR; PG8_MMA(1, 1, At, B1); PG8_BAR;
            }
        }
        if constexpr (ALIGN_EPI) { if (wr == 0) PG8_BAR; }
        if constexpr (!Epi::AFTER_DRAIN) { E(acc, cur, wr, wc, fr, fq); S.done(cur); }
        if (!has_next) break;
#pragma unroll
        for (int a = 0; a < 2; ++a)
#pragma unroll
            for (int b = 0; b < 2; ++b)
#pragma unroll
                for (int m = 0; m < 4; ++m)
#pragma unroll
                    for (int n = 0; n < 2; ++n) acc[a][b][m][n] = (f32x4){0.f, 0.f, 0.f, 0.f};
        cur = nxt; cA = nA; cB = nB; ++ui;
        if constexpr (ALIGN_EPI) { if (wr == 1) PG8_BAR; }
    }
    PG8_WAIT_V(0);
    if constexpr (!ALIGN_EPI) { if (wr == 0) PG8_BAR; }
    PG8_BAR;
    if constexpr (Epi::AFTER_DRAIN) { E.fused(acc, cur, wr, wc, fr, fq, lds, wid, lane); S.done(cur); }
#undef PG8_SA
#undef PG8_SB
#undef PG8_STAGE
#undef PG8_LDA
#undef PG8_LDB
#undef PG8_MMA
#undef PG8_WAIT_V
#undef PG8_WAIT_L
#undef PG8_BAR
#undef PG8_SCHED
}
}

constexpr int D = 1024, BATCH = 16, SEQ = 2048, CTX = 256, DEPTH = 4;
constexpr int TPB = CTX + SEQ;
constexpr int M = BATCH * TPB;
constexpr int DIN = 3088, NP = 3072, DFF = 4096;
constexpr int PC_DNQ = 0, PC_DNG = 768, PC_SQ = 1024, PC_SK = 1536, PC_SV = 1664, PC_HQ = 1792, PC_HF = 2048, PC_HI = 2560, PC_HG = 2816;
constexpr float EPS = 1e-6f;
constexpr size_t MiB = 1u << 20;
constexpr size_t WS_CTL = 0, WS_MODS = 1 * MiB, WS_ROPE = 3 * MiB, WS_LB = 3 * MiB + 512 * 1024, WS_AB = 4 * MiB;
constexpr size_t WS_WIN = 7 * MiB, WS_WOUT = 13 * MiB, WS_W1 = 15 * MiB, WS_W2 = 23 * MiB, WS_XC = 32 * MiB, WS_HY = 48 * MiB, WS_P = 120 * MiB;
constexpr size_t WS_OD = WS_P + 216 * MiB, WS_QKV = WS_P + 288 * MiB, WS_END = WS_QKV + 64 * MiB;
constexpr int LDS_BYTES = 147456;
constexpr int NWAVES = 8, NTHR = 512;

#define LAS __attribute__((address_space(3)))
typedef unsigned short bf16_t;
typedef float f32x4 __attribute__((ext_vector_type(4)));
typedef short bf16x8 __attribute__((ext_vector_type(8)));
typedef short s16x4 __attribute__((ext_vector_type(4)));
typedef unsigned u32x4 __attribute__((ext_vector_type(4)));
typedef unsigned u32x2 __attribute__((ext_vector_type(2)));

struct Params {
    const float *x, *c, *ctx, *c_ctx, *w_ada, *b_ada, *norm1, *norm2, *w_in, *dn_conv, *dn_A_log, *dn_dt_bias, *dn_norm, *swa_sink, *hg_lb, *hg_norm, *w_out, *w_ff1, *w_ff2, *norm_f;
    float* out; unsigned char* ws;
};

__device__ __forceinline__ float bflo(unsigned u) { return __uint_as_float(u << 16); }
__device__ __forceinline__ float bfhi(unsigned u) { return __uint_as_float(u & 0xffff0000u); }
__device__ __forceinline__ unsigned pk2(float lo, float hi) { return pg8::cvt_pk_bf16(lo, hi); }
__device__ __forceinline__ bf16_t bf1(float f) { return __builtin_bit_cast(bf16_t, (__bf16)f); }
__device__ __forceinline__ float siluf(float v) { return v / (1.f + __expf(-v)); }
__device__ __forceinline__ float sigmf(float v) { return 1.f / (1.f + __expf(-v)); }
__device__ __forceinline__ float bperm(float v, int srclane) { return __builtin_bit_cast(float, __builtin_amdgcn_ds_bpermute(srclane << 2, __builtin_bit_cast(int, v))); }
__device__ __forceinline__ float wave_sum(float v) {
    const int ln = lane_id_fresh();
#pragma unroll
    for (int o = 1; o < 64; o <<= 1) v += bperm(v, ln ^ o);
    return v;
}
template <int CTRL> __device__ __forceinline__ float dpp(float x) { return __builtin_bit_cast(float, __builtin_amdgcn_mov_dpp(__builtin_bit_cast(int, x), CTRL, 0xf, 0xf, true)); }
constexpr int XOR1 = 0xB1, XOR2 = 0x4E, XOR7 = 0x141;
__device__ __forceinline__ float sum8(float v) { v += dpp<XOR1>(v); v += dpp<XOR2>(v); v += dpp<XOR7>(v); return v; }
__device__ __forceinline__ float xrow16_max(float x) {
    auto s = __builtin_amdgcn_permlane16_swap(__float_as_uint(x), __float_as_uint(x), false, false);
    x = fmaxf(__uint_as_float(s[0]), __uint_as_float(s[1]));
    auto t = __builtin_amdgcn_permlane32_swap(__float_as_uint(x), __float_as_uint(x), false, false);
    return fmaxf(__uint_as_float(t[0]), __uint_as_float(t[1]));
}
__device__ __forceinline__ float xrow16_sum(float x) {
    auto s = __builtin_amdgcn_permlane16_swap(__float_as_uint(x), __float_as_uint(x), false, false);
    x = __uint_as_float(s[0]) + __uint_as_float(s[1]);
    auto t = __builtin_amdgcn_permlane32_swap(__float_as_uint(x), __float_as_uint(x), false, false);
    return __uint_as_float(t[0]) + __uint_as_float(t[1]);
}
__device__ __forceinline__ const float* xrow_c(const float* Xl, const float* Xc, int r) { const int b = r / TPB, t = r - b * TPB; return t < CTX ? Xc + ((size_t)(b * CTX + t) << 10) : Xl + ((size_t)(b * SEQ + t - CTX) << 10); }
__device__ __forceinline__ int cidx(int r) { const int b = r / TPB, t = r - b * TPB; return t < CTX ? 16 : b; }

__device__ __forceinline__ void phase_prologue(const Params& p, LAS unsigned char* lds, const int wvs) {
    const int tid = wvs * 64 + lane_id_fresh(); const int lane = tid & 63, w = tid >> 6;
    float* mods = (float*)(p.ws + WS_MODS);
    LAS float* sc = (LAS float*)lds;
    LAS float* red = (LAS float*)(lds + 81920);
    for (int idx = tid; idx < 17 * 1024; idx += NTHR) { const int ci = idx >> 10, k = idx & 1023; const float v = ci < 16 ? p.c[ci * 1024 + k] : p.c_ctx[k]; sc[k * 20 + ci] = v / (1.f + expf(-v)); }
    __syncthreads();
    for (int it = blockIdx.x; it < DEPTH * 96; it += gridDim.x) {
        const int l = it / 96, cgp = it - l * 96, col = cgp * 64 + lane;
        float acc[17];
#pragma unroll
        for (int i = 0; i < 17; ++i) acc[i] = 0.f;
        const float* wp = p.w_ada + ((size_t)l * 1024 + w * 128) * 6144 + col;
#pragma unroll 16
        for (int kk = 0; kk < 128; ++kk) {
            const float wv = wp[(size_t)kk * 6144];
            const LAS f32x4* s4 = (const LAS f32x4*)(sc + (w * 128 + kk) * 20);
            const f32x4 s0 = s4[0], s1 = s4[1], s2 = s4[2], s3 = s4[3]; const float s16 = sc[(w * 128 + kk) * 20 + 16];
#pragma unroll
            for (int e = 0; e < 4; ++e) { acc[e] += wv * s0[e]; acc[4 + e] += wv * s1[e]; acc[8 + e] += wv * s2[e]; acc[12 + e] += wv * s3[e]; }
            acc[16] += wv * s16;
        }
#pragma unroll
        for (int i = 0; i < 17; ++i) red[(w * 17 + i) * 64 + lane] = acc[i];
        __syncthreads();
        for (int idx = tid; idx < 17 * 64; idx += NTHR) { const int i = idx >> 6, cl = idx & 63; float s = 0.f;
#pragma unroll
            for (int ww = 0; ww < 8; ++ww) s += red[(ww * 17 + i) * 64 + cl];
            mods[((size_t)l * 17 + i) * 6144 + cgp * 64 + cl] = s + p.b_ada[l * 6144 + cgp * 64 + cl]; }
        __syncthreads();
    }
    const int gt = blockIdx.x * NTHR + tid, GT = gridDim.x * NTHR;
    { float* rc = (float*)(p.ws + WS_ROPE); float* rs = rc + 2048 * 32;
      for (int idx = gt; idx < 2048 * 32; idx += GT) { const int t = idx >> 5, d = idx & 31; const float pos = (float)(d < 16 ? (t >> 6) : (t & 63));
          const float inv = expf(-(float)(d & 15) * (9.210340371976184f / 16.f)); const float ang = pos * inv; rc[idx] = cosf(ang); rs[idx] = sinf(ang); } }
    { float* LB = (float*)(p.ws + WS_LB);
      for (int idx = gt; idx < 2 * 256; idx += GT) { const int d = idx >> 8, cc = idx & 255; float v[DEPTH]; float mx = -1e30f;
#pragma unroll
          for (int l = 0; l < DEPTH; ++l) { v[l] = p.hg_lb[(d * DEPTH + l) * 256 + cc]; mx = fmaxf(mx, v[l]); }
          float s = 0.f;
#pragma unroll
          for (int l = 0; l < DEPTH; ++l) { v[l] = expf(v[l] - mx); s += v[l]; }
          float cum = 0.f;
#pragma unroll
          for (int l = 0; l < DEPTH; ++l) { if (l > 0) cum += v[l] / s; LB[(d * DEPTH + l) * 256 + cc] = cum; } } }
}

__device__ __forceinline__ void transpose_item(const float* W, int K, int ldw, int scol0, bf16_t* WT, int n0, int k0, LAS float* scr, int lane) {
#pragma unroll 8
    for (int i = 0; i < 32; ++i) { const int kk = 2 * i + (lane >> 5); scr[kk * 33 + (lane & 31)] = W[(size_t)(k0 + kk) * ldw + scol0 + (lane & 31)]; }
    asm volatile("s_waitcnt lgkmcnt(0)" ::: "memory");
    const int c = lane & 7;
#pragma unroll
    for (int j = 0; j < 4; ++j) { const int n = (lane >> 3) + 8 * j; const LAS float* s = scr + (8 * c) * 33 + n;
        u32x4 o; o.x = pk2(s[0 * 33], s[1 * 33]); o.y = pk2(s[2 * 33], s[3 * 33]); o.z = pk2(s[4 * 33], s[5 * 33]); o.w = pk2(s[6 * 33], s[7 * 33]);
        *(u32x4*)(WT + (size_t)(n0 + n) * K + k0 + 8 * c) = o; }
    asm volatile("s_waitcnt lgkmcnt(0)" ::: "memory");
}

template <bool FIRST> __device__ __forceinline__ void phase_norm(const Params& p, int l, LAS unsigned char* lds, const int wvs) {
    const int tid = wvs * 64 + lane_id_fresh(); const int lane = tid & 63, w = tid >> 6;
    const int gw = blockIdx.x * NWAVES + w, NGW = gridDim.x * NWAVES;
    const float* mods = (const float*)(p.ws + WS_MODS);
    constexpr int WST = 1032;
    LAS bf16_t* wab = (LAS bf16_t*)lds;
    if (FIRST) {
        LAS float* scr = (LAS float*)(lds + 65536 + w * 8704);
        constexpr int I_IN = 16 * 96, I_OUT = 16 * 32, I_1 = 16 * 128, I_2 = 64 * 32;
        for (int it = gw; it < I_IN + I_OUT + I_1 + I_2; it += NGW) {
            int r = it;
            if (r < I_IN) { const int kb = r / 96, nb = r - kb * 96; const int n0 = nb * 32; transpose_item(p.w_in + (size_t)l * D * DIN, D, DIN, n0 + (n0 >= 1024 ? 16 : 0), (bf16_t*)(p.ws + WS_WIN), n0, kb * 64, scr, lane); continue; }
            r -= I_IN;
            if (r < I_OUT) { const int kb = r / 32, nb = r - kb * 32; transpose_item(p.w_out + (size_t)l * D * D, D, D, nb * 32, (bf16_t*)(p.ws + WS_WOUT), nb * 32, kb * 64, scr, lane); continue; }
            r -= I_OUT;
            if (r < I_1) { const int kb = r / 128, nb = r - kb * 128; transpose_item(p.w_ff1 + (size_t)l * D * DFF, D, DFF, nb * 32, (bf16_t*)(p.ws + WS_W1), nb * 32, kb * 64, scr, lane); continue; }
            r -= I_1;
            { const int kb = r / 32, nb = r - kb * 32; transpose_item(p.w_ff2 + (size_t)l * DFF * D, DFF, D, nb * 32, (bf16_t*)(p.ws + WS_W2), nb * 32, kb * 64, scr, lane); }
        }
        const float* wi = p.w_in + (size_t)l * D * DIN + 1024;
        for (int idx = tid; idx < 4096; idx += NTHR) { const int k = idx >> 2, j4 = (idx & 3) * 4; const f32x4 v = *(const f32x4*)(wi + (size_t)k * DIN + j4);
#pragma unroll
            for (int e = 0; e < 4; ++e) wab[(j4 + e) * WST + k] = bf1(v[e]); }
        __syncthreads();
    }
    const float* nw = (FIRST ? p.norm1 : p.norm2) + l * D;
    bf16_t* H = (bf16_t*)(p.ws + WS_HY);
    float* AB = (float*)(p.ws + WS_AB);
    float* Xc = (float*)(p.ws + WS_XC);
    const float* part = (const float*)(p.ws + WS_QKV);
    const bool fix = FIRST ? (l > 0) : (l < DEPTH - 1);
    const float* fgate = mods + ((size_t)(FIRST ? (l > 0 ? l - 1 : 0) : l) * 17 + 16) * 6144 + (FIRST ? 5 : 2) * 1024;
    int nrows = 0;
    for (int r = gw; r < M; r += NGW) {
        ++nrows;
        if (!FIRST && l == DEPTH - 1 && (r % TPB) < CTX) continue;
        const f32x4* xr = (const f32x4*)((FIRST && l == 0) ? xrow_c(p.x, p.ctx, r) : xrow_c(p.out, Xc, r)) + lane;
        f32x4 v[4]; float ss = 0.f;
        const int rb = r / TPB, rt = r - rb * TPB;
        if (fix && rt < CTX) {
            const f32x4* xin = (const f32x4*)((!FIRST && l == 0) ? p.ctx + ((size_t)(rb * CTX + rt) << 10) : Xc + ((size_t)(rb * CTX + rt) << 10)) + lane;
            const f32x4* pr = (const f32x4*)(part + ((size_t)(rb * CTX + rt) << 10)) + lane; f32x4* xo = (f32x4*)(Xc + ((size_t)(rb * CTX + rt) << 10)) + lane;
#pragma unroll
            for (int j = 0; j < 4; ++j) { const f32x4 gq = *(const f32x4*)(fgate + 4 * (lane + 64 * j));
                const f32x4 s4 = (pr[64 * j] + pr[64 * j + 1048576]) + (pr[64 * j + 2 * 1048576] + pr[64 * j + 3 * 1048576]);
                v[j] = xin[64 * j] + gq * s4; xo[64 * j] = v[j]; }
        } else {
#pragma unroll
            for (int j = 0; j < 4; ++j) v[j] = xr[64 * j];
        }
#pragma unroll
        for (int j = 0; j < 4; ++j) ss += (v[j][0] * v[j][0] + v[j][1] * v[j][1]) + (v[j][2] * v[j][2] + v[j][3] * v[j][3]);
        const float rstd = rsqrtf(wave_sum(ss) * (1.f / D) + EPS);
        const float* md = mods + ((size_t)l * 17 + cidx(r)) * 6144 + (FIRST ? 0 : 3 * 1024);
        u32x2* hp = (u32x2*)(H + (size_t)r * D) + lane;
#pragma unroll
        for (int j = 0; j < 4; ++j) { const int k = 4 * (lane + 64 * j);
            const f32x4 g = *(const f32x4*)(nw + k), sh = *(const f32x4*)(md + k), sl = *(const f32x4*)(md + 1024 + k);
            f32x4 h;
#pragma unroll
            for (int e = 0; e < 4; ++e) h[e] = (v[j][e] * rstd * g[e]) * (1.f + sl[e]) + sh[e];
            u32x2 o2; o2.x = pk2(h[0], h[1]); o2.y = pk2(h[2], h[3]); hp[64 * j] = o2;
        }
    }
    if (FIRST) {
        asm volatile("s_waitcnt vmcnt(0)" ::: "memory");
        const int fr = lane & 15, fq = lane >> 4;
        for (int b0 = 0; b0 < nrows; b0 += 16) {
            const int kr = b0 + fr; const bool ok = kr < nrows; const bf16_t* hp = H + (size_t)(gw + (ok ? kr : 0) * NGW) * D + fq * 8;
            f32x4 c = (f32x4){0.f, 0.f, 0.f, 0.f};
#pragma unroll 8
            for (int ks = 0; ks < 32; ++ks) { u32x4 av = *(const u32x4*)(hp + ks * 32); if (!ok) av = (u32x4){0u, 0u, 0u, 0u};
                const bf16x8 bv = *(const LAS bf16x8*)(wab + fr * WST + ks * 32 + fq * 8);
                c = __builtin_amdgcn_mfma_f32_16x16x32_bf16(__builtin_bit_cast(bf16x8, av), bv, c, 0, 0, 0); }
#pragma unroll
            for (int j = 0; j < 4; ++j) { const int k2 = b0 + fq * 4 + j; if (k2 < nrows) AB[(size_t)(gw + k2 * NGW) * 16 + fr] = c[j]; }
        }
    }
}

constexpr int SST = 68;
constexpr int HST = 72;
__device__ __forceinline__ bf16x8 ldA_perm(const LAS bf16_t* base, int row, int s, int fq) {
    const LAS bf16_t* ap = base + row * HST + s * 32 + fq * 4; const u32x2 lo = *(const LAS u32x2*)ap, hi = *(const LAS u32x2*)(ap + 16);
    u32x4 av; av[0] = lo[0]; av[1] = lo[1]; av[2] = hi[0]; av[3] = hi[1]; return __builtin_bit_cast(bf16x8, av);
}
__device__ __forceinline__ bf16x8 packB(const f32x4& a, const f32x4& b) {
    u32x4 pb; pb[0] = pk2(a[0], a[1]); pb[1] = pk2(a[2], a[3]); pb[2] = pk2(b[0], b[1]); pb[3] = pk2(b[2], b[3]);
    return __builtin_bit_cast(bf16x8, pb);
}
__device__ __forceinline__ void phase_dnprep(const Params& p, int l, LAS unsigned char* lds, const int wvs) {
    const int tid = wvs * 64 + lane_id_fresh();
    constexpr int RST = 200;
    LAS float* qs = (LAS float*)lds; LAS float* ks = qs + 64 * SST; LAS float* vs = ks + 64 * SST; LAS bf16_t* RAW = (LAS bf16_t*)(vs + 64 * SST);
    const bf16_t* P = (const bf16_t*)(p.ws + WS_P);
    bf16_t* QKV = (bf16_t*)(p.ws + WS_QKV);
    const float* cw = p.dn_conv + (size_t)l * 5 * 768;
    const int c4 = tid % 48, tg = tid / 48;
    LAS float* cdst = ((c4 >> 4) == 0 ? qs : ((c4 >> 4) == 1 ? ks : vs)) + (c4 & 15) * 4;
#define PREP_LOADRAW(itx) do { const int h_ = (itx) & 3, bc_ = (itx) >> 2, b_ = bc_ / 36, nc_ = bc_ - b_ * 36; const int base_ = b_ * TPB + nc_ * 64, lo_ = b_ * TPB + (nc_ < 4 ? 0 : CTX), hi_ = b_ * TPB + (nc_ < 4 ? CTX : TPB); \
        _Pragma("unroll") for (int k = 0; k < 4; ++k) { const int q = tid + NTHR * k; const int rr = q / 24, pc = q - rr * 24; const int r = base_ - 2 + rr; \
            praw[k] = (q < 68 * 24 && r >= lo_ && r < hi_) ? *(const u32x4*)(P + (size_t)r * NP + (pc >> 3) * 256 + h_ * 64 + (pc & 7) * 8) : (u32x4){0u, 0u, 0u, 0u}; } } while (0)
    u32x4 praw[4];
    if ((int)blockIdx.x < BATCH * 36 * 4) PREP_LOADRAW((int)blockIdx.x);
    for (int it = blockIdx.x; it < BATCH * 36 * 4; it += gridDim.x) {
        const int h = it & 3, bc = it >> 2, b = bc / 36, nc = bc - b * 36;
        const int base = b * TPB + nc * 64;
        float wc[5][4];
        { const int ch = c4 * 4, pcol = (ch >> 6) * 256 + h * 64 + (ch & 63);
#pragma unroll
          for (int t = 0; t < 5; ++t) { const f32x4 w4 = *(const f32x4*)(cw + t * 768 + pcol); wc[t][0] = w4[0]; wc[t][1] = w4[1]; wc[t][2] = w4[2]; wc[t][3] = w4[3]; } }
#pragma unroll
        for (int k = 0; k < 4; ++k) { const int q = tid + NTHR * k; if (q < 68 * 24) { const int rr = q / 24, pc = q - rr * 24; *(LAS u32x4*)(RAW + rr * RST + pc * 8) = praw[k]; } }
        if (it + (int)gridDim.x < BATCH * 36 * 4) PREP_LOADRAW(it + (int)gridDim.x);
        __syncthreads();
        if (tid < 480) {
#pragma unroll
            for (int m = 0; m < 7; ++m) { const int pp = tg + 10 * m; if (pp < 64) { float a0 = 0.f, a1 = 0.f, a2 = 0.f, a3 = 0.f;
#pragma unroll
                for (int t = 0; t < 5; ++t) { const u32x2 raw = *(const LAS u32x2*)(RAW + (pp + t) * RST + c4 * 4);
                    a0 += bflo(raw[0]) * wc[t][0]; a1 += bfhi(raw[0]) * wc[t][1]; a2 += bflo(raw[1]) * wc[t][2]; a3 += bfhi(raw[1]) * wc[t][3]; }
                f32x4 o; o[0] = a0 / (1.f + __expf(-a0)); o[1] = a1 / (1.f + __expf(-a1)); o[2] = a2 / (1.f + __expf(-a2)); o[3] = a3 / (1.f + __expf(-a3));
                *(LAS f32x4*)(cdst + pp * SST) = o; } } }
        __syncthreads();
        { const int t = tid >> 3, part = tid & 7;
          const f32x4 q0 = *(const LAS f32x4*)(qs + t * SST + part * 8), q1 = *(const LAS f32x4*)(qs + t * SST + part * 8 + 4);
          const f32x4 k0 = *(const LAS f32x4*)(ks + t * SST + part * 8), k1 = *(const LAS f32x4*)(ks + t * SST + part * 8 + 4);
          const f32x4 v0 = *(const LAS f32x4*)(vs + t * SST + part * 8), v1 = *(const LAS f32x4*)(vs + t * SST + part * 8 + 4);
          float sq = (q0[0] * q0[0] + q0[1] * q0[1]) + (q0[2] * q0[2] + q0[3] * q0[3]) + (q1[0] * q1[0] + q1[1] * q1[1]) + (q1[2] * q1[2] + q1[3] * q1[3]);
          float sk = (k0[0] * k0[0] + k0[1] * k0[1]) + (k0[2] * k0[2] + k0[3] * k0[3]) + (k1[0] * k1[0] + k1[1] * k1[1]) + (k1[2] * k1[2] + k1[3] * k1[3]);
          sq = sum8(sq); sk = sum8(sk);
          const float rq = rsqrtf(sq + EPS) * 0.125f, rk = rsqrtf(sk + EPS);
          u32x4 qo, ko, vo;
          qo[0] = pk2(q0[0] * rq, q0[1] * rq); qo[1] = pk2(q0[2] * rq, q0[3] * rq); qo[2] = pk2(q1[0] * rq, q1[1] * rq); qo[3] = pk2(q1[2] * rq, q1[3] * rq);
          ko[0] = pk2(k0[0] * rk, k0[1] * rk); ko[1] = pk2(k0[2] * rk, k0[3] * rk); ko[2] = pk2(k1[0] * rk, k1[1] * rk); ko[3] = pk2(k1[2] * rk, k1[3] * rk);
          vo[0] = pk2(v0[0], v0[1]); vo[1] = pk2(v0[2], v0[3]); vo[2] = pk2(v1[0], v1[1]); vo[3] = pk2(v1[2], v1[3]);
          bf16_t* dst = QKV + ((size_t)(base + t) * 4 + h) * 192 + part * 8;
          *(u32x4*)dst = qo; *(u32x4*)(dst + 64) = ko; *(u32x4*)(dst + 128) = vo; }
        __syncthreads();
    }
#undef PREP_LOADRAW
    { bf16_t* Pw = (bf16_t*)(p.ws + WS_P); const float* rc = (const float*)(p.ws + WS_ROPE); const float* rs = rc + 2048 * 32;
      const int gt = blockIdx.x * NTHR + tid, GT = gridDim.x * NTHR;
      for (int idx = gt; idx < BATCH * SEQ * 8; idx += GT) { const int rl = idx >> 3, rem = idx & 7, kh = rem >> 2, g = rem & 3;
          const int bb = rl >> 11, t = rl & 2047;
          bf16_t* pp = Pw + (size_t)(bb * TPB + CTX + t) * NP + PC_SK + kh * 64 + g * 8;
          const u32x4 r1 = *(const u32x4*)pp, r2 = *(const u32x4*)(pp + 32);
          const f32x4 c0 = *(const f32x4*)(rc + t * 32 + g * 8), c1 = *(const f32x4*)(rc + t * 32 + g * 8 + 4), s0 = *(const f32x4*)(rs + t * 32 + g * 8), s1 = *(const f32x4*)(rs + t * 32 + g * 8 + 4);
          u32x4 o1, o2;
#pragma unroll
          for (int e = 0; e < 4; ++e) { const float xa = bflo(r1[e]), xb = bfhi(r1[e]), ya = bflo(r2[e]), yb = bfhi(r2[e]);
              const float ca = e < 2 ? c0[2 * e] : c1[2 * e - 4], cb = e < 2 ? c0[2 * e + 1] : c1[2 * e - 3], sa = e < 2 ? s0[2 * e] : s1[2 * e - 4], sb = e < 2 ? s0[2 * e + 1] : s1[2 * e - 3];
              o1[e] = pk2(xa * ca - ya * sa, xb * cb - yb * sb); o2[e] = pk2(xa * sa + ya * ca, xb * sb + yb * cb); }
          *(u32x4*)pp = o1; *(u32x4*)(pp + 32) = o2; } }
}

__device__ __forceinline__ void dn_seq(const Params& p, int l, int s, LAS unsigned char* lds, const int wvs) {
    const int tid = wvs * 64 + lane_id_fresh(); const int lane = tid & 63;
    const int b = s >> 3, h = (s >> 1) & 3, d = s & 1;
    constexpr int TILEB = 64 * HST * 2, BUFB = 6 * TILEB + 4 * 16 * 24 * 2 + 1024;
    LAS bf16_t* OB = (LAS bf16_t*)(lds + 2 * BUFB); LAS float* LF = (LAS float*)(lds + 2 * BUFB + TILEB);
    const bf16_t* QKV = (const bf16_t*)(p.ws + WS_QKV);
    const float* AB = (const float*)(p.ws + WS_AB);
    bf16_t* OD = (bf16_t*)(p.ws + WS_OD) + (size_t)d * M * 512 + h * 64;
    const float nA = -expf(p.dn_A_log[(l * 2 + d) * 4 + h]); const float dtb = p.dn_dt_bias[(l * 2 + d) * 4 + h];
    const int fr = lane & 15, fq = lane >> 4, V = wvs & 3;
    const bool isP = wvs < 4;
    const f32x4 zero4 = (f32x4){0.f, 0.f, 0.f, 0.f};
    u32x4 praw[6]; float pa = 0.f, pb_ = 0.f;
    f32x4 Sacc[4], R[4], QS[4];
#pragma unroll
    for (int T = 0; T < 4; ++T) { Sacc[T] = zero4; R[T] = zero4; QS[T] = zero4; }
#define DN_BASE(ci) (b * TPB + ((d == 0) ? (ci) : ((ci) < 4 ? 3 - (ci) : 39 - (ci))) * 64)
#define DN_LOADRAW(ci) do { const int base_ = DN_BASE(ci); int tl_ = tid; asm volatile("" : "+v"(tl_)); _Pragma("unroll") for (int k = 0; k < 6; ++k) { const int q = tl_ + 256 * k; const int rr = q / 24, pc = q - rr * 24; \
            praw[k] = *(const u32x4*)(QKV + ((size_t)(base_ + rr) * 4 + h) * 192 + pc * 8); } \
        if (wvs == 0) { const int r_ = base_ + (d ? 63 - lane : lane); pa = AB[(size_t)r_ * 16 + d * 4 + h]; pb_ = AB[(size_t)r_ * 16 + 8 + d * 4 + h]; } } while (0)
#define DN_S1(buf) do { LAS bf16_t* QH_ = (LAS bf16_t*)(lds + (buf) * BUFB); LAS float* SCL_ = (LAS float*)(lds + (buf) * BUFB + 6 * TILEB + 4 * 16 * 24 * 2); \
        int tl_ = tid; asm volatile("" : "+v"(tl_)); _Pragma("unroll") for (int k = 0; k < 6; ++k) { const int q = tl_ + 256 * k; const int rr = q / 24, pc = q - rr * 24; const int t = d ? 63 - rr : rr; \
            *(LAS u32x4*)(QH_ + (pc >> 3) * 64 * HST + t * HST + (pc & 7) * 8) = praw[k]; } \
        if (wvs == 0) { const float xs = pa + dtb; const float sp = xs > 15.f ? xs : (xs < -15.f ? __expf(xs) : __logf(1.f + __expf(xs))); float x = nA * sp; \
            _Pragma("unroll") for (int o = 1; o < 64; o <<= 1) { const float y = bperm(x, lane - o); if (lane >= o) x += y; } \
            SCL_[lane] = x; SCL_[64 + lane] = __expf(x); SCL_[128 + lane] = __builtin_amdgcn_rcpf(1.f + __expf(-pb_)); if (lane == 63) { SCL_[192] = x; SCL_[193] = __expf(x); } } } while (0)
    if (isP) {
        DN_LOADRAW(0); DN_S1(0);
        __syncthreads();
    for (int ci = -1; ci < 36; ++ci) {
        const int cur = ci & 1, nxt = cur ^ 1;
        LAS bf16_t* QH = (LAS bf16_t*)(lds + cur * BUFB); LAS bf16_t* KH = QH + 64 * HST; LAS bf16_t* VB = KH + 64 * HST; LAS bf16_t* KTT = VB + 64 * HST; LAS bf16_t* LM = KTT + 64 * HST; LAS bf16_t* SCM = LM + 64 * HST;
        LAS bf16_t* DI = SCM + 64 * HST; LAS float* GC = (LAS float*)(DI + 4 * 16 * 24); LAS float* EG = GC + 64; LAS float* BETA = EG + 64; LAS float* GL = BETA + 64;
            if (ci >= 0) {
                const int I = wvs;
                { const int t = tid >> 2, part = tid & 3; const float ekt = __expf(GL[0] - GC[t]);
#pragma unroll
                  for (int hh = 0; hh < 2; ++hh) { const u32x4 kr = *(const LAS u32x4*)(KH + t * HST + part * 16 + hh * 8);
#pragma unroll
                      for (int e = 0; e < 4; ++e) { KTT[(part * 16 + hh * 8 + 2 * e) * HST + t] = bf1(bflo(kr[e]) * ekt); KTT[(part * 16 + hh * 8 + 2 * e + 1) * HST + t] = bf1(bfhi(kr[e]) * ekt); } } }
                  asm volatile("s_waitcnt lgkmcnt(0)" ::: "memory");
                  { int c = lane & 15; asm volatile("" : "+v"(c)); float x[16]; const LAS f32x4* LB_ = (const LAS f32x4*)(LF + I * 16 * 20);
#define DN_LROW(dst, i0, i1) _Pragma("unroll") for (int i = (i0); i <= (i1); ++i) _Pragma("unroll") for (int j4 = 0; j4 < (i + 3) / 4; ++j4) dst[i - (i0)][j4] = LB_[i * 5 + j4]
#define DN_SOLVE(srcv, i0, i1) _Pragma("unroll") for (int i = (i0); i <= (i1); ++i) { float acc = (i == c) ? 1.f : 0.f; _Pragma("unroll") for (int j2 = 0; j2 < i; ++j2) acc -= srcv[i - (i0)][j2 >> 2][j2 & 3] * x[j2]; x[i] = acc; }
                    x[0] = (c == 0) ? 1.f : 0.f;
                    { f32x4 La[8][2]; DN_LROW(La, 1, 8); asm volatile("s_waitcnt lgkmcnt(0)" ::: "memory"); DN_SOLVE(La, 1, 8); }
                    { f32x4 Lb[4][3]; DN_LROW(Lb, 9, 12); asm volatile("s_waitcnt lgkmcnt(0)" ::: "memory"); DN_SOLVE(Lb, 9, 12); }
                    { f32x4 Lc[3][4]; DN_LROW(Lc, 13, 15); asm volatile("s_waitcnt lgkmcnt(0)" ::: "memory"); DN_SOLVE(Lc, 13, 15); }
#undef DN_LROW
#undef DN_SOLVE
                    if (lane < 16) {
#pragma unroll
                        for (int i = 0; i < 16; ++i) DI[(I * 16 + i) * 24 + c] = bf1(x[i]); } }
            }
            if (ci >= 0 && ci + 1 < 36) DN_S1(nxt);
            __syncthreads();
            {
            const int pb2 = (ci < 0) ? 0 : nxt;
            if (ci + 1 < 36) {
                LAS bf16_t* QHn = (LAS bf16_t*)(lds + pb2 * BUFB); LAS bf16_t* KHn = QHn + 64 * HST; LAS bf16_t* KTTn = KHn + 2 * 64 * HST; LAS bf16_t* LMn = KTTn + 64 * HST; LAS bf16_t* SCMn = LMn + 64 * HST;
                LAS bf16_t* DIn = SCMn + 64 * HST; LAS float* GCn = (LAS float*)(DIn + 4 * 16 * 24); LAS float* BETAn = GCn + 128; LAS float* GLn = GCn + 192;
                { const int I = wvs;
                  float gci[4], bti[4], gcj[4];
#pragma unroll
                  for (int r = 0; r < 4; ++r) { gci[r] = GCn[I * 16 + fq * 4 + r]; bti[r] = BETAn[I * 16 + fq * 4 + r]; gcj[r] = GCn[r * 16 + fr]; }
#pragma unroll
                  for (int J = 0; J < 4; ++J) { f32x4 ckk = zero4, cqk = zero4;
                      if (J <= I) {
#pragma unroll
                          for (int kk = 0; kk < 2; ++kk) { const bf16x8 Ak = *(const LAS bf16x8*)(KHn + (I * 16 + fr) * HST + kk * 32 + fq * 8), Aq = *(const LAS bf16x8*)(QHn + (I * 16 + fr) * HST + kk * 32 + fq * 8);
                              const bf16x8 B = *(const LAS bf16x8*)(KHn + (J * 16 + fr) * HST + kk * 32 + fq * 8);
                              ckk = __builtin_amdgcn_mfma_f32_16x16x32_bf16(Ak, B, ckk, 0, 0, 0); cqk = __builtin_amdgcn_mfma_f32_16x16x32_bf16(Aq, B, cqk, 0, 0, 0); } }
                      const int j = J * 16 + fr; const float gj = gcj[J];
#pragma unroll
                      for (int r = 0; r < 4; ++r) { const int i = I * 16 + fq * 4 + r; const float dec = __expf(fminf(gci[r] - gj, 0.f));
                          const float lvv = bti[r] * ckk[r] * dec, svv = cqk[r] * dec;
                          const float lv = j < i ? lvv : 0.f, sv = j <= i ? svv : 0.f;
                          LMn[i * HST + j] = bf1(lv); SCMn[i * HST + j] = bf1(sv); if (I == J) LF[(I * 16 + fq * 4 + r) * 20 + fr] = lv; } }
 }
                if (ci + 2 < 36) DN_LOADRAW(ci + 2);
            }
            }
            __syncthreads();
        }
    } else {
        __syncthreads();
    for (int ci = -1; ci < 36; ++ci) {
        const int cur = ci & 1, nxt = cur ^ 1;
        LAS bf16_t* QH = (LAS bf16_t*)(lds + cur * BUFB); LAS bf16_t* KH = QH + 64 * HST; LAS bf16_t* VB = KH + 64 * HST; LAS bf16_t* KTT = VB + 64 * HST; LAS bf16_t* LM = KTT + 64 * HST; LAS bf16_t* SCM = LM + 64 * HST;
        LAS bf16_t* DI = SCM + 64 * HST; LAS float* GC = (LAS float*)(DI + 4 * 16 * 24); LAS float* EG = GC + 64; LAS float* BETA = EG + 64; LAS float* GL = BETA + 64;
            if (ci >= 0) {
            if (ci > 0) { const int basep = DN_BASE(ci - 1); const int u = tid - 256;
#pragma unroll
                for (int it = 0; it < 8; ++it) { const int idx = u + 256 * it; const int i = idx >> 5, c2 = (idx & 31) * 2; const int row = basep + (d ? 63 - i : i);
                    *(unsigned*)(OD + (size_t)row * 512 + c2) = *(const LAS unsigned*)(OB + i * HST + c2); } }
            bf16x8 Bs[2];
#pragma unroll
            for (int s2 = 0; s2 < 2; ++s2) Bs[s2] = packB(Sacc[2 * s2], Sacc[2 * s2 + 1]);
#pragma unroll
            for (int I = 0; I < 4; ++I) { f32x4 c = zero4, cq = zero4;
#pragma unroll
                for (int s2 = 0; s2 < 2; ++s2) { c = __builtin_amdgcn_mfma_f32_16x16x32_bf16(ldA_perm(KH, I * 16 + fr, s2, fq), Bs[s2], c, 0, 0, 0); cq = __builtin_amdgcn_mfma_f32_16x16x32_bf16(ldA_perm(QH, I * 16 + fr, s2, fq), Bs[s2], cq, 0, 0, 0); }
#pragma unroll
                for (int r = 0; r < 4; ++r) { const int i = I * 16 + fq * 4 + r; R[I][r] = BETA[i] * (bflo((unsigned)VB[i * HST + V * 16 + fr]) - EG[i] * c[r]); QS[I][r] = EG[i] * cq[r]; } }
                    }
            __syncthreads();
            if (ci >= 0) {
            bf16x8 Bx0, Bx1;
            { bf16x8 AD[4];
#pragma unroll
              for (int I = 0; I < 4; ++I) { const u32x2 lo = *(const LAS u32x2*)(DI + (I * 16 + fr) * 24 + fq * 4); u32x4 av; av[0] = lo[0]; av[1] = lo[1]; av[2] = 0u; av[3] = 0u; AD[I] = __builtin_bit_cast(bf16x8, av); }
              const f32x4 X0 = __builtin_amdgcn_mfma_f32_16x16x32_bf16(AD[0], packB(R[0], zero4), zero4, 0, 0, 0);
              f32x4 T1 = __builtin_amdgcn_mfma_f32_16x16x32_bf16(ldA_perm(LM, 16 + fr, 0, fq), packB(X0, zero4), zero4, 0, 0, 0);
              const f32x4 X1 = __builtin_amdgcn_mfma_f32_16x16x32_bf16(AD[1], packB(R[1] - T1, zero4), zero4, 0, 0, 0);
              Bx0 = packB(X0, X1);
              f32x4 T2 = __builtin_amdgcn_mfma_f32_16x16x32_bf16(ldA_perm(LM, 32 + fr, 0, fq), Bx0, zero4, 0, 0, 0);
              const f32x4 X2 = __builtin_amdgcn_mfma_f32_16x16x32_bf16(AD[2], packB(R[2] - T2, zero4), zero4, 0, 0, 0);
              f32x4 T3 = __builtin_amdgcn_mfma_f32_16x16x32_bf16(ldA_perm(LM, 48 + fr, 0, fq), Bx0, zero4, 0, 0, 0);
              T3 = __builtin_amdgcn_mfma_f32_16x16x32_bf16(ldA_perm(LM, 48 + fr, 1, fq), packB(X2, zero4), T3, 0, 0, 0);
              const f32x4 X3 = __builtin_amdgcn_mfma_f32_16x16x32_bf16(AD[3], packB(R[3] - T3, zero4), zero4, 0, 0, 0);
              Bx1 = packB(X2, X3); }
#pragma unroll
            for (int I = 0; I < 4; ++I) { f32x4 c = QS[I];
                c = __builtin_amdgcn_mfma_f32_16x16x32_bf16(ldA_perm(SCM, I * 16 + fr, 0, fq), Bx0, c, 0, 0, 0);
                c = __builtin_amdgcn_mfma_f32_16x16x32_bf16(ldA_perm(SCM, I * 16 + fr, 1, fq), Bx1, c, 0, 0, 0);
#pragma unroll
                for (int r = 0; r < 4; ++r) OB[(I * 16 + fq * 4 + r) * HST + V * 16 + fr] = bf1(c[r]); }
            { const float egl = GL[1];
#pragma unroll
              for (int T = 0; T < 4; ++T) { f32x4 c = Sacc[T] * egl;
                  c = __builtin_amdgcn_mfma_f32_16x16x32_bf16(ldA_perm(KTT, T * 16 + fr, 0, fq), Bx0, c, 0, 0, 0);
                  c = __builtin_amdgcn_mfma_f32_16x16x32_bf16(ldA_perm(KTT, T * 16 + fr, 1, fq), Bx1, c, 0, 0, 0);
                  Sacc[T] = c; } }
                    }
            __syncthreads();
        }
    }
    if (!isP) { const int basep = DN_BASE(35); const int u = tid - 256;
#pragma unroll
        for (int it = 0; it < 8; ++it) { const int idx = u + 256 * it; const int i = idx >> 5, c2 = (idx & 31) * 2; const int row = basep + (d ? 63 - i : i);
            *(unsigned*)(OD + (size_t)row * 512 + c2) = *(const LAS unsigned*)(OB + i * HST + c2); } }
    __syncthreads();
#undef DN_BASE
#undef DN_LOADRAW
#undef DN_S1
}

__device__ __forceinline__ void hg_seq(const Params& p, int l, int s, LAS unsigned char* lds, const int wvs) {
    const int tid = wvs * 64 + lane_id_fresh(); const int lane = tid & 63;
    const int b = s >> 3, h = (s >> 1) & 3, d = s & 1;
    constexpr int BUFB = 5 * 64 * HST * 2;
    LAS bf16_t* SC = (LAS bf16_t*)(lds + 2 * BUFB); LAS bf16_t* OB = SC + 64 * HST;
    LAS float* GS = (LAS float*)(OB + 64 * HST); LAS float* EBL = GS + 256;
    const bf16_t* P = (const bf16_t*)(p.ws + WS_P);
    bf16_t* OD = (bf16_t*)(p.ws + WS_OD) + (size_t)d * M * 512 + 256 + h * 64;
    const bool isA = wvs < 4;
    const int kx = tid & 63, g = wvs & 3;
    const float lb = ((const float*)(p.ws + WS_LB))[(d * DEPTH + l) * 256 + h * 64 + kx];
    const int fr = lane & 15, fq = lane >> 4, V = wvs & 3;
    f32x4 Sacc[4];
#pragma unroll
    for (int T = 0; T < 4; ++T) Sacc[T] = (f32x4){0.f, 0.f, 0.f, 0.f};
    unsigned short rq[16], rz[16], rv[16];
    float qv[16], kv[16], bc[16];
#define HG_BASE(ci) (b * TPB + ((d == 0) ? (ci) : ((ci) < 4 ? 3 - (ci) : 39 - (ci))) * 64)
#define HG_LOADRAW(ci) do { const int base_ = HG_BASE(ci); _Pragma("unroll") for (int e = 0; e < 16; ++e) { const int t = g * 16 + e; const int pp = d ? 63 - t : t; const bf16_t* rp = P + (size_t)(base_ + pp) * NP + h * 64 + kx; \
        rq[e] = rp[PC_HQ]; rz[e] = rp[PC_HF + d * 256]; rv[e] = rp[PC_HI]; } } while (0)
#define HG_A1(buf) do { LAS bf16_t* VT_ = (LAS bf16_t*)(lds + (buf) * BUFB) + 4 * 64 * HST; float run = 0.f; \
        _Pragma("unroll") for (int e = 0; e < 16; ++e) { const float z = bflo(rz[e]); const float sg = __builtin_amdgcn_rcpf(1.f + __expf(-z)); const float f = lb + (1.f - lb) * sg; \
            run += __logf(f); bc[e] = run; kv[e] = (1.f - lb) * (1.f - sg); qv[e] = bflo(rq[e]); VT_[kx * HST + g * 16 + e] = rv[e]; } \
        GS[g * 64 + kx] = run; } while (0)
#define HG_A2(buf) do { LAS bf16_t* QT_ = (LAS bf16_t*)(lds + (buf) * BUFB); LAS bf16_t* KT_ = QT_ + 64 * HST; LAS bf16_t* QP_ = KT_ + 64 * HST; LAS bf16_t* KTT_ = QP_ + 64 * HST; \
        const float g0 = GS[kx], g1 = GS[64 + kx], g2 = GS[128 + kx], g3 = GS[192 + kx]; const float mid = g0 + g1, bl = (g0 + g1) + (g2 + g3); \
        const float off = (g > 0 ? g0 : 0.f) + (g > 1 ? g1 : 0.f) + (g > 2 ? g2 : 0.f); \
        if (g == 3) EBL[(buf) * 64 + kx] = __expf(bl); \
        _Pragma("unroll") for (int e = 0; e < 16; ++e) { const int t = g * 16 + e; const float bce = bc[e] + off; const float E = fminf(fmaxf(bce - mid, -80.f), 80.f); \
            QT_[t * HST + kx] = bf1(qv[e] * __expf(E)); KT_[t * HST + kx] = bf1(kv[e] * __expf(-E)); \
            QP_[t * HST + kx] = bf1(qv[e] * __expf(bce)); KTT_[kx * HST + t] = bf1(kv[e] * __expf(bl - bce)); } } while (0)
    if (isA) { HG_LOADRAW(0); HG_A1(0); }
    __syncthreads();
    if (isA) { HG_A2(0); HG_LOADRAW(1); }
    __syncthreads();
    for (int ci = 0; ci < 36; ++ci) {
        const int cur = ci & 1, nxt = cur ^ 1;
        LAS bf16_t* QT = (LAS bf16_t*)(lds + cur * BUFB); LAS bf16_t* KT = QT + 64 * HST; LAS bf16_t* QP = KT + 64 * HST; LAS bf16_t* KTT = QP + 64 * HST; LAS bf16_t* VT = KTT + 64 * HST;
        if (isA) { if (ci + 1 < 36) HG_A1(nxt); }
        else {
            if (ci > 0) { const int basep = HG_BASE(ci - 1); const int u = tid - 256;
#pragma unroll
                for (int it = 0; it < 8; ++it) { const int idx = u + 256 * it; const int i = idx >> 5, c2 = (idx & 31) * 2; const int row = basep + (d ? 63 - i : i);
                    *(unsigned*)(OD + (size_t)row * 512 + c2) = *(const LAS unsigned*)(OB + i * HST + c2); } }
            { const int I = V;
#pragma unroll
              for (int J = 0; J < 4; ++J) { f32x4 c = (f32x4){0.f, 0.f, 0.f, 0.f};
                  if (J <= I) {
#pragma unroll
                      for (int kk = 0; kk < 2; ++kk) { const bf16x8 A = *(const LAS bf16x8*)(QT + (I * 16 + fr) * HST + kk * 32 + fq * 8); const bf16x8 B = *(const LAS bf16x8*)(KT + (J * 16 + fr) * HST + kk * 32 + fq * 8);
                          c = __builtin_amdgcn_mfma_f32_16x16x32_bf16(A, B, c, 0, 0, 0); } }
#pragma unroll
                  for (int r = 0; r < 4; ++r) { const int i = I * 16 + fq * 4 + r, j = J * 16 + fr; SC[i * HST + j] = bf1(j <= i ? c[r] : 0.f); } } }
        }
        __syncthreads();
        if (isA) { if (ci + 1 < 36) { HG_A2(nxt); if (ci + 2 < 36) HG_LOADRAW(ci + 2); } }
        else {
            bf16x8 Bs[2], Bv[2];
#pragma unroll
            for (int s2 = 0; s2 < 2; ++s2) { Bs[s2] = packB(Sacc[2 * s2], Sacc[2 * s2 + 1]); Bv[s2] = *(const LAS bf16x8*)(VT + (V * 16 + fr) * HST + s2 * 32 + fq * 8); }
#pragma unroll
            for (int I = 0; I < 4; ++I) { f32x4 o = (f32x4){0.f, 0.f, 0.f, 0.f};
#pragma unroll
                for (int s2 = 0; s2 < 2; ++s2) o = __builtin_amdgcn_mfma_f32_16x16x32_bf16(ldA_perm(QP, I * 16 + fr, s2, fq), Bs[s2], o, 0, 0, 0);
#pragma unroll
                for (int s2 = 0; s2 < 2; ++s2) { const bf16x8 A = *(const LAS bf16x8*)(SC + (I * 16 + fr) * HST + s2 * 32 + fq * 8); o = __builtin_amdgcn_mfma_f32_16x16x32_bf16(A, Bv[s2], o, 0, 0, 0); }
#pragma unroll
                for (int r = 0; r < 4; ++r) OB[(I * 16 + fq * 4 + r) * HST + V * 16 + fr] = bf1(o[r]); }
#pragma unroll
            for (int T = 0; T < 4; ++T) { f32x4 c;
#pragma unroll
                for (int r = 0; r < 4; ++r) c[r] = Sacc[T][r] * EBL[cur * 64 + T * 16 + fq * 4 + r];
#pragma unroll
                for (int s2 = 0; s2 < 2; ++s2) { const bf16x8 A = *(const LAS bf16x8*)(KTT + (T * 16 + fr) * HST + s2 * 32 + fq * 8); c = __builtin_amdgcn_mfma_f32_16x16x32_bf16(A, Bv[s2], c, 0, 0, 0); }
                Sacc[T] = c; }
        }
        __syncthreads();
    }
    if (!isA) { const int basep = HG_BASE(35); const int u = tid - 256;
#pragma unroll
        for (int it = 0; it < 8; ++it) { const int idx = u + 256 * it; const int i = idx >> 5, c2 = (idx & 31) * 2; const int row = basep + (d ? 63 - i : i);
            *(unsigned*)(OD + (size_t)row * 512 + c2) = *(const LAS unsigned*)(OB + i * HST + c2); } }
    __syncthreads();
#undef HG_BASE
#undef HG_LOADRAW
#undef HG_A1
#undef HG_A2
}

constexpr int KST = 72, VST = 136;
__device__ __forceinline__ void swa_unit(const Params& p, int l, int unit, LAS unsigned char* lds, const int wvs) {
    const int tid = wvs * 64 + lane_id_fresh(); const int lane = tid & 63;
    int b, kvh, qb;
    if (unit < 512) { b = unit >> 5; kvh = (unit >> 4) & 1; qb = 2 + (unit & 15); } else { const int v = unit - 512; b = v >> 2; kvh = (v >> 1) & 1; qb = v & 1; }
    const bool qctx = qb < 2;
    const bf16_t* P = (const bf16_t*)(p.ws + WS_P);
    const float* rc = (const float*)(p.ws + WS_ROPE); const float* rs = rc + 2048 * 32;
    bf16_t* Y = (bf16_t*)(p.ws + WS_HY);
    LAS bf16_t* Ks = (LAS bf16_t*)lds; LAS bf16_t* Vt = Ks + 128 * KST;
    const int hh = wvs >> 1, qhalf = wvs & 1, head = kvh * 4 + hh;
    const int fr = lane & 15, fq = lane >> 4;
    const int rowq0 = b * TPB + qb * 128 + qhalf * 64;
    const int f0 = (!qctx && qb == 2) ? 1 : 0, nl = qctx ? 0 : 3 - f0 - (qb == 17 ? 1 : 0), nkb = nl + 2;
#define SWA_BLK(j) ((j) < nl ? qb - 1 + f0 + (j) : (j) - nl)
#define SWA_REL(j) ((j) < nl ? f0 + (j) - 1 : 0)
    bf16x8 qf[4][2];
#pragma unroll
    for (int qt = 0; qt < 4; ++qt) {
        const int row = rowq0 + qt * 16 + fr; const bf16_t* qp = P + (size_t)row * NP + PC_SQ + head * 64 + fq * 8;
        const u32x4 r1 = *(const u32x4*)qp, r2 = *(const u32x4*)(qp + 32);
        float a1[8], a2[8];
#pragma unroll
        for (int e = 0; e < 4; ++e) { a1[2 * e] = bflo(r1[e]); a1[2 * e + 1] = bfhi(r1[e]); a2[2 * e] = bflo(r2[e]); a2[2 * e + 1] = bfhi(r2[e]); }
        if (!qctx) { const int t = (qb - 2) * 128 + qhalf * 64 + qt * 16 + fr; const float* cp = rc + t * 32 + fq * 8; const float* sp = rs + t * 32 + fq * 8;
#pragma unroll
            for (int e = 0; e < 8; ++e) { const float cs = cp[e], sn = sp[e]; const float o1 = a1[e] * cs - a2[e] * sn, o2 = a1[e] * sn + a2[e] * cs; a1[e] = o1; a2[e] = o2; } }
        u32x4 o1, o2;
#pragma unroll
        for (int e = 0; e < 4; ++e) { o1[e] = pk2(a1[2 * e] * 0.125f, a1[2 * e + 1] * 0.125f); o2[e] = pk2(a2[2 * e] * 0.125f, a2[2 * e + 1] * 0.125f); }
        qf[qt][0] = __builtin_bit_cast(bf16x8, o1); qf[qt][1] = __builtin_bit_cast(bf16x8, o2);
    }
    const int skey = tid >> 2, sg = tid & 3;
    const float sink = p.swa_sink[l * 8 + head];
    float mrun[4], lrun[4]; f32x4 O[4][4];
#pragma unroll
    for (int qt = 0; qt < 4; ++qt) { mrun[qt] = sink; lrun[qt] = 1.f;
#pragma unroll
        for (int dv = 0; dv < 4; ++dv) O[qt][dv] = (f32x4){0.f, 0.f, 0.f, 0.f}; }
    for (int j = 0; j < nkb; ++j) {
        const int rel = SWA_REL(j);
        u32x4 kreg[2], vreg[2];
        { const int rowk0 = b * TPB + SWA_BLK(j) * 128; const bf16_t* kp = P + (size_t)(rowk0 + skey) * NP + PC_SK + kvh * 64 + sg * 8;
          kreg[0] = *(const u32x4*)kp; kreg[1] = *(const u32x4*)(kp + 32);
#pragma unroll
          for (int it = 0; it < 2; ++it) { const int idx = tid + NTHR * it; vreg[it] = *(const u32x4*)(P + (size_t)(rowk0 + (idx >> 3)) * NP + PC_SV + kvh * 64 + (idx & 7) * 8); } }
        *(LAS u32x4*)(Ks + skey * KST + sg * 8) = kreg[0]; *(LAS u32x4*)(Ks + skey * KST + 32 + sg * 8) = kreg[1];
#pragma unroll
        for (int it = 0; it < 2; ++it) { const int idx = tid + NTHR * it; const int vk = idx >> 3, vg = idx & 7;
#pragma unroll
            for (int e = 0; e < 4; ++e) { Vt[(vg * 8 + 2 * e) * VST + vk] = (bf16_t)(vreg[it][e] & 0xffffu); Vt[(vg * 8 + 2 * e + 1) * VST + vk] = (bf16_t)(vreg[it][e] >> 16); } }
        __syncthreads();
#pragma unroll
        for (int qp2 = 0; qp2 < 2; ++qp2) {
            f32x4 Sx[2][8];
#pragma unroll
            for (int kt = 0; kt < 8; ++kt) { Sx[0][kt] = (f32x4){0.f, 0.f, 0.f, 0.f}; Sx[1][kt] = (f32x4){0.f, 0.f, 0.f, 0.f};
#pragma unroll
                for (int kk = 0; kk < 2; ++kk) { const bf16x8 A = *(const LAS bf16x8*)(Ks + (kt * 16 + fr) * KST + kk * 32 + fq * 8);
                    Sx[0][kt] = __builtin_amdgcn_mfma_f32_16x16x32_bf16(A, qf[2 * qp2][kk], Sx[0][kt], 0, 0, 0);
                    Sx[1][kt] = __builtin_amdgcn_mfma_f32_16x16x32_bf16(A, qf[2 * qp2 + 1][kk], Sx[1][kt], 0, 0, 0); } }
#pragma unroll
            for (int u = 0; u < 2; ++u) { const int qt = 2 * qp2 + u;
                if (rel != 0) { int qi = qhalf * 64 + qt * 16 + fr; asm volatile("" : "+v"(qi));
#pragma unroll
                    for (int kt = 0; kt < 8; ++kt)
#pragma unroll
                        for (int jx = 0; jx < 4; ++jx) { const int kx = kt * 16 + fq * 4 + jx; const bool ok = rel < 0 ? (kx >= qi) : (kx <= qi); if (!ok) Sx[u][kt][jx] = -1e30f; } }
                float mx = -1e30f;
#pragma unroll
                for (int kt = 0; kt < 8; ++kt) mx = fmaxf(mx, fmaxf(fmaxf(Sx[u][kt][0], Sx[u][kt][1]), fmaxf(Sx[u][kt][2], Sx[u][kt][3])));
                mx = xrow16_max(mx);
                const float mnew = fmaxf(mrun[qt], mx); const float alpha = __expf(mrun[qt] - mnew); mrun[qt] = mnew;
                float rsum = 0.f;
#pragma unroll
                for (int kt = 0; kt < 8; ++kt)
#pragma unroll
                    for (int jx = 0; jx < 4; ++jx) { const float e = __expf(Sx[u][kt][jx] - mnew); Sx[u][kt][jx] = e; rsum += e; }
                rsum = xrow16_sum(rsum);
                lrun[qt] = lrun[qt] * alpha + rsum;
#pragma unroll
                for (int dv = 0; dv < 4; ++dv) O[qt][dv] = O[qt][dv] * alpha; }
#pragma unroll
            for (int ks2 = 0; ks2 < 4; ++ks2) {
                bf16x8 Bp[2];
#pragma unroll
                for (int u = 0; u < 2; ++u) { u32x4 pb; pb[0] = pk2(Sx[u][2 * ks2][0], Sx[u][2 * ks2][1]); pb[1] = pk2(Sx[u][2 * ks2][2], Sx[u][2 * ks2][3]); pb[2] = pk2(Sx[u][2 * ks2 + 1][0], Sx[u][2 * ks2 + 1][1]); pb[3] = pk2(Sx[u][2 * ks2 + 1][2], Sx[u][2 * ks2 + 1][3]); Bp[u] = __builtin_bit_cast(bf16x8, pb); }
#pragma unroll
                for (int dv = 0; dv < 4; ++dv) { const LAS bf16_t* vp = Vt + (dv * 16 + fr) * VST + ks2 * 32 + fq * 4;
                    const u32x2 lo = *(const LAS u32x2*)vp, hi = *(const LAS u32x2*)(vp + 16);
                    u32x4 av; av[0] = lo[0]; av[1] = lo[1]; av[2] = hi[0]; av[3] = hi[1]; const bf16x8 Av = __builtin_bit_cast(bf16x8, av);
                    O[2 * qp2][dv] = __builtin_amdgcn_mfma_f32_16x16x32_bf16(Av, Bp[0], O[2 * qp2][dv], 0, 0, 0);
                    O[2 * qp2 + 1][dv] = __builtin_amdgcn_mfma_f32_16x16x32_bf16(Av, Bp[1], O[2 * qp2 + 1][dv], 0, 0, 0); }
            }
        }
        __syncthreads();
    }
#undef SWA_BLK
#undef SWA_REL
#pragma unroll
    for (int qt = 0; qt < 4; ++qt) { const float inv = 1.f / lrun[qt]; const int row = rowq0 + qt * 16 + fr;
#pragma unroll
        for (int dv = 0; dv < 4; ++dv) { u32x2 o2; o2[0] = pk2(O[qt][dv][0] * inv, O[qt][dv][1] * inv); o2[1] = pk2(O[qt][dv][2] * inv, O[qt][dv][3] * inv);
            *(u32x2*)(Y + (size_t)row * D + 256 + head * 64 + dv * 16 + fq * 4) = o2; } }
}

__device__ __forceinline__ void phase_mixers(const Params& p, int l, LAS unsigned char* lds, const int wvs) {
    for (int s = blockIdx.x; s < 256; s += gridDim.x) { if (s < 128) dn_seq(p, l, s, lds, wvs); else hg_seq(p, l, s - 128, lds, wvs); }
    unsigned* ctr = (unsigned*)(p.ws + WS_CTL) + 64 * (1 + l);
    LAS int* su = (LAS int*)(lds + 140 * 1024);
    for (;;) {
        __syncthreads();
        if (wvs == 0 && lane_id_fresh() == 0) su[0] = (int)atomicAdd(ctr, 1u);
        __syncthreads();
        const int unit = su[0];
        if (unit >= (l == DEPTH - 1 ? 512 : 576)) break;
        swa_unit(p, l, unit, lds, wvs);
    }
}

__device__ __forceinline__ void phase_finalize(const Params& p, int l, const int wvs) {
    const int tid = wvs * 64 + lane_id_fresh(); const int lane = tid & 63, w = tid >> 6;
    const int gw = blockIdx.x * NWAVES + w, NGW = gridDim.x * NWAVES;
    const bf16_t* P = (const bf16_t*)(p.ws + WS_P);
    const bf16_t* OD0 = (const bf16_t*)(p.ws + WS_OD); const bf16_t* OD1 = OD0 + (size_t)M * 512;
    bf16_t* Y = (bf16_t*)(p.ws + WS_HY);
    const int seg = lane >> 3, d0 = (lane & 7) * 8;
    const int hd = seg & 3; const bool isdn = seg < 4;
    const float* gain = (isdn ? p.dn_norm : p.hg_norm) + l * 64 + d0;
    const f32x4 g0 = *(const f32x4*)gain, g1 = *(const f32x4*)(gain + 4);
    const int ocol = (isdn ? 0 : 256) + hd * 64 + d0, gcol = (isdn ? PC_DNG : PC_HG) + hd * 64 + d0, ycol = (isdn ? 0 : 768) + hd * 64 + d0;
    for (int r = gw; r < M; r += NGW) {
        const u32x4 a = *(const u32x4*)(OD0 + (size_t)r * 512 + ocol), bq = *(const u32x4*)(OD1 + (size_t)r * 512 + ocol), gt = *(const u32x4*)(P + (size_t)r * NP + gcol);
        float o[8]; float ss = 0.f;
#pragma unroll
        for (int e = 0; e < 4; ++e) { o[2 * e] = bflo(a[e]) + bflo(bq[e]); o[2 * e + 1] = bfhi(a[e]) + bfhi(bq[e]); ss += o[2 * e] * o[2 * e] + o[2 * e + 1] * o[2 * e + 1]; }
        ss = sum8(ss);
        const float rms = rsqrtf(ss * (1.f / 64.f) + EPS);
        u32x4 y;
#pragma unroll
        for (int e = 0; e < 4; ++e) { const float ga = bflo(gt[e]), gb = bfhi(gt[e]);
            const float ge0 = e < 2 ? g0[2 * e] : g1[2 * e - 4], ge1 = e < 2 ? g0[2 * e + 1] : g1[2 * e - 3];
            y[e] = pk2(o[2 * e] * rms * ge0 * siluf(ga), o[2 * e + 1] * rms * ge1 * siluf(gb)); }
        *(u32x4*)(Y + (size_t)r * D + ycol) = y;
    }
}

__device__ __forceinline__ void phase_final(const Params& p, const int wvs) {
    const int tid = wvs * 64 + lane_id_fresh(); const int lane = tid & 63, w = tid >> 6;
    const int gw = blockIdx.x * NWAVES + w, NGW = gridDim.x * NWAVES;
    for (int r = gw; r < BATCH * SEQ; r += NGW) {
        f32x4* xr = (f32x4*)(p.out + ((size_t)r << 10)) + lane;
        f32x4 v[4]; float ss = 0.f;
#pragma unroll
        for (int j = 0; j < 4; ++j) { v[j] = xr[64 * j]; ss += (v[j][0] * v[j][0] + v[j][1] * v[j][1]) + (v[j][2] * v[j][2] + v[j][3] * v[j][3]); }
        const float rstd = rsqrtf(wave_sum(ss) * (1.f / D) + EPS);
#pragma unroll
        for (int j = 0; j < 4; ++j) { const f32x4 g = *(const f32x4*)(p.norm_f + 4 * (lane + 64 * j)); xr[64 * j] = v[j] * rstd * g; }
    }
}

#define XB_TMO      128
#define XB_XCNT(j)  (256  + 64 * (j))
#define XB_XSUB(j)  (1280 + 64 * (j))
#define XB_XGEN(j)  (2304 + 64 * (j))
#define XB_TOP      3328
#define XB_TOPGEN   3392
#define XCD_BAR_WORDS 3456
#define XB_SPIN_CAP (1u << 18)

__device__ __forceinline__ unsigned xb_ld(unsigned* p)              { return __hip_atomic_load(p, __ATOMIC_RELAXED, __HIP_MEMORY_SCOPE_AGENT); }
__device__ __forceinline__ unsigned xb_add(unsigned* p, unsigned v) { return __hip_atomic_fetch_add(p, v, __ATOMIC_RELAXED, __HIP_MEMORY_SCOPE_AGENT); }
__device__ __forceinline__ unsigned xb_xcc_id() { return (unsigned)__builtin_amdgcn_s_getreg((3 << 11) | 20) & 0xFu; }
#define XB_SPIN(cond, bar) do { unsigned _sp = 0; while (cond) { __builtin_amdgcn_s_sleep(1); \
    if ((++_sp & 255u) == 0u) { if (xb_ld(&(bar)[XB_TMO])) break; if (_sp > XB_SPIN_CAP) { atomicAdd(&(bar)[XB_TMO], 1u); break; } } } } while (0)

struct XcdBarrier {
    unsigned* bar; unsigned x;
    volatile LAS unsigned* st;
};

__device__ __forceinline__ XcdBarrier xcd_barrier_post(unsigned* bar, volatile LAS unsigned* st) {
    XcdBarrier b; b.bar = bar; b.x = xb_xcc_id(); b.st = st;
    if (threadIdx.x == 0) (void)xb_add(&bar[XB_XCNT(b.x)], 1u);
    return b;
}
__device__ __forceinline__ void xcd_barrier_complete(unsigned* bar, unsigned x, unsigned& nloc, unsigned& nx) {
    const unsigned G = gridDim.x * gridDim.y * gridDim.z;
    unsigned sum, cnt, mine, sp = 0u;
    for (;;) {
        sum = 0u; cnt = 0u; mine = 0u;
#pragma unroll
        for (unsigned j = 0; j < 16; ++j) { const unsigned c = xb_ld(&bar[XB_XCNT(j)]); sum += c; cnt += (c > 0u) ? 1u : 0u; mine = (j == x) ? c : mine; }
        if (sum == G) break;
        __builtin_amdgcn_s_sleep(1);
        if ((++sp & 255u) == 0u) { if (xb_ld(&bar[XB_TMO])) break; if (sp > XB_SPIN_CAP) { atomicAdd(&bar[XB_TMO], 1u); break; } }
    }
    nloc = mine > 0u ? mine : 1u; nx = cnt > 0u ? cnt : 1u;
}

__device__ __forceinline__ void xcd_barrier(const XcdBarrier& b, const int wvs) {
    asm volatile("s_waitcnt vmcnt(0)" ::: "memory");
    __syncthreads();
    if (wvs == 0 && lane_id_fresh() == 0) {
        unsigned* bar = b.bar;
        __builtin_amdgcn_s_waitcnt(0);
        unsigned nloc = b.st[0], nx = b.st[1];
        if (nloc == 0u) { xcd_barrier_complete(bar, b.x, nloc, nx); b.st[0] = nloc; b.st[1] = nx; }
        const unsigned old = xb_add(&bar[XB_XSUB(b.x)], 1u);
        const unsigned gen = old / nloc;
        if (old + 1u == (gen + 1u) * nloc) {
            __builtin_amdgcn_fence(__ATOMIC_RELEASE, "agent");
            asm volatile("s_waitcnt vmcnt(0)" ::: "memory");
            const unsigned og = xb_add(&bar[XB_TOP], 1u);
            const unsigned tg = og / nx;
            if (og + 1u == (tg + 1u) * nx) xb_add(&bar[XB_TOPGEN], 1u);
            else XB_SPIN(xb_ld(&bar[XB_TOPGEN]) == tg, bar);
            __builtin_amdgcn_fence(__ATOMIC_ACQUIRE, "agent");
            xb_add(&bar[XB_XGEN(b.x)], 1u);
            asm volatile("s_waitcnt vmcnt(0)" ::: "memory");
        } else {
            XB_SPIN(xb_ld(&bar[XB_XGEN(b.x)]) == gen, bar);
            __builtin_amdgcn_fence(__ATOMIC_ACQUIRE, "agent");
            asm volatile("s_waitcnt vmcnt(0)" ::: "memory");
        }
    }
    __syncthreads();
}

__device__ __forceinline__ void gsync(cg::grid_group& grid) {
    asm volatile("s_waitcnt vmcnt(0) lgkmcnt(0)" ::: "memory");
    grid.sync();
    __builtin_amdgcn_fence(__ATOMIC_ACQUIRE, "agent");
    asm volatile("s_waitcnt vmcnt(0)" ::: "memory");
}
__global__ void __launch_bounds__(NTHR, 2) fwd_megakernel(Params p) {
    extern __shared__ __attribute__((aligned(16))) unsigned char lds_raw[];
    LAS unsigned char* lds = (LAS unsigned char*)lds_raw;
    cg::grid_group grid = cg::this_grid();
    const int G = gridDim.x, c = blockIdx.x;
    const int wvs = __builtin_amdgcn_readfirstlane((int)(threadIdx.x >> 6));
    { volatile LAS unsigned* st0 = (volatile LAS unsigned*)(lds + 143360 + 64); if (threadIdx.x < 2) st0[threadIdx.x] = 0u; }
    __syncthreads();
    const XcdBarrier xbar = xcd_barrier_post((unsigned*)(p.ws + WS_CTL) + 4096, (volatile LAS unsigned*)(lds + 143360 + 64));
    phase_prologue(p, lds, wvs);
    if (p.ws == nullptr) gsync(grid);
    xcd_barrier(xbar, wvs);
    const float* mods = (const float*)(p.ws + WS_MODS);
    float* Xc = (float*)(p.ws + WS_XC);
    bf16_t* HY = (bf16_t*)(p.ws + WS_HY); bf16_t* PB = (bf16_t*)(p.ws + WS_P);
    for (int l = 0; l < DEPTH; ++l) {
        const int lastl = (l == DEPTH - 1) ? 1 : 0;
        phase_norm<true>(p, l, lds, wvs);
        xcd_barrier(xbar, wvs);
        { pg8::Gemm g{HY, (const bf16_t*)(p.ws + WS_WIN), M, NP, D, D}; pg8::StaticOrder S; S.init(M, NP, G, c); pg8::EpiBf16<0> E{PB, NP};
          pg8::gemm_phase<pg8::EpiBf16<0>, pg8::StaticOrder, true, true>(lds, g, S, E, wvs); }
        xcd_barrier(xbar, wvs);
        phase_dnprep(p, l, lds, wvs);
        xcd_barrier(xbar, wvs);
        phase_mixers(p, l, lds, wvs);
        xcd_barrier(xbar, wvs);
        phase_finalize(p, l, wvs);
        xcd_barrier(xbar, wvs);
        { pg8::Gemm g{HY, (const bf16_t*)(p.ws + WS_WOUT), M, D, D, D}; pg8::Order2 S; S.init(D, G, c, 1); pg8::EpiRes E{p.out, Xc, mods + ((size_t)l * 17 * 6 + 2) * 1024, l == 0 ? p.x : (const float*)p.out, l == 0 ? p.ctx : (const float*)Xc};
          pg8::gemm_phase<pg8::EpiRes, pg8::Order2, true, true>(lds, g, S, E, wvs); }
        if (!lastl) { pg8::Gemm g{HY, (const bf16_t*)(p.ws + WS_WOUT), M, D, D / 4, D}; pg8::CtxSplitOrder S; S.init(G, c); pg8::EpiPart E{(float*)(p.ws + WS_QKV)};
          pg8::gemm_phase<pg8::EpiPart, pg8::CtxSplitOrder, false, true>(lds, g, S, E, wvs); }
        xcd_barrier(xbar, wvs);
        phase_norm<false>(p, l, lds, wvs);
        xcd_barrier(xbar, wvs);
        { pg8::Gemm g{HY, (const bf16_t*)(p.ws + WS_W1), M, DFF, D, D}; pg8::Order2 S; S.init(DFF, G, c, lastl); pg8::EpiBf16<1> E{PB, DFF};
          pg8::gemm_phase<pg8::EpiBf16<1>, pg8::Order2, true, true>(lds, g, S, E, wvs); }
        xcd_barrier(xbar, wvs);
        { pg8::Gemm g{PB, (const bf16_t*)(p.ws + WS_W2), M, D, DFF, DFF}; pg8::Order2 S; S.init(D, G, c, 1); pg8::EpiRes E{p.out, Xc, mods + ((size_t)l * 17 * 6 + 5) * 1024, (const float*)p.out, (const float*)Xc};
          pg8::gemm_phase<pg8::EpiRes, pg8::Order2, true, true>(lds, g, S, E, wvs); }
        if (!lastl) { pg8::Gemm g{PB, (const bf16_t*)(p.ws + WS_W2), M, D, DFF / 4, DFF}; pg8::CtxSplitOrder S; S.init(G, c); pg8::EpiPart E{(float*)(p.ws + WS_QKV)};
          pg8::gemm_phase<pg8::EpiPart, pg8::CtxSplitOrder, false, true>(lds, g, S, E, wvs); }
        xcd_barrier(xbar, wvs);
    }
    phase_final(p, wvs);
}

extern "C" void kernel_launch(void* const* d_in, const int* in_sizes, int n_in, void* d_out, int out_size, void* d_ws, size_t ws_size, hipStream_t stream) {
    static int grid = 0;
    if (grid == 0) {
        if (n_in != 20 || ws_size < WS_END) { fprintf(stderr, "kernel_launch: need 20 inputs and >= %zu bytes of workspace (got %d, %zu)\n", (size_t)WS_END, n_in, ws_size); grid = -1; return; }
        int dev = 0, cus = 0, per_cu = 0;
        hipGetDevice(&dev); hipDeviceGetAttribute(&cus, hipDeviceAttributeMultiprocessorCount, dev);
        if (hipFuncSetAttribute((const void*)fwd_megakernel, hipFuncAttributeMaxDynamicSharedMemorySize, LDS_BYTES) != hipSuccess) { fprintf(stderr, "kernel_launch: hipFuncSetAttribute failed\n"); grid = -1; return; }
        if (hipOccupancyMaxActiveBlocksPerMultiprocessor(&per_cu, (const void*)fwd_megakernel, NTHR, LDS_BYTES) != hipSuccess || per_cu < 1) { fprintf(stderr, "kernel_launch: occupancy query says %d blocks/CU\n", per_cu); per_cu = 1; }
        (void)hipGetLastError();
        grid = cus;
    }
    if (grid < 0) return;
    hipMemsetAsync((char*)d_ws + WS_CTL, 0, 65536, stream);
    Params p{};
    const float** pp = (const float**)&p;
    for (int i = 0; i < 20; ++i) pp[i] = (const float*)d_in[i];
    p.out = (float*)d_out; p.ws = (unsigned char*)d_ws;
    void* args[] = {&p};
    hipError_t e = hipLaunchCooperativeKernel((const void*)fwd_megakernel, dim3(grid), dim3(NTHR), args, LDS_BYTES, stream);
    if (e != hipSuccess) fprintf(stderr, "cooperative launch failed: %s (grid %d)\n", hipGetErrorString(e), grid);
}
```

```cpp
#include <hip/hip_runtime.h>
#include <hip/hip_cooperative_groups.h>
#include <cstdio>
#include <cstdint>
namespace cg = cooperative_groups;

__device__ __forceinline__ int lane_id_fresh() { unsigned m = ~0u; asm volatile("" : "+s"(m)); return (int)__builtin_amdgcn_mbcnt_hi(m, __builtin_amdgcn_mbcnt_lo(m, 0u)); }
namespace pg8 {
#define PG8_LAS __attribute__((address_space(3)))
typedef unsigned short bf16_t;
typedef short bf16x8 __attribute__((ext_vector_type(8)));
typedef float f32x4 __attribute__((ext_vector_type(4)));
typedef unsigned u32x4 __attribute__((ext_vector_type(4)));
constexpr int BM = 256, BK = 64, HALF = 128, HTB = HALF * BK * 2  , STAGE_BYTES = 8 * HTB, NXCD = 8, WGM = 8;

__host__ __device__ __forceinline__ int lds_byte(int r, int c) { const int st = (r >> 4) * 2 + (c >> 5), rr = r & 15, cc = c & 31, ob = rr * 64 + cc * 2; return st * 1024 + (ob ^ (((ob >> 9) & 1) << 5)); }
__host__ __device__ __forceinline__ void stage_rc(int b, int& R, int& C) { const int st = b / 1024, sb = b % 1024, swz = sb ^ (((sb >> 9) & 1) << 5); R = (st >> 1) * 16 + swz / 64; C = (st & 1) * 32 + (swz % 64) / 2; }
__host__ __device__ __forceinline__ int perm32(int rho) { const int n = rho >> 4, i = rho & 15; return 8 * (i >> 2) + 4 * n + (i & 3); }

struct Unit { int pm, pn, ks; };
struct Gemm { const bf16_t* A; const bf16_t* Bt; int M, N, K, ldk; };

struct StaticOrder {
    int nM, nN, nwg, G, c;
    __host__ __device__ void init(int M, int N, int G_, int c_) { nM = M / BM; nN = N / BM; nwg = nM * nN; G = G_; c = c_; }
    __host__ __device__ bool next(int i, Unit& u) const {
        const long L = (long)i * G + c; if (L >= nwg) return false;
        int wgid = (int)L; { const int q = nwg / NXCD, r = nwg % NXCD, xcd = wgid % NXCD, off = wgid / NXCD; wgid = (xcd < r ? xcd * (q + 1) : r * (q + 1) + (xcd - r) * q) + off; }
        const int nig = WGM * nN, gid = wgid / nig, fm = gid * WGM, gsz = (nM - fm) < WGM ? (nM - fm) : WGM;
        u.pm = fm + ((wgid % nig) % gsz); u.pn = (wgid % nig) / gsz; u.ks = 0; return true;
    }
    __device__ __forceinline__ void a_ready(const Unit&) const {}
    __device__ __forceinline__ void done(const Unit&) const {}
};

struct Order2 {
    StaticOrder so; int lat;
    __host__ __device__ void init(int N, int G_, int c_, int lat_) { lat = lat_; so.init(lat_ ? 32768 : 36864, N, G_, c_); }
    __host__ __device__ bool next(int i, Unit& u) const { if (!so.next(i, u)) return false; if (lat) u.pm = (u.pm >> 3) * 9 + 1 + (u.pm & 7); return true; }
    __device__ __forceinline__ void a_ready(const Unit&) const {}
    __device__ __forceinline__ void done(const Unit&) const {}
};
struct CtxSplitOrder {
    int G, c;
    __host__ __device__ void init(int G_, int c_) { G = G_; c = c_; }
    __host__ __device__ bool next(int i, Unit& u) const { const long L = (long)i * G + c; if (L >= 256) return false; u.ks = (int)L & 3; u.pn = ((int)L >> 2) & 3; u.pm = ((int)L >> 4) * 9; return true; }
    __device__ __forceinline__ void a_ready(const Unit&) const {}
    __device__ __forceinline__ void done(const Unit&) const {}
};
typedef float f32x2c __attribute__((ext_vector_type(2)));
typedef __bf16 bf16x2c __attribute__((ext_vector_type(2)));
__device__ __forceinline__ unsigned cvt_pk_bf16(float lo, float hi) { const f32x2c v = {lo, hi}; return __builtin_bit_cast(unsigned, __builtin_convertvector(v, bf16x2c)); }

template <int ACT  > struct EpiBf16 {
    static constexpr bool PERM = true, AFTER_DRAIN = false;
    bf16_t* O; int ldc;
    __device__ __forceinline__ void operator()(const f32x4 (&acc)[2][2][4][2], const Unit& u, int wr, int wc, int fr, int fq) const {
        const int row0 = u.pm * BM + wr * 64 + fr; const int col0 = u.pn * BM + wc * 32 + 8 * fq;
#pragma unroll
        for (int ai = 0; ai < 2; ++ai)
#pragma unroll
            for (int m = 0; m < 4; ++m) { bf16_t* rowp = O + (size_t)(row0 + ai * HALF + m * 16) * ldc + col0;
#pragma unroll
                for (int bj = 0; bj < 2; ++bj) { f32x4 v0 = acc[ai][bj][m][0], v1 = acc[ai][bj][m][1];
                    if (ACT == 1) {
#pragma unroll
                        for (int e = 0; e < 4; ++e) { float a = fmaxf(v0[e], 0.f), b = fmaxf(v1[e], 0.f); v0[e] = a * a; v1[e] = b * b; } }
                    u32x4 w; w.x = cvt_pk_bf16(v0[0], v0[1]); w.y = cvt_pk_bf16(v0[2], v0[3]); w.z = cvt_pk_bf16(v1[0], v1[1]); w.w = cvt_pk_bf16(v1[2], v1[3]);
                    *(u32x4*)(rowp + bj * HALF) = w; } }
    }
};
struct EpiRes {
    static constexpr bool PERM = false, AFTER_DRAIN = false;
    float* Xl; float* Xc; const float* gates;
    const float* Xl_in; const float* Xc_in;
    __device__ __forceinline__ void operator()(const f32x4 (&acc)[2][2][4][2], const Unit& u, int wr, int wc, int fr, int fq) const {
        const int b = u.pm / 9, tt = u.pm - b * 9;
        const size_t toff = (tt == 0) ? ((size_t)(b * 256) << 10) : ((size_t)(b * 2048 + (tt - 1) * 256) << 10);
        float* base = ((tt == 0) ? Xc : Xl) + toff; const float* base_in = ((tt == 0) ? Xc_in : Xl_in) + toff;
        const float* g = gates + (size_t)((tt == 0) ? 16 : b) * 6144;
        const int col0 = u.pn * BM + wc * 32 + 4 * fq;
        float* rp0 = base + ((size_t)(wr * 64 + fr) << 10) + col0; const float* rq0 = base_in + ((size_t)(wr * 64 + fr) << 10) + col0;
#pragma unroll
        for (int bj = 0; bj < 2; ++bj)
#pragma unroll
            for (int n = 0; n < 2; ++n) { const f32x4 gvv = *(const f32x4*)(g + col0 + bj * HALF + n * 16);
#pragma unroll
                for (int ai = 0; ai < 2; ++ai) {
#pragma unroll
                    for (int m = 0; m < 4; ++m) { const size_t eo = (size_t)(ai * HALF + m * 16) * 1024 + bj * HALF + n * 16; f32x4 xv = *(const f32x4*)(rq0 + eo); xv = xv + gvv * acc[ai][bj][m][n]; *(f32x4*)(rp0 + eo) = xv; }
                    asm volatile("" ::: "memory"); } }
    }
};
struct EpiPart {
    static constexpr bool PERM = false, AFTER_DRAIN = false;
    float* part;
    __device__ __forceinline__ void operator()(const f32x4 (&acc)[2][2][4][2], const Unit& u, int wr, int wc, int fr, int fq) const {
        float* rp0 = part + (((size_t)u.ks * 4096 + (size_t)(u.pm / 9) * 256 + wr * 64 + fr) << 10) + u.pn * BM + wc * 32 + 4 * fq;
#pragma unroll
        for (int ai = 0; ai < 2; ++ai)
#pragma unroll
            for (int m = 0; m < 4; ++m)
#pragma unroll
                for (int bj = 0; bj < 2; ++bj)
#pragma unroll
                    for (int n = 0; n < 2; ++n) *(f32x4*)(rp0 + (size_t)(ai * HALF + m * 16) * 1024 + bj * HALF + n * 16) = acc[ai][bj][m][n];
    }
};
template <class Epi, class Sched, bool ALIGN_EPI = false, bool SP2 = false>
__device__ __forceinline__ void gemm_phase(PG8_LAS unsigned char* lds, const Gemm g, const Sched& S, const Epi& E, const int wvs) {
    const int tid = wvs * 64 + lane_id_fresh(); const int wid = __builtin_amdgcn_readfirstlane(tid >> 6), lane = tid & 63, wr = wid >> 2, wc = wid & 3, fr = lane & 15, fq = lane >> 4;
    const int K = g.ldk, nt = g.K / BK; const size_t sstep = (size_t)g.K * 2;
    unsigned voffA[2], voffB[2];
#pragma unroll
    for (int i = 0; i < 2; ++i) { int R, C; stage_rc(tid * 16 + i * 8192, R, C); const int Rb = Epi::PERM ? ((R & ~31) + perm32(R & 31)) : R;
        voffA[i] = (unsigned)(R * K + C) * 2u; voffB[i] = (unsigned)(Rb * K + C) * 2u; }
    const size_t kstep = (size_t)(BK * 2);
    const size_t hstep = (size_t)HALF * K * 2;
    const size_t tstep = 2 * hstep;
    const unsigned ldsw = (unsigned)wid * 1024u;
    const int aoff = lds_byte(wr * 64 + fr, fq * 8), boff = lds_byte(wc * 32 + fr, fq * 8);
#define PG8_SA(b, h) (((b) * 2 + (h)) * HTB)
#define PG8_SB(b, h) ((4 + (b) * 2 + (h)) * HTB)
#define PG8_STAGE(bufoff, gbase, voff) do { _Pragma("unroll") for (int _i = 0; _i < 2; ++_i) \
        __builtin_amdgcn_global_load_lds((const unsigned*)((const char*)(gbase) + (voff)[_i]), (PG8_LAS unsigned*)(lds + (bufoff) + ldsw + _i * 8192), 16, 0, 0); } while (0)
#define PG8_LDA(dst, b, h) do { _Pragma("unroll") for (int m = 0; m < 4; ++m) _Pragma("unroll") for (int k = 0; k < 2; ++k) dst[m][k] = *(const PG8_LAS bf16x8*)(lds + PG8_SA(b, h) + aoff + m * 2048 + k * 1024); } while (0)
#define PG8_LDB(dst, b, h) do { _Pragma("unroll") for (int n = 0; n < 2; ++n) _Pragma("unroll") for (int k = 0; k < 2; ++k) dst[n][k] = *(const PG8_LAS bf16x8*)(lds + PG8_SB(b, h) + boff + n * 2048 + k * 1024); } while (0)
#define PG8_MMA(ai, bj, At, Bt) do { __builtin_amdgcn_s_setprio(1); _Pragma("unroll") for (int m = 0; m < 4; ++m) _Pragma("unroll") for (int n = 0; n < 2; ++n) _Pragma("unroll") for (int k = 0; k < 2; ++k) \
        acc[ai][bj][m][n] = __builtin_amdgcn_mfma_f32_16x16x32_bf16(Bt[n][k], At[m][k], acc[ai][bj][m][n], 0, 0, 0); __builtin_amdgcn_s_setprio(0); } while (0)
#define PG8_WAIT_V(n) asm volatile("s_waitcnt vmcnt(" #n ")" ::: "memory")
#define PG8_WAIT_L(n) asm volatile("s_waitcnt lgkmcnt(" #n ")" ::: "memory")
#define PG8_BAR __builtin_amdgcn_s_barrier()
#define PG8_SCHED __builtin_amdgcn_sched_barrier(0)
    Unit cur, nxt; int ui = 0;
    if (!S.next(0, cur)) return;
    f32x4 acc[2][2][4][2];
#pragma unroll
    for (int a = 0; a < 2; ++a)
#pragma unroll
        for (int b = 0; b < 2; ++b)
#pragma unroll
            for (int m = 0; m < 4; ++m)
#pragma unroll
                for (int n = 0; n < 2; ++n) acc[a][b][m][n] = (f32x4){0.f, 0.f, 0.f, 0.f};
    bf16x8 At[4][2], B0[2][2], B1[2][2];
    const char* cA = (const char*)g.A + (size_t)cur.pm * tstep + (size_t)cur.ks * sstep; const char* cB = (const char*)g.Bt + (size_t)cur.pn * tstep + (size_t)cur.ks * sstep;
    S.a_ready(cur);
    if constexpr (SP2) {
        PG8_STAGE(PG8_SB(0, 0), cB, voffB); PG8_STAGE(PG8_SB(0, 1), cB + hstep, voffB); PG8_STAGE(PG8_SA(0, 0), cA, voffA); PG8_STAGE(PG8_SA(0, 1), cA + hstep, voffA);
        if (wr == 1) PG8_BAR;
        PG8_WAIT_V(2); PG8_BAR;
        PG8_STAGE(PG8_SB(1, 0), cB + kstep, voffB); PG8_STAGE(PG8_SA(1, 0), cA + kstep, voffA); PG8_STAGE(PG8_SB(1, 1), cB + hstep + kstep, voffB);
        PG8_WAIT_V(6); PG8_BAR;
    } else {
        PG8_STAGE(PG8_SB(0, 0), cB, voffB); PG8_STAGE(PG8_SA(0, 0), cA, voffA); PG8_STAGE(PG8_SB(0, 1), cB + hstep, voffB); PG8_STAGE(PG8_SA(0, 1), cA + hstep, voffA);
        if (wr == 1) PG8_BAR;
        PG8_WAIT_V(4); PG8_BAR;
        PG8_STAGE(PG8_SB(1, 0), cB + kstep, voffB); PG8_STAGE(PG8_SA(1, 0), cA + kstep, voffA); PG8_STAGE(PG8_SB(1, 1), cB + hstep + kstep, voffB);
        PG8_WAIT_V(6); PG8_BAR;
    }
    for (;;) {
        const bool has_next = S.next(ui + 1, nxt);
        const char* nA = has_next ? (const char*)g.A + (size_t)nxt.pm * tstep + (size_t)nxt.ks * sstep : cA; const char* nB = has_next ? (const char*)g.Bt + (size_t)nxt.pn * tstep + (size_t)nxt.ks * sstep : cB;
        for (int t = 0; t < nt; t += 2) {
            const bool last = (t == nt - 2);
            const char* a1 = cA + (size_t)(t + 1) * kstep;
            const char* a2 = last ? nA : cA + (size_t)(t + 2) * kstep; const char* b2 = last ? nB : cB + (size_t)(t + 2) * kstep;
            const char* a3 = a2 + kstep; const char* b3 = b2 + kstep;
            if (last && has_next) S.a_ready(nxt);
            if constexpr (SP2) {
            PG8_LDB(B0, 0, 0); PG8_LDB(B1, 0, 1); PG8_SCHED; PG8_LDA(At, 0, 0); PG8_STAGE(PG8_SA(1, 1), a1 + hstep, voffA);
            PG8_WAIT_V(8); PG8_WAIT_L(0); PG8_BAR; PG8_MMA(0, 0, At, B0); PG8_MMA(0, 1, At, B1); PG8_BAR; PG8_SCHED;
            PG8_LDA(At, 0, 1); PG8_STAGE(PG8_SB(0, 0), b2, voffB); PG8_STAGE(PG8_SB(0, 1), b2 + hstep, voffB); PG8_STAGE(PG8_SA(0, 0), a2, voffA);
            PG8_WAIT_V(8); PG8_WAIT_L(0); PG8_BAR; PG8_MMA(1, 0, At, B0); PG8_MMA(1, 1, At, B1); PG8_BAR; PG8_SCHED;
            PG8_LDB(B0, 1, 0); PG8_LDB(B1, 1, 1); PG8_SCHED; PG8_LDA(At, 1, 0); PG8_STAGE(PG8_SA(0, 1), a2 + hstep, voffA);
            PG8_WAIT_V(8); PG8_WAIT_L(0); PG8_BAR; PG8_MMA(0, 0, At, B0); PG8_MMA(0, 1, At, B1); PG8_BAR; PG8_SCHED;
            PG8_LDA(At, 1, 1); PG8_STAGE(PG8_SB(1, 0), b3, voffB); PG8_STAGE(PG8_SB(1, 1), b3 + hstep, voffB); PG8_STAGE(PG8_SA(1, 0), a3, voffA);
            PG8_WAIT_V(8); PG8_WAIT_L(0); PG8_BAR; PG8_MMA(1, 0, At, B0); PG8_MMA(1, 1, At, B1); PG8_BAR; PG8_SCHED;
            } else {
            PG8_LDB(B0, 0, 0); PG8_SCHED; PG8_LDA(At, 0, 0); PG8_STAGE(PG8_SA(1, 1), a1 + hstep, voffA);
            PG8_WAIT_L(8); PG8_BAR; PG8_WAIT_L(0); PG8_MMA(0, 0, At, B0); PG8_BAR; PG8_SCHED;
            PG8_LDB(B1, 0, 1); PG8_STAGE(PG8_SB(0, 0), b2, voffB);
            PG8_BAR; PG8_WAIT_L(0); PG8_MMA(0, 1, At, B1); PG8_BAR;
            PG8_LDA(At, 0, 1); PG8_STAGE(PG8_SA(0, 0), a2, voffA);
            PG8_BAR; PG8_WAIT_L(0); PG8_MMA(1, 0, At, B0); PG8_BAR; PG8_SCHED;
            PG8_STAGE(PG8_SB(0, 1), b2 + hstep, voffB);
            PG8_WAIT_V(6); PG8_BAR; PG8_MMA(1, 1, At, B1); PG8_BAR;
            PG8_LDB(B0, 1, 0); PG8_SCHED; PG8_LDA(At, 1, 0); PG8_STAGE(PG8_SA(0, 1), a2 + hstep, voffA);
            PG8_WAIT_L(8); PG8_BAR; PG8_WAIT_L(0); PG8_MMA(0, 0, At, B0); PG8_BAR; PG8_SCHED;
            PG8_LDB(B1, 1, 1); PG8_STAGE(PG8_SB(1, 0), b3, voffB);
            PG8_BAR; PG8_WAIT_L(0); PG8_MMA(0, 1, At, B1); PG8_BAR;
            PG8_LDA(At, 1, 1); PG8_STAGE(PG8_SA(1, 0), a3, voffA);
            PG8_BAR; PG8_WAIT_L(0); PG8_MMA(1, 0, At, B0); PG8_BAR; PG8_SCHED;
            PG8_STAGE(PG8_SB(1, 1), b3 + hstep, voffB);
            PG8_WAIT_V(6); PG8_BAR; PG8_MMA(1, 1, At, B1); PG8_BAR;
            }
        }
        if constexpr (ALIGN_EPI) { if (wr == 0) PG8_BAR; }
        if constexpr (!Epi::AFTER_DRAIN) { E(acc, cur, wr, wc, fr, fq); S.done(cur); }
        if (!has_next) break;
#pragma unroll
        for (int a = 0; a < 2; ++a)
#pragma unroll
            for (int b = 0; b < 2; ++b)
#pragma unroll
                for (int m = 0; m < 4; ++m)
#pragma unroll
                    for (int n = 0; n < 2; ++n) acc[a][b][m][n] = (f32x4){0.f, 0.f, 0.f, 0.f};
        cur = nxt; cA = nA; cB = nB; ++ui;
        if constexpr (ALIGN_EPI) { if (wr == 1) PG8_BAR; }
    }
    PG8_WAIT_V(0);
    if constexpr (!ALIGN_EPI) { if (wr == 0) PG8_BAR; }
    PG8_BAR;
    if constexpr (Epi::AFTER_DRAIN) { E.fused(acc, cur, wr, wc, fr, fq, lds, wid, lane); S.done(cur); }
#undef PG8_SA
#undef PG8_SB
#undef PG8_STAGE
#undef PG8_LDA
#undef PG8_LDB
#undef PG8_MMA
#undef PG8_WAIT_V
#undef PG8_WAIT_L
#undef PG8_BAR
#undef PG8_SCHED
}
}

constexpr int D = 1024, BATCH = 16, SEQ = 2048, CTX = 256, DEPTH = 4;
constexpr int TPB = CTX + SEQ;
constexpr int M = BATCH * TPB;
constexpr int DIN = 3088, NP = 3072, DFF = 4096;
constexpr int PC_DNQ = 0, PC_DNG = 768, PC_SQ = 1024, PC_SK = 1536, PC_SV = 1664, PC_HQ = 1792, PC_HF = 2048, PC_HI = 2560, PC_HG = 2816;
constexpr float EPS = 1e-6f;
constexpr size_t MiB = 1u << 20;
constexpr size_t WS_CTL = 0, WS_MODS = 1 * MiB, WS_ROPE = 3 * MiB, WS_LB = 3 * MiB + 512 * 1024, WS_AB = 4 * MiB;
constexpr size_t WS_WIN = 7 * MiB, WS_WOUT = 13 * MiB, WS_W1 = 15 * MiB, WS_W2 = 23 * MiB, WS_XC = 32 * MiB, WS_HY = 48 * MiB, WS_P = 120 * MiB;
constexpr size_t WS_OD = WS_P + 216 * MiB, WS_QKV = WS_P + 288 * MiB, WS_END = WS_QKV + 64 * MiB;
constexpr int LDS_BYTES = 147456;
constexpr int NWAVES = 8, NTHR = 512;

#define LAS __attribute__((address_space(3)))
typedef unsigned short bf16_t;
typedef float f32x4 __attribute__((ext_vector_type(4)));
typedef short bf16x8 __attribute__((ext_vector_type(8)));
typedef short s16x4 __attribute__((ext_vector_type(4)));
typedef unsigned u32x4 __attribute__((ext_vector_type(4)));
typedef unsigned u32x2 __attribute__((ext_vector_type(2)));

struct Params {
    const float *x, *c, *ctx, *c_ctx, *w_ada, *b_ada, *norm1, *norm2, *w_in, *dn_conv, *dn_A_log, *dn_dt_bias, *dn_norm, *swa_sink, *hg_lb, *hg_norm, *w_out, *w_ff1, *w_ff2, *norm_f;
    float* out; unsigned char* ws;
};

__device__ __forceinline__ float bflo(unsigned u) { return __uint_as_float(u << 16); }
__device__ __forceinline__ float bfhi(unsigned u) { return __uint_as_float(u & 0xffff0000u); }
__device__ __forceinline__ unsigned pk2(float lo, float hi) { return pg8::cvt_pk_bf16(lo, hi); }
__device__ __forceinline__ bf16_t bf1(float f) { return __builtin_bit_cast(bf16_t, (__bf16)f); }
__device__ __forceinline__ float siluf(float v) { return v / (1.f + __expf(-v)); }
__device__ __forceinline__ float sigmf(float v) { return 1.f / (1.f + __expf(-v)); }
__device__ __forceinline__ float bperm(float v, int srclane) { return __builtin_bit_cast(float, __builtin_amdgcn_ds_bpermute(srclane << 2, __builtin_bit_cast(int, v))); }
__device__ __forceinline__ float wave_sum(float v) {
    const int ln = lane_id_fresh();
#pragma unroll
    for (int o = 1; o < 64; o <<= 1) v += bperm(v, ln ^ o);
    return v;
}
template <int CTRL> __device__ __forceinline__ float dpp(float x) { return __builtin_bit_cast(float, __builtin_amdgcn_mov_dpp(__builtin_bit_cast(int, x), CTRL, 0xf, 0xf, true)); }
constexpr int XOR1 = 0xB1, XOR2 = 0x4E, XOR7 = 0x141;
__device__ __forceinline__ float sum8(float v) { v += dpp<XOR1>(v); v += dpp<XOR2>(v); v += dpp<XOR7>(v); return v; }
__device__ __forceinline__ float xrow16_max(float x) {
    auto s = __builtin_amdgcn_permlane16_swap(__float_as_uint(x), __float_as_uint(x), false, false);
    x = fmaxf(__uint_as_float(s[0]), __uint_as_float(s[1]));
    auto t = __builtin_amdgcn_permlane32_swap(__float_as_uint(x), __float_as_uint(x), false, false);
    return fmaxf(__uint_as_float(t[0]), __uint_as_float(t[1]));
}
__device__ __forceinline__ float xrow16_sum(float x) {
    auto s = __builtin_amdgcn_permlane16_swap(__float_as_uint(x), __float_as_uint(x), false, false);
    x = __uint_as_float(s[0]) + __uint_as_float(s[1]);
    auto t = __builtin_amdgcn_permlane32_swap(__float_as_uint(x), __float_as_uint(x), false, false);
    return __uint_as_float(t[0]) + __uint_as_float(t[1]);
}
__device__ __forceinline__ const float* xrow_c(const float* Xl, const float* Xc, int r) { const int b = r / TPB, t = r - b * TPB; return t < CTX ? Xc + ((size_t)(b * CTX + t) << 10) : Xl + ((size_t)(b * SEQ + t - CTX) << 10); }
__device__ __forceinline__ int cidx(int r) { const int b = r / TPB, t = r - b * TPB; return t < CTX ? 16 : b; }

__device__ __forceinline__ void phase_prologue(const Params& p, LAS unsigned char* lds, const int wvs) {
    const int tid = wvs * 64 + lane_id_fresh(); const int lane = tid & 63, w = tid >> 6;
    float* mods = (float*)(p.ws + WS_MODS);
    LAS float* sc = (LAS float*)lds;
    LAS float* red = (LAS float*)(lds + 81920);
    for (int idx = tid; idx < 17 * 1024; idx += NTHR) { const int ci = idx >> 10, k = idx & 1023; const float v = ci < 16 ? p.c[ci * 1024 + k] : p.c_ctx[k]; sc[k * 20 + ci] = v / (1.f + expf(-v)); }
    __syncthreads();
    for (int it = blockIdx.x; it < DEPTH * 96; it += gridDim.x) {
        const int l = it / 96, cgp = it - l * 96, col = cgp * 64 + lane;
        float acc[17];
#pragma unroll
        for (int i = 0; i < 17; ++i) acc[i] = 0.f;
        const float* wp = p.w_ada + ((size_t)l * 1024 + w * 128) * 6144 + col;
#pragma unroll 16
        for (int kk = 0; kk < 128; ++kk) {
            const float wv = wp[(size_t)kk * 6144];
            const LAS f32x4* s4 = (const LAS f32x4*)(sc + (w * 128 + kk) * 20);
            const f32x4 s0 = s4[0], s1 = s4[1], s2 = s4[2], s3 = s4[3]; const float s16 = sc[(w * 128 + kk) * 20 + 16];
#pragma unroll
            for (int e = 0; e < 4; ++e) { acc[e] += wv * s0[e]; acc[4 + e] += wv * s1[e]; acc[8 + e] += wv * s2[e]; acc[12 + e] += wv * s3[e]; }
            acc[16] += wv * s16;
        }
#pragma unroll
        for (int i = 0; i < 17; ++i) red[(w * 17 + i) * 64 + lane] = acc[i];
        __syncthreads();
        for (int idx = tid; idx < 17 * 64; idx += NTHR) { const int i = idx >> 6, cl = idx & 63; float s = 0.f;
#pragma unroll
            for (int ww = 0; ww < 8; ++ww) s += red[(ww * 17 + i) * 64 + cl];
            mods[((size_t)l * 17 + i) * 6144 + cgp * 64 + cl] = s + p.b_ada[l * 6144 + cgp * 64 + cl]; }
        __syncthreads();
    }
    const int gt = blockIdx.x * NTHR + tid, GT = gridDim.x * NTHR;
    { float* rc = (float*)(p.ws + WS_ROPE); float* rs = rc + 2048 * 32;
      for (int idx = gt; idx < 2048 * 32; idx += GT) { const int t = idx >> 5, d = idx & 31; const float pos = (float)(d < 16 ? (t >> 6) : (t & 63));
          const float inv = expf(-(float)(d & 15) * (9.210340371976184f / 16.f)); const float ang = pos * inv; rc[idx] = cosf(ang); rs[idx] = sinf(ang); } }
    { float* LB = (float*)(p.ws + WS_LB);
      for (int idx = gt; idx < 2 * 256; idx += GT) { const int d = idx >> 8, cc = idx & 255; float v[DEPTH]; float mx = -1e30f;
#pragma unroll
          for (int l = 0; l < DEPTH; ++l) { v[l] = p.hg_lb[(d * DEPTH + l) * 256 + cc]; mx = fmaxf(mx, v[l]); }
          float s = 0.f;
#pragma unroll
          for (int l = 0; l < DEPTH; ++l) { v[l] = expf(v[l] - mx); s += v[l]; }
          float cum = 0.f;
#pragma unroll
          for (int l = 0; l < DEPTH; ++l) { if (l > 0) cum += v[l] / s; LB[(d * DEPTH + l) * 256 + cc] = cum; } } }
}

__device__ __forceinline__ void transpose_item(const float* W, int K, int ldw, int scol0, bf16_t* WT, int n0, int k0, LAS float* scr, int lane) {
#pragma unroll 8
    for (int i = 0; i < 32; ++i) { const int kk = 2 * i + (lane >> 5); scr[kk * 33 + (lane & 31)] = W[(size_t)(k0 + kk) * ldw + scol0 + (lane & 31)]; }
    asm volatile("s_waitcnt lgkmcnt(0)" ::: "memory");
    const int c = lane & 7;
#pragma unroll
    for (int j = 0; j < 4; ++j) { const int n = (lane >> 3) + 8 * j; const LAS float* s = scr + (8 * c) * 33 + n;
        u32x4 o; o.x = pk2(s[0 * 33], s[1 * 33]); o.y = pk2(s[2 * 33], s[3 * 33]); o.z = pk2(s[4 * 33], s[5 * 33]); o.w = pk2(s[6 * 33], s[7 * 33]);
        *(u32x4*)(WT + (size_t)(n0 + n) * K + k0 + 8 * c) = o; }
    asm volatile("s_waitcnt lgkmcnt(0)" ::: "memory");
}

template <bool FIRST> __device__ __forceinline__ void phase_norm(const Params& p, int l, LAS unsigned char* lds, const int wvs) {
    const int tid = wvs * 64 + lane_id_fresh(); const int lane = tid & 63, w = tid >> 6;
    const int gw = blockIdx.x * NWAVES + w, NGW = gridDim.x * NWAVES;
    const float* mods = (const float*)(p.ws + WS_MODS);
    constexpr int WST = 1032;
    LAS bf16_t* wab = (LAS bf16_t*)lds;
    if (FIRST) {
        LAS float* scr = (LAS float*)(lds + 65536 + w * 8704);
        constexpr int I_IN = 16 * 96, I_OUT = 16 * 32, I_1 = 16 * 128, I_2 = 64 * 32;
        for (int it = gw; it < I_IN + I_OUT + I_1 + I_2; it += NGW) {
            int r = it;
            if (r < I_IN) { const int kb = r / 96, nb = r - kb * 96; const int n0 = nb * 32; transpose_item(p.w_in + (size_t)l * D * DIN, D, DIN, n0 + (n0 >= 1024 ? 16 : 0), (bf16_t*)(p.ws + WS_WIN), n0, kb * 64, scr, lane); continue; }
            r -= I_IN;
            if (r < I_OUT) { const int kb = r / 32, nb = r - kb * 32; transpose_item(p.w_out + (size_t)l * D * D, D, D, nb * 32, (bf16_t*)(p.ws + WS_WOUT), nb * 32, kb * 64, scr, lane); continue; }
            r -= I_OUT;
            if (r < I_1) { const int kb = r / 128, nb = r - kb * 128; transpose_item(p.w_ff1 + (size_t)l * D * DFF, D, DFF, nb * 32, (bf16_t*)(p.ws + WS_W1), nb * 32, kb * 64, scr, lane); continue; }
            r -= I_1;
            { const int kb = r / 32, nb = r - kb * 32; transpose_item(p.w_ff2 + (size_t)l * DFF * D, DFF, D, nb * 32, (bf16_t*)(p.ws + WS_W2), nb * 32, kb * 64, scr, lane); }
        }
        const float* wi = p.w_in + (size_t)l * D * DIN + 1024;
        for (int idx = tid; idx < 4096; idx += NTHR) { const int k = idx >> 2, j4 = (idx & 3) * 4; const f32x4 v = *(const f32x4*)(wi + (size_t)k * DIN + j4);
#pragma unroll
            for (int e = 0; e < 4; ++e) wab[(j4 + e) * WST + k] = bf1(v[e]); }
        __syncthreads();
    }
    const float* nw = (FIRST ? p.norm1 : p.norm2) + l * D;
    bf16_t* H = (bf16_t*)(p.ws + WS_HY);
    float* AB = (float*)(p.ws + WS_AB);
    float* Xc = (float*)(p.ws + WS_XC);
    const float* part = (const float*)(p.ws + WS_QKV);
    const bool fix = FIRST ? (l > 0) : (l < DEPTH - 1);
    const float* fgate = mods + ((size_t)(FIRST ? (l > 0 ? l - 1 : 0) : l) * 17 + 16) * 6144 + (FIRST ? 5 : 2) * 1024;
    f32x4 nwv[4];
#pragma unroll
    for (int j = 0; j < 4; ++j) nwv[j] = *(const f32x4*)(nw + 4 * (lane + 64 * j));
    int nrows = 0;
    for (int r = gw; r < M; r += NGW) {
        ++nrows;
        if (!FIRST && l == DEPTH - 1 && (r % TPB) < CTX) continue;
        const f32x4* xr = (const f32x4*)((FIRST && l == 0) ? xrow_c(p.x, p.ctx, r) : xrow_c(p.out, Xc, r)) + lane;
        f32x4 v[4]; float ss = 0.f;
        const int rb = r / TPB, rt = r - rb * TPB;
        const float* md = mods + ((size_t)l * 17 + (rt < CTX ? 16 : rb)) * 6144 + (FIRST ? 0 : 3 * 1024);
        f32x4 shv[4], slv[4];
#pragma unroll
        for (int j = 0; j < 4; ++j) { shv[j] = *(const f32x4*)(md + 4 * (lane + 64 * j)); slv[j] = *(const f32x4*)(md + 1024 + 4 * (lane + 64 * j)); }
        if (fix && rt < CTX) {
            const f32x4* xin = (const f32x4*)((!FIRST && l == 0) ? p.ctx + ((size_t)(rb * CTX + rt) << 10) : Xc + ((size_t)(rb * CTX + rt) << 10)) + lane;
            const f32x4* pr = (const f32x4*)(part + ((size_t)(rb * CTX + rt) << 10)) + lane; f32x4* xo = (f32x4*)(Xc + ((size_t)(rb * CTX + rt) << 10)) + lane;
#pragma unroll
            for (int j = 0; j < 4; ++j) { const f32x4 gq = *(const f32x4*)(fgate + 4 * (lane + 64 * j));
                const f32x4 s4 = (pr[64 * j] + pr[64 * j + 1048576]) + (pr[64 * j + 2 * 1048576] + pr[64 * j + 3 * 1048576]);
                v[j] = xin[64 * j] + gq * s4; xo[64 * j] = v[j]; }
        } else {
#pragma unroll
            for (int j = 0; j < 4; ++j) v[j] = xr[64 * j];
        }
#pragma unroll
        for (int j = 0; j < 4; ++j) ss += (v[j][0] * v[j][0] + v[j][1] * v[j][1]) + (v[j][2] * v[j][2] + v[j][3] * v[j][3]);
        __builtin_amdgcn_sched_barrier(0);
        const float rstd = rsqrtf(wave_sum(ss) * (1.f / D) + EPS);
        u32x2* hp = (u32x2*)(H + (size_t)r * D) + lane;
#pragma unroll
        for (int j = 0; j < 4; ++j) { const int k = 4 * (lane + 64 * j);
            const f32x4 g = nwv[j], sh = shv[j], sl = slv[j];
            f32x4 h;
#pragma unroll
            for (int e = 0; e < 4; ++e) h[e] = (v[j][e] * rstd * g[e]) * (1.f + sl[e]) + sh[e];
            u32x2 o2; o2.x = pk2(h[0], h[1]); o2.y = pk2(h[2], h[3]); hp[64 * j] = o2;
        }
    }
    if (FIRST) {
        asm volatile("s_waitcnt vmcnt(0)" ::: "memory");
        const int fr = lane & 15, fq = lane >> 4;
        for (int b0 = 0; b0 < nrows; b0 += 16) {
            const int kr = b0 + fr; const bool ok = kr < nrows; const bf16_t* hp = H + (size_t)(gw + (ok ? kr : 0) * NGW) * D + fq * 8;
            f32x4 c = (f32x4){0.f, 0.f, 0.f, 0.f};
#pragma unroll 8
            for (int ks = 0; ks < 32; ++ks) { u32x4 av = *(const u32x4*)(hp + ks * 32); if (!ok) av = (u32x4){0u, 0u, 0u, 0u};
                const bf16x8 bv = *(const LAS bf16x8*)(wab + fr * WST + ks * 32 + fq * 8);
                c = __builtin_amdgcn_mfma_f32_16x16x32_bf16(__builtin_bit_cast(bf16x8, av), bv, c, 0, 0, 0); }
#pragma unroll
            for (int j = 0; j < 4; ++j) { const int k2 = b0 + fq * 4 + j; if (k2 < nrows) AB[(size_t)(gw + k2 * NGW) * 16 + fr] = c[j]; }
        }
    }
}

constexpr int SST = 68;
constexpr int HST = 72;
__device__ __forceinline__ bf16x8 ldA_perm(const LAS bf16_t* base, int row, int s, int fq) {
    const LAS bf16_t* ap = base + row * HST + s * 32 + fq * 4; const u32x2 lo = *(const LAS u32x2*)ap, hi = *(const LAS u32x2*)(ap + 16);
    u32x4 av; av[0] = lo[0]; av[1] = lo[1]; av[2] = hi[0]; av[3] = hi[1]; return __builtin_bit_cast(bf16x8, av);
}
__device__ __forceinline__ bf16x8 packB(const f32x4& a, const f32x4& b) {
    u32x4 pb; pb[0] = pk2(a[0], a[1]); pb[1] = pk2(a[2], a[3]); pb[2] = pk2(b[0], b[1]); pb[3] = pk2(b[2], b[3]);
    return __builtin_bit_cast(bf16x8, pb);
}
__device__ __forceinline__ void phase_dnprep(const Params& p, int l, LAS unsigned char* lds, const int wvs) {
    const int tid = wvs * 64 + lane_id_fresh();
    constexpr int RST = 200;
    LAS float* qs = (LAS float*)lds; LAS float* ks = qs + 64 * SST; LAS float* vs = ks + 64 * SST; LAS bf16_t* RAW = (LAS bf16_t*)(vs + 64 * SST);
    const bf16_t* P = (const bf16_t*)(p.ws + WS_P);
    bf16_t* QKV = (bf16_t*)(p.ws + WS_QKV);
    const float* cw = p.dn_conv + (size_t)l * 5 * 768;
    const int c4 = tid % 48, tg = tid / 48;
    LAS float* cdst = ((c4 >> 4) == 0 ? qs : ((c4 >> 4) == 1 ? ks : vs)) + (c4 & 15) * 4;
#define PREP_LOADRAW(itx) do { const int h_ = (itx) & 3, bc_ = (itx) >> 2, b_ = bc_ / 36, nc_ = bc_ - b_ * 36; const int base_ = b_ * TPB + nc_ * 64, lo_ = b_ * TPB + (nc_ < 4 ? 0 : CTX), hi_ = b_ * TPB + (nc_ < 4 ? CTX : TPB); \
        _Pragma("unroll") for (int k = 0; k < 4; ++k) { const int q = tid + NTHR * k; const int rr = q / 24, pc = q - rr * 24; const int r = base_ - 2 + rr; \
            praw[k] = (q < 68 * 24 && r >= lo_ && r < hi_) ? *(const u32x4*)(P + (size_t)r * NP + (pc >> 3) * 256 + h_ * 64 + (pc & 7) * 8) : (u32x4){0u, 0u, 0u, 0u}; } } while (0)
    u32x4 praw[4];
    if ((int)blockIdx.x < BATCH * 36 * 4) PREP_LOADRAW((int)blockIdx.x);
    for (int it = blockIdx.x; it < BATCH * 36 * 4; it += gridDim.x) {
        const int h = it & 3, bc = it >> 2, b = bc / 36, nc = bc - b * 36;
        const int base = b * TPB + nc * 64;
        float wc[5][4];
        { const int ch = c4 * 4, pcol = (ch >> 6) * 256 + h * 64 + (ch & 63);
#pragma unroll
          for (int t = 0; t < 5; ++t) { const f32x4 w4 = *(const f32x4*)(cw + t * 768 + pcol); wc[t][0] = w4[0]; wc[t][1] = w4[1]; wc[t][2] = w4[2]; wc[t][3] = w4[3]; } }
#pragma unroll
        for (int k = 0; k < 4; ++k) { const int q = tid + NTHR * k; if (q < 68 * 24) { const int rr = q / 24, pc = q - rr * 24; *(LAS u32x4*)(RAW + rr * RST + pc * 8) = praw[k]; } }
        if (it + (int)gridDim.x < BATCH * 36 * 4) PREP_LOADRAW(it + (int)gridDim.x);
        __syncthreads();
        if (tid < 480) {
#pragma unroll
            for (int m = 0; m < 7; ++m) { const int pp = tg + 10 * m; if (pp < 64) { float a0 = 0.f, a1 = 0.f, a2 = 0.f, a3 = 0.f;
#pragma unroll
                for (int t = 0; t < 5; ++t) { const u32x2 raw = *(const LAS u32x2*)(RAW + (pp + t) * RST + c4 * 4);
                    a0 += bflo(raw[0]) * wc[t][0]; a1 += bfhi(raw[0]) * wc[t][1]; a2 += bflo(raw[1]) * wc[t][2]; a3 += bfhi(raw[1]) * wc[t][3]; }
                f32x4 o; o[0] = a0 / (1.f + __expf(-a0)); o[1] = a1 / (1.f + __expf(-a1)); o[2] = a2 / (1.f + __expf(-a2)); o[3] = a3 / (1.f + __expf(-a3));
                *(LAS f32x4*)(cdst + pp * SST) = o; } } }
        __syncthreads();
        { const int t = tid >> 3, part = tid & 7;
          const f32x4 q0 = *(const LAS f32x4*)(qs + t * SST + part * 8), q1 = *(const LAS f32x4*)(qs + t * SST + part * 8 + 4);
          const f32x4 k0 = *(const LAS f32x4*)(ks + t * SST + part * 8), k1 = *(const LAS f32x4*)(ks + t * SST + part * 8 + 4);
          const f32x4 v0 = *(const LAS f32x4*)(vs + t * SST + part * 8), v1 = *(const LAS f32x4*)(vs + t * SST + part * 8 + 4);
          float sq = (q0[0] * q0[0] + q0[1] * q0[1]) + (q0[2] * q0[2] + q0[3] * q0[3]) + (q1[0] * q1[0] + q1[1] * q1[1]) + (q1[2] * q1[2] + q1[3] * q1[3]);
          float sk = (k0[0] * k0[0] + k0[1] * k0[1]) + (k0[2] * k0[2] + k0[3] * k0[3]) + (k1[0] * k1[0] + k1[1] * k1[1]) + (k1[2] * k1[2] + k1[3] * k1[3]);
          sq = sum8(sq); sk = sum8(sk);
          const float rq = rsqrtf(sq + EPS) * 0.125f, rk = rsqrtf(sk + EPS);
          u32x4 qo, ko, vo;
          qo[0] = pk2(q0[0] * rq, q0[1] * rq); qo[1] = pk2(q0[2] * rq, q0[3] * rq); qo[2] = pk2(q1[0] * rq, q1[1] * rq); qo[3] = pk2(q1[2] * rq, q1[3] * rq);
          ko[0] = pk2(k0[0] * rk, k0[1] * rk); ko[1] = pk2(k0[2] * rk, k0[3] * rk); ko[2] = pk2(k1[0] * rk, k1[1] * rk); ko[3] = pk2(k1[2] * rk, k1[3] * rk);
          vo[0] = pk2(v0[0], v0[1]); vo[1] = pk2(v0[2], v0[3]); vo[2] = pk2(v1[0], v1[1]); vo[3] = pk2(v1[2], v1[3]);
          bf16_t* dst = QKV + ((size_t)(base + t) * 4 + h) * 192 + part * 8;
          *(u32x4*)dst = qo; *(u32x4*)(dst + 64) = ko; *(u32x4*)(dst + 128) = vo; }
        __syncthreads();
    }
#undef PREP_LOADRAW
    { bf16_t* Pw = (bf16_t*)(p.ws + WS_P); const float* rc = (const float*)(p.ws + WS_ROPE); const float* rs = rc + 2048 * 32;
      const int gt = blockIdx.x * NTHR + tid, GT = gridDim.x * NTHR;
      for (int idx = gt; idx < BATCH * SEQ * 8; idx += GT) { const int rl = idx >> 3, rem = idx & 7, kh = rem >> 2, g = rem & 3;
          const int bb = rl >> 11, t = rl & 2047;
          bf16_t* pp = Pw + (size_t)(bb * TPB + CTX + t) * NP + PC_SK + kh * 64 + g * 8;
          const u32x4 r1 = *(const u32x4*)pp, r2 = *(const u32x4*)(pp + 32);
          const f32x4 c0 = *(const f32x4*)(rc + t * 32 + g * 8), c1 = *(const f32x4*)(rc + t * 32 + g * 8 + 4), s0 = *(const f32x4*)(rs + t * 32 + g * 8), s1 = *(const f32x4*)(rs + t * 32 + g * 8 + 4);
          u32x4 o1, o2;
#pragma unroll
          for (int e = 0; e < 4; ++e) { const float xa = bflo(r1[e]), xb = bfhi(r1[e]), ya = bflo(r2[e]), yb = bfhi(r2[e]);
              const float ca = e < 2 ? c0[2 * e] : c1[2 * e - 4], cb = e < 2 ? c0[2 * e + 1] : c1[2 * e - 3], sa = e < 2 ? s0[2 * e] : s1[2 * e - 4], sb = e < 2 ? s0[2 * e + 1] : s1[2 * e - 3];
              o1[e] = pk2(xa * ca - ya * sa, xb * cb - yb * sb); o2[e] = pk2(xa * sa + ya * ca, xb * sb + yb * cb); }
          *(u32x4*)pp = o1; *(u32x4*)(pp + 32) = o2; } }
}

__device__ __forceinline__ void dn_seq(const Params& p, int l, int s, LAS unsigned char* lds, const int wvs) {
    const int tid = wvs * 64 + lane_id_fresh(); const int lane = tid & 63;
    const int b = s >> 3, h = (s >> 1) & 3, d = s & 1;
    constexpr int TILEB = 64 * HST * 2, BUFB = 6 * TILEB + 4 * 16 * 24 * 2 + 1024;
    LAS bf16_t* OB = (LAS bf16_t*)(lds + 2 * BUFB); LAS float* LF = (LAS float*)(lds + 2 * BUFB + TILEB);
    const bf16_t* QKV = (const bf16_t*)(p.ws + WS_QKV);
    const float* AB = (const float*)(p.ws + WS_AB);
    bf16_t* OD = (bf16_t*)(p.ws + WS_OD) + (size_t)d * M * 512 + h * 64;
    const float nA = -expf(p.dn_A_log[(l * 2 + d) * 4 + h]); const float dtb = p.dn_dt_bias[(l * 2 + d) * 4 + h];
    const int fr = lane & 15, fq = lane >> 4, V = wvs & 3;
    const bool isP = wvs < 4;
    const f32x4 zero4 = (f32x4){0.f, 0.f, 0.f, 0.f};
    u32x4 praw[6]; float pa = 0.f, pb_ = 0.f;
    f32x4 Sacc[4], R[4], QS[4];
#pragma unroll
    for (int T = 0; T < 4; ++T) { Sacc[T] = zero4; R[T] = zero4; QS[T] = zero4; }
#define DN_BASE(ci) (b * TPB + ((d == 0) ? (ci) : ((ci) < 4 ? 3 - (ci) : 39 - (ci))) * 64)
#define DN_LOADRAW(ci) do { const int base_ = DN_BASE(ci); int tl_ = tid; asm volatile("" : "+v"(tl_)); _Pragma("unroll") for (int k = 0; k < 6; ++k) { const int q = tl_ + 256 * k; const int rr = q / 24, pc = q - rr * 24; \
            praw[k] = *(const u32x4*)(QKV + ((size_t)(base_ + rr) * 4 + h) * 192 + pc * 8); } \
        if (wvs == 0) { const int r_ = base_ + (d ? 63 - lane : lane); pa = AB[(size_t)r_ * 16 + d * 4 + h]; pb_ = AB[(size_t)r_ * 16 + 8 + d * 4 + h]; } } while (0)
#define DN_S1(buf) do { LAS bf16_t* QH_ = (LAS bf16_t*)(lds + (buf) * BUFB); LAS float* SCL_ = (LAS float*)(lds + (buf) * BUFB + 6 * TILEB + 4 * 16 * 24 * 2); \
        int tl_ = tid; asm volatile("" : "+v"(tl_)); _Pragma("unroll") for (int k = 0; k < 6; ++k) { const int q = tl_ + 256 * k; const int rr = q / 24, pc = q - rr * 24; const int t = d ? 63 - rr : rr; \
            *(LAS u32x4*)(QH_ + (pc >> 3) * 64 * HST + t * HST + (pc & 7) * 8) = praw[k]; } \
        if (wvs == 0) { const float xs = pa + dtb; const float sp = xs > 15.f ? xs : (xs < -15.f ? __expf(xs) : __logf(1.f + __expf(xs))); float x = nA * sp; \
            _Pragma("unroll") for (int o = 1; o < 64; o <<= 1) { const float y = bperm(x, lane - o); if (lane >= o) x += y; } \
            SCL_[lane] = x; SCL_[64 + lane] = __expf(x); SCL_[128 + lane] = __builtin_amdgcn_rcpf(1.f + __expf(-pb_)); if (lane == 63) { SCL_[192] = x; SCL_[193] = __expf(x); } } } while (0)
    if (isP) {
        DN_LOADRAW(0); DN_S1(0);
        __syncthreads();
    for (int ci = -1; ci < 36; ++ci) {
        const int cur = ci & 1, nxt = cur ^ 1;
        LAS bf16_t* QH = (LAS bf16_t*)(lds + cur * BUFB); LAS bf16_t* KH = QH + 64 * HST; LAS bf16_t* VB = KH + 64 * HST; LAS bf16_t* KTT = VB + 64 * HST; LAS bf16_t* LM = KTT + 64 * HST; LAS bf16_t* SCM = LM + 64 * HST;
        LAS bf16_t* DI = SCM + 64 * HST; LAS float* GC = (LAS float*)(DI + 4 * 16 * 24); LAS float* EG = GC + 64; LAS float* BETA = EG + 64; LAS float* GL = BETA + 64;
            if (ci >= 0) {
                const int I = wvs;
                { const int t = tid >> 2, part = tid & 3; const float ekt = __expf(GL[0] - GC[t]);
#pragma unroll
                  for (int hh = 0; hh < 2; ++hh) { const u32x4 kr = *(const LAS u32x4*)(KH + t * HST + part * 16 + hh * 8);
#pragma unroll
                      for (int e = 0; e < 4; ++e) { KTT[(part * 16 + hh * 8 + 2 * e) * HST + t] = bf1(bflo(kr[e]) * ekt); KTT[(part * 16 + hh * 8 + 2 * e + 1) * HST + t] = bf1(bfhi(kr[e]) * ekt); } } }
                  asm volatile("s_waitcnt lgkmcnt(0)" ::: "memory");
                  { int c = lane & 15; asm volatile("" : "+v"(c)); float x[16]; const LAS f32x4* LB_ = (const LAS f32x4*)(LF + I * 16 * 20);
#define DN_LROW(dst, i0, i1) _Pragma("unroll") for (int i = (i0); i <= (i1); ++i) _Pragma("unroll") for (int j4 = 0; j4 < (i + 3) / 4; ++j4) dst[i - (i0)][j4] = LB_[i * 5 + j4]
#define DN_SOLVE(srcv, i0, i1) _Pragma("unroll") for (int i = (i0); i <= (i1); ++i) { float acc = (i == c) ? 1.f : 0.f; _Pragma("unroll") for (int j2 = 0; j2 < i; ++j2) acc -= srcv[i - (i0)][j2 >> 2][j2 & 3] * x[j2]; x[i] = acc; }
                    x[0] = (c == 0) ? 1.f : 0.f;
                    { f32x4 La[8][2]; DN_LROW(La, 1, 8); asm volatile("s_waitcnt lgkmcnt(0)" ::: "memory"); DN_SOLVE(La, 1, 8); }
                    { f32x4 Lb[4][3]; DN_LROW(Lb, 9, 12); asm volatile("s_waitcnt lgkmcnt(0)" ::: "memory"); DN_SOLVE(Lb, 9, 12); }
                    { f32x4 Lc[3][4]; DN_LROW(Lc, 13, 15); asm volatile("s_waitcnt lgkmcnt(0)" ::: "memory"); DN_SOLVE(Lc, 13, 15); }
#undef DN_LROW
#undef DN_SOLVE
                    if (lane < 16) {
#pragma unroll
                        for (int i = 0; i < 16; ++i) DI[(I * 16 + i) * 24 + c] = bf1(x[i]); } }
            }
            if (ci >= 0 && ci + 1 < 36) DN_S1(nxt);
            __syncthreads();
            {
            const int pb2 = (ci < 0) ? 0 : nxt;
            if (ci + 1 < 36) {
                LAS bf16_t* QHn = (LAS bf16_t*)(lds + pb2 * BUFB); LAS bf16_t* KHn = QHn + 64 * HST; LAS bf16_t* KTTn = KHn + 2 * 64 * HST; LAS bf16_t* LMn = KTTn + 64 * HST; LAS bf16_t* SCMn = LMn + 64 * HST;
                LAS bf16_t* DIn = SCMn + 64 * HST; LAS float* GCn = (LAS float*)(DIn + 4 * 16 * 24); LAS float* BETAn = GCn + 128; LAS float* GLn = GCn + 192;
                { const int I = wvs;
                  float gci[4], bti[4], gcj[4];
#pragma unroll
                  for (int r = 0; r < 4; ++r) { gci[r] = GCn[I * 16 + fq * 4 + r]; bti[r] = BETAn[I * 16 + fq * 4 + r]; gcj[r] = GCn[r * 16 + fr]; }
#pragma unroll
                  for (int J = 0; J < 4; ++J) { f32x4 ckk = zero4, cqk = zero4;
                      if (J <= I) {
#pragma unroll
                          for (int kk = 0; kk < 2; ++kk) { const bf16x8 Ak = *(const LAS bf16x8*)(KHn + (I * 16 + fr) * HST + kk * 32 + fq * 8), Aq = *(const LAS bf16x8*)(QHn + (I * 16 + fr) * HST + kk * 32 + fq * 8);
                              const bf16x8 B = *(const LAS bf16x8*)(KHn + (J * 16 + fr) * HST + kk * 32 + fq * 8);
                              ckk = __builtin_amdgcn_mfma_f32_16x16x32_bf16(Ak, B, ckk, 0, 0, 0); cqk = __builtin_amdgcn_mfma_f32_16x16x32_bf16(Aq, B, cqk, 0, 0, 0); } }
                      const int j = J * 16 + fr; const float gj = gcj[J];
#pragma unroll
                      for (int r = 0; r < 4; ++r) { const int i = I * 16 + fq * 4 + r; const float dec = __expf(fminf(gci[r] - gj, 0.f));
                          const float lvv = bti[r] * ckk[r] * dec, svv = cqk[r] * dec;
                          const float lv = j < i ? lvv : 0.f, sv = j <= i ? svv : 0.f;
                          LMn[i * HST + j] = bf1(lv); SCMn[i * HST + j] = bf1(sv); if (I == J) LF[(I * 16 + fq * 4 + r) * 20 + fr] = lv; } }
 }
                if (ci + 2 < 36) DN_LOADRAW(ci + 2);
            }
            }
            __syncthreads();
        }
    } else {
        __syncthreads();
    for (int ci = -1; ci < 36; ++ci) {
        const int cur = ci & 1, nxt = cur ^ 1;
        LAS bf16_t* QH = (LAS bf16_t*)(lds + cur * BUFB); LAS bf16_t* KH = QH + 64 * HST; LAS bf16_t* VB = KH + 64 * HST; LAS bf16_t* KTT = VB + 64 * HST; LAS bf16_t* LM = KTT + 64 * HST; LAS bf16_t* SCM = LM + 64 * HST;
        LAS bf16_t* DI = SCM + 64 * HST; LAS float* GC = (LAS float*)(DI + 4 * 16 * 24); LAS float* EG = GC + 64; LAS float* BETA = EG + 64; LAS float* GL = BETA + 64;
            if (ci >= 0) {
            if (ci > 0) { const int basep = DN_BASE(ci - 1); const int u = tid - 256;
#pragma unroll
                for (int it = 0; it < 8; ++it) { const int idx = u + 256 * it; const int i = idx >> 5, c2 = (idx & 31) * 2; const int row = basep + (d ? 63 - i : i);
                    *(unsigned*)(OD + (size_t)row * 512 + c2) = *(const LAS unsigned*)(OB + i * HST + c2); } }
            bf16x8 Bs[2];
#pragma unroll
            for (int s2 = 0; s2 < 2; ++s2) Bs[s2] = packB(Sacc[2 * s2], Sacc[2 * s2 + 1]);
#pragma unroll
            for (int I = 0; I < 4; ++I) { f32x4 c = zero4, cq = zero4;
#pragma unroll
                for (int s2 = 0; s2 < 2; ++s2) { c = __builtin_amdgcn_mfma_f32_16x16x32_bf16(ldA_perm(KH, I * 16 + fr, s2, fq), Bs[s2], c, 0, 0, 0); cq = __builtin_amdgcn_mfma_f32_16x16x32_bf16(ldA_perm(QH, I * 16 + fr, s2, fq), Bs[s2], cq, 0, 0, 0); }
#pragma unroll
                for (int r = 0; r < 4; ++r) { const int i = I * 16 + fq * 4 + r; R[I][r] = BETA[i] * (bflo((unsigned)VB[i * HST + V * 16 + fr]) - EG[i] * c[r]); QS[I][r] = EG[i] * cq[r]; } }
                    }
            __syncthreads();
            if (ci >= 0) {
            bf16x8 Bx0, Bx1;
            { bf16x8 AD[4];
#pragma unroll
              for (int I = 0; I < 4; ++I) { const u32x2 lo = *(const LAS u32x2*)(DI + (I * 16 + fr) * 24 + fq * 4); u32x4 av; av[0] = lo[0]; av[1] = lo[1]; av[2] = 0u; av[3] = 0u; AD[I] = __builtin_bit_cast(bf16x8, av); }
              const f32x4 X0 = __builtin_amdgcn_mfma_f32_16x16x32_bf16(AD[0], packB(R[0], zero4), zero4, 0, 0, 0);
              f32x4 T1 = __builtin_amdgcn_mfma_f32_16x16x32_bf16(ldA_perm(LM, 16 + fr, 0, fq), packB(X0, zero4), zero4, 0, 0, 0);
              const f32x4 X1 = __builtin_amdgcn_mfma_f32_16x16x32_bf16(AD[1], packB(R[1] - T1, zero4), zero4, 0, 0, 0);
              Bx0 = packB(X0, X1);
              f32x4 T2 = __builtin_amdgcn_mfma_f32_16x16x32_bf16(ldA_perm(LM, 32 + fr, 0, fq), Bx0, zero4, 0, 0, 0);
              const f32x4 X2 = __builtin_amdgcn_mfma_f32_16x16x32_bf16(AD[2], packB(R[2] - T2, zero4), zero4, 0, 0, 0);
              f32x4 T3 = __builtin_amdgcn_mfma_f32_16x16x32_bf16(ldA_perm(LM, 48 + fr, 0, fq), Bx0, zero4, 0, 0, 0);
              T3 = __builtin_amdgcn_mfma_f32_16x16x32_bf16(ldA_perm(LM, 48 + fr, 1, fq), packB(X2, zero4), T3, 0, 0, 0);
              const f32x4 X3 = __builtin_amdgcn_mfma_f32_16x16x32_bf16(AD[3], packB(R[3] - T3, zero4), zero4, 0, 0, 0);
              Bx1 = packB(X2, X3); }
#pragma unroll
            for (int I = 0; I < 4; ++I) { f32x4 c = QS[I];
                c = __builtin_amdgcn_mfma_f32_16x16x32_bf16(ldA_perm(SCM, I * 16 + fr, 0, fq), Bx0, c, 0, 0, 0);
                c = __builtin_amdgcn_mfma_f32_16x16x32_bf16(ldA_perm(SCM, I * 16 + fr, 1, fq), Bx1, c, 0, 0, 0);
#pragma unroll
                for (int r = 0; r < 4; ++r) OB[(I * 16 + fq * 4 + r) * HST + V * 16 + fr] = bf1(c[r]); }
            { const float egl = GL[1];
#pragma unroll
              for (int T = 0; T < 4; ++T) { f32x4 c = Sacc[T] * egl;
                  c = __builtin_amdgcn_mfma_f32_16x16x32_bf16(ldA_perm(KTT, T * 16 + fr, 0, fq), Bx0, c, 0, 0, 0);
                  c = __builtin_amdgcn_mfma_f32_16x16x32_bf16(ldA_perm(KTT, T * 16 + fr, 1, fq), Bx1, c, 0, 0, 0);
                  Sacc[T] = c; } }
                    }
            __syncthreads();
        }
    }
    if (!isP) { const int basep = DN_BASE(35); const int u = tid - 256;
#pragma unroll
        for (int it = 0; it < 8; ++it) { const int idx = u + 256 * it; const int i = idx >> 5, c2 = (idx & 31) * 2; const int row = basep + (d ? 63 - i : i);
            *(unsigned*)(OD + (size_t)row * 512 + c2) = *(const LAS unsigned*)(OB + i * HST + c2); } }
    __syncthreads();
#undef DN_BASE
#undef DN_LOADRAW
#undef DN_S1
}

__device__ __forceinline__ void hg_seq(const Params& p, int l, int s, LAS unsigned char* lds, const int wvs) {
    const int tid = wvs * 64 + lane_id_fresh(); const int lane = tid & 63;
    const int b = s >> 3, h = (s >> 1) & 3, d = s & 1;
    constexpr int BUFB = 5 * 64 * HST * 2;
    LAS bf16_t* SC = (LAS bf16_t*)(lds + 2 * BUFB); LAS bf16_t* OB = SC + 64 * HST;
    LAS float* GS = (LAS float*)(OB + 64 * HST); LAS float* EBL = GS + 256;
    const bf16_t* P = (const bf16_t*)(p.ws + WS_P);
    bf16_t* OD = (bf16_t*)(p.ws + WS_OD) + (size_t)d * M * 512 + 256 + h * 64;
    const bool isA = wvs < 4;
    const int kx = tid & 63, g = wvs & 3;
    const float lb = ((const float*)(p.ws + WS_LB))[(d * DEPTH + l) * 256 + h * 64 + kx];
    const int fr = lane & 15, fq = lane >> 4, V = wvs & 3;
    f32x4 Sacc[4];
#pragma unroll
    for (int T = 0; T < 4; ++T) Sacc[T] = (f32x4){0.f, 0.f, 0.f, 0.f};
    unsigned short rq[16], rz[16], rv[16];
    float qv[16], kv[16], bc[16];
#define HG_BASE(ci) (b * TPB + ((d == 0) ? (ci) : ((ci) < 4 ? 3 - (ci) : 39 - (ci))) * 64)
#define HG_LOADRAW(ci) do { const int base_ = HG_BASE(ci); _Pragma("unroll") for (int e = 0; e < 16; ++e) { const int t = g * 16 + e; const int pp = d ? 63 - t : t; const bf16_t* rp = P + (size_t)(base_ + pp) * NP + h * 64 + kx; \
        rq[e] = rp[PC_HQ]; rz[e] = rp[PC_HF + d * 256]; rv[e] = rp[PC_HI]; } } while (0)
#define HG_A1(buf) do { LAS bf16_t* VT_ = (LAS bf16_t*)(lds + (buf) * BUFB) + 4 * 64 * HST; float run = 0.f; \
        _Pragma("unroll") for (int e = 0; e < 16; ++e) { const float z = bflo(rz[e]); const float sg = __builtin_amdgcn_rcpf(1.f + __expf(-z)); const float f = lb + (1.f - lb) * sg; \
            run += __logf(f); bc[e] = run; kv[e] = (1.f - lb) * (1.f - sg); qv[e] = bflo(rq[e]); VT_[kx * HST + g * 16 + e] = rv[e]; } \
        GS[g * 64 + kx] = run; } while (0)
#define HG_A2(buf) do { LAS bf16_t* QT_ = (LAS bf16_t*)(lds + (buf) * BUFB); LAS bf16_t* KT_ = QT_ + 64 * HST; LAS bf16_t* QP_ = KT_ + 64 * HST; LAS bf16_t* KTT_ = QP_ + 64 * HST; \
        const float g0 = GS[kx], g1 = GS[64 + kx], g2 = GS[128 + kx], g3 = GS[192 + kx]; const float mid = g0 + g1, bl = (g0 + g1) + (g2 + g3); \
        const float off = (g > 0 ? g0 : 0.f) + (g > 1 ? g1 : 0.f) + (g > 2 ? g2 : 0.f); \
        if (g == 3) EBL[(buf) * 64 + kx] = __expf(bl); \
        _Pragma("unroll") for (int e = 0; e < 16; ++e) { const int t = g * 16 + e; const float bce = bc[e] + off; const float E = fminf(fmaxf(bce - mid, -80.f), 80.f); \
            QT_[t * HST + kx] = bf1(qv[e] * __expf(E)); KT_[t * HST + kx] = bf1(kv[e] * __expf(-E)); \
            QP_[t * HST + kx] = bf1(qv[e] * __expf(bce)); KTT_[kx * HST + t] = bf1(kv[e] * __expf(bl - bce)); } } while (0)
    if (isA) { HG_LOADRAW(0); HG_A1(0); }
    __syncthreads();
    if (isA) { HG_A2(0); HG_LOADRAW(1); }
    __syncthreads();
    for (int ci = 0; ci < 36; ++ci) {
        const int cur = ci & 1, nxt = cur ^ 1;
        LAS bf16_t* QT = (LAS bf16_t*)(lds + cur * BUFB); LAS bf16_t* KT = QT + 64 * HST; LAS bf16_t* QP = KT + 64 * HST; LAS bf16_t* KTT = QP + 64 * HST; LAS bf16_t* VT = KTT + 64 * HST;
        if (isA) { if (ci + 1 < 36) HG_A1(nxt); }
        else {
            if (ci > 0) { const int basep = HG_BASE(ci - 1); const int u = tid - 256;
#pragma unroll
                for (int it = 0; it < 8; ++it) { const int idx = u + 256 * it; const int i = idx >> 5, c2 = (idx & 31) * 2; const int row = basep + (d ? 63 - i : i);
                    *(unsigned*)(OD + (size_t)row * 512 + c2) = *(const LAS unsigned*)(OB + i * HST + c2); } }
            { const int I = V;
#pragma unroll
              for (int J = 0; J < 4; ++J) { f32x4 c = (f32x4){0.f, 0.f, 0.f, 0.f};
                  if (J <= I) {
#pragma unroll
                      for (int kk = 0; kk < 2; ++kk) { const bf16x8 A = *(const LAS bf16x8*)(QT + (I * 16 + fr) * HST + kk * 32 + fq * 8); const bf16x8 B = *(const LAS bf16x8*)(KT + (J * 16 + fr) * HST + kk * 32 + fq * 8);
                          c = __builtin_amdgcn_mfma_f32_16x16x32_bf16(A, B, c, 0, 0, 0); } }
#pragma unroll
                  for (int r = 0; r < 4; ++r) { const int i = I * 16 + fq * 4 + r, j = J * 16 + fr; SC[i * HST + j] = bf1(j <= i ? c[r] : 0.f); } } }
        }
        __syncthreads();
        if (isA) { if (ci + 1 < 36) { HG_A2(nxt); if (ci + 2 < 36) HG_LOADRAW(ci + 2); } }
        else {
            bf16x8 Bs[2], Bv[2];
#pragma unroll
            for (int s2 = 0; s2 < 2; ++s2) { Bs[s2] = packB(Sacc[2 * s2], Sacc[2 * s2 + 1]); Bv[s2] = *(const LAS bf16x8*)(VT + (V * 16 + fr) * HST + s2 * 32 + fq * 8); }
#pragma unroll
            for (int I = 0; I < 4; ++I) { f32x4 o = (f32x4){0.f, 0.f, 0.f, 0.f};
#pragma unroll
                for (int s2 = 0; s2 < 2; ++s2) o = __builtin_amdgcn_mfma_f32_16x16x32_bf16(ldA_perm(QP, I * 16 + fr, s2, fq), Bs[s2], o, 0, 0, 0);
#pragma unroll
                for (int s2 = 0; s2 < 2; ++s2) { const bf16x8 A = *(const LAS bf16x8*)(SC + (I * 16 + fr) * HST + s2 * 32 + fq * 8); o = __builtin_amdgcn_mfma_f32_16x16x32_bf16(A, Bv[s2], o, 0, 0, 0); }
#pragma unroll
                for (int r = 0; r < 4; ++r) OB[(I * 16 + fq * 4 + r) * HST + V * 16 + fr] = bf1(o[r]); }
#pragma unroll
            for (int T = 0; T < 4; ++T) { f32x4 c;
#pragma unroll
                for (int r = 0; r < 4; ++r) c[r] = Sacc[T][r] * EBL[cur * 64 + T * 16 + fq * 4 + r];
#pragma unroll
                for (int s2 = 0; s2 < 2; ++s2) { const bf16x8 A = *(const LAS bf16x8*)(KTT + (T * 16 + fr) * HST + s2 * 32 + fq * 8); c = __builtin_amdgcn_mfma_f32_16x16x32_bf16(A, Bv[s2], c, 0, 0, 0); }
                Sacc[T] = c; }
        }
        __syncthreads();
    }
    if (!isA) { const int basep = HG_BASE(35); const int u = tid - 256;
#pragma unroll
        for (int it = 0; it < 8; ++it) { const int idx = u + 256 * it; const int i = idx >> 5, c2 = (idx & 31) * 2; const int row = basep + (d ? 63 - i : i);
            *(unsigned*)(OD + (size_t)row * 512 + c2) = *(const LAS unsigned*)(OB + i * HST + c2); } }
    __syncthreads();
#undef HG_BASE
#undef HG_LOADRAW
#undef HG_A1
#undef HG_A2
}

constexpr int KST = 72, VST = 136;
__device__ __forceinline__ void swa_unit(const Params& p, int l, int unit, LAS unsigned char* lds, const int wvs) {
    const int tid = wvs * 64 + lane_id_fresh(); const int lane = tid & 63;
    int b, kvh, qb;
    if (unit < 512) { b = unit >> 5; kvh = (unit >> 4) & 1; qb = 2 + (unit & 15); } else { const int v = unit - 512; b = v >> 2; kvh = (v >> 1) & 1; qb = v & 1; }
    const bool qctx = qb < 2;
    const bf16_t* P = (const bf16_t*)(p.ws + WS_P);
    const float* rc = (const float*)(p.ws + WS_ROPE); const float* rs = rc + 2048 * 32;
    bf16_t* Y = (bf16_t*)(p.ws + WS_HY);
    LAS bf16_t* Ks = (LAS bf16_t*)lds; LAS bf16_t* Vt = Ks + 128 * KST;
    const int hh = wvs >> 1, qhalf = wvs & 1, head = kvh * 4 + hh;
    const int fr = lane & 15, fq = lane >> 4;
    const int rowq0 = b * TPB + qb * 128 + qhalf * 64;
    const int f0 = (!qctx && qb == 2) ? 1 : 0, nl = qctx ? 0 : 3 - f0 - (qb == 17 ? 1 : 0), nkb = nl + 2;
#define SWA_BLK(j) ((j) < nl ? qb - 1 + f0 + (j) : (j) - nl)
#define SWA_REL(j) ((j) < nl ? f0 + (j) - 1 : 0)
    bf16x8 qf[4][2];
#pragma unroll
    for (int qt = 0; qt < 4; ++qt) {
        const int row = rowq0 + qt * 16 + fr; const bf16_t* qp = P + (size_t)row * NP + PC_SQ + head * 64 + fq * 8;
        const u32x4 r1 = *(const u32x4*)qp, r2 = *(const u32x4*)(qp + 32);
        float a1[8], a2[8];
#pragma unroll
        for (int e = 0; e < 4; ++e) { a1[2 * e] = bflo(r1[e]); a1[2 * e + 1] = bfhi(r1[e]); a2[2 * e] = bflo(r2[e]); a2[2 * e + 1] = bfhi(r2[e]); }
        if (!qctx) { const int t = (qb - 2) * 128 + qhalf * 64 + qt * 16 + fr; const float* cp = rc + t * 32 + fq * 8; const float* sp = rs + t * 32 + fq * 8;
#pragma unroll
            for (int e = 0; e < 8; ++e) { const float cs = cp[e], sn = sp[e]; const float o1 = a1[e] * cs - a2[e] * sn, o2 = a1[e] * sn + a2[e] * cs; a1[e] = o1; a2[e] = o2; } }
        u32x4 o1, o2;
#pragma unroll
        for (int e = 0; e < 4; ++e) { o1[e] = pk2(a1[2 * e] * 0.125f, a1[2 * e + 1] * 0.125f); o2[e] = pk2(a2[2 * e] * 0.125f, a2[2 * e + 1] * 0.125f); }
        qf[qt][0] = __builtin_bit_cast(bf16x8, o1); qf[qt][1] = __builtin_bit_cast(bf16x8, o2);
    }
    const int skey = tid >> 2, sg = tid & 3;
    const float sink = p.swa_sink[l * 8 + head];
    float mrun[4], lrun[4]; f32x4 O[4][4];
#pragma unroll
    for (int qt = 0; qt < 4; ++qt) { mrun[qt] = sink; lrun[qt] = 1.f;
#pragma unroll
        for (int dv = 0; dv < 4; ++dv) O[qt][dv] = (f32x4){0.f, 0.f, 0.f, 0.f}; }
    for (int j = 0; j < nkb; ++j) {
        const int rel = SWA_REL(j);
        u32x4 kreg[2], vreg[2];
        { const int rowk0 = b * TPB + SWA_BLK(j) * 128; const bf16_t* kp = P + (size_t)(rowk0 + skey) * NP + PC_SK + kvh * 64 + sg * 8;
          kreg[0] = *(const u32x4*)kp; kreg[1] = *(const u32x4*)(kp + 32);
#pragma unroll
          for (int it = 0; it < 2; ++it) { const int idx = tid + NTHR * it; vreg[it] = *(const u32x4*)(P + (size_t)(rowk0 + (idx >> 3)) * NP + PC_SV + kvh * 64 + (idx & 7) * 8); } }
        *(LAS u32x4*)(Ks + skey * KST + sg * 8) = kreg[0]; *(LAS u32x4*)(Ks + skey * KST + 32 + sg * 8) = kreg[1];
#pragma unroll
        for (int it = 0; it < 2; ++it) { const int idx = tid + NTHR * it; const int vk = idx >> 3, vg = idx & 7;
#pragma unroll
            for (int e = 0; e < 4; ++e) { Vt[(vg * 8 + 2 * e) * VST + vk] = (bf16_t)(vreg[it][e] & 0xffffu); Vt[(vg * 8 + 2 * e + 1) * VST + vk] = (bf16_t)(vreg[it][e] >> 16); } }
        __syncthreads();
#pragma unroll
        for (int qp2 = 0; qp2 < 2; ++qp2) {
            f32x4 Sx[2][8];
#pragma unroll
            for (int kt = 0; kt < 8; ++kt) { Sx[0][kt] = (f32x4){0.f, 0.f, 0.f, 0.f}; Sx[1][kt] = (f32x4){0.f, 0.f, 0.f, 0.f};
#pragma unroll
                for (int kk = 0; kk < 2; ++kk) { const bf16x8 A = *(const LAS bf16x8*)(Ks + (kt * 16 + fr) * KST + kk * 32 + fq * 8);
                    Sx[0][kt] = __builtin_amdgcn_mfma_f32_16x16x32_bf16(A, qf[2 * qp2][kk], Sx[0][kt], 0, 0, 0);
                    Sx[1][kt] = __builtin_amdgcn_mfma_f32_16x16x32_bf16(A, qf[2 * qp2 + 1][kk], Sx[1][kt], 0, 0, 0); } }
#pragma unroll
            for (int u = 0; u < 2; ++u) { const int qt = 2 * qp2 + u;
                if (rel != 0) { int qi = qhalf * 64 + qt * 16 + fr; asm volatile("" : "+v"(qi));
#pragma unroll
                    for (int kt = 0; kt < 8; ++kt)
#pragma unroll
                        for (int jx = 0; jx < 4; ++jx) { const int kx = kt * 16 + fq * 4 + jx; const bool ok = rel < 0 ? (kx >= qi) : (kx <= qi); if (!ok) Sx[u][kt][jx] = -1e30f; } }
                float mx = -1e30f;
#pragma unroll
                for (int kt = 0; kt < 8; ++kt) mx = fmaxf(mx, fmaxf(fmaxf(Sx[u][kt][0], Sx[u][kt][1]), fmaxf(Sx[u][kt][2], Sx[u][kt][3])));
                mx = xrow16_max(mx);
                const float mnew = fmaxf(mrun[qt], mx); const float alpha = __expf(mrun[qt] - mnew); mrun[qt] = mnew;
                float rsum = 0.f;
#pragma unroll
                for (int kt = 0; kt < 8; ++kt)
#pragma unroll
                    for (int jx = 0; jx < 4; ++jx) { const float e = __expf(Sx[u][kt][jx] - mnew); Sx[u][kt][jx] = e; rsum += e; }
                rsum = xrow16_sum(rsum);
                lrun[qt] = lrun[qt] * alpha + rsum;
#pragma unroll
                for (int dv = 0; dv < 4; ++dv) O[qt][dv] = O[qt][dv] * alpha; }
#pragma unroll
            for (int ks2 = 0; ks2 < 4; ++ks2) {
                bf16x8 Bp[2];
#pragma unroll
                for (int u = 0; u < 2; ++u) { u32x4 pb; pb[0] = pk2(Sx[u][2 * ks2][0], Sx[u][2 * ks2][1]); pb[1] = pk2(Sx[u][2 * ks2][2], Sx[u][2 * ks2][3]); pb[2] = pk2(Sx[u][2 * ks2 + 1][0], Sx[u][2 * ks2 + 1][1]); pb[3] = pk2(Sx[u][2 * ks2 + 1][2], Sx[u][2 * ks2 + 1][3]); Bp[u] = __builtin_bit_cast(bf16x8, pb); }
#pragma unroll
                for (int dv = 0; dv < 4; ++dv) { const LAS bf16_t* vp = Vt + (dv * 16 + fr) * VST + ks2 * 32 + fq * 4;
                    const u32x2 lo = *(const LAS u32x2*)vp, hi = *(const LAS u32x2*)(vp + 16);
                    u32x4 av; av[0] = lo[0]; av[1] = lo[1]; av[2] = hi[0]; av[3] = hi[1]; const bf16x8 Av = __builtin_bit_cast(bf16x8, av);
                    O[2 * qp2][dv] = __builtin_amdgcn_mfma_f32_16x16x32_bf16(Av, Bp[0], O[2 * qp2][dv], 0, 0, 0);
                    O[2 * qp2 + 1][dv] = __builtin_amdgcn_mfma_f32_16x16x32_bf16(Av, Bp[1], O[2 * qp2 + 1][dv], 0, 0, 0); }
            }
        }
        __syncthreads();
    }
#undef SWA_BLK
#undef SWA_REL
#pragma unroll
    for (int qt = 0; qt < 4; ++qt) { const float inv = 1.f / lrun[qt]; const int row = rowq0 + qt * 16 + fr;
#pragma unroll
        for (int dv = 0; dv < 4; ++dv) { u32x2 o2; o2[0] = pk2(O[qt][dv][0] * inv, O[qt][dv][1] * inv); o2[1] = pk2(O[qt][dv][2] * inv, O[qt][dv][3] * inv);
            *(u32x2*)(Y + (size_t)row * D + 256 + head * 64 + dv * 16 + fq * 4) = o2; } }
}

__device__ __forceinline__ void phase_mixers(const Params& p, int l, LAS unsigned char* lds, const int wvs) {
    for (int s = blockIdx.x; s < 256; s += gridDim.x) { if (s < 128) dn_seq(p, l, s, lds, wvs); else hg_seq(p, l, s - 128, lds, wvs); }
    unsigned* ctr = (unsigned*)(p.ws + WS_CTL) + 64 * (1 + l);
    LAS int* su = (LAS int*)(lds + 140 * 1024);
    for (;;) {
        __syncthreads();
        if (wvs == 0 && lane_id_fresh() == 0) su[0] = (int)atomicAdd(ctr, 1u);
        __syncthreads();
        const int unit = su[0];
        if (unit >= (l == DEPTH - 1 ? 512 : 576)) break;
        swa_unit(p, l, unit, lds, wvs);
    }
}

__device__ __forceinline__ void phase_finalize(const Params& p, int l, const int wvs) {
    const int tid = wvs * 64 + lane_id_fresh(); const int lane = tid & 63, w = tid >> 6;
    const int gw = blockIdx.x * NWAVES + w, NGW = gridDim.x * NWAVES;
    const bf16_t* P = (const bf16_t*)(p.ws + WS_P);
    const bf16_t* OD0 = (const bf16_t*)(p.ws + WS_OD); const bf16_t* OD1 = OD0 + (size_t)M * 512;
    bf16_t* Y = (bf16_t*)(p.ws + WS_HY);
    const int seg = lane >> 3, d0 = (lane & 7) * 8;
    const int hd = seg & 3; const bool isdn = seg < 4;
    const float* gain = (isdn ? p.dn_norm : p.hg_norm) + l * 64 + d0;
    const f32x4 g0 = *(const f32x4*)gain, g1 = *(const f32x4*)(gain + 4);
    const int ocol = (isdn ? 0 : 256) + hd * 64 + d0, gcol = (isdn ? PC_DNG : PC_HG) + hd * 64 + d0, ycol = (isdn ? 0 : 768) + hd * 64 + d0;
    for (int r = gw; r < M; r += NGW) {
        const u32x4 a = *(const u32x4*)(OD0 + (size_t)r * 512 + ocol), bq = *(const u32x4*)(OD1 + (size_t)r * 512 + ocol), gt = *(const u32x4*)(P + (size_t)r * NP + gcol);
        float o[8]; float ss = 0.f;
#pragma unroll
        for (int e = 0; e < 4; ++e) { o[2 * e] = bflo(a[e]) + bflo(bq[e]); o[2 * e + 1] = bfhi(a[e]) + bfhi(bq[e]); ss += o[2 * e] * o[2 * e] + o[2 * e + 1] * o[2 * e + 1]; }
        ss = sum8(ss);
        const float rms = rsqrtf(ss * (1.f / 64.f) + EPS);
        u32x4 y;
#pragma unroll
        for (int e = 0; e < 4; ++e) { const float ga = bflo(gt[e]), gb = bfhi(gt[e]);
            const float ge0 = e < 2 ? g0[2 * e] : g1[2 * e - 4], ge1 = e < 2 ? g0[2 * e + 1] : g1[2 * e - 3];
            y[e] = pk2(o[2 * e] * rms * ge0 * siluf(ga), o[2 * e + 1] * rms * ge1 * siluf(gb)); }
        *(u32x4*)(Y + (size_t)r * D + ycol) = y;
    }
}

__device__ __forceinline__ void phase_final(const Params& p, const int wvs) {
    const int tid = wvs * 64 + lane_id_fresh(); const int lane = tid & 63, w = tid >> 6;
    const int gw = blockIdx.x * NWAVES + w, NGW = gridDim.x * NWAVES;
    f32x4 gfv[4];
#pragma unroll
    for (int j = 0; j < 4; ++j) gfv[j] = *(const f32x4*)(p.norm_f + 4 * (lane + 64 * j));
    for (int r = gw; r < BATCH * SEQ; r += NGW) {
        f32x4* xr = (f32x4*)(p.out + ((size_t)r << 10)) + lane;
        f32x4 v[4]; float ss = 0.f;
#pragma unroll
        for (int j = 0; j < 4; ++j) { v[j] = xr[64 * j]; ss += (v[j][0] * v[j][0] + v[j][1] * v[j][1]) + (v[j][2] * v[j][2] + v[j][3] * v[j][3]); }
        const float rstd = rsqrtf(wave_sum(ss) * (1.f / D) + EPS);
#pragma unroll
        for (int j = 0; j < 4; ++j) xr[64 * j] = v[j] * rstd * gfv[j];
    }
}

#define XB_TMO      128
#define XB_XCNT(j)  (256  + 64 * (j))
#define XB_XSUB(j)  (1280 + 64 * (j))
#define XB_XGEN(j)  (2304 + 64 * (j))
#define XB_TOP      3328
#define XB_TOPGEN   3392
#define XCD_BAR_WORDS 3456
#define XB_SPIN_CAP (1u << 18)

__device__ __forceinline__ unsigned xb_ld(unsigned* p)              { return __hip_atomic_load(p, __ATOMIC_RELAXED, __HIP_MEMORY_SCOPE_AGENT); }
__device__ __forceinline__ unsigned xb_add(unsigned* p, unsigned v) { return __hip_atomic_fetch_add(p, v, __ATOMIC_RELAXED, __HIP_MEMORY_SCOPE_AGENT); }
__device__ __forceinline__ unsigned xb_xcc_id() { return (unsigned)__builtin_amdgcn_s_getreg((3 << 11) | 20) & 0xFu; }
#define XB_SPIN(cond, bar) do { unsigned _sp = 0; while (cond) { __builtin_amdgcn_s_sleep(1); \
    if ((++_sp & 255u) == 0u) { if (xb_ld(&(bar)[XB_TMO])) break; if (_sp > XB_SPIN_CAP) { atomicAdd(&(bar)[XB_TMO], 1u); break; } } } } while (0)

struct XcdBarrier {
    unsigned* bar; unsigned x;
    volatile LAS unsigned* st;
};

__device__ __forceinline__ XcdBarrier xcd_barrier_post(unsigned* bar, volatile LAS unsigned* st) {
    XcdBarrier b; b.bar = bar; b.x = xb_xcc_id(); b.st = st;
    if (threadIdx.x == 0) (void)xb_add(&bar[XB_XCNT(b.x)], 1u);
    return b;
}
__device__ __forceinline__ void xcd_barrier_complete(unsigned* bar, unsigned x, unsigned& nloc, unsigned& nx) {
    const unsigned G = gridDim.x * gridDim.y * gridDim.z;
    unsigned sum, cnt, mine, sp = 0u;
    for (;;) {
        sum = 0u; cnt = 0u; mine = 0u;
#pragma unroll
        for (unsigned j = 0; j < 16; ++j) { const unsigned c = xb_ld(&bar[XB_XCNT(j)]); sum += c; cnt += (c > 0u) ? 1u : 0u; mine = (j == x) ? c : mine; }
        if (sum == G) break;
        __builtin_amdgcn_s_sleep(1);
        if ((++sp & 255u) == 0u) { if (xb_ld(&bar[XB_TMO])) break; if (sp > XB_SPIN_CAP) { atomicAdd(&bar[XB_TMO], 1u); break; } }
    }
    nloc = mine > 0u ? mine : 1u; nx = cnt > 0u ? cnt : 1u;
}

__device__ __forceinline__ void xcd_barrier(const XcdBarrier& b, const int wvs) {
    asm volatile("s_waitcnt vmcnt(0)" ::: "memory");
    __syncthreads();
    if (wvs == 0 && lane_id_fresh() == 0) {
        unsigned* bar = b.bar;
        __builtin_amdgcn_s_waitcnt(0);
        unsigned nloc = b.st[0], nx = b.st[1];
        if (nloc == 0u) { xcd_barrier_complete(bar, b.x, nloc, nx); b.st[0] = nloc; b.st[1] = nx; }
        const unsigned old = xb_add(&bar[XB_XSUB(b.x)], 1u);
        const unsigned gen = old / nloc;
        if (old + 1u == (gen + 1u) * nloc) {
            __builtin_amdgcn_fence(__ATOMIC_RELEASE, "agent");
            asm volatile("s_waitcnt vmcnt(0)" ::: "memory");
            const unsigned og = xb_add(&bar[XB_TOP], 1u);
            const unsigned tg = og / nx;
            if (og + 1u == (tg + 1u) * nx) xb_add(&bar[XB_TOPGEN], 1u);
            else XB_SPIN(xb_ld(&bar[XB_TOPGEN]) == tg, bar);
            __builtin_amdgcn_fence(__ATOMIC_ACQUIRE, "agent");
            xb_add(&bar[XB_XGEN(b.x)], 1u);
            asm volatile("s_waitcnt vmcnt(0)" ::: "memory");
        } else {
            XB_SPIN(xb_ld(&bar[XB_XGEN(b.x)]) == gen, bar);
            __builtin_amdgcn_fence(__ATOMIC_ACQUIRE, "agent");
            asm volatile("s_waitcnt vmcnt(0)" ::: "memory");
        }
    }
    __syncthreads();
}

__device__ __forceinline__ void gsync(cg::grid_group& grid) {
    asm volatile("s_waitcnt vmcnt(0) lgkmcnt(0)" ::: "memory");
    grid.sync();
    __builtin_amdgcn_fence(__ATOMIC_ACQUIRE, "agent");
    asm volatile("s_waitcnt vmcnt(0)" ::: "memory");
}
__global__ void __launch_bounds__(NTHR, 2) fwd_megakernel(Params p) {
    extern __shared__ __attribute__((aligned(16))) unsigned char lds_raw[];
    LAS unsigned char* lds = (LAS unsigned char*)lds_raw;
    cg::grid_group grid = cg::this_grid();
    const int G = gridDim.x, c = blockIdx.x;
    const int wvs = __builtin_amdgcn_readfirstlane((int)(threadIdx.x >> 6));
    { volatile LAS unsigned* st0 = (volatile LAS unsigned*)(lds + 143360 + 64); if (threadIdx.x < 2) st0[threadIdx.x] = 0u; }
    __syncthreads();
    const XcdBarrier xbar = xcd_barrier_post((unsigned*)(p.ws + WS_CTL) + 4096, (volatile LAS unsigned*)(lds + 143360 + 64));
    phase_prologue(p, lds, wvs);
    if (p.ws == nullptr) gsync(grid);
    xcd_barrier(xbar, wvs);
    const float* mods = (const float*)(p.ws + WS_MODS);
    float* Xc = (float*)(p.ws + WS_XC);
    bf16_t* HY = (bf16_t*)(p.ws + WS_HY); bf16_t* PB = (bf16_t*)(p.ws + WS_P);
    for (int l = 0; l < DEPTH; ++l) {
        const int lastl = (l == DEPTH - 1) ? 1 : 0;
        phase_norm<true>(p, l, lds, wvs);
        xcd_barrier(xbar, wvs);
        { pg8::Gemm g{HY, (const bf16_t*)(p.ws + WS_WIN), M, NP, D, D}; pg8::StaticOrder S; S.init(M, NP, G, c); pg8::EpiBf16<0> E{PB, NP};
          pg8::gemm_phase<pg8::EpiBf16<0>, pg8::StaticOrder, true, true>(lds, g, S, E, wvs); }
        xcd_barrier(xbar, wvs);
        phase_dnprep(p, l, lds, wvs);
        xcd_barrier(xbar, wvs);
        phase_mixers(p, l, lds, wvs);
        xcd_barrier(xbar, wvs);
        phase_finalize(p, l, wvs);
        xcd_barrier(xbar, wvs);
        { pg8::Gemm g{HY, (const bf16_t*)(p.ws + WS_WOUT), M, D, D, D}; pg8::Order2 S; S.init(D, G, c, 1); pg8::EpiRes E{p.out, Xc, mods + ((size_t)l * 17 * 6 + 2) * 1024, l == 0 ? p.x : (const float*)p.out, l == 0 ? p.ctx : (const float*)Xc};
          pg8::gemm_phase<pg8::EpiRes, pg8::Order2, true, true>(lds, g, S, E, wvs); }
        if (!lastl) { pg8::Gemm g{HY, (const bf16_t*)(p.ws + WS_WOUT), M, D, D / 4, D}; pg8::CtxSplitOrder S; S.init(G, c); pg8::EpiPart E{(float*)(p.ws + WS_QKV)};
          pg8::gemm_phase<pg8::EpiPart, pg8::CtxSplitOrder, false, true>(lds, g, S, E, wvs); }
        xcd_barrier(xbar, wvs);
        phase_norm<false>(p, l, lds, wvs);
        xcd_barrier(xbar, wvs);
        { pg8::Gemm g{HY, (const bf16_t*)(p.ws + WS_W1), M, DFF, D, D}; pg8::Order2 S; S.init(DFF, G, c, lastl); pg8::EpiBf16<1> E{PB, DFF};
          pg8::gemm_phase<pg8::EpiBf16<1>, pg8::Order2, true, true>(lds, g, S, E, wvs); }
        xcd_barrier(xbar, wvs);
        { pg8::Gemm g{PB, (const bf16_t*)(p.ws + WS_W2), M, D, DFF, DFF}; pg8::Order2 S; S.init(D, G, c, 1); pg8::EpiRes E{p.out, Xc, mods + ((size_t)l * 17 * 6 + 5) * 1024, (const float*)p.out, (const float*)Xc};
          pg8::gemm_phase<pg8::EpiRes, pg8::Order2, true, true>(lds, g, S, E, wvs); }
        if (!lastl) { pg8::Gemm g{PB, (const bf16_t*)(p.ws + WS_W2), M, D, DFF / 4, DFF}; pg8::CtxSplitOrder S; S.init(G, c); pg8::EpiPart E{(float*)(p.ws + WS_QKV)};
          pg8::gemm_phase<pg8::EpiPart, pg8::CtxSplitOrder, false, true>(lds, g, S, E, wvs); }
        xcd_barrier(xbar, wvs);
    }
    phase_final(p, wvs);
}

extern "C" void kernel_launch(void* const* d_in, const int* in_sizes, int n_in, void* d_out, int out_size, void* d_ws, size_t ws_size, hipStream_t stream) {
    static int grid = 0;
    if (grid == 0) {
        if (n_in != 20 || ws_size < WS_END) { fprintf(stderr, "kernel_launch: need 20 inputs and >= %zu bytes of workspace (got %d, %zu)\n", (size_t)WS_END, n_in, ws_size); grid = -1; return; }
        int dev = 0, cus = 0, per_cu = 0;
        hipGetDevice(&dev); hipDeviceGetAttribute(&cus, hipDeviceAttributeMultiprocessorCount, dev);
        if (hipFuncSetAttribute((const void*)fwd_megakernel, hipFuncAttributeMaxDynamicSharedMemorySize, LDS_BYTES) != hipSuccess) { fprintf(stderr, "kernel_launch: hipFuncSetAttribute failed\n"); grid = -1; return; }
        if (hipOccupancyMaxActiveBlocksPerMultiprocessor(&per_cu, (const void*)fwd_megakernel, NTHR, LDS_BYTES) != hipSuccess || per_cu < 1) { fprintf(stderr, "kernel_launch: occupancy query says %d blocks/CU\n", per_cu); per_cu = 1; }
        (void)hipGetLastError();
        grid = cus;
    }
    if (grid < 0) return;
    hipMemsetAsync((char*)d_ws + WS_CTL, 0, 65536, stream);
    Params p{};
    const float** pp = (const float**)&p;
    for (int i = 0; i < 20; ++i) pp[i] = (const float*)d_in[i];
    p.out = (float*)d_out; p.ws = (unsigned char*)d_ws;
    void* args[] = {&p};
    hipError_t e = hipLaunchCooperativeKernel((const void*)fwd_megakernel, dim3(grid), dim3(NTHR), args, LDS_BYTES, stream);
    if (e != hipSuccess) fprintf(stderr, "cooperative launch failed: %s (grid %d)\n", hipGetErrorString(e), grid);
}
```
